# Optimizing an MI355X kernel written in HIP

```python
import jax, jax.numpy as jnp
from jax import lax
import numpy as np

D_MODEL = 1024
BATCH = 8
SEQ = 2048
DEPTH = 4
DEC_BATCH = 128
DEC_SEQ = 8
PAST_LEN = 8192
PAGE_SIZE = 128

GDN_DK = 128
GDN_DV = 128
GDN_HEADS = D_MODEL // GDN_DV
GDN_KEY_DIM = GDN_HEADS * GDN_DK
GDN_VAL_DIM = GDN_HEADS * GDN_DV
CONV_WIDTH = 4
CONV_DIM = 2 * GDN_KEY_DIM + GDN_VAL_DIM
GDN_CHUNK = 64
SWA_HD = 64
SWA_HEADS = D_MODEL // SWA_HD
SWA_KV_HEADS = SWA_HEADS // 4
SWA_GROUP = SWA_HEADS // SWA_KV_HEADS
SWA_Q_DIM = SWA_HEADS * SWA_HD
SWA_KV_DIM = SWA_KV_HEADS * SWA_HD
WINDOW = 128
D_FF = 4 * D_MODEL
PLE_DIM = 256
EPS = 1e-6
IN_DIM = CONV_DIM + GDN_VAL_DIM + 2 * GDN_HEADS + SWA_Q_DIM + 2 * SWA_KV_DIM + 2 * D_MODEL

kernel_name = 'hybrid_gdn_swa_decoder_step'


def rmsnorm(x, w):
    xf = x.astype(jnp.float32)
    xf = xf * lax.rsqrt(jnp.mean(xf * xf, axis=-1, keepdims=True) + EPS)
    return xf.astype(x.dtype) * w


def l2norm(x):
    xf = x.astype(jnp.float32)
    return (xf * lax.rsqrt(jnp.sum(xf * xf, axis=-1, keepdims=True) + EPS)).astype(x.dtype)


def causal_conv(u, buf, w):
    t = u.shape[1]
    full = jnp.concatenate([buf.astype(u.dtype), u], axis=1)
    out = full[:, 0:t] * w[0]
    for j in range(1, CONV_WIDTH):
        out = out + full[:, j:j + t] * w[j]
    return jax.nn.silu(out), full[:, t:]


def gated_delta_rule(q, k, v, g, beta, s0):
    b, t, h, dk = q.shape
    dv = v.shape[-1]
    c = min(GDN_CHUNK, t)
    n = -(-t // c)
    pad = n * c - t
    f32 = jnp.float32

    def blocks(a):
        a = a.astype(f32)
        a = jnp.pad(a, [(0, 0), (0, pad)] + [(0, 0)] * (a.ndim - 2))
        a = a.reshape((b, n, c) + a.shape[2:])
        return jnp.moveaxis(a, 2, 3)

    q, k, v, g, beta = blocks(q), blocks(k), blocks(v), blocks(g), blocks(beta)
    gc = jnp.cumsum(g, axis=-1)
    incl = jnp.tril(jnp.ones((c, c), dtype=bool))
    strict = jnp.tril(jnp.ones((c, c), dtype=bool), -1)
    decay = jnp.exp(jnp.where(incl, gc[..., :, None] - gc[..., None, :], -jnp.inf))
    kb = k * beta[..., None]
    a_mat = jnp.where(strict, jnp.einsum('bnhid,bnhjd->bnhij', kb, k) * decay, 0.0)
    rhs = jnp.concatenate([v * beta[..., None], kb * jnp.exp(gc)[..., None]], axis=-1)
    sol = lax.linalg.triangular_solve(a_mat, rhs, left_side=True, lower=True, unit_diagonal=True)
    u, w = sol[..., :dv], sol[..., dv:]
    qk = jnp.einsum('bnhid,bnhjd->bnhij', q, k) * decay

    def step(s, xs):
        q_c, k_c, u_c, w_c, qk_c, g_c = xs
        v_new = u_c - jnp.einsum('bhck,bhkv->bhcv', w_c, s)
        o_c = (jnp.einsum('bhck,bhkv->bhcv', q_c * jnp.exp(g_c)[..., None], s)
               + jnp.einsum('bhij,bhjv->bhiv', qk_c, v_new))
        g_last = g_c[..., -1:]
        s = s * jnp.exp(g_last)[..., None] + jnp.einsum(
            'bhck,bhcv->bhkv', k_c * jnp.exp(g_last - g_c)[..., None], v_new)
        return s, o_c

    xs = (jnp.moveaxis(q, 1, 0), jnp.moveaxis(k, 1, 0), jnp.moveaxis(u, 1, 0),
          jnp.moveaxis(w, 1, 0), jnp.moveaxis(qk, 1, 0), jnp.moveaxis(gc, 1, 0))
    s_final, o = lax.scan(step, s0.astype(f32), xs)
    o = jnp.moveaxis(o, 0, 1)
    o = jnp.moveaxis(o, 3, 2).reshape(b, n * c, h, dv)[:, :t]
    return o, s_final


def gdn_branch(qkv, z, b_logit, a_logit, conv_buf, s0, conv_w, a_log, dt_bias, gdn_norm):
    b, t, _ = qkv.shape
    if conv_buf is None:
        conv_buf = jnp.zeros((b, CONV_WIDTH - 1, CONV_DIM), qkv.dtype)
    if s0 is None:
        s0 = jnp.zeros((b, GDN_HEADS, GDN_DK, GDN_DV), jnp.float32)
    qkv_c, new_buf = causal_conv(qkv, conv_buf, conv_w)
    q = qkv_c[..., :GDN_KEY_DIM].reshape(b, t, GDN_HEADS, GDN_DK)
    k = qkv_c[..., GDN_KEY_DIM:2 * GDN_KEY_DIM].reshape(b, t, GDN_HEADS, GDN_DK)
    v = qkv_c[..., 2 * GDN_KEY_DIM:].reshape(b, t, GDN_HEADS, GDN_DV)
    q = l2norm(q) * (GDN_DK ** -0.5)
    k = l2norm(k)
    beta = jax.nn.sigmoid(b_logit.astype(jnp.float32))
    g = -jnp.exp(a_log.astype(jnp.float32)) * jax.nn.softplus(a_logit.astype(jnp.float32) + dt_bias.astype(jnp.float32))
    o, s_new = gated_delta_rule(q, k, v, g, beta, s0)
    o = rmsnorm(o.astype(v.dtype), gdn_norm) * jax.nn.silu(z.reshape(b, t, GDN_HEADS, GDN_DV))
    return o.reshape(b, t, GDN_VAL_DIM), new_buf, s_new


def alibi_slopes():
    hh = jnp.arange(1, SWA_HEADS + 1, dtype=jnp.float32)
    return jnp.exp2(-8.0 * hh / SWA_HEADS).reshape(SWA_KV_HEADS, SWA_GROUP)


def swa_attend(q, k, v, q_pos, k_pos, sinks, slopes):
    s = jnp.einsum('bnqkgd,bnskd->bnkgqs', q, k).astype(jnp.float32) * (SWA_HD ** -0.5)
    dist = q_pos[:, :, None] - k_pos[:, None, :]
    ok = (dist >= 0) & (dist <= WINDOW) & (k_pos[:, None, :] >= 0)
    s = s - slopes[:, :, None, None] * dist.astype(jnp.float32)[:, None, None]
    s = jnp.where(ok[:, None, None], s, -jnp.inf)
    sink = jnp.broadcast_to(sinks.astype(jnp.float32)[:, :, None, None], s.shape[:-1] + (1,))
    p = jax.nn.softmax(jnp.concatenate([s, sink], axis=-1), axis=-1)[..., :-1]
    return jnp.einsum('bnkgqs,bnskd->bnqkgd', p.astype(v.dtype), v)


def swa_branch(sq, sk, sv, q_norm, k_norm, sinks, cache_k, cache_v):
    b, t, _ = sq.shape
    q = rmsnorm(sq.reshape(b, t, SWA_KV_HEADS, SWA_GROUP, SWA_HD), q_norm)
    k = rmsnorm(sk.reshape(b, t, SWA_KV_HEADS, SWA_HD), k_norm)
    v = sv.reshape(b, t, SWA_KV_HEADS, SWA_HD)
    slopes = alibi_slopes()
    sinks = sinks.reshape(SWA_KV_HEADS, SWA_GROUP)
    if cache_k is None:
        nb = t // WINDOW
        qb = q.reshape(b, nb, WINDOW, SWA_KV_HEADS, SWA_GROUP, SWA_HD)
        zpad = jnp.zeros((b, WINDOW, SWA_KV_HEADS, SWA_HD), k.dtype)

        def band(a):
            prev = jnp.concatenate([zpad, a[:, :-WINDOW]], axis=1).reshape(b, nb, WINDOW, SWA_KV_HEADS, SWA_HD)
            return jnp.concatenate([prev, a.reshape(b, nb, WINDOW, SWA_KV_HEADS, SWA_HD)], axis=2)

        q_pos = jnp.arange(t, dtype=jnp.int32).reshape(nb, WINDOW)
        k_pos = (jnp.arange(nb, dtype=jnp.int32)[:, None] - 1) * WINDOW + jnp.arange(2 * WINDOW, dtype=jnp.int32)[None, :]
        o = swa_attend(qb, band(k), band(v), q_pos, k_pos, sinks, slopes)
        k_all, v_all = k, v
    else:
        k_all = jnp.concatenate([cache_k.astype(k.dtype), k], axis=1)
        v_all = jnp.concatenate([cache_v.astype(v.dtype), v], axis=1)
        q_pos = (PAST_LEN + jnp.arange(t, dtype=jnp.int32))[None, :]
        k_pos = (PAST_LEN - WINDOW + jnp.arange(WINDOW + t, dtype=jnp.int32))[None, :]
        o = swa_attend(q[:, None], k_all[:, None], v_all[:, None], q_pos, k_pos, sinks, slopes)
    return o.reshape(b, t, SWA_Q_DIM), k_all[:, -WINDOW:], v_all[:, -WINDOW:]


def trunk_layer(h, p_l, conv_buf, gdn_s0, swa_k_buf, swa_v_buf, norm_mix, w_in, conv_w, a_log, dt_bias,
                gdn_norm, q_norm, k_norm, sinks, w_out, norm_ffn, w_up, w_down, norm_ple, w_ple_gate, w_ple_proj):
    proj = rmsnorm(h, norm_mix) @ w_in
    cuts = [int(c) for c in np.cumsum([CONV_DIM, GDN_VAL_DIM, GDN_HEADS, GDN_HEADS,
                                       SWA_Q_DIM, SWA_KV_DIM, SWA_KV_DIM])]
    qkv, z, b_logit, a_logit, sq, sk, sv, gates = jnp.split(proj, cuts, axis=-1)
    o_a, conv_new, s_new = gdn_branch(qkv, z, b_logit, a_logit, conv_buf, gdn_s0, conv_w, a_log, dt_bias, gdn_norm)
    o_b, k_new, v_new = swa_branch(sq, sk, sv, q_norm, k_norm, sinks, swa_k_buf, swa_v_buf)
    gates = jax.nn.sigmoid(gates)
    mix = gates[..., :D_MODEL] * o_a + gates[..., D_MODEL:] * o_b
    h = h + mix @ w_out
    hid = jax.nn.relu(rmsnorm(h, norm_ffn) @ w_up)
    h = h + (hid * hid) @ w_down
    h = h + jax.nn.sigmoid(rmsnorm(h, norm_ple) @ w_ple_gate) * (p_l @ w_ple_proj)
    return h, conv_new, s_new, k_new, v_new


def setup_inputs(seed: int = 0) -> dict:
    key = jax.random.key(seed)
    ks = jax.random.split(key, 32)
    f32 = jnp.float32
    nrm = lambda k, shape, s: jax.random.normal(k, shape, f32) * s
    dt = jnp.exp(jax.random.uniform(ks[10], (DEPTH, GDN_HEADS), f32, np.log(1e-3), np.log(1e-1)))
    return {
        'x_prompt': nrm(ks[0], (BATCH, SEQ, D_MODEL), 1.0),
        'x_sample': nrm(ks[1], (DEC_BATCH, DEC_SEQ, D_MODEL), 1.0),
        'cache_conv': nrm(ks[2], (DEPTH, DEC_BATCH, CONV_WIDTH - 1, CONV_DIM), 1.0),
        'state_gdn': nrm(ks[3], (DEPTH, DEC_BATCH, GDN_HEADS, GDN_DK, GDN_DV), 0.1),
        'cache_swa_k': nrm(ks[4], (DEPTH, DEC_BATCH, WINDOW, SWA_KV_HEADS, SWA_HD), 1.0),
        'cache_swa_v': nrm(ks[5], (DEPTH, DEC_BATCH, WINDOW, SWA_KV_HEADS, SWA_HD), 1.0),
        'p_prompt': nrm(ks[6], (DEPTH, BATCH, SEQ, PLE_DIM), 1.0),
        'p_sample': nrm(ks[7], (DEPTH, DEC_BATCH, DEC_SEQ, PLE_DIM), 1.0),
        'norm_mix': 1.0 + nrm(ks[8], (DEPTH, D_MODEL), 0.1),
        'w_in': nrm(ks[9], (DEPTH, D_MODEL, IN_DIM), D_MODEL ** -0.5),
        'conv_w': nrm(ks[11], (DEPTH, CONV_WIDTH, CONV_DIM), 0.5),
        'a_log': jnp.log(jax.random.uniform(ks[12], (DEPTH, GDN_HEADS), f32, 1.0, 16.0)),
        'dt_bias': dt + jnp.log(-jnp.expm1(-dt)),
        'gdn_norm': 1.0 + nrm(ks[13], (DEPTH, GDN_DV), 0.1),
        'q_norm': 1.0 + nrm(ks[14], (DEPTH, SWA_HD), 0.1),
        'k_norm': 1.0 + nrm(ks[15], (DEPTH, SWA_HD), 0.1),
        'attn_sinks': nrm(ks[16], (DEPTH, SWA_HEADS), 0.5),
        'w_out': nrm(ks[17], (DEPTH, D_MODEL, D_MODEL), D_MODEL ** -0.5),
        'norm_ffn': 1.0 + nrm(ks[18], (DEPTH, D_MODEL), 0.1),
        'w_up': nrm(ks[19], (DEPTH, D_MODEL, D_FF), D_MODEL ** -0.5),
        'w_down': nrm(ks[20], (DEPTH, D_FF, D_MODEL), D_FF ** -0.5),
        'norm_ple': 1.0 + nrm(ks[21], (DEPTH, D_MODEL), 0.1),
        'w_ple_gate': nrm(ks[22], (DEPTH, D_MODEL, D_MODEL), D_MODEL ** -0.5),
        'w_ple_proj': nrm(ks[23], (DEPTH, PLE_DIM, D_MODEL), PLE_DIM ** -0.5),
    }


def reference(x_prompt, x_sample, cache_conv, state_gdn, cache_swa_k, cache_swa_v, p_prompt, p_sample,
              norm_mix, w_in, conv_w, a_log, dt_bias, gdn_norm, q_norm, k_norm, attn_sinks, w_out,
              norm_ffn, w_up, w_down, norm_ple, w_ple_gate, w_ple_proj):
    hp, hs = x_prompt, x_sample
    conv_p, gdn_p, kp_l, vp_l = [], [], [], []
    conv_s, gdn_s, ks_l, vs_l = [], [], [], []
    for i in range(DEPTH):
        wts = (norm_mix[i], w_in[i], conv_w[i], a_log[i], dt_bias[i], gdn_norm[i], q_norm[i], k_norm[i],
               attn_sinks[i], w_out[i], norm_ffn[i], w_up[i], w_down[i], norm_ple[i], w_ple_gate[i], w_ple_proj[i])
        hp, c1, s1, k1, v1 = trunk_layer(hp, p_prompt[i], None, None, None, None, *wts)
        hs, c2, s2, k2, v2 = trunk_layer(hs, p_sample[i], cache_conv[i], state_gdn[i],
                                         cache_swa_k[i], cache_swa_v[i], *wts)
        conv_p.append(c1); gdn_p.append(s1); kp_l.append(k1); vp_l.append(v1)
        conv_s.append(c2); gdn_s.append(s2); ks_l.append(k2); vs_l.append(v2)
    return (hp, hs,
            jnp.stack(conv_p), jnp.stack(gdn_p), jnp.stack(kp_l), jnp.stack(vp_l),
            jnp.stack(conv_s), jnp.stack(gdn_s), jnp.stack(ks_l), jnp.stack(vs_l))
```

```cpp
#include <hip/hip_runtime.h>
#include <hip/hip_cooperative_groups.h>
#include <cstdio>
namespace cg = cooperative_groups;

typedef unsigned short bf16_t;
typedef short bf16x8 __attribute__((ext_vector_type(8)));
typedef float f32x4 __attribute__((ext_vector_type(4)));
typedef float f32x2 __attribute__((ext_vector_type(2)));
typedef unsigned u32x4 __attribute__((ext_vector_type(4)));
typedef unsigned u32x2 __attribute__((ext_vector_type(2)));

#define DEVI __device__ __forceinline__
DEVI int opq(int x) { asm volatile("" : "+v"(x)); return x; }

constexpr int NL = 4;
constexpr int MTOK = 17408, MP = 16384, MS = 1024;
constexpr int DM = 1024, NIN = 7696, NPJ = 7680, DFF = 4096, PLE = 256;
constexpr int C_Z = 3072, C_SQ = 4096, C_SK = 5120, C_SV = 5376, C_G = 5632;
constexpr float EPS = 1e-6f;
constexpr int NTHR = 256;
constexpr int SMEM_BYTES = 79872;
constexpr size_t SCR_ITEM = 73728;

constexpr size_t O_YP = 0, O_YS = 16777216, O_CONVP = 17825792, O_GDNP = 18120704, O_KP = 22315008, O_VP = 23363584,
                 O_CONVS = 24412160, O_GDNS = 29130752, O_KS = 96239616, O_VS = 113016832, O_END = 129794048;

constexpr size_t al256(size_t x) { return (x + 255) & ~(size_t)255; }
constexpr size_t WO_wt_in = 0;
constexpr size_t WO_wt_out = WO_wt_in + al256((size_t)NL * NIN * DM * 2);
constexpr size_t WO_wt_up = WO_wt_out + al256((size_t)NL * DM * DM * 2);
constexpr size_t WO_wt_down = WO_wt_up + al256((size_t)NL * DFF * DM * 2);
constexpr size_t WO_wt_gate = WO_wt_down + al256((size_t)NL * DM * DFF * 2);
constexpr size_t WO_wt_proj = WO_wt_gate + al256((size_t)NL * DM * DM * 2);
constexpr size_t WO_hb = WO_wt_proj + al256((size_t)NL * DM * PLE * 2);
constexpr size_t WO_hb2 = WO_hb + al256((size_t)MTOK * DM * 2);
constexpr size_t WO_proj = WO_hb2 + al256((size_t)MTOK * DM * 2);
constexpr size_t WO_scr = WO_proj + al256((size_t)MTOK * NPJ * 2);
constexpr size_t WO_ogdn = WO_scr + al256((size_t)2048 * SCR_ITEM);
constexpr size_t WO_oswa = WO_ogdn + al256((size_t)MTOK * DM * 2);
constexpr size_t WO_mix = WO_oswa + al256((size_t)MTOK * DM * 2);
constexpr size_t WO_pb = WO_mix + al256((size_t)MTOK * DM * 2);
constexpr size_t WO_pp = WO_pb + al256((size_t)NL * MTOK * PLE * 2);
constexpr size_t WO_ssq0 = WO_pp + al256((size_t)NL * MTOK * DM * 2);
constexpr size_t WO_ssq1 = WO_ssq0 + al256((size_t)MTOK * 16 * 4);
constexpr size_t WO_ssq2 = WO_ssq1 + al256((size_t)MTOK * 16 * 4);
constexpr size_t WO_logits = WO_ssq2 + al256((size_t)MTOK * 16 * 4);
constexpr size_t WO_gsc = WO_logits + al256((size_t)MTOK * 16 * 4);
constexpr size_t WO_bar = WO_gsc + al256((size_t)2048 * 4);
constexpr size_t WS_TOTAL = WO_bar + al256((size_t)3456 * 4);
struct Params {
  const float *x_prompt, *x_sample, *cache_conv, *state_gdn, *cache_k, *cache_v, *p_prompt, *p_sample;
  const float *norm_mix, *w_in, *conv_w, *a_log, *dt_bias, *gdn_norm, *q_norm, *k_norm, *sinks, *w_out, *norm_ffn, *w_up, *w_down,
      *norm_ple, *w_gate, *w_proj;
  float* out;
  unsigned char* ws;
  DEVI bf16_t* wt_in() const { return (bf16_t*)(ws + WO_wt_in); }
  DEVI bf16_t* wt_out() const { return (bf16_t*)(ws + WO_wt_out); }
  DEVI bf16_t* wt_up() const { return (bf16_t*)(ws + WO_wt_up); }
  DEVI bf16_t* wt_down() const { return (bf16_t*)(ws + WO_wt_down); }
  DEVI bf16_t* wt_gate() const { return (bf16_t*)(ws + WO_wt_gate); }
  DEVI bf16_t* wt_proj() const { return (bf16_t*)(ws + WO_wt_proj); }
  DEVI bf16_t* hb() const { return (bf16_t*)(ws + WO_hb); }
  DEVI bf16_t* hb2() const { return (bf16_t*)(ws + WO_hb2); }
  DEVI bf16_t* proj() const { return (bf16_t*)(ws + WO_proj); }
  DEVI bf16_t* scr() const { return (bf16_t*)(ws + WO_scr); }
  DEVI bf16_t* ogdn() const { return (bf16_t*)(ws + WO_ogdn); }
  DEVI bf16_t* oswa() const { return (bf16_t*)(ws + WO_oswa); }
  DEVI bf16_t* mix() const { return (bf16_t*)(ws + WO_mix); }
  DEVI bf16_t* pb() const { return (bf16_t*)(ws + WO_pb); }
  DEVI bf16_t* pp() const { return (bf16_t*)(ws + WO_pp); }
  DEVI float* ssq0() const { return (float*)(ws + WO_ssq0); }
  DEVI float* ssq1() const { return (float*)(ws + WO_ssq1); }
  DEVI float* ssq2() const { return (float*)(ws + WO_ssq2); }
  DEVI float* logits() const { return (float*)(ws + WO_logits); }
  DEVI float* gsc() const { return (float*)(ws + WO_gsc); }
  DEVI unsigned* bar() const { return (unsigned*)(ws + WO_bar); }
};

DEVI float lo2f(unsigned u) { return __uint_as_float(u << 16); }
DEVI float hi2f(unsigned u) { return __uint_as_float(u & 0xffff0000u); }
DEVI float bf2f(bf16_t v) { return __uint_as_float(((unsigned)v) << 16); }
typedef __bf16 bf16x2_t __attribute__((ext_vector_type(2)));
DEVI unsigned pk2(float lo, float hi) { const f32x2 v = {lo, hi}; const bf16x2_t r = __builtin_convertvector(v, bf16x2_t); return __builtin_bit_cast(unsigned, r); }
DEVI bf16_t f2bf(float f) { return (bf16_t)(pk2(f, 0.f) & 0xffffu); }
DEVI float sigm(float x) { return 1.f / (1.f + __expf(-x)); }
DEVI float silu(float x) { return x * sigm(x); }
DEVI f32x4 mfma16(bf16x8 a, bf16x8 b, f32x4 c) { return __builtin_amdgcn_mfma_f32_16x16x32_bf16(a, b, c, 0, 0, 0); }
DEVI bf16x8 as_bf(u32x4 v) { return __builtin_bit_cast(bf16x8, v); }
#define UNPACK8(v, f) do { f[0] = lo2f(v.x); f[1] = hi2f(v.x); f[2] = lo2f(v.y); f[3] = hi2f(v.y); f[4] = lo2f(v.z); f[5] = hi2f(v.z); f[6] = lo2f(v.w); f[7] = hi2f(v.w); } while (0)

DEVI int inmap(int n) { return n < 4096 ? n : (n < 7680 ? n + 16 : n - 7680 + 4096); }

__device__ void wconv_tile(const float* __restrict__ src, int ldsrc, int K, int Nd, bf16_t* __restrict__ dst, const float* __restrict__ scale,
                           bool remap, int kt, int nt, float* sm) {
  const int tid = opq(threadIdx.x);
  const int nl = tid & 63, kq = tid >> 6;
  const int n = nt * 64 + nl;
  const bool ok = n < Nd;
  const int sc = remap ? inmap(n) : n;
#pragma unroll 4
  for (int r = 0; r < 16; ++r) {
    const int kl = r * 4 + kq, k = kt * 64 + kl;
    float v = 0.f;
    if (ok) { v = src[(size_t)k * ldsrc + sc]; if (scale) v *= scale[k]; }
    sm[kl * 65 + nl] = v;
  }
  __syncthreads();
  const int nr = tid >> 2, ks = (tid & 3) * 16;
  if (nt * 64 + nr < Nd) {
    unsigned w[8];
#pragma unroll
    for (int i = 0; i < 8; ++i) w[i] = pk2(sm[(ks + 2 * i) * 65 + nr], sm[(ks + 2 * i + 1) * 65 + nr]);
    u32x4* d = (u32x4*)(dst + (size_t)(nt * 64 + nr) * K + kt * 64 + ks);
    d[0] = (u32x4){w[0], w[1], w[2], w[3]};
    d[1] = (u32x4){w[4], w[5], w[6], w[7]};
  }
  __syncthreads();
}

__device__ void phase_p0(const Params& p, unsigned char* smem) {
  float* sm = (float*)smem;
  const int tid = opq(threadIdx.x), lane = tid & 63, wid = tid >> 6;
  constexpr int T_IN = 16 * 121, T_OUT = 256, T_UP = 1024, T_DOWN = 1024, T_GATE = 256, T_PROJ = 64;
  constexpr int T_L = T_IN + T_OUT + T_UP + T_DOWN + T_GATE + T_PROJ;
  for (int it = blockIdx.x; it < NL * T_L; it += gridDim.x) {
    const int l = it / T_L;
    int r = it % T_L;
    if (r < T_IN) { wconv_tile(p.w_in + (size_t)l * DM * NIN, NIN, DM, NIN, p.wt_in() + (size_t)l * NIN * DM, p.norm_mix + l * DM, true, r % 16, r / 16, sm); continue; }
    r -= T_IN;
    if (r < T_OUT) { wconv_tile(p.w_out + (size_t)l * DM * DM, DM, DM, DM, p.wt_out() + (size_t)l * DM * DM, nullptr, false, r % 16, r / 16, sm); continue; }
    r -= T_OUT;
    if (r < T_UP) { wconv_tile(p.w_up + (size_t)l * DM * DFF, DFF, DM, DFF, p.wt_up() + (size_t)l * DFF * DM, p.norm_ffn + l * DM, false, r % 16, r / 16, sm); continue; }
    r -= T_UP;
    if (r < T_DOWN) { wconv_tile(p.w_down + (size_t)l * DFF * DM, DM, DFF, DM, p.wt_down() + (size_t)l * DM * DFF, nullptr, false, r % 64, r / 64, sm); continue; }
    r -= T_DOWN;
    if (r < T_GATE) { wconv_tile(p.w_gate + (size_t)l * DM * DM, DM, DM, DM, p.wt_gate() + (size_t)l * DM * DM, p.norm_ple + l * DM, false, r % 16, r / 16, sm); continue; }
    r -= T_GATE;
    wconv_tile(p.w_proj + (size_t)l * PLE * DM, DM, PLE, DM, p.wt_proj() + (size_t)l * DM * PLE, nullptr, false, r % 4, r / 4, sm);
  }
  for (int it = blockIdx.x; it < MTOK / 4; it += gridDim.x) {
    const int row = it * 4 + wid;
    const float* src = row < MP ? p.x_prompt + (size_t)row * DM : p.x_sample + (size_t)(row - MP) * DM;
    float* hd = p.out + (size_t)row * DM;
    bf16_t* hbd = p.hb() + (size_t)row * DM;
    float ss = 0.f;
#pragma unroll
    for (int i = 0; i < 4; ++i) {
      const int c = i * 256 + lane * 4;
      const f32x4 v = *(const f32x4*)(src + c);
      ss += v.x * v.x + v.y * v.y + v.z * v.z + v.w * v.w;
      *(f32x4*)(hd + c) = v;
      *(u32x2*)(hbd + c) = (u32x2){pk2(v.x, v.y), pk2(v.z, v.w)};
    }
#pragma unroll
    for (int o = 1; o < 64; o <<= 1) ss += __shfl_xor(ss, o);
    if (lane < 16) p.ssq0()[(size_t)row * 16 + lane] = lane == 0 ? ss : 0.f;
  }
  const int G = NL * MTOK * 32;
  for (int g = blockIdx.x * NTHR + tid; g < G; g += gridDim.x * NTHR) {
    const int l = g / (MTOK * 32), rem = g % (MTOK * 32), row = rem >> 5, c8 = rem & 31;
    const float* src = row < MP ? p.p_prompt + ((size_t)(l * MP + row) * PLE + c8 * 8) : p.p_sample + ((size_t)(l * MS + row - MP) * PLE + c8 * 8);
    const f32x4 a = *(const f32x4*)src, b = *(const f32x4*)(src + 4);
    *(u32x4*)(p.pb() + (size_t)g * 8) = (u32x4){pk2(a.x, a.y), pk2(a.z, a.w), pk2(b.x, b.y), pk2(b.z, b.w)};
  }
}

enum { EPI_PROJ = 0, EPI_LOGIT = 1, EPI_RESID = 2, EPI_UP = 3, EPI_PLE = 4, EPI_PP = 5 };
struct EpiArgs {
  const float* ssq_in; float* ssq_out; float* h; bf16_t* hb; bf16_t* obf; int ldo; float* of32; const bf16_t* pp;
};

template <int WMT, int WNT, int WGM, int WGN, int EPI>
__device__ __forceinline__ void gemm_tile(const bf16_t* __restrict__ A, int lda, const bf16_t* __restrict__ Bt, int ldb, int K, int m0, int n0,
                                          bf16_t* lds, const EpiArgs& e) {
  constexpr int BM = WGM * WMT * 16, BN = WGN * WNT * 16, LDR = 40;
  constexpr int STAGE = (BM + BN) * LDR;
  constexpr int NA = BM * 4 / NTHR, NB = (BN * 4 + NTHR - 1) / NTHR;
  const int tid = opq(threadIdx.x), lane = tid & 63, wid = tid >> 6;
  const int wm = wid / WGN, wn = wid % WGN;
  const int fr = lane & 15, fq = lane >> 4;
  f32x4 acc[WMT][WNT];
#pragma unroll
  for (int i = 0; i < WMT; ++i)
#pragma unroll
    for (int j = 0; j < WNT; ++j) acc[i][j] = (f32x4){0.f, 0.f, 0.f, 0.f};
  u32x4 ra[NA], rb[NB];
  const int nk = K / 32;
  const int prow = tid >> 2, ppc = tid & 3;
  const bf16_t* Ap = A + (size_t)(m0 + prow) * lda + ppc * 8;
  const bf16_t* Bp = Bt + (size_t)(n0 + prow) * ldb + ppc * 8;
#define GLOAD(kt) do { \
    _Pragma("unroll") for (int i = 0; i < NA; ++i) ra[i] = *(const u32x4*)(Ap + (size_t)i * 64 * lda + (kt) * 32); \
    _Pragma("unroll") for (int i = 0; i < NB; ++i) if (BN * 4 >= NTHR * (i + 1) || tid + i * NTHR < BN * 4) rb[i] = *(const u32x4*)(Bp + (size_t)i * 64 * ldb + (kt) * 32); \
  } while (0)
#define LSTORE(st) do { bf16_t* sA_ = lds + (st) * STAGE; bf16_t* sB_ = sA_ + BM * LDR; \
    _Pragma("unroll") for (int i = 0; i < NA; ++i) *(u32x4*)(sA_ + (prow + i * 64) * LDR + ppc * 8) = ra[i]; \
    _Pragma("unroll") for (int i = 0; i < NB; ++i) if (BN * 4 >= NTHR * (i + 1) || tid + i * NTHR < BN * 4) *(u32x4*)(sB_ + (prow + i * 64) * LDR + ppc * 8) = rb[i]; \
  } while (0)
  GLOAD(0);
  LSTORE(0);
  __syncthreads();
  for (int kt = 0; kt < nk; ++kt) {
    if (kt + 1 < nk) GLOAD(kt + 1);
    const bf16_t* sA = lds + (kt & 1) * STAGE;
    const bf16_t* sB = sA + BM * LDR;
    bf16x8 bfr[WNT];
#pragma unroll
    for (int nt = 0; nt < WNT; ++nt) bfr[nt] = *(const bf16x8*)(sB + (wn * WNT * 16 + nt * 16 + fr) * LDR + fq * 8);
#pragma unroll
    for (int mt = 0; mt < WMT; ++mt) {
      const bf16x8 af = *(const bf16x8*)(sA + (wm * WMT * 16 + mt * 16 + fr) * LDR + fq * 8);
#pragma unroll
      for (int nt = 0; nt < WNT; ++nt) acc[mt][nt] = mfma16(bfr[nt], af, acc[mt][nt]);
    }
    if (kt + 1 < nk) LSTORE((kt + 1) & 1);
    __syncthreads();
  }
#undef GLOAD
#undef LSTORE
#pragma unroll
  for (int mt = 0; mt < WMT; ++mt) {
    const int row = m0 + wm * WMT * 16 + mt * 16 + fr;
    float rs = 1.f;
    if (EPI == EPI_PROJ || EPI == EPI_LOGIT || EPI == EPI_UP || EPI == EPI_PLE) {
      const f32x4* sp = (const f32x4*)(e.ssq_in + (size_t)row * 16);
      const f32x4 a = sp[0], b = sp[1], c = sp[2], d = sp[3];
      const float s = ((a.x + a.y) + (a.z + a.w)) + ((b.x + b.y) + (b.z + b.w)) + ((c.x + c.y) + (c.z + c.w)) + ((d.x + d.y) + (d.z + d.w));
      rs = rsqrtf(s * (1.f / 1024.f) + EPS);
    }
    float sq = 0.f;
#pragma unroll
    for (int nt = 0; nt < WNT; ++nt) {
      const int col = n0 + wn * WNT * 16 + nt * 16 + fq * 4;
      f32x4 v = acc[mt][nt];
      if (EPI == EPI_PROJ) {
        v *= rs;
        *(u32x2*)(e.obf + (size_t)row * e.ldo + col) = (u32x2){pk2(v.x, v.y), pk2(v.z, v.w)};
      } else if (EPI == EPI_LOGIT) {
        v *= rs;
        *(f32x4*)(e.of32 + (size_t)row * 16 + col) = v;
      } else if (EPI == EPI_PP) {
        *(u32x2*)(e.obf + (size_t)row * e.ldo + col) = (u32x2){pk2(v.x, v.y), pk2(v.z, v.w)};
      } else if (EPI == EPI_UP) {
        v *= rs;
        v.x = fmaxf(v.x, 0.f); v.y = fmaxf(v.y, 0.f); v.z = fmaxf(v.z, 0.f); v.w = fmaxf(v.w, 0.f);
        v = v * v;
        *(u32x2*)(e.obf + (size_t)row * e.ldo + col) = (u32x2){pk2(v.x, v.y), pk2(v.z, v.w)};
      } else {
        float* hp = e.h + (size_t)row * DM + col;
        f32x4 hv = *(const f32x4*)hp;
        if (EPI == EPI_RESID) {
          hv += v;
        } else {
          const u32x2 pv = *(const u32x2*)(e.pp + (size_t)row * DM + col);
          hv.x += sigm(v.x * rs) * lo2f(pv.x); hv.y += sigm(v.y * rs) * hi2f(pv.x);
          hv.z += sigm(v.z * rs) * lo2f(pv.y); hv.w += sigm(v.w * rs) * hi2f(pv.y);
        }
        *(f32x4*)hp = hv;
        *(u32x2*)(e.hb + (size_t)row * DM + col) = (u32x2){pk2(hv.x, hv.y), pk2(hv.z, hv.w)};
        sq += hv.x * hv.x + hv.y * hv.y + hv.z * hv.z + hv.w * hv.w;
      }
    }
    if (EPI == EPI_RESID || EPI == EPI_PLE) {
      sq += __shfl_xor(sq, 16);
      sq += __shfl_xor(sq, 32);
      if (fq == 0) e.ssq_out[(size_t)row * 16 + (n0 / BN) * WGN + wn] = sq;
    }
  }
}

template <int EPI>
__device__ void gemm_phase(const bf16_t* A, int lda, const bf16_t* Bt, int ldb, int K, int M, int N, unsigned char* smem, const EpiArgs& e) {
  const int nM = M / 256, nN = N / 128;
  for (int t = blockIdx.x; t < nM * nN; t += gridDim.x) {
    const int mi = t / nN, ni = t % nN;
    gemm_tile<8, 4, 2, 2, EPI>(A, lda, Bt, ldb, K, mi * 256, ni * 128, (bf16_t*)smem, e);
  }
}


template <int I, int J4>
DEVI void solve_sub4(float& r, const float (&x)[64], const float* Am) {
  if constexpr (J4 * 4 < I) {
    const f32x4 a = *(const f32x4*)(Am + I * 64 + J4 * 4);
    if constexpr (J4 * 4 + 0 < I) r -= a.x * x[J4 * 4 + 0];
    if constexpr (J4 * 4 + 1 < I) r -= a.y * x[J4 * 4 + 1];
    if constexpr (J4 * 4 + 2 < I) r -= a.z * x[J4 * 4 + 2];
    if constexpr (J4 * 4 + 3 < I) r -= a.w * x[J4 * 4 + 3];
    solve_sub4<I, J4 + 1>(r, x, Am);
  }
}
template <int I>
DEVI void solve_rows(float (&x)[64], const float* Am, const bf16_t* src, const float* sc) {
  if constexpr (I < 64) {
    float r = bf2f(src[I * 136]) * sc[I];
    solve_sub4<I, 0>(r, x, Am);
    x[I] = r;
    asm volatile("" ::: "memory");
    solve_rows<I + 1>(x, Am, src, sc);
  }
}

__device__ void gdn_prep_item(const Params& p, int l, int item, unsigned char* smem) {
  const int tid = opq(threadIdx.x), lane = tid & 63, wid = tid >> 6, fr = lane & 15, fq = lane >> 4;
  const int h = item & 7, n = (item >> 3) & 31, b = item >> 8;
  const int tok0 = b * 2048 + n * 64;
  bf16_t* qh = (bf16_t*)smem;
  bf16_t* kh = qh + 64 * 136;
  bf16_t* vh = kh + 64 * 136;
  float* Am = (float*)(vh + 64 * 136);
  float* sbeta = Am + 64 * 64;
  float* sgc = sbeta + 64;
  float* sbe = sgc + 64;
  unsigned char* scr = (unsigned char*)p.scr() + (size_t)item * SCR_ITEM;
  bf16_t* g_uT = (bf16_t*)scr;
  bf16_t* g_w = (bf16_t*)(scr + 16384);
  bf16_t* g_qg = (bf16_t*)(scr + 32768);
  bf16_t* g_kgT = (bf16_t*)(scr + 49152);
  bf16_t* g_qk = (bf16_t*)(scr + 65536);

  if (wid == 0) {
    const float* lg = p.logits() + (size_t)(tok0 + lane) * 16;
    const float bl = lg[h], al = lg[8 + h];
    const float x = al + p.dt_bias[l * 8 + h];
    const float sp = x > 20.f ? x : log1pf(__expf(x));
    float g = -__expf(p.a_log[l * 8 + h]) * sp;
#pragma unroll
    for (int o = 1; o < 64; o <<= 1) { const float t = __shfl_up(g, o); if (lane >= o) g += t; }
    sbeta[lane] = sigm(bl);
    sgc[lane] = g;
    sbe[lane] = sigm(bl) * __expf(g);
  }
#pragma unroll 1
  for (int sect = 0; sect < 3; ++sect) {
    const int ch0 = sect * 1024 + h * 128 + fr * 8;
    float cw[4][8];
#pragma unroll
    for (int j = 0; j < 4; ++j) {
      const f32x4 a = *(const f32x4*)(p.conv_w + (size_t)(l * 4 + j) * 3072 + ch0), c = *(const f32x4*)(p.conv_w + (size_t)(l * 4 + j) * 3072 + ch0 + 4);
      cw[j][0] = a.x; cw[j][1] = a.y; cw[j][2] = a.z; cw[j][3] = a.w; cw[j][4] = c.x; cw[j][5] = c.y; cw[j][6] = c.z; cw[j][7] = c.w;
    }
    const int ib = wid * 16 + fq * 4;
    u32x4 rw[7];
#pragma unroll
    for (int r = 0; r < 7; ++r) {
      const int tl = n * 64 + ib - 3 + r;
      rw[r] = (u32x4){0u, 0u, 0u, 0u};
      if (tl >= 0) rw[r] = *(const u32x4*)(p.proj() + (size_t)(b * 2048 + tl) * NPJ + ch0);
    }
#pragma unroll
    for (int it = 0; it < 4; ++it) {
      float o[8];
#pragma unroll
      for (int c = 0; c < 8; ++c) o[c] = 0.f;
#pragma unroll
      for (int j = 0; j < 4; ++j) {
        float f[8];
        UNPACK8(rw[it + j], f);
#pragma unroll
        for (int c = 0; c < 8; ++c) o[c] += f[c] * cw[j][c];
      }
      float ss = 0.f;
#pragma unroll
      for (int c = 0; c < 8; ++c) { o[c] = silu(o[c]); ss += o[c] * o[c]; }
      if (sect < 2) {
        ss += __shfl_xor(ss, 1); ss += __shfl_xor(ss, 2); ss += __shfl_xor(ss, 4); ss += __shfl_xor(ss, 8);
        float rn = rsqrtf(ss + EPS);
        if (sect == 0) rn *= 0.08838834764831845f;
#pragma unroll
        for (int c = 0; c < 8; ++c) o[c] *= rn;
      }
      const u32x4 pk = (u32x4){pk2(o[0], o[1]), pk2(o[2], o[3]), pk2(o[4], o[5]), pk2(o[6], o[7])};
      bf16_t* dst = sect == 0 ? qh + (ib + it) * 136 + fr * 8 : (sect == 1 ? kh + (ib + it) * 136 + fr * 8 : vh + (ib + it) * 136 + fr * 8);
      *(u32x4*)dst = pk;
    }
  }
  __syncthreads();
  {
    const int i = wid * 16 + fr;
    const float gi = sgc[i], bi = sbeta[i];
    bf16x8 kx[4], qx[4];
#pragma unroll
    for (int ks = 0; ks < 4; ++ks) {
      kx[ks] = *(const bf16x8*)(kh + i * 136 + ks * 32 + fq * 8);
      qx[ks] = *(const bf16x8*)(qh + i * 136 + ks * 32 + fq * 8);
    }
#pragma unroll
    for (int jt = 0; jt < 4; ++jt) {
      f32x4 akk = (f32x4){0.f, 0.f, 0.f, 0.f}, aqk = (f32x4){0.f, 0.f, 0.f, 0.f};
      if (jt <= wid) {
#pragma unroll
        for (int ks = 0; ks < 4; ++ks) {
          const bf16x8 kj = *(const bf16x8*)(kh + (jt * 16 + fr) * 136 + ks * 32 + fq * 8);
          akk = mfma16(kj, kx[ks], akk);
          aqk = mfma16(kj, qx[ks], aqk);
        }
      }
      const int j0 = jt * 16 + fq * 4;
      float av[4], qv[4];
#pragma unroll
      for (int jj = 0; jj < 4; ++jj) {
        const int j = j0 + jj;
        const float dec = j <= i ? __expf(gi - sgc[j]) : 0.f;
        av[jj] = j < i ? bi * akk[jj] * dec : 0.f;
        qv[jj] = aqk[jj] * dec;
      }
      *(f32x4*)(Am + i * 64 + j0) = (f32x4){av[0], av[1], av[2], av[3]};
      *(u32x2*)(g_qk + i * 64 + j0) = (u32x2){pk2(qv[0], qv[1]), pk2(qv[2], qv[3])};
    }
  }
  __syncthreads();
  {
    float x[64];
    const bool isu = tid < 128;
    const int cc = tid & 127;
    solve_rows<0>(x, Am, (isu ? vh : kh) + cc, isu ? sbeta : sbe);
    if (isu) {
      u32x4* d = (u32x4*)(g_uT + cc * 64);
#pragma unroll
      for (int q = 0; q < 8; ++q) d[q] = (u32x4){pk2(x[q * 8], x[q * 8 + 1]), pk2(x[q * 8 + 2], x[q * 8 + 3]), pk2(x[q * 8 + 4], x[q * 8 + 5]), pk2(x[q * 8 + 6], x[q * 8 + 7])};
    } else {
#pragma unroll
      for (int i = 0; i < 64; ++i) g_w[i * 128 + cc] = f2bf(x[i]);
    }
  }
  {
    const float gl = sgc[63];
#pragma unroll
    for (int q = 0; q < 4; ++q) {
      const int pc = tid + q * 256, i = pc >> 4, c8 = pc & 15;
      const u32x4 v = *(const u32x4*)(qh + i * 136 + c8 * 8);
      float f[8];
      UNPACK8(v, f);
      const float s = __expf(sgc[i]);
      *(u32x4*)(g_qg + i * 128 + c8 * 8) = (u32x4){pk2(f[0] * s, f[1] * s), pk2(f[2] * s, f[3] * s), pk2(f[4] * s, f[5] * s), pk2(f[6] * s, f[7] * s)};
    }
    if (tid >= 128) {
      const int dk = tid - 128;
      u32x4* d = (u32x4*)(g_kgT + dk * 64);
#pragma unroll
      for (int q = 0; q < 8; ++q) {
        float f[8];
#pragma unroll
        for (int c = 0; c < 8; ++c) { const int i = q * 8 + c; f[c] = bf2f(kh[i * 136 + dk]) * __expf(gl - sgc[i]); }
        d[q] = (u32x4){pk2(f[0], f[1]), pk2(f[2], f[3]), pk2(f[4], f[5]), pk2(f[6], f[7])};
      }
    }
    if (tid == 0) p.gsc()[item] = __expf(gl);
  }
  __syncthreads();
}

__device__ void gdn_scan_item(const Params& p, int l, int item, unsigned char* smem) {
  const int tid = opq(threadIdx.x), lane = tid & 63, wid = tid >> 6, fr = lane & 15, fq = lane >> 4;
  const int dvs = item & 3, h = (item >> 2) & 7, b = item >> 5;
  bf16_t* ST = (bf16_t*)smem;
  bf16_t* VT = ST + 2 * 32 * 136;
  f32x4 S[2][2];
#pragma unroll
  for (int a = 0; a < 2; ++a)
#pragma unroll
    for (int c = 0; c < 2; ++c) S[a][c] = (f32x4){0.f, 0.f, 0.f, 0.f};
  __syncthreads();
  for (int n = 0; n < 32; ++n) {
    const int it = ((b * 32 + n) << 3) + h;
    const unsigned char* scr = (const unsigned char*)p.scr() + (size_t)it * SCR_ITEM;
    const bf16_t* g_uT = (const bf16_t*)scr;
    const bf16_t* g_w = (const bf16_t*)(scr + 16384);
    const bf16_t* g_qg = (const bf16_t*)(scr + 32768);
    const bf16_t* g_kgT = (const bf16_t*)(scr + 49152);
    const bf16_t* g_qk = (const bf16_t*)(scr + 65536);
    bf16x8 fw[4], fqg[4], fqk[2], fkg[2][2];
    u32x2 fu[2];
#pragma unroll
    for (int ks = 0; ks < 4; ++ks) {
      fw[ks] = *(const bf16x8*)(g_w + (wid * 16 + fr) * 128 + ks * 32 + fq * 8);
      fqg[ks] = *(const bf16x8*)(g_qg + (wid * 16 + fr) * 128 + ks * 32 + fq * 8);
    }
#pragma unroll
    for (int ks = 0; ks < 2; ++ks) {
      fqk[ks] = *(const bf16x8*)(g_qk + (wid * 16 + fr) * 64 + ks * 32 + fq * 8);
#pragma unroll
      for (int mt = 0; mt < 2; ++mt) fkg[mt][ks] = *(const bf16x8*)(g_kgT + ((2 * wid + mt) * 16 + fr) * 64 + ks * 32 + fq * 8);
    }
#pragma unroll
    for (int nt = 0; nt < 2; ++nt) fu[nt] = *(const u32x2*)(g_uT + (dvs * 32 + nt * 16 + fr) * 64 + wid * 16 + fq * 4);
    const float gs = p.gsc()[it];
    bf16_t* STc = ST + (n & 1) * 32 * 136;
#pragma unroll
    for (int mt = 0; mt < 2; ++mt)
#pragma unroll
      for (int nt = 0; nt < 2; ++nt)
        *(u32x2*)(STc + (nt * 16 + fr) * 136 + (2 * wid + mt) * 16 + fq * 4) = (u32x2){pk2(S[mt][nt].x, S[mt][nt].y), pk2(S[mt][nt].z, S[mt][nt].w)};
    __syncthreads();
#pragma unroll
    for (int nt = 0; nt < 2; ++nt) {
      f32x4 a = (f32x4){0.f, 0.f, 0.f, 0.f};
#pragma unroll
      for (int ks = 0; ks < 4; ++ks) {
        const bf16x8 sb = *(const bf16x8*)(STc + (nt * 16 + fr) * 136 + ks * 32 + fq * 8);
        a = mfma16(fw[ks], sb, a);
      }
      const float v0 = lo2f(fu[nt].x) - a.x, v1 = hi2f(fu[nt].x) - a.y, v2 = lo2f(fu[nt].y) - a.z, v3 = hi2f(fu[nt].y) - a.w;
      *(u32x2*)(VT + (nt * 16 + fr) * 72 + wid * 16 + fq * 4) = (u32x2){pk2(v0, v1), pk2(v2, v3)};
    }
    __syncthreads();
#pragma unroll
    for (int mt = 0; mt < 2; ++mt) {
      f32x4 a = (f32x4){0.f, 0.f, 0.f, 0.f};
#pragma unroll
      for (int ks = 0; ks < 4; ++ks) {
        const bf16x8 sa = *(const bf16x8*)(STc + (mt * 16 + fr) * 136 + ks * 32 + fq * 8);
        a = mfma16(sa, fqg[ks], a);
      }
#pragma unroll
      for (int ks = 0; ks < 2; ++ks) {
        const bf16x8 va = *(const bf16x8*)(VT + (mt * 16 + fr) * 72 + ks * 32 + fq * 8);
        a = mfma16(va, fqk[ks], a);
      }
      const size_t row = (size_t)b * 2048 + n * 64 + wid * 16 + fr;
      *(u32x2*)(p.ogdn() + row * DM + h * 128 + dvs * 32 + mt * 16 + fq * 4) = (u32x2){pk2(a.x, a.y), pk2(a.z, a.w)};
    }
#pragma unroll
    for (int mt = 0; mt < 2; ++mt)
#pragma unroll
      for (int nt = 0; nt < 2; ++nt) {
        f32x4 a = S[mt][nt] * gs;
#pragma unroll
        for (int ks = 0; ks < 2; ++ks) {
          const bf16x8 vb = *(const bf16x8*)(VT + (nt * 16 + fr) * 72 + ks * 32 + fq * 8);
          a = mfma16(fkg[mt][ks], vb, a);
        }
        S[mt][nt] = a;
      }
  }
  float* so = p.out + O_GDNP + ((size_t)(l * 8 + b) * 8 + h) * 16384;
#pragma unroll
  for (int mt = 0; mt < 2; ++mt)
#pragma unroll
    for (int nt = 0; nt < 2; ++nt)
#pragma unroll
      for (int jj = 0; jj < 4; ++jj) so[((2 * wid + mt) * 16 + fq * 4 + jj) * 128 + dvs * 32 + nt * 16 + fr] = S[mt][nt][jj];
  __syncthreads();
}

__device__ void gdn_sample_item(const Params& p, int l, int item, unsigned char* smem) {
  const int tid = opq(threadIdx.x), lane = tid & 63, wid = tid >> 6;
  const int h = item & 7, b = item >> 3;
  float* qs = (float*)smem;
  float* ks = qs + 1024;
  float* vs = ks + 1024;
  float* part = vs + 1024;
  float* sbeta = part + 256;
  float* sa = sbeta + 8;
  const int dv = tid & 127, half = tid >> 7;
  float S[64];
  const float* s0 = p.state_gdn + ((size_t)(l * 128 + b) * 8 + h) * 16384 + (half * 8192 + dv);
#pragma unroll
  for (int k = 0; k < 64; ++k) S[k] = s0[k * 128];
#pragma unroll 1
  for (int r = 0; r < 12; ++r) {
    const int idx = tid + r * 256, t = idx / 384, c = idx % 384, sect = c >> 7, ci = c & 127;
    const int ch = sect * 1024 + h * 128 + ci;
    float o = 0.f;
#pragma unroll
    for (int j = 0; j < 4; ++j) {
      const int tt = t + j - 3;
      const float xv = tt >= 0 ? bf2f(p.proj()[(size_t)(MP + b * 8 + tt) * NPJ + ch]) : p.cache_conv[((size_t)(l * 128 + b) * 3 + (tt + 3)) * 3072 + ch];
      o += xv * p.conv_w[(size_t)(l * 4 + j) * 3072 + ch];
    }
    o = silu(o);
    (sect == 0 ? qs : (sect == 1 ? ks : vs))[t * 128 + ci] = o;
  }
  if (tid < 8) {
    const float* lg = p.logits() + (size_t)(MP + b * 8 + tid) * 16;
    const float x = lg[8 + h] + p.dt_bias[l * 8 + h];
    const float sp = x > 20.f ? x : log1pf(__expf(x));
    sa[tid] = __expf(-__expf(p.a_log[l * 8 + h]) * sp);
    sbeta[tid] = sigm(lg[h]);
  }
  __syncthreads();
#pragma unroll
  for (int u = 0; u < 4; ++u) {
    const int t = wid * 2 + (u >> 1);
    float* arr = (u & 1) ? ks : qs;
    const float a0 = arr[t * 128 + lane], a1 = arr[t * 128 + 64 + lane];
    float ss = a0 * a0 + a1 * a1;
#pragma unroll
    for (int o = 1; o < 64; o <<= 1) ss += __shfl_xor(ss, o);
    float rn = rsqrtf(ss + EPS);
    if (!(u & 1)) rn *= 0.08838834764831845f;
    arr[t * 128 + lane] = a0 * rn;
    arr[t * 128 + 64 + lane] = a1 * rn;
  }
  __syncthreads();
#pragma unroll 1
  for (int t = 0; t < 8; ++t) {
    const float a = sa[t], bt = sbeta[t];
    float kv = 0.f;
#pragma unroll
    for (int k4 = 0; k4 < 16; ++k4) {
      const f32x4 kk = *(const f32x4*)(ks + t * 128 + half * 64 + k4 * 4);
      S[k4 * 4 + 0] *= a; S[k4 * 4 + 1] *= a; S[k4 * 4 + 2] *= a; S[k4 * 4 + 3] *= a;
      kv += S[k4 * 4 + 0] * kk.x + S[k4 * 4 + 1] * kk.y + S[k4 * 4 + 2] * kk.z + S[k4 * 4 + 3] * kk.w;
      if ((k4 & 3) == 3) asm volatile("" ::: "memory");
    }
    part[half * 128 + dv] = kv;
    __syncthreads();
    const float delta = bt * (vs[t * 128 + dv] - (part[dv] + part[128 + dv]));
    __syncthreads();
    float o = 0.f;
#pragma unroll
    for (int k4 = 0; k4 < 16; ++k4) {
      const f32x4 kk = *(const f32x4*)(ks + t * 128 + half * 64 + k4 * 4);
      const f32x4 qq = *(const f32x4*)(qs + t * 128 + half * 64 + k4 * 4);
      S[k4 * 4 + 0] += kk.x * delta; S[k4 * 4 + 1] += kk.y * delta; S[k4 * 4 + 2] += kk.z * delta; S[k4 * 4 + 3] += kk.w * delta;
      o += S[k4 * 4 + 0] * qq.x + S[k4 * 4 + 1] * qq.y + S[k4 * 4 + 2] * qq.z + S[k4 * 4 + 3] * qq.w;
      if ((k4 & 3) == 3) asm volatile("" ::: "memory");
    }
    part[half * 128 + dv] = o;
    __syncthreads();
    if (half == 0) p.ogdn()[(size_t)(MP + b * 8 + t) * DM + h * 128 + dv] = f2bf(part[dv] + part[128 + dv]);
    __syncthreads();
  }
  float* so = p.out + O_GDNS + ((size_t)(l * 128 + b) * 8 + h) * 16384 + opq(half * 8192 + dv);
#pragma unroll
  for (int k = 0; k < 64; ++k) so[k * 128] = S[k];
  __syncthreads();
}

__device__ void swa_prompt_item(const Params& p, int l, int item, unsigned char* smem) {
  const int tid = opq(threadIdx.x), lane = tid & 63, wid = tid >> 6, fr = lane & 15, fq = lane >> 4;
  const int kvh = item & 3, hb2 = (item >> 2) & 31, b = item >> 7;
  bf16_t* Ks = (bf16_t*)smem;
  bf16_t* VT = Ks + 208 * 72;
  bf16_t* Pw = VT + 64 * 216 + wid * 16 * 168;
  const int tk0 = hb2 * 64 - 128;
  for (int pc = tid; pc < 208 * 8; pc += NTHR) {
    const int kj = pc >> 3, c8 = pc & 7, tk = tk0 + kj;
    const bool ok = kj < 192 && tk >= 0;
    float kf[8], vf[8];
#pragma unroll
    for (int c = 0; c < 8; ++c) { kf[c] = 0.f; vf[c] = 0.f; }
    if (ok) {
      const bf16_t* base = p.proj() + (size_t)(b * 2048 + tk) * NPJ + kvh * 64 + c8 * 8;
      const u32x4 kr = *(const u32x4*)(base + C_SK), vr = *(const u32x4*)(base + C_SV);
      UNPACK8(kr, kf);
      UNPACK8(vr, vf);
    }
    float ss = 0.f;
#pragma unroll
    for (int c = 0; c < 8; ++c) ss += kf[c] * kf[c];
    ss += __shfl_xor(ss, 1); ss += __shfl_xor(ss, 2); ss += __shfl_xor(ss, 4);
    const float rn = rsqrtf(ss * (1.f / 64.f) + EPS);
    const f32x4 w0 = *(const f32x4*)(p.k_norm + l * 64 + c8 * 8), w1 = *(const f32x4*)(p.k_norm + l * 64 + c8 * 8 + 4);
    kf[0] *= rn * w0.x; kf[1] *= rn * w0.y; kf[2] *= rn * w0.z; kf[3] *= rn * w0.w;
    kf[4] *= rn * w1.x; kf[5] *= rn * w1.y; kf[6] *= rn * w1.z; kf[7] *= rn * w1.w;
    *(u32x4*)(Ks + kj * 72 + c8 * 8) = (u32x4){pk2(kf[0], kf[1]), pk2(kf[2], kf[3]), pk2(kf[4], kf[5]), pk2(kf[6], kf[7])};
#pragma unroll
    for (int c = 0; c < 8; ++c) VT[(c8 * 8 + c) * 216 + kj] = f2bf(vf[c]);
    if (ok && tk >= 1920 && kj >= 128) {
      float* ko = p.out + O_KP + (((size_t)(l * 8 + b) * 128 + (tk - 1920)) * 4 + kvh) * 64 + c8 * 8;
      float* vo = p.out + O_VP + (((size_t)(l * 8 + b) * 128 + (tk - 1920)) * 4 + kvh) * 64 + c8 * 8;
      *(f32x4*)ko = (f32x4){kf[0], kf[1], kf[2], kf[3]};
      *(f32x4*)(ko + 4) = (f32x4){kf[4], kf[5], kf[6], kf[7]};
      *(f32x4*)vo = (f32x4){vf[0], vf[1], vf[2], vf[3]};
      *(f32x4*)(vo + 4) = (f32x4){vf[4], vf[5], vf[6], vf[7]};
    }
  }
  __syncthreads();
  const int kbase = wid * 16;
  const int ql = wid * 16 + fr;
  const size_t qrow = (size_t)b * 2048 + hb2 * 64 + ql;
#pragma unroll 1
  for (int g = 0; g < 4; ++g) {
    const int head = kvh * 4 + g;
    const float slope = exp2f(-0.5f * (float)(head + 1));
    const float sink = p.sinks[l * 16 + head];
    bf16x8 qf[2];
    {
      const bf16_t* qp = p.proj() + qrow * NPJ + C_SQ + head * 64 + fq * 8;
      const u32x4 r0 = *(const u32x4*)qp, r1 = *(const u32x4*)(qp + 32);
      float f0[8], f1[8];
      UNPACK8(r0, f0);
      UNPACK8(r1, f1);
      float ss = 0.f;
#pragma unroll
      for (int c = 0; c < 8; ++c) ss += f0[c] * f0[c] + f1[c] * f1[c];
      ss += __shfl_xor(ss, 16); ss += __shfl_xor(ss, 32);
      const float rn = rsqrtf(ss * (1.f / 64.f) + EPS) * 0.125f;
      const float* qn = p.q_norm + l * 64 + fq * 8;
#pragma unroll
      for (int c = 0; c < 8; ++c) { f0[c] *= rn * qn[c]; f1[c] *= rn * qn[32 + c]; }
      qf[0] = as_bf((u32x4){pk2(f0[0], f0[1]), pk2(f0[2], f0[3]), pk2(f0[4], f0[5]), pk2(f0[6], f0[7])});
      qf[1] = as_bf((u32x4){pk2(f1[0], f1[1]), pk2(f1[2], f1[3]), pk2(f1[4], f1[5]), pk2(f1[6], f1[7])});
    }
    f32x4 sc[9];
    float mx = sink;
#pragma unroll
    for (int kt = 0; kt < 9; ++kt) {
      f32x4 a = (f32x4){0.f, 0.f, 0.f, 0.f};
#pragma unroll
      for (int ks = 0; ks < 2; ++ks) {
        const bf16x8 kf = *(const bf16x8*)(Ks + (kbase + kt * 16 + fr) * 72 + ks * 32 + fq * 8);
        a = mfma16(kf, qf[ks], a);
      }
#pragma unroll
      for (int jj = 0; jj < 4; ++jj) {
        const int kj = kbase + kt * 16 + fq * 4 + jj;
        const int dist = ql + 128 - kj;
        const bool ok = dist >= 0 && dist <= 128 && (tk0 + kj) >= 0;
        const float s = ok ? a[jj] - slope * (float)dist : -INFINITY;
        a[jj] = s;
        mx = fmaxf(mx, s);
      }
      sc[kt] = a;
    }
    mx = fmaxf(mx, __shfl_xor(mx, 16));
    mx = fmaxf(mx, __shfl_xor(mx, 32));
    float sum = 0.f;
#pragma unroll
    for (int kt = 0; kt < 9; ++kt) {
      f32x4 e;
#pragma unroll
      for (int jj = 0; jj < 4; ++jj) { e[jj] = __expf(sc[kt][jj] - mx); sum += e[jj]; }
      *(u32x2*)(Pw + fr * 168 + kt * 16 + fq * 4) = (u32x2){pk2(e.x, e.y), pk2(e.z, e.w)};
    }
    *(u32x2*)(Pw + fr * 168 + 144 + fq * 4) = (u32x2){0u, 0u};
    sum += __shfl_xor(sum, 16);
    sum += __shfl_xor(sum, 32);
    const float inv = 1.f / (sum + __expf(sink - mx));
    __builtin_amdgcn_wave_barrier();
#pragma unroll
    for (int dt = 0; dt < 4; ++dt) {
      f32x4 a = (f32x4){0.f, 0.f, 0.f, 0.f};
#pragma unroll
      for (int ks = 0; ks < 5; ++ks) {
        const bf16x8 vf = *(const bf16x8*)(VT + (dt * 16 + fr) * 216 + kbase + ks * 32 + fq * 8);
        const bf16x8 pf = *(const bf16x8*)(Pw + fr * 168 + ks * 32 + fq * 8);
        a = mfma16(vf, pf, a);
      }
      a *= inv;
      *(u32x2*)(p.oswa() + qrow * DM + head * 64 + dt * 16 + fq * 4) = (u32x2){pk2(a.x, a.y), pk2(a.z, a.w)};
    }
    __builtin_amdgcn_wave_barrier();
  }
  __syncthreads();
}

__device__ void swa_sample_item(const Params& p, int l, int item, unsigned char* smem) {
  const int tid = opq(threadIdx.x), lane = tid & 63, wid = tid >> 6;
  const int kvh = item & 3, b = item >> 2;
  float* Ks = (float*)smem;
  float* Vs = Ks + 136 * 65;
  float* Qs = Vs + 136 * 64;
  float* Sc = Qs + 512;
  const size_t cbase = (size_t)(l * 128 + b) * 128;
  for (int idx = tid; idx < 128 * 16; idx += NTHR) {
    const int j = idx >> 4, c4 = idx & 15;
    const f32x4 kv = *(const f32x4*)(p.cache_k + ((cbase + j) * 4 + kvh) * 64 + c4 * 4);
    const f32x4 vv = *(const f32x4*)(p.cache_v + ((cbase + j) * 4 + kvh) * 64 + c4 * 4);
    Ks[j * 65 + c4 * 4 + 0] = kv.x; Ks[j * 65 + c4 * 4 + 1] = kv.y; Ks[j * 65 + c4 * 4 + 2] = kv.z; Ks[j * 65 + c4 * 4 + 3] = kv.w;
    *(f32x4*)(Vs + j * 64 + c4 * 4) = vv;
  }
  {
    const int t = tid >> 5, d = (tid & 31) * 2;
    const bf16_t* base = p.proj() + (size_t)(MP + b * 8 + t) * NPJ + kvh * 64 + d;
    const unsigned kr = *(const unsigned*)(base + C_SK), vr = *(const unsigned*)(base + C_SV);
    float k0 = lo2f(kr), k1 = hi2f(kr);
    float ss = k0 * k0 + k1 * k1;
#pragma unroll
    for (int o = 1; o < 32; o <<= 1) ss += __shfl_xor(ss, o);
    const float rn = rsqrtf(ss * (1.f / 64.f) + EPS);
    Ks[(128 + t) * 65 + d] = k0 * rn * p.k_norm[l * 64 + d];
    Ks[(128 + t) * 65 + d + 1] = k1 * rn * p.k_norm[l * 64 + d + 1];
    Vs[(128 + t) * 64 + d] = lo2f(vr);
    Vs[(128 + t) * 64 + d + 1] = hi2f(vr);
  }
  __syncthreads();
  for (int idx = tid; idx < 128 * 64; idx += NTHR) {
    const int j = idx >> 6, d = idx & 63;
    p.out[O_KS + ((cbase + j) * 4 + kvh) * 64 + d] = Ks[(j + 8) * 65 + d];
    p.out[O_VS + ((cbase + j) * 4 + kvh) * 64 + d] = Vs[(j + 8) * 64 + d];
  }
#pragma unroll 1
  for (int g = 0; g < 4; ++g) {
    const int head = kvh * 4 + g;
    const float slope = exp2f(-0.5f * (float)(head + 1));
    const float sink = p.sinks[l * 16 + head];
    {
      const int t = tid >> 5, d = (tid & 31) * 2;
      const unsigned qr = *(const unsigned*)(p.proj() + (size_t)(MP + b * 8 + t) * NPJ + C_SQ + head * 64 + d);
      const float q0 = lo2f(qr), q1 = hi2f(qr);
      float ss = q0 * q0 + q1 * q1;
#pragma unroll
      for (int o = 1; o < 32; o <<= 1) ss += __shfl_xor(ss, o);
      const float rn = rsqrtf(ss * (1.f / 64.f) + EPS) * 0.125f;
      Qs[t * 64 + d] = q0 * rn * p.q_norm[l * 64 + d];
      Qs[t * 64 + d + 1] = q1 * rn * p.q_norm[l * 64 + d + 1];
    }
    __syncthreads();
    for (int idx = tid; idx < 8 * 136; idx += NTHR) {
      const int tq = idx / 136, j = idx % 136;
      float s = 0.f;
#pragma unroll 16
      for (int d = 0; d < 64; ++d) s += Qs[tq * 64 + d] * Ks[j * 65 + d];
      const int dist = tq + 128 - j;
      Sc[tq * 136 + j] = (dist >= 0 && dist <= 128) ? s - slope * (float)dist : -INFINITY;
    }
    __syncthreads();
#pragma unroll
    for (int u = 0; u < 2; ++u) {
      const int tq = wid * 2 + u;
      const float s0 = Sc[tq * 136 + lane], s1 = Sc[tq * 136 + 64 + lane], s2 = lane < 8 ? Sc[tq * 136 + 128 + lane] : -INFINITY;
      float mx = fmaxf(fmaxf(s0, s1), fmaxf(s2, sink));
#pragma unroll
      for (int o = 1; o < 64; o <<= 1) mx = fmaxf(mx, __shfl_xor(mx, o));
      const float e0 = __expf(s0 - mx), e1 = __expf(s1 - mx), e2 = __expf(s2 - mx);
      float sum = e0 + e1 + e2;
#pragma unroll
      for (int o = 1; o < 64; o <<= 1) sum += __shfl_xor(sum, o);
      const float inv = 1.f / (sum + __expf(sink - mx));
      Sc[tq * 136 + lane] = e0 * inv;
      Sc[tq * 136 + 64 + lane] = e1 * inv;
      if (lane < 8) Sc[tq * 136 + 128 + lane] = e2 * inv;
    }
    __syncthreads();
    {
      const int tq = tid >> 5, d = (tid & 31) * 2;
      float o0 = 0.f, o1 = 0.f;
#pragma unroll 8
      for (int j = 0; j < 136; ++j) {
        const float pj = Sc[tq * 136 + j];
        const f32x2 v = *(const f32x2*)(Vs + j * 64 + d);
        o0 += pj * v.x;
        o1 += pj * v.y;
      }
      *(unsigned*)(p.oswa() + (size_t)(MP + b * 8 + tq) * DM + head * 64 + d) = pk2(o0, o1);
    }
    __syncthreads();
  }
}

__device__ void phase_mix(const Params& p, int l) {
  const int tid = opq(threadIdx.x), lane = tid & 63, wid = tid >> 6, fr = lane & 15, fq = lane >> 4;
  for (int it = blockIdx.x; it < MTOK / 4; it += gridDim.x) {
    const size_t row = (size_t)it * 4 + wid;
#pragma unroll
    for (int ps = 0; ps < 2; ++ps) {
      const int ch = (ps * 4 + fq) * 128 + fr * 8;
      const u32x4 og = *(const u32x4*)(p.ogdn() + row * DM + ch);
      const u32x4 ob = *(const u32x4*)(p.oswa() + row * DM + ch);
      const u32x4 zz = *(const u32x4*)(p.proj() + row * NPJ + C_Z + ch);
      const u32x4 ga = *(const u32x4*)(p.proj() + row * NPJ + C_G + ch);
      const u32x4 gb = *(const u32x4*)(p.proj() + row * NPJ + C_G + 1024 + ch);
      float fo[8], fb[8], fz[8], fa[8], fg[8];
      UNPACK8(og, fo); UNPACK8(ob, fb); UNPACK8(zz, fz); UNPACK8(ga, fa); UNPACK8(gb, fg);
      float ss = 0.f;
#pragma unroll
      for (int c = 0; c < 8; ++c) ss += fo[c] * fo[c];
      ss += __shfl_xor(ss, 1); ss += __shfl_xor(ss, 2); ss += __shfl_xor(ss, 4); ss += __shfl_xor(ss, 8);
      const float rn = rsqrtf(ss * (1.f / 128.f) + EPS);
      const f32x4 w0 = *(const f32x4*)(p.gdn_norm + l * 128 + fr * 8), w1 = *(const f32x4*)(p.gdn_norm + l * 128 + fr * 8 + 4);
      const float wn[8] = {w0.x, w0.y, w0.z, w0.w, w1.x, w1.y, w1.z, w1.w};
      float m[8];
#pragma unroll
      for (int c = 0; c < 8; ++c) m[c] = sigm(fa[c]) * (fo[c] * rn * wn[c] * silu(fz[c])) + sigm(fg[c]) * fb[c];
      *(u32x4*)(p.mix() + row * DM + ch) = (u32x4){pk2(m[0], m[1]), pk2(m[2], m[3]), pk2(m[4], m[5]), pk2(m[6], m[7])};
    }
  }
  const int NC = (8 + 128) * 3 * 3072;
  for (int i = blockIdx.x * NTHR + tid; i < NC; i += gridDim.x * NTHR) {
    const int c = i % 3072, r = (i / 3072) % 3, bb = i / 9216;
    if (bb < 8) p.out[O_CONVP + ((size_t)(l * 8 + bb) * 3 + r) * 3072 + c] = bf2f(p.proj()[(size_t)(bb * 2048 + 2045 + r) * NPJ + c]);
    else p.out[O_CONVS + ((size_t)(l * 128 + bb - 8) * 3 + r) * 3072 + c] = bf2f(p.proj()[(size_t)(MP + (bb - 8) * 8 + 5 + r) * NPJ + c]);
  }
}

#define XB_TMO      128
#define XB_XCNT(j)  (256  + 64 * (j))
#define XB_XSUB(j)  (1280 + 64 * (j))
#define XB_XGEN(j)  (2304 + 64 * (j))
#define XB_TOP      3328
#define XB_TOPGEN   3392
#define XCD_BAR_WORDS 3456
#define XB_SPIN_CAP (1u << 18)
#define LAS __attribute__((address_space(3)))

__device__ __forceinline__ unsigned xb_ld(unsigned* p)              { return __hip_atomic_load(p, __ATOMIC_RELAXED, __HIP_MEMORY_SCOPE_AGENT); }
__device__ __forceinline__ unsigned xb_add(unsigned* p, unsigned v) { return __hip_atomic_fetch_add(p, v, __ATOMIC_RELAXED, __HIP_MEMORY_SCOPE_AGENT); }
__device__ __forceinline__ unsigned xb_xcc_id() { return (unsigned)__builtin_amdgcn_s_getreg((3 << 11) | 20) & 0xFu; }
#define XB_SPIN(cond, bar) do { unsigned _sp = 0; while (cond) { __builtin_amdgcn_s_sleep(1); \
    if ((++_sp & 255u) == 0u) { if (xb_ld(&(bar)[XB_TMO])) break; if (_sp > XB_SPIN_CAP) { atomicAdd(&(bar)[XB_TMO], 1u); break; } } } } while (0)

struct XcdBarrier {
    unsigned* bar; unsigned x;
    volatile LAS unsigned* st;
};

__device__ __forceinline__ XcdBarrier xcd_barrier_post(unsigned* bar, volatile LAS unsigned* st) {
    XcdBarrier b; b.bar = bar; b.x = xb_xcc_id(); b.st = st;
    if (threadIdx.x == 0) (void)xb_add(&bar[XB_XCNT(b.x)], 1u);
    return b;
}
__device__ __forceinline__ void xcd_barrier_complete(unsigned* bar, unsigned x, unsigned& nloc, unsigned& nx) {
    const unsigned G = gridDim.x * gridDim.y * gridDim.z;
    unsigned sum, cnt, mine, sp = 0u;
    for (;;) {
        sum = 0u; cnt = 0u; mine = 0u;
#pragma unroll
        for (unsigned j = 0; j < 16; ++j) { const unsigned c = xb_ld(&bar[XB_XCNT(j)]); sum += c; cnt += (c > 0u) ? 1u : 0u; mine = (j == x) ? c : mine; }
        if (sum == G) break;
        __builtin_amdgcn_s_sleep(1);
        if ((++sp & 255u) == 0u) { if (xb_ld(&bar[XB_TMO])) break; if (sp > XB_SPIN_CAP) { atomicAdd(&bar[XB_TMO], 1u); break; } }
    }
    nloc = mine > 0u ? mine : 1u; nx = cnt > 0u ? cnt : 1u;
}

__device__ __forceinline__ void xcd_barrier(const XcdBarrier& b) {
    asm volatile("s_waitcnt vmcnt(0)" ::: "memory");
    __syncthreads();
    if (threadIdx.x == 0) {
        unsigned* bar = b.bar;
        __builtin_amdgcn_s_waitcnt(0);
        unsigned nloc = b.st[0], nx = b.st[1];
        if (nloc == 0u) { xcd_barrier_complete(bar, b.x, nloc, nx); b.st[0] = nloc; b.st[1] = nx; }
        const unsigned old = xb_add(&bar[XB_XSUB(b.x)], 1u);
        const unsigned gen = old / nloc;
        if (old + 1u == (gen + 1u) * nloc) {
            __builtin_amdgcn_fence(__ATOMIC_RELEASE, "agent");
            asm volatile("s_waitcnt vmcnt(0)" ::: "memory");
            const unsigned og = xb_add(&bar[XB_TOP], 1u);
            const unsigned tg = og / nx;
            if (og + 1u == (tg + 1u) * nx) xb_add(&bar[XB_TOPGEN], 1u);
            else XB_SPIN(xb_ld(&bar[XB_TOPGEN]) == tg, bar);
            __builtin_amdgcn_fence(__ATOMIC_ACQUIRE, "agent");
            xb_add(&bar[XB_XGEN(b.x)], 1u);
            asm volatile("s_waitcnt vmcnt(0)" ::: "memory");
        } else {
            XB_SPIN(xb_ld(&bar[XB_XGEN(b.x)]) == gen, bar);
            __builtin_amdgcn_fence(__ATOMIC_ACQUIRE, "agent");
            asm volatile("s_waitcnt vmcnt(0)" ::: "memory");
        }
    }
    __syncthreads();
}


#define NPHASE_PRE 2
#define NPHASE_L 8
__global__ void __launch_bounds__(NTHR, 2) mega(Params p, int ph_lo, int ph_hi) {
  __shared__ __attribute__((aligned(16))) unsigned char smem[SMEM_BYTES];
  if (ph_hi < 0) cg::this_grid().sync();
  __shared__ uint4 xb_words;
  if (threadIdx.x == 0) xb_words = make_uint4(0u, 0u, 0u, 0u);
  __syncthreads();
  XcdBarrier xb = xcd_barrier_post(p.bar(), (volatile LAS unsigned*)&xb_words);
  for (int ph = ph_lo; ph < ph_hi; ++ph) {
    if (ph > ph_lo) xcd_barrier(xb);
    if (ph == 0) { phase_p0(p, smem); continue; }
    if (ph == 1) {
      for (int t = blockIdx.x; t < NL * 68 * 8; t += gridDim.x) {
        const int l = t / 544, r = t % 544;
        EpiArgs e{};
        e.obf = p.pp() + (size_t)l * MTOK * DM; e.ldo = DM;
        gemm_tile<8, 4, 2, 2, EPI_PP>(p.pb() + (size_t)l * MTOK * PLE, PLE, p.wt_proj() + (size_t)l * DM * PLE, PLE, PLE, (r / 8) * 256, (r % 8) * 128, (bf16_t*)smem, e);
      }
      continue;
    }
    const int l = (ph - NPHASE_PRE) / NPHASE_L, s = (ph - NPHASE_PRE) % NPHASE_L;
    switch (s) {
      case 0: {
        EpiArgs e{};
        e.ssq_in = p.ssq0(); e.obf = p.proj(); e.ldo = NPJ; e.of32 = p.logits();
        const bf16_t* Bt = p.wt_in() + (size_t)l * NIN * DM;
        for (int t = blockIdx.x; t < 68 * 60 + 68; t += gridDim.x) {
          if (t < 68 * 60) gemm_tile<8, 4, 2, 2, EPI_PROJ>(p.hb(), DM, Bt, DM, DM, (t / 60) * 256, (t % 60) * 128, (bf16_t*)smem, e);
          else gemm_tile<4, 1, 4, 1, EPI_LOGIT>(p.hb(), DM, Bt + (size_t)NPJ * DM, DM, DM, (t - 68 * 60) * 256, 0, (bf16_t*)smem, e);
        }
      } break;
      case 1: {
        for (int t = blockIdx.x; t < 2048 + 1024 + 512; t += gridDim.x) {
          if (t < 2048) gdn_prep_item(p, l, t, smem);
          else if (t < 3072) swa_prompt_item(p, l, t - 2048, smem);
          else swa_sample_item(p, l, t - 3072, smem);
        }
      } break;
      case 2: {
        if (gridDim.x >= 512) {
          if (blockIdx.x < 256) gdn_scan_item(p, l, blockIdx.x, smem);
          else for (int t = blockIdx.x - 256; t < 1024; t += gridDim.x - 256) gdn_sample_item(p, l, t, smem);
        } else {
          for (int t = blockIdx.x; t < 256 + 1024; t += gridDim.x) {
            if (t < 256) gdn_scan_item(p, l, t, smem);
            else gdn_sample_item(p, l, t - 256, smem);
          }
        }
      } break;
      case 3: phase_mix(p, l); break;
      case 4: {
        EpiArgs e{};
        e.h = p.out; e.hb = p.hb2(); e.ssq_out = p.ssq1();
        gemm_phase<EPI_RESID>(p.mix(), DM, p.wt_out() + (size_t)l * DM * DM, DM, DM, MTOK, DM, smem, e);
      } break;
      case 5: {
        EpiArgs e{};
        e.ssq_in = p.ssq1(); e.obf = p.proj(); e.ldo = DFF;
        gemm_phase<EPI_UP>(p.hb2(), DM, p.wt_up() + (size_t)l * DFF * DM, DM, DM, MTOK, DFF, smem, e);
      } break;
      case 6: {
        EpiArgs e{};
        e.h = p.out; e.hb = p.hb2(); e.ssq_out = p.ssq2();
        gemm_phase<EPI_RESID>(p.proj(), DFF, p.wt_down() + (size_t)l * DM * DFF, DFF, DFF, MTOK, DM, smem, e);
      } break;
      case 7: {
        EpiArgs e{};
        e.h = p.out; e.hb = p.hb(); e.ssq_in = p.ssq2(); e.ssq_out = p.ssq0(); e.pp = p.pp() + (size_t)l * MTOK * DM;
        gemm_phase<EPI_PLE>(p.hb2(), DM, p.wt_gate() + (size_t)l * DM * DM, DM, DM, MTOK, DM, smem, e);
      } break;
    }
  }
}

extern "C" void kernel_launch(void* const* d_in, const int* in_sizes, int n_in, void* d_out, int out_size, void* d_ws, size_t ws_size,
                              hipStream_t stream) {
  Params p{};
  const float* const* in = (const float* const*)d_in;
  p.x_prompt = in[0]; p.x_sample = in[1]; p.cache_conv = in[2]; p.state_gdn = in[3]; p.cache_k = in[4]; p.cache_v = in[5];
  p.p_prompt = in[6]; p.p_sample = in[7]; p.norm_mix = in[8]; p.w_in = in[9]; p.conv_w = in[10]; p.a_log = in[11]; p.dt_bias = in[12];
  p.gdn_norm = in[13]; p.q_norm = in[14]; p.k_norm = in[15]; p.sinks = in[16]; p.w_out = in[17]; p.norm_ffn = in[18]; p.w_up = in[19];
  p.w_down = in[20]; p.norm_ple = in[21]; p.w_gate = in[22]; p.w_proj = in[23];
  p.out = (float*)d_out;
  p.ws = (unsigned char*)d_ws;
  if (WS_TOTAL > ws_size) { fprintf(stderr, "workspace too small: need %zu have %zu\n", (size_t)WS_TOTAL, ws_size); return; }

  static int grid_blocks = 0;
  if (!grid_blocks) {
    int dev = 0, cus = 0, per_cu = 0;
    hipGetDevice(&dev);
    hipDeviceGetAttribute(&cus, hipDeviceAttributeMultiprocessorCount, dev);
    hipOccupancyMaxActiveBlocksPerMultiprocessor(&per_cu, mega, NTHR, 0);
    if (per_cu > 2) per_cu = 2;
    if (per_cu < 1) per_cu = 1;
    grid_blocks = cus * per_cu;
  }
  (void)hipMemsetAsync(p.ws + WO_bar, 0, (size_t)XCD_BAR_WORDS * 4, stream);
  int lo = 0, hi = NPHASE_PRE + NL * NPHASE_L;
  void* args[] = {&p, &lo, &hi};
  hipError_t e = hipLaunchCooperativeKernel((void*)mega, dim3(grid_blocks), dim3(NTHR), args, 0, stream);
  if (e != hipSuccess) fprintf(stderr, "cooperative launch failed: %s (grid %d)\n", hipGetErrorString(e), grid_blocks);
}
```

```cpp
#include <hip/hip_runtime.h>
#include <hip/hip_cooperative_groups.h>
#include <cstdio>
namespace cg = cooperative_groups;

typedef unsigned short bf16_t;
typedef short bf16x8 __attribute__((ext_vector_type(8)));
typedef float f32x4 __attribute__((ext_vector_type(4)));
typedef float f32x2 __attribute__((ext_vector_type(2)));
typedef unsigned u32x4 __attribute__((ext_vector_type(4)));
typedef unsigned u32x2 __attribute__((ext_vector_type(2)));

#define DEVI __device__ __forceinline__
DEVI int opq(int x) { asm volatile("" : "+v"(x)); return x; }

constexpr int NL = 4;
constexpr int MTOK = 17408, MP = 16384, MS = 1024;
constexpr int DM = 1024, NIN = 7696, NPJ = 7680, DFF = 4096, PLE = 256;
constexpr int C_Z = 3072, C_SQ = 4096, C_SK = 5120, C_SV = 5376, C_G = 5632;
constexpr float EPS = 1e-6f;
constexpr int NTHR = 256;
constexpr int SMEM_BYTES = 79872;
constexpr size_t SCR_ITEM = 73728;

constexpr size_t O_YP = 0, O_YS = 16777216, O_CONVP = 17825792, O_GDNP = 18120704, O_KP = 22315008, O_VP = 23363584,
                 O_CONVS = 24412160, O_GDNS = 29130752, O_KS = 96239616, O_VS = 113016832, O_END = 129794048;

constexpr size_t al256(size_t x) { return (x + 255) & ~(size_t)255; }
constexpr size_t WO_wt_in = 0;
constexpr size_t WO_wt_out = WO_wt_in + al256((size_t)NL * NIN * DM * 2);
constexpr size_t WO_wt_up = WO_wt_out + al256((size_t)NL * DM * DM * 2);
constexpr size_t WO_wt_down = WO_wt_up + al256((size_t)NL * DFF * DM * 2);
constexpr size_t WO_wt_gate = WO_wt_down + al256((size_t)NL * DM * DFF * 2);
constexpr size_t WO_wt_proj = WO_wt_gate + al256((size_t)NL * DM * DM * 2);
constexpr size_t WO_hb = WO_wt_proj + al256((size_t)NL * DM * PLE * 2);
constexpr size_t WO_hb2 = WO_hb + al256((size_t)MTOK * DM * 2);
constexpr size_t WO_proj = WO_hb2 + al256((size_t)MTOK * DM * 2);
constexpr size_t WO_scr = WO_proj + al256((size_t)MTOK * NPJ * 2);
constexpr size_t WO_ogdn = WO_scr + al256((size_t)2048 * SCR_ITEM);
constexpr size_t WO_oswa = WO_ogdn + al256((size_t)MTOK * DM * 2);
constexpr size_t WO_mix = WO_oswa + al256((size_t)MTOK * DM * 2);
constexpr size_t WO_pb = WO_mix + al256((size_t)MTOK * DM * 2);
constexpr size_t WO_pp = WO_pb + al256((size_t)NL * MTOK * PLE * 2);
constexpr size_t WO_ssq0 = WO_pp + al256((size_t)NL * MTOK * DM * 2);
constexpr size_t WO_ssq1 = WO_ssq0 + al256((size_t)MTOK * 16 * 4);
constexpr size_t WO_ssq2 = WO_ssq1 + al256((size_t)MTOK * 16 * 4);
constexpr size_t WO_logits = WO_ssq2 + al256((size_t)MTOK * 16 * 4);
constexpr size_t WO_gsc = WO_logits + al256((size_t)MTOK * 16 * 4);
constexpr size_t WO_bar = WO_gsc + al256((size_t)2048 * 4);
constexpr size_t WS_TOTAL = WO_bar + al256((size_t)3456 * 4);
struct Params {
  const float *x_prompt, *x_sample, *cache_conv, *state_gdn, *cache_k, *cache_v, *p_prompt, *p_sample;
  const float *norm_mix, *w_in, *conv_w, *a_log, *dt_bias, *gdn_norm, *q_norm, *k_norm, *sinks, *w_out, *norm_ffn, *w_up, *w_down,
      *norm_ple, *w_gate, *w_proj;
  float* out;
  unsigned char* ws;
  DEVI bf16_t* wt_in() const { return (bf16_t*)(ws + WO_wt_in); }
  DEVI bf16_t* wt_out() const { return (bf16_t*)(ws + WO_wt_out); }
  DEVI bf16_t* wt_up() const { return (bf16_t*)(ws + WO_wt_up); }
  DEVI bf16_t* wt_down() const { return (bf16_t*)(ws + WO_wt_down); }
  DEVI bf16_t* wt_gate() const { return (bf16_t*)(ws + WO_wt_gate); }
  DEVI bf16_t* wt_proj() const { return (bf16_t*)(ws + WO_wt_proj); }
  DEVI bf16_t* hb() const { return (bf16_t*)(ws + WO_hb); }
  DEVI bf16_t* hb2() const { return (bf16_t*)(ws + WO_hb2); }
  DEVI bf16_t* proj() const { return (bf16_t*)(ws + WO_proj); }
  DEVI bf16_t* scr() const { return (bf16_t*)(ws + WO_scr); }
  DEVI bf16_t* ogdn() const { return (bf16_t*)(ws + WO_ogdn); }
  DEVI bf16_t* oswa() const { return (bf16_t*)(ws + WO_oswa); }
  DEVI bf16_t* mix() const { return (bf16_t*)(ws + WO_mix); }
  DEVI bf16_t* pb() const { return (bf16_t*)(ws + WO_pb); }
  DEVI bf16_t* pp() const { return (bf16_t*)(ws + WO_pp); }
  DEVI float* ssq0() const { return (float*)(ws + WO_ssq0); }
  DEVI float* ssq1() const { return (float*)(ws + WO_ssq1); }
  DEVI float* ssq2() const { return (float*)(ws + WO_ssq2); }
  DEVI float* logits() const { return (float*)(ws + WO_logits); }
  DEVI float* gsc() const { return (float*)(ws + WO_gsc); }
  DEVI unsigned* bar() const { return (unsigned*)(ws + WO_bar); }
};

DEVI float lo2f(unsigned u) { return __uint_as_float(u << 16); }
DEVI float hi2f(unsigned u) { return __uint_as_float(u & 0xffff0000u); }
DEVI float bf2f(bf16_t v) { return __uint_as_float(((unsigned)v) << 16); }
typedef __bf16 bf16x2_t __attribute__((ext_vector_type(2)));
DEVI unsigned pk2(float lo, float hi) { const f32x2 v = {lo, hi}; const bf16x2_t r = __builtin_convertvector(v, bf16x2_t); return __builtin_bit_cast(unsigned, r); }
DEVI bf16_t f2bf(float f) { return (bf16_t)(pk2(f, 0.f) & 0xffffu); }
DEVI float sigm(float x) { return 1.f / (1.f + __expf(-x)); }
DEVI float silu(float x) { return x * sigm(x); }
DEVI f32x4 mfma16(bf16x8 a, bf16x8 b, f32x4 c) { return __builtin_amdgcn_mfma_f32_16x16x32_bf16(a, b, c, 0, 0, 0); }
DEVI bf16x8 as_bf(u32x4 v) { return __builtin_bit_cast(bf16x8, v); }
#define UNPACK8(v, f) do { f[0] = lo2f(v.x); f[1] = hi2f(v.x); f[2] = lo2f(v.y); f[3] = hi2f(v.y); f[4] = lo2f(v.z); f[5] = hi2f(v.z); f[6] = lo2f(v.w); f[7] = hi2f(v.w); } while (0)

DEVI int inmap(int n) { return n < 4096 ? n : (n < 7680 ? n + 16 : n - 7680 + 4096); }

__device__ void wconv_tile(const float* __restrict__ src, int ldsrc, int K, int Nd, bf16_t* __restrict__ dst, const float* __restrict__ scale,
                           bool remap, int kt, int nt, float* sm) {
  const int tid = opq(threadIdx.x);
  const int nl = tid & 63, kq = tid >> 6;
  const int n = nt * 64 + nl;
  const bool ok = n < Nd;
  const int sc = remap ? inmap(n) : n;
#pragma unroll 4
  for (int r = 0; r < 16; ++r) {
    const int kl = r * 4 + kq, k = kt * 64 + kl;
    float v = 0.f;
    if (ok) { v = src[(size_t)k * ldsrc + sc]; if (scale) v *= scale[k]; }
    sm[kl * 65 + nl] = v;
  }
  __syncthreads();
  const int nr = tid >> 2, ks = (tid & 3) * 16;
  if (nt * 64 + nr < Nd) {
    unsigned w[8];
#pragma unroll
    for (int i = 0; i < 8; ++i) w[i] = pk2(sm[(ks + 2 * i) * 65 + nr], sm[(ks + 2 * i + 1) * 65 + nr]);
    u32x4* d = (u32x4*)(dst + (size_t)(nt * 64 + nr) * K + kt * 64 + ks);
    d[0] = (u32x4){w[0], w[1], w[2], w[3]};
    d[1] = (u32x4){w[4], w[5], w[6], w[7]};
  }
  __syncthreads();
}

__device__ void phase_p0(const Params& p, unsigned char* smem) {
  float* sm = (float*)smem;
  const int tid = opq(threadIdx.x), lane = tid & 63, wid = tid >> 6;
  constexpr int T_IN = 16 * 121, T_OUT = 256, T_UP = 1024, T_DOWN = 1024, T_GATE = 256, T_PROJ = 64;
  constexpr int T_L = T_IN + T_OUT + T_UP + T_DOWN + T_GATE + T_PROJ;
  for (int it = blockIdx.x; it < NL * T_L; it += gridDim.x) {
    const int l = it / T_L;
    int r = it % T_L;
    if (r < T_IN) { wconv_tile(p.w_in + (size_t)l * DM * NIN, NIN, DM, NIN, p.wt_in() + (size_t)l * NIN * DM, p.norm_mix + l * DM, true, r % 16, r / 16, sm); continue; }
    r -= T_IN;
    if (r < T_OUT) { wconv_tile(p.w_out + (size_t)l * DM * DM, DM, DM, DM, p.wt_out() + (size_t)l * DM * DM, nullptr, false, r % 16, r / 16, sm); continue; }
    r -= T_OUT;
    if (r < T_UP) { wconv_tile(p.w_up + (size_t)l * DM * DFF, DFF, DM, DFF, p.wt_up() + (size_t)l * DFF * DM, p.norm_ffn + l * DM, false, r % 16, r / 16, sm); continue; }
    r -= T_UP;
    if (r < T_DOWN) { wconv_tile(p.w_down + (size_t)l * DFF * DM, DM, DFF, DM, p.wt_down() + (size_t)l * DM * DFF, nullptr, false, r % 64, r / 64, sm); continue; }
    r -= T_DOWN;
    if (r < T_GATE) { wconv_tile(p.w_gate + (size_t)l * DM * DM, DM, DM, DM, p.wt_gate() + (size_t)l * DM * DM, p.norm_ple + l * DM, false, r % 16, r / 16, sm); continue; }
    r -= T_GATE;
    wconv_tile(p.w_proj + (size_t)l * PLE * DM, DM, PLE, DM, p.wt_proj() + (size_t)l * DM * PLE, nullptr, false, r % 4, r / 4, sm);
  }
  for (int it = blockIdx.x; it < MTOK / 4; it += gridDim.x) {
    const int row = it * 4 + wid;
    const float* src = row < MP ? p.x_prompt + (size_t)row * DM : p.x_sample + (size_t)(row - MP) * DM;
    float* hd = p.out + (size_t)row * DM;
    bf16_t* hbd = p.hb() + (size_t)row * DM;
    float ss = 0.f;
#pragma unroll
    for (int i = 0; i < 4; ++i) {
      const int c = i * 256 + lane * 4;
      const f32x4 v = *(const f32x4*)(src + c);
      ss += v.x * v.x + v.y * v.y + v.z * v.z + v.w * v.w;
      *(f32x4*)(hd + c) = v;
      *(u32x2*)(hbd + c) = (u32x2){pk2(v.x, v.y), pk2(v.z, v.w)};
    }
#pragma unroll
    for (int o = 1; o < 64; o <<= 1) ss += __shfl_xor(ss, o);
    if (lane < 16) p.ssq0()[(size_t)row * 16 + lane] = lane == 0 ? ss : 0.f;
  }
  const int G = NL * MTOK * 32;
  for (int g = blockIdx.x * NTHR + tid; g < G; g += gridDim.x * NTHR) {
    const int l = g / (MTOK * 32), rem = g % (MTOK * 32), row = rem >> 5, c8 = rem & 31;
    const float* src = row < MP ? p.p_prompt + ((size_t)(l * MP + row) * PLE + c8 * 8) : p.p_sample + ((size_t)(l * MS + row - MP) * PLE + c8 * 8);
    const f32x4 a = *(const f32x4*)src, b = *(const f32x4*)(src + 4);
    *(u32x4*)(p.pb() + (size_t)g * 8) = (u32x4){pk2(a.x, a.y), pk2(a.z, a.w), pk2(b.x, b.y), pk2(b.z, b.w)};
  }
}

enum { EPI_PROJ = 0, EPI_LOGIT = 1, EPI_RESID = 2, EPI_UP = 3, EPI_PLE = 4, EPI_PP = 5 };
struct EpiArgs {
  const float* ssq_in; float* ssq_out; float* h; bf16_t* hb; bf16_t* obf; int ldo; float* of32; const bf16_t* pp;
};

template <int WMT, int WNT, int WGM, int WGN, int EPI>
__device__ __forceinline__ void gemm_tile(const bf16_t* __restrict__ A, int lda, const bf16_t* __restrict__ Bt, int ldb, int K, int m0, int n0,
                                          bf16_t* lds, const EpiArgs& e) {
  constexpr int BM = WGM * WMT * 16, BN = WGN * WNT * 16, LDR = 40;
  constexpr int STAGE = (BM + BN) * LDR;
  constexpr int NA = BM * 4 / NTHR, NB = (BN * 4 + NTHR - 1) / NTHR;
  const int tid = opq(threadIdx.x), lane = tid & 63, wid = tid >> 6;
  const int wm = wid / WGN, wn = wid % WGN;
  const int fr = lane & 15, fq = lane >> 4;
  f32x4 acc[WMT][WNT];
#pragma unroll
  for (int i = 0; i < WMT; ++i)
#pragma unroll
    for (int j = 0; j < WNT; ++j) acc[i][j] = (f32x4){0.f, 0.f, 0.f, 0.f};
  u32x4 ra[NA], rb[NB];
  const int nk = K / 32;
  const int prow = tid >> 2, ppc = tid & 3;
  const bf16_t* Ap = A + (size_t)(m0 + prow) * lda + ppc * 8;
  const bf16_t* Bp = Bt + (size_t)(n0 + prow) * ldb + ppc * 8;
#define GLOAD(kt) do { \
    _Pragma("unroll") for (int i = 0; i < NA; ++i) ra[i] = *(const u32x4*)(Ap + (size_t)i * 64 * lda + (kt) * 32); \
    _Pragma("unroll") for (int i = 0; i < NB; ++i) if (BN * 4 >= NTHR * (i + 1) || tid + i * NTHR < BN * 4) rb[i] = *(const u32x4*)(Bp + (size_t)i * 64 * ldb + (kt) * 32); \
  } while (0)
#define LSTORE(st) do { bf16_t* sA_ = lds + (st) * STAGE; bf16_t* sB_ = sA_ + BM * LDR; \
    _Pragma("unroll") for (int i = 0; i < NA; ++i) *(u32x4*)(sA_ + (prow + i * 64) * LDR + ppc * 8) = ra[i]; \
    _Pragma("unroll") for (int i = 0; i < NB; ++i) if (BN * 4 >= NTHR * (i + 1) || tid + i * NTHR < BN * 4) *(u32x4*)(sB_ + (prow + i * 64) * LDR + ppc * 8) = rb[i]; \
  } while (0)
  GLOAD(0);
  LSTORE(0);
  __syncthreads();
  for (int kt = 0; kt < nk; ++kt) {
    if (kt + 1 < nk) GLOAD(kt + 1);
    const bf16_t* sA = lds + (kt & 1) * STAGE;
    const bf16_t* sB = sA + BM * LDR;
    bf16x8 bfr[WNT];
#pragma unroll
    for (int nt = 0; nt < WNT; ++nt) bfr[nt] = *(const bf16x8*)(sB + (wn * WNT * 16 + nt * 16 + fr) * LDR + fq * 8);
#pragma unroll
    for (int mt = 0; mt < WMT; ++mt) {
      const bf16x8 af = *(const bf16x8*)(sA + (wm * WMT * 16 + mt * 16 + fr) * LDR + fq * 8);
#pragma unroll
      for (int nt = 0; nt < WNT; ++nt) acc[mt][nt] = mfma16(bfr[nt], af, acc[mt][nt]);
    }
    if (kt + 1 < nk) LSTORE((kt + 1) & 1);
    __syncthreads();
  }
#undef GLOAD
#undef LSTORE
#pragma unroll
  for (int mt = 0; mt < WMT; ++mt) {
    const int row = m0 + wm * WMT * 16 + mt * 16 + fr;
    float rs = 1.f;
    if (EPI == EPI_PROJ || EPI == EPI_LOGIT || EPI == EPI_UP || EPI == EPI_PLE) {
      const f32x4* sp = (const f32x4*)(e.ssq_in + (size_t)row * 16);
      const f32x4 a = sp[0], b = sp[1], c = sp[2], d = sp[3];
      const float s = ((a.x + a.y) + (a.z + a.w)) + ((b.x + b.y) + (b.z + b.w)) + ((c.x + c.y) + (c.z + c.w)) + ((d.x + d.y) + (d.z + d.w));
      rs = rsqrtf(s * (1.f / 1024.f) + EPS);
    }
    float sq = 0.f;
#pragma unroll
    for (int nt = 0; nt < WNT; ++nt) {
      const int col = n0 + wn * WNT * 16 + nt * 16 + fq * 4;
      f32x4 v = acc[mt][nt];
      if (EPI == EPI_PROJ) {
        v *= rs;
        *(u32x2*)(e.obf + (size_t)row * e.ldo + col) = (u32x2){pk2(v.x, v.y), pk2(v.z, v.w)};
      } else if (EPI == EPI_LOGIT) {
        v *= rs;
        *(f32x4*)(e.of32 + (size_t)row * 16 + col) = v;
      } else if (EPI == EPI_PP) {
        *(u32x2*)(e.obf + (size_t)row * e.ldo + col) = (u32x2){pk2(v.x, v.y), pk2(v.z, v.w)};
      } else if (EPI == EPI_UP) {
        v *= rs;
        v.x = fmaxf(v.x, 0.f); v.y = fmaxf(v.y, 0.f); v.z = fmaxf(v.z, 0.f); v.w = fmaxf(v.w, 0.f);
        v = v * v;
        *(u32x2*)(e.obf + (size_t)row * e.ldo + col) = (u32x2){pk2(v.x, v.y), pk2(v.z, v.w)};
      } else {
        float* hp = e.h + (size_t)row * DM + col;
        f32x4 hv = *(const f32x4*)hp;
        if (EPI == EPI_RESID) {
          hv += v;
        } else {
          const u32x2 pv = *(const u32x2*)(e.pp + (size_t)row * DM + col);
          hv.x += sigm(v.x * rs) * lo2f(pv.x); hv.y += sigm(v.y * rs) * hi2f(pv.x);
          hv.z += sigm(v.z * rs) * lo2f(pv.y); hv.w += sigm(v.w * rs) * hi2f(pv.y);
        }
        *(f32x4*)hp = hv;
        *(u32x2*)(e.hb + (size_t)row * DM + col) = (u32x2){pk2(hv.x, hv.y), pk2(hv.z, hv.w)};
        sq += hv.x * hv.x + hv.y * hv.y + hv.z * hv.z + hv.w * hv.w;
      }
    }
    if (EPI == EPI_RESID || EPI == EPI_PLE) {
      sq += __shfl_xor(sq, 16);
      sq += __shfl_xor(sq, 32);
      if (fq == 0) e.ssq_out[(size_t)row * 16 + (n0 / BN) * WGN + wn] = sq;
    }
  }
}

template <int EPI>
__device__ void gemm_phase(const bf16_t* A, int lda, const bf16_t* Bt, int ldb, int K, int M, int N, unsigned char* smem, const EpiArgs& e) {
  const int nM = M / 256, nN = N / 128, G = gridDim.x;
  const int nT = nM * nN;
  int nFull = nT;
  const int L = nT % G;
  if (L > 0 && L <= G / 4) nFull = nT - L;
  for (int t = blockIdx.x; t < nFull; t += G) {
    const int mi = t / nN, ni = t % nN;
    gemm_tile<8, 4, 2, 2, EPI>(A, lda, Bt, ldb, K, mi * 256, ni * 128, (bf16_t*)smem, e);
  }
  for (int st = blockIdx.x; st < (nT - nFull) * 8; st += G) {
    const int t = nFull + (st >> 3), sub = st & 7;
    const int mi = t / nN, ni = t % nN;
    gemm_tile<1, 4, 4, 1, EPI>(A, lda, Bt, ldb, K, mi * 256 + (sub >> 1) * 64, ni * 128 + (sub & 1) * 64, (bf16_t*)smem, e);
  }
}


template <int I, int J4>
DEVI void solve_sub4(float& r, const float (&x)[64], const float* Am) {
  if constexpr (J4 * 4 < I) {
    const f32x4 a = *(const f32x4*)(Am + I * 64 + J4 * 4);
    if constexpr (J4 * 4 + 0 < I) r -= a.x * x[J4 * 4 + 0];
    if constexpr (J4 * 4 + 1 < I) r -= a.y * x[J4 * 4 + 1];
    if constexpr (J4 * 4 + 2 < I) r -= a.z * x[J4 * 4 + 2];
    if constexpr (J4 * 4 + 3 < I) r -= a.w * x[J4 * 4 + 3];
    solve_sub4<I, J4 + 1>(r, x, Am);
  }
}
template <int I>
DEVI void solve_rows(float (&x)[64], const float* Am, const bf16_t* src, const float* sc) {
  if constexpr (I < 64) {
    float r = bf2f(src[I * 136]) * sc[I];
    solve_sub4<I, 0>(r, x, Am);
    x[I] = r;
    asm volatile("" ::: "memory");
    solve_rows<I + 1>(x, Am, src, sc);
  }
}

__device__ void gdn_prep_item(const Params& p, int l, int item, unsigned char* smem) {
  const int tid = opq(threadIdx.x), lane = tid & 63, wid = tid >> 6, fr = lane & 15, fq = lane >> 4;
  const int h = item & 7, n = (item >> 3) & 31, b = item >> 8;
  const int tok0 = b * 2048 + n * 64;
  bf16_t* qh = (bf16_t*)smem;
  bf16_t* kh = qh + 64 * 136;
  bf16_t* vh = kh + 64 * 136;
  float* Am = (float*)(vh + 64 * 136);
  float* sbeta = Am + 64 * 64;
  float* sgc = sbeta + 64;
  float* sbe = sgc + 64;
  unsigned char* scr = (unsigned char*)p.scr() + (size_t)item * SCR_ITEM;
  bf16_t* g_uT = (bf16_t*)scr;
  bf16_t* g_w = (bf16_t*)(scr + 16384);
  bf16_t* g_qg = (bf16_t*)(scr + 32768);
  bf16_t* g_kgT = (bf16_t*)(scr + 49152);
  bf16_t* g_qk = (bf16_t*)(scr + 65536);

  if (wid == 0) {
    const float* lg = p.logits() + (size_t)(tok0 + lane) * 16;
    const float bl = lg[h], al = lg[8 + h];
    const float x = al + p.dt_bias[l * 8 + h];
    const float sp = x > 20.f ? x : log1pf(__expf(x));
    float g = -__expf(p.a_log[l * 8 + h]) * sp;
#pragma unroll
    for (int o = 1; o < 64; o <<= 1) { const float t = __shfl_up(g, o); if (lane >= o) g += t; }
    sbeta[lane] = sigm(bl);
    sgc[lane] = g;
    sbe[lane] = sigm(bl) * __expf(g);
  }
#pragma unroll 1
  for (int sect = 0; sect < 3; ++sect) {
    const int ch0 = sect * 1024 + h * 128 + fr * 8;
    float cw[4][8];
#pragma unroll
    for (int j = 0; j < 4; ++j) {
      const f32x4 a = *(const f32x4*)(p.conv_w + (size_t)(l * 4 + j) * 3072 + ch0), c = *(const f32x4*)(p.conv_w + (size_t)(l * 4 + j) * 3072 + ch0 + 4);
      cw[j][0] = a.x; cw[j][1] = a.y; cw[j][2] = a.z; cw[j][3] = a.w; cw[j][4] = c.x; cw[j][5] = c.y; cw[j][6] = c.z; cw[j][7] = c.w;
    }
    const int ib = wid * 16 + fq * 4;
    u32x4 rw[7];
#pragma unroll
    for (int r = 0; r < 7; ++r) {
      const int tl = n * 64 + ib - 3 + r;
      rw[r] = (u32x4){0u, 0u, 0u, 0u};
      if (tl >= 0) rw[r] = *(const u32x4*)(p.proj() + (size_t)(b * 2048 + tl) * NPJ + ch0);
    }
#pragma unroll
    for (int it = 0; it < 4; ++it) {
      float o[8];
#pragma unroll
      for (int c = 0; c < 8; ++c) o[c] = 0.f;
#pragma unroll
      for (int j = 0; j < 4; ++j) {
        float f[8];
        UNPACK8(rw[it + j], f);
#pragma unroll
        for (int c = 0; c < 8; ++c) o[c] += f[c] * cw[j][c];
      }
      float ss = 0.f;
#pragma unroll
      for (int c = 0; c < 8; ++c) { o[c] = silu(o[c]); ss += o[c] * o[c]; }
      if (sect < 2) {
        ss += __shfl_xor(ss, 1); ss += __shfl_xor(ss, 2); ss += __shfl_xor(ss, 4); ss += __shfl_xor(ss, 8);
        float rn = rsqrtf(ss + EPS);
        if (sect == 0) rn *= 0.08838834764831845f;
#pragma unroll
        for (int c = 0; c < 8; ++c) o[c] *= rn;
      }
      const u32x4 pk = (u32x4){pk2(o[0], o[1]), pk2(o[2], o[3]), pk2(o[4], o[5]), pk2(o[6], o[7])};
      bf16_t* dst = sect == 0 ? qh + (ib + it) * 136 + fr * 8 : (sect == 1 ? kh + (ib + it) * 136 + fr * 8 : vh + (ib + it) * 136 + fr * 8);
      *(u32x4*)dst = pk;
    }
  }
  __syncthreads();
  {
    const int i = wid * 16 + fr;
    const float gi = sgc[i], bi = sbeta[i];
    bf16x8 kx[4], qx[4];
#pragma unroll
    for (int ks = 0; ks < 4; ++ks) {
      kx[ks] = *(const bf16x8*)(kh + i * 136 + ks * 32 + fq * 8);
      qx[ks] = *(const bf16x8*)(qh + i * 136 + ks * 32 + fq * 8);
    }
#pragma unroll
    for (int jt = 0; jt < 4; ++jt) {
      f32x4 akk = (f32x4){0.f, 0.f, 0.f, 0.f}, aqk = (f32x4){0.f, 0.f, 0.f, 0.f};
      if (jt <= wid) {
#pragma unroll
        for (int ks = 0; ks < 4; ++ks) {
          const bf16x8 kj = *(const bf16x8*)(kh + (jt * 16 + fr) * 136 + ks * 32 + fq * 8);
          akk = mfma16(kj, kx[ks], akk);
          aqk = mfma16(kj, qx[ks], aqk);
        }
      }
      const int j0 = jt * 16 + fq * 4;
      float av[4], qv[4];
#pragma unroll
      for (int jj = 0; jj < 4; ++jj) {
        const int j = j0 + jj;
        const float dec = j <= i ? __expf(gi - sgc[j]) : 0.f;
        av[jj] = j < i ? bi * akk[jj] * dec : 0.f;
        qv[jj] = aqk[jj] * dec;
      }
      *(f32x4*)(Am + i * 64 + j0) = (f32x4){av[0], av[1], av[2], av[3]};
      *(u32x2*)(g_qk + i * 64 + j0) = (u32x2){pk2(qv[0], qv[1]), pk2(qv[2], qv[3])};
    }
  }
  __syncthreads();
  {
    float x[64];
    const bool isu = tid < 128;
    const int cc = tid & 127;
    solve_rows<0>(x, Am, (isu ? vh : kh) + cc, isu ? sbeta : sbe);
    if (isu) {
      u32x4* d = (u32x4*)(g_uT + cc * 64);
#pragma unroll
      for (int q = 0; q < 8; ++q) d[q] = (u32x4){pk2(x[q * 8], x[q * 8 + 1]), pk2(x[q * 8 + 2], x[q * 8 + 3]), pk2(x[q * 8 + 4], x[q * 8 + 5]), pk2(x[q * 8 + 6], x[q * 8 + 7])};
    } else {
#pragma unroll
      for (int i = 0; i < 64; ++i) g_w[i * 128 + cc] = f2bf(x[i]);
    }
  }
  {
    const float gl = sgc[63];
#pragma unroll
    for (int q = 0; q < 4; ++q) {
      const int pc = tid + q * 256, i = pc >> 4, c8 = pc & 15;
      const u32x4 v = *(const u32x4*)(qh + i * 136 + c8 * 8);
      float f[8];
      UNPACK8(v, f);
      const float s = __expf(sgc[i]);
      *(u32x4*)(g_qg + i * 128 + c8 * 8) = (u32x4){pk2(f[0] * s, f[1] * s), pk2(f[2] * s, f[3] * s), pk2(f[4] * s, f[5] * s), pk2(f[6] * s, f[7] * s)};
    }
    if (tid >= 128) {
      const int dk = tid - 128;
      u32x4* d = (u32x4*)(g_kgT + dk * 64);
#pragma unroll
      for (int q = 0; q < 8; ++q) {
        float f[8];
#pragma unroll
        for (int c = 0; c < 8; ++c) { const int i = q * 8 + c; f[c] = bf2f(kh[i * 136 + dk]) * __expf(gl - sgc[i]); }
        d[q] = (u32x4){pk2(f[0], f[1]), pk2(f[2], f[3]), pk2(f[4], f[5]), pk2(f[6], f[7])};
      }
    }
    if (tid == 0) p.gsc()[item] = __expf(gl);
  }
  __syncthreads();
}

__device__ void gdn_scan_item(const Params& p, int l, int item, unsigned char* smem) {
  const int tid = opq(threadIdx.x), lane = tid & 63, wid = tid >> 6, fr = lane & 15, fq = lane >> 4;
  const int dvs = item & 3, h = (item >> 2) & 7, b = item >> 5;
  bf16_t* ST = (bf16_t*)smem;
  bf16_t* VT = ST + 2 * 32 * 136;
  f32x4 S[2][2];
#pragma unroll
  for (int a = 0; a < 2; ++a)
#pragma unroll
    for (int c = 0; c < 2; ++c) S[a][c] = (f32x4){0.f, 0.f, 0.f, 0.f};
  __syncthreads();
  bf16x8 fw[4], fqg[4], fqk[2], fkg[2][2];
  u32x2 fu[2];
  float gs;
  bf16x8 nw[4], nqg[4], nqk[2], nkg[2][2];
  u32x2 nu[2];
  float ngs;
#define SCAN_LOAD(n_, W, QG, QK, KG, U, GS) do { \
    const int it_ = ((b * 32 + (n_)) << 3) + h; \
    const unsigned char* scr_ = (const unsigned char*)p.scr() + (size_t)it_ * SCR_ITEM; \
    const bf16_t* g_uT = (const bf16_t*)scr_; const bf16_t* g_w = (const bf16_t*)(scr_ + 16384); const bf16_t* g_qg = (const bf16_t*)(scr_ + 32768); \
    const bf16_t* g_kgT = (const bf16_t*)(scr_ + 49152); const bf16_t* g_qk = (const bf16_t*)(scr_ + 65536); \
    _Pragma("unroll") for (int ks = 0; ks < 4; ++ks) { \
      W[ks] = *(const bf16x8*)(g_w + (wid * 16 + fr) * 128 + ks * 32 + fq * 8); \
      QG[ks] = *(const bf16x8*)(g_qg + (wid * 16 + fr) * 128 + ks * 32 + fq * 8); } \
    _Pragma("unroll") for (int ks = 0; ks < 2; ++ks) { \
      QK[ks] = *(const bf16x8*)(g_qk + (wid * 16 + fr) * 64 + ks * 32 + fq * 8); \
      _Pragma("unroll") for (int mt = 0; mt < 2; ++mt) KG[mt][ks] = *(const bf16x8*)(g_kgT + ((2 * wid + mt) * 16 + fr) * 64 + ks * 32 + fq * 8); } \
    _Pragma("unroll") for (int nt = 0; nt < 2; ++nt) U[nt] = *(const u32x2*)(g_uT + (dvs * 32 + nt * 16 + fr) * 64 + wid * 16 + fq * 4); \
    GS = p.gsc()[it_]; } while (0)
  SCAN_LOAD(0, nw, nqg, nqk, nkg, nu, ngs);
  for (int n = 0; n < 32; ++n) {
#pragma unroll
    for (int ks = 0; ks < 4; ++ks) { fw[ks] = nw[ks]; fqg[ks] = nqg[ks]; }
#pragma unroll
    for (int ks = 0; ks < 2; ++ks) { fqk[ks] = nqk[ks]; fkg[0][ks] = nkg[0][ks]; fkg[1][ks] = nkg[1][ks]; }
    fu[0] = nu[0]; fu[1] = nu[1]; gs = ngs;
    if (n + 1 < 32) SCAN_LOAD(n + 1, nw, nqg, nqk, nkg, nu, ngs);
    bf16_t* STc = ST + (n & 1) * 32 * 136;
#pragma unroll
    for (int mt = 0; mt < 2; ++mt)
#pragma unroll
      for (int nt = 0; nt < 2; ++nt)
        *(u32x2*)(STc + (nt * 16 + fr) * 136 + (2 * wid + mt) * 16 + fq * 4) = (u32x2){pk2(S[mt][nt].x, S[mt][nt].y), pk2(S[mt][nt].z, S[mt][nt].w)};
    __syncthreads();
#pragma unroll
    for (int nt = 0; nt < 2; ++nt) {
      f32x4 a = (f32x4){0.f, 0.f, 0.f, 0.f};
#pragma unroll
      for (int ks = 0; ks < 4; ++ks) {
        const bf16x8 sb = *(const bf16x8*)(STc + (nt * 16 + fr) * 136 + ks * 32 + fq * 8);
        a = mfma16(fw[ks], sb, a);
      }
      const float v0 = lo2f(fu[nt].x) - a.x, v1 = hi2f(fu[nt].x) - a.y, v2 = lo2f(fu[nt].y) - a.z, v3 = hi2f(fu[nt].y) - a.w;
      *(u32x2*)(VT + (nt * 16 + fr) * 72 + wid * 16 + fq * 4) = (u32x2){pk2(v0, v1), pk2(v2, v3)};
    }
    __syncthreads();
#pragma unroll
    for (int mt = 0; mt < 2; ++mt) {
      f32x4 a = (f32x4){0.f, 0.f, 0.f, 0.f};
#pragma unroll
      for (int ks = 0; ks < 4; ++ks) {
        const bf16x8 sa = *(const bf16x8*)(STc + (mt * 16 + fr) * 136 + ks * 32 + fq * 8);
        a = mfma16(sa, fqg[ks], a);
      }
#pragma unroll
      for (int ks = 0; ks < 2; ++ks) {
        const bf16x8 va = *(const bf16x8*)(VT + (mt * 16 + fr) * 72 + ks * 32 + fq * 8);
        a = mfma16(va, fqk[ks], a);
      }
      const size_t row = (size_t)b * 2048 + n * 64 + wid * 16 + fr;
      *(u32x2*)(p.ogdn() + row * DM + h * 128 + dvs * 32 + mt * 16 + fq * 4) = (u32x2){pk2(a.x, a.y), pk2(a.z, a.w)};
    }
#pragma unroll
    for (int mt = 0; mt < 2; ++mt)
#pragma unroll
      for (int nt = 0; nt < 2; ++nt) {
        f32x4 a = S[mt][nt] * gs;
#pragma unroll
        for (int ks = 0; ks < 2; ++ks) {
          const bf16x8 vb = *(const bf16x8*)(VT + (nt * 16 + fr) * 72 + ks * 32 + fq * 8);
          a = mfma16(fkg[mt][ks], vb, a);
        }
        S[mt][nt] = a;
      }
  }
  float* so = p.out + O_GDNP + ((size_t)(l * 8 + b) * 8 + h) * 16384;
#pragma unroll
  for (int mt = 0; mt < 2; ++mt)
#pragma unroll
    for (int nt = 0; nt < 2; ++nt)
#pragma unroll
      for (int jj = 0; jj < 4; ++jj) so[((2 * wid + mt) * 16 + fq * 4 + jj) * 128 + dvs * 32 + nt * 16 + fr] = S[mt][nt][jj];
  __syncthreads();
#undef SCAN_LOAD
}

__device__ void gdn_sample_item(const Params& p, int l, int item, unsigned char* smem) {
  const int tid = opq(threadIdx.x), lane = tid & 63, wid = tid >> 6;
  const int h = item & 7, b = item >> 3;
  float* qs = (float*)smem;
  float* ks = qs + 1024;
  float* vs = ks + 1024;
  float* part = vs + 1024;
  float* sbeta = part + 256;
  float* sa = sbeta + 8;
  const int dv = tid & 127, half = tid >> 7;
  float S[64];
  const float* s0 = p.state_gdn + ((size_t)(l * 128 + b) * 8 + h) * 16384 + (half * 8192 + dv);
#pragma unroll
  for (int k = 0; k < 64; ++k) S[k] = s0[k * 128];
#pragma unroll
  for (int ps = 0; ps < 2; ++ps) {
    const int c = tid + ps * 256;
    if (c < 384) {
      const int sect = c >> 7, ci = c & 127;
      const int ch = sect * 1024 + h * 128 + ci;
      float xw[11], cwv[4];
#pragma unroll
      for (int j = 0; j < 4; ++j) cwv[j] = p.conv_w[(size_t)(l * 4 + j) * 3072 + ch];
#pragma unroll
      for (int j = 0; j < 3; ++j) xw[j] = p.cache_conv[((size_t)(l * 128 + b) * 3 + j) * 3072 + ch];
#pragma unroll
      for (int t = 0; t < 8; ++t) xw[3 + t] = bf2f(p.proj()[(size_t)(MP + b * 8 + t) * NPJ + ch]);
      float* dst = sect == 0 ? qs : (sect == 1 ? ks : vs);
#pragma unroll
      for (int t = 0; t < 8; ++t) dst[t * 128 + ci] = silu(xw[t] * cwv[0] + xw[t + 1] * cwv[1] + xw[t + 2] * cwv[2] + xw[t + 3] * cwv[3]);
    }
  }
  if (tid < 8) {
    const float* lg = p.logits() + (size_t)(MP + b * 8 + tid) * 16;
    const float x = lg[8 + h] + p.dt_bias[l * 8 + h];
    const float sp = x > 20.f ? x : log1pf(__expf(x));
    sa[tid] = __expf(-__expf(p.a_log[l * 8 + h]) * sp);
    sbeta[tid] = sigm(lg[h]);
  }
  __syncthreads();
#pragma unroll
  for (int u = 0; u < 4; ++u) {
    const int t = wid * 2 + (u >> 1);
    float* arr = (u & 1) ? ks : qs;
    const float a0 = arr[t * 128 + lane], a1 = arr[t * 128 + 64 + lane];
    float ss = a0 * a0 + a1 * a1;
#pragma unroll
    for (int o = 1; o < 64; o <<= 1) ss += __shfl_xor(ss, o);
    float rn = rsqrtf(ss + EPS);
    if (!(u & 1)) rn *= 0.08838834764831845f;
    arr[t * 128 + lane] = a0 * rn;
    arr[t * 128 + 64 + lane] = a1 * rn;
  }
  __syncthreads();
#pragma unroll 1
  for (int t = 0; t < 8; ++t) {
    const float a = sa[t], bt = sbeta[t];
    float kv = 0.f;
#pragma unroll
    for (int k4 = 0; k4 < 16; ++k4) {
      const f32x4 kk = *(const f32x4*)(ks + t * 128 + half * 64 + k4 * 4);
      S[k4 * 4 + 0] *= a; S[k4 * 4 + 1] *= a; S[k4 * 4 + 2] *= a; S[k4 * 4 + 3] *= a;
      kv += S[k4 * 4 + 0] * kk.x + S[k4 * 4 + 1] * kk.y + S[k4 * 4 + 2] * kk.z + S[k4 * 4 + 3] * kk.w;
      if ((k4 & 3) == 3) asm volatile("" ::: "memory");
    }
    part[half * 128 + dv] = kv;
    __syncthreads();
    const float delta = bt * (vs[t * 128 + dv] - (part[dv] + part[128 + dv]));
    __syncthreads();
    float o = 0.f;
#pragma unroll
    for (int k4 = 0; k4 < 16; ++k4) {
      const f32x4 kk = *(const f32x4*)(ks + t * 128 + half * 64 + k4 * 4);
      const f32x4 qq = *(const f32x4*)(qs + t * 128 + half * 64 + k4 * 4);
      S[k4 * 4 + 0] += kk.x * delta; S[k4 * 4 + 1] += kk.y * delta; S[k4 * 4 + 2] += kk.z * delta; S[k4 * 4 + 3] += kk.w * delta;
      o += S[k4 * 4 + 0] * qq.x + S[k4 * 4 + 1] * qq.y + S[k4 * 4 + 2] * qq.z + S[k4 * 4 + 3] * qq.w;
      if ((k4 & 3) == 3) asm volatile("" ::: "memory");
    }
    part[half * 128 + dv] = o;
    __syncthreads();
    if (half == 0) p.ogdn()[(size_t)(MP + b * 8 + t) * DM + h * 128 + dv] = f2bf(part[dv] + part[128 + dv]);
    __syncthreads();
  }
  float* so = p.out + O_GDNS + ((size_t)(l * 128 + b) * 8 + h) * 16384 + opq(half * 8192 + dv);
#pragma unroll
  for (int k = 0; k < 64; ++k) so[k * 128] = S[k];
  __syncthreads();
}

__device__ void swa_prompt_item(const Params& p, int l, int item, unsigned char* smem) {
  const int tid = opq(threadIdx.x), lane = tid & 63, wid = tid >> 6, fr = lane & 15, fq = lane >> 4;
  const int kvh = item & 3, hb2 = (item >> 2) & 31, b = item >> 7;
  bf16_t* Ks = (bf16_t*)smem;
  bf16_t* VT = Ks + 208 * 72;
  bf16_t* Pw = VT + 64 * 216 + wid * 16 * 168;
  const int tk0 = hb2 * 64 - 128;
  for (int pc = tid; pc < 208 * 8; pc += NTHR) {
    const int kj = pc >> 3, c8 = pc & 7, tk = tk0 + kj;
    const bool ok = kj < 192 && tk >= 0;
    float kf[8], vf[8];
#pragma unroll
    for (int c = 0; c < 8; ++c) { kf[c] = 0.f; vf[c] = 0.f; }
    if (ok) {
      const bf16_t* base = p.proj() + (size_t)(b * 2048 + tk) * NPJ + kvh * 64 + c8 * 8;
      const u32x4 kr = *(const u32x4*)(base + C_SK), vr = *(const u32x4*)(base + C_SV);
      UNPACK8(kr, kf);
      UNPACK8(vr, vf);
    }
    float ss = 0.f;
#pragma unroll
    for (int c = 0; c < 8; ++c) ss += kf[c] * kf[c];
    ss += __shfl_xor(ss, 1); ss += __shfl_xor(ss, 2); ss += __shfl_xor(ss, 4);
    const float rn = rsqrtf(ss * (1.f / 64.f) + EPS);
    const f32x4 w0 = *(const f32x4*)(p.k_norm + l * 64 + c8 * 8), w1 = *(const f32x4*)(p.k_norm + l * 64 + c8 * 8 + 4);
    kf[0] *= rn * w0.x; kf[1] *= rn * w0.y; kf[2] *= rn * w0.z; kf[3] *= rn * w0.w;
    kf[4] *= rn * w1.x; kf[5] *= rn * w1.y; kf[6] *= rn * w1.z; kf[7] *= rn * w1.w;
    *(u32x4*)(Ks + kj * 72 + c8 * 8) = (u32x4){pk2(kf[0], kf[1]), pk2(kf[2], kf[3]), pk2(kf[4], kf[5]), pk2(kf[6], kf[7])};
#pragma unroll
    for (int c = 0; c < 8; ++c) VT[(c8 * 8 + c) * 216 + kj] = f2bf(vf[c]);
    if (ok && tk >= 1920 && kj >= 128) {
      float* ko = p.out + O_KP + (((size_t)(l * 8 + b) * 128 + (tk - 1920)) * 4 + kvh) * 64 + c8 * 8;
      float* vo = p.out + O_VP + (((size_t)(l * 8 + b) * 128 + (tk - 1920)) * 4 + kvh) * 64 + c8 * 8;
      *(f32x4*)ko = (f32x4){kf[0], kf[1], kf[2], kf[3]};
      *(f32x4*)(ko + 4) = (f32x4){kf[4], kf[5], kf[6], kf[7]};
      *(f32x4*)vo = (f32x4){vf[0], vf[1], vf[2], vf[3]};
      *(f32x4*)(vo + 4) = (f32x4){vf[4], vf[5], vf[6], vf[7]};
    }
  }
  __syncthreads();
  const int kbase = wid * 16;
  const int ql = wid * 16 + fr;
  const size_t qrow = (size_t)b * 2048 + hb2 * 64 + ql;
#pragma unroll 1
  for (int g = 0; g < 4; ++g) {
    const int head = kvh * 4 + g;
    const float slope = exp2f(-0.5f * (float)(head + 1));
    const float sink = p.sinks[l * 16 + head];
    bf16x8 qf[2];
    {
      const bf16_t* qp = p.proj() + qrow * NPJ + C_SQ + head * 64 + fq * 8;
      const u32x4 r0 = *(const u32x4*)qp, r1 = *(const u32x4*)(qp + 32);
      float f0[8], f1[8];
      UNPACK8(r0, f0);
      UNPACK8(r1, f1);
      float ss = 0.f;
#pragma unroll
      for (int c = 0; c < 8; ++c) ss += f0[c] * f0[c] + f1[c] * f1[c];
      ss += __shfl_xor(ss, 16); ss += __shfl_xor(ss, 32);
      const float rn = rsqrtf(ss * (1.f / 64.f) + EPS) * 0.125f;
      const float* qn = p.q_norm + l * 64 + fq * 8;
#pragma unroll
      for (int c = 0; c < 8; ++c) { f0[c] *= rn * qn[c]; f1[c] *= rn * qn[32 + c]; }
      qf[0] = as_bf((u32x4){pk2(f0[0], f0[1]), pk2(f0[2], f0[3]), pk2(f0[4], f0[5]), pk2(f0[6], f0[7])});
      qf[1] = as_bf((u32x4){pk2(f1[0], f1[1]), pk2(f1[2], f1[3]), pk2(f1[4], f1[5]), pk2(f1[6], f1[7])});
    }
    f32x4 sc[9];
    float mx = sink;
#pragma unroll
    for (int kt = 0; kt < 9; ++kt) {
      f32x4 a = (f32x4){0.f, 0.f, 0.f, 0.f};
#pragma unroll
      for (int ks = 0; ks < 2; ++ks) {
        const bf16x8 kf = *(const bf16x8*)(Ks + (kbase + kt * 16 + fr) * 72 + ks * 32 + fq * 8);
        a = mfma16(kf, qf[ks], a);
      }
#pragma unroll
      for (int jj = 0; jj < 4; ++jj) {
        const int kj = kbase + kt * 16 + fq * 4 + jj;
        const int dist = ql + 128 - kj;
        const bool ok = dist >= 0 && dist <= 128 && (tk0 + kj) >= 0;
        const float s = ok ? a[jj] - slope * (float)dist : -INFINITY;
        a[jj] = s;
        mx = fmaxf(mx, s);
      }
      sc[kt] = a;
    }
    mx = fmaxf(mx, __shfl_xor(mx, 16));
    mx = fmaxf(mx, __shfl_xor(mx, 32));
    float sum = 0.f;
#pragma unroll
    for (int kt = 0; kt < 9; ++kt) {
      f32x4 e;
#pragma unroll
      for (int jj = 0; jj < 4; ++jj) { e[jj] = __expf(sc[kt][jj] - mx); sum += e[jj]; }
      *(u32x2*)(Pw + fr * 168 + kt * 16 + fq * 4) = (u32x2){pk2(e.x, e.y), pk2(e.z, e.w)};
    }
    *(u32x2*)(Pw + fr * 168 + 144 + fq * 4) = (u32x2){0u, 0u};
    sum += __shfl_xor(sum, 16);
    sum += __shfl_xor(sum, 32);
    const float inv = 1.f / (sum + __expf(sink - mx));
    __builtin_amdgcn_wave_barrier();
#pragma unroll
    for (int dt = 0; dt < 4; ++dt) {
      f32x4 a = (f32x4){0.f, 0.f, 0.f, 0.f};
#pragma unroll
      for (int ks = 0; ks < 5; ++ks) {
        const bf16x8 vf = *(const bf16x8*)(VT + (dt * 16 + fr) * 216 + kbase + ks * 32 + fq * 8);
        const bf16x8 pf = *(const bf16x8*)(Pw + fr * 168 + ks * 32 + fq * 8);
        a = mfma16(vf, pf, a);
      }
      a *= inv;
      *(u32x2*)(p.oswa() + qrow * DM + head * 64 + dt * 16 + fq * 4) = (u32x2){pk2(a.x, a.y), pk2(a.z, a.w)};
    }
    __builtin_amdgcn_wave_barrier();
  }
  __syncthreads();
}

__device__ void swa_sample_item(const Params& p, int l, int item, unsigned char* smem) {
  const int tid = opq(threadIdx.x), lane = tid & 63, wid = tid >> 6;
  const int kvh = item & 3, b = item >> 2;
  float* Ks = (float*)smem;
  float* Vs = Ks + 136 * 65;
  float* Qs = Vs + 136 * 64;
  float* Sc = Qs + 512;
  const size_t cbase = (size_t)(l * 128 + b) * 128;
  for (int idx = tid; idx < 128 * 16; idx += NTHR) {
    const int j = idx >> 4, c4 = idx & 15;
    const f32x4 kv = *(const f32x4*)(p.cache_k + ((cbase + j) * 4 + kvh) * 64 + c4 * 4);
    const f32x4 vv = *(const f32x4*)(p.cache_v + ((cbase + j) * 4 + kvh) * 64 + c4 * 4);
    Ks[j * 65 + c4 * 4 + 0] = kv.x; Ks[j * 65 + c4 * 4 + 1] = kv.y; Ks[j * 65 + c4 * 4 + 2] = kv.z; Ks[j * 65 + c4 * 4 + 3] = kv.w;
    *(f32x4*)(Vs + j * 64 + c4 * 4) = vv;
  }
  {
    const int t = tid >> 5, d = (tid & 31) * 2;
    const bf16_t* base = p.proj() + (size_t)(MP + b * 8 + t) * NPJ + kvh * 64 + d;
    const unsigned kr = *(const unsigned*)(base + C_SK), vr = *(const unsigned*)(base + C_SV);
    float k0 = lo2f(kr), k1 = hi2f(kr);
    float ss = k0 * k0 + k1 * k1;
#pragma unroll
    for (int o = 1; o < 32; o <<= 1) ss += __shfl_xor(ss, o);
    const float rn = rsqrtf(ss * (1.f / 64.f) + EPS);
    Ks[(128 + t) * 65 + d] = k0 * rn * p.k_norm[l * 64 + d];
    Ks[(128 + t) * 65 + d + 1] = k1 * rn * p.k_norm[l * 64 + d + 1];
    Vs[(128 + t) * 64 + d] = lo2f(vr);
    Vs[(128 + t) * 64 + d + 1] = hi2f(vr);
  }
  __syncthreads();
  for (int idx = tid; idx < 128 * 64; idx += NTHR) {
    const int j = idx >> 6, d = idx & 63;
    p.out[O_KS + ((cbase + j) * 4 + kvh) * 64 + d] = Ks[(j + 8) * 65 + d];
    p.out[O_VS + ((cbase + j) * 4 + kvh) * 64 + d] = Vs[(j + 8) * 64 + d];
  }
#pragma unroll 1
  for (int g = 0; g < 4; ++g) {
    const int head = kvh * 4 + g;
    const float slope = exp2f(-0.5f * (float)(head + 1));
    const float sink = p.sinks[l * 16 + head];
    {
      const int t = tid >> 5, d = (tid & 31) * 2;
      const unsigned qr = *(const unsigned*)(p.proj() + (size_t)(MP + b * 8 + t) * NPJ + C_SQ + head * 64 + d);
      const float q0 = lo2f(qr), q1 = hi2f(qr);
      float ss = q0 * q0 + q1 * q1;
#pragma unroll
      for (int o = 1; o < 32; o <<= 1) ss += __shfl_xor(ss, o);
      const float rn = rsqrtf(ss * (1.f / 64.f) + EPS) * 0.125f;
      Qs[t * 64 + d] = q0 * rn * p.q_norm[l * 64 + d];
      Qs[t * 64 + d + 1] = q1 * rn * p.q_norm[l * 64 + d + 1];
    }
    __syncthreads();
    for (int idx = tid; idx < 8 * 136; idx += NTHR) {
      const int tq = idx / 136, j = idx % 136;
      float s = 0.f;
#pragma unroll 16
      for (int d = 0; d < 64; ++d) s += Qs[tq * 64 + d] * Ks[j * 65 + d];
      const int dist = tq + 128 - j;
      Sc[tq * 136 + j] = (dist >= 0 && dist <= 128) ? s - slope * (float)dist : -INFINITY;
    }
    __syncthreads();
#pragma unroll
    for (int u = 0; u < 2; ++u) {
      const int tq = wid * 2 + u;
      const float s0 = Sc[tq * 136 + lane], s1 = Sc[tq * 136 + 64 + lane], s2 = lane < 8 ? Sc[tq * 136 + 128 + lane] : -INFINITY;
      float mx = fmaxf(fmaxf(s0, s1), fmaxf(s2, sink));
#pragma unroll
      for (int o = 1; o < 64; o <<= 1) mx = fmaxf(mx, __shfl_xor(mx, o));
      const float e0 = __expf(s0 - mx), e1 = __expf(s1 - mx), e2 = __expf(s2 - mx);
      float sum = e0 + e1 + e2;
#pragma unroll
      for (int o = 1; o < 64; o <<= 1) sum += __shfl_xor(sum, o);
      const float inv = 1.f / (sum + __expf(sink - mx));
      Sc[tq * 136 + lane] = e0 * inv;
      Sc[tq * 136 + 64 + lane] = e1 * inv;
      if (lane < 8) Sc[tq * 136 + 128 + lane] = e2 * inv;
    }
    __syncthreads();
    {
      const int tq = tid >> 5, d = (tid & 31) * 2;
      float o0 = 0.f, o1 = 0.f;
#pragma unroll 8
      for (int j = 0; j < 136; ++j) {
        const float pj = Sc[tq * 136 + j];
        const f32x2 v = *(const f32x2*)(Vs + j * 64 + d);
        o0 += pj * v.x;
        o1 += pj * v.y;
      }
      *(unsigned*)(p.oswa() + (size_t)(MP + b * 8 + tq) * DM + head * 64 + d) = pk2(o0, o1);
    }
    __syncthreads();
  }
}

__device__ void phase_mix(const Params& p, int l) {
  const int tid = opq(threadIdx.x), lane = tid & 63, wid = tid >> 6, fr = lane & 15, fq = lane >> 4;
  for (int it = blockIdx.x; it < MTOK / 4; it += gridDim.x) {
    const size_t row = (size_t)it * 4 + wid;
#pragma unroll
    for (int ps = 0; ps < 2; ++ps) {
      const int ch = (ps * 4 + fq) * 128 + fr * 8;
      const u32x4 og = *(const u32x4*)(p.ogdn() + row * DM + ch);
      const u32x4 ob = *(const u32x4*)(p.oswa() + row * DM + ch);
      const u32x4 zz = *(const u32x4*)(p.proj() + row * NPJ + C_Z + ch);
      const u32x4 ga = *(const u32x4*)(p.proj() + row * NPJ + C_G + ch);
      const u32x4 gb = *(const u32x4*)(p.proj() + row * NPJ + C_G + 1024 + ch);
      float fo[8], fb[8], fz[8], fa[8], fg[8];
      UNPACK8(og, fo); UNPACK8(ob, fb); UNPACK8(zz, fz); UNPACK8(ga, fa); UNPACK8(gb, fg);
      float ss = 0.f;
#pragma unroll
      for (int c = 0; c < 8; ++c) ss += fo[c] * fo[c];
      ss += __shfl_xor(ss, 1); ss += __shfl_xor(ss, 2); ss += __shfl_xor(ss, 4); ss += __shfl_xor(ss, 8);
      const float rn = rsqrtf(ss * (1.f / 128.f) + EPS);
      const f32x4 w0 = *(const f32x4*)(p.gdn_norm + l * 128 + fr * 8), w1 = *(const f32x4*)(p.gdn_norm + l * 128 + fr * 8 + 4);
      const float wn[8] = {w0.x, w0.y, w0.z, w0.w, w1.x, w1.y, w1.z, w1.w};
      float m[8];
#pragma unroll
      for (int c = 0; c < 8; ++c) m[c] = sigm(fa[c]) * (fo[c] * rn * wn[c] * silu(fz[c])) + sigm(fg[c]) * fb[c];
      *(u32x4*)(p.mix() + row * DM + ch) = (u32x4){pk2(m[0], m[1]), pk2(m[2], m[3]), pk2(m[4], m[5]), pk2(m[6], m[7])};
    }
  }
  const int NC = (8 + 128) * 3 * 3072;
  for (int i = blockIdx.x * NTHR + tid; i < NC; i += gridDim.x * NTHR) {
    const int c = i % 3072, r = (i / 3072) % 3, bb = i / 9216;
    if (bb < 8) p.out[O_CONVP + ((size_t)(l * 8 + bb) * 3 + r) * 3072 + c] = bf2f(p.proj()[(size_t)(bb * 2048 + 2045 + r) * NPJ + c]);
    else p.out[O_CONVS + ((size_t)(l * 128 + bb - 8) * 3 + r) * 3072 + c] = bf2f(p.proj()[(size_t)(MP + (bb - 8) * 8 + 5 + r) * NPJ + c]);
  }
}

#define XB_TMO      128
#define XB_XCNT(j)  (256  + 64 * (j))
#define XB_XSUB(j)  (1280 + 64 * (j))
#define XB_XGEN(j)  (2304 + 64 * (j))
#define XB_TOP      3328
#define XB_TOPGEN   3392
#define XCD_BAR_WORDS 3456
#define XB_SPIN_CAP (1u << 18)
#define LAS __attribute__((address_space(3)))

__device__ __forceinline__ unsigned xb_ld(unsigned* p)              { return __hip_atomic_load(p, __ATOMIC_RELAXED, __HIP_MEMORY_SCOPE_AGENT); }
__device__ __forceinline__ unsigned xb_add(unsigned* p, unsigned v) { return __hip_atomic_fetch_add(p, v, __ATOMIC_RELAXED, __HIP_MEMORY_SCOPE_AGENT); }
__device__ __forceinline__ unsigned xb_xcc_id() { return (unsigned)__builtin_amdgcn_s_getreg((3 << 11) | 20) & 0xFu; }
#define XB_SPIN(cond, bar) do { unsigned _sp = 0; while (cond) { __builtin_amdgcn_s_sleep(1); \
    if ((++_sp & 255u) == 0u) { if (xb_ld(&(bar)[XB_TMO])) break; if (_sp > XB_SPIN_CAP) { atomicAdd(&(bar)[XB_TMO], 1u); break; } } } } while (0)

struct XcdBarrier {
    unsigned* bar; unsigned x;
    volatile LAS unsigned* st;
};

__device__ __forceinline__ XcdBarrier xcd_barrier_post(unsigned* bar, volatile LAS unsigned* st) {
    XcdBarrier b; b.bar = bar; b.x = xb_xcc_id(); b.st = st;
    if (threadIdx.x == 0) (void)xb_add(&bar[XB_XCNT(b.x)], 1u);
    return b;
}
__device__ __forceinline__ void xcd_barrier_complete(unsigned* bar, unsigned x, unsigned& nloc, unsigned& nx) {
    const unsigned G = gridDim.x * gridDim.y * gridDim.z;
    unsigned sum, cnt, mine, sp = 0u;
    for (;;) {
        sum = 0u; cnt = 0u; mine = 0u;
#pragma unroll
        for (unsigned j = 0; j < 16; ++j) { const unsigned c = xb_ld(&bar[XB_XCNT(j)]); sum += c; cnt += (c > 0u) ? 1u : 0u; mine = (j == x) ? c : mine; }
        if (sum == G) break;
        __builtin_amdgcn_s_sleep(1);
        if ((++sp & 255u) == 0u) { if (xb_ld(&bar[XB_TMO])) break; if (sp > XB_SPIN_CAP) { atomicAdd(&bar[XB_TMO], 1u); break; } }
    }
    nloc = mine > 0u ? mine : 1u; nx = cnt > 0u ? cnt : 1u;
}

__device__ __forceinline__ void xcd_barrier(const XcdBarrier& b) {
    asm volatile("s_waitcnt vmcnt(0)" ::: "memory");
    __syncthreads();
    if (threadIdx.x == 0) {
        unsigned* bar = b.bar;
        __builtin_amdgcn_s_waitcnt(0);
        unsigned nloc = b.st[0], nx = b.st[1];
        if (nloc == 0u) { xcd_barrier_complete(bar, b.x, nloc, nx); b.st[0] = nloc; b.st[1] = nx; }
        const unsigned old = xb_add(&bar[XB_XSUB(b.x)], 1u);
        const unsigned gen = old / nloc;
        if (old + 1u == (gen + 1u) * nloc) {
            __builtin_amdgcn_fence(__ATOMIC_RELEASE, "agent");
            asm volatile("s_waitcnt vmcnt(0)" ::: "memory");
            const unsigned og = xb_add(&bar[XB_TOP], 1u);
            const unsigned tg = og / nx;
            if (og + 1u == (tg + 1u) * nx) xb_add(&bar[XB_TOPGEN], 1u);
            else XB_SPIN(xb_ld(&bar[XB_TOPGEN]) == tg, bar);
            __builtin_amdgcn_fence(__ATOMIC_ACQUIRE, "agent");
            xb_add(&bar[XB_XGEN(b.x)], 1u);
            asm volatile("s_waitcnt vmcnt(0)" ::: "memory");
        } else {
            XB_SPIN(xb_ld(&bar[XB_XGEN(b.x)]) == gen, bar);
            __builtin_amdgcn_fence(__ATOMIC_ACQUIRE, "agent");
            asm volatile("s_waitcnt vmcnt(0)" ::: "memory");
        }
    }
    __syncthreads();
}


#define NPHASE_PRE 2
#define NPHASE_L 8
__global__ void __launch_bounds__(NTHR, 2) mega(Params p, int ph_lo, int ph_hi) {
  __shared__ __attribute__((aligned(16))) unsigned char smem[SMEM_BYTES];
  if (ph_hi < 0) cg::this_grid().sync();
  __shared__ uint4 xb_words;
  if (threadIdx.x == 0) xb_words = make_uint4(0u, 0u, 0u, 0u);
  __syncthreads();
  XcdBarrier xb = xcd_barrier_post(p.bar(), (volatile LAS unsigned*)&xb_words);
  for (int ph = ph_lo; ph < ph_hi; ++ph) {
    if (ph > ph_lo) xcd_barrier(xb);
    if (ph == 0) { phase_p0(p, smem); continue; }
    if (ph == 1) {
      for (int t = blockIdx.x; t < NL * 68 * 8; t += gridDim.x) {
        const int l = t / 544, r = t % 544;
        EpiArgs e{};
        e.obf = p.pp() + (size_t)l * MTOK * DM; e.ldo = DM;
        gemm_tile<8, 4, 2, 2, EPI_PP>(p.pb() + (size_t)l * MTOK * PLE, PLE, p.wt_proj() + (size_t)l * DM * PLE, PLE, PLE, (r / 8) * 256, (r % 8) * 128, (bf16_t*)smem, e);
      }
      continue;
    }
    const int l = (ph - NPHASE_PRE) / NPHASE_L, s = (ph - NPHASE_PRE) % NPHASE_L;
#ifndef REPMASK
#define REPMASK 0
#endif
    for (int rep = 0; rep < (((REPMASK >> s) & 1) ? 2 : 1); ++rep) {
    if (rep) xcd_barrier(xb);
    switch (s) {
      case 0: {
        EpiArgs e{};
        e.ssq_in = p.ssq0(); e.obf = p.proj(); e.ldo = NPJ; e.of32 = p.logits();
        const bf16_t* Bt = p.wt_in() + (size_t)l * NIN * DM;
        for (int t = blockIdx.x; t < 68 * 60 + 68; t += gridDim.x) {
          if (t < 68 * 60) gemm_tile<8, 4, 2, 2, EPI_PROJ>(p.hb(), DM, Bt, DM, DM, (t / 60) * 256, (t % 60) * 128, (bf16_t*)smem, e);
          else gemm_tile<4, 1, 4, 1, EPI_LOGIT>(p.hb(), DM, Bt + (size_t)NPJ * DM, DM, DM, (t - 68 * 60) * 256, 0, (bf16_t*)smem, e);
        }
      } break;
      case 1: {
        for (int t = blockIdx.x; t < 2048 + 1024 + 512; t += gridDim.x) {
          if (t < 2048) gdn_prep_item(p, l, t, smem);
          else if (t < 3072) swa_prompt_item(p, l, t - 2048, smem);
          else swa_sample_item(p, l, t - 3072, smem);
        }
      } break;
      case 2: {
        if (gridDim.x >= 512) {
          if (blockIdx.x < 256) { gdn_scan_item(p, l, blockIdx.x, smem); gdn_sample_item(p, l, 768 + blockIdx.x, smem); }
          else for (int t = blockIdx.x - 256; t < 768; t += gridDim.x - 256) gdn_sample_item(p, l, t, smem);
        } else {
          for (int t = blockIdx.x; t < 256 + 1024; t += gridDim.x) {
            if (t < 256) gdn_scan_item(p, l, t, smem);
            else gdn_sample_item(p, l, t - 256, smem);
          }
        }
      } break;
      case 3: phase_mix(p, l); break;
      case 4: {
        EpiArgs e{};
        e.h = p.out; e.hb = p.hb2(); e.ssq_out = p.ssq1();
        gemm_phase<EPI_RESID>(p.mix(), DM, p.wt_out() + (size_t)l * DM * DM, DM, DM, MTOK, DM, smem, e);
      } break;
      case 5: {
        EpiArgs e{};
        e.ssq_in = p.ssq1(); e.obf = p.proj(); e.ldo = DFF;
        gemm_phase<EPI_UP>(p.hb2(), DM, p.wt_up() + (size_t)l * DFF * DM, DM, DM, MTOK, DFF, smem, e);
      } break;
      case 6: {
        EpiArgs e{};
        e.h = p.out; e.hb = p.hb2(); e.ssq_out = p.ssq2();
        gemm_phase<EPI_RESID>(p.proj(), DFF, p.wt_down() + (size_t)l * DM * DFF, DFF, DFF, MTOK, DM, smem, e);
      } break;
      case 7: {
        EpiArgs e{};
        e.h = p.out; e.hb = p.hb(); e.ssq_in = p.ssq2(); e.ssq_out = p.ssq0(); e.pp = p.pp() + (size_t)l * MTOK * DM;
        gemm_phase<EPI_PLE>(p.hb2(), DM, p.wt_gate() + (size_t)l * DM * DM, DM, DM, MTOK, DM, smem, e);
      } break;
    }
    }
  }
}

extern "C" void kernel_launch(void* const* d_in, const int* in_sizes, int n_in, void* d_out, int out_size, void* d_ws, size_t ws_size,
                              hipStream_t stream) {
  Params p{};
  const float* const* in = (const float* const*)d_in;
  p.x_prompt = in[0]; p.x_sample = in[1]; p.cache_conv = in[2]; p.state_gdn = in[3]; p.cache_k = in[4]; p.cache_v = in[5];
  p.p_prompt = in[6]; p.p_sample = in[7]; p.norm_mix = in[8]; p.w_in = in[9]; p.conv_w = in[10]; p.a_log = in[11]; p.dt_bias = in[12];
  p.gdn_norm = in[13]; p.q_norm = in[14]; p.k_norm = in[15]; p.sinks = in[16]; p.w_out = in[17]; p.norm_ffn = in[18]; p.w_up = in[19];
  p.w_down = in[20]; p.norm_ple = in[21]; p.w_gate = in[22]; p.w_proj = in[23];
  p.out = (float*)d_out;
  p.ws = (unsigned char*)d_ws;
  if (WS_TOTAL > ws_size) { fprintf(stderr, "workspace too small: need %zu have %zu\n", (size_t)WS_TOTAL, ws_size); return; }

  static int grid_blocks = 0;
  if (!grid_blocks) {
    int dev = 0, cus = 0, per_cu = 0;
    hipGetDevice(&dev);
    hipDeviceGetAttribute(&cus, hipDeviceAttributeMultiprocessorCount, dev);
    hipOccupancyMaxActiveBlocksPerMultiprocessor(&per_cu, mega, NTHR, 0);
    if (per_cu > 2) per_cu = 2;
    if (per_cu < 1) per_cu = 1;
    grid_blocks = cus * per_cu;
  }
  (void)hipMemsetAsync(p.ws + WO_bar, 0, (size_t)XCD_BAR_WORDS * 4, stream);
  int lo = 0, hi = NPHASE_PRE + NL * NPHASE_L;
  void* args[] = {&p, &lo, &hi};
  hipError_t e = hipLaunchCooperativeKernel((void*)mega, dim3(grid_blocks), dim3(NTHR), args, 0, stream);
  if (e != hipSuccess) fprintf(stderr, "cooperative launch failed: %s (grid %d)\n", hipGetErrorString(e), grid_blocks);
}
```

```cpp
#include <hip/hip_runtime.h>
#include <hip/hip_cooperative_groups.h>
#include <cstdio>
namespace cg = cooperative_groups;

typedef unsigned short bf16_t;
typedef short bf16x8 __attribute__((ext_vector_type(8)));
typedef float f32x4 __attribute__((ext_vector_type(4)));
typedef float f32x2 __attribute__((ext_vector_type(2)));
typedef unsigned u32x4 __attribute__((ext_vector_type(4)));
typedef unsigned u32x2 __attribute__((ext_vector_type(2)));

#define DEVI __device__ __forceinline__
DEVI int opq(int x) { asm volatile("" : "+v"(x)); return x; }

constexpr int NL = 4;
constexpr int MTOK = 17408, MP = 16384, MS = 1024;
constexpr int DM = 1024, NIN = 7696, NPJ = 7680, DFF = 4096, PLE = 256;
constexpr int C_Z = 3072, C_SQ = 4096, C_SK = 5120, C_SV = 5376, C_G = 5632;
constexpr float EPS = 1e-6f;
constexpr int NTHR = 256;
constexpr int SMEM_BYTES = 79872;
constexpr size_t SCR_ITEM = 73728;

constexpr size_t O_YP = 0, O_YS = 16777216, O_CONVP = 17825792, O_GDNP = 18120704, O_KP = 22315008, O_VP = 23363584,
                 O_CONVS = 24412160, O_GDNS = 29130752, O_KS = 96239616, O_VS = 113016832, O_END = 129794048;

constexpr size_t al256(size_t x) { return (x + 255) & ~(size_t)255; }
constexpr size_t WO_wt_in = 0;
constexpr size_t WO_wt_out = WO_wt_in + al256((size_t)NL * NIN * DM * 2);
constexpr size_t WO_wt_up = WO_wt_out + al256((size_t)NL * DM * DM * 2);
constexpr size_t WO_wt_down = WO_wt_up + al256((size_t)NL * DFF * DM * 2);
constexpr size_t WO_wt_gate = WO_wt_down + al256((size_t)NL * DM * DFF * 2);
constexpr size_t WO_wt_proj = WO_wt_gate + al256((size_t)NL * DM * DM * 2);
constexpr size_t WO_hb = WO_wt_proj + al256((size_t)NL * DM * PLE * 2);
constexpr size_t WO_hb2 = WO_hb + al256((size_t)MTOK * DM * 2);
constexpr size_t WO_proj = WO_hb2 + al256((size_t)MTOK * DM * 2);
constexpr size_t WO_scr = WO_proj + al256((size_t)MTOK * NPJ * 2);
constexpr size_t WO_ogdn = WO_scr + al256((size_t)2048 * SCR_ITEM);
constexpr size_t WO_oswa = WO_ogdn + al256((size_t)MTOK * DM * 2);
constexpr size_t WO_mix = WO_oswa + al256((size_t)MTOK * DM * 2);
constexpr size_t WO_pb = WO_mix + al256((size_t)MTOK * DM * 2);
constexpr size_t WO_pp = WO_pb + al256((size_t)NL * MTOK * PLE * 2);
constexpr size_t WO_ssq0 = WO_pp + al256((size_t)NL * MTOK * DM * 2);
constexpr size_t WO_ssq1 = WO_ssq0 + al256((size_t)MTOK * 16 * 4);
constexpr size_t WO_ssq2 = WO_ssq1 + al256((size_t)MTOK * 16 * 4);
constexpr size_t WO_logits = WO_ssq2 + al256((size_t)MTOK * 16 * 4);
constexpr size_t WO_gsc = WO_logits + al256((size_t)MTOK * 16 * 4);
constexpr size_t WO_bar = WO_gsc + al256((size_t)2048 * 4);
constexpr size_t WS_TOTAL = WO_bar + al256((size_t)3456 * 4);
struct Params {
  const float *x_prompt, *x_sample, *cache_conv, *state_gdn, *cache_k, *cache_v, *p_prompt, *p_sample;
  const float *norm_mix, *w_in, *conv_w, *a_log, *dt_bias, *gdn_norm, *q_norm, *k_norm, *sinks, *w_out, *norm_ffn, *w_up, *w_down,
      *norm_ple, *w_gate, *w_proj;
  float* out;
  unsigned char* ws;
  DEVI bf16_t* wt_in() const { return (bf16_t*)(ws + WO_wt_in); }
  DEVI bf16_t* wt_out() const { return (bf16_t*)(ws + WO_wt_out); }
  DEVI bf16_t* wt_up() const { return (bf16_t*)(ws + WO_wt_up); }
  DEVI bf16_t* wt_down() const { return (bf16_t*)(ws + WO_wt_down); }
  DEVI bf16_t* wt_gate() const { return (bf16_t*)(ws + WO_wt_gate); }
  DEVI bf16_t* wt_proj() const { return (bf16_t*)(ws + WO_wt_proj); }
  DEVI bf16_t* hb() const { return (bf16_t*)(ws + WO_hb); }
  DEVI bf16_t* hb2() const { return (bf16_t*)(ws + WO_hb2); }
  DEVI bf16_t* proj() const { return (bf16_t*)(ws + WO_proj); }
  DEVI bf16_t* scr() const { return (bf16_t*)(ws + WO_scr); }
  DEVI bf16_t* ogdn() const { return (bf16_t*)(ws + WO_ogdn); }
  DEVI bf16_t* oswa() const { return (bf16_t*)(ws + WO_oswa); }
  DEVI bf16_t* mix() const { return (bf16_t*)(ws + WO_mix); }
  DEVI bf16_t* pb() const { return (bf16_t*)(ws + WO_pb); }
  DEVI bf16_t* pp() const { return (bf16_t*)(ws + WO_pp); }
  DEVI float* ssq0() const { return (float*)(ws + WO_ssq0); }
  DEVI float* ssq1() const { return (float*)(ws + WO_ssq1); }
  DEVI float* ssq2() const { return (float*)(ws + WO_ssq2); }
  DEVI float* logits() const { return (float*)(ws + WO_logits); }
  DEVI float* gsc() const { return (float*)(ws + WO_gsc); }
  DEVI unsigned* bar() const { return (unsigned*)(ws + WO_bar); }
};

DEVI float shx(float v, int m, int ln) { return __builtin_bit_cast(float, __builtin_amdgcn_ds_bpermute((ln ^ m) << 2, __builtin_bit_cast(int, v))); }
DEVI float shup(float v, int o, int ln) { return __builtin_bit_cast(float, __builtin_amdgcn_ds_bpermute((ln >= o ? ln - o : ln) << 2, __builtin_bit_cast(int, v))); }
DEVI float lo2f(unsigned u) { return __uint_as_float(u << 16); }
DEVI float hi2f(unsigned u) { return __uint_as_float(u & 0xffff0000u); }
DEVI float bf2f(bf16_t v) { return __uint_as_float(((unsigned)v) << 16); }
typedef __bf16 bf16x2_t __attribute__((ext_vector_type(2)));
DEVI unsigned pk2(float lo, float hi) { const f32x2 v = {lo, hi}; const bf16x2_t r = __builtin_convertvector(v, bf16x2_t); return __builtin_bit_cast(unsigned, r); }
DEVI bf16_t f2bf(float f) { return (bf16_t)(pk2(f, 0.f) & 0xffffu); }
DEVI float sigm(float x) { return 1.f / (1.f + __expf(-x)); }
DEVI float silu(float x) { return x * sigm(x); }
DEVI float softplus_f(float x) {
  const float e = __expf(x);
  return x > 20.f ? x : (e < 0.01f ? e * (1.f - 0.5f * e + 0.33333334f * e * e) : __logf(1.f + e));
}
DEVI f32x4 mfma16(bf16x8 a, bf16x8 b, f32x4 c) { return __builtin_amdgcn_mfma_f32_16x16x32_bf16(a, b, c, 0, 0, 0); }
DEVI bf16x8 as_bf(u32x4 v) { return __builtin_bit_cast(bf16x8, v); }
#define UNPACK8(v, f) do { f[0] = lo2f(v.x); f[1] = hi2f(v.x); f[2] = lo2f(v.y); f[3] = hi2f(v.y); f[4] = lo2f(v.z); f[5] = hi2f(v.z); f[6] = lo2f(v.w); f[7] = hi2f(v.w); } while (0)

DEVI int inmap(int n) { return n < 4096 ? n : (n < 7680 ? n + 16 : n - 7680 + 4096); }

__device__ void wconv_tile(const float* __restrict__ src, int ldsrc, int K, int Nd, bf16_t* __restrict__ dst, const float* __restrict__ scale,
                           bool remap, int kt, int nt, float* sm) {
  const int tid = opq(threadIdx.x);
  const int nl = tid & 63, kq = tid >> 6;
  const int n = nt * 64 + nl;
  const bool ok = n < Nd;
  const int sc = remap ? inmap(n) : n;
#pragma unroll 4
  for (int r = 0; r < 16; ++r) {
    const int kl = r * 4 + kq, k = kt * 64 + kl;
    float v = 0.f;
    if (ok) { v = src[(size_t)k * ldsrc + sc]; if (scale) v *= scale[k]; }
    sm[kl * 65 + nl] = v;
  }
  __syncthreads();
  const int nr = tid >> 2, ks = (tid & 3) * 16;
  if (nt * 64 + nr < Nd) {
    unsigned w[8];
#pragma unroll
    for (int i = 0; i < 8; ++i) w[i] = pk2(sm[(ks + 2 * i) * 65 + nr], sm[(ks + 2 * i + 1) * 65 + nr]);
    u32x4* d = (u32x4*)(dst + (size_t)(nt * 64 + nr) * K + kt * 64 + ks);
    d[0] = (u32x4){w[0], w[1], w[2], w[3]};
    d[1] = (u32x4){w[4], w[5], w[6], w[7]};
  }
  __syncthreads();
}

__device__ void phase_p0(const Params& p, unsigned char* smem) {
  float* sm = (float*)smem;
  const int tid = opq(threadIdx.x), lane = tid & 63, wid = tid >> 6;
  constexpr int T_IN = 16 * 121, T_OUT = 256, T_UP = 1024, T_DOWN = 1024, T_GATE = 256, T_PROJ = 64;
  constexpr int T_L = T_IN + T_OUT + T_UP + T_DOWN + T_GATE + T_PROJ;
  for (int it = blockIdx.x; it < NL * T_L; it += gridDim.x) {
    const int l = it / T_L;
    int r = it % T_L;
    if (r < T_IN) { wconv_tile(p.w_in + (size_t)l * DM * NIN, NIN, DM, NIN, p.wt_in() + (size_t)l * NIN * DM, p.norm_mix + l * DM, true, r % 16, r / 16, sm); continue; }
    r -= T_IN;
    if (r < T_OUT) { wconv_tile(p.w_out + (size_t)l * DM * DM, DM, DM, DM, p.wt_out() + (size_t)l * DM * DM, nullptr, false, r % 16, r / 16, sm); continue; }
    r -= T_OUT;
    if (r < T_UP) { wconv_tile(p.w_up + (size_t)l * DM * DFF, DFF, DM, DFF, p.wt_up() + (size_t)l * DFF * DM, p.norm_ffn + l * DM, false, r % 16, r / 16, sm); continue; }
    r -= T_UP;
    if (r < T_DOWN) { wconv_tile(p.w_down + (size_t)l * DFF * DM, DM, DFF, DM, p.wt_down() + (size_t)l * DM * DFF, nullptr, false, r % 64, r / 64, sm); continue; }
    r -= T_DOWN;
    if (r < T_GATE) { wconv_tile(p.w_gate + (size_t)l * DM * DM, DM, DM, DM, p.wt_gate() + (size_t)l * DM * DM, p.norm_ple + l * DM, false, r % 16, r / 16, sm); continue; }
    r -= T_GATE;
    wconv_tile(p.w_proj + (size_t)l * PLE * DM, DM, PLE, DM, p.wt_proj() + (size_t)l * DM * PLE, nullptr, false, r % 4, r / 4, sm);
  }
  for (int it = blockIdx.x; it < MTOK / 4; it += gridDim.x) {
    const int row = it * 4 + wid;
    const float* src = row < MP ? p.x_prompt + (size_t)row * DM : p.x_sample + (size_t)(row - MP) * DM;
    float* hd = p.out + (size_t)row * DM;
    bf16_t* hbd = p.hb() + (size_t)row * DM;
    float ss = 0.f;
#pragma unroll
    for (int i = 0; i < 4; ++i) {
      const int c = i * 256 + lane * 4;
      const f32x4 v = *(const f32x4*)(src + c);
      ss += v.x * v.x + v.y * v.y + v.z * v.z + v.w * v.w;
      *(f32x4*)(hd + c) = v;
      *(u32x2*)(hbd + c) = (u32x2){pk2(v.x, v.y), pk2(v.z, v.w)};
    }
#pragma unroll
    for (int o = 1; o < 64; o <<= 1) ss += shx(ss, o, lane);
    if (lane < 16) p.ssq0()[(size_t)row * 16 + lane] = lane == 0 ? ss : 0.f;
  }
  const int G = NL * MTOK * 32;
  for (int g = blockIdx.x * NTHR + tid; g < G; g += gridDim.x * NTHR) {
    const int l = g / (MTOK * 32), rem = g % (MTOK * 32), row = rem >> 5, c8 = rem & 31;
    const float* src = row < MP ? p.p_prompt + ((size_t)(l * MP + row) * PLE + c8 * 8) : p.p_sample + ((size_t)(l * MS + row - MP) * PLE + c8 * 8);
    const f32x4 a = *(const f32x4*)src, b = *(const f32x4*)(src + 4);
    *(u32x4*)(p.pb() + (size_t)g * 8) = (u32x4){pk2(a.x, a.y), pk2(a.z, a.w), pk2(b.x, b.y), pk2(b.z, b.w)};
  }
}

enum { EPI_PROJ = 0, EPI_LOGIT = 1, EPI_RESID = 2, EPI_UP = 3, EPI_PLE = 4, EPI_PP = 5 };
struct EpiArgs {
  const float* ssq_in; float* ssq_out; float* h; bf16_t* hb; bf16_t* obf; int ldo; float* of32; const bf16_t* pp;
};

template <int WMT, int WNT, int WGM, int WGN, int EPI, int BK = 32>
__device__ __forceinline__ void gemm_tile(const bf16_t* __restrict__ A, int lda, const bf16_t* __restrict__ Bt, int ldb, int K, int m0, int n0,
                                          bf16_t* lds, const EpiArgs& e) {
  constexpr int BM = WGM * WMT * 16, BN = WGN * WNT * 16, LDR = BK + 8;
  constexpr int STAGE = (BM + BN) * LDR;
  constexpr int PPR = BK / 8, RPI = NTHR / PPR;
  constexpr int NA = BM / RPI, NB = (BN + RPI - 1) / RPI;
  const int tid = opq(threadIdx.x), lane = tid & 63, wid = tid >> 6;
  const int wm = wid / WGN, wn = wid % WGN;
  const int fr = lane & 15, fq = lane >> 4;
  f32x4 acc[WMT][WNT];
#pragma unroll
  for (int i = 0; i < WMT; ++i)
#pragma unroll
    for (int j = 0; j < WNT; ++j) acc[i][j] = (f32x4){0.f, 0.f, 0.f, 0.f};
  u32x4 ra0[NA], rb0[NB], ra1[NA], rb1[NB];
  const int nk = K / BK;
  const int prow = tid / PPR, ppc = tid % PPR;
  const unsigned ta = (unsigned)(prow * lda + ppc * 8) * 2u, tb = (unsigned)(prow * ldb + ppc * 8) * 2u;
  const char* Au = (const char*)(A + (size_t)m0 * lda);
  const char* Bu = (const char*)(Bt + (size_t)n0 * ldb);
#define BGUARD(i) (BN >= RPI * ((i) + 1) || prow + (i) * RPI < BN)
#define GLOAD(kt, RA, RB) do { \
    _Pragma("unroll") for (int i = 0; i < NA; ++i) RA[i] = *(const u32x4*)(Au + ((size_t)i * RPI * lda + (size_t)(kt) * BK) * 2 + ta); \
    _Pragma("unroll") for (int i = 0; i < NB; ++i) if (BGUARD(i)) RB[i] = *(const u32x4*)(Bu + ((size_t)i * RPI * ldb + (size_t)(kt) * BK) * 2 + tb); \
  } while (0)
#define LSTORE(st, RA, RB) do { bf16_t* sA_ = lds + (st) * STAGE; bf16_t* sB_ = sA_ + BM * LDR; \
    _Pragma("unroll") for (int i = 0; i < NA; ++i) *(u32x4*)(sA_ + (prow + i * RPI) * LDR + ppc * 8) = RA[i]; \
    _Pragma("unroll") for (int i = 0; i < NB; ++i) if (BGUARD(i)) *(u32x4*)(sB_ + (prow + i * RPI) * LDR + ppc * 8) = RB[i]; \
  } while (0)
#define COMPUTE(st) do { const bf16_t* sA = lds + (st) * STAGE; const bf16_t* sB = sA + BM * LDR; \
    _Pragma("unroll") for (int kk = 0; kk < BK / 32; ++kk) { \
      bf16x8 bfr[WNT]; \
      _Pragma("unroll") for (int nt = 0; nt < WNT; ++nt) bfr[nt] = *(const bf16x8*)(sB + (wn * WNT * 16 + nt * 16 + fr) * LDR + kk * 32 + fq * 8); \
      _Pragma("unroll") for (int mt = 0; mt < WMT; ++mt) { \
        const bf16x8 af = *(const bf16x8*)(sA + (wm * WMT * 16 + mt * 16 + fr) * LDR + kk * 32 + fq * 8); \
        _Pragma("unroll") for (int nt = 0; nt < WNT; ++nt) acc[mt][nt] = mfma16(bfr[nt], af, acc[mt][nt]); } } \
  } while (0)
  GLOAD(0, ra0, rb0);
  GLOAD(1, ra1, rb1);
  LSTORE(0, ra0, rb0);
  __syncthreads();
  for (int kt = 0; kt < nk; kt += 2) {
    const int k2 = kt + 2 < nk ? kt + 2 : nk - 2;
    GLOAD(k2, ra0, rb0);
    COMPUTE(0);
    LSTORE(1, ra1, rb1);
    __syncthreads();
    GLOAD(k2 + 1, ra1, rb1);
    COMPUTE(1);
    LSTORE(0, ra0, rb0);
    __syncthreads();
  }
#undef BGUARD
#undef COMPUTE
#undef GLOAD
#undef LSTORE
#pragma unroll
  for (int mt = 0; mt < WMT; ++mt) {
    const int row = m0 + wm * WMT * 16 + mt * 16 + fr;
    float rs = 1.f;
    if (EPI == EPI_PROJ || EPI == EPI_LOGIT || EPI == EPI_UP || EPI == EPI_PLE) {
      const f32x4* sp = (const f32x4*)(e.ssq_in + (size_t)row * 16);
      const f32x4 a = sp[0], b = sp[1], c = sp[2], d = sp[3];
      const float s = ((a.x + a.y) + (a.z + a.w)) + ((b.x + b.y) + (b.z + b.w)) + ((c.x + c.y) + (c.z + c.w)) + ((d.x + d.y) + (d.z + d.w));
      rs = rsqrtf(s * (1.f / 1024.f) + EPS);
    }
    float sq = 0.f;
#pragma unroll
    for (int nt = 0; nt < WNT; ++nt) {
      const int col = n0 + wn * WNT * 16 + nt * 16 + fq * 4;
      f32x4 v = acc[mt][nt];
      if (EPI == EPI_PROJ) {
        v *= rs;
        *(u32x2*)(e.obf + (size_t)row * e.ldo + col) = (u32x2){pk2(v.x, v.y), pk2(v.z, v.w)};
      } else if (EPI == EPI_LOGIT) {
        v *= rs;
        *(f32x4*)(e.of32 + (size_t)row * 16 + col) = v;
      } else if (EPI == EPI_PP) {
        *(u32x2*)(e.obf + (size_t)row * e.ldo + col) = (u32x2){pk2(v.x, v.y), pk2(v.z, v.w)};
      } else if (EPI == EPI_UP) {
        v *= rs;
        v.x = fmaxf(v.x, 0.f); v.y = fmaxf(v.y, 0.f); v.z = fmaxf(v.z, 0.f); v.w = fmaxf(v.w, 0.f);
        v = v * v;
        *(u32x2*)(e.obf + (size_t)row * e.ldo + col) = (u32x2){pk2(v.x, v.y), pk2(v.z, v.w)};
      } else {
        float* hp = e.h + (size_t)row * DM + col;
        f32x4 hv = *(const f32x4*)hp;
        if (EPI == EPI_RESID) {
          hv += v;
        } else {
          const u32x2 pv = *(const u32x2*)(e.pp + (size_t)row * DM + col);
          hv.x += sigm(v.x * rs) * lo2f(pv.x); hv.y += sigm(v.y * rs) * hi2f(pv.x);
          hv.z += sigm(v.z * rs) * lo2f(pv.y); hv.w += sigm(v.w * rs) * hi2f(pv.y);
        }
        *(f32x4*)hp = hv;
        *(u32x2*)(e.hb + (size_t)row * DM + col) = (u32x2){pk2(hv.x, hv.y), pk2(hv.z, hv.w)};
        sq += hv.x * hv.x + hv.y * hv.y + hv.z * hv.z + hv.w * hv.w;
      }
    }
    if (EPI == EPI_RESID || EPI == EPI_PLE) {
      sq += shx(sq, 16, lane);
      sq += shx(sq, 32, lane);
      if (fq == 0) e.ssq_out[(size_t)row * 16 + (n0 / BN) * WGN + wn] = sq;
    }
  }
}

template <int EPI>
__device__ void gemm_phase(const bf16_t* A, int lda, const bf16_t* Bt, int ldb, int K, int M, int N, unsigned char* smem, const EpiArgs& e) {
  const int nM = M / 256, nN = N / 128, G = gridDim.x;
  const int nT = nM * nN;
  int nFull = nT;
  const int L = nT % G;
  if (L > 0 && L <= G / 4) nFull = nT - L;
  for (int t = blockIdx.x; t < nFull; t += G) {
    const int mi = t / nN, ni = t % nN;
    gemm_tile<8, 4, 2, 2, EPI>(A, lda, Bt, ldb, K, mi * 256, ni * 128, (bf16_t*)smem, e);
  }
  for (int st = blockIdx.x; st < (nT - nFull) * 8; st += G) {
    const int t = nFull + (st >> 3), sub = st & 7;
    const int mi = t / nN, ni = t % nN;
    gemm_tile<1, 4, 4, 1, EPI, 128>(A, lda, Bt, ldb, K, mi * 256 + (sub >> 1) * 64, ni * 128 + (sub & 1) * 64, (bf16_t*)smem, e);
  }
}


template <int I, int J4>
DEVI void solve_sub4(float& r, const float (&x)[64], const float* Am) {
  if constexpr (J4 * 4 < I) {
    const f32x4 a = *(const f32x4*)(Am + I * 64 + J4 * 4);
    if constexpr (J4 * 4 + 0 < I) r -= a.x * x[J4 * 4 + 0];
    if constexpr (J4 * 4 + 1 < I) r -= a.y * x[J4 * 4 + 1];
    if constexpr (J4 * 4 + 2 < I) r -= a.z * x[J4 * 4 + 2];
    if constexpr (J4 * 4 + 3 < I) r -= a.w * x[J4 * 4 + 3];
    solve_sub4<I, J4 + 1>(r, x, Am);
  }
}
template <int I>
DEVI void solve_rows(float (&x)[64], const float* Am, const bf16_t* src, const float* sc) {
  if constexpr (I < 64) {
    float r = bf2f(src[I * 136]) * sc[I];
    solve_sub4<I, 0>(r, x, Am);
    x[I] = r;
    asm volatile("" ::: "memory");
    solve_rows<I + 1>(x, Am, src, sc);
  }
}

__device__ void gdn_prep_item(const Params& p, int l, int item, unsigned char* smem) {
  const int tid = opq(threadIdx.x), lane = tid & 63, wid = tid >> 6, fr = lane & 15, fq = lane >> 4;
  const int h = item & 7, n = (item >> 3) & 31, b = item >> 8;
  const int tok0 = b * 2048 + n * 64;
  bf16_t* qh = (bf16_t*)smem;
  bf16_t* kh = qh + 64 * 136;
  bf16_t* vh = kh + 64 * 136;
  float* Am = (float*)(vh + 64 * 136);
  float* sbeta = Am + 64 * 64;
  float* sgc = sbeta + 64;
  float* sbe = sgc + 64;
  unsigned char* scr = (unsigned char*)p.scr() + (size_t)item * SCR_ITEM;
  bf16_t* g_uT = (bf16_t*)scr;
  bf16_t* g_w = (bf16_t*)(scr + 16384);
  bf16_t* g_qg = (bf16_t*)(scr + 32768);
  bf16_t* g_kgT = (bf16_t*)(scr + 49152);
  bf16_t* g_qk = (bf16_t*)(scr + 65536);

  if (wid == 0) {
    const float* lg = p.logits() + (size_t)(tok0 + lane) * 16;
    const float bl = lg[h], al = lg[8 + h];
    const float x = al + p.dt_bias[l * 8 + h];
    const float sp = softplus_f(x);
    float g = -__expf(p.a_log[l * 8 + h]) * sp;
#pragma unroll
    for (int o = 1; o < 64; o <<= 1) { const float t = shup(g, o, lane); if (lane >= o) g += t; }
    sbeta[lane] = sigm(bl);
    sgc[lane] = g;
    sbe[lane] = sigm(bl) * __expf(g);
  }
  u32x4 rwall[3][7];
#pragma unroll
  for (int sect = 0; sect < 3; ++sect)
#pragma unroll
    for (int r = 0; r < 7; ++r) {
      const int tl = n * 64 + wid * 16 + fq * 4 - 3 + r;
      rwall[sect][r] = (u32x4){0u, 0u, 0u, 0u};
      if (tl >= 0) rwall[sect][r] = *(const u32x4*)(p.proj() + (size_t)(b * 2048 + tl) * NPJ + sect * 1024 + h * 128 + fr * 8);
    }
#pragma unroll
  for (int sect = 0; sect < 3; ++sect) {
    const int ch0 = sect * 1024 + h * 128 + fr * 8;
    float cw[4][8];
#pragma unroll
    for (int j = 0; j < 4; ++j) {
      const f32x4 a = *(const f32x4*)(p.conv_w + (size_t)(l * 4 + j) * 3072 + ch0), c = *(const f32x4*)(p.conv_w + (size_t)(l * 4 + j) * 3072 + ch0 + 4);
      cw[j][0] = a.x; cw[j][1] = a.y; cw[j][2] = a.z; cw[j][3] = a.w; cw[j][4] = c.x; cw[j][5] = c.y; cw[j][6] = c.z; cw[j][7] = c.w;
    }
    const int ib = wid * 16 + fq * 4;
#pragma unroll
    for (int it = 0; it < 4; ++it) {
      float o[8];
#pragma unroll
      for (int c = 0; c < 8; ++c) o[c] = 0.f;
#pragma unroll
      for (int j = 0; j < 4; ++j) {
        float f[8];
        UNPACK8(rwall[sect][it + j], f);
#pragma unroll
        for (int c = 0; c < 8; ++c) o[c] += f[c] * cw[j][c];
      }
      float ss = 0.f;
#pragma unroll
      for (int c = 0; c < 8; ++c) { o[c] = silu(o[c]); ss += o[c] * o[c]; }
      if (sect < 2) {
        ss += shx(ss, 1, lane); ss += shx(ss, 2, lane); ss += shx(ss, 4, lane); ss += shx(ss, 8, lane);
        float rn = rsqrtf(ss + EPS);
        if (sect == 0) rn *= 0.08838834764831845f;
#pragma unroll
        for (int c = 0; c < 8; ++c) o[c] *= rn;
      }
      const u32x4 pk = (u32x4){pk2(o[0], o[1]), pk2(o[2], o[3]), pk2(o[4], o[5]), pk2(o[6], o[7])};
      bf16_t* dst = sect == 0 ? qh + (ib + it) * 136 + fr * 8 : (sect == 1 ? kh + (ib + it) * 136 + fr * 8 : vh + (ib + it) * 136 + fr * 8);
      *(u32x4*)dst = pk;
    }
  }
  __syncthreads();
  {
    const int i = wid * 16 + fr;
    const float gi = sgc[i], bi = sbeta[i];
    bf16x8 kx[4], qx[4];
#pragma unroll
    for (int ks = 0; ks < 4; ++ks) {
      kx[ks] = *(const bf16x8*)(kh + i * 136 + ks * 32 + fq * 8);
      qx[ks] = *(const bf16x8*)(qh + i * 136 + ks * 32 + fq * 8);
    }
#pragma unroll
    for (int jt = 0; jt < 4; ++jt) {
      f32x4 akk = (f32x4){0.f, 0.f, 0.f, 0.f}, aqk = (f32x4){0.f, 0.f, 0.f, 0.f};
      if (jt <= wid) {
#pragma unroll
        for (int ks = 0; ks < 4; ++ks) {
          const bf16x8 kj = *(const bf16x8*)(kh + (jt * 16 + fr) * 136 + ks * 32 + fq * 8);
          akk = mfma16(kj, kx[ks], akk);
          aqk = mfma16(kj, qx[ks], aqk);
        }
      }
      const int j0 = jt * 16 + fq * 4;
      float av[4], qv[4];
#pragma unroll
      for (int jj = 0; jj < 4; ++jj) {
        const int j = j0 + jj;
        const float dec = j <= i ? __expf(gi - sgc[j]) : 0.f;
        av[jj] = j < i ? bi * akk[jj] * dec : 0.f;
        qv[jj] = aqk[jj] * dec;
      }
      *(f32x4*)(Am + i * 64 + j0) = (f32x4){av[0], av[1], av[2], av[3]};
      *(u32x2*)(g_qk + i * 64 + j0) = (u32x2){pk2(qv[0], qv[1]), pk2(qv[2], qv[3])};
    }
  }
  __syncthreads();
  {
    float x[64];
    const bool isu = tid < 128;
    const int cc = tid & 127;
    solve_rows<0>(x, Am, (isu ? vh : kh) + cc, isu ? sbeta : sbe);
    if (isu) {
      u32x4* d = (u32x4*)(g_uT + cc * 64);
#pragma unroll
      for (int q = 0; q < 8; ++q) d[q] = (u32x4){pk2(x[q * 8], x[q * 8 + 1]), pk2(x[q * 8 + 2], x[q * 8 + 3]), pk2(x[q * 8 + 4], x[q * 8 + 5]), pk2(x[q * 8 + 6], x[q * 8 + 7])};
    } else {
#pragma unroll
      for (int i = 0; i < 64; ++i) g_w[i * 128 + cc] = f2bf(x[i]);
    }
  }
  {
    const float gl = sgc[63];
#pragma unroll
    for (int q = 0; q < 4; ++q) {
      const int pc = tid + q * 256, i = pc >> 4, c8 = pc & 15;
      const u32x4 v = *(const u32x4*)(qh + i * 136 + c8 * 8);
      float f[8];
      UNPACK8(v, f);
      const float s = __expf(sgc[i]);
      *(u32x4*)(g_qg + i * 128 + c8 * 8) = (u32x4){pk2(f[0] * s, f[1] * s), pk2(f[2] * s, f[3] * s), pk2(f[4] * s, f[5] * s), pk2(f[6] * s, f[7] * s)};
    }
    if (tid >= 128) {
      const int dk = tid - 128;
      u32x4* d = (u32x4*)(g_kgT + dk * 64);
#pragma unroll
      for (int q = 0; q < 8; ++q) {
        float f[8];
#pragma unroll
        for (int c = 0; c < 8; ++c) { const int i = q * 8 + c; f[c] = bf2f(kh[i * 136 + dk]) * __expf(gl - sgc[i]); }
        d[q] = (u32x4){pk2(f[0], f[1]), pk2(f[2], f[3]), pk2(f[4], f[5]), pk2(f[6], f[7])};
      }
    }
    if (tid == 0) p.gsc()[item] = __expf(gl);
  }
  __syncthreads();
}

__device__ void gdn_scan_item(const Params& p, int l, int item, unsigned char* smem) {
  const int tid = opq(threadIdx.x), lane = tid & 63, wid = tid >> 6, fr = lane & 15, fq = lane >> 4;
  const int dvs = item & 3, h = (item >> 2) & 7, b = item >> 5;
  bf16_t* ST = (bf16_t*)smem;
  bf16_t* VT = ST + 2 * 32 * 136;
  f32x4 S[2][2];
#pragma unroll
  for (int a = 0; a < 2; ++a)
#pragma unroll
    for (int c = 0; c < 2; ++c) S[a][c] = (f32x4){0.f, 0.f, 0.f, 0.f};
  __syncthreads();
  bf16x8 fw[4], fqg[4], fqk[2], fkg[2][2];
  u32x2 fu[2];
  float gs;
  bf16x8 nw[4], nqg[4], nqk[2], nkg[2][2];
  u32x2 nu[2];
  float ngs;
#define SCAN_LOAD(n_, W, QG, QK, KG, U, GS) do { \
    const int it_ = ((b * 32 + (n_)) << 3) + h; \
    const unsigned char* scr_ = (const unsigned char*)p.scr() + (size_t)it_ * SCR_ITEM; \
    const bf16_t* g_uT = (const bf16_t*)scr_; const bf16_t* g_w = (const bf16_t*)(scr_ + 16384); const bf16_t* g_qg = (const bf16_t*)(scr_ + 32768); \
    const bf16_t* g_kgT = (const bf16_t*)(scr_ + 49152); const bf16_t* g_qk = (const bf16_t*)(scr_ + 65536); \
    _Pragma("unroll") for (int ks = 0; ks < 4; ++ks) { \
      W[ks] = *(const bf16x8*)(g_w + (wid * 16 + fr) * 128 + ks * 32 + fq * 8); \
      QG[ks] = *(const bf16x8*)(g_qg + (wid * 16 + fr) * 128 + ks * 32 + fq * 8); } \
    _Pragma("unroll") for (int ks = 0; ks < 2; ++ks) { \
      QK[ks] = *(const bf16x8*)(g_qk + (wid * 16 + fr) * 64 + ks * 32 + fq * 8); \
      _Pragma("unroll") for (int mt = 0; mt < 2; ++mt) KG[mt][ks] = *(const bf16x8*)(g_kgT + ((2 * wid + mt) * 16 + fr) * 64 + ks * 32 + fq * 8); } \
    _Pragma("unroll") for (int nt = 0; nt < 2; ++nt) U[nt] = *(const u32x2*)(g_uT + (dvs * 32 + nt * 16 + fr) * 64 + wid * 16 + fq * 4); \
    GS = p.gsc()[it_]; } while (0)
  SCAN_LOAD(0, nw, nqg, nqk, nkg, nu, ngs);
  for (int n = 0; n < 32; ++n) {
#pragma unroll
    for (int ks = 0; ks < 4; ++ks) { fw[ks] = nw[ks]; fqg[ks] = nqg[ks]; }
#pragma unroll
    for (int ks = 0; ks < 2; ++ks) { fqk[ks] = nqk[ks]; fkg[0][ks] = nkg[0][ks]; fkg[1][ks] = nkg[1][ks]; }
    fu[0] = nu[0]; fu[1] = nu[1]; gs = ngs;
    if (n + 1 < 32) SCAN_LOAD(n + 1, nw, nqg, nqk, nkg, nu, ngs);
    bf16_t* STc = ST + (n & 1) * 32 * 136;
#pragma unroll
    for (int mt = 0; mt < 2; ++mt)
#pragma unroll
      for (int nt = 0; nt < 2; ++nt)
        *(u32x2*)(STc + (nt * 16 + fr) * 136 + (2 * wid + mt) * 16 + fq * 4) = (u32x2){pk2(S[mt][nt].x, S[mt][nt].y), pk2(S[mt][nt].z, S[mt][nt].w)};
    __syncthreads();
#pragma unroll
    for (int nt = 0; nt < 2; ++nt) {
      f32x4 a = (f32x4){0.f, 0.f, 0.f, 0.f};
#pragma unroll
      for (int ks = 0; ks < 4; ++ks) {
        const bf16x8 sb = *(const bf16x8*)(STc + (nt * 16 + fr) * 136 + ks * 32 + fq * 8);
        a = mfma16(fw[ks], sb, a);
      }
      const float v0 = lo2f(fu[nt].x) - a.x, v1 = hi2f(fu[nt].x) - a.y, v2 = lo2f(fu[nt].y) - a.z, v3 = hi2f(fu[nt].y) - a.w;
      *(u32x2*)(VT + (nt * 16 + fr) * 72 + wid * 16 + fq * 4) = (u32x2){pk2(v0, v1), pk2(v2, v3)};
    }
    __syncthreads();
#pragma unroll
    for (int mt = 0; mt < 2; ++mt) {
      f32x4 a = (f32x4){0.f, 0.f, 0.f, 0.f};
#pragma unroll
      for (int ks = 0; ks < 4; ++ks) {
        const bf16x8 sa = *(const bf16x8*)(STc + (mt * 16 + fr) * 136 + ks * 32 + fq * 8);
        a = mfma16(sa, fqg[ks], a);
      }
#pragma unroll
      for (int ks = 0; ks < 2; ++ks) {
        const bf16x8 va = *(const bf16x8*)(VT + (mt * 16 + fr) * 72 + ks * 32 + fq * 8);
        a = mfma16(va, fqk[ks], a);
      }
      const size_t row = (size_t)b * 2048 + n * 64 + wid * 16 + fr;
      *(u32x2*)(p.ogdn() + row * DM + h * 128 + dvs * 32 + mt * 16 + fq * 4) = (u32x2){pk2(a.x, a.y), pk2(a.z, a.w)};
    }
#pragma unroll
    for (int mt = 0; mt < 2; ++mt)
#pragma unroll
      for (int nt = 0; nt < 2; ++nt) {
        f32x4 a = S[mt][nt] * gs;
#pragma unroll
        for (int ks = 0; ks < 2; ++ks) {
          const bf16x8 vb = *(const bf16x8*)(VT + (nt * 16 + fr) * 72 + ks * 32 + fq * 8);
          a = mfma16(fkg[mt][ks], vb, a);
        }
        S[mt][nt] = a;
      }
  }
  float* so = p.out + O_GDNP + ((size_t)(l * 8 + b) * 8 + h) * 16384;
#pragma unroll
  for (int mt = 0; mt < 2; ++mt)
#pragma unroll
    for (int nt = 0; nt < 2; ++nt)
#pragma unroll
      for (int jj = 0; jj < 4; ++jj) so[((2 * wid + mt) * 16 + fq * 4 + jj) * 128 + dvs * 32 + nt * 16 + fr] = S[mt][nt][jj];
  __syncthreads();
#undef SCAN_LOAD
}

__device__ void gdn_sample_item(const Params& p, int l, int item, unsigned char* smem) {
  const int tid = opq(threadIdx.x), lane = tid & 63, wid = tid >> 6;
  const int h = item & 7, b = item >> 3;
  float* qs = (float*)smem;
  float* ks = qs + 1024;
  float* vs = ks + 1024;
  float* part = vs + 1024;
  float* sbeta = part + 256;
  float* sa = sbeta + 8;
  const int dv = tid & 127, half = tid >> 7;
  float S[64];
  const float* s0 = p.state_gdn + ((size_t)(l * 128 + b) * 8 + h) * 16384 + (half * 8192 + dv);
#pragma unroll
  for (int k = 0; k < 64; ++k) S[k] = s0[k * 128];
#pragma unroll
  for (int ps = 0; ps < 2; ++ps) {
    const int c = tid + ps * 256;
    if (c < 384) {
      const int sect = c >> 7, ci = c & 127;
      const int ch = sect * 1024 + h * 128 + ci;
      float xw[11], cwv[4];
#pragma unroll
      for (int j = 0; j < 4; ++j) cwv[j] = p.conv_w[(size_t)(l * 4 + j) * 3072 + ch];
#pragma unroll
      for (int j = 0; j < 3; ++j) xw[j] = p.cache_conv[((size_t)(l * 128 + b) * 3 + j) * 3072 + ch];
#pragma unroll
      for (int t = 0; t < 8; ++t) xw[3 + t] = bf2f(p.proj()[(size_t)(MP + b * 8 + t) * NPJ + ch]);
      float* dst = sect == 0 ? qs : (sect == 1 ? ks : vs);
#pragma unroll
      for (int t = 0; t < 8; ++t) dst[t * 128 + ci] = silu(xw[t] * cwv[0] + xw[t + 1] * cwv[1] + xw[t + 2] * cwv[2] + xw[t + 3] * cwv[3]);
    }
  }
  if (tid < 8) {
    const float* lg = p.logits() + (size_t)(MP + b * 8 + tid) * 16;
    const float x = lg[8 + h] + p.dt_bias[l * 8 + h];
    const float sp = softplus_f(x);
    sa[tid] = __expf(-__expf(p.a_log[l * 8 + h]) * sp);
    sbeta[tid] = sigm(lg[h]);
  }
  __syncthreads();
#pragma unroll
  for (int u = 0; u < 4; ++u) {
    const int t = wid * 2 + (u >> 1);
    float* arr = (u & 1) ? ks : qs;
    const float a0 = arr[t * 128 + lane], a1 = arr[t * 128 + 64 + lane];
    float ss = a0 * a0 + a1 * a1;
#pragma unroll
    for (int o = 1; o < 64; o <<= 1) ss += shx(ss, o, lane);
    float rn = rsqrtf(ss + EPS);
    if (!(u & 1)) rn *= 0.08838834764831845f;
    arr[t * 128 + lane] = a0 * rn;
    arr[t * 128 + 64 + lane] = a1 * rn;
  }
  __syncthreads();
#pragma unroll 1
  for (int t = 0; t < 8; ++t) {
    const float a = sa[t], bt = sbeta[t];
    float kv = 0.f;
#pragma unroll
    for (int k4 = 0; k4 < 16; ++k4) {
      const f32x4 kk = *(const f32x4*)(ks + t * 128 + half * 64 + k4 * 4);
      S[k4 * 4 + 0] *= a; S[k4 * 4 + 1] *= a; S[k4 * 4 + 2] *= a; S[k4 * 4 + 3] *= a;
      kv += S[k4 * 4 + 0] * kk.x + S[k4 * 4 + 1] * kk.y + S[k4 * 4 + 2] * kk.z + S[k4 * 4 + 3] * kk.w;
      if ((k4 & 3) == 3) asm volatile("" ::: "memory");
    }
    part[half * 128 + dv] = kv;
    __syncthreads();
    const float delta = bt * (vs[t * 128 + dv] - (part[dv] + part[128 + dv]));
    __syncthreads();
    float o = 0.f;
#pragma unroll
    for (int k4 = 0; k4 < 16; ++k4) {
      const f32x4 kk = *(const f32x4*)(ks + t * 128 + half * 64 + k4 * 4);
      const f32x4 qq = *(const f32x4*)(qs + t * 128 + half * 64 + k4 * 4);
      S[k4 * 4 + 0] += kk.x * delta; S[k4 * 4 + 1] += kk.y * delta; S[k4 * 4 + 2] += kk.z * delta; S[k4 * 4 + 3] += kk.w * delta;
      o += S[k4 * 4 + 0] * qq.x + S[k4 * 4 + 1] * qq.y + S[k4 * 4 + 2] * qq.z + S[k4 * 4 + 3] * qq.w;
      if ((k4 & 3) == 3) asm volatile("" ::: "memory");
    }
    part[half * 128 + dv] = o;
    __syncthreads();
    if (half == 0) p.ogdn()[(size_t)(MP + b * 8 + t) * DM + h * 128 + dv] = f2bf(part[dv] + part[128 + dv]);
    __syncthreads();
  }
  float* so = p.out + O_GDNS + ((size_t)(l * 128 + b) * 8 + h) * 16384 + opq(half * 8192 + dv);
#pragma unroll
  for (int k = 0; k < 64; ++k) so[k * 128] = S[k];
  __syncthreads();
}

__device__ void gdn_sample_pair(const Params& p, int l, int pair, unsigned char* smem) {
  const int tid = opq(threadIdx.x), lane = tid & 63, wid = tid >> 6;
  const int sub = tid >> 7, dv = tid & 127;
  const int item = pair * 2 + sub, h = item & 7, b = item >> 3;
  float* qs = (float*)smem + sub * 3104;
  float* ks = qs + 1024;
  float* vs = qs + 2048;
  float* sbeta = qs + 3072;
  float* sa = qs + 3080;
  f32x2 S2[64];
  const float* s0 = p.state_gdn + ((size_t)(l * 128 + b) * 8 + h) * 16384 + dv;
#pragma unroll
  for (int k = 0; k < 64; ++k) { S2[k].x = s0[(2 * k) * 128]; S2[k].y = s0[(2 * k + 1) * 128]; }
#pragma unroll
  for (int sect = 0; sect < 3; ++sect) {
    const int ch = sect * 1024 + h * 128 + dv;
    float xw[11], cwv[4];
#pragma unroll
    for (int j = 0; j < 4; ++j) cwv[j] = p.conv_w[(size_t)(l * 4 + j) * 3072 + ch];
#pragma unroll
    for (int j = 0; j < 3; ++j) xw[j] = p.cache_conv[((size_t)(l * 128 + b) * 3 + j) * 3072 + ch];
#pragma unroll
    for (int t = 0; t < 8; ++t) xw[3 + t] = bf2f(p.proj()[(size_t)(MP + b * 8 + t) * NPJ + ch]);
    float* dst = sect == 0 ? qs : (sect == 1 ? ks : vs);
#pragma unroll
    for (int t = 0; t < 8; ++t) dst[t * 128 + dv] = silu(xw[t] * cwv[0] + xw[t + 1] * cwv[1] + xw[t + 2] * cwv[2] + xw[t + 3] * cwv[3]);
  }
  if (dv < 8) {
    const float* lg = p.logits() + (size_t)(MP + b * 8 + dv) * 16;
    const float x = lg[8 + h] + p.dt_bias[l * 8 + h];
    sa[dv] = __expf(-__expf(p.a_log[l * 8 + h]) * softplus_f(x));
    sbeta[dv] = sigm(lg[h]);
  }
  __syncthreads();
#pragma unroll
  for (int u = 0; u < 8; ++u) {
    const int t = (wid & 1) * 4 + (u >> 1);
    float* arr = (u & 1) ? ks : qs;
    const float a0 = arr[t * 128 + lane], a1 = arr[t * 128 + 64 + lane];
    float ss = a0 * a0 + a1 * a1;
#pragma unroll
    for (int o = 1; o < 64; o <<= 1) ss += shx(ss, o, lane);
    float rn = rsqrtf(ss + EPS);
    if (!(u & 1)) rn *= 0.08838834764831845f;
    arr[t * 128 + lane] = a0 * rn;
    arr[t * 128 + 64 + lane] = a1 * rn;
  }
  __syncthreads();
#pragma unroll 1
  for (int t = 0; t < 8; ++t) {
    const float a = sa[t], bt = sbeta[t];
    f32x2 kv2 = (f32x2){0.f, 0.f};
#pragma unroll
    for (int k4 = 0; k4 < 32; ++k4) {
      const f32x4 kk = *(const f32x4*)(ks + t * 128 + k4 * 4);
      kv2 += S2[2 * k4] * (f32x2){kk.x, kk.y};
      kv2 += S2[2 * k4 + 1] * (f32x2){kk.z, kk.w};
      if ((k4 & 3) == 3) asm volatile("" ::: "memory");
    }
    const float delta = bt * (vs[t * 128 + dv] - a * (kv2.x + kv2.y));
    const f32x2 a2 = (f32x2){a, a}, d2 = (f32x2){delta, delta};
    f32x2 o2 = (f32x2){0.f, 0.f};
#pragma unroll
    for (int k4 = 0; k4 < 32; ++k4) {
      const f32x4 kk = *(const f32x4*)(ks + t * 128 + k4 * 4);
      const f32x4 qq = *(const f32x4*)(qs + t * 128 + k4 * 4);
      S2[2 * k4] = S2[2 * k4] * a2 + (f32x2){kk.x, kk.y} * d2;
      S2[2 * k4 + 1] = S2[2 * k4 + 1] * a2 + (f32x2){kk.z, kk.w} * d2;
      o2 += S2[2 * k4] * (f32x2){qq.x, qq.y};
      o2 += S2[2 * k4 + 1] * (f32x2){qq.z, qq.w};
      if ((k4 & 3) == 3) asm volatile("" ::: "memory");
    }
    p.ogdn()[(size_t)(MP + b * 8 + t) * DM + h * 128 + dv] = f2bf(o2.x + o2.y);
  }
  float* so = p.out + O_GDNS + ((size_t)(l * 128 + b) * 8 + h) * 16384 + opq(dv);
#pragma unroll
  for (int k = 0; k < 64; ++k) { so[(2 * k) * 128] = S2[k].x; so[(2 * k + 1) * 128] = S2[k].y; }
  __syncthreads();
}

__device__ void swa_prompt_item(const Params& p, int l, int item, unsigned char* smem) {
  const int tid = opq(threadIdx.x), lane = tid & 63, wid = tid >> 6, fr = lane & 15, fq = lane >> 4;
  const int kvh = item & 3, hb2 = (item >> 2) & 31, b = item >> 7;
  bf16_t* Ks = (bf16_t*)smem;
  bf16_t* VT = Ks + 208 * 72;
  bf16_t* Pw = VT + 64 * 216 + wid * 16 * 168;
  const int tk0 = hb2 * 64 - 128;
  u32x4 krw[7], vrw[7];
#pragma unroll
  for (int i = 0; i < 7; ++i) {
    const int pc = tid + i * NTHR, kj = pc >> 3, c8 = pc & 7, tk = tk0 + kj;
    krw[i] = (u32x4){0u, 0u, 0u, 0u}; vrw[i] = (u32x4){0u, 0u, 0u, 0u};
    if (pc < 208 * 8 && kj < 192 && tk >= 0) {
      const bf16_t* base = p.proj() + (size_t)(b * 2048 + tk) * NPJ + kvh * 64 + c8 * 8;
      krw[i] = *(const u32x4*)(base + C_SK); vrw[i] = *(const u32x4*)(base + C_SV);
    }
  }
#pragma unroll
  for (int i = 0; i < 7; ++i) {
    const int pc = tid + i * NTHR;
    if (pc >= 208 * 8) break;
    const int kj = pc >> 3, c8 = pc & 7, tk = tk0 + kj;
    const bool ok = kj < 192 && tk >= 0;
    float kf[8], vf[8];
    UNPACK8(krw[i], kf);
    UNPACK8(vrw[i], vf);
    float ss = 0.f;
#pragma unroll
    for (int c = 0; c < 8; ++c) ss += kf[c] * kf[c];
    ss += shx(ss, 1, lane); ss += shx(ss, 2, lane); ss += shx(ss, 4, lane);
    const float rn = rsqrtf(ss * (1.f / 64.f) + EPS);
    const f32x4 w0 = *(const f32x4*)(p.k_norm + l * 64 + c8 * 8), w1 = *(const f32x4*)(p.k_norm + l * 64 + c8 * 8 + 4);
    kf[0] *= rn * w0.x; kf[1] *= rn * w0.y; kf[2] *= rn * w0.z; kf[3] *= rn * w0.w;
    kf[4] *= rn * w1.x; kf[5] *= rn * w1.y; kf[6] *= rn * w1.z; kf[7] *= rn * w1.w;
    *(u32x4*)(Ks + kj * 72 + c8 * 8) = (u32x4){pk2(kf[0], kf[1]), pk2(kf[2], kf[3]), pk2(kf[4], kf[5]), pk2(kf[6], kf[7])};
#pragma unroll
    for (int c = 0; c < 8; ++c) VT[(c8 * 8 + c) * 216 + kj] = f2bf(vf[c]);
    if (ok && tk >= 1920 && kj >= 128) {
      float* ko = p.out + O_KP + (((size_t)(l * 8 + b) * 128 + (tk - 1920)) * 4 + kvh) * 64 + c8 * 8;
      float* vo = p.out + O_VP + (((size_t)(l * 8 + b) * 128 + (tk - 1920)) * 4 + kvh) * 64 + c8 * 8;
      *(f32x4*)ko = (f32x4){kf[0], kf[1], kf[2], kf[3]};
      *(f32x4*)(ko + 4) = (f32x4){kf[4], kf[5], kf[6], kf[7]};
      *(f32x4*)vo = (f32x4){vf[0], vf[1], vf[2], vf[3]};
      *(f32x4*)(vo + 4) = (f32x4){vf[4], vf[5], vf[6], vf[7]};
    }
  }
  __syncthreads();
  const int kbase = wid * 16;
  const int ql = wid * 16 + fr;
  const size_t qrow = (size_t)b * 2048 + hb2 * 64 + ql;
  u32x4 qraw[4][2];
#pragma unroll
  for (int g = 0; g < 4; ++g) {
    const bf16_t* qp = p.proj() + qrow * NPJ + C_SQ + (kvh * 4 + g) * 64 + fq * 8;
    qraw[g][0] = *(const u32x4*)qp; qraw[g][1] = *(const u32x4*)(qp + 32);
  }
#pragma unroll
  for (int g = 0; g < 4; ++g) {
    const int head = kvh * 4 + g;
    const float slope = exp2f(-0.5f * (float)(head + 1));
    const float sink = p.sinks[l * 16 + head];
    bf16x8 qf[2];
    {
      const u32x4 r0 = qraw[g][0], r1 = qraw[g][1];
      float f0[8], f1[8];
      UNPACK8(r0, f0);
      UNPACK8(r1, f1);
      float ss = 0.f;
#pragma unroll
      for (int c = 0; c < 8; ++c) ss += f0[c] * f0[c] + f1[c] * f1[c];
      ss += shx(ss, 16, lane); ss += shx(ss, 32, lane);
      const float rn = rsqrtf(ss * (1.f / 64.f) + EPS) * 0.125f;
      const float* qn = p.q_norm + l * 64 + fq * 8;
#pragma unroll
      for (int c = 0; c < 8; ++c) { f0[c] *= rn * qn[c]; f1[c] *= rn * qn[32 + c]; }
      qf[0] = as_bf((u32x4){pk2(f0[0], f0[1]), pk2(f0[2], f0[3]), pk2(f0[4], f0[5]), pk2(f0[6], f0[7])});
      qf[1] = as_bf((u32x4){pk2(f1[0], f1[1]), pk2(f1[2], f1[3]), pk2(f1[4], f1[5]), pk2(f1[6], f1[7])});
    }
    f32x4 sc[9];
    float mx = sink;
#pragma unroll
    for (int kt = 0; kt < 9; ++kt) {
      f32x4 a = (f32x4){0.f, 0.f, 0.f, 0.f};
#pragma unroll
      for (int ks = 0; ks < 2; ++ks) {
        const bf16x8 kf = *(const bf16x8*)(Ks + (kbase + kt * 16 + fr) * 72 + ks * 32 + fq * 8);
        a = mfma16(kf, qf[ks], a);
      }
#pragma unroll
      for (int jj = 0; jj < 4; ++jj) {
        const int kj = kbase + kt * 16 + fq * 4 + jj;
        const int dist = ql + 128 - kj;
        const bool ok = dist >= 0 && dist <= 128 && (tk0 + kj) >= 0;
        const float s = ok ? a[jj] - slope * (float)dist : -INFINITY;
        a[jj] = s;
        mx = fmaxf(mx, s);
      }
      sc[kt] = a;
    }
    mx = fmaxf(mx, shx(mx, 16, lane));
    mx = fmaxf(mx, shx(mx, 32, lane));
    float sum = 0.f;
#pragma unroll
    for (int kt = 0; kt < 9; ++kt) {
      f32x4 e;
#pragma unroll
      for (int jj = 0; jj < 4; ++jj) { e[jj] = __expf(sc[kt][jj] - mx); sum += e[jj]; }
      *(u32x2*)(Pw + fr * 168 + kt * 16 + fq * 4) = (u32x2){pk2(e.x, e.y), pk2(e.z, e.w)};
    }
    *(u32x2*)(Pw + fr * 168 + 144 + fq * 4) = (u32x2){0u, 0u};
    sum += shx(sum, 16, lane);
    sum += shx(sum, 32, lane);
    const float inv = 1.f / (sum + __expf(sink - mx));
    __builtin_amdgcn_wave_barrier();
#pragma unroll
    for (int dt = 0; dt < 4; ++dt) {
      f32x4 a = (f32x4){0.f, 0.f, 0.f, 0.f};
#pragma unroll
      for (int ks = 0; ks < 5; ++ks) {
        const bf16x8 vf = *(const bf16x8*)(VT + (dt * 16 + fr) * 216 + kbase + ks * 32 + fq * 8);
        const bf16x8 pf = *(const bf16x8*)(Pw + fr * 168 + ks * 32 + fq * 8);
        a = mfma16(vf, pf, a);
      }
      a *= inv;
      *(u32x2*)(p.oswa() + qrow * DM + head * 64 + dt * 16 + fq * 4) = (u32x2){pk2(a.x, a.y), pk2(a.z, a.w)};
    }
    __builtin_amdgcn_wave_barrier();
  }
  __syncthreads();
}

__device__ void swa_sample_item(const Params& p, int l, int item, unsigned char* smem) {
  const int tid = opq(threadIdx.x), lane = tid & 63, wid = tid >> 6;
  const int kvh = item & 3, b = item >> 2;
  float* Ks = (float*)smem;
  float* Vs = Ks + 136 * 65;
  float* Qs = Vs + 136 * 64;
  float* Sc = Qs + 512;
  const size_t cbase = (size_t)(l * 128 + b) * 128;
  f32x4 kvr[8], vvr[8];
#pragma unroll
  for (int i = 0; i < 8; ++i) {
    const int idx = tid + i * NTHR, j = idx >> 4, c4 = idx & 15;
    kvr[i] = *(const f32x4*)(p.cache_k + ((cbase + j) * 4 + kvh) * 64 + c4 * 4);
    vvr[i] = *(const f32x4*)(p.cache_v + ((cbase + j) * 4 + kvh) * 64 + c4 * 4);
  }
  unsigned qrw[4];
#pragma unroll
  for (int g = 0; g < 4; ++g) qrw[g] = *(const unsigned*)(p.proj() + (size_t)(MP + b * 8 + (tid >> 5)) * NPJ + C_SQ + (kvh * 4 + g) * 64 + (tid & 31) * 2);
#pragma unroll
  for (int i = 0; i < 8; ++i) {
    const int idx = tid + i * NTHR, j = idx >> 4, c4 = idx & 15;
    const f32x4 kv = kvr[i], vv = vvr[i];
    Ks[j * 65 + c4 * 4 + 0] = kv.x; Ks[j * 65 + c4 * 4 + 1] = kv.y; Ks[j * 65 + c4 * 4 + 2] = kv.z; Ks[j * 65 + c4 * 4 + 3] = kv.w;
    *(f32x4*)(Vs + j * 64 + c4 * 4) = vv;
  }
  {
    const int t = tid >> 5, d = (tid & 31) * 2;
    const bf16_t* base = p.proj() + (size_t)(MP + b * 8 + t) * NPJ + kvh * 64 + d;
    const unsigned kr = *(const unsigned*)(base + C_SK), vr = *(const unsigned*)(base + C_SV);
    float k0 = lo2f(kr), k1 = hi2f(kr);
    float ss = k0 * k0 + k1 * k1;
#pragma unroll
    for (int o = 1; o < 32; o <<= 1) ss += shx(ss, o, lane);
    const float rn = rsqrtf(ss * (1.f / 64.f) + EPS);
    Ks[(128 + t) * 65 + d] = k0 * rn * p.k_norm[l * 64 + d];
    Ks[(128 + t) * 65 + d + 1] = k1 * rn * p.k_norm[l * 64 + d + 1];
    Vs[(128 + t) * 64 + d] = lo2f(vr);
    Vs[(128 + t) * 64 + d + 1] = hi2f(vr);
  }
  __syncthreads();
  for (int idx = tid; idx < 128 * 64; idx += NTHR) {
    const int j = idx >> 6, d = idx & 63;
    p.out[O_KS + ((cbase + j) * 4 + kvh) * 64 + d] = Ks[(j + 8) * 65 + d];
    p.out[O_VS + ((cbase + j) * 4 + kvh) * 64 + d] = Vs[(j + 8) * 64 + d];
  }
#pragma unroll
  for (int g = 0; g < 4; ++g) {
    const int head = kvh * 4 + g;
    const float slope = exp2f(-0.5f * (float)(head + 1));
    const float sink = p.sinks[l * 16 + head];
    {
      const int t = tid >> 5, d = (tid & 31) * 2;
      const unsigned qr = qrw[g];
      const float q0 = lo2f(qr), q1 = hi2f(qr);
      float ss = q0 * q0 + q1 * q1;
#pragma unroll
      for (int o = 1; o < 32; o <<= 1) ss += shx(ss, o, lane);
      const float rn = rsqrtf(ss * (1.f / 64.f) + EPS) * 0.125f;
      Qs[t * 64 + d] = q0 * rn * p.q_norm[l * 64 + d];
      Qs[t * 64 + d + 1] = q1 * rn * p.q_norm[l * 64 + d + 1];
    }
    __syncthreads();
    for (int idx = tid; idx < 8 * 136; idx += NTHR) {
      const int tq = idx / 136, j = idx % 136;
      float s = 0.f;
#pragma unroll 16
      for (int d = 0; d < 64; ++d) s += Qs[tq * 64 + d] * Ks[j * 65 + d];
      const int dist = tq + 128 - j;
      Sc[tq * 136 + j] = (dist >= 0 && dist <= 128) ? s - slope * (float)dist : -INFINITY;
    }
    __syncthreads();
#pragma unroll
    for (int u = 0; u < 2; ++u) {
      const int tq = wid * 2 + u;
      const float s0 = Sc[tq * 136 + lane], s1 = Sc[tq * 136 + 64 + lane], s2 = lane < 8 ? Sc[tq * 136 + 128 + lane] : -INFINITY;
      float mx = fmaxf(fmaxf(s0, s1), fmaxf(s2, sink));
#pragma unroll
      for (int o = 1; o < 64; o <<= 1) mx = fmaxf(mx, shx(mx, o, lane));
      const float e0 = __expf(s0 - mx), e1 = __expf(s1 - mx), e2 = __expf(s2 - mx);
      float sum = e0 + e1 + e2;
#pragma unroll
      for (int o = 1; o < 64; o <<= 1) sum += shx(sum, o, lane);
      const float inv = 1.f / (sum + __expf(sink - mx));
      Sc[tq * 136 + lane] = e0 * inv;
      Sc[tq * 136 + 64 + lane] = e1 * inv;
      if (lane < 8) Sc[tq * 136 + 128 + lane] = e2 * inv;
    }
    __syncthreads();
    {
      const int tq = tid >> 5, d = (tid & 31) * 2;
      float o0 = 0.f, o1 = 0.f;
#pragma unroll 8
      for (int j = 0; j < 136; ++j) {
        const float pj = Sc[tq * 136 + j];
        const f32x2 v = *(const f32x2*)(Vs + j * 64 + d);
        o0 += pj * v.x;
        o1 += pj * v.y;
      }
      *(unsigned*)(p.oswa() + (size_t)(MP + b * 8 + tq) * DM + head * 64 + d) = pk2(o0, o1);
    }
    __syncthreads();
  }
}

__device__ void phase_mix(const Params& p, int l) {
  const int tid = opq(threadIdx.x), lane = tid & 63, wid = tid >> 6, fr = lane & 15, fq = lane >> 4;
  for (int it = blockIdx.x; it < MTOK / 4; it += gridDim.x) {
    const size_t row = (size_t)it * 4 + wid;
#pragma unroll
    for (int ps = 0; ps < 2; ++ps) {
      const int ch = (ps * 4 + fq) * 128 + fr * 8;
      const u32x4 og = *(const u32x4*)(p.ogdn() + row * DM + ch);
      const u32x4 ob = *(const u32x4*)(p.oswa() + row * DM + ch);
      const u32x4 zz = *(const u32x4*)(p.proj() + row * NPJ + C_Z + ch);
      const u32x4 ga = *(const u32x4*)(p.proj() + row * NPJ + C_G + ch);
      const u32x4 gb = *(const u32x4*)(p.proj() + row * NPJ + C_G + 1024 + ch);
      float fo[8], fb[8], fz[8], fa[8], fg[8];
      UNPACK8(og, fo); UNPACK8(ob, fb); UNPACK8(zz, fz); UNPACK8(ga, fa); UNPACK8(gb, fg);
      float ss = 0.f;
#pragma unroll
      for (int c = 0; c < 8; ++c) ss += fo[c] * fo[c];
      ss += shx(ss, 1, lane); ss += shx(ss, 2, lane); ss += shx(ss, 4, lane); ss += shx(ss, 8, lane);
      const float rn = rsqrtf(ss * (1.f / 128.f) + EPS);
      const f32x4 w0 = *(const f32x4*)(p.gdn_norm + l * 128 + fr * 8), w1 = *(const f32x4*)(p.gdn_norm + l * 128 + fr * 8 + 4);
      const float wn[8] = {w0.x, w0.y, w0.z, w0.w, w1.x, w1.y, w1.z, w1.w};
      float m[8];
#pragma unroll
      for (int c = 0; c < 8; ++c) m[c] = sigm(fa[c]) * (fo[c] * rn * wn[c] * silu(fz[c])) + sigm(fg[c]) * fb[c];
      *(u32x4*)(p.mix() + row * DM + ch) = (u32x4){pk2(m[0], m[1]), pk2(m[2], m[3]), pk2(m[4], m[5]), pk2(m[6], m[7])};
    }
  }
  const int NC = (8 + 128) * 3 * 3072;
  for (int i = blockIdx.x * NTHR + tid; i < NC; i += gridDim.x * NTHR) {
    const int c = i % 3072, r = (i / 3072) % 3, bb = i / 9216;
    if (bb < 8) p.out[O_CONVP + ((size_t)(l * 8 + bb) * 3 + r) * 3072 + c] = bf2f(p.proj()[(size_t)(bb * 2048 + 2045 + r) * NPJ + c]);
    else p.out[O_CONVS + ((size_t)(l * 128 + bb - 8) * 3 + r) * 3072 + c] = bf2f(p.proj()[(size_t)(MP + (bb - 8) * 8 + 5 + r) * NPJ + c]);
  }
}

#define XB_TMO      128
#define XB_XCNT(j)  (256  + 64 * (j))
#define XB_XSUB(j)  (1280 + 64 * (j))
#define XB_XGEN(j)  (2304 + 64 * (j))
#define XB_TOP      3328
#define XB_TOPGEN   3392
#define XCD_BAR_WORDS 3456
#define XB_SPIN_CAP (1u << 18)
#define LAS __attribute__((address_space(3)))

__device__ __forceinline__ unsigned xb_ld(unsigned* p)              { return __hip_atomic_load(p, __ATOMIC_RELAXED, __HIP_MEMORY_SCOPE_AGENT); }
__device__ __forceinline__ unsigned xb_add(unsigned* p, unsigned v) { return __hip_atomic_fetch_add(p, v, __ATOMIC_RELAXED, __HIP_MEMORY_SCOPE_AGENT); }
__device__ __forceinline__ unsigned xb_xcc_id() { return (unsigned)__builtin_amdgcn_s_getreg((3 << 11) | 20) & 0xFu; }
#define XB_SPIN(cond, bar) do { unsigned _sp = 0; while (cond) { __builtin_amdgcn_s_sleep(1); \
    if ((++_sp & 255u) == 0u) { if (xb_ld(&(bar)[XB_TMO])) break; if (_sp > XB_SPIN_CAP) { atomicAdd(&(bar)[XB_TMO], 1u); break; } } } } while (0)

struct XcdBarrier {
    unsigned* bar; unsigned x;
    volatile LAS unsigned* st;
};

__device__ __forceinline__ XcdBarrier xcd_barrier_post(unsigned* bar, volatile LAS unsigned* st) {
    XcdBarrier b; b.bar = bar; b.x = xb_xcc_id(); b.st = st;
    if (threadIdx.x == 0) (void)xb_add(&bar[XB_XCNT(b.x)], 1u);
    return b;
}
__device__ __forceinline__ void xcd_barrier_complete(unsigned* bar, unsigned x, unsigned& nloc, unsigned& nx) {
    const unsigned G = gridDim.x * gridDim.y * gridDim.z;
    unsigned sum, cnt, mine, sp = 0u;
    for (;;) {
        sum = 0u; cnt = 0u; mine = 0u;
#pragma unroll
        for (unsigned j = 0; j < 16; ++j) { const unsigned c = xb_ld(&bar[XB_XCNT(j)]); sum += c; cnt += (c > 0u) ? 1u : 0u; mine = (j == x) ? c : mine; }
        if (sum == G) break;
        __builtin_amdgcn_s_sleep(1);
        if ((++sp & 255u) == 0u) { if (xb_ld(&bar[XB_TMO])) break; if (sp > XB_SPIN_CAP) { atomicAdd(&bar[XB_TMO], 1u); break; } }
    }
    nloc = mine > 0u ? mine : 1u; nx = cnt > 0u ? cnt : 1u;
}

__device__ __forceinline__ void xcd_barrier(const XcdBarrier& b) {
    asm volatile("s_waitcnt vmcnt(0)" ::: "memory");
    __syncthreads();
    if (threadIdx.x == 0) {
        unsigned* bar = b.bar;
        __builtin_amdgcn_s_waitcnt(0);
        unsigned nloc = b.st[0], nx = b.st[1];
        if (nloc == 0u) { xcd_barrier_complete(bar, b.x, nloc, nx); b.st[0] = nloc; b.st[1] = nx; }
        const unsigned old = xb_add(&bar[XB_XSUB(b.x)], 1u);
        const unsigned gen = old / nloc;
        if (old + 1u == (gen + 1u) * nloc) {
            __builtin_amdgcn_fence(__ATOMIC_RELEASE, "agent");
            asm volatile("s_waitcnt vmcnt(0)" ::: "memory");
            const unsigned og = xb_add(&bar[XB_TOP], 1u);
            const unsigned tg = og / nx;
            if (og + 1u == (tg + 1u) * nx) xb_add(&bar[XB_TOPGEN], 1u);
            else XB_SPIN(xb_ld(&bar[XB_TOPGEN]) == tg, bar);
            __builtin_amdgcn_fence(__ATOMIC_ACQUIRE, "agent");
            xb_add(&bar[XB_XGEN(b.x)], 1u);
            asm volatile("s_waitcnt vmcnt(0)" ::: "memory");
        } else {
            XB_SPIN(xb_ld(&bar[XB_XGEN(b.x)]) == gen, bar);
            __builtin_amdgcn_fence(__ATOMIC_ACQUIRE, "agent");
            asm volatile("s_waitcnt vmcnt(0)" ::: "memory");
        }
    }
    __syncthreads();
}


#define NPHASE_PRE 2
#define NPHASE_L 8
__global__ void __launch_bounds__(NTHR, 2) mega(Params p, int ph_lo, int ph_hi) {
  __shared__ __attribute__((aligned(16))) unsigned char smem[SMEM_BYTES];
  if (ph_hi < 0) cg::this_grid().sync();
  __shared__ uint4 xb_words;
  if (threadIdx.x == 0) xb_words = make_uint4(0u, 0u, 0u, 0u);
  __syncthreads();
  XcdBarrier xb = xcd_barrier_post(p.bar(), (volatile LAS unsigned*)&xb_words);
  for (int ph = ph_lo; ph < ph_hi; ++ph) {
    if (ph > ph_lo) xcd_barrier(xb);
    if (ph == 0) { phase_p0(p, smem); continue; }
    if (ph == 1) {
      for (int t = blockIdx.x; t < NL * 68 * 8; t += gridDim.x) {
        const int l = t / 544, r = t % 544;
        EpiArgs e{};
        e.obf = p.pp() + (size_t)l * MTOK * DM; e.ldo = DM;
        gemm_tile<8, 4, 2, 2, EPI_PP>(p.pb() + (size_t)l * MTOK * PLE, PLE, p.wt_proj() + (size_t)l * DM * PLE, PLE, PLE, (r / 8) * 256, (r % 8) * 128, (bf16_t*)smem, e);
      }
      continue;
    }
    const int l = (ph - NPHASE_PRE) / NPHASE_L, s = (ph - NPHASE_PRE) % NPHASE_L;
#ifndef REPMASK
#define REPMASK 0
#endif
    for (int rep = 0; rep < (((REPMASK >> s) & 1) ? 2 : 1); ++rep) {
    if (rep) xcd_barrier(xb);
    switch (s) {
      case 0: {
        EpiArgs e{};
        e.ssq_in = p.ssq0(); e.obf = p.proj(); e.ldo = NPJ; e.of32 = p.logits();
        const bf16_t* Bt = p.wt_in() + (size_t)l * NIN * DM;
        for (int t = blockIdx.x; t < 68 * 60; t += gridDim.x)
          gemm_tile<8, 4, 2, 2, EPI_PROJ>(p.hb(), DM, Bt, DM, DM, (t / 60) * 256, (t % 60) * 128, (bf16_t*)smem, e);
        {
          const int G = gridDim.x, bi = blockIdx.x, rem = (68 * 60) % G, nIdle = rem ? G - rem : 0;
          const int first = nIdle * 5 < 272 ? nIdle * 5 : 272;
          if (bi >= rem && nIdle) for (int t = bi - rem; t < first; t += nIdle)
            gemm_tile<1, 1, 4, 1, EPI_LOGIT, 128>(p.hb(), DM, Bt + (size_t)NPJ * DM, DM, DM, t * 64, 0, (bf16_t*)smem, e);
          for (int t = first + bi; t < 272; t += G)
            gemm_tile<1, 1, 4, 1, EPI_LOGIT, 128>(p.hb(), DM, Bt + (size_t)NPJ * DM, DM, DM, t * 64, 0, (bf16_t*)smem, e);
        }
      } break;
      case 1: {
        for (int t = blockIdx.x; t < 2048 + 1024 + 512; t += gridDim.x) {
          if (t < 2048) gdn_prep_item(p, l, t, smem);
          else if (t < 3072) swa_prompt_item(p, l, t - 2048, smem);
          else swa_sample_item(p, l, t - 3072, smem);
        }
      } break;
      case 2: {
        if (gridDim.x == 512) {
          if (blockIdx.x < 256) gdn_scan_item(p, l, blockIdx.x, smem);
          else { gdn_sample_pair(p, l, (int)blockIdx.x - 256, smem); gdn_sample_pair(p, l, (int)blockIdx.x, smem); }
        } else {
          for (int t = blockIdx.x; t < 256 + 512; t += gridDim.x) {
            if (t < 256) gdn_scan_item(p, l, t, smem);
            else gdn_sample_pair(p, l, t - 256, smem);
          }
        }
      } break;
      case 3: phase_mix(p, l); break;
      case 4: {
        EpiArgs e{};
        e.h = p.out; e.hb = p.hb2(); e.ssq_out = p.ssq1();
        gemm_phase<EPI_RESID>(p.mix(), DM, p.wt_out() + (size_t)l * DM * DM, DM, DM, MTOK, DM, smem, e);
      } break;
      case 5: {
        EpiArgs e{};
        e.ssq_in = p.ssq1(); e.obf = p.proj(); e.ldo = DFF;
        gemm_phase<EPI_UP>(p.hb2(), DM, p.wt_up() + (size_t)l * DFF * DM, DM, DM, MTOK, DFF, smem, e);
      } break;
      case 6: {
        EpiArgs e{};
        e.h = p.out; e.hb = p.hb2(); e.ssq_out = p.ssq2();
        gemm_phase<EPI_RESID>(p.proj(), DFF, p.wt_down() + (size_t)l * DM * DFF, DFF, DFF, MTOK, DM, smem, e);
      } break;
      case 7: {
        EpiArgs e{};
        e.h = p.out; e.hb = p.hb(); e.ssq_in = p.ssq2(); e.ssq_out = p.ssq0(); e.pp = p.pp() + (size_t)l * MTOK * DM;
        gemm_phase<EPI_PLE>(p.hb2(), DM, p.wt_gate() + (size_t)l * DM * DM, DM, DM, MTOK, DM, smem, e);
      } break;
    }
    }
  }
}

extern "C" void kernel_launch(void* const* d_in, const int* in_sizes, int n_in, void* d_out, int out_size, void* d_ws, size_t ws_size,
                              hipStream_t stream) {
  Params p{};
  const float* const* in = (const float* const*)d_in;
  p.x_prompt = in[0]; p.x_sample = in[1]; p.cache_conv = in[2]; p.state_gdn = in[3]; p.cache_k = in[4]; p.cache_v = in[5];
  p.p_prompt = in[6]; p.p_sample = in[7]; p.norm_mix = in[8]; p.w_in = in[9]; p.conv_w = in[10]; p.a_log = in[11]; p.dt_bias = in[12];
  p.gdn_norm = in[13]; p.q_norm = in[14]; p.k_norm = in[15]; p.sinks = in[16]; p.w_out = in[17]; p.norm_ffn = in[18]; p.w_up = in[19];
  p.w_down = in[20]; p.norm_ple = in[21]; p.w_gate = in[22]; p.w_proj = in[23];
  p.out = (float*)d_out;
  p.ws = (unsigned char*)d_ws;
  if (WS_TOTAL > ws_size) { fprintf(stderr, "workspace too small: need %zu have %zu\n", (size_t)WS_TOTAL, ws_size); return; }

  static int grid_blocks = 0;
  if (!grid_blocks) {
    int dev = 0, cus = 0, per_cu = 0;
    hipGetDevice(&dev);
    hipDeviceGetAttribute(&cus, hipDeviceAttributeMultiprocessorCount, dev);
    hipOccupancyMaxActiveBlocksPerMultiprocessor(&per_cu, mega, NTHR, 0);
    if (per_cu > 2) per_cu = 2;
    if (per_cu < 1) per_cu = 1;
    grid_blocks = cus * per_cu;
  }
  (void)hipMemsetAsync(p.ws + WO_bar, 0, (size_t)XCD_BAR_WORDS * 4, stream);
  int lo = 0, hi = NPHASE_PRE + NL * NPHASE_L;
  void* args[] = {&p, &lo, &hi};
  hipError_t e = hipLaunchCooperativeKernel((void*)mega, dim3(grid_blocks), dim3(NTHR), args, 0, stream);
  if (e != hipSuccess) fprintf(stderr, "cooperative launch failed: %s (grid %d)\n", hipGetErrorString(e), grid_blocks);
}
```

```cpp
#include <hip/hip_runtime.h>
#include <hip/hip_cooperative_groups.h>
#include <cstdio>
namespace cg = cooperative_groups;

typedef unsigned short bf16_t;
typedef short bf16x8 __attribute__((ext_vector_type(8)));
typedef float f32x4 __attribute__((ext_vector_type(4)));
typedef float f32x2 __attribute__((ext_vector_type(2)));
typedef unsigned u32x4 __attribute__((ext_vector_type(4)));
typedef unsigned u32x2 __attribute__((ext_vector_type(2)));

#define DEVI __device__ __forceinline__
DEVI int opq(int x) { asm volatile("" : "+v"(x)); return x; }

#define VHALF ((int)__builtin_amdgcn_readfirstlane((int)(threadIdx.x >> 8)))
#define VB ((int)blockIdx.x * 2 + VHALF)
#define VG ((int)gridDim.x * 2)
constexpr int NL = 4;
constexpr int MTOK = 17408, MP = 16384, MS = 1024;
constexpr int DM = 1024, NIN = 7696, NPJ = 7680, DFF = 4096, PLE = 256;
constexpr int C_Z = 3072, C_SQ = 4096, C_SK = 5120, C_SV = 5376, C_G = 5632;
constexpr float EPS = 1e-6f;
constexpr int NTHR = 256;
constexpr int SMEM_BYTES = 79872;
constexpr size_t SCR_ITEM = 73728;

constexpr size_t O_YP = 0, O_YS = 16777216, O_CONVP = 17825792, O_GDNP = 18120704, O_KP = 22315008, O_VP = 23363584,
                 O_CONVS = 24412160, O_GDNS = 29130752, O_KS = 96239616, O_VS = 113016832, O_END = 129794048;

constexpr size_t al256(size_t x) { return (x + 255) & ~(size_t)255; }
constexpr size_t WO_wt_in = 0;
constexpr size_t WO_wt_out = WO_wt_in + al256((size_t)NL * NIN * DM * 2);
constexpr size_t WO_wt_up = WO_wt_out + al256((size_t)NL * DM * DM * 2);
constexpr size_t WO_wt_down = WO_wt_up + al256((size_t)NL * DFF * DM * 2);
constexpr size_t WO_wt_gate = WO_wt_down + al256((size_t)NL * DM * DFF * 2);
constexpr size_t WO_wt_proj = WO_wt_gate + al256((size_t)NL * DM * DM * 2);
constexpr size_t WO_hb = WO_wt_proj + al256((size_t)NL * DM * PLE * 2);
constexpr size_t WO_hb2 = WO_hb + al256((size_t)MTOK * DM * 2);
constexpr size_t WO_proj = WO_hb2 + al256((size_t)MTOK * DM * 2);
constexpr size_t WO_scr = WO_proj + al256((size_t)MTOK * NPJ * 2);
constexpr size_t WO_ogdn = WO_scr + al256((size_t)2048 * SCR_ITEM);
constexpr size_t WO_oswa = WO_ogdn + al256((size_t)MTOK * DM * 2);
constexpr size_t WO_mix = WO_oswa + al256((size_t)MTOK * DM * 2);
constexpr size_t WO_pb = WO_mix + al256((size_t)MTOK * DM * 2);
constexpr size_t WO_pp = WO_pb + al256((size_t)NL * MTOK * PLE * 2);
constexpr size_t WO_ssq0 = WO_pp + al256((size_t)NL * MTOK * DM * 2);
constexpr size_t WO_ssq1 = WO_ssq0 + al256((size_t)MTOK * 16 * 4);
constexpr size_t WO_ssq2 = WO_ssq1 + al256((size_t)MTOK * 16 * 4);
constexpr size_t WO_logits = WO_ssq2 + al256((size_t)MTOK * 16 * 4);
constexpr size_t WO_gsc = WO_logits + al256((size_t)MTOK * 16 * 4);
constexpr size_t WO_bar = WO_gsc + al256((size_t)2048 * 4);
constexpr size_t WS_TOTAL = WO_bar + al256((size_t)3456 * 4);
struct Params {
  const float *x_prompt, *x_sample, *cache_conv, *state_gdn, *cache_k, *cache_v, *p_prompt, *p_sample;
  const float *norm_mix, *w_in, *conv_w, *a_log, *dt_bias, *gdn_norm, *q_norm, *k_norm, *sinks, *w_out, *norm_ffn, *w_up, *w_down,
      *norm_ple, *w_gate, *w_proj;
  float* out;
  unsigned char* ws;
  DEVI bf16_t* wt_in() const { return (bf16_t*)(ws + WO_wt_in); }
  DEVI bf16_t* wt_out() const { return (bf16_t*)(ws + WO_wt_out); }
  DEVI bf16_t* wt_up() const { return (bf16_t*)(ws + WO_wt_up); }
  DEVI bf16_t* wt_down() const { return (bf16_t*)(ws + WO_wt_down); }
  DEVI bf16_t* wt_gate() const { return (bf16_t*)(ws + WO_wt_gate); }
  DEVI bf16_t* wt_proj() const { return (bf16_t*)(ws + WO_wt_proj); }
  DEVI bf16_t* hb() const { return (bf16_t*)(ws + WO_hb); }
  DEVI bf16_t* hb2() const { return (bf16_t*)(ws + WO_hb2); }
  DEVI bf16_t* proj() const { return (bf16_t*)(ws + WO_proj); }
  DEVI bf16_t* scr() const { return (bf16_t*)(ws + WO_scr); }
  DEVI bf16_t* ogdn() const { return (bf16_t*)(ws + WO_ogdn); }
  DEVI bf16_t* oswa() const { return (bf16_t*)(ws + WO_oswa); }
  DEVI bf16_t* mix() const { return (bf16_t*)(ws + WO_mix); }
  DEVI bf16_t* pb() const { return (bf16_t*)(ws + WO_pb); }
  DEVI bf16_t* pp() const { return (bf16_t*)(ws + WO_pp); }
  DEVI float* ssq0() const { return (float*)(ws + WO_ssq0); }
  DEVI float* ssq1() const { return (float*)(ws + WO_ssq1); }
  DEVI float* ssq2() const { return (float*)(ws + WO_ssq2); }
  DEVI float* logits() const { return (float*)(ws + WO_logits); }
  DEVI float* gsc() const { return (float*)(ws + WO_gsc); }
  DEVI unsigned* bar() const { return (unsigned*)(ws + WO_bar); }
};

DEVI float shx(float v, int m, int ln) { return __builtin_bit_cast(float, __builtin_amdgcn_ds_bpermute((ln ^ m) << 2, __builtin_bit_cast(int, v))); }
DEVI float shup(float v, int o, int ln) { return __builtin_bit_cast(float, __builtin_amdgcn_ds_bpermute((ln >= o ? ln - o : ln) << 2, __builtin_bit_cast(int, v))); }
DEVI float lo2f(unsigned u) { return __uint_as_float(u << 16); }
DEVI float hi2f(unsigned u) { return __uint_as_float(u & 0xffff0000u); }
DEVI float bf2f(bf16_t v) { return __uint_as_float(((unsigned)v) << 16); }
typedef __bf16 bf16x2_t __attribute__((ext_vector_type(2)));
DEVI unsigned pk2(float lo, float hi) { const f32x2 v = {lo, hi}; const bf16x2_t r = __builtin_convertvector(v, bf16x2_t); return __builtin_bit_cast(unsigned, r); }
DEVI bf16_t f2bf(float f) { return (bf16_t)(pk2(f, 0.f) & 0xffffu); }
DEVI float sigm(float x) { return 1.f / (1.f + __expf(-x)); }
DEVI float silu(float x) { return x * sigm(x); }
DEVI float softplus_f(float x) {
  const float e = __expf(x);
  return x > 20.f ? x : (e < 0.01f ? e * (1.f - 0.5f * e + 0.33333334f * e * e) : __logf(1.f + e));
}
DEVI f32x4 mfma16(bf16x8 a, bf16x8 b, f32x4 c) { return __builtin_amdgcn_mfma_f32_16x16x32_bf16(a, b, c, 0, 0, 0); }
DEVI bf16x8 as_bf(u32x4 v) { return __builtin_bit_cast(bf16x8, v); }
#define UNPACK8(v, f) do { f[0] = lo2f(v.x); f[1] = hi2f(v.x); f[2] = lo2f(v.y); f[3] = hi2f(v.y); f[4] = lo2f(v.z); f[5] = hi2f(v.z); f[6] = lo2f(v.w); f[7] = hi2f(v.w); } while (0)

DEVI int inmap(int n) { return n < 4096 ? n : (n < 7680 ? n + 16 : n - 7680 + 4096); }

__device__ void wconv_tile(const float* __restrict__ src, int ldsrc, int K, int Nd, bf16_t* __restrict__ dst, const float* __restrict__ scale,
                           bool remap, int kt, int nt, float* sm) {
  const int tid = (opq(threadIdx.x) & 255);
  const int nl = tid & 63, kq = tid >> 6;
  const int n = nt * 64 + nl;
  const bool ok = n < Nd;
  const int sc = remap ? inmap(n) : n;
#pragma unroll 4
  for (int r = 0; r < 16; ++r) {
    const int kl = r * 4 + kq, k = kt * 64 + kl;
    float v = 0.f;
    if (ok) { v = src[(size_t)k * ldsrc + sc]; if (scale) v *= scale[k]; }
    sm[kl * 65 + nl] = v;
  }
  __syncthreads();
  const int nr = tid >> 2, ks = (tid & 3) * 16;
  if (nt * 64 + nr < Nd) {
    unsigned w[8];
#pragma unroll
    for (int i = 0; i < 8; ++i) w[i] = pk2(sm[(ks + 2 * i) * 65 + nr], sm[(ks + 2 * i + 1) * 65 + nr]);
    u32x4* d = (u32x4*)(dst + (size_t)(nt * 64 + nr) * K + kt * 64 + ks);
    d[0] = (u32x4){w[0], w[1], w[2], w[3]};
    d[1] = (u32x4){w[4], w[5], w[6], w[7]};
  }
  __syncthreads();
}

__device__ void phase_p0(const Params& p, unsigned char* smem) {
  float* sm = (float*)smem;
  const int tid = (opq(threadIdx.x) & 255), lane = tid & 63, wid = tid >> 6;
  constexpr int T_IN = 16 * 121, T_OUT = 256, T_UP = 1024, T_DOWN = 1024, T_GATE = 256, T_PROJ = 64;
  constexpr int T_L = T_IN + T_OUT + T_UP + T_DOWN + T_GATE + T_PROJ;
  for (int it = VB; it < NL * T_L; it += VG) {
    const int l = it / T_L;
    int r = it % T_L;
    if (r < T_IN) { wconv_tile(p.w_in + (size_t)l * DM * NIN, NIN, DM, NIN, p.wt_in() + (size_t)l * NIN * DM, p.norm_mix + l * DM, true, r % 16, r / 16, sm); continue; }
    r -= T_IN;
    if (r < T_OUT) { wconv_tile(p.w_out + (size_t)l * DM * DM, DM, DM, DM, p.wt_out() + (size_t)l * DM * DM, nullptr, false, r % 16, r / 16, sm); continue; }
    r -= T_OUT;
    if (r < T_UP) { wconv_tile(p.w_up + (size_t)l * DM * DFF, DFF, DM, DFF, p.wt_up() + (size_t)l * DFF * DM, p.norm_ffn + l * DM, false, r % 16, r / 16, sm); continue; }
    r -= T_UP;
    if (r < T_DOWN) { wconv_tile(p.w_down + (size_t)l * DFF * DM, DM, DFF, DM, p.wt_down() + (size_t)l * DM * DFF, nullptr, false, r % 64, r / 64, sm); continue; }
    r -= T_DOWN;
    if (r < T_GATE) { wconv_tile(p.w_gate + (size_t)l * DM * DM, DM, DM, DM, p.wt_gate() + (size_t)l * DM * DM, p.norm_ple + l * DM, false, r % 16, r / 16, sm); continue; }
    r -= T_GATE;
    wconv_tile(p.w_proj + (size_t)l * PLE * DM, DM, PLE, DM, p.wt_proj() + (size_t)l * DM * PLE, nullptr, false, r % 4, r / 4, sm);
  }
  for (int it = VB; it < MTOK / 4; it += VG) {
    const int row = it * 4 + wid;
    const float* src = row < MP ? p.x_prompt + (size_t)row * DM : p.x_sample + (size_t)(row - MP) * DM;
    float* hd = p.out + (size_t)row * DM;
    bf16_t* hbd = p.hb() + (size_t)row * DM;
    float ss = 0.f;
#pragma unroll
    for (int i = 0; i < 4; ++i) {
      const int c = i * 256 + lane * 4;
      const f32x4 v = *(const f32x4*)(src + c);
      ss += v.x * v.x + v.y * v.y + v.z * v.z + v.w * v.w;
      *(f32x4*)(hd + c) = v;
      *(u32x2*)(hbd + c) = (u32x2){pk2(v.x, v.y), pk2(v.z, v.w)};
    }
#pragma unroll
    for (int o = 1; o < 64; o <<= 1) ss += shx(ss, o, lane);
    if (lane < 16) p.ssq0()[(size_t)row * 16 + lane] = lane == 0 ? ss : 0.f;
  }
  const int G = NL * MTOK * 32;
  for (int g = VB * NTHR + tid; g < G; g += VG * NTHR) {
    const int l = g / (MTOK * 32), rem = g % (MTOK * 32), row = rem >> 5, c8 = rem & 31;
    const float* src = row < MP ? p.p_prompt + ((size_t)(l * MP + row) * PLE + c8 * 8) : p.p_sample + ((size_t)(l * MS + row - MP) * PLE + c8 * 8);
    const f32x4 a = *(const f32x4*)src, b = *(const f32x4*)(src + 4);
    *(u32x4*)(p.pb() + (size_t)g * 8) = (u32x4){pk2(a.x, a.y), pk2(a.z, a.w), pk2(b.x, b.y), pk2(b.z, b.w)};
  }
}

enum { EPI_PROJ = 0, EPI_LOGIT = 1, EPI_RESID = 2, EPI_UP = 3, EPI_PLE = 4, EPI_PP = 5 };
struct EpiArgs {
  const float* ssq_in; float* ssq_out; float* h; bf16_t* hb; bf16_t* obf; int ldo; float* of32; const bf16_t* pp;
};

template <int EPI>
DEVI float epi_rs(const EpiArgs& e, int row) {
  if (EPI == EPI_PROJ || EPI == EPI_LOGIT || EPI == EPI_UP || EPI == EPI_PLE) {
    const f32x4* sp = (const f32x4*)(e.ssq_in + (size_t)row * 16);
    const f32x4 a = sp[0], b = sp[1], c = sp[2], d = sp[3];
    const float s = ((a.x + a.y) + (a.z + a.w)) + ((b.x + b.y) + (b.z + b.w)) + ((c.x + c.y) + (c.z + c.w)) + ((d.x + d.y) + (d.z + d.w));
    return rsqrtf(s * (1.f / 1024.f) + EPS);
  }
  return 1.f;
}
template <int EPI>
DEVI void epi_elem(const EpiArgs& e, int row, int col, f32x4 v, float rs, float& sq) {
  if (EPI == EPI_PROJ) {
    v *= rs;
    *(u32x2*)(e.obf + (size_t)row * e.ldo + col) = (u32x2){pk2(v.x, v.y), pk2(v.z, v.w)};
  } else if (EPI == EPI_LOGIT) {
    v *= rs;
    *(f32x4*)(e.of32 + (size_t)row * 16 + col) = v;
  } else if (EPI == EPI_PP) {
    *(u32x2*)(e.obf + (size_t)row * e.ldo + col) = (u32x2){pk2(v.x, v.y), pk2(v.z, v.w)};
  } else if (EPI == EPI_UP) {
    v *= rs;
    v.x = fmaxf(v.x, 0.f); v.y = fmaxf(v.y, 0.f); v.z = fmaxf(v.z, 0.f); v.w = fmaxf(v.w, 0.f);
    v = v * v;
    *(u32x2*)(e.obf + (size_t)row * e.ldo + col) = (u32x2){pk2(v.x, v.y), pk2(v.z, v.w)};
  } else {
    float* hp = e.h + (size_t)row * DM + col;
    f32x4 hv = *(const f32x4*)hp;
    if (EPI == EPI_RESID) {
      hv += v;
    } else {
      const u32x2 pv = *(const u32x2*)(e.pp + (size_t)row * DM + col);
      hv.x += sigm(v.x * rs) * lo2f(pv.x); hv.y += sigm(v.y * rs) * hi2f(pv.x);
      hv.z += sigm(v.z * rs) * lo2f(pv.y); hv.w += sigm(v.w * rs) * hi2f(pv.y);
    }
    *(f32x4*)hp = hv;
    *(u32x2*)(e.hb + (size_t)row * DM + col) = (u32x2){pk2(hv.x, hv.y), pk2(hv.z, hv.w)};
    sq += hv.x * hv.x + hv.y * hv.y + hv.z * hv.z + hv.w * hv.w;
  }
}

template <int WMT, int WNT, int WGM, int WGN, int EPI, int BK = 32>
__device__ __forceinline__ void gemm_tile(const bf16_t* __restrict__ A, int lda, const bf16_t* __restrict__ Bt, int ldb, int K, int m0, int n0,
                                          bf16_t* lds, const EpiArgs& e) {
  constexpr int BM = WGM * WMT * 16, BN = WGN * WNT * 16, LDR = BK + 8;
  constexpr int STAGE = (BM + BN) * LDR;
  constexpr int PPR = BK / 8, RPI = NTHR / PPR;
  constexpr int NA = BM / RPI, NB = (BN + RPI - 1) / RPI;
  const int tid = (opq(threadIdx.x) & 255), lane = tid & 63, wid = tid >> 6;
  const int wm = wid / WGN, wn = wid % WGN;
  const int fr = lane & 15, fq = lane >> 4;
  f32x4 acc[WMT][WNT];
#pragma unroll
  for (int i = 0; i < WMT; ++i)
#pragma unroll
    for (int j = 0; j < WNT; ++j) acc[i][j] = (f32x4){0.f, 0.f, 0.f, 0.f};
  u32x4 ra0[NA], rb0[NB], ra1[NA], rb1[NB];
  const int nk = K / BK;
  const int prow = tid / PPR, ppc = tid % PPR;
  const unsigned ta = (unsigned)(prow * lda + ppc * 8) * 2u, tb = (unsigned)(prow * ldb + ppc * 8) * 2u;
  const char* Au = (const char*)(A + (size_t)m0 * lda);
  const char* Bu = (const char*)(Bt + (size_t)n0 * ldb);
#define BGUARD(i) (BN >= RPI * ((i) + 1) || prow + (i) * RPI < BN)
#define GLOAD(kt, RA, RB) do { \
    _Pragma("unroll") for (int i = 0; i < NA; ++i) RA[i] = *(const u32x4*)(Au + ((size_t)i * RPI * lda + (size_t)(kt) * BK) * 2 + ta); \
    _Pragma("unroll") for (int i = 0; i < NB; ++i) if (BGUARD(i)) RB[i] = *(const u32x4*)(Bu + ((size_t)i * RPI * ldb + (size_t)(kt) * BK) * 2 + tb); \
  } while (0)
#define LSTORE(st, RA, RB) do { bf16_t* sA_ = lds + (st) * STAGE; bf16_t* sB_ = sA_ + BM * LDR; \
    _Pragma("unroll") for (int i = 0; i < NA; ++i) *(u32x4*)(sA_ + (prow + i * RPI) * LDR + ppc * 8) = RA[i]; \
    _Pragma("unroll") for (int i = 0; i < NB; ++i) if (BGUARD(i)) *(u32x4*)(sB_ + (prow + i * RPI) * LDR + ppc * 8) = RB[i]; \
  } while (0)
#define COMPUTE(st) do { const bf16_t* sA = lds + (st) * STAGE; const bf16_t* sB = sA + BM * LDR; \
    _Pragma("unroll") for (int kk = 0; kk < BK / 32; ++kk) { \
      bf16x8 bfr[WNT]; \
      _Pragma("unroll") for (int nt = 0; nt < WNT; ++nt) bfr[nt] = *(const bf16x8*)(sB + (wn * WNT * 16 + nt * 16 + fr) * LDR + kk * 32 + fq * 8); \
      _Pragma("unroll") for (int mt = 0; mt < WMT; ++mt) { \
        const bf16x8 af = *(const bf16x8*)(sA + (wm * WMT * 16 + mt * 16 + fr) * LDR + kk * 32 + fq * 8); \
        _Pragma("unroll") for (int nt = 0; nt < WNT; ++nt) acc[mt][nt] = mfma16(bfr[nt], af, acc[mt][nt]); } } \
  } while (0)
  GLOAD(0, ra0, rb0);
  GLOAD(1, ra1, rb1);
  LSTORE(0, ra0, rb0);
  __syncthreads();
  for (int kt = 0; kt < nk; kt += 2) {
    const int k2 = kt + 2 < nk ? kt + 2 : nk - 2;
    GLOAD(k2, ra0, rb0);
    COMPUTE(0);
    LSTORE(1, ra1, rb1);
    __syncthreads();
    GLOAD(k2 + 1, ra1, rb1);
    COMPUTE(1);
    LSTORE(0, ra0, rb0);
    __syncthreads();
  }
#undef BGUARD
#undef COMPUTE
#undef GLOAD
#undef LSTORE
#pragma unroll
  for (int mt = 0; mt < WMT; ++mt) {
    const int row = m0 + wm * WMT * 16 + mt * 16 + fr;
    const float rs = epi_rs<EPI>(e, row);
    float sq = 0.f;
#pragma unroll
    for (int nt = 0; nt < WNT; ++nt) epi_elem<EPI>(e, row, n0 + wn * WNT * 16 + nt * 16 + fq * 4, acc[mt][nt], rs, sq);
    if (EPI == EPI_RESID || EPI == EPI_PLE) {
      sq += shx(sq, 16, lane);
      sq += shx(sq, 32, lane);
      if (fq == 0) e.ssq_out[(size_t)row * 16 + (n0 / BN) * WGN + wn] = sq;
    }
  }
}

namespace pg8 {
#define PG8_LAS __attribute__((address_space(3)))
typedef unsigned short bf16_t;
typedef short bf16x8 __attribute__((ext_vector_type(8)));
typedef float f32x4 __attribute__((ext_vector_type(4)));
typedef unsigned u32x4 __attribute__((ext_vector_type(4)));
constexpr int BM = 256, BK = 64, HALF = 128, HTB = HALF * BK * 2  , STAGE_BYTES = 8 * HTB, NXCD = 8, WGM = 8;

__host__ __device__ __forceinline__ int lds_byte(int r, int c) { const int st = (r >> 4) * 2 + (c >> 5), rr = r & 15, cc = c & 31, ob = rr * 64 + cc * 2; return st * 1024 + (ob ^ (((ob >> 9) & 1) << 5)); }
__host__ __device__ __forceinline__ void stage_rc(int b, int& R, int& C) { const int st = b / 1024, sb = b % 1024, swz = sb ^ (((sb >> 9) & 1) << 5); R = (st >> 1) * 16 + swz / 64; C = (st & 1) * 32 + (swz % 64) / 2; }
__host__ __device__ __forceinline__ int perm32(int rho) { const int n = rho >> 4, i = rho & 15; return 8 * (i >> 2) + 4 * n + (i & 3); }

struct Unit { int pm, pn; };
struct Gemm { const bf16_t* A; const bf16_t* Bt; int M, N, K; };

template <class Epi, class Sched, bool STAMP = false>
__device__ __forceinline__ void gemm_phase(PG8_LAS unsigned char* lds, const Gemm g, const Sched& S, const Epi& E, unsigned long long* stamps) {
    const int tid = opq((int)threadIdx.x), wid = __builtin_amdgcn_readfirstlane(tid >> 6), lane = tid & 63, wr = wid >> 2, wc = wid & 3, fr = lane & 15, fq = lane >> 4;
    const int K = g.K, nt = K / BK;
    int ts_lo = 0, ts_hi = 0, nts = 0; const unsigned long long rt_entry = STAMP ? (unsigned long long)wall_clock64() : 0ull;
#define PG8_STAMP() do { if (STAMP && wid == 0 && nts < 64) { const unsigned long long _c = (unsigned long long)clock64(); \
        ts_lo = (lane == nts) ? (int)(unsigned)_c : ts_lo; ts_hi = (lane == nts) ? (int)(unsigned)(_c >> 32) : ts_hi; ++nts; } } while (0)
    PG8_STAMP();
    unsigned voffA[2], voffB[2];
#pragma unroll
    for (int i = 0; i < 2; ++i) { int R, C; stage_rc(tid * 16 + i * 8192, R, C); const int Rb = Epi::PERM ? ((R & ~31) + perm32(R & 31)) : R;
        voffA[i] = (unsigned)(R * K + C) * 2u; voffB[i] = (unsigned)(Rb * K + C) * 2u; }
    const size_t kstep = (size_t)(BK * 2);
    const size_t hstep = (size_t)HALF * K * 2;
    const size_t tstep = 2 * hstep;
    const unsigned ldsw = (unsigned)wid * 1024u;
    const int aoff = lds_byte(wr * 64 + fr, fq * 8), boff = lds_byte(wc * 32 + fr, fq * 8);
#define PG8_SA(b, h) (((b) * 2 + (h)) * HTB)
#define PG8_SB(b, h) ((4 + (b) * 2 + (h)) * HTB)
#define PG8_STAGE(bufoff, gbase, voff) do { _Pragma("unroll") for (int _i = 0; _i < 2; ++_i) \
        __builtin_amdgcn_global_load_lds((const unsigned*)((const char*)(gbase) + (voff)[_i]), (PG8_LAS unsigned*)(lds + (bufoff) + ldsw + _i * 8192), 16, 0, 0); } while (0)
#define PG8_LDA(dst, b, h) do { _Pragma("unroll") for (int m = 0; m < 4; ++m) _Pragma("unroll") for (int k = 0; k < 2; ++k) dst[m][k] = *(const PG8_LAS bf16x8*)(lds + PG8_SA(b, h) + aoff + m * 2048 + k * 1024); } while (0)
#define PG8_LDB(dst, b, h) do { _Pragma("unroll") for (int n = 0; n < 2; ++n) _Pragma("unroll") for (int k = 0; k < 2; ++k) dst[n][k] = *(const PG8_LAS bf16x8*)(lds + PG8_SB(b, h) + boff + n * 2048 + k * 1024); } while (0)
#define PG8_MMA(ai, bj, At, Bt) do { __builtin_amdgcn_s_setprio(1); _Pragma("unroll") for (int m = 0; m < 4; ++m) _Pragma("unroll") for (int n = 0; n < 2; ++n) _Pragma("unroll") for (int k = 0; k < 2; ++k) \
        acc[ai][bj][m][n] = __builtin_amdgcn_mfma_f32_16x16x32_bf16(Bt[n][k], At[m][k], acc[ai][bj][m][n], 0, 0, 0); __builtin_amdgcn_s_setprio(0); } while (0)
#define PG8_WAIT_V(n) asm volatile("s_waitcnt vmcnt(" #n ")" ::: "memory")
#define PG8_WAIT_L(n) asm volatile("s_waitcnt lgkmcnt(" #n ")" ::: "memory")
#define PG8_BAR __builtin_amdgcn_s_barrier()
#define PG8_SCHED __builtin_amdgcn_sched_barrier(0)
    Unit cur, nxt; int ui = 0;
    if (!S.next(0, cur)) return;
    f32x4 acc[2][2][4][2];
#pragma unroll
    for (int a = 0; a < 2; ++a)
#pragma unroll
        for (int b = 0; b < 2; ++b)
#pragma unroll
            for (int m = 0; m < 4; ++m)
#pragma unroll
                for (int n = 0; n < 2; ++n) acc[a][b][m][n] = (f32x4){0.f, 0.f, 0.f, 0.f};
    bf16x8 At[4][2], B0[2][2], B1[2][2];
    const char* cA = (const char*)g.A + (size_t)cur.pm * tstep; const char* cB = (const char*)g.Bt + (size_t)cur.pn * tstep;
    S.a_ready(cur);
    PG8_STAGE(PG8_SB(0, 0), cB, voffB); PG8_STAGE(PG8_SA(0, 0), cA, voffA); PG8_STAGE(PG8_SB(0, 1), cB + hstep, voffB); PG8_STAGE(PG8_SA(0, 1), cA + hstep, voffA);
    if (wr == 1) PG8_BAR;
    PG8_WAIT_V(4); PG8_BAR;
    PG8_STAGE(PG8_SB(1, 0), cB + kstep, voffB); PG8_STAGE(PG8_SA(1, 0), cA + kstep, voffA); PG8_STAGE(PG8_SB(1, 1), cB + hstep + kstep, voffB);
    PG8_WAIT_V(6); PG8_BAR;
    PG8_STAMP();
    for (;;) {
        const bool has_next = S.next(ui + 1, nxt);
        const char* nA = has_next ? (const char*)g.A + (size_t)nxt.pm * tstep : cA; const char* nB = has_next ? (const char*)g.Bt + (size_t)nxt.pn * tstep : cB;
        for (int t = 0; t < nt; t += 2) {
            const bool last = (t == nt - 2);
            const char* a1 = cA + (size_t)(t + 1) * kstep;
            const char* a2 = last ? nA : cA + (size_t)(t + 2) * kstep; const char* b2 = last ? nB : cB + (size_t)(t + 2) * kstep;
            const char* a3 = a2 + kstep; const char* b3 = b2 + kstep;
            if (last && has_next) S.a_ready(nxt);
            PG8_LDB(B0, 0, 0); PG8_SCHED; PG8_LDA(At, 0, 0); PG8_STAGE(PG8_SA(1, 1), a1 + hstep, voffA);
            PG8_WAIT_L(8); PG8_BAR; PG8_WAIT_L(0); PG8_MMA(0, 0, At, B0); PG8_BAR; PG8_SCHED;
            PG8_LDB(B1, 0, 1); PG8_STAGE(PG8_SB(0, 0), b2, voffB);
            PG8_BAR; PG8_WAIT_L(0); PG8_MMA(0, 1, At, B1); PG8_BAR;
            PG8_LDA(At, 0, 1); PG8_STAGE(PG8_SA(0, 0), a2, voffA);
            PG8_BAR; PG8_WAIT_L(0); PG8_MMA(1, 0, At, B0); PG8_BAR; PG8_SCHED;
            PG8_STAGE(PG8_SB(0, 1), b2 + hstep, voffB);
            PG8_WAIT_V(6); PG8_BAR; PG8_MMA(1, 1, At, B1); PG8_BAR;
            PG8_LDB(B0, 1, 0); PG8_SCHED; PG8_LDA(At, 1, 0); PG8_STAGE(PG8_SA(0, 1), a2 + hstep, voffA);
            PG8_WAIT_L(8); PG8_BAR; PG8_WAIT_L(0); PG8_MMA(0, 0, At, B0); PG8_BAR; PG8_SCHED;
            PG8_LDB(B1, 1, 1); PG8_STAGE(PG8_SB(1, 0), b3, voffB);
            PG8_BAR; PG8_WAIT_L(0); PG8_MMA(0, 1, At, B1); PG8_BAR;
            PG8_LDA(At, 1, 1); PG8_STAGE(PG8_SA(1, 0), a3, voffA);
            PG8_BAR; PG8_WAIT_L(0); PG8_MMA(1, 0, At, B0); PG8_BAR; PG8_SCHED;
            PG8_STAGE(PG8_SB(1, 1), b3 + hstep, voffB);
            PG8_WAIT_V(6); PG8_BAR; PG8_MMA(1, 1, At, B1); PG8_BAR;
        }
        PG8_STAMP();
        if constexpr (!Epi::AFTER_DRAIN) { E(acc, cur, wr, wc, fr, fq); S.done(cur); }
        PG8_STAMP();
        if (!has_next) break;
#pragma unroll
        for (int a = 0; a < 2; ++a)
#pragma unroll
            for (int b = 0; b < 2; ++b)
#pragma unroll
                for (int m = 0; m < 4; ++m)
#pragma unroll
                    for (int n = 0; n < 2; ++n) acc[a][b][m][n] = (f32x4){0.f, 0.f, 0.f, 0.f};
        cur = nxt; cA = nA; cB = nB; ++ui;
    }
    PG8_WAIT_V(0);
    if (wr == 0) PG8_BAR;
    PG8_BAR;
    if constexpr (Epi::AFTER_DRAIN) { E.fused(acc, cur, wr, wc, fr, fq, lds, wid, lane); S.done(cur); }
    PG8_STAMP();
    if (STAMP && wid == 0) { stamps[lane] = lane < nts ? (((unsigned long long)(unsigned)ts_hi << 32) | (unsigned)ts_lo) : 0ull;
        if (lane == 62) stamps[62] = rt_entry; if (lane == 63) stamps[63] = (unsigned long long)wall_clock64(); }
#undef PG8_STAMP
#undef PG8_SA
#undef PG8_SB
#undef PG8_STAGE
#undef PG8_LDA
#undef PG8_LDB
#undef PG8_MMA
#undef PG8_WAIT_V
#undef PG8_WAIT_L
#undef PG8_BAR
#undef PG8_SCHED
}
}

struct RowSched {
  int nN, nLimit, G, c;
  __device__ __forceinline__ bool next(int i, pg8::Unit& u) const { const int L = i * G + c; if (L >= nLimit) return false; u.pm = L / nN; u.pn = L - u.pm * nN; return true; }
  __device__ __forceinline__ void a_ready(const pg8::Unit&) const {}
  __device__ __forceinline__ void done(const pg8::Unit&) const {}
};
template <int EPI> struct BigEpi {
  static constexpr bool PERM = false, AFTER_DRAIN = false;
  EpiArgs e;
  __device__ __forceinline__ void operator()(const f32x4 (&acc)[2][2][4][2], const pg8::Unit& u, int wr, int wc, int fr, int fq) const {
    const int lane = fq * 16 + fr;
#pragma unroll
    for (int ai = 0; ai < 2; ++ai)
#pragma unroll
      for (int m = 0; m < 4; ++m) {
        const int row = u.pm * 256 + ai * 128 + wr * 64 + m * 16 + fr;
        const float rs = epi_rs<EPI>(e, row);
        float sq = 0.f;
#pragma unroll
        for (int bj = 0; bj < 2; ++bj)
#pragma unroll
          for (int n = 0; n < 2; ++n) epi_elem<EPI>(e, row, u.pn * 256 + bj * 128 + wc * 32 + n * 16 + fq * 4, acc[ai][bj][m][n], rs, sq);
        if (EPI == EPI_RESID || EPI == EPI_PLE) {
          sq += shx(sq, 16, lane);
          sq += shx(sq, 32, lane);
          if (fq == 0) e.ssq_out[(size_t)row * 16 + u.pn * 4 + wc] = sq;
        }
      }
  }
};

template <int EPI>
__device__ void gemm_big_phase(const bf16_t* A, const bf16_t* Bt, int K, int M, int N, unsigned char* lds_all, unsigned char* smem_half, const EpiArgs& e) {
  const int nM = M / 256, nN = N / 256, nU = nM * nN, G = gridDim.x;
  const int L = nU % G;
  const int nLimit = (L > 0 && L <= G / 4) ? nU - L : nU;
  RowSched S; S.nN = nN; S.nLimit = nLimit; S.G = G; S.c = blockIdx.x;
  pg8::Gemm g; g.A = A; g.Bt = Bt; g.M = M; g.N = N; g.K = K;
  BigEpi<EPI> E; E.e = e;
  pg8::gemm_phase<BigEpi<EPI>, RowSched>((PG8_LAS unsigned char*)lds_all, g, S, E, nullptr);
  __syncthreads();
  for (int st = VB; st < (nU - nLimit) * 16; st += VG) {
    const int u = nLimit + (st >> 4), sub = st & 15, pm = u / nN, pn = u - pm * nN;
    gemm_tile<1, 4, 4, 1, EPI, 128>(A, K, Bt, K, K, pm * 256 + (sub >> 2) * 64, pn * 256 + (sub & 3) * 64, (bf16_t*)smem_half, e);
  }
}


template <int I, int J4>
DEVI void solve_sub4(float& r, const float (&x)[64], const float* Am) {
  if constexpr (J4 * 4 < I) {
    const f32x4 a = *(const f32x4*)(Am + I * 64 + J4 * 4);
    if constexpr (J4 * 4 + 0 < I) r -= a.x * x[J4 * 4 + 0];
    if constexpr (J4 * 4 + 1 < I) r -= a.y * x[J4 * 4 + 1];
    if constexpr (J4 * 4 + 2 < I) r -= a.z * x[J4 * 4 + 2];
    if constexpr (J4 * 4 + 3 < I) r -= a.w * x[J4 * 4 + 3];
    solve_sub4<I, J4 + 1>(r, x, Am);
  }
}
template <int I>
DEVI void solve_rows(float (&x)[64], const float* Am, const bf16_t* src, const float* sc) {
  if constexpr (I < 64) {
    float r = bf2f(src[I * 136]) * sc[I];
    solve_sub4<I, 0>(r, x, Am);
    x[I] = r;
    asm volatile("" ::: "memory");
    solve_rows<I + 1>(x, Am, src, sc);
  }
}

__device__ void gdn_prep_item(const Params& p, int l, int item, unsigned char* smem) {
  const int tid = (opq(threadIdx.x) & 255), lane = tid & 63, wid = tid >> 6, fr = lane & 15, fq = lane >> 4;
  const int h = item & 7, n = (item >> 3) & 31, b = item >> 8;
  const int tok0 = b * 2048 + n * 64;
  bf16_t* qh = (bf16_t*)smem;
  bf16_t* kh = qh + 64 * 136;
  bf16_t* vh = kh + 64 * 136;
  float* Am = (float*)(vh + 64 * 136);
  float* sbeta = Am + 64 * 64;
  float* sgc = sbeta + 64;
  float* sbe = sgc + 64;
  unsigned char* scr = (unsigned char*)p.scr() + (size_t)item * SCR_ITEM;
  bf16_t* g_uT = (bf16_t*)scr;
  bf16_t* g_w = (bf16_t*)(scr + 16384);
  bf16_t* g_qg = (bf16_t*)(scr + 32768);
  bf16_t* g_kgT = (bf16_t*)(scr + 49152);
  bf16_t* g_qk = (bf16_t*)(scr + 65536);

  if (wid == 0) {
    const float* lg = p.logits() + (size_t)(tok0 + lane) * 16;
    const float bl = lg[h], al = lg[8 + h];
    const float x = al + p.dt_bias[l * 8 + h];
    const float sp = softplus_f(x);
    float g = -__expf(p.a_log[l * 8 + h]) * sp;
#pragma unroll
    for (int o = 1; o < 64; o <<= 1) { const float t = shup(g, o, lane); if (lane >= o) g += t; }
    sbeta[lane] = sigm(bl);
    sgc[lane] = g;
    sbe[lane] = sigm(bl) * __expf(g);
  }
  u32x4 rwall[3][7];
#pragma unroll
  for (int sect = 0; sect < 3; ++sect)
#pragma unroll
    for (int r = 0; r < 7; ++r) {
      const int tl = n * 64 + wid * 16 + fq * 4 - 3 + r;
      rwall[sect][r] = (u32x4){0u, 0u, 0u, 0u};
      if (tl >= 0) rwall[sect][r] = *(const u32x4*)(p.proj() + (size_t)(b * 2048 + tl) * NPJ + sect * 1024 + h * 128 + fr * 8);
    }
#pragma unroll
  for (int sect = 0; sect < 3; ++sect) {
    const int ch0 = sect * 1024 + h * 128 + fr * 8;
    float cw[4][8];
#pragma unroll
    for (int j = 0; j < 4; ++j) {
      const f32x4 a = *(const f32x4*)(p.conv_w + (size_t)(l * 4 + j) * 3072 + ch0), c = *(const f32x4*)(p.conv_w + (size_t)(l * 4 + j) * 3072 + ch0 + 4);
      cw[j][0] = a.x; cw[j][1] = a.y; cw[j][2] = a.z; cw[j][3] = a.w; cw[j][4] = c.x; cw[j][5] = c.y; cw[j][6] = c.z; cw[j][7] = c.w;
    }
    const int ib = wid * 16 + fq * 4;
#pragma unroll
    for (int it = 0; it < 4; ++it) {
      float o[8];
#pragma unroll
      for (int c = 0; c < 8; ++c) o[c] = 0.f;
#pragma unroll
      for (int j = 0; j < 4; ++j) {
        float f[8];
        UNPACK8(rwall[sect][it + j], f);
#pragma unroll
        for (int c = 0; c < 8; ++c) o[c] += f[c] * cw[j][c];
      }
      float ss = 0.f;
#pragma unroll
      for (int c = 0; c < 8; ++c) { o[c] = silu(o[c]); ss += o[c] * o[c]; }
      if (sect < 2) {
        ss += shx(ss, 1, lane); ss += shx(ss, 2, lane); ss += shx(ss, 4, lane); ss += shx(ss, 8, lane);
        float rn = rsqrtf(ss + EPS);
        if (sect == 0) rn *= 0.08838834764831845f;
#pragma unroll
        for (int c = 0; c < 8; ++c) o[c] *= rn;
      }
      const u32x4 pk = (u32x4){pk2(o[0], o[1]), pk2(o[2], o[3]), pk2(o[4], o[5]), pk2(o[6], o[7])};
      bf16_t* dst = sect == 0 ? qh + (ib + it) * 136 + fr * 8 : (sect == 1 ? kh + (ib + it) * 136 + fr * 8 : vh + (ib + it) * 136 + fr * 8);
      *(u32x4*)dst = pk;
    }
  }
  __syncthreads();
  {
    const int i = wid * 16 + fr;
    const float gi = sgc[i], bi = sbeta[i];
    bf16x8 kx[4], qx[4];
#pragma unroll
    for (int ks = 0; ks < 4; ++ks) {
      kx[ks] = *(const bf16x8*)(kh + i * 136 + ks * 32 + fq * 8);
      qx[ks] = *(const bf16x8*)(qh + i * 136 + ks * 32 + fq * 8);
    }
#pragma unroll
    for (int jt = 0; jt < 4; ++jt) {
      f32x4 akk = (f32x4){0.f, 0.f, 0.f, 0.f}, aqk = (f32x4){0.f, 0.f, 0.f, 0.f};
      if (jt <= wid) {
#pragma unroll
        for (int ks = 0; ks < 4; ++ks) {
          const bf16x8 kj = *(const bf16x8*)(kh + (jt * 16 + fr) * 136 + ks * 32 + fq * 8);
          akk = mfma16(kj, kx[ks], akk);
          aqk = mfma16(kj, qx[ks], aqk);
        }
      }
      const int j0 = jt * 16 + fq * 4;
      float av[4], qv[4];
#pragma unroll
      for (int jj = 0; jj < 4; ++jj) {
        const int j = j0 + jj;
        const float dec = j <= i ? __expf(gi - sgc[j]) : 0.f;
        av[jj] = j < i ? bi * akk[jj] * dec : 0.f;
        qv[jj] = aqk[jj] * dec;
      }
      *(f32x4*)(Am + i * 64 + j0) = (f32x4){av[0], av[1], av[2], av[3]};
      *(u32x2*)(g_qk + i * 64 + j0) = (u32x2){pk2(qv[0], qv[1]), pk2(qv[2], qv[3])};
    }
  }
  __syncthreads();
  {
    float x[64];
    const bool isu = tid < 128;
    const int cc = tid & 127;
    solve_rows<0>(x, Am, (isu ? vh : kh) + cc, isu ? sbeta : sbe);
    if (isu) {
      u32x4* d = (u32x4*)(g_uT + cc * 64);
#pragma unroll
      for (int q = 0; q < 8; ++q) d[q] = (u32x4){pk2(x[q * 8], x[q * 8 + 1]), pk2(x[q * 8 + 2], x[q * 8 + 3]), pk2(x[q * 8 + 4], x[q * 8 + 5]), pk2(x[q * 8 + 6], x[q * 8 + 7])};
    } else {
#pragma unroll
      for (int i = 0; i < 64; ++i) g_w[i * 128 + cc] = f2bf(x[i]);
    }
  }
  {
    const float gl = sgc[63];
#pragma unroll
    for (int q = 0; q < 4; ++q) {
      const int pc = tid + q * 256, i = pc >> 4, c8 = pc & 15;
      const u32x4 v = *(const u32x4*)(qh + i * 136 + c8 * 8);
      float f[8];
      UNPACK8(v, f);
      const float s = __expf(sgc[i]);
      *(u32x4*)(g_qg + i * 128 + c8 * 8) = (u32x4){pk2(f[0] * s, f[1] * s), pk2(f[2] * s, f[3] * s), pk2(f[4] * s, f[5] * s), pk2(f[6] * s, f[7] * s)};
    }
    if (tid >= 128) {
      const int dk = tid - 128;
      u32x4* d = (u32x4*)(g_kgT + dk * 64);
#pragma unroll
      for (int q = 0; q < 8; ++q) {
        float f[8];
#pragma unroll
        for (int c = 0; c < 8; ++c) { const int i = q * 8 + c; f[c] = bf2f(kh[i * 136 + dk]) * __expf(gl - sgc[i]); }
        d[q] = (u32x4){pk2(f[0], f[1]), pk2(f[2], f[3]), pk2(f[4], f[5]), pk2(f[6], f[7])};
      }
    }
    if (tid == 0) p.gsc()[item] = __expf(gl);
  }
  __syncthreads();
}

__device__ void gdn_scan_item(const Params& p, int l, int item, unsigned char* smem) {
  const int tid = (opq(threadIdx.x) & 255), lane = tid & 63, wid = tid >> 6, fr = lane & 15, fq = lane >> 4;
  const int dvs = item & 3, h = (item >> 2) & 7, b = item >> 5;
  bf16_t* ST = (bf16_t*)smem;
  bf16_t* VT = ST + 2 * 32 * 136;
  f32x4 S[2][2];
#pragma unroll
  for (int a = 0; a < 2; ++a)
#pragma unroll
    for (int c = 0; c < 2; ++c) S[a][c] = (f32x4){0.f, 0.f, 0.f, 0.f};
  __syncthreads();
  bf16x8 fw[4], fqg[4], fqk[2], fkg[2][2];
  u32x2 fu[2];
  float gs;
  bf16x8 nw[4], nqg[4], nqk[2], nkg[2][2];
  u32x2 nu[2];
  float ngs;
#define SCAN_LOAD(n_, W, QG, QK, KG, U, GS) do { \
    const int it_ = ((b * 32 + (n_)) << 3) + h; \
    const unsigned char* scr_ = (const unsigned char*)p.scr() + (size_t)it_ * SCR_ITEM; \
    const bf16_t* g_uT = (const bf16_t*)scr_; const bf16_t* g_w = (const bf16_t*)(scr_ + 16384); const bf16_t* g_qg = (const bf16_t*)(scr_ + 32768); \
    const bf16_t* g_kgT = (const bf16_t*)(scr_ + 49152); const bf16_t* g_qk = (const bf16_t*)(scr_ + 65536); \
    _Pragma("unroll") for (int ks = 0; ks < 4; ++ks) { \
      W[ks] = *(const bf16x8*)(g_w + (wid * 16 + fr) * 128 + ks * 32 + fq * 8); \
      QG[ks] = *(const bf16x8*)(g_qg + (wid * 16 + fr) * 128 + ks * 32 + fq * 8); } \
    _Pragma("unroll") for (int ks = 0; ks < 2; ++ks) { \
      QK[ks] = *(const bf16x8*)(g_qk + (wid * 16 + fr) * 64 + ks * 32 + fq * 8); \
      _Pragma("unroll") for (int mt = 0; mt < 2; ++mt) KG[mt][ks] = *(const bf16x8*)(g_kgT + ((2 * wid + mt) * 16 + fr) * 64 + ks * 32 + fq * 8); } \
    _Pragma("unroll") for (int nt = 0; nt < 2; ++nt) U[nt] = *(const u32x2*)(g_uT + (dvs * 32 + nt * 16 + fr) * 64 + wid * 16 + fq * 4); \
    GS = p.gsc()[it_]; } while (0)
  SCAN_LOAD(0, nw, nqg, nqk, nkg, nu, ngs);
  for (int n = 0; n < 32; ++n) {
#pragma unroll
    for (int ks = 0; ks < 4; ++ks) { fw[ks] = nw[ks]; fqg[ks] = nqg[ks]; }
#pragma unroll
    for (int ks = 0; ks < 2; ++ks) { fqk[ks] = nqk[ks]; fkg[0][ks] = nkg[0][ks]; fkg[1][ks] = nkg[1][ks]; }
    fu[0] = nu[0]; fu[1] = nu[1]; gs = ngs;
    if (n + 1 < 32) SCAN_LOAD(n + 1, nw, nqg, nqk, nkg, nu, ngs);
    bf16_t* STc = ST + (n & 1) * 32 * 136;
#pragma unroll
    for (int mt = 0; mt < 2; ++mt)
#pragma unroll
      for (int nt = 0; nt < 2; ++nt)
        *(u32x2*)(STc + (nt * 16 + fr) * 136 + (2 * wid + mt) * 16 + fq * 4) = (u32x2){pk2(S[mt][nt].x, S[mt][nt].y), pk2(S[mt][nt].z, S[mt][nt].w)};
    __syncthreads();
#pragma unroll
    for (int nt = 0; nt < 2; ++nt) {
      f32x4 a = (f32x4){0.f, 0.f, 0.f, 0.f};
#pragma unroll
      for (int ks = 0; ks < 4; ++ks) {
        const bf16x8 sb = *(const bf16x8*)(STc + (nt * 16 + fr) * 136 + ks * 32 + fq * 8);
        a = mfma16(fw[ks], sb, a);
      }
      const float v0 = lo2f(fu[nt].x) - a.x, v1 = hi2f(fu[nt].x) - a.y, v2 = lo2f(fu[nt].y) - a.z, v3 = hi2f(fu[nt].y) - a.w;
      *(u32x2*)(VT + (nt * 16 + fr) * 72 + wid * 16 + fq * 4) = (u32x2){pk2(v0, v1), pk2(v2, v3)};
    }
    __syncthreads();
#pragma unroll
    for (int mt = 0; mt < 2; ++mt) {
      f32x4 a = (f32x4){0.f, 0.f, 0.f, 0.f};
#pragma unroll
      for (int ks = 0; ks < 4; ++ks) {
        const bf16x8 sa = *(const bf16x8*)(STc + (mt * 16 + fr) * 136 + ks * 32 + fq * 8);
        a = mfma16(sa, fqg[ks], a);
      }
#pragma unroll
      for (int ks = 0; ks < 2; ++ks) {
        const bf16x8 va = *(const bf16x8*)(VT + (mt * 16 + fr) * 72 + ks * 32 + fq * 8);
        a = mfma16(va, fqk[ks], a);
      }
      const size_t row = (size_t)b * 2048 + n * 64 + wid * 16 + fr;
      *(u32x2*)(p.ogdn() + row * DM + h * 128 + dvs * 32 + mt * 16 + fq * 4) = (u32x2){pk2(a.x, a.y), pk2(a.z, a.w)};
    }
#pragma unroll
    for (int mt = 0; mt < 2; ++mt)
#pragma unroll
      for (int nt = 0; nt < 2; ++nt) {
        f32x4 a = S[mt][nt] * gs;
#pragma unroll
        for (int ks = 0; ks < 2; ++ks) {
          const bf16x8 vb = *(const bf16x8*)(VT + (nt * 16 + fr) * 72 + ks * 32 + fq * 8);
          a = mfma16(fkg[mt][ks], vb, a);
        }
        S[mt][nt] = a;
      }
  }
  float* so = p.out + O_GDNP + ((size_t)(l * 8 + b) * 8 + h) * 16384;
#pragma unroll
  for (int mt = 0; mt < 2; ++mt)
#pragma unroll
    for (int nt = 0; nt < 2; ++nt)
#pragma unroll
      for (int jj = 0; jj < 4; ++jj) so[((2 * wid + mt) * 16 + fq * 4 + jj) * 128 + dvs * 32 + nt * 16 + fr] = S[mt][nt][jj];
  __syncthreads();
#undef SCAN_LOAD
}

__device__ void gdn_sample_item(const Params& p, int l, int item, unsigned char* smem) {
  const int tid = (opq(threadIdx.x) & 255), lane = tid & 63, wid = tid >> 6;
  const int h = item & 7, b = item >> 3;
  float* qs = (float*)smem;
  float* ks = qs + 1024;
  float* vs = ks + 1024;
  float* part = vs + 1024;
  float* sbeta = part + 256;
  float* sa = sbeta + 8;
  const int dv = tid & 127, half = tid >> 7;
  float S[64];
  const float* s0 = p.state_gdn + ((size_t)(l * 128 + b) * 8 + h) * 16384 + (half * 8192 + dv);
#pragma unroll
  for (int k = 0; k < 64; ++k) S[k] = s0[k * 128];
#pragma unroll
  for (int ps = 0; ps < 2; ++ps) {
    const int c = tid + ps * 256;
    if (c < 384) {
      const int sect = c >> 7, ci = c & 127;
      const int ch = sect * 1024 + h * 128 + ci;
      float xw[11], cwv[4];
#pragma unroll
      for (int j = 0; j < 4; ++j) cwv[j] = p.conv_w[(size_t)(l * 4 + j) * 3072 + ch];
#pragma unroll
      for (int j = 0; j < 3; ++j) xw[j] = p.cache_conv[((size_t)(l * 128 + b) * 3 + j) * 3072 + ch];
#pragma unroll
      for (int t = 0; t < 8; ++t) xw[3 + t] = bf2f(p.proj()[(size_t)(MP + b * 8 + t) * NPJ + ch]);
      float* dst = sect == 0 ? qs : (sect == 1 ? ks : vs);
#pragma unroll
      for (int t = 0; t < 8; ++t) dst[t * 128 + ci] = silu(xw[t] * cwv[0] + xw[t + 1] * cwv[1] + xw[t + 2] * cwv[2] + xw[t + 3] * cwv[3]);
    }
  }
  if (tid < 8) {
    const float* lg = p.logits() + (size_t)(MP + b * 8 + tid) * 16;
    const float x = lg[8 + h] + p.dt_bias[l * 8 + h];
    const float sp = softplus_f(x);
    sa[tid] = __expf(-__expf(p.a_log[l * 8 + h]) * sp);
    sbeta[tid] = sigm(lg[h]);
  }
  __syncthreads();
#pragma unroll
  for (int u = 0; u < 4; ++u) {
    const int t = wid * 2 + (u >> 1);
    float* arr = (u & 1) ? ks : qs;
    const float a0 = arr[t * 128 + lane], a1 = arr[t * 128 + 64 + lane];
    float ss = a0 * a0 + a1 * a1;
#pragma unroll
    for (int o = 1; o < 64; o <<= 1) ss += shx(ss, o, lane);
    float rn = rsqrtf(ss + EPS);
    if (!(u & 1)) rn *= 0.08838834764831845f;
    arr[t * 128 + lane] = a0 * rn;
    arr[t * 128 + 64 + lane] = a1 * rn;
  }
  __syncthreads();
#pragma unroll 1
  for (int t = 0; t < 8; ++t) {
    const float a = sa[t], bt = sbeta[t];
    float kv = 0.f;
#pragma unroll
    for (int k4 = 0; k4 < 16; ++k4) {
      const f32x4 kk = *(const f32x4*)(ks + t * 128 + half * 64 + k4 * 4);
      S[k4 * 4 + 0] *= a; S[k4 * 4 + 1] *= a; S[k4 * 4 + 2] *= a; S[k4 * 4 + 3] *= a;
      kv += S[k4 * 4 + 0] * kk.x + S[k4 * 4 + 1] * kk.y + S[k4 * 4 + 2] * kk.z + S[k4 * 4 + 3] * kk.w;
      if ((k4 & 3) == 3) asm volatile("" ::: "memory");
    }
    part[half * 128 + dv] = kv;
    __syncthreads();
    const float delta = bt * (vs[t * 128 + dv] - (part[dv] + part[128 + dv]));
    __syncthreads();
    float o = 0.f;
#pragma unroll
    for (int k4 = 0; k4 < 16; ++k4) {
      const f32x4 kk = *(const f32x4*)(ks + t * 128 + half * 64 + k4 * 4);
      const f32x4 qq = *(const f32x4*)(qs + t * 128 + half * 64 + k4 * 4);
      S[k4 * 4 + 0] += kk.x * delta; S[k4 * 4 + 1] += kk.y * delta; S[k4 * 4 + 2] += kk.z * delta; S[k4 * 4 + 3] += kk.w * delta;
      o += S[k4 * 4 + 0] * qq.x + S[k4 * 4 + 1] * qq.y + S[k4 * 4 + 2] * qq.z + S[k4 * 4 + 3] * qq.w;
      if ((k4 & 3) == 3) asm volatile("" ::: "memory");
    }
    part[half * 128 + dv] = o;
    __syncthreads();
    if (half == 0) p.ogdn()[(size_t)(MP + b * 8 + t) * DM + h * 128 + dv] = f2bf(part[dv] + part[128 + dv]);
    __syncthreads();
  }
  float* so = p.out + O_GDNS + ((size_t)(l * 128 + b) * 8 + h) * 16384 + opq(half * 8192 + dv);
#pragma unroll
  for (int k = 0; k < 64; ++k) so[k * 128] = S[k];
  __syncthreads();
}

__device__ void gdn_sample_pair(const Params& p, int l, int pair, unsigned char* smem) {
  const int tid = (opq(threadIdx.x) & 255), lane = tid & 63, wid = tid >> 6;
  const int sub = tid >> 7, dv = tid & 127;
  const int item = pair * 2 + sub, h = item & 7, b = item >> 3;
  float* qs = (float*)smem + sub * 3104;
  float* ks = qs + 1024;
  float* vs = qs + 2048;
  float* sbeta = qs + 3072;
  float* sa = qs + 3080;
  f32x2 S2[64];
  const float* s0 = p.state_gdn + ((size_t)(l * 128 + b) * 8 + h) * 16384 + dv;
#pragma unroll
  for (int k = 0; k < 64; ++k) { S2[k].x = s0[(2 * k) * 128]; S2[k].y = s0[(2 * k + 1) * 128]; }
#pragma unroll
  for (int sect = 0; sect < 3; ++sect) {
    const int ch = sect * 1024 + h * 128 + dv;
    float xw[11], cwv[4];
#pragma unroll
    for (int j = 0; j < 4; ++j) cwv[j] = p.conv_w[(size_t)(l * 4 + j) * 3072 + ch];
#pragma unroll
    for (int j = 0; j < 3; ++j) xw[j] = p.cache_conv[((size_t)(l * 128 + b) * 3 + j) * 3072 + ch];
#pragma unroll
    for (int t = 0; t < 8; ++t) xw[3 + t] = bf2f(p.proj()[(size_t)(MP + b * 8 + t) * NPJ + ch]);
    float* dst = sect == 0 ? qs : (sect == 1 ? ks : vs);
#pragma unroll
    for (int t = 0; t < 8; ++t) dst[t * 128 + dv] = silu(xw[t] * cwv[0] + xw[t + 1] * cwv[1] + xw[t + 2] * cwv[2] + xw[t + 3] * cwv[3]);
  }
  if (dv < 8) {
    const float* lg = p.logits() + (size_t)(MP + b * 8 + dv) * 16;
    const float x = lg[8 + h] + p.dt_bias[l * 8 + h];
    sa[dv] = __expf(-__expf(p.a_log[l * 8 + h]) * softplus_f(x));
    sbeta[dv] = sigm(lg[h]);
  }
  __syncthreads();
#pragma unroll
  for (int u = 0; u < 8; ++u) {
    const int t = (wid & 1) * 4 + (u >> 1);
    float* arr = (u & 1) ? ks : qs;
    const float a0 = arr[t * 128 + lane], a1 = arr[t * 128 + 64 + lane];
    float ss = a0 * a0 + a1 * a1;
#pragma unroll
    for (int o = 1; o < 64; o <<= 1) ss += shx(ss, o, lane);
    float rn = rsqrtf(ss + EPS);
    if (!(u & 1)) rn *= 0.08838834764831845f;
    arr[t * 128 + lane] = a0 * rn;
    arr[t * 128 + 64 + lane] = a1 * rn;
  }
  __syncthreads();
#pragma unroll 1
  for (int t = 0; t < 8; ++t) {
    const float a = sa[t], bt = sbeta[t];
    f32x2 kv2 = (f32x2){0.f, 0.f};
#pragma unroll
    for (int k4 = 0; k4 < 32; ++k4) {
      const f32x4 kk = *(const f32x4*)(ks + t * 128 + k4 * 4);
      kv2 += S2[2 * k4] * (f32x2){kk.x, kk.y};
      kv2 += S2[2 * k4 + 1] * (f32x2){kk.z, kk.w};
      if ((k4 & 3) == 3) asm volatile("" ::: "memory");
    }
    const float delta = bt * (vs[t * 128 + dv] - a * (kv2.x + kv2.y));
    const f32x2 a2 = (f32x2){a, a}, d2 = (f32x2){delta, delta};
    f32x2 o2 = (f32x2){0.f, 0.f};
#pragma unroll
    for (int k4 = 0; k4 < 32; ++k4) {
      const f32x4 kk = *(const f32x4*)(ks + t * 128 + k4 * 4);
      const f32x4 qq = *(const f32x4*)(qs + t * 128 + k4 * 4);
      S2[2 * k4] = S2[2 * k4] * a2 + (f32x2){kk.x, kk.y} * d2;
      S2[2 * k4 + 1] = S2[2 * k4 + 1] * a2 + (f32x2){kk.z, kk.w} * d2;
      o2 += S2[2 * k4] * (f32x2){qq.x, qq.y};
      o2 += S2[2 * k4 + 1] * (f32x2){qq.z, qq.w};
      if ((k4 & 3) == 3) asm volatile("" ::: "memory");
    }
    p.ogdn()[(size_t)(MP + b * 8 + t) * DM + h * 128 + dv] = f2bf(o2.x + o2.y);
  }
  float* so = p.out + O_GDNS + ((size_t)(l * 128 + b) * 8 + h) * 16384 + opq(dv);
#pragma unroll
  for (int k = 0; k < 64; ++k) { so[(2 * k) * 128] = S2[k].x; so[(2 * k + 1) * 128] = S2[k].y; }
  __syncthreads();
}

__device__ void swa_prompt_item(const Params& p, int l, int item, unsigned char* smem) {
  const int tid = (opq(threadIdx.x) & 255), lane = tid & 63, wid = tid >> 6, fr = lane & 15, fq = lane >> 4;
  const int kvh = item & 3, hb2 = (item >> 2) & 31, b = item >> 7;
  bf16_t* Ks = (bf16_t*)smem;
  bf16_t* VT = Ks + 208 * 72;
  bf16_t* Pw = VT + 64 * 216 + wid * 16 * 168;
  const int tk0 = hb2 * 64 - 128;
  u32x4 krw[7], vrw[7];
#pragma unroll
  for (int i = 0; i < 7; ++i) {
    const int pc = tid + i * NTHR, kj = pc >> 3, c8 = pc & 7, tk = tk0 + kj;
    krw[i] = (u32x4){0u, 0u, 0u, 0u}; vrw[i] = (u32x4){0u, 0u, 0u, 0u};
    if (pc < 208 * 8 && kj < 192 && tk >= 0) {
      const bf16_t* base = p.proj() + (size_t)(b * 2048 + tk) * NPJ + kvh * 64 + c8 * 8;
      krw[i] = *(const u32x4*)(base + C_SK); vrw[i] = *(const u32x4*)(base + C_SV);
    }
  }
#pragma unroll
  for (int i = 0; i < 7; ++i) {
    const int pc = tid + i * NTHR;
    if (pc >= 208 * 8) break;
    const int kj = pc >> 3, c8 = pc & 7, tk = tk0 + kj;
    const bool ok = kj < 192 && tk >= 0;
    float kf[8], vf[8];
    UNPACK8(krw[i], kf);
    UNPACK8(vrw[i], vf);
    float ss = 0.f;
#pragma unroll
    for (int c = 0; c < 8; ++c) ss += kf[c] * kf[c];
    ss += shx(ss, 1, lane); ss += shx(ss, 2, lane); ss += shx(ss, 4, lane);
    const float rn = rsqrtf(ss * (1.f / 64.f) + EPS);
    const f32x4 w0 = *(const f32x4*)(p.k_norm + l * 64 + c8 * 8), w1 = *(const f32x4*)(p.k_norm + l * 64 + c8 * 8 + 4);
    kf[0] *= rn * w0.x; kf[1] *= rn * w0.y; kf[2] *= rn * w0.z; kf[3] *= rn * w0.w;
    kf[4] *= rn * w1.x; kf[5] *= rn * w1.y; kf[6] *= rn * w1.z; kf[7] *= rn * w1.w;
    *(u32x4*)(Ks + kj * 72 + c8 * 8) = (u32x4){pk2(kf[0], kf[1]), pk2(kf[2], kf[3]), pk2(kf[4], kf[5]), pk2(kf[6], kf[7])};
#pragma unroll
    for (int c = 0; c < 8; ++c) VT[(c8 * 8 + c) * 216 + kj] = f2bf(vf[c]);
    if (ok && tk >= 1920 && kj >= 128) {
      float* ko = p.out + O_KP + (((size_t)(l * 8 + b) * 128 + (tk - 1920)) * 4 + kvh) * 64 + c8 * 8;
      float* vo = p.out + O_VP + (((size_t)(l * 8 + b) * 128 + (tk - 1920)) * 4 + kvh) * 64 + c8 * 8;
      *(f32x4*)ko = (f32x4){kf[0], kf[1], kf[2], kf[3]};
      *(f32x4*)(ko + 4) = (f32x4){kf[4], kf[5], kf[6], kf[7]};
      *(f32x4*)vo = (f32x4){vf[0], vf[1], vf[2], vf[3]};
      *(f32x4*)(vo + 4) = (f32x4){vf[4], vf[5], vf[6], vf[7]};
    }
  }
  __syncthreads();
  const int kbase = wid * 16;
  const int ql = wid * 16 + fr;
  const size_t qrow = (size_t)b * 2048 + hb2 * 64 + ql;
  u32x4 qraw[4][2];
#pragma unroll
  for (int g = 0; g < 4; ++g) {
    const bf16_t* qp = p.proj() + qrow * NPJ + C_SQ + (kvh * 4 + g) * 64 + fq * 8;
    qraw[g][0] = *(const u32x4*)qp; qraw[g][1] = *(const u32x4*)(qp + 32);
  }
#pragma unroll
  for (int g = 0; g < 4; ++g) {
    const int head = kvh * 4 + g;
    const float slope = exp2f(-0.5f * (float)(head + 1));
    const float sink = p.sinks[l * 16 + head];
    bf16x8 qf[2];
    {
      const u32x4 r0 = qraw[g][0], r1 = qraw[g][1];
      float f0[8], f1[8];
      UNPACK8(r0, f0);
      UNPACK8(r1, f1);
      float ss = 0.f;
#pragma unroll
      for (int c = 0; c < 8; ++c) ss += f0[c] * f0[c] + f1[c] * f1[c];
      ss += shx(ss, 16, lane); ss += shx(ss, 32, lane);
      const float rn = rsqrtf(ss * (1.f / 64.f) + EPS) * 0.125f;
      const float* qn = p.q_norm + l * 64 + fq * 8;
#pragma unroll
      for (int c = 0; c < 8; ++c) { f0[c] *= rn * qn[c]; f1[c] *= rn * qn[32 + c]; }
      qf[0] = as_bf((u32x4){pk2(f0[0], f0[1]), pk2(f0[2], f0[3]), pk2(f0[4], f0[5]), pk2(f0[6], f0[7])});
      qf[1] = as_bf((u32x4){pk2(f1[0], f1[1]), pk2(f1[2], f1[3]), pk2(f1[4], f1[5]), pk2(f1[6], f1[7])});
    }
    f32x4 sc[9];
    float mx = sink;
#pragma unroll
    for (int kt = 0; kt < 9; ++kt) {
      f32x4 a = (f32x4){0.f, 0.f, 0.f, 0.f};
#pragma unroll
      for (int ks = 0; ks < 2; ++ks) {
        const bf16x8 kf = *(const bf16x8*)(Ks + (kbase + kt * 16 + fr) * 72 + ks * 32 + fq * 8);
        a = mfma16(kf, qf[ks], a);
      }
#pragma unroll
      for (int jj = 0; jj < 4; ++jj) {
        const int kj = kbase + kt * 16 + fq * 4 + jj;
        const int dist = ql + 128 - kj;
        const bool ok = dist >= 0 && dist <= 128 && (tk0 + kj) >= 0;
        const float s = ok ? a[jj] - slope * (float)dist : -INFINITY;
        a[jj] = s;
        mx = fmaxf(mx, s);
      }
      sc[kt] = a;
    }
    mx = fmaxf(mx, shx(mx, 16, lane));
    mx = fmaxf(mx, shx(mx, 32, lane));
    float sum = 0.f;
#pragma unroll
    for (int kt = 0; kt < 9; ++kt) {
      f32x4 e;
#pragma unroll
      for (int jj = 0; jj < 4; ++jj) { e[jj] = __expf(sc[kt][jj] - mx); sum += e[jj]; }
      *(u32x2*)(Pw + fr * 168 + kt * 16 + fq * 4) = (u32x2){pk2(e.x, e.y), pk2(e.z, e.w)};
    }
    *(u32x2*)(Pw + fr * 168 + 144 + fq * 4) = (u32x2){0u, 0u};
    sum += shx(sum, 16, lane);
    sum += shx(sum, 32, lane);
    const float inv = 1.f / (sum + __expf(sink - mx));
    __builtin_amdgcn_wave_barrier();
#pragma unroll
    for (int dt = 0; dt < 4; ++dt) {
      f32x4 a = (f32x4){0.f, 0.f, 0.f, 0.f};
#pragma unroll
      for (int ks = 0; ks < 5; ++ks) {
        const bf16x8 vf = *(const bf16x8*)(VT + (dt * 16 + fr) * 216 + kbase + ks * 32 + fq * 8);
        const bf16x8 pf = *(const bf16x8*)(Pw + fr * 168 + ks * 32 + fq * 8);
        a = mfma16(vf, pf, a);
      }
      a *= inv;
      *(u32x2*)(p.oswa() + qrow * DM + head * 64 + dt * 16 + fq * 4) = (u32x2){pk2(a.x, a.y), pk2(a.z, a.w)};
    }
    __builtin_amdgcn_wave_barrier();
  }
  __syncthreads();
}

__device__ void swa_sample_item(const Params& p, int l, int item, unsigned char* smem) {
  const int tid = (opq(threadIdx.x) & 255), lane = tid & 63, wid = tid >> 6;
  const int kvh = item & 3, b = item >> 2;
  float* Ks = (float*)smem;
  float* Vs = Ks + 136 * 65;
  float* Qs = Vs + 136 * 64;
  float* Sc = Qs + 512;
  const size_t cbase = (size_t)(l * 128 + b) * 128;
  f32x4 kvr[8], vvr[8];
#pragma unroll
  for (int i = 0; i < 8; ++i) {
    const int idx = tid + i * NTHR, j = idx >> 4, c4 = idx & 15;
    kvr[i] = *(const f32x4*)(p.cache_k + ((cbase + j) * 4 + kvh) * 64 + c4 * 4);
    vvr[i] = *(const f32x4*)(p.cache_v + ((cbase + j) * 4 + kvh) * 64 + c4 * 4);
  }
  unsigned qrw[4];
#pragma unroll
  for (int g = 0; g < 4; ++g) qrw[g] = *(const unsigned*)(p.proj() + (size_t)(MP + b * 8 + (tid >> 5)) * NPJ + C_SQ + (kvh * 4 + g) * 64 + (tid & 31) * 2);
#pragma unroll
  for (int i = 0; i < 8; ++i) {
    const int idx = tid + i * NTHR, j = idx >> 4, c4 = idx & 15;
    const f32x4 kv = kvr[i], vv = vvr[i];
    Ks[j * 65 + c4 * 4 + 0] = kv.x; Ks[j * 65 + c4 * 4 + 1] = kv.y; Ks[j * 65 + c4 * 4 + 2] = kv.z; Ks[j * 65 + c4 * 4 + 3] = kv.w;
    *(f32x4*)(Vs + j * 64 + c4 * 4) = vv;
  }
  {
    const int t = tid >> 5, d = (tid & 31) * 2;
    const bf16_t* base = p.proj() + (size_t)(MP + b * 8 + t) * NPJ + kvh * 64 + d;
    const unsigned kr = *(const unsigned*)(base + C_SK), vr = *(const unsigned*)(base + C_SV);
    float k0 = lo2f(kr), k1 = hi2f(kr);
    float ss = k0 * k0 + k1 * k1;
#pragma unroll
    for (int o = 1; o < 32; o <<= 1) ss += shx(ss, o, lane);
    const float rn = rsqrtf(ss * (1.f / 64.f) + EPS);
    Ks[(128 + t) * 65 + d] = k0 * rn * p.k_norm[l * 64 + d];
    Ks[(128 + t) * 65 + d + 1] = k1 * rn * p.k_norm[l * 64 + d + 1];
    Vs[(128 + t) * 64 + d] = lo2f(vr);
    Vs[(128 + t) * 64 + d + 1] = hi2f(vr);
  }
  __syncthreads();
  for (int idx = tid; idx < 128 * 64; idx += NTHR) {
    const int j = idx >> 6, d = idx & 63;
    p.out[O_KS + ((cbase + j) * 4 + kvh) * 64 + d] = Ks[(j + 8) * 65 + d];
    p.out[O_VS + ((cbase + j) * 4 + kvh) * 64 + d] = Vs[(j + 8) * 64 + d];
  }
#pragma unroll
  for (int g = 0; g < 4; ++g) {
    const int head = kvh * 4 + g;
    const float slope = exp2f(-0.5f * (float)(head + 1));
    const float sink = p.sinks[l * 16 + head];
    {
      const int t = tid >> 5, d = (tid & 31) * 2;
      const unsigned qr = qrw[g];
      const float q0 = lo2f(qr), q1 = hi2f(qr);
      float ss = q0 * q0 + q1 * q1;
#pragma unroll
      for (int o = 1; o < 32; o <<= 1) ss += shx(ss, o, lane);
      const float rn = rsqrtf(ss * (1.f / 64.f) + EPS) * 0.125f;
      Qs[t * 64 + d] = q0 * rn * p.q_norm[l * 64 + d];
      Qs[t * 64 + d + 1] = q1 * rn * p.q_norm[l * 64 + d + 1];
    }
    __syncthreads();
    for (int idx = tid; idx < 8 * 136; idx += NTHR) {
      const int tq = idx / 136, j = idx % 136;
      float s = 0.f;
#pragma unroll 16
      for (int d = 0; d < 64; ++d) s += Qs[tq * 64 + d] * Ks[j * 65 + d];
      const int dist = tq + 128 - j;
      Sc[tq * 136 + j] = (dist >= 0 && dist <= 128) ? s - slope * (float)dist : -INFINITY;
    }
    __syncthreads();
#pragma unroll
    for (int u = 0; u < 2; ++u) {
      const int tq = wid * 2 + u;
      const float s0 = Sc[tq * 136 + lane], s1 = Sc[tq * 136 + 64 + lane], s2 = lane < 8 ? Sc[tq * 136 + 128 + lane] : -INFINITY;
      float mx = fmaxf(fmaxf(s0, s1), fmaxf(s2, sink));
#pragma unroll
      for (int o = 1; o < 64; o <<= 1) mx = fmaxf(mx, shx(mx, o, lane));
      const float e0 = __expf(s0 - mx), e1 = __expf(s1 - mx), e2 = __expf(s2 - mx);
      float sum = e0 + e1 + e2;
#pragma unroll
      for (int o = 1; o < 64; o <<= 1) sum += shx(sum, o, lane);
      const float inv = 1.f / (sum + __expf(sink - mx));
      Sc[tq * 136 + lane] = e0 * inv;
      Sc[tq * 136 + 64 + lane] = e1 * inv;
      if (lane < 8) Sc[tq * 136 + 128 + lane] = e2 * inv;
    }
    __syncthreads();
    {
      const int tq = tid >> 5, d = (tid & 31) * 2;
      float o0 = 0.f, o1 = 0.f;
#pragma unroll 8
      for (int j = 0; j < 136; ++j) {
        const float pj = Sc[tq * 136 + j];
        const f32x2 v = *(const f32x2*)(Vs + j * 64 + d);
        o0 += pj * v.x;
        o1 += pj * v.y;
      }
      *(unsigned*)(p.oswa() + (size_t)(MP + b * 8 + tq) * DM + head * 64 + d) = pk2(o0, o1);
    }
    __syncthreads();
  }
}

__device__ void phase_mix(const Params& p, int l) {
  const int tid = (opq(threadIdx.x) & 255), lane = tid & 63, wid = tid >> 6, fr = lane & 15, fq = lane >> 4;
  for (int it = VB; it < MTOK / 4; it += VG) {
    const size_t row = (size_t)it * 4 + wid;
#pragma unroll
    for (int ps = 0; ps < 2; ++ps) {
      const int ch = (ps * 4 + fq) * 128 + fr * 8;
      const u32x4 og = *(const u32x4*)(p.ogdn() + row * DM + ch);
      const u32x4 ob = *(const u32x4*)(p.oswa() + row * DM + ch);
      const u32x4 zz = *(const u32x4*)(p.proj() + row * NPJ + C_Z + ch);
      const u32x4 ga = *(const u32x4*)(p.proj() + row * NPJ + C_G + ch);
      const u32x4 gb = *(const u32x4*)(p.proj() + row * NPJ + C_G + 1024 + ch);
      float fo[8], fb[8], fz[8], fa[8], fg[8];
      UNPACK8(og, fo); UNPACK8(ob, fb); UNPACK8(zz, fz); UNPACK8(ga, fa); UNPACK8(gb, fg);
      float ss = 0.f;
#pragma unroll
      for (int c = 0; c < 8; ++c) ss += fo[c] * fo[c];
      ss += shx(ss, 1, lane); ss += shx(ss, 2, lane); ss += shx(ss, 4, lane); ss += shx(ss, 8, lane);
      const float rn = rsqrtf(ss * (1.f / 128.f) + EPS);
      const f32x4 w0 = *(const f32x4*)(p.gdn_norm + l * 128 + fr * 8), w1 = *(const f32x4*)(p.gdn_norm + l * 128 + fr * 8 + 4);
      const float wn[8] = {w0.x, w0.y, w0.z, w0.w, w1.x, w1.y, w1.z, w1.w};
      float m[8];
#pragma unroll
      for (int c = 0; c < 8; ++c) m[c] = sigm(fa[c]) * (fo[c] * rn * wn[c] * silu(fz[c])) + sigm(fg[c]) * fb[c];
      *(u32x4*)(p.mix() + row * DM + ch) = (u32x4){pk2(m[0], m[1]), pk2(m[2], m[3]), pk2(m[4], m[5]), pk2(m[6], m[7])};
    }
  }
  const int NC = (8 + 128) * 3 * 3072;
  for (int i = VB * NTHR + tid; i < NC; i += VG * NTHR) {
    const int c = i % 3072, r = (i / 3072) % 3, bb = i / 9216;
    if (bb < 8) p.out[O_CONVP + ((size_t)(l * 8 + bb) * 3 + r) * 3072 + c] = bf2f(p.proj()[(size_t)(bb * 2048 + 2045 + r) * NPJ + c]);
    else p.out[O_CONVS + ((size_t)(l * 128 + bb - 8) * 3 + r) * 3072 + c] = bf2f(p.proj()[(size_t)(MP + (bb - 8) * 8 + 5 + r) * NPJ + c]);
  }
}

#define XB_TMO      128
#define XB_XCNT(j)  (256  + 64 * (j))
#define XB_XSUB(j)  (1280 + 64 * (j))
#define XB_XGEN(j)  (2304 + 64 * (j))
#define XB_TOP      3328
#define XB_TOPGEN   3392
#define XCD_BAR_WORDS 3456
#define XB_SPIN_CAP (1u << 18)
#define LAS __attribute__((address_space(3)))

__device__ __forceinline__ unsigned xb_ld(unsigned* p)              { return __hip_atomic_load(p, __ATOMIC_RELAXED, __HIP_MEMORY_SCOPE_AGENT); }
__device__ __forceinline__ unsigned xb_add(unsigned* p, unsigned v) { return __hip_atomic_fetch_add(p, v, __ATOMIC_RELAXED, __HIP_MEMORY_SCOPE_AGENT); }
__device__ __forceinline__ unsigned xb_xcc_id() { return (unsigned)__builtin_amdgcn_s_getreg((3 << 11) | 20) & 0xFu; }
#define XB_SPIN(cond, bar) do { unsigned _sp = 0; while (cond) { __builtin_amdgcn_s_sleep(1); \
    if ((++_sp & 255u) == 0u) { if (xb_ld(&(bar)[XB_TMO])) break; if (_sp > XB_SPIN_CAP) { atomicAdd(&(bar)[XB_TMO], 1u); break; } } } } while (0)

struct XcdBarrier {
    unsigned* bar; unsigned x;
    volatile LAS unsigned* st;
};

__device__ __forceinline__ XcdBarrier xcd_barrier_post(unsigned* bar, volatile LAS unsigned* st) {
    XcdBarrier b; b.bar = bar; b.x = xb_xcc_id(); b.st = st;
    if (threadIdx.x == 0) (void)xb_add(&bar[XB_XCNT(b.x)], 1u);
    return b;
}
__device__ __forceinline__ void xcd_barrier_complete(unsigned* bar, unsigned x, unsigned& nloc, unsigned& nx) {
    const unsigned G = gridDim.x * gridDim.y * gridDim.z;
    unsigned sum, cnt, mine, sp = 0u;
    for (;;) {
        sum = 0u; cnt = 0u; mine = 0u;
#pragma unroll
        for (unsigned j = 0; j < 16; ++j) { const unsigned c = xb_ld(&bar[XB_XCNT(j)]); sum += c; cnt += (c > 0u) ? 1u : 0u; mine = (j == x) ? c : mine; }
        if (sum == G) break;
        __builtin_amdgcn_s_sleep(1);
        if ((++sp & 255u) == 0u) { if (xb_ld(&bar[XB_TMO])) break; if (sp > XB_SPIN_CAP) { atomicAdd(&bar[XB_TMO], 1u); break; } }
    }
    nloc = mine > 0u ? mine : 1u; nx = cnt > 0u ? cnt : 1u;
}

__device__ __forceinline__ void xcd_barrier(const XcdBarrier& b) {
    asm volatile("s_waitcnt vmcnt(0)" ::: "memory");
    __syncthreads();
    if (threadIdx.x == 0) {
        unsigned* bar = b.bar;
        __builtin_amdgcn_s_waitcnt(0);
        unsigned nloc = b.st[0], nx = b.st[1];
        if (nloc == 0u) { xcd_barrier_complete(bar, b.x, nloc, nx); b.st[0] = nloc; b.st[1] = nx; }
        const unsigned old = xb_add(&bar[XB_XSUB(b.x)], 1u);
        const unsigned gen = old / nloc;
        if (old + 1u == (gen + 1u) * nloc) {
            __builtin_amdgcn_fence(__ATOMIC_RELEASE, "agent");
            asm volatile("s_waitcnt vmcnt(0)" ::: "memory");
            const unsigned og = xb_add(&bar[XB_TOP], 1u);
            const unsigned tg = og / nx;
            if (og + 1u == (tg + 1u) * nx) xb_add(&bar[XB_TOPGEN], 1u);
            else XB_SPIN(xb_ld(&bar[XB_TOPGEN]) == tg, bar);
            __builtin_amdgcn_fence(__ATOMIC_ACQUIRE, "agent");
            xb_add(&bar[XB_XGEN(b.x)], 1u);
            asm volatile("s_waitcnt vmcnt(0)" ::: "memory");
        } else {
            XB_SPIN(xb_ld(&bar[XB_XGEN(b.x)]) == gen, bar);
            __builtin_amdgcn_fence(__ATOMIC_ACQUIRE, "agent");
            asm volatile("s_waitcnt vmcnt(0)" ::: "memory");
        }
    }
    __syncthreads();
}


#define NPHASE_PRE 2
#define NPHASE_L 8
constexpr int LDS_TOTAL = 2 * SMEM_BYTES;
__global__ void __launch_bounds__(512, 2) mega(Params p, int ph_lo, int ph_hi) {
  extern __shared__ __attribute__((aligned(16))) unsigned char lds_all[];
  if (ph_hi < 0) cg::this_grid().sync();
  __shared__ uint4 xb_words;
  if (threadIdx.x == 0) xb_words = make_uint4(0u, 0u, 0u, 0u);
  __syncthreads();
  XcdBarrier xb = xcd_barrier_post(p.bar(), (volatile LAS unsigned*)&xb_words);
  unsigned char* smem = lds_all + VHALF * SMEM_BYTES;
  for (int ph = ph_lo; ph < ph_hi; ++ph) {
    if (ph > ph_lo) xcd_barrier(xb);
    if (ph == 0) { phase_p0(p, smem); continue; }
    if (ph == 1) {
      for (int t = VB; t < NL * 68 * 8; t += VG) {
        const int l = t / 544, r = t % 544;
        EpiArgs e{};
        e.obf = p.pp() + (size_t)l * MTOK * DM; e.ldo = DM;
        gemm_tile<8, 4, 2, 2, EPI_PP>(p.pb() + (size_t)l * MTOK * PLE, PLE, p.wt_proj() + (size_t)l * DM * PLE, PLE, PLE, (r / 8) * 256, (r % 8) * 128, (bf16_t*)smem, e);
      }
      continue;
    }
    const int l = (ph - NPHASE_PRE) / NPHASE_L, s = (ph - NPHASE_PRE) % NPHASE_L;
    switch (s) {
      case 0: {
        EpiArgs e{};
        e.ssq_in = p.ssq0(); e.obf = p.proj(); e.ldo = NPJ; e.of32 = p.logits();
        const bf16_t* Bt = p.wt_in() + (size_t)l * NIN * DM;
        gemm_big_phase<EPI_PROJ>(p.hb(), Bt, DM, MTOK, NPJ, lds_all, smem, e);
        for (int t = VB; t < 272; t += VG)
          gemm_tile<1, 1, 4, 1, EPI_LOGIT, 128>(p.hb(), DM, Bt + (size_t)NPJ * DM, DM, DM, t * 64, 0, (bf16_t*)smem, e);
      } break;
      case 1: {
        for (int t = VB; t < 2048 + 1024 + 512; t += VG) {
          if (t < 2048) gdn_prep_item(p, l, t, smem);
          else if (t < 3072) swa_prompt_item(p, l, t - 2048, smem);
          else swa_sample_item(p, l, t - 3072, smem);
        }
      } break;
      case 2: {
        if (VG == 512) {
          if (VB < 256) gdn_scan_item(p, l, VB, smem);
          else { gdn_sample_pair(p, l, VB - 256, smem); gdn_sample_pair(p, l, VB, smem); }
        } else {
          for (int t = VB; t < 256 + 512; t += VG) {
            if (t < 256) gdn_scan_item(p, l, t, smem);
            else gdn_sample_pair(p, l, t - 256, smem);
          }
        }
      } break;
      case 3: phase_mix(p, l); break;
      case 4: {
        EpiArgs e{};
        e.h = p.out; e.hb = p.hb2(); e.ssq_out = p.ssq1();
        gemm_big_phase<EPI_RESID>(p.mix(), p.wt_out() + (size_t)l * DM * DM, DM, MTOK, DM, lds_all, smem, e);
      } break;
      case 5: {
        EpiArgs e{};
        e.ssq_in = p.ssq1(); e.obf = p.proj(); e.ldo = DFF;
        gemm_big_phase<EPI_UP>(p.hb2(), p.wt_up() + (size_t)l * DFF * DM, DM, MTOK, DFF, lds_all, smem, e);
      } break;
      case 6: {
        EpiArgs e{};
        e.h = p.out; e.hb = p.hb2(); e.ssq_out = p.ssq2();
        gemm_big_phase<EPI_RESID>(p.proj(), p.wt_down() + (size_t)l * DM * DFF, DFF, MTOK, DM, lds_all, smem, e);
      } break;
      case 7: {
        EpiArgs e{};
        e.h = p.out; e.hb = p.hb(); e.ssq_in = p.ssq2(); e.ssq_out = p.ssq0(); e.pp = p.pp() + (size_t)l * MTOK * DM;
        gemm_big_phase<EPI_PLE>(p.hb2(), p.wt_gate() + (size_t)l * DM * DM, DM, MTOK, DM, lds_all, smem, e);
      } break;
    }
  }
}

extern "C" void kernel_launch(void* const* d_in, const int* in_sizes, int n_in, void* d_out, int out_size, void* d_ws, size_t ws_size,
                              hipStream_t stream) {
  Params p{};
  const float* const* in = (const float* const*)d_in;
  p.x_prompt = in[0]; p.x_sample = in[1]; p.cache_conv = in[2]; p.state_gdn = in[3]; p.cache_k = in[4]; p.cache_v = in[5];
  p.p_prompt = in[6]; p.p_sample = in[7]; p.norm_mix = in[8]; p.w_in = in[9]; p.conv_w = in[10]; p.a_log = in[11]; p.dt_bias = in[12];
  p.gdn_norm = in[13]; p.q_norm = in[14]; p.k_norm = in[15]; p.sinks = in[16]; p.w_out = in[17]; p.norm_ffn = in[18]; p.w_up = in[19];
  p.w_down = in[20]; p.norm_ple = in[21]; p.w_gate = in[22]; p.w_proj = in[23];
  p.out = (float*)d_out;
  p.ws = (unsigned char*)d_ws;
  if (WS_TOTAL > ws_size) { fprintf(stderr, "workspace too small: need %zu have %zu\n", (size_t)WS_TOTAL, ws_size); return; }

  static int grid_blocks = 0;
  if (!grid_blocks) {
    int dev = 0, cus = 0, per_cu = 0;
    (void)hipGetDevice(&dev);
    (void)hipDeviceGetAttribute(&cus, hipDeviceAttributeMultiprocessorCount, dev);
    if (hipFuncSetAttribute((const void*)mega, hipFuncAttributeMaxDynamicSharedMemorySize, LDS_TOTAL) != hipSuccess) { fprintf(stderr, "hipFuncSetAttribute(dynamic LDS %d) failed\n", LDS_TOTAL); grid_blocks = -1; return; }
    (void)hipOccupancyMaxActiveBlocksPerMultiprocessor(&per_cu, (const void*)mega, 512, LDS_TOTAL);
    (void)hipGetLastError();
    grid_blocks = cus;
  }
  if (grid_blocks < 0) return;
  (void)hipMemsetAsync(p.ws + WO_bar, 0, (size_t)XCD_BAR_WORDS * 4, stream);
  int lo = 0, hi = NPHASE_PRE + NL * NPHASE_L;
  void* args[] = {&p, &lo, &hi};
  hipError_t e = hipLaunchCooperativeKernel((void*)mega, dim3(grid_blocks), dim3(512), args, LDS_TOTAL, stream);
  if (e != hipSuccess) fprintf(stderr, "cooperative launch failed: %s (grid %d)\n", hipGetErrorString(e), grid_blocks);
}
```

```cpp
#include <hip/hip_runtime.h>
#include <hip/hip_cooperative_groups.h>
#include <cstdio>
namespace cg = cooperative_groups;

typedef unsigned short bf16_t;
typedef short bf16x8 __attribute__((ext_vector_type(8)));
typedef float f32x4 __attribute__((ext_vector_type(4)));
typedef float f32x2 __attribute__((ext_vector_type(2)));
typedef unsigned u32x4 __attribute__((ext_vector_type(4)));
typedef unsigned u32x2 __attribute__((ext_vector_type(2)));

#define DEVI __device__ __forceinline__
DEVI int opq(int x) { asm volatile("" : "+v"(x)); return x; }

#define VHALF ((int)__builtin_amdgcn_readfirstlane((int)(threadIdx.x >> 8)))
#define VB ((int)blockIdx.x * 2 + VHALF)
#define VG ((int)gridDim.x * 2)
constexpr int NL = 4;
constexpr int MTOK = 17408, MP = 16384, MS = 1024;
constexpr int DM = 1024, NIN = 7696, NPJ = 7680, DFF = 4096, PLE = 256;
constexpr int C_Z = 3072, C_SQ = 4096, C_SK = 5120, C_SV = 5376, C_G = 5632;
constexpr float EPS = 1e-6f;
constexpr int NTHR = 256;
constexpr int SMEM_BYTES = 79872;
constexpr size_t SCR_ITEM = 73728;

constexpr size_t O_YP = 0, O_YS = 16777216, O_CONVP = 17825792, O_GDNP = 18120704, O_KP = 22315008, O_VP = 23363584,
                 O_CONVS = 24412160, O_GDNS = 29130752, O_KS = 96239616, O_VS = 113016832, O_END = 129794048;

constexpr size_t al256(size_t x) { return (x + 255) & ~(size_t)255; }
constexpr size_t WO_wt_in = 0;
constexpr size_t WO_wt_out = WO_wt_in + al256((size_t)NL * NIN * DM * 2);
constexpr size_t WO_wt_up = WO_wt_out + al256((size_t)NL * DM * DM * 2);
constexpr size_t WO_wt_down = WO_wt_up + al256((size_t)NL * DFF * DM * 2);
constexpr size_t WO_wt_gate = WO_wt_down + al256((size_t)NL * DM * DFF * 2);
constexpr size_t WO_wt_proj = WO_wt_gate + al256((size_t)NL * DM * DM * 2);
constexpr size_t WO_hb = WO_wt_proj + al256((size_t)NL * DM * PLE * 2);
constexpr size_t WO_hb2 = WO_hb + al256((size_t)MTOK * DM * 2);
constexpr size_t WO_proj = WO_hb2 + al256((size_t)MTOK * DM * 2);
constexpr size_t WO_scr = WO_proj + al256((size_t)MTOK * NPJ * 2);
constexpr size_t WO_ogdn = WO_scr + al256((size_t)2048 * SCR_ITEM);
constexpr size_t WO_oswa = WO_ogdn + al256((size_t)MTOK * DM * 2);
constexpr size_t WO_mix = WO_oswa + al256((size_t)MTOK * DM * 2);
constexpr size_t WO_pb = WO_mix + al256((size_t)MTOK * DM * 2);
constexpr size_t WO_pp = WO_pb + al256((size_t)NL * MTOK * PLE * 2);
constexpr size_t WO_ssq0 = WO_pp + al256((size_t)NL * MTOK * DM * 2);
constexpr size_t WO_ssq1 = WO_ssq0 + al256((size_t)MTOK * 16 * 4);
constexpr size_t WO_ssq2 = WO_ssq1 + al256((size_t)MTOK * 16 * 4);
constexpr size_t WO_logits = WO_ssq2 + al256((size_t)MTOK * 16 * 4);
constexpr size_t WO_gsc = WO_logits + al256((size_t)MTOK * 16 * 4);
constexpr size_t WO_bar = WO_gsc + al256((size_t)2048 * 4);
constexpr size_t WS_TOTAL = WO_bar + al256((size_t)3456 * 4);
struct Params {
  const float *x_prompt, *x_sample, *cache_conv, *state_gdn, *cache_k, *cache_v, *p_prompt, *p_sample;
  const float *norm_mix, *w_in, *conv_w, *a_log, *dt_bias, *gdn_norm, *q_norm, *k_norm, *sinks, *w_out, *norm_ffn, *w_up, *w_down,
      *norm_ple, *w_gate, *w_proj;
  float* out;
  unsigned char* ws;
  DEVI bf16_t* wt_in() const { return (bf16_t*)(ws + WO_wt_in); }
  DEVI bf16_t* wt_out() const { return (bf16_t*)(ws + WO_wt_out); }
  DEVI bf16_t* wt_up() const { return (bf16_t*)(ws + WO_wt_up); }
  DEVI bf16_t* wt_down() const { return (bf16_t*)(ws + WO_wt_down); }
  DEVI bf16_t* wt_gate() const { return (bf16_t*)(ws + WO_wt_gate); }
  DEVI bf16_t* wt_proj() const { return (bf16_t*)(ws + WO_wt_proj); }
  DEVI bf16_t* hb() const { return (bf16_t*)(ws + WO_hb); }
  DEVI bf16_t* hb2() const { return (bf16_t*)(ws + WO_hb2); }
  DEVI bf16_t* proj() const { return (bf16_t*)(ws + WO_proj); }
  DEVI bf16_t* scr() const { return (bf16_t*)(ws + WO_scr); }
  DEVI bf16_t* ogdn() const { return (bf16_t*)(ws + WO_ogdn); }
  DEVI bf16_t* oswa() const { return (bf16_t*)(ws + WO_oswa); }
  DEVI bf16_t* mix() const { return (bf16_t*)(ws + WO_mix); }
  DEVI bf16_t* pb() const { return (bf16_t*)(ws + WO_pb); }
  DEVI bf16_t* pp() const { return (bf16_t*)(ws + WO_pp); }
  DEVI float* ssq0() const { return (float*)(ws + WO_ssq0); }
  DEVI float* ssq1() const { return (float*)(ws + WO_ssq1); }
  DEVI float* ssq2() const { return (float*)(ws + WO_ssq2); }
  DEVI float* logits() const { return (float*)(ws + WO_logits); }
  DEVI float* gsc() const { return (float*)(ws + WO_gsc); }
  DEVI unsigned* bar() const { return (unsigned*)(ws + WO_bar); }
};

DEVI float shx(float v, int m, int ln) { return __builtin_bit_cast(float, __builtin_amdgcn_ds_bpermute((ln ^ m) << 2, __builtin_bit_cast(int, v))); }
DEVI float shup(float v, int o, int ln) { return __builtin_bit_cast(float, __builtin_amdgcn_ds_bpermute((ln >= o ? ln - o : ln) << 2, __builtin_bit_cast(int, v))); }
DEVI float lo2f(unsigned u) { return __uint_as_float(u << 16); }
DEVI float hi2f(unsigned u) { return __uint_as_float(u & 0xffff0000u); }
DEVI float bf2f(bf16_t v) { return __uint_as_float(((unsigned)v) << 16); }
typedef __bf16 bf16x2_t __attribute__((ext_vector_type(2)));
DEVI unsigned pk2(float lo, float hi) { const f32x2 v = {lo, hi}; const bf16x2_t r = __builtin_convertvector(v, bf16x2_t); return __builtin_bit_cast(unsigned, r); }
DEVI bf16_t f2bf(float f) { return (bf16_t)(pk2(f, 0.f) & 0xffffu); }
DEVI float sigm(float x) { return 1.f / (1.f + __expf(-x)); }
DEVI float silu(float x) { return x * sigm(x); }
DEVI float softplus_f(float x) {
  const float e = __expf(x);
  return x > 20.f ? x : (e < 0.01f ? e * (1.f - 0.5f * e + 0.33333334f * e * e) : __logf(1.f + e));
}
DEVI f32x4 mfma16(bf16x8 a, bf16x8 b, f32x4 c) { return __builtin_amdgcn_mfma_f32_16x16x32_bf16(a, b, c, 0, 0, 0); }
DEVI bf16x8 as_bf(u32x4 v) { return __builtin_bit_cast(bf16x8, v); }
#define UNPACK8(v, f) do { f[0] = lo2f(v.x); f[1] = hi2f(v.x); f[2] = lo2f(v.y); f[3] = hi2f(v.y); f[4] = lo2f(v.z); f[5] = hi2f(v.z); f[6] = lo2f(v.w); f[7] = hi2f(v.w); } while (0)

DEVI int inmap(int n) { return n < 4096 ? n : (n < 7680 ? n + 16 : n - 7680 + 4096); }

__device__ void wconv_tile(const float* __restrict__ src, int ldsrc, int K, int Nd, bf16_t* __restrict__ dst, const float* __restrict__ scale,
                           bool remap, int kt, int nt, float* sm) {
  const int tid = (opq(threadIdx.x) & 255);
  const int nl = tid & 63, kq = tid >> 6;
  const int n = nt * 64 + nl;
  const bool ok = n < Nd;
  const int sc = remap ? inmap(n) : n;
#pragma unroll 4
  for (int r = 0; r < 16; ++r) {
    const int kl = r * 4 + kq, k = kt * 64 + kl;
    float v = 0.f;
    if (ok) { v = src[(size_t)k * ldsrc + sc]; if (scale) v *= scale[k]; }
    sm[kl * 65 + nl] = v;
  }
  __syncthreads();
  const int nr = tid >> 2, ks = (tid & 3) * 16;
  if (nt * 64 + nr < Nd) {
    unsigned w[8];
#pragma unroll
    for (int i = 0; i < 8; ++i) w[i] = pk2(sm[(ks + 2 * i) * 65 + nr], sm[(ks + 2 * i + 1) * 65 + nr]);
    u32x4* d = (u32x4*)(dst + (size_t)(nt * 64 + nr) * K + kt * 64 + ks);
    d[0] = (u32x4){w[0], w[1], w[2], w[3]};
    d[1] = (u32x4){w[4], w[5], w[6], w[7]};
  }
  __syncthreads();
}

__device__ void phase_p0(const Params& p, unsigned char* smem) {
  float* sm = (float*)smem;
  const int tid = (opq(threadIdx.x) & 255), lane = tid & 63, wid = tid >> 6;
  constexpr int T_IN = 16 * 121, T_OUT = 256, T_UP = 1024, T_DOWN = 1024, T_GATE = 256, T_PROJ = 64;
  constexpr int T_L = T_IN + T_OUT + T_UP + T_DOWN + T_GATE + T_PROJ;
  for (int it = VB; it < NL * T_L; it += VG) {
    const int l = it / T_L;
    int r = it % T_L;
    if (r < T_IN) { wconv_tile(p.w_in + (size_t)l * DM * NIN, NIN, DM, NIN, p.wt_in() + (size_t)l * NIN * DM, p.norm_mix + l * DM, true, r % 16, r / 16, sm); continue; }
    r -= T_IN;
    if (r < T_OUT) { wconv_tile(p.w_out + (size_t)l * DM * DM, DM, DM, DM, p.wt_out() + (size_t)l * DM * DM, nullptr, false, r % 16, r / 16, sm); continue; }
    r -= T_OUT;
    if (r < T_UP) { wconv_tile(p.w_up + (size_t)l * DM * DFF, DFF, DM, DFF, p.wt_up() + (size_t)l * DFF * DM, p.norm_ffn + l * DM, false, r % 16, r / 16, sm); continue; }
    r -= T_UP;
    if (r < T_DOWN) { wconv_tile(p.w_down + (size_t)l * DFF * DM, DM, DFF, DM, p.wt_down() + (size_t)l * DM * DFF, nullptr, false, r % 64, r / 64, sm); continue; }
    r -= T_DOWN;
    if (r < T_GATE) { wconv_tile(p.w_gate + (size_t)l * DM * DM, DM, DM, DM, p.wt_gate() + (size_t)l * DM * DM, p.norm_ple + l * DM, false, r % 16, r / 16, sm); continue; }
    r -= T_GATE;
    wconv_tile(p.w_proj + (size_t)l * PLE * DM, DM, PLE, DM, p.wt_proj() + (size_t)l * DM * PLE, nullptr, false, r % 4, r / 4, sm);
  }
  for (int it = VB; it < MTOK / 4; it += VG) {
    const int row = it * 4 + wid;
    const float* src = row < MP ? p.x_prompt + (size_t)row * DM : p.x_sample + (size_t)(row - MP) * DM;
    float* hd = p.out + (size_t)row * DM;
    bf16_t* hbd = p.hb() + (size_t)row * DM;
    float ss = 0.f;
#pragma unroll
    for (int i = 0; i < 4; ++i) {
      const int c = i * 256 + lane * 4;
      const f32x4 v = *(const f32x4*)(src + c);
      ss += v.x * v.x + v.y * v.y + v.z * v.z + v.w * v.w;
      *(f32x4*)(hd + c) = v;
      *(u32x2*)(hbd + c) = (u32x2){pk2(v.x, v.y), pk2(v.z, v.w)};
    }
#pragma unroll
    for (int o = 1; o < 64; o <<= 1) ss += shx(ss, o, lane);
    if (lane < 16) p.ssq0()[(size_t)row * 16 + lane] = lane == 0 ? ss : 0.f;
  }
  const int G = NL * MTOK * 32;
  for (int g = VB * NTHR + tid; g < G; g += VG * NTHR) {
    const int l = g / (MTOK * 32), rem = g % (MTOK * 32), row = rem >> 5, c8 = rem & 31;
    const float* src = row < MP ? p.p_prompt + ((size_t)(l * MP + row) * PLE + c8 * 8) : p.p_sample + ((size_t)(l * MS + row - MP) * PLE + c8 * 8);
    const f32x4 a = *(const f32x4*)src, b = *(const f32x4*)(src + 4);
    *(u32x4*)(p.pb() + (size_t)g * 8) = (u32x4){pk2(a.x, a.y), pk2(a.z, a.w), pk2(b.x, b.y), pk2(b.z, b.w)};
  }
}

enum { EPI_PROJ = 0, EPI_LOGIT = 1, EPI_RESID = 2, EPI_UP = 3, EPI_PLE = 4, EPI_PP = 5 };
struct EpiArgs {
  const float* ssq_in; float* ssq_out; float* h; bf16_t* hb; bf16_t* obf; int ldo; float* of32; const bf16_t* pp;
};

template <int EPI>
DEVI float epi_rs(const EpiArgs& e, int row) {
  if (EPI == EPI_PROJ || EPI == EPI_LOGIT || EPI == EPI_UP || EPI == EPI_PLE) {
    const f32x4* sp = (const f32x4*)(e.ssq_in + (size_t)row * 16);
    const f32x4 a = sp[0], b = sp[1], c = sp[2], d = sp[3];
    const float s = ((a.x + a.y) + (a.z + a.w)) + ((b.x + b.y) + (b.z + b.w)) + ((c.x + c.y) + (c.z + c.w)) + ((d.x + d.y) + (d.z + d.w));
    return rsqrtf(s * (1.f / 1024.f) + EPS);
  }
  return 1.f;
}
template <int EPI>
DEVI void epi_elem(const EpiArgs& e, int row, int col, f32x4 v, float rs, float& sq) {
  if (EPI == EPI_PROJ) {
    v *= rs;
    *(u32x2*)(e.obf + (size_t)row * e.ldo + col) = (u32x2){pk2(v.x, v.y), pk2(v.z, v.w)};
  } else if (EPI == EPI_LOGIT) {
    v *= rs;
    *(f32x4*)(e.of32 + (size_t)row * 16 + col) = v;
  } else if (EPI == EPI_PP) {
    *(u32x2*)(e.obf + (size_t)row * e.ldo + col) = (u32x2){pk2(v.x, v.y), pk2(v.z, v.w)};
  } else if (EPI == EPI_UP) {
    v *= rs;
    v.x = fmaxf(v.x, 0.f); v.y = fmaxf(v.y, 0.f); v.z = fmaxf(v.z, 0.f); v.w = fmaxf(v.w, 0.f);
    v = v * v;
    *(u32x2*)(e.obf + (size_t)row * e.ldo + col) = (u32x2){pk2(v.x, v.y), pk2(v.z, v.w)};
  } else {
    float* hp = e.h + (size_t)row * DM + col;
    f32x4 hv = *(const f32x4*)hp;
    if (EPI == EPI_RESID) {
      hv += v;
    } else {
      const u32x2 pv = *(const u32x2*)(e.pp + (size_t)row * DM + col);
      hv.x += sigm(v.x * rs) * lo2f(pv.x); hv.y += sigm(v.y * rs) * hi2f(pv.x);
      hv.z += sigm(v.z * rs) * lo2f(pv.y); hv.w += sigm(v.w * rs) * hi2f(pv.y);
    }
    *(f32x4*)hp = hv;
    *(u32x2*)(e.hb + (size_t)row * DM + col) = (u32x2){pk2(hv.x, hv.y), pk2(hv.z, hv.w)};
    sq += hv.x * hv.x + hv.y * hv.y + hv.z * hv.z + hv.w * hv.w;
  }
}

template <int WMT, int WNT, int WGM, int WGN, int EPI, int BK = 32>
__device__ __forceinline__ void gemm_tile(const bf16_t* __restrict__ A, int lda, const bf16_t* __restrict__ Bt, int ldb, int K, int m0, int n0,
                                          bf16_t* lds, const EpiArgs& e) {
  constexpr int BM = WGM * WMT * 16, BN = WGN * WNT * 16, LDR = BK + 8;
  constexpr int STAGE = (BM + BN) * LDR;
  constexpr int PPR = BK / 8, RPI = NTHR / PPR;
  constexpr int NA = BM / RPI, NB = (BN + RPI - 1) / RPI;
  const int tid = (opq(threadIdx.x) & 255), lane = tid & 63, wid = tid >> 6;
  const int wm = wid / WGN, wn = wid % WGN;
  const int fr = lane & 15, fq = lane >> 4;
  f32x4 acc[WMT][WNT];
#pragma unroll
  for (int i = 0; i < WMT; ++i)
#pragma unroll
    for (int j = 0; j < WNT; ++j) acc[i][j] = (f32x4){0.f, 0.f, 0.f, 0.f};
  u32x4 ra0[NA], rb0[NB], ra1[NA], rb1[NB];
  const int nk = K / BK;
  const int prow = tid / PPR, ppc = tid % PPR;
  const unsigned ta = (unsigned)(prow * lda + ppc * 8) * 2u, tb = (unsigned)(prow * ldb + ppc * 8) * 2u;
  const char* Au = (const char*)(A + (size_t)m0 * lda);
  const char* Bu = (const char*)(Bt + (size_t)n0 * ldb);
#define BGUARD(i) (BN >= RPI * ((i) + 1) || prow + (i) * RPI < BN)
#define GLOAD(kt, RA, RB) do { \
    _Pragma("unroll") for (int i = 0; i < NA; ++i) RA[i] = *(const u32x4*)(Au + ((size_t)i * RPI * lda + (size_t)(kt) * BK) * 2 + ta); \
    _Pragma("unroll") for (int i = 0; i < NB; ++i) if (BGUARD(i)) RB[i] = *(const u32x4*)(Bu + ((size_t)i * RPI * ldb + (size_t)(kt) * BK) * 2 + tb); \
  } while (0)
#define LSTORE(st, RA, RB) do { bf16_t* sA_ = lds + (st) * STAGE; bf16_t* sB_ = sA_ + BM * LDR; \
    _Pragma("unroll") for (int i = 0; i < NA; ++i) *(u32x4*)(sA_ + (prow + i * RPI) * LDR + ppc * 8) = RA[i]; \
    _Pragma("unroll") for (int i = 0; i < NB; ++i) if (BGUARD(i)) *(u32x4*)(sB_ + (prow + i * RPI) * LDR + ppc * 8) = RB[i]; \
  } while (0)
#define COMPUTE(st) do { const bf16_t* sA = lds + (st) * STAGE; const bf16_t* sB = sA + BM * LDR; \
    _Pragma("unroll") for (int kk = 0; kk < BK / 32; ++kk) { \
      bf16x8 bfr[WNT]; \
      _Pragma("unroll") for (int nt = 0; nt < WNT; ++nt) bfr[nt] = *(const bf16x8*)(sB + (wn * WNT * 16 + nt * 16 + fr) * LDR + kk * 32 + fq * 8); \
      _Pragma("unroll") for (int mt = 0; mt < WMT; ++mt) { \
        const bf16x8 af = *(const bf16x8*)(sA + (wm * WMT * 16 + mt * 16 + fr) * LDR + kk * 32 + fq * 8); \
        _Pragma("unroll") for (int nt = 0; nt < WNT; ++nt) acc[mt][nt] = mfma16(bfr[nt], af, acc[mt][nt]); } } \
  } while (0)
  GLOAD(0, ra0, rb0);
  GLOAD(1, ra1, rb1);
  LSTORE(0, ra0, rb0);
  __syncthreads();
  for (int kt = 0; kt < nk; kt += 2) {
    const int k2 = kt + 2 < nk ? kt + 2 : nk - 2;
    GLOAD(k2, ra0, rb0);
    COMPUTE(0);
    LSTORE(1, ra1, rb1);
    __syncthreads();
    GLOAD(k2 + 1, ra1, rb1);
    COMPUTE(1);
    LSTORE(0, ra0, rb0);
    __syncthreads();
  }
#undef BGUARD
#undef COMPUTE
#undef GLOAD
#undef LSTORE
#pragma unroll
  for (int mt = 0; mt < WMT; ++mt) {
    const int row = m0 + wm * WMT * 16 + mt * 16 + fr;
    const float rs = epi_rs<EPI>(e, row);
    float sq = 0.f;
#pragma unroll
    for (int nt = 0; nt < WNT; ++nt) epi_elem<EPI>(e, row, n0 + wn * WNT * 16 + nt * 16 + fq * 4, acc[mt][nt], rs, sq);
    if (EPI == EPI_RESID || EPI == EPI_PLE) {
      sq += shx(sq, 16, lane);
      sq += shx(sq, 32, lane);
      if (fq == 0) e.ssq_out[(size_t)row * 16 + (n0 / BN) * WGN + wn] = sq;
    }
  }
}

namespace pg8 {
#define PG8_LAS __attribute__((address_space(3)))
typedef unsigned short bf16_t;
typedef short bf16x8 __attribute__((ext_vector_type(8)));
typedef float f32x4 __attribute__((ext_vector_type(4)));
typedef unsigned u32x4 __attribute__((ext_vector_type(4)));
constexpr int BM = 256, BK = 64, HALF = 128, HTB = HALF * BK * 2  , STAGE_BYTES = 8 * HTB, NXCD = 8, WGM = 8;

__host__ __device__ __forceinline__ int lds_byte(int r, int c) { const int st = (r >> 4) * 2 + (c >> 5), rr = r & 15, cc = c & 31, ob = rr * 64 + cc * 2; return st * 1024 + (ob ^ (((ob >> 9) & 1) << 5)); }
__host__ __device__ __forceinline__ void stage_rc(int b, int& R, int& C) { const int st = b / 1024, sb = b % 1024, swz = sb ^ (((sb >> 9) & 1) << 5); R = (st >> 1) * 16 + swz / 64; C = (st & 1) * 32 + (swz % 64) / 2; }
__host__ __device__ __forceinline__ int perm32(int rho) { const int n = rho >> 4, i = rho & 15; return 8 * (i >> 2) + 4 * n + (i & 3); }

struct Unit { int pm, pn; };
struct Gemm { const bf16_t* A; const bf16_t* Bt; int M, N, K; };

template <class Epi, class Sched, bool STAMP = false>
__device__ __forceinline__ void gemm_phase(PG8_LAS unsigned char* lds, const Gemm g, const Sched& S, const Epi& E, unsigned long long* stamps) {
    const int tid = opq((int)threadIdx.x), wid = __builtin_amdgcn_readfirstlane(tid >> 6), lane = tid & 63, wr = wid >> 2, wc = wid & 3, fr = lane & 15, fq = lane >> 4;
    const int K = g.K, nt = K / BK;
    int ts_lo = 0, ts_hi = 0, nts = 0; const unsigned long long rt_entry = STAMP ? (unsigned long long)wall_clock64() : 0ull;
#define PG8_STAMP() do { if (STAMP && wid == 0 && nts < 64) { const unsigned long long _c = (unsigned long long)clock64(); \
        ts_lo = (lane == nts) ? (int)(unsigned)_c : ts_lo; ts_hi = (lane == nts) ? (int)(unsigned)(_c >> 32) : ts_hi; ++nts; } } while (0)
    PG8_STAMP();
    unsigned voffA[2], voffB[2];
#pragma unroll
    for (int i = 0; i < 2; ++i) { int R, C; stage_rc(tid * 16 + i * 8192, R, C); const int Rb = Epi::PERM ? ((R & ~31) + perm32(R & 31)) : R;
        voffA[i] = (unsigned)(R * K + C) * 2u; voffB[i] = (unsigned)(Rb * K + C) * 2u; }
    const size_t kstep = (size_t)(BK * 2);
    const size_t hstep = (size_t)HALF * K * 2;
    const size_t tstep = 2 * hstep;
    const unsigned ldsw = (unsigned)wid * 1024u;
    const int aoff = lds_byte(wr * 64 + fr, fq * 8), boff = lds_byte(wc * 32 + fr, fq * 8);
#define PG8_SA(b, h) (((b) * 2 + (h)) * HTB)
#define PG8_SB(b, h) ((4 + (b) * 2 + (h)) * HTB)
#define PG8_STAGE(bufoff, gbase, voff) do { _Pragma("unroll") for (int _i = 0; _i < 2; ++_i) \
        __builtin_amdgcn_global_load_lds((const unsigned*)((const char*)(gbase) + (voff)[_i]), (PG8_LAS unsigned*)(lds + (bufoff) + ldsw + _i * 8192), 16, 0, 0); } while (0)
#define PG8_LDA(dst, b, h) do { _Pragma("unroll") for (int m = 0; m < 4; ++m) _Pragma("unroll") for (int k = 0; k < 2; ++k) dst[m][k] = *(const PG8_LAS bf16x8*)(lds + PG8_SA(b, h) + aoff + m * 2048 + k * 1024); } while (0)
#define PG8_LDB(dst, b, h) do { _Pragma("unroll") for (int n = 0; n < 2; ++n) _Pragma("unroll") for (int k = 0; k < 2; ++k) dst[n][k] = *(const PG8_LAS bf16x8*)(lds + PG8_SB(b, h) + boff + n * 2048 + k * 1024); } while (0)
#define PG8_MMA(ai, bj, At, Bt) do { __builtin_amdgcn_s_setprio(1); _Pragma("unroll") for (int m = 0; m < 4; ++m) _Pragma("unroll") for (int n = 0; n < 2; ++n) _Pragma("unroll") for (int k = 0; k < 2; ++k) \
        acc[ai][bj][m][n] = __builtin_amdgcn_mfma_f32_16x16x32_bf16(Bt[n][k], At[m][k], acc[ai][bj][m][n], 0, 0, 0); __builtin_amdgcn_s_setprio(0); } while (0)
#define PG8_WAIT_V(n) asm volatile("s_waitcnt vmcnt(" #n ")" ::: "memory")
#define PG8_WAIT_L(n) asm volatile("s_waitcnt lgkmcnt(" #n ")" ::: "memory")
#define PG8_BAR __builtin_amdgcn_s_barrier()
#define PG8_SCHED __builtin_amdgcn_sched_barrier(0)
    Unit cur, nxt; int ui = 0;
    if (!S.next(0, cur)) return;
    f32x4 acc[2][2][4][2];
#pragma unroll
    for (int a = 0; a < 2; ++a)
#pragma unroll
        for (int b = 0; b < 2; ++b)
#pragma unroll
            for (int m = 0; m < 4; ++m)
#pragma unroll
                for (int n = 0; n < 2; ++n) acc[a][b][m][n] = (f32x4){0.f, 0.f, 0.f, 0.f};
    bf16x8 At[4][2], B0[2][2], B1[2][2];
    const char* cA = (const char*)g.A + (size_t)cur.pm * tstep; const char* cB = (const char*)g.Bt + (size_t)cur.pn * tstep;
    S.a_ready(cur);
    PG8_STAGE(PG8_SB(0, 0), cB, voffB); PG8_STAGE(PG8_SA(0, 0), cA, voffA); PG8_STAGE(PG8_SB(0, 1), cB + hstep, voffB); PG8_STAGE(PG8_SA(0, 1), cA + hstep, voffA);
    if (wr == 1) PG8_BAR;
    PG8_WAIT_V(4); PG8_BAR;
    PG8_STAGE(PG8_SB(1, 0), cB + kstep, voffB); PG8_STAGE(PG8_SA(1, 0), cA + kstep, voffA); PG8_STAGE(PG8_SB(1, 1), cB + hstep + kstep, voffB);
    PG8_WAIT_V(6); PG8_BAR;
    PG8_STAMP();
    for (;;) {
        const bool has_next = S.next(ui + 1, nxt);
        const char* nA = has_next ? (const char*)g.A + (size_t)nxt.pm * tstep : cA; const char* nB = has_next ? (const char*)g.Bt + (size_t)nxt.pn * tstep : cB;
        for (int t = 0; t < nt; t += 2) {
            const bool last = (t == nt - 2);
            const char* a1 = cA + (size_t)(t + 1) * kstep;
            const char* a2 = last ? nA : cA + (size_t)(t + 2) * kstep; const char* b2 = last ? nB : cB + (size_t)(t + 2) * kstep;
            const char* a3 = a2 + kstep; const char* b3 = b2 + kstep;
            if (last && has_next) S.a_ready(nxt);
            PG8_LDB(B0, 0, 0); PG8_SCHED; PG8_LDA(At, 0, 0); PG8_STAGE(PG8_SA(1, 1), a1 + hstep, voffA);
            PG8_WAIT_L(8); PG8_BAR; PG8_WAIT_L(0); PG8_MMA(0, 0, At, B0); PG8_BAR; PG8_SCHED;
            PG8_LDB(B1, 0, 1); PG8_STAGE(PG8_SB(0, 0), b2, voffB);
            PG8_BAR; PG8_WAIT_L(0); PG8_MMA(0, 1, At, B1); PG8_BAR;
            PG8_LDA(At, 0, 1); PG8_STAGE(PG8_SA(0, 0), a2, voffA);
            PG8_BAR; PG8_WAIT_L(0); PG8_MMA(1, 0, At, B0); PG8_BAR; PG8_SCHED;
            PG8_STAGE(PG8_SB(0, 1), b2 + hstep, voffB);
            PG8_WAIT_V(6); PG8_BAR; PG8_MMA(1, 1, At, B1); PG8_BAR;
            PG8_LDB(B0, 1, 0); PG8_SCHED; PG8_LDA(At, 1, 0); PG8_STAGE(PG8_SA(0, 1), a2 + hstep, voffA);
            PG8_WAIT_L(8); PG8_BAR; PG8_WAIT_L(0); PG8_MMA(0, 0, At, B0); PG8_BAR; PG8_SCHED;
            PG8_LDB(B1, 1, 1); PG8_STAGE(PG8_SB(1, 0), b3, voffB);
            PG8_BAR; PG8_WAIT_L(0); PG8_MMA(0, 1, At, B1); PG8_BAR;
            PG8_LDA(At, 1, 1); PG8_STAGE(PG8_SA(1, 0), a3, voffA);
            PG8_BAR; PG8_WAIT_L(0); PG8_MMA(1, 0, At, B0); PG8_BAR; PG8_SCHED;
            PG8_STAGE(PG8_SB(1, 1), b3 + hstep, voffB);
            PG8_WAIT_V(6); PG8_BAR; PG8_MMA(1, 1, At, B1); PG8_BAR;
        }
        PG8_STAMP();
        if constexpr (!Epi::AFTER_DRAIN) { E(acc, cur, wr, wc, fr, fq); S.done(cur); }
        PG8_STAMP();
        if (!has_next) break;
#pragma unroll
        for (int a = 0; a < 2; ++a)
#pragma unroll
            for (int b = 0; b < 2; ++b)
#pragma unroll
                for (int m = 0; m < 4; ++m)
#pragma unroll
                    for (int n = 0; n < 2; ++n) acc[a][b][m][n] = (f32x4){0.f, 0.f, 0.f, 0.f};
        cur = nxt; cA = nA; cB = nB; ++ui;
    }
    PG8_WAIT_V(0);
    if (wr == 0) PG8_BAR;
    PG8_BAR;
    if constexpr (Epi::AFTER_DRAIN) { E.fused(acc, cur, wr, wc, fr, fq, lds, wid, lane); S.done(cur); }
    PG8_STAMP();
    if (STAMP && wid == 0) { stamps[lane] = lane < nts ? (((unsigned long long)(unsigned)ts_hi << 32) | (unsigned)ts_lo) : 0ull;
        if (lane == 62) stamps[62] = rt_entry; if (lane == 63) stamps[63] = (unsigned long long)wall_clock64(); }
#undef PG8_STAMP
#undef PG8_SA
#undef PG8_SB
#undef PG8_STAGE
#undef PG8_LDA
#undef PG8_LDB
#undef PG8_MMA
#undef PG8_WAIT_V
#undef PG8_WAIT_L
#undef PG8_BAR
#undef PG8_SCHED
}
}

struct RowSched {
  int nN, nLimit, G, c;
  __device__ __forceinline__ bool next(int i, pg8::Unit& u) const { const int L = i * G + c; if (L >= nLimit) return false; u.pm = L / nN; u.pn = L - u.pm * nN; return true; }
  __device__ __forceinline__ void a_ready(const pg8::Unit&) const {}
  __device__ __forceinline__ void done(const pg8::Unit&) const {}
};
template <int EPI> struct BigEpi {
  static constexpr bool PERM = false, AFTER_DRAIN = false;
  EpiArgs e;
  __device__ __forceinline__ void operator()(const f32x4 (&acc)[2][2][4][2], const pg8::Unit& u, int wr, int wc, int fr, int fq) const {
    const int lane = fq * 16 + fr;
#pragma unroll
    for (int ai = 0; ai < 2; ++ai)
#pragma unroll
      for (int m = 0; m < 4; ++m) {
        const int row = u.pm * 256 + ai * 128 + wr * 64 + m * 16 + fr;
        const float rs = epi_rs<EPI>(e, row);
        float sq = 0.f;
#pragma unroll
        for (int bj = 0; bj < 2; ++bj)
#pragma unroll
          for (int n = 0; n < 2; ++n) epi_elem<EPI>(e, row, u.pn * 256 + bj * 128 + wc * 32 + n * 16 + fq * 4, acc[ai][bj][m][n], rs, sq);
        if (EPI == EPI_RESID || EPI == EPI_PLE) {
          sq += shx(sq, 16, lane);
          sq += shx(sq, 32, lane);
          if (fq == 0) e.ssq_out[(size_t)row * 16 + u.pn * 4 + wc] = sq;
        }
      }
  }
};

template <int EPI>
__device__ void gemm_big_phase(const bf16_t* A, const bf16_t* Bt, int K, int M, int N, unsigned char* lds_all, unsigned char* smem_half, const EpiArgs& e) {
  const int nM = M / 256, nN = N / 256, nU = nM * nN, G = gridDim.x;
  const int L = nU % G;
  const int nLimit = (L > 0 && L <= G / 4) ? nU - L : nU;
  RowSched S; S.nN = nN; S.nLimit = nLimit; S.G = G; S.c = blockIdx.x;
  pg8::Gemm g; g.A = A; g.Bt = Bt; g.M = M; g.N = N; g.K = K;
  BigEpi<EPI> E; E.e = e;
  pg8::gemm_phase<BigEpi<EPI>, RowSched>((PG8_LAS unsigned char*)lds_all, g, S, E, nullptr);
  __syncthreads();
  for (int st = VB; st < (nU - nLimit) * 16; st += VG) {
    const int u = nLimit + (st >> 4), sub = st & 15, pm = u / nN, pn = u - pm * nN;
    gemm_tile<1, 4, 4, 1, EPI, 128>(A, K, Bt, K, K, pm * 256 + (sub >> 2) * 64, pn * 256 + (sub & 3) * 64, (bf16_t*)smem_half, e);
  }
}


template <int I, int J4>
DEVI void solve_sub4(float& r, const float (&x)[64], const float* Am) {
  if constexpr (J4 * 4 < I) {
    const f32x4 a = *(const f32x4*)(Am + I * 64 + J4 * 4);
    if constexpr (J4 * 4 + 0 < I) r -= a.x * x[J4 * 4 + 0];
    if constexpr (J4 * 4 + 1 < I) r -= a.y * x[J4 * 4 + 1];
    if constexpr (J4 * 4 + 2 < I) r -= a.z * x[J4 * 4 + 2];
    if constexpr (J4 * 4 + 3 < I) r -= a.w * x[J4 * 4 + 3];
    solve_sub4<I, J4 + 1>(r, x, Am);
  }
}
template <int I>
DEVI void solve_rows(float (&x)[64], const float* Am, const bf16_t* src, const float* sc) {
  if constexpr (I < 64) {
    float r = bf2f(src[I * 136]) * sc[I];
    solve_sub4<I, 0>(r, x, Am);
    x[I] = r;
    asm volatile("" ::: "memory");
    solve_rows<I + 1>(x, Am, src, sc);
  }
}

__device__ void gdn_prep_item(const Params& p, int l, int item, unsigned char* smem) {
  const int tid = (opq(threadIdx.x) & 255), lane = tid & 63, wid = tid >> 6, fr = lane & 15, fq = lane >> 4;
  const int h = item & 7, n = (item >> 3) & 31, b = item >> 8;
  const int tok0 = b * 2048 + n * 64;
  bf16_t* qh = (bf16_t*)smem;
  bf16_t* kh = qh + 64 * 136;
  bf16_t* vh = kh + 64 * 136;
  float* Am = (float*)(vh + 64 * 136);
  float* sbeta = Am + 64 * 64;
  float* sgc = sbeta + 64;
  float* sbe = sgc + 64;
  unsigned char* scr = (unsigned char*)p.scr() + (size_t)item * SCR_ITEM;
  bf16_t* g_uT = (bf16_t*)scr;
  bf16_t* g_w = (bf16_t*)(scr + 16384);
  bf16_t* g_qg = (bf16_t*)(scr + 32768);
  bf16_t* g_kgT = (bf16_t*)(scr + 49152);
  bf16_t* g_qk = (bf16_t*)(scr + 65536);

  if (wid == 0) {
    const float* lg = p.logits() + (size_t)(tok0 + lane) * 16;
    const float bl = lg[h], al = lg[8 + h];
    const float x = al + p.dt_bias[l * 8 + h];
    const float sp = softplus_f(x);
    float g = -__expf(p.a_log[l * 8 + h]) * sp;
#pragma unroll
    for (int o = 1; o < 64; o <<= 1) { const float t = shup(g, o, lane); if (lane >= o) g += t; }
    sbeta[lane] = sigm(bl);
    sgc[lane] = g;
    sbe[lane] = sigm(bl) * __expf(g);
  }
  u32x4 rwall[3][7];
#pragma unroll
  for (int sect = 0; sect < 3; ++sect)
#pragma unroll
    for (int r = 0; r < 7; ++r) {
      const int tl = n * 64 + wid * 16 + fq * 4 - 3 + r;
      rwall[sect][r] = (u32x4){0u, 0u, 0u, 0u};
      if (tl >= 0) rwall[sect][r] = *(const u32x4*)(p.proj() + (size_t)(b * 2048 + tl) * NPJ + sect * 1024 + h * 128 + fr * 8);
    }
#pragma unroll
  for (int sect = 0; sect < 3; ++sect) {
    const int ch0 = sect * 1024 + h * 128 + fr * 8;
    float cw[4][8];
#pragma unroll
    for (int j = 0; j < 4; ++j) {
      const f32x4 a = *(const f32x4*)(p.conv_w + (size_t)(l * 4 + j) * 3072 + ch0), c = *(const f32x4*)(p.conv_w + (size_t)(l * 4 + j) * 3072 + ch0 + 4);
      cw[j][0] = a.x; cw[j][1] = a.y; cw[j][2] = a.z; cw[j][3] = a.w; cw[j][4] = c.x; cw[j][5] = c.y; cw[j][6] = c.z; cw[j][7] = c.w;
    }
    const int ib = wid * 16 + fq * 4;
#pragma unroll
    for (int it = 0; it < 4; ++it) {
      float o[8];
#pragma unroll
      for (int c = 0; c < 8; ++c) o[c] = 0.f;
#pragma unroll
      for (int j = 0; j < 4; ++j) {
        float f[8];
        UNPACK8(rwall[sect][it + j], f);
#pragma unroll
        for (int c = 0; c < 8; ++c) o[c] += f[c] * cw[j][c];
      }
      float ss = 0.f;
#pragma unroll
      for (int c = 0; c < 8; ++c) { o[c] = silu(o[c]); ss += o[c] * o[c]; }
      if (sect < 2) {
        ss += shx(ss, 1, lane); ss += shx(ss, 2, lane); ss += shx(ss, 4, lane); ss += shx(ss, 8, lane);
        float rn = rsqrtf(ss + EPS);
        if (sect == 0) rn *= 0.08838834764831845f;
#pragma unroll
        for (int c = 0; c < 8; ++c) o[c] *= rn;
      }
      const u32x4 pk = (u32x4){pk2(o[0], o[1]), pk2(o[2], o[3]), pk2(o[4], o[5]), pk2(o[6], o[7])};
      bf16_t* dst = sect == 0 ? qh + (ib + it) * 136 + fr * 8 : (sect == 1 ? kh + (ib + it) * 136 + fr * 8 : vh + (ib + it) * 136 + fr * 8);
      *(u32x4*)dst = pk;
    }
  }
  __syncthreads();
  {
    const int i = wid * 16 + fr;
    const float gi = sgc[i], bi = sbeta[i];
    bf16x8 kx[4], qx[4];
#pragma unroll
    for (int ks = 0; ks < 4; ++ks) {
      kx[ks] = *(const bf16x8*)(kh + i * 136 + ks * 32 + fq * 8);
      qx[ks] = *(const bf16x8*)(qh + i * 136 + ks * 32 + fq * 8);
    }
#pragma unroll
    for (int jt = 0; jt < 4; ++jt) {
      f32x4 akk = (f32x4){0.f, 0.f, 0.f, 0.f}, aqk = (f32x4){0.f, 0.f, 0.f, 0.f};
      if (jt <= wid) {
#pragma unroll
        for (int ks = 0; ks < 4; ++ks) {
          const bf16x8 kj = *(const bf16x8*)(kh + (jt * 16 + fr) * 136 + ks * 32 + fq * 8);
          akk = mfma16(kj, kx[ks], akk);
          aqk = mfma16(kj, qx[ks], aqk);
        }
      }
      const int j0 = jt * 16 + fq * 4;
      float av[4], qv[4];
#pragma unroll
      for (int jj = 0; jj < 4; ++jj) {
        const int j = j0 + jj;
        const float dec = j <= i ? __expf(gi - sgc[j]) : 0.f;
        av[jj] = j < i ? bi * akk[jj] * dec : 0.f;
        qv[jj] = aqk[jj] * dec;
      }
      *(f32x4*)(Am + i * 64 + j0) = (f32x4){av[0], av[1], av[2], av[3]};
      *(u32x2*)(g_qk + i * 64 + j0) = (u32x2){pk2(qv[0], qv[1]), pk2(qv[2], qv[3])};
    }
  }
  __syncthreads();
  {
    float x[64];
    const bool isu = tid < 128;
    const int cc = tid & 127;
    solve_rows<0>(x, Am, (isu ? vh : kh) + cc, isu ? sbeta : sbe);
    if (isu) {
      u32x4* d = (u32x4*)(g_uT + cc * 64);
#pragma unroll
      for (int q = 0; q < 8; ++q) d[q] = (u32x4){pk2(x[q * 8], x[q * 8 + 1]), pk2(x[q * 8 + 2], x[q * 8 + 3]), pk2(x[q * 8 + 4], x[q * 8 + 5]), pk2(x[q * 8 + 6], x[q * 8 + 7])};
    } else {
#pragma unroll
      for (int i = 0; i < 64; ++i) g_w[i * 128 + cc] = f2bf(x[i]);
    }
  }
  {
    const float gl = sgc[63];
#pragma unroll
    for (int q = 0; q < 4; ++q) {
      const int pc = tid + q * 256, i = pc >> 4, c8 = pc & 15;
      const u32x4 v = *(const u32x4*)(qh + i * 136 + c8 * 8);
      float f[8];
      UNPACK8(v, f);
      const float s = __expf(sgc[i]);
      *(u32x4*)(g_qg + i * 128 + c8 * 8) = (u32x4){pk2(f[0] * s, f[1] * s), pk2(f[2] * s, f[3] * s), pk2(f[4] * s, f[5] * s), pk2(f[6] * s, f[7] * s)};
    }
    if (tid >= 128) {
      const int dk = tid - 128;
      u32x4* d = (u32x4*)(g_kgT + dk * 64);
#pragma unroll
      for (int q = 0; q < 8; ++q) {
        float f[8];
#pragma unroll
        for (int c = 0; c < 8; ++c) { const int i = q * 8 + c; f[c] = bf2f(kh[i * 136 + dk]) * __expf(gl - sgc[i]); }
        d[q] = (u32x4){pk2(f[0], f[1]), pk2(f[2], f[3]), pk2(f[4], f[5]), pk2(f[6], f[7])};
      }
    }
    if (tid == 0) p.gsc()[item] = __expf(gl);
  }
  __syncthreads();
}

__device__ void gdn_scan_item(const Params& p, int l, int item, unsigned char* smem) {
  const int tid = (opq(threadIdx.x) & 255), lane = tid & 63, wid = tid >> 6, fr = lane & 15, fq = lane >> 4;
  const int dvs = item & 3, h = (item >> 2) & 7, b = item >> 5;
  bf16_t* ST = (bf16_t*)smem;
  bf16_t* VT = ST + 2 * 32 * 136;
  f32x4 S[2][2];
#pragma unroll
  for (int a = 0; a < 2; ++a)
#pragma unroll
    for (int c = 0; c < 2; ++c) S[a][c] = (f32x4){0.f, 0.f, 0.f, 0.f};
  __syncthreads();
  bf16x8 fw[4], fqg[4], fqk[2], fkg[2][2];
  u32x2 fu[2];
  float gs;
  bf16x8 nw[4], nqg[4], nqk[2], nkg[2][2];
  u32x2 nu[2];
  float ngs;
#define SCAN_LOAD(n_, W, QG, QK, KG, U, GS) do { \
    const int it_ = ((b * 32 + (n_)) << 3) + h; \
    const unsigned char* scr_ = (const unsigned char*)p.scr() + (size_t)it_ * SCR_ITEM; \
    const bf16_t* g_uT = (const bf16_t*)scr_; const bf16_t* g_w = (const bf16_t*)(scr_ + 16384); const bf16_t* g_qg = (const bf16_t*)(scr_ + 32768); \
    const bf16_t* g_kgT = (const bf16_t*)(scr_ + 49152); const bf16_t* g_qk = (const bf16_t*)(scr_ + 65536); \
    _Pragma("unroll") for (int ks = 0; ks < 4; ++ks) { \
      W[ks] = *(const bf16x8*)(g_w + (wid * 16 + fr) * 128 + ks * 32 + fq * 8); \
      QG[ks] = *(const bf16x8*)(g_qg + (wid * 16 + fr) * 128 + ks * 32 + fq * 8); } \
    _Pragma("unroll") for (int ks = 0; ks < 2; ++ks) { \
      QK[ks] = *(const bf16x8*)(g_qk + (wid * 16 + fr) * 64 + ks * 32 + fq * 8); \
      _Pragma("unroll") for (int mt = 0; mt < 2; ++mt) KG[mt][ks] = *(const bf16x8*)(g_kgT + ((2 * wid + mt) * 16 + fr) * 64 + ks * 32 + fq * 8); } \
    _Pragma("unroll") for (int nt = 0; nt < 2; ++nt) U[nt] = *(const u32x2*)(g_uT + (dvs * 32 + nt * 16 + fr) * 64 + wid * 16 + fq * 4); \
    GS = p.gsc()[it_]; } while (0)
  SCAN_LOAD(0, nw, nqg, nqk, nkg, nu, ngs);
  for (int n = 0; n < 32; ++n) {
#pragma unroll
    for (int ks = 0; ks < 4; ++ks) { fw[ks] = nw[ks]; fqg[ks] = nqg[ks]; }
#pragma unroll
    for (int ks = 0; ks < 2; ++ks) { fqk[ks] = nqk[ks]; fkg[0][ks] = nkg[0][ks]; fkg[1][ks] = nkg[1][ks]; }
    fu[0] = nu[0]; fu[1] = nu[1]; gs = ngs;
    if (n + 1 < 32) SCAN_LOAD(n + 1, nw, nqg, nqk, nkg, nu, ngs);
    bf16_t* STc = ST + (n & 1) * 32 * 136;
#pragma unroll
    for (int mt = 0; mt < 2; ++mt)
#pragma unroll
      for (int nt = 0; nt < 2; ++nt)
        *(u32x2*)(STc + (nt * 16 + fr) * 136 + (2 * wid + mt) * 16 + fq * 4) = (u32x2){pk2(S[mt][nt].x, S[mt][nt].y), pk2(S[mt][nt].z, S[mt][nt].w)};
    __syncthreads();
#pragma unroll
    for (int nt = 0; nt < 2; ++nt) {
      f32x4 a = (f32x4){0.f, 0.f, 0.f, 0.f};
#pragma unroll
      for (int ks = 0; ks < 4; ++ks) {
        const bf16x8 sb = *(const bf16x8*)(STc + (nt * 16 + fr) * 136 + ks * 32 + fq * 8);
        a = mfma16(fw[ks], sb, a);
      }
      const float v0 = lo2f(fu[nt].x) - a.x, v1 = hi2f(fu[nt].x) - a.y, v2 = lo2f(fu[nt].y) - a.z, v3 = hi2f(fu[nt].y) - a.w;
      *(u32x2*)(VT + (nt * 16 + fr) * 72 + wid * 16 + fq * 4) = (u32x2){pk2(v0, v1), pk2(v2, v3)};
    }
    __syncthreads();
#pragma unroll
    for (int mt = 0; mt < 2; ++mt) {
      f32x4 a = (f32x4){0.f, 0.f, 0.f, 0.f};
#pragma unroll
      for (int ks = 0; ks < 4; ++ks) {
        const bf16x8 sa = *(const bf16x8*)(STc + (mt * 16 + fr) * 136 + ks * 32 + fq * 8);
        a = mfma16(sa, fqg[ks], a);
      }
#pragma unroll
      for (int ks = 0; ks < 2; ++ks) {
        const bf16x8 va = *(const bf16x8*)(VT + (mt * 16 + fr) * 72 + ks * 32 + fq * 8);
        a = mfma16(va, fqk[ks], a);
      }
      const size_t row = (size_t)b * 2048 + n * 64 + wid * 16 + fr;
      *(u32x2*)(p.ogdn() + row * DM + h * 128 + dvs * 32 + mt * 16 + fq * 4) = (u32x2){pk2(a.x, a.y), pk2(a.z, a.w)};
    }
#pragma unroll
    for (int mt = 0; mt < 2; ++mt)
#pragma unroll
      for (int nt = 0; nt < 2; ++nt) {
        f32x4 a = S[mt][nt] * gs;
#pragma unroll
        for (int ks = 0; ks < 2; ++ks) {
          const bf16x8 vb = *(const bf16x8*)(VT + (nt * 16 + fr) * 72 + ks * 32 + fq * 8);
          a = mfma16(fkg[mt][ks], vb, a);
        }
        S[mt][nt] = a;
      }
  }
  float* so = p.out + O_GDNP + ((size_t)(l * 8 + b) * 8 + h) * 16384;
#pragma unroll
  for (int mt = 0; mt < 2; ++mt)
#pragma unroll
    for (int nt = 0; nt < 2; ++nt)
#pragma unroll
      for (int jj = 0; jj < 4; ++jj) so[((2 * wid + mt) * 16 + fq * 4 + jj) * 128 + dvs * 32 + nt * 16 + fr] = S[mt][nt][jj];
  __syncthreads();
#undef SCAN_LOAD
}

__device__ void gdn_sample_item(const Params& p, int l, int item, unsigned char* smem) {
  const int tid = (opq(threadIdx.x) & 255), lane = tid & 63, wid = tid >> 6;
  const int h = item & 7, b = item >> 3;
  float* qs = (float*)smem;
  float* ks = qs + 1024;
  float* vs = ks + 1024;
  float* part = vs + 1024;
  float* sbeta = part + 256;
  float* sa = sbeta + 8;
  const int dv = tid & 127, half = tid >> 7;
  float S[64];
  const float* s0 = p.state_gdn + ((size_t)(l * 128 + b) * 8 + h) * 16384 + (half * 8192 + dv);
#pragma unroll
  for (int k = 0; k < 64; ++k) S[k] = s0[k * 128];
#pragma unroll
  for (int ps = 0; ps < 2; ++ps) {
    const int c = tid + ps * 256;
    if (c < 384) {
      const int sect = c >> 7, ci = c & 127;
      const int ch = sect * 1024 + h * 128 + ci;
      float xw[11], cwv[4];
#pragma unroll
      for (int j = 0; j < 4; ++j) cwv[j] = p.conv_w[(size_t)(l * 4 + j) * 3072 + ch];
#pragma unroll
      for (int j = 0; j < 3; ++j) xw[j] = p.cache_conv[((size_t)(l * 128 + b) * 3 + j) * 3072 + ch];
#pragma unroll
      for (int t = 0; t < 8; ++t) xw[3 + t] = bf2f(p.proj()[(size_t)(MP + b * 8 + t) * NPJ + ch]);
      float* dst = sect == 0 ? qs : (sect == 1 ? ks : vs);
#pragma unroll
      for (int t = 0; t < 8; ++t) dst[t * 128 + ci] = silu(xw[t] * cwv[0] + xw[t + 1] * cwv[1] + xw[t + 2] * cwv[2] + xw[t + 3] * cwv[3]);
    }
  }
  if (tid < 8) {
    const float* lg = p.logits() + (size_t)(MP + b * 8 + tid) * 16;
    const float x = lg[8 + h] + p.dt_bias[l * 8 + h];
    const float sp = softplus_f(x);
    sa[tid] = __expf(-__expf(p.a_log[l * 8 + h]) * sp);
    sbeta[tid] = sigm(lg[h]);
  }
  __syncthreads();
#pragma unroll
  for (int u = 0; u < 4; ++u) {
    const int t = wid * 2 + (u >> 1);
    float* arr = (u & 1) ? ks : qs;
    const float a0 = arr[t * 128 + lane], a1 = arr[t * 128 + 64 + lane];
    float ss = a0 * a0 + a1 * a1;
#pragma unroll
    for (int o = 1; o < 64; o <<= 1) ss += shx(ss, o, lane);
    float rn = rsqrtf(ss + EPS);
    if (!(u & 1)) rn *= 0.08838834764831845f;
    arr[t * 128 + lane] = a0 * rn;
    arr[t * 128 + 64 + lane] = a1 * rn;
  }
  __syncthreads();
#pragma unroll 1
  for (int t = 0; t < 8; ++t) {
    const float a = sa[t], bt = sbeta[t];
    float kv = 0.f;
#pragma unroll
    for (int k4 = 0; k4 < 16; ++k4) {
      const f32x4 kk = *(const f32x4*)(ks + t * 128 + half * 64 + k4 * 4);
      S[k4 * 4 + 0] *= a; S[k4 * 4 + 1] *= a; S[k4 * 4 + 2] *= a; S[k4 * 4 + 3] *= a;
      kv += S[k4 * 4 + 0] * kk.x + S[k4 * 4 + 1] * kk.y + S[k4 * 4 + 2] * kk.z + S[k4 * 4 + 3] * kk.w;
      if ((k4 & 3) == 3) asm volatile("" ::: "memory");
    }
    part[half * 128 + dv] = kv;
    __syncthreads();
    const float delta = bt * (vs[t * 128 + dv] - (part[dv] + part[128 + dv]));
    __syncthreads();
    float o = 0.f;
#pragma unroll
    for (int k4 = 0; k4 < 16; ++k4) {
      const f32x4 kk = *(const f32x4*)(ks + t * 128 + half * 64 + k4 * 4);
      const f32x4 qq = *(const f32x4*)(qs + t * 128 + half * 64 + k4 * 4);
      S[k4 * 4 + 0] += kk.x * delta; S[k4 * 4 + 1] += kk.y * delta; S[k4 * 4 + 2] += kk.z * delta; S[k4 * 4 + 3] += kk.w * delta;
      o += S[k4 * 4 + 0] * qq.x + S[k4 * 4 + 1] * qq.y + S[k4 * 4 + 2] * qq.z + S[k4 * 4 + 3] * qq.w;
      if ((k4 & 3) == 3) asm volatile("" ::: "memory");
    }
    part[half * 128 + dv] = o;
    __syncthreads();
    if (half == 0) p.ogdn()[(size_t)(MP + b * 8 + t) * DM + h * 128 + dv] = f2bf(part[dv] + part[128 + dv]);
    __syncthreads();
  }
  float* so = p.out + O_GDNS + ((size_t)(l * 128 + b) * 8 + h) * 16384 + opq(half * 8192 + dv);
#pragma unroll
  for (int k = 0; k < 64; ++k) so[k * 128] = S[k];
  __syncthreads();
}

__device__ void gdn_sample_pair(const Params& p, int l, int pair, unsigned char* smem) {
  const int tid = (opq(threadIdx.x) & 255), lane = tid & 63, wid = tid >> 6;
  const int sub = tid >> 7, dv = tid & 127;
  const int item = pair * 2 + sub, h = item & 7, b = item >> 3;
  float* qs = (float*)smem + sub * 3104;
  float* ks = qs + 1024;
  float* vs = qs + 2048;
  float* sbeta = qs + 3072;
  float* sa = qs + 3080;
  f32x2 S2[64];
  const float* s0 = p.state_gdn + ((size_t)(l * 128 + b) * 8 + h) * 16384 + dv;
#pragma unroll
  for (int k = 0; k < 64; ++k) { S2[k].x = s0[(2 * k) * 128]; S2[k].y = s0[(2 * k + 1) * 128]; }
#pragma unroll
  for (int sect = 0; sect < 3; ++sect) {
    const int ch = sect * 1024 + h * 128 + dv;
    float xw[11], cwv[4];
#pragma unroll
    for (int j = 0; j < 4; ++j) cwv[j] = p.conv_w[(size_t)(l * 4 + j) * 3072 + ch];
#pragma unroll
    for (int j = 0; j < 3; ++j) xw[j] = p.cache_conv[((size_t)(l * 128 + b) * 3 + j) * 3072 + ch];
#pragma unroll
    for (int t = 0; t < 8; ++t) xw[3 + t] = bf2f(p.proj()[(size_t)(MP + b * 8 + t) * NPJ + ch]);
    float* dst = sect == 0 ? qs : (sect == 1 ? ks : vs);
#pragma unroll
    for (int t = 0; t < 8; ++t) dst[t * 128 + dv] = silu(xw[t] * cwv[0] + xw[t + 1] * cwv[1] + xw[t + 2] * cwv[2] + xw[t + 3] * cwv[3]);
  }
  if (dv < 8) {
    const float* lg = p.logits() + (size_t)(MP + b * 8 + dv) * 16;
    const float x = lg[8 + h] + p.dt_bias[l * 8 + h];
    sa[dv] = __expf(-__expf(p.a_log[l * 8 + h]) * softplus_f(x));
    sbeta[dv] = sigm(lg[h]);
  }
  __syncthreads();
#pragma unroll
  for (int u = 0; u < 8; ++u) {
    const int t = (wid & 1) * 4 + (u >> 1);
    float* arr = (u & 1) ? ks : qs;
    const float a0 = arr[t * 128 + lane], a1 = arr[t * 128 + 64 + lane];
    float ss = a0 * a0 + a1 * a1;
#pragma unroll
    for (int o = 1; o < 64; o <<= 1) ss += shx(ss, o, lane);
    float rn = rsqrtf(ss + EPS);
    if (!(u & 1)) rn *= 0.08838834764831845f;
    arr[t * 128 + lane] = a0 * rn;
    arr[t * 128 + 64 + lane] = a1 * rn;
  }
  __syncthreads();
#pragma unroll 1
  for (int t = 0; t < 8; ++t) {
    const float a = sa[t], bt = sbeta[t];
    f32x2 kv2 = (f32x2){0.f, 0.f};
#pragma unroll
    for (int k4 = 0; k4 < 32; ++k4) {
      const f32x4 kk = *(const f32x4*)(ks + t * 128 + k4 * 4);
      kv2 += S2[2 * k4] * (f32x2){kk.x, kk.y};
      kv2 += S2[2 * k4 + 1] * (f32x2){kk.z, kk.w};
      if ((k4 & 3) == 3) asm volatile("" ::: "memory");
    }
    const float delta = bt * (vs[t * 128 + dv] - a * (kv2.x + kv2.y));
    const f32x2 a2 = (f32x2){a, a}, d2 = (f32x2){delta, delta};
    f32x2 o2 = (f32x2){0.f, 0.f};
#pragma unroll
    for (int k4 = 0; k4 < 32; ++k4) {
      const f32x4 kk = *(const f32x4*)(ks + t * 128 + k4 * 4);
      const f32x4 qq = *(const f32x4*)(qs + t * 128 + k4 * 4);
      S2[2 * k4] = S2[2 * k4] * a2 + (f32x2){kk.x, kk.y} * d2;
      S2[2 * k4 + 1] = S2[2 * k4 + 1] * a2 + (f32x2){kk.z, kk.w} * d2;
      o2 += S2[2 * k4] * (f32x2){qq.x, qq.y};
      o2 += S2[2 * k4 + 1] * (f32x2){qq.z, qq.w};
      if ((k4 & 3) == 3) asm volatile("" ::: "memory");
    }
    p.ogdn()[(size_t)(MP + b * 8 + t) * DM + h * 128 + dv] = f2bf(o2.x + o2.y);
  }
  float* so = p.out + O_GDNS + ((size_t)(l * 128 + b) * 8 + h) * 16384 + opq(dv);
#pragma unroll
  for (int k = 0; k < 64; ++k) { so[(2 * k) * 128] = S2[k].x; so[(2 * k + 1) * 128] = S2[k].y; }
  __syncthreads();
}

__device__ void swa_prompt_item(const Params& p, int l, int item, unsigned char* smem) {
  const int tid = (opq(threadIdx.x) & 255), lane = tid & 63, wid = tid >> 6, fr = lane & 15, fq = lane >> 4;
  const int kvh = item & 3, hb2 = (item >> 2) & 31, b = item >> 7;
  bf16_t* Ks = (bf16_t*)smem;
  bf16_t* VT = Ks + 208 * 72;
  bf16_t* Pw = VT + 64 * 216 + wid * 16 * 168;
  const int tk0 = hb2 * 64 - 128;
  u32x4 krw[7], vrw[7];
#pragma unroll
  for (int i = 0; i < 7; ++i) {
    const int pc = tid + i * NTHR, kj = pc >> 3, c8 = pc & 7, tk = tk0 + kj;
    krw[i] = (u32x4){0u, 0u, 0u, 0u}; vrw[i] = (u32x4){0u, 0u, 0u, 0u};
    if (pc < 208 * 8 && kj < 192 && tk >= 0) {
      const bf16_t* base = p.proj() + (size_t)(b * 2048 + tk) * NPJ + kvh * 64 + c8 * 8;
      krw[i] = *(const u32x4*)(base + C_SK); vrw[i] = *(const u32x4*)(base + C_SV);
    }
  }
#pragma unroll
  for (int i = 0; i < 7; ++i) {
    const int pc = tid + i * NTHR;
    if (pc >= 208 * 8) break;
    const int kj = pc >> 3, c8 = pc & 7, tk = tk0 + kj;
    const bool ok = kj < 192 && tk >= 0;
    float kf[8], vf[8];
    UNPACK8(krw[i], kf);
    UNPACK8(vrw[i], vf);
    float ss = 0.f;
#pragma unroll
    for (int c = 0; c < 8; ++c) ss += kf[c] * kf[c];
    ss += shx(ss, 1, lane); ss += shx(ss, 2, lane); ss += shx(ss, 4, lane);
    const float rn = rsqrtf(ss * (1.f / 64.f) + EPS);
    const f32x4 w0 = *(const f32x4*)(p.k_norm + l * 64 + c8 * 8), w1 = *(const f32x4*)(p.k_norm + l * 64 + c8 * 8 + 4);
    kf[0] *= rn * w0.x; kf[1] *= rn * w0.y; kf[2] *= rn * w0.z; kf[3] *= rn * w0.w;
    kf[4] *= rn * w1.x; kf[5] *= rn * w1.y; kf[6] *= rn * w1.z; kf[7] *= rn * w1.w;
    *(u32x4*)(Ks + kj * 72 + c8 * 8) = (u32x4){pk2(kf[0], kf[1]), pk2(kf[2], kf[3]), pk2(kf[4], kf[5]), pk2(kf[6], kf[7])};
#pragma unroll
    for (int c = 0; c < 8; ++c) VT[(c8 * 8 + c) * 216 + kj] = f2bf(vf[c]);
    if (ok && tk >= 1920 && kj >= 128) {
      float* ko = p.out + O_KP + (((size_t)(l * 8 + b) * 128 + (tk - 1920)) * 4 + kvh) * 64 + c8 * 8;
      float* vo = p.out + O_VP + (((size_t)(l * 8 + b) * 128 + (tk - 1920)) * 4 + kvh) * 64 + c8 * 8;
      *(f32x4*)ko = (f32x4){kf[0], kf[1], kf[2], kf[3]};
      *(f32x4*)(ko + 4) = (f32x4){kf[4], kf[5], kf[6], kf[7]};
      *(f32x4*)vo = (f32x4){vf[0], vf[1], vf[2], vf[3]};
      *(f32x4*)(vo + 4) = (f32x4){vf[4], vf[5], vf[6], vf[7]};
    }
  }
  __syncthreads();
  const int kbase = wid * 16;
  const int ql = wid * 16 + fr;
  const size_t qrow = (size_t)b * 2048 + hb2 * 64 + ql;
  u32x4 qraw[4][2];
#pragma unroll
  for (int g = 0; g < 4; ++g) {
    const bf16_t* qp = p.proj() + qrow * NPJ + C_SQ + (kvh * 4 + g) * 64 + fq * 8;
    qraw[g][0] = *(const u32x4*)qp; qraw[g][1] = *(const u32x4*)(qp + 32);
  }
#pragma unroll
  for (int g = 0; g < 4; ++g) {
    const int head = kvh * 4 + g;
    const float slope = exp2f(-0.5f * (float)(head + 1));
    const float sink = p.sinks[l * 16 + head];
    bf16x8 qf[2];
    {
      const u32x4 r0 = qraw[g][0], r1 = qraw[g][1];
      float f0[8], f1[8];
      UNPACK8(r0, f0);
      UNPACK8(r1, f1);
      float ss = 0.f;
#pragma unroll
      for (int c = 0; c < 8; ++c) ss += f0[c] * f0[c] + f1[c] * f1[c];
      ss += shx(ss, 16, lane); ss += shx(ss, 32, lane);
      const float rn = rsqrtf(ss * (1.f / 64.f) + EPS) * 0.125f;
      const float* qn = p.q_norm + l * 64 + fq * 8;
#pragma unroll
      for (int c = 0; c < 8; ++c) { f0[c] *= rn * qn[c]; f1[c] *= rn * qn[32 + c]; }
      qf[0] = as_bf((u32x4){pk2(f0[0], f0[1]), pk2(f0[2], f0[3]), pk2(f0[4], f0[5]), pk2(f0[6], f0[7])});
      qf[1] = as_bf((u32x4){pk2(f1[0], f1[1]), pk2(f1[2], f1[3]), pk2(f1[4], f1[5]), pk2(f1[6], f1[7])});
    }
    f32x4 sc[9];
    float mx = sink;
#pragma unroll
    for (int kt = 0; kt < 9; ++kt) {
      f32x4 a = (f32x4){0.f, 0.f, 0.f, 0.f};
#pragma unroll
      for (int ks = 0; ks < 2; ++ks) {
        const bf16x8 kf = *(const bf16x8*)(Ks + (kbase + kt * 16 + fr) * 72 + ks * 32 + fq * 8);
        a = mfma16(kf, qf[ks], a);
      }
#pragma unroll
      for (int jj = 0; jj < 4; ++jj) {
        const int kj = kbase + kt * 16 + fq * 4 + jj;
        const int dist = ql + 128 - kj;
        const bool ok = dist >= 0 && dist <= 128 && (tk0 + kj) >= 0;
        const float s = ok ? a[jj] - slope * (float)dist : -INFINITY;
        a[jj] = s;
        mx = fmaxf(mx, s);
      }
      sc[kt] = a;
    }
    mx = fmaxf(mx, shx(mx, 16, lane));
    mx = fmaxf(mx, shx(mx, 32, lane));
    float sum = 0.f;
#pragma unroll
    for (int kt = 0; kt < 9; ++kt) {
      f32x4 e;
#pragma unroll
      for (int jj = 0; jj < 4; ++jj) { e[jj] = __expf(sc[kt][jj] - mx); sum += e[jj]; }
      *(u32x2*)(Pw + fr * 168 + kt * 16 + fq * 4) = (u32x2){pk2(e.x, e.y), pk2(e.z, e.w)};
    }
    *(u32x2*)(Pw + fr * 168 + 144 + fq * 4) = (u32x2){0u, 0u};
    sum += shx(sum, 16, lane);
    sum += shx(sum, 32, lane);
    const float inv = 1.f / (sum + __expf(sink - mx));
    __builtin_amdgcn_wave_barrier();
#pragma unroll
    for (int dt = 0; dt < 4; ++dt) {
      f32x4 a = (f32x4){0.f, 0.f, 0.f, 0.f};
#pragma unroll
      for (int ks = 0; ks < 5; ++ks) {
        const bf16x8 vf = *(const bf16x8*)(VT + (dt * 16 + fr) * 216 + kbase + ks * 32 + fq * 8);
        const bf16x8 pf = *(const bf16x8*)(Pw + fr * 168 + ks * 32 + fq * 8);
        a = mfma16(vf, pf, a);
      }
      a *= inv;
      *(u32x2*)(p.oswa() + qrow * DM + head * 64 + dt * 16 + fq * 4) = (u32x2){pk2(a.x, a.y), pk2(a.z, a.w)};
    }
    __builtin_amdgcn_wave_barrier();
  }
  __syncthreads();
}

__device__ void swa_sample_item(const Params& p, int l, int item, unsigned char* smem) {
  const int tid = (opq(threadIdx.x) & 255), lane = tid & 63, wid = tid >> 6;
  const int kvh = item & 3, b = item >> 2;
  float* Ks = (float*)smem;
  float* Vs = Ks + 136 * 68;
  float* Qs = Vs + 136 * 64;
  float* Sc = Qs + 512;
  const size_t cbase = (size_t)(l * 128 + b) * 128;
  f32x4 kvr[8], vvr[8];
#pragma unroll
  for (int i = 0; i < 8; ++i) {
    const int idx = tid + i * NTHR, j = idx >> 4, c4 = idx & 15;
    kvr[i] = *(const f32x4*)(p.cache_k + ((cbase + j) * 4 + kvh) * 64 + c4 * 4);
    vvr[i] = *(const f32x4*)(p.cache_v + ((cbase + j) * 4 + kvh) * 64 + c4 * 4);
  }
  unsigned qrw[4];
#pragma unroll
  for (int g = 0; g < 4; ++g) qrw[g] = *(const unsigned*)(p.proj() + (size_t)(MP + b * 8 + (tid >> 5)) * NPJ + C_SQ + (kvh * 4 + g) * 64 + (tid & 31) * 2);
#pragma unroll
  for (int i = 0; i < 8; ++i) {
    const int idx = tid + i * NTHR, j = idx >> 4, c4 = idx & 15;
    const f32x4 kv = kvr[i], vv = vvr[i];
    *(f32x4*)(Ks + j * 68 + c4 * 4) = kv;
    *(f32x4*)(Vs + j * 64 + c4 * 4) = vv;
  }
  {
    const int t = tid >> 5, d = (tid & 31) * 2;
    const bf16_t* base = p.proj() + (size_t)(MP + b * 8 + t) * NPJ + kvh * 64 + d;
    const unsigned kr = *(const unsigned*)(base + C_SK), vr = *(const unsigned*)(base + C_SV);
    float k0 = lo2f(kr), k1 = hi2f(kr);
    float ss = k0 * k0 + k1 * k1;
#pragma unroll
    for (int o = 1; o < 32; o <<= 1) ss += shx(ss, o, lane);
    const float rn = rsqrtf(ss * (1.f / 64.f) + EPS);
    Ks[(128 + t) * 68 + d] = k0 * rn * p.k_norm[l * 64 + d];
    Ks[(128 + t) * 68 + d + 1] = k1 * rn * p.k_norm[l * 64 + d + 1];
    Vs[(128 + t) * 64 + d] = lo2f(vr);
    Vs[(128 + t) * 64 + d + 1] = hi2f(vr);
  }
  __syncthreads();
  for (int idx = tid; idx < 128 * 64; idx += NTHR) {
    const int j = idx >> 6, d = idx & 63;
    p.out[O_KS + ((cbase + j) * 4 + kvh) * 64 + d] = Ks[(j + 8) * 68 + d];
    p.out[O_VS + ((cbase + j) * 4 + kvh) * 64 + d] = Vs[(j + 8) * 64 + d];
  }
#pragma unroll
  for (int g = 0; g < 4; ++g) {
    const int head = kvh * 4 + g;
    const float slope = exp2f(-0.5f * (float)(head + 1));
    const float sink = p.sinks[l * 16 + head];
    {
      const int t = tid >> 5, d = (tid & 31) * 2;
      const unsigned qr = qrw[g];
      const float q0 = lo2f(qr), q1 = hi2f(qr);
      float ss = q0 * q0 + q1 * q1;
#pragma unroll
      for (int o = 1; o < 32; o <<= 1) ss += shx(ss, o, lane);
      const float rn = rsqrtf(ss * (1.f / 64.f) + EPS) * 0.125f;
      Qs[t * 64 + d] = q0 * rn * p.q_norm[l * 64 + d];
      Qs[t * 64 + d + 1] = q1 * rn * p.q_norm[l * 64 + d + 1];
    }
    __syncthreads();
    for (int idx = tid; idx < 8 * 136; idx += NTHR) {
      const int tq = idx / 136, j = idx % 136;
      float s = 0.f;
#pragma unroll
      for (int d4 = 0; d4 < 16; ++d4) {
        const f32x4 qv = *(const f32x4*)(Qs + tq * 64 + d4 * 4), kq = *(const f32x4*)(Ks + j * 68 + d4 * 4);
        s += (qv.x * kq.x + qv.y * kq.y) + (qv.z * kq.z + qv.w * kq.w);
      }
      const int dist = tq + 128 - j;
      Sc[tq * 136 + j] = (dist >= 0 && dist <= 128) ? s - slope * (float)dist : -INFINITY;
    }
    __syncthreads();
#pragma unroll
    for (int u = 0; u < 2; ++u) {
      const int tq = wid * 2 + u;
      const float s0 = Sc[tq * 136 + lane], s1 = Sc[tq * 136 + 64 + lane], s2 = lane < 8 ? Sc[tq * 136 + 128 + lane] : -INFINITY;
      float mx = fmaxf(fmaxf(s0, s1), fmaxf(s2, sink));
#pragma unroll
      for (int o = 1; o < 64; o <<= 1) mx = fmaxf(mx, shx(mx, o, lane));
      const float e0 = __expf(s0 - mx), e1 = __expf(s1 - mx), e2 = __expf(s2 - mx);
      float sum = e0 + e1 + e2;
#pragma unroll
      for (int o = 1; o < 64; o <<= 1) sum += shx(sum, o, lane);
      const float inv = 1.f / (sum + __expf(sink - mx));
      Sc[tq * 136 + lane] = e0 * inv;
      Sc[tq * 136 + 64 + lane] = e1 * inv;
      if (lane < 8) Sc[tq * 136 + 128 + lane] = e2 * inv;
    }
    __syncthreads();
    {
      const int tq = tid >> 5, d = (tid & 31) * 2;
      float o0 = 0.f, o1 = 0.f;
#pragma unroll 2
      for (int j4 = 0; j4 < 34; ++j4) {
        const f32x4 pj = *(const f32x4*)(Sc + tq * 136 + j4 * 4);
        const f32x2 va = *(const f32x2*)(Vs + (j4 * 4 + 0) * 64 + d), vb = *(const f32x2*)(Vs + (j4 * 4 + 1) * 64 + d);
        const f32x2 vc = *(const f32x2*)(Vs + (j4 * 4 + 2) * 64 + d), vd = *(const f32x2*)(Vs + (j4 * 4 + 3) * 64 + d);
        o0 += (pj.x * va.x + pj.y * vb.x) + (pj.z * vc.x + pj.w * vd.x);
        o1 += (pj.x * va.y + pj.y * vb.y) + (pj.z * vc.y + pj.w * vd.y);
      }
      *(unsigned*)(p.oswa() + (size_t)(MP + b * 8 + tq) * DM + head * 64 + d) = pk2(o0, o1);
    }
    __syncthreads();
  }
}

__device__ void phase_mix(const Params& p, int l) {
  const int tid = (opq(threadIdx.x) & 255), lane = tid & 63, wid = tid >> 6, fr = lane & 15, fq = lane >> 4;
  for (int it = VB; it < MTOK / 4; it += VG) {
    const size_t row = (size_t)it * 4 + wid;
#pragma unroll
    for (int ps = 0; ps < 2; ++ps) {
      const int ch = (ps * 4 + fq) * 128 + fr * 8;
      const u32x4 og = *(const u32x4*)(p.ogdn() + row * DM + ch);
      const u32x4 ob = *(const u32x4*)(p.oswa() + row * DM + ch);
      const u32x4 zz = *(const u32x4*)(p.proj() + row * NPJ + C_Z + ch);
      const u32x4 ga = *(const u32x4*)(p.proj() + row * NPJ + C_G + ch);
      const u32x4 gb = *(const u32x4*)(p.proj() + row * NPJ + C_G + 1024 + ch);
      float fo[8], fb[8], fz[8], fa[8], fg[8];
      UNPACK8(og, fo); UNPACK8(ob, fb); UNPACK8(zz, fz); UNPACK8(ga, fa); UNPACK8(gb, fg);
      float ss = 0.f;
#pragma unroll
      for (int c = 0; c < 8; ++c) ss += fo[c] * fo[c];
      ss += shx(ss, 1, lane); ss += shx(ss, 2, lane); ss += shx(ss, 4, lane); ss += shx(ss, 8, lane);
      const float rn = rsqrtf(ss * (1.f / 128.f) + EPS);
      const f32x4 w0 = *(const f32x4*)(p.gdn_norm + l * 128 + fr * 8), w1 = *(const f32x4*)(p.gdn_norm + l * 128 + fr * 8 + 4);
      const float wn[8] = {w0.x, w0.y, w0.z, w0.w, w1.x, w1.y, w1.z, w1.w};
      float m[8];
#pragma unroll
      for (int c = 0; c < 8; ++c) m[c] = sigm(fa[c]) * (fo[c] * rn * wn[c] * silu(fz[c])) + sigm(fg[c]) * fb[c];
      *(u32x4*)(p.mix() + row * DM + ch) = (u32x4){pk2(m[0], m[1]), pk2(m[2], m[3]), pk2(m[4], m[5]), pk2(m[6], m[7])};
    }
  }
  const int NC = (8 + 128) * 3 * 3072;
  for (int i = VB * NTHR + tid; i < NC; i += VG * NTHR) {
    const int c = i % 3072, r = (i / 3072) % 3, bb = i / 9216;
    if (bb < 8) p.out[O_CONVP + ((size_t)(l * 8 + bb) * 3 + r) * 3072 + c] = bf2f(p.proj()[(size_t)(bb * 2048 + 2045 + r) * NPJ + c]);
    else p.out[O_CONVS + ((size_t)(l * 128 + bb - 8) * 3 + r) * 3072 + c] = bf2f(p.proj()[(size_t)(MP + (bb - 8) * 8 + 5 + r) * NPJ + c]);
  }
}

#define XB_TMO      128
#define XB_XCNT(j)  (256  + 64 * (j))
#define XB_XSUB(j)  (1280 + 64 * (j))
#define XB_XGEN(j)  (2304 + 64 * (j))
#define XB_TOP      3328
#define XB_TOPGEN   3392
#define XCD_BAR_WORDS 3456
#define XB_SPIN_CAP (1u << 18)
#define LAS __attribute__((address_space(3)))

__device__ __forceinline__ unsigned xb_ld(unsigned* p)              { return __hip_atomic_load(p, __ATOMIC_RELAXED, __HIP_MEMORY_SCOPE_AGENT); }
__device__ __forceinline__ unsigned xb_add(unsigned* p, unsigned v) { return __hip_atomic_fetch_add(p, v, __ATOMIC_RELAXED, __HIP_MEMORY_SCOPE_AGENT); }
__device__ __forceinline__ unsigned xb_xcc_id() { return (unsigned)__builtin_amdgcn_s_getreg((3 << 11) | 20) & 0xFu; }
#define XB_SPIN(cond, bar) do { unsigned _sp = 0; while (cond) { __builtin_amdgcn_s_sleep(1); \
    if ((++_sp & 255u) == 0u) { if (xb_ld(&(bar)[XB_TMO])) break; if (_sp > XB_SPIN_CAP) { atomicAdd(&(bar)[XB_TMO], 1u); break; } } } } while (0)

struct XcdBarrier {
    unsigned* bar; unsigned x;
    volatile LAS unsigned* st;
};

__device__ __forceinline__ XcdBarrier xcd_barrier_post(unsigned* bar, volatile LAS unsigned* st) {
    XcdBarrier b; b.bar = bar; b.x = xb_xcc_id(); b.st = st;
    if (threadIdx.x == 0) (void)xb_add(&bar[XB_XCNT(b.x)], 1u);
    return b;
}
__device__ __forceinline__ void xcd_barrier_complete(unsigned* bar, unsigned x, unsigned& nloc, unsigned& nx) {
    const unsigned G = gridDim.x * gridDim.y * gridDim.z;
    unsigned sum, cnt, mine, sp = 0u;
    for (;;) {
        sum = 0u; cnt = 0u; mine = 0u;
#pragma unroll
        for (unsigned j = 0; j < 16; ++j) { const unsigned c = xb_ld(&bar[XB_XCNT(j)]); sum += c; cnt += (c > 0u) ? 1u : 0u; mine = (j == x) ? c : mine; }
        if (sum == G) break;
        __builtin_amdgcn_s_sleep(1);
        if ((++sp & 255u) == 0u) { if (xb_ld(&bar[XB_TMO])) break; if (sp > XB_SPIN_CAP) { atomicAdd(&bar[XB_TMO], 1u); break; } }
    }
    nloc = mine > 0u ? mine : 1u; nx = cnt > 0u ? cnt : 1u;
}

__device__ __forceinline__ void xcd_barrier(const XcdBarrier& b) {
    asm volatile("s_waitcnt vmcnt(0)" ::: "memory");
    __syncthreads();
    if (threadIdx.x == 0) {
        unsigned* bar = b.bar;
        __builtin_amdgcn_s_waitcnt(0);
        unsigned nloc = b.st[0], nx = b.st[1];
        if (nloc == 0u) { xcd_barrier_complete(bar, b.x, nloc, nx); b.st[0] = nloc; b.st[1] = nx; }
        const unsigned old = xb_add(&bar[XB_XSUB(b.x)], 1u);
        const unsigned gen = old / nloc;
        if (old + 1u == (gen + 1u) * nloc) {
            __builtin_amdgcn_fence(__ATOMIC_RELEASE, "agent");
            asm volatile("s_waitcnt vmcnt(0)" ::: "memory");
            const unsigned og = xb_add(&bar[XB_TOP], 1u);
            const unsigned tg = og / nx;
            if (og + 1u == (tg + 1u) * nx) xb_add(&bar[XB_TOPGEN], 1u);
            else XB_SPIN(xb_ld(&bar[XB_TOPGEN]) == tg, bar);
            __builtin_amdgcn_fence(__ATOMIC_ACQUIRE, "agent");
            xb_add(&bar[XB_XGEN(b.x)], 1u);
            asm volatile("s_waitcnt vmcnt(0)" ::: "memory");
        } else {
            XB_SPIN(xb_ld(&bar[XB_XGEN(b.x)]) == gen, bar);
            __builtin_amdgcn_fence(__ATOMIC_ACQUIRE, "agent");
            asm volatile("s_waitcnt vmcnt(0)" ::: "memory");
        }
    }
    __syncthreads();
}


#define NPHASE_PRE 2
#define NPHASE_L 8
constexpr int LDS_TOTAL = 2 * SMEM_BYTES;
__global__ void __launch_bounds__(512, 2) mega(Params p, int ph_lo, int ph_hi) {
  extern __shared__ __attribute__((aligned(16))) unsigned char lds_all[];
  if (ph_hi < 0) cg::this_grid().sync();
  __shared__ uint4 xb_words;
  if (threadIdx.x == 0) xb_words = make_uint4(0u, 0u, 0u, 0u);
  __syncthreads();
  XcdBarrier xb = xcd_barrier_post(p.bar(), (volatile LAS unsigned*)&xb_words);
  unsigned char* smem = lds_all + VHALF * SMEM_BYTES;
  for (int ph = ph_lo; ph < ph_hi; ++ph) {
    if (ph > ph_lo) xcd_barrier(xb);
    if (ph == 0) { phase_p0(p, smem); continue; }
    if (ph == 1) {
      for (int t = VB; t < NL * 68 * 8; t += VG) {
        const int l = t / 544, r = t % 544;
        EpiArgs e{};
        e.obf = p.pp() + (size_t)l * MTOK * DM; e.ldo = DM;
        gemm_tile<8, 4, 2, 2, EPI_PP>(p.pb() + (size_t)l * MTOK * PLE, PLE, p.wt_proj() + (size_t)l * DM * PLE, PLE, PLE, (r / 8) * 256, (r % 8) * 128, (bf16_t*)smem, e);
      }
      continue;
    }
    const int l = (ph - NPHASE_PRE) / NPHASE_L, s = (ph - NPHASE_PRE) % NPHASE_L;
#ifndef REPMASK
#define REPMASK 0
#endif
    for (int rep = 0; rep < (((REPMASK >> s) & 1) ? 2 : 1); ++rep) {
    if (rep) xcd_barrier(xb);
    switch (s) {
      case 0: {
        EpiArgs e{};
        e.ssq_in = p.ssq0(); e.obf = p.proj(); e.ldo = NPJ; e.of32 = p.logits();
        const bf16_t* Bt = p.wt_in() + (size_t)l * NIN * DM;
        gemm_big_phase<EPI_PROJ>(p.hb(), Bt, DM, MTOK, NPJ, lds_all, smem, e);
        for (int t = VB; t < 272; t += VG)
          gemm_tile<1, 1, 4, 1, EPI_LOGIT, 128>(p.hb(), DM, Bt + (size_t)NPJ * DM, DM, DM, t * 64, 0, (bf16_t*)smem, e);
      } break;
      case 1: {
        const int nB1 = VG == 512 ? 3072 : 3584;
        for (int t = VB; t < nB1; t += VG) {
          if (t < 2048) gdn_prep_item(p, l, t, smem);
          else if (t < 3072) swa_prompt_item(p, l, t - 2048, smem);
          else swa_sample_item(p, l, t - 3072, smem);
        }
      } break;
      case 2: {
        if (VG == 512) {
          if (VB < 256) gdn_scan_item(p, l, VB, smem);
          else {
            gdn_sample_pair(p, l, VB - 256, smem); gdn_sample_pair(p, l, VB, smem);
            swa_sample_item(p, l, (VB - 256) * 2, smem); swa_sample_item(p, l, (VB - 256) * 2 + 1, smem);
          }
        } else {
          for (int t = VB; t < 256 + 512; t += VG) {
            if (t < 256) gdn_scan_item(p, l, t, smem);
            else gdn_sample_pair(p, l, t - 256, smem);
          }
        }
      } break;
      case 3: phase_mix(p, l); break;
      case 4: {
        EpiArgs e{};
        e.h = p.out; e.hb = p.hb2(); e.ssq_out = p.ssq1();
        gemm_big_phase<EPI_RESID>(p.mix(), p.wt_out() + (size_t)l * DM * DM, DM, MTOK, DM, lds_all, smem, e);
      } break;
      case 5: {
        EpiArgs e{};
        e.ssq_in = p.ssq1(); e.obf = p.proj(); e.ldo = DFF;
        gemm_big_phase<EPI_UP>(p.hb2(), p.wt_up() + (size_t)l * DFF * DM, DM, MTOK, DFF, lds_all, smem, e);
      } break;
      case 6: {
        EpiArgs e{};
        e.h = p.out; e.hb = p.hb2(); e.ssq_out = p.ssq2();
        gemm_big_phase<EPI_RESID>(p.proj(), p.wt_down() + (size_t)l * DM * DFF, DFF, MTOK, DM, lds_all, smem, e);
      } break;
      case 7: {
        EpiArgs e{};
        e.h = p.out; e.hb = p.hb(); e.ssq_in = p.ssq2(); e.ssq_out = p.ssq0(); e.pp = p.pp() + (size_t)l * MTOK * DM;
        gemm_big_phase<EPI_PLE>(p.hb2(), p.wt_gate() + (size_t)l * DM * DM, DM, MTOK, DM, lds_all, smem, e);
      } break;
    }
    }
  }
}

extern "C" void kernel_launch(void* const* d_in, const int* in_sizes, int n_in, void* d_out, int out_size, void* d_ws, size_t ws_size,
                              hipStream_t stream) {
  Params p{};
  const float* const* in = (const float* const*)d_in;
  p.x_prompt = in[0]; p.x_sample = in[1]; p.cache_conv = in[2]; p.state_gdn = in[3]; p.cache_k = in[4]; p.cache_v = in[5];
  p.p_prompt = in[6]; p.p_sample = in[7]; p.norm_mix = in[8]; p.w_in = in[9]; p.conv_w = in[10]; p.a_log = in[11]; p.dt_bias = in[12];
  p.gdn_norm = in[13]; p.q_norm = in[14]; p.k_norm = in[15]; p.sinks = in[16]; p.w_out = in[17]; p.norm_ffn = in[18]; p.w_up = in[19];
  p.w_down = in[20]; p.norm_ple = in[21]; p.w_gate = in[22]; p.w_proj = in[23];
  p.out = (float*)d_out;
  p.ws = (unsigned char*)d_ws;
  if (WS_TOTAL > ws_size) { fprintf(stderr, "workspace too small: need %zu have %zu\n", (size_t)WS_TOTAL, ws_size); return; }

  static int grid_blocks = 0;
  if (!grid_blocks) {
    int dev = 0, cus = 0, per_cu = 0;
    (void)hipGetDevice(&dev);
    (void)hipDeviceGetAttribute(&cus, hipDeviceAttributeMultiprocessorCount, dev);
    if (hipFuncSetAttribute((const void*)mega, hipFuncAttributeMaxDynamicSharedMemorySize, LDS_TOTAL) != hipSuccess) { fprintf(stderr, "hipFuncSetAttribute(dynamic LDS %d) failed\n", LDS_TOTAL); grid_blocks = -1; return; }
    (void)hipOccupancyMaxActiveBlocksPerMultiprocessor(&per_cu, (const void*)mega, 512, LDS_TOTAL);
    (void)hipGetLastError();
    grid_blocks = cus;
  }
  if (grid_blocks < 0) return;
  (void)hipMemsetAsync(p.ws + WO_bar, 0, (size_t)XCD_BAR_WORDS * 4, stream);
  int lo = 0, hi = NPHASE_PRE + NL * NPHASE_L;
  void* args[] = {&p, &lo, &hi};
  hipError_t e = hipLaunchCooperativeKernel((void*)mega, dim3(grid_blocks), dim3(512), args, LDS_TOTAL, stream);
  if (e != hipSuccess) fprintf(stderr, "cooperative launch failed: %s (grid %d)\n", hipGetErrorString(e), grid_blocks);
}
```

```cpp
#include <hip/hip_runtime.h>
#include <hip/hip_cooperative_groups.h>
#include <cstdio>
namespace cg = cooperative_groups;

typedef unsigned short bf16_t;
typedef short bf16x8 __attribute__((ext_vector_type(8)));
typedef float f32x4 __attribute__((ext_vector_type(4)));
typedef float f32x2 __attribute__((ext_vector_type(2)));
typedef unsigned u32x4 __attribute__((ext_vector_type(4)));
typedef unsigned u32x2 __attribute__((ext_vector_type(2)));

#define DEVI __device__ __forceinline__
DEVI int opq(int x) { asm volatile("" : "+v"(x)); return x; }

#define VHALF ((int)__builtin_amdgcn_readfirstlane((int)(threadIdx.x >> 8)))
#define VB ((int)blockIdx.x * 2 + VHALF)
#define VG ((int)gridDim.x * 2)
constexpr int NL = 4;
constexpr int MTOK = 17408, MP = 16384, MS = 1024;
constexpr int DM = 1024, NIN = 7696, NPJ = 7680, DFF = 4096, PLE = 256;
constexpr int C_Z = 3072, C_SQ = 4096, C_SK = 5120, C_SV = 5376, C_G = 5632;
constexpr float EPS = 1e-6f;
constexpr int NTHR = 256;
constexpr int SMEM_BYTES = 79872;
constexpr size_t SCR_ITEM = 73728;

constexpr size_t O_YP = 0, O_YS = 16777216, O_CONVP = 17825792, O_GDNP = 18120704, O_KP = 22315008, O_VP = 23363584,
                 O_CONVS = 24412160, O_GDNS = 29130752, O_KS = 96239616, O_VS = 113016832, O_END = 129794048;

constexpr size_t al256(size_t x) { return (x + 255) & ~(size_t)255; }
constexpr size_t WO_wt_in = 0;
constexpr size_t WO_wt_out = WO_wt_in + al256((size_t)NL * NIN * DM * 2);
constexpr size_t WO_wt_up = WO_wt_out + al256((size_t)NL * DM * DM * 2);
constexpr size_t WO_wt_down = WO_wt_up + al256((size_t)NL * DFF * DM * 2);
constexpr size_t WO_wt_gate = WO_wt_down + al256((size_t)NL * DM * DFF * 2);
constexpr size_t WO_wt_proj = WO_wt_gate + al256((size_t)NL * DM * DM * 2);
constexpr size_t WO_hb = WO_wt_proj + al256((size_t)NL * DM * PLE * 2);
constexpr size_t WO_hb2 = WO_hb + al256((size_t)MTOK * DM * 2);
constexpr size_t WO_proj = WO_hb2 + al256((size_t)MTOK * DM * 2);
constexpr size_t WO_scr = WO_proj + al256((size_t)MTOK * NPJ * 2);
constexpr size_t WO_ogdn = WO_scr + al256((size_t)2048 * SCR_ITEM);
constexpr size_t WO_oswa = WO_ogdn + al256((size_t)MTOK * DM * 2);
constexpr size_t WO_mix = WO_oswa + al256((size_t)MTOK * DM * 2);
constexpr size_t WO_pb = WO_mix + al256((size_t)MTOK * DM * 2);
constexpr size_t WO_pp = WO_pb + al256((size_t)NL * MTOK * PLE * 2);
constexpr size_t WO_ssq0 = WO_pp + al256((size_t)NL * MTOK * DM * 2);
constexpr size_t WO_ssq1 = WO_ssq0 + al256((size_t)MTOK * 16 * 4);
constexpr size_t WO_ssq2 = WO_ssq1 + al256((size_t)MTOK * 16 * 4);
constexpr size_t WO_logits = WO_ssq2 + al256((size_t)MTOK * 16 * 4);
constexpr size_t WO_gsc = WO_logits + al256((size_t)MTOK * 16 * 4);
constexpr size_t WO_bar = WO_gsc + al256((size_t)2048 * 4);
constexpr size_t WS_TOTAL = WO_bar + al256((size_t)3456 * 4);
struct Params {
  const float *x_prompt, *x_sample, *cache_conv, *state_gdn, *cache_k, *cache_v, *p_prompt, *p_sample;
  const float *norm_mix, *w_in, *conv_w, *a_log, *dt_bias, *gdn_norm, *q_norm, *k_norm, *sinks, *w_out, *norm_ffn, *w_up, *w_down,
      *norm_ple, *w_gate, *w_proj;
  float* out;
  unsigned char* ws;
  DEVI bf16_t* wt_in() const { return (bf16_t*)(ws + WO_wt_in); }
  DEVI bf16_t* wt_out() const { return (bf16_t*)(ws + WO_wt_out); }
  DEVI bf16_t* wt_up() const { return (bf16_t*)(ws + WO_wt_up); }
  DEVI bf16_t* wt_down() const { return (bf16_t*)(ws + WO_wt_down); }
  DEVI bf16_t* wt_gate() const { return (bf16_t*)(ws + WO_wt_gate); }
  DEVI bf16_t* wt_proj() const { return (bf16_t*)(ws + WO_wt_proj); }
  DEVI bf16_t* hb() const { return (bf16_t*)(ws + WO_hb); }
  DEVI bf16_t* hb2() const { return (bf16_t*)(ws + WO_hb2); }
  DEVI bf16_t* proj() const { return (bf16_t*)(ws + WO_proj); }
  DEVI bf16_t* scr() const { return (bf16_t*)(ws + WO_scr); }
  DEVI bf16_t* ogdn() const { return (bf16_t*)(ws + WO_ogdn); }
  DEVI bf16_t* oswa() const { return (bf16_t*)(ws + WO_oswa); }
  DEVI bf16_t* mix() const { return (bf16_t*)(ws + WO_mix); }
  DEVI bf16_t* pb() const { return (bf16_t*)(ws + WO_pb); }
  DEVI bf16_t* pp() const { return (bf16_t*)(ws + WO_pp); }
  DEVI float* ssq0() const { return (float*)(ws + WO_ssq0); }
  DEVI float* ssq1() const { return (float*)(ws + WO_ssq1); }
  DEVI float* ssq2() const { return (float*)(ws + WO_ssq2); }
  DEVI float* logits() const { return (float*)(ws + WO_logits); }
  DEVI float* gsc() const { return (float*)(ws + WO_gsc); }
  DEVI unsigned* bar() const { return (unsigned*)(ws + WO_bar); }
};

DEVI float shx(float v, int m, int ln) { return __builtin_bit_cast(float, __builtin_amdgcn_ds_bpermute((ln ^ m) << 2, __builtin_bit_cast(int, v))); }
DEVI float shup(float v, int o, int ln) { return __builtin_bit_cast(float, __builtin_amdgcn_ds_bpermute((ln >= o ? ln - o : ln) << 2, __builtin_bit_cast(int, v))); }
DEVI float lo2f(unsigned u) { return __uint_as_float(u << 16); }
DEVI float hi2f(unsigned u) { return __uint_as_float(u & 0xffff0000u); }
DEVI float bf2f(bf16_t v) { return __uint_as_float(((unsigned)v) << 16); }
typedef __bf16 bf16x2_t __attribute__((ext_vector_type(2)));
DEVI unsigned pk2(float lo, float hi) { const f32x2 v = {lo, hi}; const bf16x2_t r = __builtin_convertvector(v, bf16x2_t); return __builtin_bit_cast(unsigned, r); }
DEVI bf16_t f2bf(float f) { return (bf16_t)(pk2(f, 0.f) & 0xffffu); }
DEVI float sigm(float x) { return 1.f / (1.f + __expf(-x)); }
DEVI float silu(float x) { return x * sigm(x); }
DEVI float softplus_f(float x) {
  const float e = __expf(x);
  return x > 20.f ? x : (e < 0.01f ? e * (1.f - 0.5f * e + 0.33333334f * e * e) : __logf(1.f + e));
}
DEVI f32x4 mfma16(bf16x8 a, bf16x8 b, f32x4 c) { return __builtin_amdgcn_mfma_f32_16x16x32_bf16(a, b, c, 0, 0, 0); }
DEVI bf16x8 as_bf(u32x4 v) { return __builtin_bit_cast(bf16x8, v); }
#define UNPACK8(v, f) do { f[0] = lo2f(v.x); f[1] = hi2f(v.x); f[2] = lo2f(v.y); f[3] = hi2f(v.y); f[4] = lo2f(v.z); f[5] = hi2f(v.z); f[6] = lo2f(v.w); f[7] = hi2f(v.w); } while (0)

DEVI int inmap(int n) { return n < 4096 ? n : (n < 7680 ? n + 16 : n - 7680 + 4096); }

__device__ void wconv_tile(const float* __restrict__ src, int ldsrc, int K, int Nd, bf16_t* __restrict__ dst, const float* __restrict__ scale,
                           bool remap, int kt, int nt, float* sm) {
  const int tid = (opq(threadIdx.x) & 255);
  const int nl = tid & 63, kq = tid >> 6;
  const int n = nt * 64 + nl;
  const bool ok = n < Nd;
  const int sc = remap ? inmap(n) : n;
#pragma unroll 4
  for (int r = 0; r < 16; ++r) {
    const int kl = r * 4 + kq, k = kt * 64 + kl;
    float v = 0.f;
    if (ok) { v = src[(size_t)k * ldsrc + sc]; if (scale) v *= scale[k]; }
    sm[kl * 65 + nl] = v;
  }
  __syncthreads();
  const int nr = tid >> 2, ks = (tid & 3) * 16;
  if (nt * 64 + nr < Nd) {
    unsigned w[8];
#pragma unroll
    for (int i = 0; i < 8; ++i) w[i] = pk2(sm[(ks + 2 * i) * 65 + nr], sm[(ks + 2 * i + 1) * 65 + nr]);
    u32x4* d = (u32x4*)(dst + (size_t)(nt * 64 + nr) * K + kt * 64 + ks);
    d[0] = (u32x4){w[0], w[1], w[2], w[3]};
    d[1] = (u32x4){w[4], w[5], w[6], w[7]};
  }
  __syncthreads();
}

__device__ void phase_p0(const Params& p, unsigned char* smem) {
  float* sm = (float*)smem;
  const int tid = (opq(threadIdx.x) & 255), lane = tid & 63, wid = tid >> 6;
  constexpr int T_IN = 16 * 121, T_OUT = 256, T_UP = 1024, T_DOWN = 1024, T_GATE = 256, T_PROJ = 64;
  constexpr int T_L = T_IN + T_OUT + T_UP + T_DOWN + T_GATE + T_PROJ;
  for (int it = VB; it < NL * T_L; it += VG) {
    const int l = it / T_L;
    int r = it % T_L;
    if (r < T_IN) { wconv_tile(p.w_in + (size_t)l * DM * NIN, NIN, DM, NIN, p.wt_in() + (size_t)l * NIN * DM, p.norm_mix + l * DM, true, r % 16, r / 16, sm); continue; }
    r -= T_IN;
    if (r < T_OUT) { wconv_tile(p.w_out + (size_t)l * DM * DM, DM, DM, DM, p.wt_out() + (size_t)l * DM * DM, nullptr, false, r % 16, r / 16, sm); continue; }
    r -= T_OUT;
    if (r < T_UP) { wconv_tile(p.w_up + (size_t)l * DM * DFF, DFF, DM, DFF, p.wt_up() + (size_t)l * DFF * DM, p.norm_ffn + l * DM, false, r % 16, r / 16, sm); continue; }
    r -= T_UP;
    if (r < T_DOWN) { wconv_tile(p.w_down + (size_t)l * DFF * DM, DM, DFF, DM, p.wt_down() + (size_t)l * DM * DFF, nullptr, false, r % 64, r / 64, sm); continue; }
    r -= T_DOWN;
    if (r < T_GATE) { wconv_tile(p.w_gate + (size_t)l * DM * DM, DM, DM, DM, p.wt_gate() + (size_t)l * DM * DM, p.norm_ple + l * DM, false, r % 16, r / 16, sm); continue; }
    r -= T_GATE;
    wconv_tile(p.w_proj + (size_t)l * PLE * DM, DM, PLE, DM, p.wt_proj() + (size_t)l * DM * PLE, nullptr, false, r % 4, r / 4, sm);
  }
  for (int it = VB; it < MTOK / 4; it += VG) {
    const int row = it * 4 + wid;
    const float* src = row < MP ? p.x_prompt + (size_t)row * DM : p.x_sample + (size_t)(row - MP) * DM;
    float* hd = p.out + (size_t)row * DM;
    bf16_t* hbd = p.hb() + (size_t)row * DM;
    float ss = 0.f;
#pragma unroll
    for (int i = 0; i < 4; ++i) {
      const int c = i * 256 + lane * 4;
      const f32x4 v = *(const f32x4*)(src + c);
      ss += v.x * v.x + v.y * v.y + v.z * v.z + v.w * v.w;
      *(f32x4*)(hd + c) = v;
      *(u32x2*)(hbd + c) = (u32x2){pk2(v.x, v.y), pk2(v.z, v.w)};
    }
#pragma unroll
    for (int o = 1; o < 64; o <<= 1) ss += shx(ss, o, lane);
    if (lane < 16) p.ssq0()[(size_t)row * 16 + lane] = lane == 0 ? ss : 0.f;
  }
  const int G = NL * MTOK * 32;
  for (int g = VB * NTHR + tid; g < G; g += VG * NTHR) {
    const int l = g / (MTOK * 32), rem = g % (MTOK * 32), row = rem >> 5, c8 = rem & 31;
    const float* src = row < MP ? p.p_prompt + ((size_t)(l * MP + row) * PLE + c8 * 8) : p.p_sample + ((size_t)(l * MS + row - MP) * PLE + c8 * 8);
    const f32x4 a = *(const f32x4*)src, b = *(const f32x4*)(src + 4);
    *(u32x4*)(p.pb() + (size_t)g * 8) = (u32x4){pk2(a.x, a.y), pk2(a.z, a.w), pk2(b.x, b.y), pk2(b.z, b.w)};
  }
}

enum { EPI_PROJ = 0, EPI_LOGIT = 1, EPI_RESID = 2, EPI_UP = 3, EPI_PLE = 4, EPI_PP = 5 };
struct EpiArgs {
  const float* ssq_in; float* ssq_out; float* h; bf16_t* hb; bf16_t* obf; int ldo; float* of32; const bf16_t* pp;
};

template <int EPI>
DEVI float epi_rs(const EpiArgs& e, int row) {
  if (EPI == EPI_PROJ || EPI == EPI_LOGIT || EPI == EPI_UP || EPI == EPI_PLE) {
    const f32x4* sp = (const f32x4*)(e.ssq_in + (size_t)row * 16);
    const f32x4 a = sp[0], b = sp[1], c = sp[2], d = sp[3];
    const float s = ((a.x + a.y) + (a.z + a.w)) + ((b.x + b.y) + (b.z + b.w)) + ((c.x + c.y) + (c.z + c.w)) + ((d.x + d.y) + (d.z + d.w));
    return rsqrtf(s * (1.f / 1024.f) + EPS);
  }
  return 1.f;
}
template <int EPI>
DEVI void epi_elem(const EpiArgs& e, int row, int col, f32x4 v, float rs, float& sq) {
  if (EPI == EPI_PROJ) {
    v *= rs;
    *(u32x2*)(e.obf + (size_t)row * e.ldo + col) = (u32x2){pk2(v.x, v.y), pk2(v.z, v.w)};
  } else if (EPI == EPI_LOGIT) {
    v *= rs;
    *(f32x4*)(e.of32 + (size_t)row * 16 + col) = v;
  } else if (EPI == EPI_PP) {
    *(u32x2*)(e.obf + (size_t)row * e.ldo + col) = (u32x2){pk2(v.x, v.y), pk2(v.z, v.w)};
  } else if (EPI == EPI_UP) {
    v *= rs;
    v.x = fmaxf(v.x, 0.f); v.y = fmaxf(v.y, 0.f); v.z = fmaxf(v.z, 0.f); v.w = fmaxf(v.w, 0.f);
    v = v * v;
    *(u32x2*)(e.obf + (size_t)row * e.ldo + col) = (u32x2){pk2(v.x, v.y), pk2(v.z, v.w)};
  } else {
    float* hp = e.h + (size_t)row * DM + col;
    f32x4 hv = *(const f32x4*)hp;
    if (EPI == EPI_RESID) {
      hv += v;
    } else {
      const u32x2 pv = *(const u32x2*)(e.pp + (size_t)row * DM + col);
      hv.x += sigm(v.x * rs) * lo2f(pv.x); hv.y += sigm(v.y * rs) * hi2f(pv.x);
      hv.z += sigm(v.z * rs) * lo2f(pv.y); hv.w += sigm(v.w * rs) * hi2f(pv.y);
    }
    *(f32x4*)hp = hv;
    *(u32x2*)(e.hb + (size_t)row * DM + col) = (u32x2){pk2(hv.x, hv.y), pk2(hv.z, hv.w)};
    sq += hv.x * hv.x + hv.y * hv.y + hv.z * hv.z + hv.w * hv.w;
  }
}

template <int WMT, int WNT, int WGM, int WGN, int EPI, int BK = 32, bool KSPLIT = false>
__device__ __forceinline__ void gemm_tile(const bf16_t* __restrict__ A, int lda, const bf16_t* __restrict__ Bt, int ldb, int K, int m0, int n0,
                                          bf16_t* lds, const EpiArgs& e) {
  constexpr int BM = WGM * WMT * 16, BN = WGN * WNT * 16, LDR = BK + 8;
  constexpr int STAGE = (BM + BN) * LDR;
  constexpr int PPR = BK / 8, RPI = NTHR / PPR;
  constexpr int NA = BM / RPI, NB = (BN + RPI - 1) / RPI;
  const int tid = (opq(threadIdx.x) & 255), lane = tid & 63, wid = tid >> 6;
  const int wm = wid / WGN, wn = wid % WGN;
  const int fr = lane & 15, fq = lane >> 4;
  f32x4 acc[WMT][WNT];
#pragma unroll
  for (int i = 0; i < WMT; ++i)
#pragma unroll
    for (int j = 0; j < WNT; ++j) acc[i][j] = (f32x4){0.f, 0.f, 0.f, 0.f};
  u32x4 ra0[NA], rb0[NB], ra1[NA], rb1[NB];
  const int khalf = KSPLIT ? VHALF : 0;
  const int nk = (KSPLIT ? K / 2 : K) / BK;
  const int prow = tid / PPR, ppc = tid % PPR;
  const unsigned ta = (unsigned)(prow * lda + ppc * 8) * 2u, tb = (unsigned)(prow * ldb + ppc * 8) * 2u;
  const char* Au = (const char*)(A + (size_t)m0 * lda + (size_t)khalf * (K / 2));
  const char* Bu = (const char*)(Bt + (size_t)n0 * ldb + (size_t)khalf * (K / 2));
#define BGUARD(i) (BN >= RPI * ((i) + 1) || prow + (i) * RPI < BN)
#define GLOAD(kt, RA, RB) do { \
    _Pragma("unroll") for (int i = 0; i < NA; ++i) RA[i] = *(const u32x4*)(Au + ((size_t)i * RPI * lda + (size_t)(kt) * BK) * 2 + ta); \
    _Pragma("unroll") for (int i = 0; i < NB; ++i) if (BGUARD(i)) RB[i] = *(const u32x4*)(Bu + ((size_t)i * RPI * ldb + (size_t)(kt) * BK) * 2 + tb); \
  } while (0)
#define LSTORE(st, RA, RB) do { bf16_t* sA_ = lds + (st) * STAGE; bf16_t* sB_ = sA_ + BM * LDR; \
    _Pragma("unroll") for (int i = 0; i < NA; ++i) *(u32x4*)(sA_ + (prow + i * RPI) * LDR + ppc * 8) = RA[i]; \
    _Pragma("unroll") for (int i = 0; i < NB; ++i) if (BGUARD(i)) *(u32x4*)(sB_ + (prow + i * RPI) * LDR + ppc * 8) = RB[i]; \
  } while (0)
#define COMPUTE(st) do { const bf16_t* sA = lds + (st) * STAGE; const bf16_t* sB = sA + BM * LDR; \
    _Pragma("unroll") for (int kk = 0; kk < BK / 32; ++kk) { \
      bf16x8 bfr[WNT]; \
      _Pragma("unroll") for (int nt = 0; nt < WNT; ++nt) bfr[nt] = *(const bf16x8*)(sB + (wn * WNT * 16 + nt * 16 + fr) * LDR + kk * 32 + fq * 8); \
      _Pragma("unroll") for (int mt = 0; mt < WMT; ++mt) { \
        const bf16x8 af = *(const bf16x8*)(sA + (wm * WMT * 16 + mt * 16 + fr) * LDR + kk * 32 + fq * 8); \
        _Pragma("unroll") for (int nt = 0; nt < WNT; ++nt) acc[mt][nt] = mfma16(bfr[nt], af, acc[mt][nt]); } } \
  } while (0)
  GLOAD(0, ra0, rb0);
  GLOAD(1, ra1, rb1);
  LSTORE(0, ra0, rb0);
  __syncthreads();
  for (int kt = 0; kt < nk; kt += 2) {
    const int k2 = kt + 2 < nk ? kt + 2 : nk - 2;
    GLOAD(k2, ra0, rb0);
    COMPUTE(0);
    LSTORE(1, ra1, rb1);
    __syncthreads();
    GLOAD(k2 + 1, ra1, rb1);
    COMPUTE(1);
    LSTORE(0, ra0, rb0);
    __syncthreads();
  }
#undef BGUARD
#undef COMPUTE
#undef GLOAD
#undef LSTORE
  if (KSPLIT) {
    f32x4* red = (f32x4*)((unsigned char*)lds + (khalf ? 0 : SMEM_BYTES));
    if (khalf == 1) {
#pragma unroll
      for (int i = 0; i < WMT; ++i)
#pragma unroll
        for (int j = 0; j < WNT; ++j) red[((wid * WMT + i) * WNT + j) * 64 + lane] = acc[i][j];
    }
    __syncthreads();
    if (khalf == 0) {
#pragma unroll
      for (int i = 0; i < WMT; ++i)
#pragma unroll
        for (int j = 0; j < WNT; ++j) acc[i][j] += red[((wid * WMT + i) * WNT + j) * 64 + lane];
    }
  }
  if (!KSPLIT || khalf == 0) {
#pragma unroll
  for (int mt = 0; mt < WMT; ++mt) {
    const int row = m0 + wm * WMT * 16 + mt * 16 + fr;
    const float rs = epi_rs<EPI>(e, row);
    float sq = 0.f;
#pragma unroll
    for (int nt = 0; nt < WNT; ++nt) epi_elem<EPI>(e, row, n0 + wn * WNT * 16 + nt * 16 + fq * 4, acc[mt][nt], rs, sq);
    if (EPI == EPI_RESID || EPI == EPI_PLE) {
      sq += shx(sq, 16, lane);
      sq += shx(sq, 32, lane);
      if (fq == 0) e.ssq_out[(size_t)row * 16 + (n0 / BN) * WGN + wn] = sq;
    }
  }
  }
  if (KSPLIT) __syncthreads();
}

namespace pg8 {
#define PG8_LAS __attribute__((address_space(3)))
typedef unsigned short bf16_t;
typedef short bf16x8 __attribute__((ext_vector_type(8)));
typedef float f32x4 __attribute__((ext_vector_type(4)));
typedef unsigned u32x4 __attribute__((ext_vector_type(4)));
constexpr int BM = 256, BK = 64, HALF = 128, HTB = HALF * BK * 2  , STAGE_BYTES = 8 * HTB, NXCD = 8, WGM = 8;

__host__ __device__ __forceinline__ int lds_byte(int r, int c) { const int st = (r >> 4) * 2 + (c >> 5), rr = r & 15, cc = c & 31, ob = rr * 64 + cc * 2; return st * 1024 + (ob ^ (((ob >> 9) & 1) << 5)); }
__host__ __device__ __forceinline__ void stage_rc(int b, int& R, int& C) { const int st = b / 1024, sb = b % 1024, swz = sb ^ (((sb >> 9) & 1) << 5); R = (st >> 1) * 16 + swz / 64; C = (st & 1) * 32 + (swz % 64) / 2; }
__host__ __device__ __forceinline__ int perm32(int rho) { const int n = rho >> 4, i = rho & 15; return 8 * (i >> 2) + 4 * n + (i & 3); }

struct Unit { int pm, pn; };
struct Gemm { const bf16_t* A; const bf16_t* Bt; int M, N, K; };

template <class Epi, class Sched, bool STAMP = false>
__device__ __forceinline__ void gemm_phase(PG8_LAS unsigned char* lds, const Gemm g, const Sched& S, const Epi& E, unsigned long long* stamps) {
    const int tid = opq((int)threadIdx.x), wid = __builtin_amdgcn_readfirstlane(tid >> 6), lane = tid & 63, wr = wid >> 2, wc = wid & 3, fr = lane & 15, fq = lane >> 4;
    const int K = g.K, nt = K / BK;
    int ts_lo = 0, ts_hi = 0, nts = 0; const unsigned long long rt_entry = STAMP ? (unsigned long long)wall_clock64() : 0ull;
#define PG8_STAMP() do { if (STAMP && wid == 0 && nts < 64) { const unsigned long long _c = (unsigned long long)clock64(); \
        ts_lo = (lane == nts) ? (int)(unsigned)_c : ts_lo; ts_hi = (lane == nts) ? (int)(unsigned)(_c >> 32) : ts_hi; ++nts; } } while (0)
    PG8_STAMP();
    unsigned voffA[2], voffB[2];
#pragma unroll
    for (int i = 0; i < 2; ++i) { int R, C; stage_rc(tid * 16 + i * 8192, R, C); const int Rb = Epi::PERM ? ((R & ~31) + perm32(R & 31)) : R;
        voffA[i] = (unsigned)(R * K + C) * 2u; voffB[i] = (unsigned)(Rb * K + C) * 2u; }
    const size_t kstep = (size_t)(BK * 2);
    const size_t hstep = (size_t)HALF * K * 2;
    const size_t tstep = 2 * hstep;
    const unsigned ldsw = (unsigned)wid * 1024u;
    const int aoff = lds_byte(wr * 64 + fr, fq * 8), boff = lds_byte(wc * 32 + fr, fq * 8);
#define PG8_SA(b, h) (((b) * 2 + (h)) * HTB)
#define PG8_SB(b, h) ((4 + (b) * 2 + (h)) * HTB)
#define PG8_STAGE(bufoff, gbase, voff) do { _Pragma("unroll") for (int _i = 0; _i < 2; ++_i) \
        __builtin_amdgcn_global_load_lds((const unsigned*)((const char*)(gbase) + (voff)[_i]), (PG8_LAS unsigned*)(lds + (bufoff) + ldsw + _i * 8192), 16, 0, 0); } while (0)
#define PG8_LDA(dst, b, h) do { _Pragma("unroll") for (int m = 0; m < 4; ++m) _Pragma("unroll") for (int k = 0; k < 2; ++k) dst[m][k] = *(const PG8_LAS bf16x8*)(lds + PG8_SA(b, h) + aoff + m * 2048 + k * 1024); } while (0)
#define PG8_LDB(dst, b, h) do { _Pragma("unroll") for (int n = 0; n < 2; ++n) _Pragma("unroll") for (int k = 0; k < 2; ++k) dst[n][k] = *(const PG8_LAS bf16x8*)(lds + PG8_SB(b, h) + boff + n * 2048 + k * 1024); } while (0)
#define PG8_MMA(ai, bj, At, Bt) do { __builtin_amdgcn_s_setprio(1); _Pragma("unroll") for (int m = 0; m < 4; ++m) _Pragma("unroll") for (int n = 0; n < 2; ++n) _Pragma("unroll") for (int k = 0; k < 2; ++k) \
        acc[ai][bj][m][n] = __builtin_amdgcn_mfma_f32_16x16x32_bf16(Bt[n][k], At[m][k], acc[ai][bj][m][n], 0, 0, 0); __builtin_amdgcn_s_setprio(0); } while (0)
#define PG8_WAIT_V(n) asm volatile("s_waitcnt vmcnt(" #n ")" ::: "memory")
#define PG8_WAIT_L(n) asm volatile("s_waitcnt lgkmcnt(" #n ")" ::: "memory")
#define PG8_BAR __builtin_amdgcn_s_barrier()
#define PG8_SCHED __builtin_amdgcn_sched_barrier(0)
    Unit cur, nxt; int ui = 0;
    if (!S.next(0, cur)) return;
    f32x4 acc[2][2][4][2];
#pragma unroll
    for (int a = 0; a < 2; ++a)
#pragma unroll
        for (int b = 0; b < 2; ++b)
#pragma unroll
            for (int m = 0; m < 4; ++m)
#pragma unroll
                for (int n = 0; n < 2; ++n) acc[a][b][m][n] = (f32x4){0.f, 0.f, 0.f, 0.f};
    bf16x8 At[4][2], B0[2][2], B1[2][2];
    const char* cA = (const char*)g.A + (size_t)cur.pm * tstep; const char* cB = (const char*)g.Bt + (size_t)cur.pn * tstep;
    S.a_ready(cur);
    PG8_STAGE(PG8_SB(0, 0), cB, voffB); PG8_STAGE(PG8_SA(0, 0), cA, voffA); PG8_STAGE(PG8_SB(0, 1), cB + hstep, voffB); PG8_STAGE(PG8_SA(0, 1), cA + hstep, voffA);
    if (wr == 1) PG8_BAR;
    PG8_WAIT_V(4); PG8_BAR;
    PG8_STAGE(PG8_SB(1, 0), cB + kstep, voffB); PG8_STAGE(PG8_SA(1, 0), cA + kstep, voffA); PG8_STAGE(PG8_SB(1, 1), cB + hstep + kstep, voffB);
    PG8_WAIT_V(6); PG8_BAR;
    PG8_STAMP();
    for (;;) {
        const bool has_next = S.next(ui + 1, nxt);
        const char* nA = has_next ? (const char*)g.A + (size_t)nxt.pm * tstep : cA; const char* nB = has_next ? (const char*)g.Bt + (size_t)nxt.pn * tstep : cB;
        for (int t = 0; t < nt; t += 2) {
            const bool last = (t == nt - 2);
            const char* a1 = cA + (size_t)(t + 1) * kstep;
            const char* a2 = last ? nA : cA + (size_t)(t + 2) * kstep; const char* b2 = last ? nB : cB + (size_t)(t + 2) * kstep;
            const char* a3 = a2 + kstep; const char* b3 = b2 + kstep;
            if (last && has_next) S.a_ready(nxt);
            PG8_LDB(B0, 0, 0); PG8_SCHED; PG8_LDA(At, 0, 0); PG8_STAGE(PG8_SA(1, 1), a1 + hstep, voffA);
            PG8_WAIT_L(8); PG8_BAR; PG8_WAIT_L(0); PG8_MMA(0, 0, At, B0); PG8_BAR; PG8_SCHED;
            PG8_LDB(B1, 0, 1); PG8_STAGE(PG8_SB(0, 0), b2, voffB);
            PG8_BAR; PG8_WAIT_L(0); PG8_MMA(0, 1, At, B1); PG8_BAR;
            PG8_LDA(At, 0, 1); PG8_STAGE(PG8_SA(0, 0), a2, voffA);
            PG8_BAR; PG8_WAIT_L(0); PG8_MMA(1, 0, At, B0); PG8_BAR; PG8_SCHED;
            PG8_STAGE(PG8_SB(0, 1), b2 + hstep, voffB);
            PG8_WAIT_V(6); PG8_BAR; PG8_MMA(1, 1, At, B1); PG8_BAR;
            PG8_LDB(B0, 1, 0); PG8_SCHED; PG8_LDA(At, 1, 0); PG8_STAGE(PG8_SA(0, 1), a2 + hstep, voffA);
            PG8_WAIT_L(8); PG8_BAR; PG8_WAIT_L(0); PG8_MMA(0, 0, At, B0); PG8_BAR; PG8_SCHED;
            PG8_LDB(B1, 1, 1); PG8_STAGE(PG8_SB(1, 0), b3, voffB);
            PG8_BAR; PG8_WAIT_L(0); PG8_MMA(0, 1, At, B1); PG8_BAR;
            PG8_LDA(At, 1, 1); PG8_STAGE(PG8_SA(1, 0), a3, voffA);
            PG8_BAR; PG8_WAIT_L(0); PG8_MMA(1, 0, At, B0); PG8_BAR; PG8_SCHED;
            PG8_STAGE(PG8_SB(1, 1), b3 + hstep, voffB);
            PG8_WAIT_V(6); PG8_BAR; PG8_MMA(1, 1, At, B1); PG8_BAR;
        }
        PG8_STAMP();
        if constexpr (!Epi::AFTER_DRAIN) { E(acc, cur, wr, wc, fr, fq); S.done(cur); }
        PG8_STAMP();
        if (!has_next) break;
#pragma unroll
        for (int a = 0; a < 2; ++a)
#pragma unroll
            for (int b = 0; b < 2; ++b)
#pragma unroll
                for (int m = 0; m < 4; ++m)
#pragma unroll
                    for (int n = 0; n < 2; ++n) acc[a][b][m][n] = (f32x4){0.f, 0.f, 0.f, 0.f};
        cur = nxt; cA = nA; cB = nB; ++ui;
    }
    PG8_WAIT_V(0);
    if (wr == 0) PG8_BAR;
    PG8_BAR;
    if constexpr (Epi::AFTER_DRAIN) { E.fused(acc, cur, wr, wc, fr, fq, lds, wid, lane); S.done(cur); }
    PG8_STAMP();
    if (STAMP && wid == 0) { stamps[lane] = lane < nts ? (((unsigned long long)(unsigned)ts_hi << 32) | (unsigned)ts_lo) : 0ull;
        if (lane == 62) stamps[62] = rt_entry; if (lane == 63) stamps[63] = (unsigned long long)wall_clock64(); }
#undef PG8_STAMP
#undef PG8_SA
#undef PG8_SB
#undef PG8_STAGE
#undef PG8_LDA
#undef PG8_LDB
#undef PG8_MMA
#undef PG8_WAIT_V
#undef PG8_WAIT_L
#undef PG8_BAR
#undef PG8_SCHED
}
}

struct RowSched {
  int nN, nLimit, G, c;
  __device__ __forceinline__ bool next(int i, pg8::Unit& u) const { const int L = i * G + c; if (L >= nLimit) return false; u.pm = L / nN; u.pn = L - u.pm * nN; return true; }
  __device__ __forceinline__ void a_ready(const pg8::Unit&) const {}
  __device__ __forceinline__ void done(const pg8::Unit&) const {}
};
template <int EPI> struct BigEpi {
  static constexpr bool PERM = false, AFTER_DRAIN = false;
  EpiArgs e;
  __device__ __forceinline__ void operator()(const f32x4 (&acc)[2][2][4][2], const pg8::Unit& u, int wr, int wc, int fr, int fq) const {
    const int lane = fq * 16 + fr;
#pragma unroll
    for (int ai = 0; ai < 2; ++ai)
#pragma unroll
      for (int m = 0; m < 4; ++m) {
        const int row = u.pm * 256 + ai * 128 + wr * 64 + m * 16 + fr;
        const float rs = epi_rs<EPI>(e, row);
        float sq = 0.f;
#pragma unroll
        for (int bj = 0; bj < 2; ++bj)
#pragma unroll
          for (int n = 0; n < 2; ++n) epi_elem<EPI>(e, row, u.pn * 256 + bj * 128 + wc * 32 + n * 16 + fq * 4, acc[ai][bj][m][n], rs, sq);
        if (EPI == EPI_RESID || EPI == EPI_PLE) {
          sq += shx(sq, 16, lane);
          sq += shx(sq, 32, lane);
          if (fq == 0) e.ssq_out[(size_t)row * 16 + u.pn * 4 + wc] = sq;
        }
      }
  }
};

template <int EPI>
__device__ void gemm_big_phase(const bf16_t* A, const bf16_t* Bt, int K, int M, int N, unsigned char* lds_all, unsigned char* smem_half, const EpiArgs& e) {
  const int nM = M / 256, nN = N / 256, nU = nM * nN, G = gridDim.x;
  const int L = nU % G;
  const int nLimit = (L > 0 && L <= G / 4) ? nU - L : nU;
  RowSched S; S.nN = nN; S.nLimit = nLimit; S.G = G; S.c = blockIdx.x;
  pg8::Gemm g; g.A = A; g.Bt = Bt; g.M = M; g.N = N; g.K = K;
  BigEpi<EPI> E; E.e = e;
  pg8::gemm_phase<BigEpi<EPI>, RowSched>((PG8_LAS unsigned char*)lds_all, g, S, E, nullptr);
  __syncthreads();
  const int nSmall = (nU - nLimit) * 16;
  if (nSmall <= G && K >= 512) {
    for (int st = blockIdx.x; st < nSmall; st += G) {
      const int u = nLimit + (st >> 4), sub = st & 15, pm = u / nN, pn = u - pm * nN;
      gemm_tile<1, 4, 4, 1, EPI, 128, true>(A, K, Bt, K, K, pm * 256 + (sub >> 2) * 64, pn * 256 + (sub & 3) * 64, (bf16_t*)smem_half, e);
    }
  } else {
    for (int st = VB; st < nSmall; st += VG) {
      const int u = nLimit + (st >> 4), sub = st & 15, pm = u / nN, pn = u - pm * nN;
      gemm_tile<1, 4, 4, 1, EPI, 128>(A, K, Bt, K, K, pm * 256 + (sub >> 2) * 64, pn * 256 + (sub & 3) * 64, (bf16_t*)smem_half, e);
    }
  }
}


template <int I, int J4>
DEVI void solve_sub4(float& r, const float (&x)[64], const float* Am) {
  if constexpr (J4 * 4 < I) {
    const f32x4 a = *(const f32x4*)(Am + I * 64 + J4 * 4);
    if constexpr (J4 * 4 + 0 < I) r -= a.x * x[J4 * 4 + 0];
    if constexpr (J4 * 4 + 1 < I) r -= a.y * x[J4 * 4 + 1];
    if constexpr (J4 * 4 + 2 < I) r -= a.z * x[J4 * 4 + 2];
    if constexpr (J4 * 4 + 3 < I) r -= a.w * x[J4 * 4 + 3];
    solve_sub4<I, J4 + 1>(r, x, Am);
  }
}
template <int I>
DEVI void solve_rows(float (&x)[64], const float* Am, const bf16_t* src, const float* sc) {
  if constexpr (I < 64) {
    float r = bf2f(src[I * 136]) * sc[I];
    solve_sub4<I, 0>(r, x, Am);
    x[I] = r;
    asm volatile("" ::: "memory");
    solve_rows<I + 1>(x, Am, src, sc);
  }
}

__device__ void gdn_prep_item(const Params& p, int l, int item, unsigned char* smem) {
  const int tid = (opq(threadIdx.x) & 255), lane = tid & 63, wid = tid >> 6, fr = lane & 15, fq = lane >> 4;
  const int h = item & 7, n = (item >> 3) & 31, b = item >> 8;
  const int tok0 = b * 2048 + n * 64;
  bf16_t* qh = (bf16_t*)smem;
  bf16_t* kh = qh + 64 * 136;
  bf16_t* vh = kh + 64 * 136;
  float* Am = (float*)(vh + 64 * 136);
  float* sbeta = Am + 64 * 64;
  float* sgc = sbeta + 64;
  float* sbe = sgc + 64;
  unsigned char* scr = (unsigned char*)p.scr() + (size_t)item * SCR_ITEM;
  bf16_t* g_uT = (bf16_t*)scr;
  bf16_t* g_w = (bf16_t*)(scr + 16384);
  bf16_t* g_qg = (bf16_t*)(scr + 32768);
  bf16_t* g_kgT = (bf16_t*)(scr + 49152);
  bf16_t* g_qk = (bf16_t*)(scr + 65536);

  if (wid == 0) {
    const float* lg = p.logits() + (size_t)(tok0 + lane) * 16;
    const float bl = lg[h], al = lg[8 + h];
    const float x = al + p.dt_bias[l * 8 + h];
    const float sp = softplus_f(x);
    float g = -__expf(p.a_log[l * 8 + h]) * sp;
#pragma unroll
    for (int o = 1; o < 64; o <<= 1) { const float t = shup(g, o, lane); if (lane >= o) g += t; }
    sbeta[lane] = sigm(bl);
    sgc[lane] = g;
    sbe[lane] = sigm(bl) * __expf(g);
  }
  u32x4 rwall[3][7];
#pragma unroll
  for (int sect = 0; sect < 3; ++sect)
#pragma unroll
    for (int r = 0; r < 7; ++r) {
      const int tl = n * 64 + wid * 16 + fq * 4 - 3 + r;
      rwall[sect][r] = (u32x4){0u, 0u, 0u, 0u};
      if (tl >= 0) rwall[sect][r] = *(const u32x4*)(p.proj() + (size_t)(b * 2048 + tl) * NPJ + sect * 1024 + h * 128 + fr * 8);
    }
#pragma unroll
  for (int sect = 0; sect < 3; ++sect) {
    const int ch0 = sect * 1024 + h * 128 + fr * 8;
    float cw[4][8];
#pragma unroll
    for (int j = 0; j < 4; ++j) {
      const f32x4 a = *(const f32x4*)(p.conv_w + (size_t)(l * 4 + j) * 3072 + ch0), c = *(const f32x4*)(p.conv_w + (size_t)(l * 4 + j) * 3072 + ch0 + 4);
      cw[j][0] = a.x; cw[j][1] = a.y; cw[j][2] = a.z; cw[j][3] = a.w; cw[j][4] = c.x; cw[j][5] = c.y; cw[j][6] = c.z; cw[j][7] = c.w;
    }
    const int ib = wid * 16 + fq * 4;
#pragma unroll
    for (int it = 0; it < 4; ++it) {
      float o[8];
#pragma unroll
      for (int c = 0; c < 8; ++c) o[c] = 0.f;
#pragma unroll
      for (int j = 0; j < 4; ++j) {
        float f[8];
        UNPACK8(rwall[sect][it + j], f);
#pragma unroll
        for (int c = 0; c < 8; ++c) o[c] += f[c] * cw[j][c];
      }
      float ss = 0.f;
#pragma unroll
      for (int c = 0; c < 8; ++c) { o[c] = silu(o[c]); ss += o[c] * o[c]; }
      if (sect < 2) {
        ss += shx(ss, 1, lane); ss += shx(ss, 2, lane); ss += shx(ss, 4, lane); ss += shx(ss, 8, lane);
        float rn = rsqrtf(ss + EPS);
        if (sect == 0) rn *= 0.08838834764831845f;
#pragma unroll
        for (int c = 0; c < 8; ++c) o[c] *= rn;
      }
      const u32x4 pk = (u32x4){pk2(o[0], o[1]), pk2(o[2], o[3]), pk2(o[4], o[5]), pk2(o[6], o[7])};
      bf16_t* dst = sect == 0 ? qh + (ib + it) * 136 + fr * 8 : (sect == 1 ? kh + (ib + it) * 136 + fr * 8 : vh + (ib + it) * 136 + fr * 8);
      *(u32x4*)dst = pk;
    }
  }
  __syncthreads();
  {
    const int i = wid * 16 + fr;
    const float gi = sgc[i], bi = sbeta[i];
    bf16x8 kx[4], qx[4];
#pragma unroll
    for (int ks = 0; ks < 4; ++ks) {
      kx[ks] = *(const bf16x8*)(kh + i * 136 + ks * 32 + fq * 8);
      qx[ks] = *(const bf16x8*)(qh + i * 136 + ks * 32 + fq * 8);
    }
#pragma unroll
    for (int jt = 0; jt < 4; ++jt) {
      f32x4 akk = (f32x4){0.f, 0.f, 0.f, 0.f}, aqk = (f32x4){0.f, 0.f, 0.f, 0.f};
      if (jt <= wid) {
#pragma unroll
        for (int ks = 0; ks < 4; ++ks) {
          const bf16x8 kj = *(const bf16x8*)(kh + (jt * 16 + fr) * 136 + ks * 32 + fq * 8);
          akk = mfma16(kj, kx[ks], akk);
          aqk = mfma16(kj, qx[ks], aqk);
        }
      }
      const int j0 = jt * 16 + fq * 4;
      float av[4], qv[4];
#pragma unroll
      for (int jj = 0; jj < 4; ++jj) {
        const int j = j0 + jj;
        const float dec = j <= i ? __expf(gi - sgc[j]) : 0.f;
        av[jj] = j < i ? bi * akk[jj] * dec : 0.f;
        qv[jj] = aqk[jj] * dec;
      }
      *(f32x4*)(Am + i * 64 + j0) = (f32x4){av[0], av[1], av[2], av[3]};
      *(u32x2*)(g_qk + i * 64 + j0) = (u32x2){pk2(qv[0], qv[1]), pk2(qv[2], qv[3])};
    }
  }
  __syncthreads();
  {
    float x[64];
    const bool isu = tid < 128;
    const int cc = tid & 127;
    solve_rows<0>(x, Am, (isu ? vh : kh) + cc, isu ? sbeta : sbe);
    if (isu) {
      u32x4* d = (u32x4*)(g_uT + cc * 64);
#pragma unroll
      for (int q = 0; q < 8; ++q) d[q] = (u32x4){pk2(x[q * 8], x[q * 8 + 1]), pk2(x[q * 8 + 2], x[q * 8 + 3]), pk2(x[q * 8 + 4], x[q * 8 + 5]), pk2(x[q * 8 + 6], x[q * 8 + 7])};
    } else {
#pragma unroll
      for (int i = 0; i < 64; ++i) g_w[i * 128 + cc] = f2bf(x[i]);
    }
  }
  {
    const float gl = sgc[63];
#pragma unroll
    for (int q = 0; q < 4; ++q) {
      const int pc = tid + q * 256, i = pc >> 4, c8 = pc & 15;
      const u32x4 v = *(const u32x4*)(qh + i * 136 + c8 * 8);
      float f[8];
      UNPACK8(v, f);
      const float s = __expf(sgc[i]);
      *(u32x4*)(g_qg + i * 128 + c8 * 8) = (u32x4){pk2(f[0] * s, f[1] * s), pk2(f[2] * s, f[3] * s), pk2(f[4] * s, f[5] * s), pk2(f[6] * s, f[7] * s)};
    }
    if (tid >= 128) {
      const int dk = tid - 128;
      u32x4* d = (u32x4*)(g_kgT + dk * 64);
#pragma unroll
      for (int q = 0; q < 8; ++q) {
        float f[8];
#pragma unroll
        for (int c = 0; c < 8; ++c) { const int i = q * 8 + c; f[c] = bf2f(kh[i * 136 + dk]) * __expf(gl - sgc[i]); }
        d[q] = (u32x4){pk2(f[0], f[1]), pk2(f[2], f[3]), pk2(f[4], f[5]), pk2(f[6], f[7])};
      }
    }
    if (tid == 0) p.gsc()[item] = __expf(gl);
  }
  __syncthreads();
}

__device__ void gdn_scan_item(const Params& p, int l, int item, unsigned char* smem) {
  const int tid = (opq(threadIdx.x) & 255), lane = tid & 63, wid = tid >> 6, fr = lane & 15, fq = lane >> 4;
  const int dvs = item & 3, h = (item >> 2) & 7, b = item >> 5;
  bf16_t* ST = (bf16_t*)smem;
  bf16_t* VT = ST + 2 * 32 * 136;
  f32x4 S[2][2];
#pragma unroll
  for (int a = 0; a < 2; ++a)
#pragma unroll
    for (int c = 0; c < 2; ++c) S[a][c] = (f32x4){0.f, 0.f, 0.f, 0.f};
  __syncthreads();
  bf16x8 fw[4], fqg[4], fqk[2], fkg[2][2];
  u32x2 fu[2];
  float gs;
  bf16x8 nw[4], nqg[4], nqk[2], nkg[2][2];
  u32x2 nu[2];
  float ngs;
#define SCAN_LOAD(n_, W, QG, QK, KG, U, GS) do { \
    const int it_ = ((b * 32 + (n_)) << 3) + h; \
    const unsigned char* scr_ = (const unsigned char*)p.scr() + (size_t)it_ * SCR_ITEM; \
    const bf16_t* g_uT = (const bf16_t*)scr_; const bf16_t* g_w = (const bf16_t*)(scr_ + 16384); const bf16_t* g_qg = (const bf16_t*)(scr_ + 32768); \
    const bf16_t* g_kgT = (const bf16_t*)(scr_ + 49152); const bf16_t* g_qk = (const bf16_t*)(scr_ + 65536); \
    _Pragma("unroll") for (int ks = 0; ks < 4; ++ks) { \
      W[ks] = *(const bf16x8*)(g_w + (wid * 16 + fr) * 128 + ks * 32 + fq * 8); \
      QG[ks] = *(const bf16x8*)(g_qg + (wid * 16 + fr) * 128 + ks * 32 + fq * 8); } \
    _Pragma("unroll") for (int ks = 0; ks < 2; ++ks) { \
      QK[ks] = *(const bf16x8*)(g_qk + (wid * 16 + fr) * 64 + ks * 32 + fq * 8); \
      _Pragma("unroll") for (int mt = 0; mt < 2; ++mt) KG[mt][ks] = *(const bf16x8*)(g_kgT + ((2 * wid + mt) * 16 + fr) * 64 + ks * 32 + fq * 8); } \
    _Pragma("unroll") for (int nt = 0; nt < 2; ++nt) U[nt] = *(const u32x2*)(g_uT + (dvs * 32 + nt * 16 + fr) * 64 + wid * 16 + fq * 4); \
    GS = p.gsc()[it_]; } while (0)
  SCAN_LOAD(0, nw, nqg, nqk, nkg, nu, ngs);
  for (int n = 0; n < 32; ++n) {
#pragma unroll
    for (int ks = 0; ks < 4; ++ks) { fw[ks] = nw[ks]; fqg[ks] = nqg[ks]; }
#pragma unroll
    for (int ks = 0; ks < 2; ++ks) { fqk[ks] = nqk[ks]; fkg[0][ks] = nkg[0][ks]; fkg[1][ks] = nkg[1][ks]; }
    fu[0] = nu[0]; fu[1] = nu[1]; gs = ngs;
    if (n + 1 < 32) SCAN_LOAD(n + 1, nw, nqg, nqk, nkg, nu, ngs);
    bf16_t* STc = ST + (n & 1) * 32 * 136;
#pragma unroll
    for (int mt = 0; mt < 2; ++mt)
#pragma unroll
      for (int nt = 0; nt < 2; ++nt)
        *(u32x2*)(STc + (nt * 16 + fr) * 136 + (2 * wid + mt) * 16 + fq * 4) = (u32x2){pk2(S[mt][nt].x, S[mt][nt].y), pk2(S[mt][nt].z, S[mt][nt].w)};
    __syncthreads();
#pragma unroll
    for (int nt = 0; nt < 2; ++nt) {
      f32x4 a = (f32x4){0.f, 0.f, 0.f, 0.f};
#pragma unroll
      for (int ks = 0; ks < 4; ++ks) {
        const bf16x8 sb = *(const bf16x8*)(STc + (nt * 16 + fr) * 136 + ks * 32 + fq * 8);
        a = mfma16(fw[ks], sb, a);
      }
      const float v0 = lo2f(fu[nt].x) - a.x, v1 = hi2f(fu[nt].x) - a.y, v2 = lo2f(fu[nt].y) - a.z, v3 = hi2f(fu[nt].y) - a.w;
      *(u32x2*)(VT + (nt * 16 + fr) * 72 + wid * 16 + fq * 4) = (u32x2){pk2(v0, v1), pk2(v2, v3)};
    }
    __syncthreads();
#pragma unroll
    for (int mt = 0; mt < 2; ++mt) {
      f32x4 a = (f32x4){0.f, 0.f, 0.f, 0.f};
#pragma unroll
      for (int ks = 0; ks < 4; ++ks) {
        const bf16x8 sa = *(const bf16x8*)(STc + (mt * 16 + fr) * 136 + ks * 32 + fq * 8);
        a = mfma16(sa, fqg[ks], a);
      }
#pragma unroll
      for (int ks = 0; ks < 2; ++ks) {
        const bf16x8 va = *(const bf16x8*)(VT + (mt * 16 + fr) * 72 + ks * 32 + fq * 8);
        a = mfma16(va, fqk[ks], a);
      }
      const size_t row = (size_t)b * 2048 + n * 64 + wid * 16 + fr;
      *(u32x2*)(p.ogdn() + row * DM + h * 128 + dvs * 32 + mt * 16 + fq * 4) = (u32x2){pk2(a.x, a.y), pk2(a.z, a.w)};
    }
#pragma unroll
    for (int mt = 0; mt < 2; ++mt)
#pragma unroll
      for (int nt = 0; nt < 2; ++nt) {
        f32x4 a = S[mt][nt] * gs;
#pragma unroll
        for (int ks = 0; ks < 2; ++ks) {
          const bf16x8 vb = *(const bf16x8*)(VT + (nt * 16 + fr) * 72 + ks * 32 + fq * 8);
          a = mfma16(fkg[mt][ks], vb, a);
        }
        S[mt][nt] = a;
      }
  }
  float* so = p.out + O_GDNP + ((size_t)(l * 8 + b) * 8 + h) * 16384;
#pragma unroll
  for (int mt = 0; mt < 2; ++mt)
#pragma unroll
    for (int nt = 0; nt < 2; ++nt)
#pragma unroll
      for (int jj = 0; jj < 4; ++jj) so[((2 * wid + mt) * 16 + fq * 4 + jj) * 128 + dvs * 32 + nt * 16 + fr] = S[mt][nt][jj];
  __syncthreads();
#undef SCAN_LOAD
}

__device__ void gdn_sample_item(const Params& p, int l, int item, unsigned char* smem) {
  const int tid = (opq(threadIdx.x) & 255), lane = tid & 63, wid = tid >> 6;
  const int h = item & 7, b = item >> 3;
  float* qs = (float*)smem;
  float* ks = qs + 1024;
  float* vs = ks + 1024;
  float* part = vs + 1024;
  float* sbeta = part + 256;
  float* sa = sbeta + 8;
  const int dv = tid & 127, half = tid >> 7;
  float S[64];
  const float* s0 = p.state_gdn + ((size_t)(l * 128 + b) * 8 + h) * 16384 + (half * 8192 + dv);
#pragma unroll
  for (int k = 0; k < 64; ++k) S[k] = s0[k * 128];
#pragma unroll
  for (int ps = 0; ps < 2; ++ps) {
    const int c = tid + ps * 256;
    if (c < 384) {
      const int sect = c >> 7, ci = c & 127;
      const int ch = sect * 1024 + h * 128 + ci;
      float xw[11], cwv[4];
#pragma unroll
      for (int j = 0; j < 4; ++j) cwv[j] = p.conv_w[(size_t)(l * 4 + j) * 3072 + ch];
#pragma unroll
      for (int j = 0; j < 3; ++j) xw[j] = p.cache_conv[((size_t)(l * 128 + b) * 3 + j) * 3072 + ch];
#pragma unroll
      for (int t = 0; t < 8; ++t) xw[3 + t] = bf2f(p.proj()[(size_t)(MP + b * 8 + t) * NPJ + ch]);
      float* dst = sect == 0 ? qs : (sect == 1 ? ks : vs);
#pragma unroll
      for (int t = 0; t < 8; ++t) dst[t * 128 + ci] = silu(xw[t] * cwv[0] + xw[t + 1] * cwv[1] + xw[t + 2] * cwv[2] + xw[t + 3] * cwv[3]);
    }
  }
  if (tid < 8) {
    const float* lg = p.logits() + (size_t)(MP + b * 8 + tid) * 16;
    const float x = lg[8 + h] + p.dt_bias[l * 8 + h];
    const float sp = softplus_f(x);
    sa[tid] = __expf(-__expf(p.a_log[l * 8 + h]) * sp);
    sbeta[tid] = sigm(lg[h]);
  }
  __syncthreads();
#pragma unroll
  for (int u = 0; u < 4; ++u) {
    const int t = wid * 2 + (u >> 1);
    float* arr = (u & 1) ? ks : qs;
    const float a0 = arr[t * 128 + lane], a1 = arr[t * 128 + 64 + lane];
    float ss = a0 * a0 + a1 * a1;
#pragma unroll
    for (int o = 1; o < 64; o <<= 1) ss += shx(ss, o, lane);
    float rn = rsqrtf(ss + EPS);
    if (!(u & 1)) rn *= 0.08838834764831845f;
    arr[t * 128 + lane] = a0 * rn;
    arr[t * 128 + 64 + lane] = a1 * rn;
  }
  __syncthreads();
#pragma unroll 1
  for (int t = 0; t < 8; ++t) {
    const float a = sa[t], bt = sbeta[t];
    float kv = 0.f;
#pragma unroll
    for (int k4 = 0; k4 < 16; ++k4) {
      const f32x4 kk = *(const f32x4*)(ks + t * 128 + half * 64 + k4 * 4);
      S[k4 * 4 + 0] *= a; S[k4 * 4 + 1] *= a; S[k4 * 4 + 2] *= a; S[k4 * 4 + 3] *= a;
      kv += S[k4 * 4 + 0] * kk.x + S[k4 * 4 + 1] * kk.y + S[k4 * 4 + 2] * kk.z + S[k4 * 4 + 3] * kk.w;
      if ((k4 & 3) == 3) asm volatile("" ::: "memory");
    }
    part[half * 128 + dv] = kv;
    __syncthreads();
    const float delta = bt * (vs[t * 128 + dv] - (part[dv] + part[128 + dv]));
    __syncthreads();
    float o = 0.f;
#pragma unroll
    for (int k4 = 0; k4 < 16; ++k4) {
      const f32x4 kk = *(const f32x4*)(ks + t * 128 + half * 64 + k4 * 4);
      const f32x4 qq = *(const f32x4*)(qs + t * 128 + half * 64 + k4 * 4);
      S[k4 * 4 + 0] += kk.x * delta; S[k4 * 4 + 1] += kk.y * delta; S[k4 * 4 + 2] += kk.z * delta; S[k4 * 4 + 3] += kk.w * delta;
      o += S[k4 * 4 + 0] * qq.x + S[k4 * 4 + 1] * qq.y + S[k4 * 4 + 2] * qq.z + S[k4 * 4 + 3] * qq.w;
      if ((k4 & 3) == 3) asm volatile("" ::: "memory");
    }
    part[half * 128 + dv] = o;
    __syncthreads();
    if (half == 0) p.ogdn()[(size_t)(MP + b * 8 + t) * DM + h * 128 + dv] = f2bf(part[dv] + part[128 + dv]);
    __syncthreads();
  }
  float* so = p.out + O_GDNS + ((size_t)(l * 128 + b) * 8 + h) * 16384 + opq(half * 8192 + dv);
#pragma unroll
  for (int k = 0; k < 64; ++k) so[k * 128] = S[k];
  __syncthreads();
}

__device__ void gdn_sample_pair(const Params& p, int l, int pair, unsigned char* smem) {
  const int tid = (opq(threadIdx.x) & 255), lane = tid & 63, wid = tid >> 6;
  const int sub = tid >> 7, dv = tid & 127;
  const int item = pair * 2 + sub, h = item & 7, b = item >> 3;
  float* qs = (float*)smem + sub * 3104;
  float* ks = qs + 1024;
  float* vs = qs + 2048;
  float* sbeta = qs + 3072;
  float* sa = qs + 3080;
  f32x2 S2[64];
  const float* s0 = p.state_gdn + ((size_t)(l * 128 + b) * 8 + h) * 16384 + dv;
#pragma unroll
  for (int k = 0; k < 64; ++k) { S2[k].x = s0[(2 * k) * 128]; S2[k].y = s0[(2 * k + 1) * 128]; }
#pragma unroll
  for (int sect = 0; sect < 3; ++sect) {
    const int ch = sect * 1024 + h * 128 + dv;
    float xw[11], cwv[4];
#pragma unroll
    for (int j = 0; j < 4; ++j) cwv[j] = p.conv_w[(size_t)(l * 4 + j) * 3072 + ch];
#pragma unroll
    for (int j = 0; j < 3; ++j) xw[j] = p.cache_conv[((size_t)(l * 128 + b) * 3 + j) * 3072 + ch];
#pragma unroll
    for (int t = 0; t < 8; ++t) xw[3 + t] = bf2f(p.proj()[(size_t)(MP + b * 8 + t) * NPJ + ch]);
    float* dst = sect == 0 ? qs : (sect == 1 ? ks : vs);
#pragma unroll
    for (int t = 0; t < 8; ++t) dst[t * 128 + dv] = silu(xw[t] * cwv[0] + xw[t + 1] * cwv[1] + xw[t + 2] * cwv[2] + xw[t + 3] * cwv[3]);
  }
  if (dv < 8) {
    const float* lg = p.logits() + (size_t)(MP + b * 8 + dv) * 16;
    const float x = lg[8 + h] + p.dt_bias[l * 8 + h];
    sa[dv] = __expf(-__expf(p.a_log[l * 8 + h]) * softplus_f(x));
    sbeta[dv] = sigm(lg[h]);
  }
  __syncthreads();
#pragma unroll
  for (int u = 0; u < 8; ++u) {
    const int t = (wid & 1) * 4 + (u >> 1);
    float* arr = (u & 1) ? ks : qs;
    const float a0 = arr[t * 128 + lane], a1 = arr[t * 128 + 64 + lane];
    float ss = a0 * a0 + a1 * a1;
#pragma unroll
    for (int o = 1; o < 64; o <<= 1) ss += shx(ss, o, lane);
    float rn = rsqrtf(ss + EPS);
    if (!(u & 1)) rn *= 0.08838834764831845f;
    arr[t * 128 + lane] = a0 * rn;
    arr[t * 128 + 64 + lane] = a1 * rn;
  }
  __syncthreads();
#pragma unroll 1
  for (int t = 0; t < 8; ++t) {
    const float a = sa[t], bt = sbeta[t];
    f32x2 kv2 = (f32x2){0.f, 0.f};
#pragma unroll
    for (int k4 = 0; k4 < 32; ++k4) {
      const f32x4 kk = *(const f32x4*)(ks + t * 128 + k4 * 4);
      kv2 += S2[2 * k4] * (f32x2){kk.x, kk.y};
      kv2 += S2[2 * k4 + 1] * (f32x2){kk.z, kk.w};
      if ((k4 & 3) == 3) asm volatile("" ::: "memory");
    }
    const float delta = bt * (vs[t * 128 + dv] - a * (kv2.x + kv2.y));
    const f32x2 a2 = (f32x2){a, a}, d2 = (f32x2){delta, delta};
    f32x2 o2 = (f32x2){0.f, 0.f};
#pragma unroll
    for (int k4 = 0; k4 < 32; ++k4) {
      const f32x4 kk = *(const f32x4*)(ks + t * 128 + k4 * 4);
      const f32x4 qq = *(const f32x4*)(qs + t * 128 + k4 * 4);
      S2[2 * k4] = S2[2 * k4] * a2 + (f32x2){kk.x, kk.y} * d2;
      S2[2 * k4 + 1] = S2[2 * k4 + 1] * a2 + (f32x2){kk.z, kk.w} * d2;
      o2 += S2[2 * k4] * (f32x2){qq.x, qq.y};
      o2 += S2[2 * k4 + 1] * (f32x2){qq.z, qq.w};
      if ((k4 & 3) == 3) asm volatile("" ::: "memory");
    }
    p.ogdn()[(size_t)(MP + b * 8 + t) * DM + h * 128 + dv] = f2bf(o2.x + o2.y);
  }
  float* so = p.out + O_GDNS + ((size_t)(l * 128 + b) * 8 + h) * 16384 + opq(dv);
#pragma unroll
  for (int k = 0; k < 64; ++k) { so[(2 * k) * 128] = S2[k].x; so[(2 * k + 1) * 128] = S2[k].y; }
  __syncthreads();
}

__device__ void swa_prompt_item(const Params& p, int l, int item, unsigned char* smem) {
  const int tid = (opq(threadIdx.x) & 255), lane = tid & 63, wid = tid >> 6, fr = lane & 15, fq = lane >> 4;
  const int kvh = item & 3, hb2 = (item >> 2) & 31, b = item >> 7;
  bf16_t* Ks = (bf16_t*)smem;
  bf16_t* VT = Ks + 208 * 72;
  bf16_t* Pw = VT + 64 * 216 + wid * 16 * 168;
  const int tk0 = hb2 * 64 - 128;
  u32x4 krw[7], vrw[7];
#pragma unroll
  for (int i = 0; i < 7; ++i) {
    const int pc = tid + i * NTHR, kj = pc >> 3, c8 = pc & 7, tk = tk0 + kj;
    krw[i] = (u32x4){0u, 0u, 0u, 0u}; vrw[i] = (u32x4){0u, 0u, 0u, 0u};
    if (pc < 208 * 8 && kj < 192 && tk >= 0) {
      const bf16_t* base = p.proj() + (size_t)(b * 2048 + tk) * NPJ + kvh * 64 + c8 * 8;
      krw[i] = *(const u32x4*)(base + C_SK); vrw[i] = *(const u32x4*)(base + C_SV);
    }
  }
#pragma unroll
  for (int i = 0; i < 7; ++i) {
    const int pc = tid + i * NTHR;
    if (pc >= 208 * 8) break;
    const int kj = pc >> 3, c8 = pc & 7, tk = tk0 + kj;
    const bool ok = kj < 192 && tk >= 0;
    float kf[8], vf[8];
    UNPACK8(krw[i], kf);
    UNPACK8(vrw[i], vf);
    float ss = 0.f;
#pragma unroll
    for (int c = 0; c < 8; ++c) ss += kf[c] * kf[c];
    ss += shx(ss, 1, lane); ss += shx(ss, 2, lane); ss += shx(ss, 4, lane);
    const float rn = rsqrtf(ss * (1.f / 64.f) + EPS);
    const f32x4 w0 = *(const f32x4*)(p.k_norm + l * 64 + c8 * 8), w1 = *(const f32x4*)(p.k_norm + l * 64 + c8 * 8 + 4);
    kf[0] *= rn * w0.x; kf[1] *= rn * w0.y; kf[2] *= rn * w0.z; kf[3] *= rn * w0.w;
    kf[4] *= rn * w1.x; kf[5] *= rn * w1.y; kf[6] *= rn * w1.z; kf[7] *= rn * w1.w;
    *(u32x4*)(Ks + kj * 72 + c8 * 8) = (u32x4){pk2(kf[0], kf[1]), pk2(kf[2], kf[3]), pk2(kf[4], kf[5]), pk2(kf[6], kf[7])};
#pragma unroll
    for (int c = 0; c < 8; ++c) VT[(c8 * 8 + c) * 216 + kj] = f2bf(vf[c]);
    if (ok && tk >= 1920 && kj >= 128) {
      float* ko = p.out + O_KP + (((size_t)(l * 8 + b) * 128 + (tk - 1920)) * 4 + kvh) * 64 + c8 * 8;
      float* vo = p.out + O_VP + (((size_t)(l * 8 + b) * 128 + (tk - 1920)) * 4 + kvh) * 64 + c8 * 8;
      *(f32x4*)ko = (f32x4){kf[0], kf[1], kf[2], kf[3]};
      *(f32x4*)(ko + 4) = (f32x4){kf[4], kf[5], kf[6], kf[7]};
      *(f32x4*)vo = (f32x4){vf[0], vf[1], vf[2], vf[3]};
      *(f32x4*)(vo + 4) = (f32x4){vf[4], vf[5], vf[6], vf[7]};
    }
  }
  __syncthreads();
  const int kbase = wid * 16;
  const int ql = wid * 16 + fr;
  const size_t qrow = (size_t)b * 2048 + hb2 * 64 + ql;
  u32x4 qraw[4][2];
#pragma unroll
  for (int g = 0; g < 4; ++g) {
    const bf16_t* qp = p.proj() + qrow * NPJ + C_SQ + (kvh * 4 + g) * 64 + fq * 8;
    qraw[g][0] = *(const u32x4*)qp; qraw[g][1] = *(const u32x4*)(qp + 32);
  }
#pragma unroll
  for (int g = 0; g < 4; ++g) {
    const int head = kvh * 4 + g;
    const float slope = exp2f(-0.5f * (float)(head + 1));
    const float sink = p.sinks[l * 16 + head];
    bf16x8 qf[2];
    {
      const u32x4 r0 = qraw[g][0], r1 = qraw[g][1];
      float f0[8], f1[8];
      UNPACK8(r0, f0);
      UNPACK8(r1, f1);
      float ss = 0.f;
#pragma unroll
      for (int c = 0; c < 8; ++c) ss += f0[c] * f0[c] + f1[c] * f1[c];
      ss += shx(ss, 16, lane); ss += shx(ss, 32, lane);
      const float rn = rsqrtf(ss * (1.f / 64.f) + EPS) * 0.125f;
      const float* qn = p.q_norm + l * 64 + fq * 8;
#pragma unroll
      for (int c = 0; c < 8; ++c) { f0[c] *= rn * qn[c]; f1[c] *= rn * qn[32 + c]; }
      qf[0] = as_bf((u32x4){pk2(f0[0], f0[1]), pk2(f0[2], f0[3]), pk2(f0[4], f0[5]), pk2(f0[6], f0[7])});
      qf[1] = as_bf((u32x4){pk2(f1[0], f1[1]), pk2(f1[2], f1[3]), pk2(f1[4], f1[5]), pk2(f1[6], f1[7])});
    }
    f32x4 sc[9];
    float mx = sink;
#pragma unroll
    for (int kt = 0; kt < 9; ++kt) {
      f32x4 a = (f32x4){0.f, 0.f, 0.f, 0.f};
#pragma unroll
      for (int ks = 0; ks < 2; ++ks) {
        const bf16x8 kf = *(const bf16x8*)(Ks + (kbase + kt * 16 + fr) * 72 + ks * 32 + fq * 8);
        a = mfma16(kf, qf[ks], a);
      }
#pragma unroll
      for (int jj = 0; jj < 4; ++jj) {
        const int kj = kbase + kt * 16 + fq * 4 + jj;
        const int dist = ql + 128 - kj;
        const bool ok = dist >= 0 && dist <= 128 && (tk0 + kj) >= 0;
        const float s = ok ? a[jj] - slope * (float)dist : -INFINITY;
        a[jj] = s;
        mx = fmaxf(mx, s);
      }
      sc[kt] = a;
    }
    mx = fmaxf(mx, shx(mx, 16, lane));
    mx = fmaxf(mx, shx(mx, 32, lane));
    float sum = 0.f;
#pragma unroll
    for (int kt = 0; kt < 9; ++kt) {
      f32x4 e;
#pragma unroll
      for (int jj = 0; jj < 4; ++jj) { e[jj] = __expf(sc[kt][jj] - mx); sum += e[jj]; }
      *(u32x2*)(Pw + fr * 168 + kt * 16 + fq * 4) = (u32x2){pk2(e.x, e.y), pk2(e.z, e.w)};
    }
    *(u32x2*)(Pw + fr * 168 + 144 + fq * 4) = (u32x2){0u, 0u};
    sum += shx(sum, 16, lane);
    sum += shx(sum, 32, lane);
    const float inv = 1.f / (sum + __expf(sink - mx));
    __builtin_amdgcn_wave_barrier();
#pragma unroll
    for (int dt = 0; dt < 4; ++dt) {
      f32x4 a = (f32x4){0.f, 0.f, 0.f, 0.f};
#pragma unroll
      for (int ks = 0; ks < 5; ++ks) {
        const bf16x8 vf = *(const bf16x8*)(VT + (dt * 16 + fr) * 216 + kbase + ks * 32 + fq * 8);
        const bf16x8 pf = *(const bf16x8*)(Pw + fr * 168 + ks * 32 + fq * 8);
        a = mfma16(vf, pf, a);
      }
      a *= inv;
      *(u32x2*)(p.oswa() + qrow * DM + head * 64 + dt * 16 + fq * 4) = (u32x2){pk2(a.x, a.y), pk2(a.z, a.w)};
    }
    __builtin_amdgcn_wave_barrier();
  }
  __syncthreads();
}

__device__ void swa_sample_item(const Params& p, int l, int item, unsigned char* smem) {
  const int tid = (opq(threadIdx.x) & 255), lane = tid & 63, wid = tid >> 6;
  const int kvh = item & 3, b = item >> 2;
  float* Ks = (float*)smem;
  float* Vs = Ks + 136 * 68;
  float* Qs = Vs + 136 * 64;
  float* Sc = Qs + 512;
  const size_t cbase = (size_t)(l * 128 + b) * 128;
  f32x4 kvr[8], vvr[8];
#pragma unroll
  for (int i = 0; i < 8; ++i) {
    const int idx = tid + i * NTHR, j = idx >> 4, c4 = idx & 15;
    kvr[i] = *(const f32x4*)(p.cache_k + ((cbase + j) * 4 + kvh) * 64 + c4 * 4);
    vvr[i] = *(const f32x4*)(p.cache_v + ((cbase + j) * 4 + kvh) * 64 + c4 * 4);
  }
  unsigned qrw[4];
#pragma unroll
  for (int g = 0; g < 4; ++g) qrw[g] = *(const unsigned*)(p.proj() + (size_t)(MP + b * 8 + (tid >> 5)) * NPJ + C_SQ + (kvh * 4 + g) * 64 + (tid & 31) * 2);
#pragma unroll
  for (int i = 0; i < 8; ++i) {
    const int idx = tid + i * NTHR, j = idx >> 4, c4 = idx & 15;
    const f32x4 kv = kvr[i], vv = vvr[i];
    *(f32x4*)(Ks + j * 68 + c4 * 4) = kv;
    *(f32x4*)(Vs + j * 64 + c4 * 4) = vv;
  }
  {
    const int t = tid >> 5, d = (tid & 31) * 2;
    const bf16_t* base = p.proj() + (size_t)(MP + b * 8 + t) * NPJ + kvh * 64 + d;
    const unsigned kr = *(const unsigned*)(base + C_SK), vr = *(const unsigned*)(base + C_SV);
    float k0 = lo2f(kr), k1 = hi2f(kr);
    float ss = k0 * k0 + k1 * k1;
#pragma unroll
    for (int o = 1; o < 32; o <<= 1) ss += shx(ss, o, lane);
    const float rn = rsqrtf(ss * (1.f / 64.f) + EPS);
    Ks[(128 + t) * 68 + d] = k0 * rn * p.k_norm[l * 64 + d];
    Ks[(128 + t) * 68 + d + 1] = k1 * rn * p.k_norm[l * 64 + d + 1];
    Vs[(128 + t) * 64 + d] = lo2f(vr);
    Vs[(128 + t) * 64 + d + 1] = hi2f(vr);
  }
  __syncthreads();
  for (int idx = tid; idx < 128 * 64; idx += NTHR) {
    const int j = idx >> 6, d = idx & 63;
    p.out[O_KS + ((cbase + j) * 4 + kvh) * 64 + d] = Ks[(j + 8) * 68 + d];
    p.out[O_VS + ((cbase + j) * 4 + kvh) * 64 + d] = Vs[(j + 8) * 64 + d];
  }
#pragma unroll
  for (int g = 0; g < 4; ++g) {
    const int head = kvh * 4 + g;
    const float slope = exp2f(-0.5f * (float)(head + 1));
    const float sink = p.sinks[l * 16 + head];
    {
      const int t = tid >> 5, d = (tid & 31) * 2;
      const unsigned qr = qrw[g];
      const float q0 = lo2f(qr), q1 = hi2f(qr);
      float ss = q0 * q0 + q1 * q1;
#pragma unroll
      for (int o = 1; o < 32; o <<= 1) ss += shx(ss, o, lane);
      const float rn = rsqrtf(ss * (1.f / 64.f) + EPS) * 0.125f;
      Qs[t * 64 + d] = q0 * rn * p.q_norm[l * 64 + d];
      Qs[t * 64 + d + 1] = q1 * rn * p.q_norm[l * 64 + d + 1];
    }
    __syncthreads();
    for (int idx = tid; idx < 8 * 136; idx += NTHR) {
      const int tq = idx / 136, j = idx % 136;
      float s = 0.f;
#pragma unroll
      for (int d4 = 0; d4 < 16; ++d4) {
        const f32x4 qv = *(const f32x4*)(Qs + tq * 64 + d4 * 4), kq = *(const f32x4*)(Ks + j * 68 + d4 * 4);
        s += (qv.x * kq.x + qv.y * kq.y) + (qv.z * kq.z + qv.w * kq.w);
      }
      const int dist = tq + 128 - j;
      Sc[tq * 136 + j] = (dist >= 0 && dist <= 128) ? s - slope * (float)dist : -INFINITY;
    }
    __syncthreads();
#pragma unroll
    for (int u = 0; u < 2; ++u) {
      const int tq = wid * 2 + u;
      const float s0 = Sc[tq * 136 + lane], s1 = Sc[tq * 136 + 64 + lane], s2 = lane < 8 ? Sc[tq * 136 + 128 + lane] : -INFINITY;
      float mx = fmaxf(fmaxf(s0, s1), fmaxf(s2, sink));
#pragma unroll
      for (int o = 1; o < 64; o <<= 1) mx = fmaxf(mx, shx(mx, o, lane));
      const float e0 = __expf(s0 - mx), e1 = __expf(s1 - mx), e2 = __expf(s2 - mx);
      float sum = e0 + e1 + e2;
#pragma unroll
      for (int o = 1; o < 64; o <<= 1) sum += shx(sum, o, lane);
      const float inv = 1.f / (sum + __expf(sink - mx));
      Sc[tq * 136 + lane] = e0 * inv;
      Sc[tq * 136 + 64 + lane] = e1 * inv;
      if (lane < 8) Sc[tq * 136 + 128 + lane] = e2 * inv;
    }
    __syncthreads();
    {
      const int tq = tid >> 5, d = (tid & 31) * 2;
      float o0 = 0.f, o1 = 0.f;
#pragma unroll 2
      for (int j4 = 0; j4 < 34; ++j4) {
        const f32x4 pj = *(const f32x4*)(Sc + tq * 136 + j4 * 4);
        const f32x2 va = *(const f32x2*)(Vs + (j4 * 4 + 0) * 64 + d), vb = *(const f32x2*)(Vs + (j4 * 4 + 1) * 64 + d);
        const f32x2 vc = *(const f32x2*)(Vs + (j4 * 4 + 2) * 64 + d), vd = *(const f32x2*)(Vs + (j4 * 4 + 3) * 64 + d);
        o0 += (pj.x * va.x + pj.y * vb.x) + (pj.z * vc.x + pj.w * vd.x);
        o1 += (pj.x * va.y + pj.y * vb.y) + (pj.z * vc.y + pj.w * vd.y);
      }
      *(unsigned*)(p.oswa() + (size_t)(MP + b * 8 + tq) * DM + head * 64 + d) = pk2(o0, o1);
    }
    __syncthreads();
  }
}

__device__ void phase_mix(const Params& p, int l) {
  const int tid = (opq(threadIdx.x) & 255), lane = tid & 63, wid = tid >> 6, fr = lane & 15, fq = lane >> 4;
  for (int it = VB; it < MTOK / 4; it += VG) {
    const size_t row = (size_t)it * 4 + wid;
#pragma unroll
    for (int ps = 0; ps < 2; ++ps) {
      const int ch = (ps * 4 + fq) * 128 + fr * 8;
      const u32x4 og = *(const u32x4*)(p.ogdn() + row * DM + ch);
      const u32x4 ob = *(const u32x4*)(p.oswa() + row * DM + ch);
      const u32x4 zz = *(const u32x4*)(p.proj() + row * NPJ + C_Z + ch);
      const u32x4 ga = *(const u32x4*)(p.proj() + row * NPJ + C_G + ch);
      const u32x4 gb = *(const u32x4*)(p.proj() + row * NPJ + C_G + 1024 + ch);
      float fo[8], fb[8], fz[8], fa[8], fg[8];
      UNPACK8(og, fo); UNPACK8(ob, fb); UNPACK8(zz, fz); UNPACK8(ga, fa); UNPACK8(gb, fg);
      float ss = 0.f;
#pragma unroll
      for (int c = 0; c < 8; ++c) ss += fo[c] * fo[c];
      ss += shx(ss, 1, lane); ss += shx(ss, 2, lane); ss += shx(ss, 4, lane); ss += shx(ss, 8, lane);
      const float rn = rsqrtf(ss * (1.f / 128.f) + EPS);
      const f32x4 w0 = *(const f32x4*)(p.gdn_norm + l * 128 + fr * 8), w1 = *(const f32x4*)(p.gdn_norm + l * 128 + fr * 8 + 4);
      const float wn[8] = {w0.x, w0.y, w0.z, w0.w, w1.x, w1.y, w1.z, w1.w};
      float m[8];
#pragma unroll
      for (int c = 0; c < 8; ++c) m[c] = sigm(fa[c]) * (fo[c] * rn * wn[c] * silu(fz[c])) + sigm(fg[c]) * fb[c];
      *(u32x4*)(p.mix() + row * DM + ch) = (u32x4){pk2(m[0], m[1]), pk2(m[2], m[3]), pk2(m[4], m[5]), pk2(m[6], m[7])};
    }
  }
  const int NC = (8 + 128) * 3 * 3072;
  for (int i = VB * NTHR + tid; i < NC; i += VG * NTHR) {
    const int c = i % 3072, r = (i / 3072) % 3, bb = i / 9216;
    if (bb < 8) p.out[O_CONVP + ((size_t)(l * 8 + bb) * 3 + r) * 3072 + c] = bf2f(p.proj()[(size_t)(bb * 2048 + 2045 + r) * NPJ + c]);
    else p.out[O_CONVS + ((size_t)(l * 128 + bb - 8) * 3 + r) * 3072 + c] = bf2f(p.proj()[(size_t)(MP + (bb - 8) * 8 + 5 + r) * NPJ + c]);
  }
}

#define XB_TMO      128
#define XB_XCNT(j)  (256  + 64 * (j))
#define XB_XSUB(j)  (1280 + 64 * (j))
#define XB_XGEN(j)  (2304 + 64 * (j))
#define XB_TOP      3328
#define XB_TOPGEN   3392
#define XCD_BAR_WORDS 3456
#define XB_SPIN_CAP (1u << 18)
#define LAS __attribute__((address_space(3)))

__device__ __forceinline__ unsigned xb_ld(unsigned* p)              { return __hip_atomic_load(p, __ATOMIC_RELAXED, __HIP_MEMORY_SCOPE_AGENT); }
__device__ __forceinline__ unsigned xb_add(unsigned* p, unsigned v) { return __hip_atomic_fetch_add(p, v, __ATOMIC_RELAXED, __HIP_MEMORY_SCOPE_AGENT); }
__device__ __forceinline__ unsigned xb_xcc_id() { return (unsigned)__builtin_amdgcn_s_getreg((3 << 11) | 20) & 0xFu; }
#define XB_SPIN(cond, bar) do { unsigned _sp = 0; while (cond) { __builtin_amdgcn_s_sleep(1); \
    if ((++_sp & 255u) == 0u) { if (xb_ld(&(bar)[XB_TMO])) break; if (_sp > XB_SPIN_CAP) { atomicAdd(&(bar)[XB_TMO], 1u); break; } } } } while (0)

struct XcdBarrier {
    unsigned* bar; unsigned x;
    volatile LAS unsigned* st;
};

__device__ __forceinline__ XcdBarrier xcd_barrier_post(unsigned* bar, volatile LAS unsigned* st) {
    XcdBarrier b; b.bar = bar; b.x = xb_xcc_id(); b.st = st;
    if (threadIdx.x == 0) (void)xb_add(&bar[XB_XCNT(b.x)], 1u);
    return b;
}
__device__ __forceinline__ void xcd_barrier_complete(unsigned* bar, unsigned x, unsigned& nloc, unsigned& nx) {
    const unsigned G = gridDim.x * gridDim.y * gridDim.z;
    unsigned sum, cnt, mine, sp = 0u;
    for (;;) {
        sum = 0u; cnt = 0u; mine = 0u;
#pragma unroll
        for (unsigned j = 0; j < 16; ++j) { const unsigned c = xb_ld(&bar[XB_XCNT(j)]); sum += c; cnt += (c > 0u) ? 1u : 0u; mine = (j == x) ? c : mine; }
        if (sum == G) break;
        __builtin_amdgcn_s_sleep(1);
        if ((++sp & 255u) == 0u) { if (xb_ld(&bar[XB_TMO])) break; if (sp > XB_SPIN_CAP) { atomicAdd(&bar[XB_TMO], 1u); break; } }
    }
    nloc = mine > 0u ? mine : 1u; nx = cnt > 0u ? cnt : 1u;
}

__device__ __forceinline__ void xcd_barrier(const XcdBarrier& b) {
    asm volatile("s_waitcnt vmcnt(0)" ::: "memory");
    __syncthreads();
    if (threadIdx.x == 0) {
        unsigned* bar = b.bar;
        __builtin_amdgcn_s_waitcnt(0);
        unsigned nloc = b.st[0], nx = b.st[1];
        if (nloc == 0u) { xcd_barrier_complete(bar, b.x, nloc, nx); b.st[0] = nloc; b.st[1] = nx; }
        const unsigned old = xb_add(&bar[XB_XSUB(b.x)], 1u);
        const unsigned gen = old / nloc;
        if (old + 1u == (gen + 1u) * nloc) {
            __builtin_amdgcn_fence(__ATOMIC_RELEASE, "agent");
            asm volatile("s_waitcnt vmcnt(0)" ::: "memory");
            const unsigned og = xb_add(&bar[XB_TOP], 1u);
            const unsigned tg = og / nx;
            if (og + 1u == (tg + 1u) * nx) xb_add(&bar[XB_TOPGEN], 1u);
            else XB_SPIN(xb_ld(&bar[XB_TOPGEN]) == tg, bar);
            __builtin_amdgcn_fence(__ATOMIC_ACQUIRE, "agent");
            xb_add(&bar[XB_XGEN(b.x)], 1u);
            asm volatile("s_waitcnt vmcnt(0)" ::: "memory");
        } else {
            XB_SPIN(xb_ld(&bar[XB_XGEN(b.x)]) == gen, bar);
            __builtin_amdgcn_fence(__ATOMIC_ACQUIRE, "agent");
            asm volatile("s_waitcnt vmcnt(0)" ::: "memory");
        }
    }
    __syncthreads();
}


#define NPHASE_PRE 2
#define NPHASE_L 8
constexpr int LDS_TOTAL = 2 * SMEM_BYTES;
__global__ void __launch_bounds__(512, 2) mega(Params p, int ph_lo, int ph_hi) {
  extern __shared__ __attribute__((aligned(16))) unsigned char lds_all[];
  if (ph_hi < 0) cg::this_grid().sync();
  __shared__ uint4 xb_words;
  if (threadIdx.x == 0) xb_words = make_uint4(0u, 0u, 0u, 0u);
  __syncthreads();
  XcdBarrier xb = xcd_barrier_post(p.bar(), (volatile LAS unsigned*)&xb_words);
  unsigned char* smem = lds_all + VHALF * SMEM_BYTES;
  for (int ph = ph_lo; ph < ph_hi; ++ph) {
    if (ph > ph_lo) xcd_barrier(xb);
    if (ph == 0) { phase_p0(p, smem); continue; }
    if (ph == 1) {
      for (int t = VB; t < NL * 68 * 8; t += VG) {
        const int l = t / 544, r = t % 544;
        EpiArgs e{};
        e.obf = p.pp() + (size_t)l * MTOK * DM; e.ldo = DM;
        gemm_tile<8, 4, 2, 2, EPI_PP>(p.pb() + (size_t)l * MTOK * PLE, PLE, p.wt_proj() + (size_t)l * DM * PLE, PLE, PLE, (r / 8) * 256, (r % 8) * 128, (bf16_t*)smem, e);
      }
      continue;
    }
    const int l = (ph - NPHASE_PRE) / NPHASE_L, s = (ph - NPHASE_PRE) % NPHASE_L;
#ifndef REPMASK
#define REPMASK 0
#endif
    for (int rep = 0; rep < (((REPMASK >> s) & 1) ? 2 : 1); ++rep) {
    if (rep) xcd_barrier(xb);
    switch (s) {
      case 0: {
        EpiArgs e{};
        e.ssq_in = p.ssq0(); e.obf = p.proj(); e.ldo = NPJ; e.of32 = p.logits();
        const bf16_t* Bt = p.wt_in() + (size_t)l * NIN * DM;
        gemm_big_phase<EPI_PROJ>(p.hb(), Bt, DM, MTOK, NPJ, lds_all, smem, e);
        for (int t = VB; t < 272; t += VG)
          gemm_tile<1, 1, 4, 1, EPI_LOGIT, 128>(p.hb(), DM, Bt + (size_t)NPJ * DM, DM, DM, t * 64, 0, (bf16_t*)smem, e);
      } break;
      case 1: {
        const int nB1 = VG == 512 ? 3072 : 3584;
        for (int t = VB; t < nB1; t += VG) {
          if (t < 2048) gdn_prep_item(p, l, t, smem);
          else if (t < 3072) swa_prompt_item(p, l, t - 2048, smem);
          else swa_sample_item(p, l, t - 3072, smem);
        }
      } break;
      case 2: {
        if (VG == 512) {
          if (VB < 256) gdn_scan_item(p, l, VB, smem);
          else {
            gdn_sample_pair(p, l, VB - 256, smem); gdn_sample_pair(p, l, VB, smem);
            swa_sample_item(p, l, (VB - 256) * 2, smem); swa_sample_item(p, l, (VB - 256) * 2 + 1, smem);
          }
        } else {
          for (int t = VB; t < 256 + 512; t += VG) {
            if (t < 256) gdn_scan_item(p, l, t, smem);
            else gdn_sample_pair(p, l, t - 256, smem);
          }
        }
      } break;
      case 3: phase_mix(p, l); break;
      case 4: {
        EpiArgs e{};
        e.h = p.out; e.hb = p.hb2(); e.ssq_out = p.ssq1();
        gemm_big_phase<EPI_RESID>(p.mix(), p.wt_out() + (size_t)l * DM * DM, DM, MTOK, DM, lds_all, smem, e);
      } break;
      case 5: {
        EpiArgs e{};
        e.ssq_in = p.ssq1(); e.obf = p.proj(); e.ldo = DFF;
        gemm_big_phase<EPI_UP>(p.hb2(), p.wt_up() + (size_t)l * DFF * DM, DM, MTOK, DFF, lds_all, smem, e);
      } break;
      case 6: {
        EpiArgs e{};
        e.h = p.out; e.hb = p.hb2(); e.ssq_out = p.ssq2();
        gemm_big_phase<EPI_RESID>(p.proj(), p.wt_down() + (size_t)l * DM * DFF, DFF, MTOK, DM, lds_all, smem, e);
      } break;
      case 7: {
        EpiArgs e{};
        e.h = p.out; e.hb = p.hb(); e.ssq_in = p.ssq2(); e.ssq_out = p.ssq0(); e.pp = p.pp() + (size_t)l * MTOK * DM;
        gemm_big_phase<EPI_PLE>(p.hb2(), p.wt_gate() + (size_t)l * DM * DM, DM, MTOK, DM, lds_all, smem, e);
      } break;
    }
    }
  }
}

extern "C" void kernel_launch(void* const* d_in, const int* in_sizes, int n_in, void* d_out, int out_size, void* d_ws, size_t ws_size,
                              hipStream_t stream) {
  Params p{};
  const float* const* in = (const float* const*)d_in;
  p.x_prompt = in[0]; p.x_sample = in[1]; p.cache_conv = in[2]; p.state_gdn = in[3]; p.cache_k = in[4]; p.cache_v = in[5];
  p.p_prompt = in[6]; p.p_sample = in[7]; p.norm_mix = in[8]; p.w_in = in[9]; p.conv_w = in[10]; p.a_log = in[11]; p.dt_bias = in[12];
  p.gdn_norm = in[13]; p.q_norm = in[14]; p.k_norm = in[15]; p.sinks = in[16]; p.w_out = in[17]; p.norm_ffn = in[18]; p.w_up = in[19];
  p.w_down = in[20]; p.norm_ple = in[21]; p.w_gate = in[22]; p.w_proj = in[23];
  p.out = (float*)d_out;
  p.ws = (unsigned char*)d_ws;
  if (WS_TOTAL > ws_size) { fprintf(stderr, "workspace too small: need %zu have %zu\n", (size_t)WS_TOTAL, ws_size); return; }

  static int grid_blocks = 0;
  if (!grid_blocks) {
    int dev = 0, cus = 0, per_cu = 0;
    (void)hipGetDevice(&dev);
    (void)hipDeviceGetAttribute(&cus, hipDeviceAttributeMultiprocessorCount, dev);
    if (hipFuncSetAttribute((const void*)mega, hipFuncAttributeMaxDynamicSharedMemorySize, LDS_TOTAL) != hipSuccess) { fprintf(stderr, "hipFuncSetAttribute(dynamic LDS %d) failed\n", LDS_TOTAL); grid_blocks = -1; return; }
    (void)hipOccupancyMaxActiveBlocksPerMultiprocessor(&per_cu, (const void*)mega, 512, LDS_TOTAL);
    (void)hipGetLastError();
    grid_blocks = cus;
  }
  if (grid_blocks < 0) return;
  (void)hipMemsetAsync(p.ws + WO_bar, 0, (size_t)XCD_BAR_WORDS * 4, stream);
  int lo = 0, hi = NPHASE_PRE + NL * NPHASE_L;
  void* args[] = {&p, &lo, &hi};
  hipError_t e = hipLaunchCooperativeKernel((void*)mega, dim3(grid_blocks), dim3(512), args, LDS_TOTAL, stream);
  if (e != hipSuccess) fprintf(stderr, "cooperative launch failed: %s (grid %d)\n", hipGetErrorString(e), grid_blocks);
}
```

```cpp
#include <hip/hip_runtime.h>
#include <hip/hip_cooperative_groups.h>
#include <cstdio>
namespace cg = cooperative_groups;

typedef unsigned short bf16_t;
typedef short bf16x8 __attribute__((ext_vector_type(8)));
typedef float f32x4 __attribute__((ext_vector_type(4)));
typedef float f32x2 __attribute__((ext_vector_type(2)));
typedef unsigned u32x4 __attribute__((ext_vector_type(4)));
typedef unsigned u32x2 __attribute__((ext_vector_type(2)));

#define DEVI __device__ __forceinline__
DEVI int opq(int x) { asm volatile("" : "+v"(x)); return x; }

#define VHALF ((int)__builtin_amdgcn_readfirstlane((int)(threadIdx.x >> 8)))
#define VB ((int)blockIdx.x * 2 + VHALF)
#define VG ((int)gridDim.x * 2)
constexpr int NL = 4;
constexpr int MTOK = 17408, MP = 16384, MS = 1024;
constexpr int DM = 1024, NIN = 7696, NPJ = 7680, DFF = 4096, PLE = 256;
constexpr int C_Z = 3072, C_SQ = 4096, C_SK = 5120, C_SV = 5376, C_G = 5632;
constexpr float EPS = 1e-6f;
constexpr int NTHR = 256;
constexpr int SMEM_BYTES = 79872;
constexpr size_t SCR_ITEM = 73728;

constexpr size_t O_YP = 0, O_YS = 16777216, O_CONVP = 17825792, O_GDNP = 18120704, O_KP = 22315008, O_VP = 23363584,
                 O_CONVS = 24412160, O_GDNS = 29130752, O_KS = 96239616, O_VS = 113016832, O_END = 129794048;

constexpr size_t al256(size_t x) { return (x + 255) & ~(size_t)255; }
constexpr size_t WO_wt_in = 0;
constexpr size_t WO_wt_out = WO_wt_in + al256((size_t)NL * NIN * DM * 2);
constexpr size_t WO_wt_up = WO_wt_out + al256((size_t)NL * DM * DM * 2);
constexpr size_t WO_wt_down = WO_wt_up + al256((size_t)NL * DFF * DM * 2);
constexpr size_t WO_wt_gate = WO_wt_down + al256((size_t)NL * DM * DFF * 2);
constexpr size_t WO_wt_proj = WO_wt_gate + al256((size_t)NL * DM * DM * 2);
constexpr size_t WO_hb = WO_wt_proj + al256((size_t)NL * DM * PLE * 2);
constexpr size_t WO_hb2 = WO_hb + al256((size_t)MTOK * DM * 2);
constexpr size_t WO_proj = WO_hb2 + al256((size_t)MTOK * DM * 2);
constexpr size_t WO_scr = WO_proj + al256((size_t)MTOK * NPJ * 2);
constexpr size_t WO_ogdn = WO_scr + al256((size_t)2048 * SCR_ITEM);
constexpr size_t WO_oswa = WO_ogdn + al256((size_t)MTOK * DM * 2);
constexpr size_t WO_mix = WO_oswa + al256((size_t)MTOK * DM * 2);
constexpr size_t WO_pb = WO_mix + al256((size_t)MTOK * DM * 2);
constexpr size_t WO_pp = WO_pb + al256((size_t)NL * MTOK * PLE * 2);
constexpr size_t WO_ssq0 = WO_pp + al256((size_t)NL * MTOK * DM * 2);
constexpr size_t WO_ssq1 = WO_ssq0 + al256((size_t)MTOK * 16 * 4);
constexpr size_t WO_ssq2 = WO_ssq1 + al256((size_t)MTOK * 16 * 4);
constexpr size_t WO_logits = WO_ssq2 + al256((size_t)MTOK * 16 * 4);
constexpr size_t WO_gsc = WO_logits + al256((size_t)MTOK * 16 * 4);
constexpr size_t WO_bar = WO_gsc + al256((size_t)2048 * 4);
constexpr size_t WS_TOTAL = WO_bar + al256((size_t)3456 * 4);
struct Params {
  const float *x_prompt, *x_sample, *cache_conv, *state_gdn, *cache_k, *cache_v, *p_prompt, *p_sample;
  const float *norm_mix, *w_in, *conv_w, *a_log, *dt_bias, *gdn_norm, *q_norm, *k_norm, *sinks, *w_out, *norm_ffn, *w_up, *w_down,
      *norm_ple, *w_gate, *w_proj;
  float* out;
  unsigned char* ws;
  DEVI bf16_t* wt_in() const { return (bf16_t*)(ws + WO_wt_in); }
  DEVI bf16_t* wt_out() const { return (bf16_t*)(ws + WO_wt_out); }
  DEVI bf16_t* wt_up() const { return (bf16_t*)(ws + WO_wt_up); }
  DEVI bf16_t* wt_down() const { return (bf16_t*)(ws + WO_wt_down); }
  DEVI bf16_t* wt_gate() const { return (bf16_t*)(ws + WO_wt_gate); }
  DEVI bf16_t* wt_proj() const { return (bf16_t*)(ws + WO_wt_proj); }
  DEVI bf16_t* hb() const { return (bf16_t*)(ws + WO_hb); }
  DEVI bf16_t* hb2() const { return (bf16_t*)(ws + WO_hb2); }
  DEVI bf16_t* proj() const { return (bf16_t*)(ws + WO_proj); }
  DEVI bf16_t* scr() const { return (bf16_t*)(ws + WO_scr); }
  DEVI bf16_t* ogdn() const { return (bf16_t*)(ws + WO_ogdn); }
  DEVI bf16_t* oswa() const { return (bf16_t*)(ws + WO_oswa); }
  DEVI bf16_t* mix() const { return (bf16_t*)(ws + WO_mix); }
  DEVI bf16_t* pb() const { return (bf16_t*)(ws + WO_pb); }
  DEVI bf16_t* pp() const { return (bf16_t*)(ws + WO_pp); }
  DEVI float* ssq0() const { return (float*)(ws + WO_ssq0); }
  DEVI float* ssq1() const { return (float*)(ws + WO_ssq1); }
  DEVI float* ssq2() const { return (float*)(ws + WO_ssq2); }
  DEVI float* logits() const { return (float*)(ws + WO_logits); }
  DEVI float* gsc() const { return (float*)(ws + WO_gsc); }
  DEVI unsigned* bar() const { return (unsigned*)(ws + WO_bar); }
};

DEVI float shx(float v, int m, int ln) { return __builtin_bit_cast(float, __builtin_amdgcn_ds_bpermute((ln ^ m) << 2, __builtin_bit_cast(int, v))); }
DEVI float shup(float v, int o, int ln) { return __builtin_bit_cast(float, __builtin_amdgcn_ds_bpermute((ln >= o ? ln - o : ln) << 2, __builtin_bit_cast(int, v))); }
DEVI float lo2f(unsigned u) { return __uint_as_float(u << 16); }
DEVI float hi2f(unsigned u) { return __uint_as_float(u & 0xffff0000u); }
DEVI float bf2f(bf16_t v) { return __uint_as_float(((unsigned)v) << 16); }
typedef __bf16 bf16x2_t __attribute__((ext_vector_type(2)));
DEVI unsigned pk2(float lo, float hi) { const f32x2 v = {lo, hi}; const bf16x2_t r = __builtin_convertvector(v, bf16x2_t); return __builtin_bit_cast(unsigned, r); }
DEVI bf16_t f2bf(float f) { return (bf16_t)(pk2(f, 0.f) & 0xffffu); }
DEVI float sigm(float x) { return 1.f / (1.f + __expf(-x)); }
DEVI float silu(float x) { return x * sigm(x); }
DEVI float softplus_f(float x) {
  const float e = __expf(x);
  return x > 20.f ? x : (e < 0.01f ? e * (1.f - 0.5f * e + 0.33333334f * e * e) : __logf(1.f + e));
}
DEVI f32x4 mfma16(bf16x8 a, bf16x8 b, f32x4 c) { return __builtin_amdgcn_mfma_f32_16x16x32_bf16(a, b, c, 0, 0, 0); }
DEVI bf16x8 as_bf(u32x4 v) { return __builtin_bit_cast(bf16x8, v); }
#define UNPACK8(v, f) do { f[0] = lo2f(v.x); f[1] = hi2f(v.x); f[2] = lo2f(v.y); f[3] = hi2f(v.y); f[4] = lo2f(v.z); f[5] = hi2f(v.z); f[6] = lo2f(v.w); f[7] = hi2f(v.w); } while (0)

DEVI int inmap(int n) { return n < 4096 ? n : (n < 7680 ? n + 16 : n - 7680 + 4096); }

__device__ void wconv_tile(const float* __restrict__ src, int ldsrc, int K, int Nd, bf16_t* __restrict__ dst, const float* __restrict__ scale,
                           bool remap, int kt, int nt, float* sm) {
  const int tid = (opq(threadIdx.x) & 255);
  const int nl = tid & 63, kq = tid >> 6;
  const int n = nt * 64 + nl;
  const bool ok = n < Nd;
  const int sc = remap ? inmap(n) : n;
#pragma unroll 4
  for (int r = 0; r < 16; ++r) {
    const int kl = r * 4 + kq, k = kt * 64 + kl;
    float v = 0.f;
    if (ok) { v = src[(size_t)k * ldsrc + sc]; if (scale) v *= scale[k]; }
    sm[kl * 65 + nl] = v;
  }
  __syncthreads();
  const int nr = tid >> 2, ks = (tid & 3) * 16;
  if (nt * 64 + nr < Nd) {
    unsigned w[8];
#pragma unroll
    for (int i = 0; i < 8; ++i) w[i] = pk2(sm[(ks + 2 * i) * 65 + nr], sm[(ks + 2 * i + 1) * 65 + nr]);
    u32x4* d = (u32x4*)(dst + (size_t)(nt * 64 + nr) * K + kt * 64 + ks);
    d[0] = (u32x4){w[0], w[1], w[2], w[3]};
    d[1] = (u32x4){w[4], w[5], w[6], w[7]};
  }
  __syncthreads();
}

__device__ void phase_p0(const Params& p, unsigned char* smem) {
  float* sm = (float*)smem;
  const int tid = (opq(threadIdx.x) & 255), lane = tid & 63, wid = tid >> 6;
  constexpr int T_IN = 16 * 121, T_OUT = 256, T_UP = 1024, T_DOWN = 1024, T_GATE = 256, T_PROJ = 64;
  constexpr int T_L = T_IN + T_OUT + T_UP + T_DOWN + T_GATE + T_PROJ;
  for (int it = VB; it < NL * T_L; it += VG) {
    const int l = it / T_L;
    int r = it % T_L;
    if (r < T_IN) { wconv_tile(p.w_in + (size_t)l * DM * NIN, NIN, DM, NIN, p.wt_in() + (size_t)l * NIN * DM, p.norm_mix + l * DM, true, r % 16, r / 16, sm); continue; }
    r -= T_IN;
    if (r < T_OUT) { wconv_tile(p.w_out + (size_t)l * DM * DM, DM, DM, DM, p.wt_out() + (size_t)l * DM * DM, nullptr, false, r % 16, r / 16, sm); continue; }
    r -= T_OUT;
    if (r < T_UP) { wconv_tile(p.w_up + (size_t)l * DM * DFF, DFF, DM, DFF, p.wt_up() + (size_t)l * DFF * DM, p.norm_ffn + l * DM, false, r % 16, r / 16, sm); continue; }
    r -= T_UP;
    if (r < T_DOWN) { wconv_tile(p.w_down + (size_t)l * DFF * DM, DM, DFF, DM, p.wt_down() + (size_t)l * DM * DFF, nullptr, false, r % 64, r / 64, sm); continue; }
    r -= T_DOWN;
    if (r < T_GATE) { wconv_tile(p.w_gate + (size_t)l * DM * DM, DM, DM, DM, p.wt_gate() + (size_t)l * DM * DM, p.norm_ple + l * DM, false, r % 16, r / 16, sm); continue; }
    r -= T_GATE;
    wconv_tile(p.w_proj + (size_t)l * PLE * DM, DM, PLE, DM, p.wt_proj() + (size_t)l * DM * PLE, nullptr, false, r % 4, r / 4, sm);
  }
  for (int it = VB; it < MTOK / 4; it += VG) {
    const int row = it * 4 + wid;
    const float* src = row < MP ? p.x_prompt + (size_t)row * DM : p.x_sample + (size_t)(row - MP) * DM;
    float* hd = p.out + (size_t)row * DM;
    bf16_t* hbd = p.hb() + (size_t)row * DM;
    float ss = 0.f;
#pragma unroll
    for (int i = 0; i < 4; ++i) {
      const int c = i * 256 + lane * 4;
      const f32x4 v = *(const f32x4*)(src + c);
      ss += v.x * v.x + v.y * v.y + v.z * v.z + v.w * v.w;
      *(f32x4*)(hd + c) = v;
      *(u32x2*)(hbd + c) = (u32x2){pk2(v.x, v.y), pk2(v.z, v.w)};
    }
#pragma unroll
    for (int o = 1; o < 64; o <<= 1) ss += shx(ss, o, lane);
    if (lane < 16) p.ssq0()[(size_t)row * 16 + lane] = lane == 0 ? ss : 0.f;
  }
  const int G = NL * MTOK * 32;
  for (int g = VB * NTHR + tid; g < G; g += VG * NTHR) {
    const int l = g / (MTOK * 32), rem = g % (MTOK * 32), row = rem >> 5, c8 = rem & 31;
    const float* src = row < MP ? p.p_prompt + ((size_t)(l * MP + row) * PLE + c8 * 8) : p.p_sample + ((size_t)(l * MS + row - MP) * PLE + c8 * 8);
    const f32x4 a = *(const f32x4*)src, b = *(const f32x4*)(src + 4);
    *(u32x4*)(p.pb() + (size_t)g * 8) = (u32x4){pk2(a.x, a.y), pk2(a.z, a.w), pk2(b.x, b.y), pk2(b.z, b.w)};
  }
}

enum { EPI_PROJ = 0, EPI_LOGIT = 1, EPI_RESID = 2, EPI_UP = 3, EPI_PLE = 4, EPI_PP = 5 };
struct EpiArgs {
  const float* ssq_in; float* ssq_out; float* h; bf16_t* hb; bf16_t* obf; int ldo; float* of32; const bf16_t* pp;
};

template <int EPI>
DEVI float epi_rs(const EpiArgs& e, int row) {
  if (EPI == EPI_PROJ || EPI == EPI_LOGIT || EPI == EPI_UP || EPI == EPI_PLE) {
    const f32x4* sp = (const f32x4*)(e.ssq_in + (size_t)row * 16);
    const f32x4 a = sp[0], b = sp[1], c = sp[2], d = sp[3];
    const float s = ((a.x + a.y) + (a.z + a.w)) + ((b.x + b.y) + (b.z + b.w)) + ((c.x + c.y) + (c.z + c.w)) + ((d.x + d.y) + (d.z + d.w));
    return rsqrtf(s * (1.f / 1024.f) + EPS);
  }
  return 1.f;
}
template <int EPI>
DEVI void epi_elem(const EpiArgs& e, int row, int col, f32x4 v, float rs, float& sq) {
  if (EPI == EPI_PROJ) {
    v *= rs;
    *(u32x2*)(e.obf + (size_t)row * e.ldo + col) = (u32x2){pk2(v.x, v.y), pk2(v.z, v.w)};
  } else if (EPI == EPI_LOGIT) {
    v *= rs;
    *(f32x4*)(e.of32 + (size_t)row * 16 + col) = v;
  } else if (EPI == EPI_PP) {
    *(u32x2*)(e.obf + (size_t)row * e.ldo + (col & 1023)) = (u32x2){pk2(v.x, v.y), pk2(v.z, v.w)};
  } else if (EPI == EPI_UP) {
    v *= rs;
    v.x = fmaxf(v.x, 0.f); v.y = fmaxf(v.y, 0.f); v.z = fmaxf(v.z, 0.f); v.w = fmaxf(v.w, 0.f);
    v = v * v;
    *(u32x2*)(e.obf + (size_t)row * e.ldo + col) = (u32x2){pk2(v.x, v.y), pk2(v.z, v.w)};
  } else {
    float* hp = e.h + (size_t)row * DM + col;
    f32x4 hv = *(const f32x4*)hp;
    if (EPI == EPI_RESID) {
      hv += v;
    } else {
      const u32x2 pv = *(const u32x2*)(e.pp + (size_t)row * DM + col);
      hv.x += sigm(v.x * rs) * lo2f(pv.x); hv.y += sigm(v.y * rs) * hi2f(pv.x);
      hv.z += sigm(v.z * rs) * lo2f(pv.y); hv.w += sigm(v.w * rs) * hi2f(pv.y);
    }
    *(f32x4*)hp = hv;
    *(u32x2*)(e.hb + (size_t)row * DM + col) = (u32x2){pk2(hv.x, hv.y), pk2(hv.z, hv.w)};
    sq += hv.x * hv.x + hv.y * hv.y + hv.z * hv.z + hv.w * hv.w;
  }
}

template <int WMT, int WNT, int WGM, int WGN, int EPI, int BK = 32, bool KSPLIT = false>
__device__ __forceinline__ void gemm_tile(const bf16_t* __restrict__ A, int lda, const bf16_t* __restrict__ Bt, int ldb, int K, int m0, int n0,
                                          bf16_t* lds, const EpiArgs& e) {
  constexpr int BM = WGM * WMT * 16, BN = WGN * WNT * 16, LDR = BK + 8;
  constexpr int STAGE = (BM + BN) * LDR;
  constexpr int PPR = BK / 8, RPI = NTHR / PPR;
  constexpr int NA = BM / RPI, NB = (BN + RPI - 1) / RPI;
  const int tid = (opq(threadIdx.x) & 255), lane = tid & 63, wid = tid >> 6;
  const int wm = wid / WGN, wn = wid % WGN;
  const int fr = lane & 15, fq = lane >> 4;
  f32x4 acc[WMT][WNT];
#pragma unroll
  for (int i = 0; i < WMT; ++i)
#pragma unroll
    for (int j = 0; j < WNT; ++j) acc[i][j] = (f32x4){0.f, 0.f, 0.f, 0.f};
  u32x4 ra0[NA], rb0[NB], ra1[NA], rb1[NB];
  const int khalf = KSPLIT ? VHALF : 0;
  const int nk = (KSPLIT ? K / 2 : K) / BK;
  const int prow = tid / PPR, ppc = tid % PPR;
  const unsigned ta = (unsigned)(prow * lda + ppc * 8) * 2u, tb = (unsigned)(prow * ldb + ppc * 8) * 2u;
  const char* Au = (const char*)(A + (size_t)m0 * lda + (size_t)khalf * (K / 2));
  const char* Bu = (const char*)(Bt + (size_t)n0 * ldb + (size_t)khalf * (K / 2));
#define BGUARD(i) (BN >= RPI * ((i) + 1) || prow + (i) * RPI < BN)
#define GLOAD(kt, RA, RB) do { \
    _Pragma("unroll") for (int i = 0; i < NA; ++i) RA[i] = *(const u32x4*)(Au + ((size_t)i * RPI * lda + (size_t)(kt) * BK) * 2 + ta); \
    _Pragma("unroll") for (int i = 0; i < NB; ++i) if (BGUARD(i)) RB[i] = *(const u32x4*)(Bu + ((size_t)i * RPI * ldb + (size_t)(kt) * BK) * 2 + tb); \
  } while (0)
#define LSTORE(st, RA, RB) do { bf16_t* sA_ = lds + (st) * STAGE; bf16_t* sB_ = sA_ + BM * LDR; \
    _Pragma("unroll") for (int i = 0; i < NA; ++i) *(u32x4*)(sA_ + (prow + i * RPI) * LDR + ppc * 8) = RA[i]; \
    _Pragma("unroll") for (int i = 0; i < NB; ++i) if (BGUARD(i)) *(u32x4*)(sB_ + (prow + i * RPI) * LDR + ppc * 8) = RB[i]; \
  } while (0)
#define COMPUTE(st) do { const bf16_t* sA = lds + (st) * STAGE; const bf16_t* sB = sA + BM * LDR; \
    _Pragma("unroll") for (int kk = 0; kk < BK / 32; ++kk) { \
      bf16x8 bfr[WNT]; \
      _Pragma("unroll") for (int nt = 0; nt < WNT; ++nt) bfr[nt] = *(const bf16x8*)(sB + (wn * WNT * 16 + nt * 16 + fr) * LDR + kk * 32 + fq * 8); \
      _Pragma("unroll") for (int mt = 0; mt < WMT; ++mt) { \
        const bf16x8 af = *(const bf16x8*)(sA + (wm * WMT * 16 + mt * 16 + fr) * LDR + kk * 32 + fq * 8); \
        _Pragma("unroll") for (int nt = 0; nt < WNT; ++nt) acc[mt][nt] = mfma16(bfr[nt], af, acc[mt][nt]); } } \
  } while (0)
  GLOAD(0, ra0, rb0);
  GLOAD(1, ra1, rb1);
  LSTORE(0, ra0, rb0);
  __syncthreads();
  for (int kt = 0; kt < nk; kt += 2) {
    const int k2 = kt + 2 < nk ? kt + 2 : nk - 2;
    GLOAD(k2, ra0, rb0);
    COMPUTE(0);
    LSTORE(1, ra1, rb1);
    __syncthreads();
    GLOAD(k2 + 1, ra1, rb1);
    COMPUTE(1);
    LSTORE(0, ra0, rb0);
    __syncthreads();
  }
#undef BGUARD
#undef COMPUTE
#undef GLOAD
#undef LSTORE
  if (KSPLIT) {
    f32x4* red = (f32x4*)((unsigned char*)lds + (khalf ? 0 : SMEM_BYTES));
    if (khalf == 1) {
#pragma unroll
      for (int i = 0; i < WMT; ++i)
#pragma unroll
        for (int j = 0; j < WNT; ++j) red[((wid * WMT + i) * WNT + j) * 64 + lane] = acc[i][j];
    }
    __syncthreads();
    if (khalf == 0) {
#pragma unroll
      for (int i = 0; i < WMT; ++i)
#pragma unroll
        for (int j = 0; j < WNT; ++j) acc[i][j] += red[((wid * WMT + i) * WNT + j) * 64 + lane];
    }
  }
  if (!KSPLIT || khalf == 0) {
#pragma unroll
  for (int mt = 0; mt < WMT; ++mt) {
    const int row = m0 + wm * WMT * 16 + mt * 16 + fr;
    const float rs = epi_rs<EPI>(e, row);
    float sq = 0.f;
#pragma unroll
    for (int nt = 0; nt < WNT; ++nt) epi_elem<EPI>(e, row, n0 + wn * WNT * 16 + nt * 16 + fq * 4, acc[mt][nt], rs, sq);
    if (EPI == EPI_RESID || EPI == EPI_PLE) {
      sq += shx(sq, 16, lane);
      sq += shx(sq, 32, lane);
      if (fq == 0) e.ssq_out[(size_t)row * 16 + (n0 / BN) * WGN + wn] = sq;
    }
  }
  }
  if (KSPLIT) __syncthreads();
}

namespace pg8 {
#define PG8_LAS __attribute__((address_space(3)))
typedef unsigned short bf16_t;
typedef short bf16x8 __attribute__((ext_vector_type(8)));
typedef float f32x4 __attribute__((ext_vector_type(4)));
typedef unsigned u32x4 __attribute__((ext_vector_type(4)));
constexpr int BM = 256, BK = 64, HALF = 128, HTB = HALF * BK * 2  , STAGE_BYTES = 8 * HTB, NXCD = 8, WGM = 8;

__host__ __device__ __forceinline__ int lds_byte(int r, int c) { const int st = (r >> 4) * 2 + (c >> 5), rr = r & 15, cc = c & 31, ob = rr * 64 + cc * 2; return st * 1024 + (ob ^ (((ob >> 9) & 1) << 5)); }
__host__ __device__ __forceinline__ void stage_rc(int b, int& R, int& C) { const int st = b / 1024, sb = b % 1024, swz = sb ^ (((sb >> 9) & 1) << 5); R = (st >> 1) * 16 + swz / 64; C = (st & 1) * 32 + (swz % 64) / 2; }
__host__ __device__ __forceinline__ int perm32(int rho) { const int n = rho >> 4, i = rho & 15; return 8 * (i >> 2) + 4 * n + (i & 3); }

struct Unit { int pm, pn; };
struct Gemm { const bf16_t* A; const bf16_t* Bt; int M, N, K; };

template <class Epi, class Sched, bool STAMP = false>
__device__ __forceinline__ void gemm_phase(PG8_LAS unsigned char* lds, const Gemm g, const Sched& S, const Epi& E, unsigned long long* stamps) {
    const int tid = opq((int)threadIdx.x), wid = __builtin_amdgcn_readfirstlane(tid >> 6), lane = tid & 63, wr = wid >> 2, wc = wid & 3, fr = lane & 15, fq = lane >> 4;
    const int K = g.K, nt = K / BK;
    int ts_lo = 0, ts_hi = 0, nts = 0; const unsigned long long rt_entry = STAMP ? (unsigned long long)wall_clock64() : 0ull;
#define PG8_STAMP() do { if (STAMP && wid == 0 && nts < 64) { const unsigned long long _c = (unsigned long long)clock64(); \
        ts_lo = (lane == nts) ? (int)(unsigned)_c : ts_lo; ts_hi = (lane == nts) ? (int)(unsigned)(_c >> 32) : ts_hi; ++nts; } } while (0)
    PG8_STAMP();
    unsigned voffA[2], voffB[2];
#pragma unroll
    for (int i = 0; i < 2; ++i) { int R, C; stage_rc(tid * 16 + i * 8192, R, C); const int Rb = Epi::PERM ? ((R & ~31) + perm32(R & 31)) : R;
        voffA[i] = (unsigned)(R * K + C) * 2u; voffB[i] = (unsigned)(Rb * K + C) * 2u; }
    const size_t kstep = (size_t)(BK * 2);
    const size_t hstep = (size_t)HALF * K * 2;
    const size_t tstep = 2 * hstep;
    const unsigned ldsw = (unsigned)wid * 1024u;
    const int aoff = lds_byte(wr * 64 + fr, fq * 8), boff = lds_byte(wc * 32 + fr, fq * 8);
#define PG8_SA(b, h) (((b) * 2 + (h)) * HTB)
#define PG8_SB(b, h) ((4 + (b) * 2 + (h)) * HTB)
#define PG8_STAGE(bufoff, gbase, voff) do { _Pragma("unroll") for (int _i = 0; _i < 2; ++_i) \
        __builtin_amdgcn_global_load_lds((const unsigned*)((const char*)(gbase) + (voff)[_i]), (PG8_LAS unsigned*)(lds + (bufoff) + ldsw + _i * 8192), 16, 0, 0); } while (0)
#define PG8_LDA(dst, b, h) do { _Pragma("unroll") for (int m = 0; m < 4; ++m) _Pragma("unroll") for (int k = 0; k < 2; ++k) dst[m][k] = *(const PG8_LAS bf16x8*)(lds + PG8_SA(b, h) + aoff + m * 2048 + k * 1024); } while (0)
#define PG8_LDB(dst, b, h) do { _Pragma("unroll") for (int n = 0; n < 2; ++n) _Pragma("unroll") for (int k = 0; k < 2; ++k) dst[n][k] = *(const PG8_LAS bf16x8*)(lds + PG8_SB(b, h) + boff + n * 2048 + k * 1024); } while (0)
#define PG8_MMA(ai, bj, At, Bt) do { __builtin_amdgcn_s_setprio(1); _Pragma("unroll") for (int m = 0; m < 4; ++m) _Pragma("unroll") for (int n = 0; n < 2; ++n) _Pragma("unroll") for (int k = 0; k < 2; ++k) \
        acc[ai][bj][m][n] = __builtin_amdgcn_mfma_f32_16x16x32_bf16(Bt[n][k], At[m][k], acc[ai][bj][m][n], 0, 0, 0); __builtin_amdgcn_s_setprio(0); } while (0)
#define PG8_WAIT_V(n) asm volatile("s_waitcnt vmcnt(" #n ")" ::: "memory")
#define PG8_WAIT_L(n) asm volatile("s_waitcnt lgkmcnt(" #n ")" ::: "memory")
#define PG8_BAR __builtin_amdgcn_s_barrier()
#define PG8_SCHED __builtin_amdgcn_sched_barrier(0)
    Unit cur, nxt; int ui = 0;
    if (!S.next(0, cur)) return;
    f32x4 acc[2][2][4][2];
#pragma unroll
    for (int a = 0; a < 2; ++a)
#pragma unroll
        for (int b = 0; b < 2; ++b)
#pragma unroll
            for (int m = 0; m < 4; ++m)
#pragma unroll
                for (int n = 0; n < 2; ++n) acc[a][b][m][n] = (f32x4){0.f, 0.f, 0.f, 0.f};
    bf16x8 At[4][2], B0[2][2], B1[2][2];
    const char* cA = (const char*)g.A + (size_t)cur.pm * tstep; const char* cB = (const char*)g.Bt + (size_t)cur.pn * tstep;
    S.a_ready(cur);
    PG8_STAGE(PG8_SB(0, 0), cB, voffB); PG8_STAGE(PG8_SA(0, 0), cA, voffA); PG8_STAGE(PG8_SB(0, 1), cB + hstep, voffB); PG8_STAGE(PG8_SA(0, 1), cA + hstep, voffA);
    if (wr == 1) PG8_BAR;
    PG8_WAIT_V(4); PG8_BAR;
    PG8_STAGE(PG8_SB(1, 0), cB + kstep, voffB); PG8_STAGE(PG8_SA(1, 0), cA + kstep, voffA); PG8_STAGE(PG8_SB(1, 1), cB + hstep + kstep, voffB);
    PG8_WAIT_V(6); PG8_BAR;
    PG8_STAMP();
    for (;;) {
        const bool has_next = S.next(ui + 1, nxt);
        const char* nA = has_next ? (const char*)g.A + (size_t)nxt.pm * tstep : cA; const char* nB = has_next ? (const char*)g.Bt + (size_t)nxt.pn * tstep : cB;
        for (int t = 0; t < nt; t += 2) {
            const bool last = (t == nt - 2);
            const char* a1 = cA + (size_t)(t + 1) * kstep;
            const char* a2 = last ? nA : cA + (size_t)(t + 2) * kstep; const char* b2 = last ? nB : cB + (size_t)(t + 2) * kstep;
            const char* a3 = a2 + kstep; const char* b3 = b2 + kstep;
            if (last && has_next) S.a_ready(nxt);
            PG8_LDB(B0, 0, 0); PG8_SCHED; PG8_LDA(At, 0, 0); PG8_STAGE(PG8_SA(1, 1), a1 + hstep, voffA);
            PG8_WAIT_L(8); PG8_BAR; PG8_WAIT_L(0); PG8_MMA(0, 0, At, B0); PG8_BAR; PG8_SCHED;
            PG8_LDB(B1, 0, 1); PG8_STAGE(PG8_SB(0, 0), b2, voffB);
            PG8_BAR; PG8_WAIT_L(0); PG8_MMA(0, 1, At, B1); PG8_BAR;
            PG8_LDA(At, 0, 1); PG8_STAGE(PG8_SA(0, 0), a2, voffA);
            PG8_BAR; PG8_WAIT_L(0); PG8_MMA(1, 0, At, B0); PG8_BAR; PG8_SCHED;
            PG8_STAGE(PG8_SB(0, 1), b2 + hstep, voffB);
            PG8_WAIT_V(6); PG8_BAR; PG8_MMA(1, 1, At, B1); PG8_BAR;
            PG8_LDB(B0, 1, 0); PG8_SCHED; PG8_LDA(At, 1, 0); PG8_STAGE(PG8_SA(0, 1), a2 + hstep, voffA);
            PG8_WAIT_L(8); PG8_BAR; PG8_WAIT_L(0); PG8_MMA(0, 0, At, B0); PG8_BAR; PG8_SCHED;
            PG8_LDB(B1, 1, 1); PG8_STAGE(PG8_SB(1, 0), b3, voffB);
            PG8_BAR; PG8_WAIT_L(0); PG8_MMA(0, 1, At, B1); PG8_BAR;
            PG8_LDA(At, 1, 1); PG8_STAGE(PG8_SA(1, 0), a3, voffA);
            PG8_BAR; PG8_WAIT_L(0); PG8_MMA(1, 0, At, B0); PG8_BAR; PG8_SCHED;
            PG8_STAGE(PG8_SB(1, 1), b3 + hstep, voffB);
            PG8_WAIT_V(6); PG8_BAR; PG8_MMA(1, 1, At, B1); PG8_BAR;
        }
        PG8_STAMP();
        if constexpr (!Epi::AFTER_DRAIN) { E(acc, cur, wr, wc, fr, fq); S.done(cur); }
        PG8_STAMP();
        if (!has_next) break;
#pragma unroll
        for (int a = 0; a < 2; ++a)
#pragma unroll
            for (int b = 0; b < 2; ++b)
#pragma unroll
                for (int m = 0; m < 4; ++m)
#pragma unroll
                    for (int n = 0; n < 2; ++n) acc[a][b][m][n] = (f32x4){0.f, 0.f, 0.f, 0.f};
        cur = nxt; cA = nA; cB = nB; ++ui;
    }
    PG8_WAIT_V(0);
    if (wr == 0) PG8_BAR;
    PG8_BAR;
    if constexpr (Epi::AFTER_DRAIN) { E.fused(acc, cur, wr, wc, fr, fq, lds, wid, lane); S.done(cur); }
    PG8_STAMP();
    if (STAMP && wid == 0) { stamps[lane] = lane < nts ? (((unsigned long long)(unsigned)ts_hi << 32) | (unsigned)ts_lo) : 0ull;
        if (lane == 62) stamps[62] = rt_entry; if (lane == 63) stamps[63] = (unsigned long long)wall_clock64(); }
#undef PG8_STAMP
#undef PG8_SA
#undef PG8_SB
#undef PG8_STAGE
#undef PG8_LDA
#undef PG8_LDB
#undef PG8_MMA
#undef PG8_WAIT_V
#undef PG8_WAIT_L
#undef PG8_BAR
#undef PG8_SCHED
}
}

struct RowSched {
  int nN, nLimit, G, c;
  __device__ __forceinline__ bool next(int i, pg8::Unit& u) const { const int L = i * G + c; if (L >= nLimit) return false; u.pm = L / nN; u.pn = L - u.pm * nN; return true; }
  __device__ __forceinline__ void a_ready(const pg8::Unit&) const {}
  __device__ __forceinline__ void done(const pg8::Unit&) const {}
};
struct DiagSched {
  int nLimit, G, c;
  __device__ __forceinline__ bool next(int i, pg8::Unit& u) const { const int L = i * G + c; if (L >= nLimit) return false; const int l = L / 272, r = L - l * 272; u.pm = l * 68 + (r >> 2); u.pn = l * 4 + (r & 3); return true; }
  __device__ __forceinline__ void a_ready(const pg8::Unit&) const {}
  __device__ __forceinline__ void done(const pg8::Unit&) const {}
};
template <int EPI> struct BigEpi {
  static constexpr bool PERM = false, AFTER_DRAIN = false;
  EpiArgs e;
  __device__ __forceinline__ void operator()(const f32x4 (&acc)[2][2][4][2], const pg8::Unit& u, int wr, int wc, int fr, int fq) const {
    const int lane = fq * 16 + fr;
#pragma unroll
    for (int ai = 0; ai < 2; ++ai)
#pragma unroll
      for (int m = 0; m < 4; ++m) {
        const int row = u.pm * 256 + ai * 128 + wr * 64 + m * 16 + fr;
        const float rs = epi_rs<EPI>(e, row);
        float sq = 0.f;
#pragma unroll
        for (int bj = 0; bj < 2; ++bj)
#pragma unroll
          for (int n = 0; n < 2; ++n) epi_elem<EPI>(e, row, u.pn * 256 + bj * 128 + wc * 32 + n * 16 + fq * 4, acc[ai][bj][m][n], rs, sq);
        if (EPI == EPI_RESID || EPI == EPI_PLE) {
          sq += shx(sq, 16, lane);
          sq += shx(sq, 32, lane);
          if (fq == 0) e.ssq_out[(size_t)row * 16 + u.pn * 4 + wc] = sq;
        }
      }
  }
};

template <int EPI>
__device__ void gemm_big_phase(const bf16_t* A, const bf16_t* Bt, int K, int M, int N, unsigned char* lds_all, unsigned char* smem_half, const EpiArgs& e) {
  const int nM = M / 256, nN = N / 256, nU = nM * nN, G = gridDim.x;
  const int L = nU % G;
  const int nLimit = (L > 0 && L <= G / 4) ? nU - L : nU;
  RowSched S; S.nN = nN; S.nLimit = nLimit; S.G = G; S.c = blockIdx.x;
  pg8::Gemm g; g.A = A; g.Bt = Bt; g.M = M; g.N = N; g.K = K;
  BigEpi<EPI> E; E.e = e;
  pg8::gemm_phase<BigEpi<EPI>, RowSched>((PG8_LAS unsigned char*)lds_all, g, S, E, nullptr);
  __syncthreads();
  const int nSmall = (nU - nLimit) * 16;
  if (nSmall <= G && K >= 512) {
    for (int st = blockIdx.x; st < nSmall; st += G) {
      const int u = nLimit + (st >> 4), sub = st & 15, pm = u / nN, pn = u - pm * nN;
      gemm_tile<1, 4, 4, 1, EPI, 128, true>(A, K, Bt, K, K, pm * 256 + (sub >> 2) * 64, pn * 256 + (sub & 3) * 64, (bf16_t*)smem_half, e);
    }
  } else {
    for (int st = VB; st < nSmall; st += VG) {
      const int u = nLimit + (st >> 4), sub = st & 15, pm = u / nN, pn = u - pm * nN;
      gemm_tile<1, 4, 4, 1, EPI, 128>(A, K, Bt, K, K, pm * 256 + (sub >> 2) * 64, pn * 256 + (sub & 3) * 64, (bf16_t*)smem_half, e);
    }
  }
}


template <int I, int J4>
DEVI void solve_sub4(float& r, const float (&x)[64], const float* Am) {
  if constexpr (J4 * 4 < I) {
    const f32x4 a = *(const f32x4*)(Am + I * 64 + J4 * 4);
    if constexpr (J4 * 4 + 0 < I) r -= a.x * x[J4 * 4 + 0];
    if constexpr (J4 * 4 + 1 < I) r -= a.y * x[J4 * 4 + 1];
    if constexpr (J4 * 4 + 2 < I) r -= a.z * x[J4 * 4 + 2];
    if constexpr (J4 * 4 + 3 < I) r -= a.w * x[J4 * 4 + 3];
    solve_sub4<I, J4 + 1>(r, x, Am);
  }
}
template <int I>
DEVI void solve_rows(float (&x)[64], const float* Am, const bf16_t* src, const float* sc) {
  if constexpr (I < 64) {
    float r = bf2f(src[I * 136]) * sc[I];
    solve_sub4<I, 0>(r, x, Am);
    x[I] = r;
    asm volatile("" ::: "memory");
    solve_rows<I + 1>(x, Am, src, sc);
  }
}

__device__ void gdn_prep_item(const Params& p, int l, int item, unsigned char* smem) {
  const int tid = (opq(threadIdx.x) & 255), lane = tid & 63, wid = tid >> 6, fr = lane & 15, fq = lane >> 4;
  const int h = item & 7, n = (item >> 3) & 31, b = item >> 8;
  const int tok0 = b * 2048 + n * 64;
  bf16_t* qh = (bf16_t*)smem;
  bf16_t* kh = qh + 64 * 136;
  bf16_t* vh = kh + 64 * 136;
  float* Am = (float*)(vh + 64 * 136);
  float* sbeta = Am + 64 * 64;
  float* sgc = sbeta + 64;
  float* sbe = sgc + 64;
  unsigned char* scr = (unsigned char*)p.scr() + (size_t)item * SCR_ITEM;
  bf16_t* g_uT = (bf16_t*)scr;
  bf16_t* g_w = (bf16_t*)(scr + 16384);
  bf16_t* g_qg = (bf16_t*)(scr + 32768);
  bf16_t* g_kgT = (bf16_t*)(scr + 49152);
  bf16_t* g_qk = (bf16_t*)(scr + 65536);

  if (wid == 0) {
    const float* lg = p.logits() + (size_t)(tok0 + lane) * 16;
    const float bl = lg[h], al = lg[8 + h];
    const float x = al + p.dt_bias[l * 8 + h];
    const float sp = softplus_f(x);
    float g = -__expf(p.a_log[l * 8 + h]) * sp;
#pragma unroll
    for (int o = 1; o < 64; o <<= 1) { const float t = shup(g, o, lane); if (lane >= o) g += t; }
    sbeta[lane] = sigm(bl);
    sgc[lane] = g;
    sbe[lane] = sigm(bl) * __expf(g);
  }
  u32x4 rwall[3][7];
#pragma unroll
  for (int sect = 0; sect < 3; ++sect)
#pragma unroll
    for (int r = 0; r < 7; ++r) {
      const int tl = n * 64 + wid * 16 + fq * 4 - 3 + r;
      rwall[sect][r] = (u32x4){0u, 0u, 0u, 0u};
      if (tl >= 0) rwall[sect][r] = *(const u32x4*)(p.proj() + (size_t)(b * 2048 + tl) * NPJ + sect * 1024 + h * 128 + fr * 8);
    }
#pragma unroll
  for (int sect = 0; sect < 3; ++sect) {
    const int ch0 = sect * 1024 + h * 128 + fr * 8;
    float cw[4][8];
#pragma unroll
    for (int j = 0; j < 4; ++j) {
      const f32x4 a = *(const f32x4*)(p.conv_w + (size_t)(l * 4 + j) * 3072 + ch0), c = *(const f32x4*)(p.conv_w + (size_t)(l * 4 + j) * 3072 + ch0 + 4);
      cw[j][0] = a.x; cw[j][1] = a.y; cw[j][2] = a.z; cw[j][3] = a.w; cw[j][4] = c.x; cw[j][5] = c.y; cw[j][6] = c.z; cw[j][7] = c.w;
    }
    const int ib = wid * 16 + fq * 4;
#pragma unroll
    for (int it = 0; it < 4; ++it) {
      float o[8];
#pragma unroll
      for (int c = 0; c < 8; ++c) o[c] = 0.f;
#pragma unroll
      for (int j = 0; j < 4; ++j) {
        float f[8];
        UNPACK8(rwall[sect][it + j], f);
#pragma unroll
        for (int c = 0; c < 8; ++c) o[c] += f[c] * cw[j][c];
      }
      float ss = 0.f;
#pragma unroll
      for (int c = 0; c < 8; ++c) { o[c] = silu(o[c]); ss += o[c] * o[c]; }
      if (sect < 2) {
        ss += shx(ss, 1, lane); ss += shx(ss, 2, lane); ss += shx(ss, 4, lane); ss += shx(ss, 8, lane);
        float rn = rsqrtf(ss + EPS);
        if (sect == 0) rn *= 0.08838834764831845f;
#pragma unroll
        for (int c = 0; c < 8; ++c) o[c] *= rn;
      }
      const u32x4 pk = (u32x4){pk2(o[0], o[1]), pk2(o[2], o[3]), pk2(o[4], o[5]), pk2(o[6], o[7])};
      bf16_t* dst = sect == 0 ? qh + (ib + it) * 136 + fr * 8 : (sect == 1 ? kh + (ib + it) * 136 + fr * 8 : vh + (ib + it) * 136 + fr * 8);
      *(u32x4*)dst = pk;
    }
  }
  __syncthreads();
  {
    const int i = wid * 16 + fr;
    const float gi = sgc[i], bi = sbeta[i];
    bf16x8 kx[4], qx[4];
#pragma unroll
    for (int ks = 0; ks < 4; ++ks) {
      kx[ks] = *(const bf16x8*)(kh + i * 136 + ks * 32 + fq * 8);
      qx[ks] = *(const bf16x8*)(qh + i * 136 + ks * 32 + fq * 8);
    }
#pragma unroll
    for (int jt = 0; jt < 4; ++jt) {
      f32x4 akk = (f32x4){0.f, 0.f, 0.f, 0.f}, aqk = (f32x4){0.f, 0.f, 0.f, 0.f};
      if (jt <= wid) {
#pragma unroll
        for (int ks = 0; ks < 4; ++ks) {
          const bf16x8 kj = *(const bf16x8*)(kh + (jt * 16 + fr) * 136 + ks * 32 + fq * 8);
          akk = mfma16(kj, kx[ks], akk);
          aqk = mfma16(kj, qx[ks], aqk);
        }
      }
      const int j0 = jt * 16 + fq * 4;
      float av[4], qv[4];
#pragma unroll
      for (int jj = 0; jj < 4; ++jj) {
        const int j = j0 + jj;
        const float dec = j <= i ? __expf(gi - sgc[j]) : 0.f;
        av[jj] = j < i ? bi * akk[jj] * dec : 0.f;
        qv[jj] = aqk[jj] * dec;
      }
      *(f32x4*)(Am + i * 64 + j0) = (f32x4){av[0], av[1], av[2], av[3]};
      *(u32x2*)(g_qk + i * 64 + j0) = (u32x2){pk2(qv[0], qv[1]), pk2(qv[2], qv[3])};
    }
  }
  __syncthreads();
  {
    float x[64];
    const bool isu = tid < 128;
    const int cc = tid & 127;
    solve_rows<0>(x, Am, (isu ? vh : kh) + cc, isu ? sbeta : sbe);
    if (isu) {
      u32x4* d = (u32x4*)(g_uT + cc * 64);
#pragma unroll
      for (int q = 0; q < 8; ++q) d[q] = (u32x4){pk2(x[q * 8], x[q * 8 + 1]), pk2(x[q * 8 + 2], x[q * 8 + 3]), pk2(x[q * 8 + 4], x[q * 8 + 5]), pk2(x[q * 8 + 6], x[q * 8 + 7])};
    } else {
#pragma unroll
      for (int i = 0; i < 64; ++i) g_w[i * 128 + cc] = f2bf(x[i]);
    }
  }
  {
    const float gl = sgc[63];
#pragma unroll
    for (int q = 0; q < 4; ++q) {
      const int pc = tid + q * 256, i = pc >> 4, c8 = pc & 15;
      const u32x4 v = *(const u32x4*)(qh + i * 136 + c8 * 8);
      float f[8];
      UNPACK8(v, f);
      const float s = __expf(sgc[i]);
      *(u32x4*)(g_qg + i * 128 + c8 * 8) = (u32x4){pk2(f[0] * s, f[1] * s), pk2(f[2] * s, f[3] * s), pk2(f[4] * s, f[5] * s), pk2(f[6] * s, f[7] * s)};
    }
    if (tid >= 128) {
      const int dk = tid - 128;
      u32x4* d = (u32x4*)(g_kgT + dk * 64);
#pragma unroll
      for (int q = 0; q < 8; ++q) {
        float f[8];
#pragma unroll
        for (int c = 0; c < 8; ++c) { const int i = q * 8 + c; f[c] = bf2f(kh[i * 136 + dk]) * __expf(gl - sgc[i]); }
        d[q] = (u32x4){pk2(f[0], f[1]), pk2(f[2], f[3]), pk2(f[4], f[5]), pk2(f[6], f[7])};
      }
    }
    if (tid == 0) p.gsc()[item] = __expf(gl);
  }
  __syncthreads();
}

__device__ void gdn_scan_item(const Params& p, int l, int item, unsigned char* smem) {
  const int tid = (opq(threadIdx.x) & 255), lane = tid & 63, wid = tid >> 6, fr = lane & 15, fq = lane >> 4;
  const int dvs = item & 3, h = (item >> 2) & 7, b = item >> 5;
  bf16_t* ST = (bf16_t*)smem;
  bf16_t* VT = ST + 2 * 32 * 136;
  f32x4 S[2][2];
#pragma unroll
  for (int a = 0; a < 2; ++a)
#pragma unroll
    for (int c = 0; c < 2; ++c) S[a][c] = (f32x4){0.f, 0.f, 0.f, 0.f};
  __syncthreads();
  bf16x8 fw[4], fqg[4], fqk[2], fkg[2][2];
  u32x2 fu[2];
  float gs;
  bf16x8 nw[4], nqg[4], nqk[2], nkg[2][2];
  u32x2 nu[2];
  float ngs;
#define SCAN_LOAD(n_, W, QG, QK, KG, U, GS) do { \
    const int it_ = ((b * 32 + (n_)) << 3) + h; \
    const unsigned char* scr_ = (const unsigned char*)p.scr() + (size_t)it_ * SCR_ITEM; \
    const bf16_t* g_uT = (const bf16_t*)scr_; const bf16_t* g_w = (const bf16_t*)(scr_ + 16384); const bf16_t* g_qg = (const bf16_t*)(scr_ + 32768); \
    const bf16_t* g_kgT = (const bf16_t*)(scr_ + 49152); const bf16_t* g_qk = (const bf16_t*)(scr_ + 65536); \
    _Pragma("unroll") for (int ks = 0; ks < 4; ++ks) { \
      W[ks] = *(const bf16x8*)(g_w + (wid * 16 + fr) * 128 + ks * 32 + fq * 8); \
      QG[ks] = *(const bf16x8*)(g_qg + (wid * 16 + fr) * 128 + ks * 32 + fq * 8); } \
    _Pragma("unroll") for (int ks = 0; ks < 2; ++ks) { \
      QK[ks] = *(const bf16x8*)(g_qk + (wid * 16 + fr) * 64 + ks * 32 + fq * 8); \
      _Pragma("unroll") for (int mt = 0; mt < 2; ++mt) KG[mt][ks] = *(const bf16x8*)(g_kgT + ((2 * wid + mt) * 16 + fr) * 64 + ks * 32 + fq * 8); } \
    _Pragma("unroll") for (int nt = 0; nt < 2; ++nt) U[nt] = *(const u32x2*)(g_uT + (dvs * 32 + nt * 16 + fr) * 64 + wid * 16 + fq * 4); \
    GS = p.gsc()[it_]; } while (0)
  SCAN_LOAD(0, nw, nqg, nqk, nkg, nu, ngs);
  for (int n = 0; n < 32; ++n) {
#pragma unroll
    for (int ks = 0; ks < 4; ++ks) { fw[ks] = nw[ks]; fqg[ks] = nqg[ks]; }
#pragma unroll
    for (int ks = 0; ks < 2; ++ks) { fqk[ks] = nqk[ks]; fkg[0][ks] = nkg[0][ks]; fkg[1][ks] = nkg[1][ks]; }
    fu[0] = nu[0]; fu[1] = nu[1]; gs = ngs;
    if (n + 1 < 32) SCAN_LOAD(n + 1, nw, nqg, nqk, nkg, nu, ngs);
    bf16_t* STc = ST + (n & 1) * 32 * 136;
#pragma unroll
    for (int mt = 0; mt < 2; ++mt)
#pragma unroll
      for (int nt = 0; nt < 2; ++nt)
        *(u32x2*)(STc + (nt * 16 + fr) * 136 + (2 * wid + mt) * 16 + fq * 4) = (u32x2){pk2(S[mt][nt].x, S[mt][nt].y), pk2(S[mt][nt].z, S[mt][nt].w)};
    __syncthreads();
#pragma unroll
    for (int nt = 0; nt < 2; ++nt) {
      f32x4 a = (f32x4){0.f, 0.f, 0.f, 0.f};
#pragma unroll
      for (int ks = 0; ks < 4; ++ks) {
        const bf16x8 sb = *(const bf16x8*)(STc + (nt * 16 + fr) * 136 + ks * 32 + fq * 8);
        a = mfma16(fw[ks], sb, a);
      }
      const float v0 = lo2f(fu[nt].x) - a.x, v1 = hi2f(fu[nt].x) - a.y, v2 = lo2f(fu[nt].y) - a.z, v3 = hi2f(fu[nt].y) - a.w;
      *(u32x2*)(VT + (nt * 16 + fr) * 72 + wid * 16 + fq * 4) = (u32x2){pk2(v0, v1), pk2(v2, v3)};
    }
    __syncthreads();
#pragma unroll
    for (int mt = 0; mt < 2; ++mt) {
      f32x4 a = (f32x4){0.f, 0.f, 0.f, 0.f};
#pragma unroll
      for (int ks = 0; ks < 4; ++ks) {
        const bf16x8 sa = *(const bf16x8*)(STc + (mt * 16 + fr) * 136 + ks * 32 + fq * 8);
        a = mfma16(sa, fqg[ks], a);
      }
#pragma unroll
      for (int ks = 0; ks < 2; ++ks) {
        const bf16x8 va = *(const bf16x8*)(VT + (mt * 16 + fr) * 72 + ks * 32 + fq * 8);
        a = mfma16(va, fqk[ks], a);
      }
      const size_t row = (size_t)b * 2048 + n * 64 + wid * 16 + fr;
      *(u32x2*)(p.ogdn() + row * DM + h * 128 + dvs * 32 + mt * 16 + fq * 4) = (u32x2){pk2(a.x, a.y), pk2(a.z, a.w)};
    }
#pragma unroll
    for (int mt = 0; mt < 2; ++mt)
#pragma unroll
      for (int nt = 0; nt < 2; ++nt) {
        f32x4 a = S[mt][nt] * gs;
#pragma unroll
        for (int ks = 0; ks < 2; ++ks) {
          const bf16x8 vb = *(const bf16x8*)(VT + (nt * 16 + fr) * 72 + ks * 32 + fq * 8);
          a = mfma16(fkg[mt][ks], vb, a);
        }
        S[mt][nt] = a;
      }
  }
  float* so = p.out + O_GDNP + ((size_t)(l * 8 + b) * 8 + h) * 16384;
#pragma unroll
  for (int mt = 0; mt < 2; ++mt)
#pragma unroll
    for (int nt = 0; nt < 2; ++nt)
#pragma unroll
      for (int jj = 0; jj < 4; ++jj) so[((2 * wid + mt) * 16 + fq * 4 + jj) * 128 + dvs * 32 + nt * 16 + fr] = S[mt][nt][jj];
  __syncthreads();
#undef SCAN_LOAD
}

__device__ void gdn_sample_item(const Params& p, int l, int item, unsigned char* smem) {
  const int tid = (opq(threadIdx.x) & 255), lane = tid & 63, wid = tid >> 6;
  const int h = item & 7, b = item >> 3;
  float* qs = (float*)smem;
  float* ks = qs + 1024;
  float* vs = ks + 1024;
  float* part = vs + 1024;
  float* sbeta = part + 256;
  float* sa = sbeta + 8;
  const int dv = tid & 127, half = tid >> 7;
  float S[64];
  const float* s0 = p.state_gdn + ((size_t)(l * 128 + b) * 8 + h) * 16384 + (half * 8192 + dv);
#pragma unroll
  for (int k = 0; k < 64; ++k) S[k] = s0[k * 128];
#pragma unroll
  for (int ps = 0; ps < 2; ++ps) {
    const int c = tid + ps * 256;
    if (c < 384) {
      const int sect = c >> 7, ci = c & 127;
      const int ch = sect * 1024 + h * 128 + ci;
      float xw[11], cwv[4];
#pragma unroll
      for (int j = 0; j < 4; ++j) cwv[j] = p.conv_w[(size_t)(l * 4 + j) * 3072 + ch];
#pragma unroll
      for (int j = 0; j < 3; ++j) xw[j] = p.cache_conv[((size_t)(l * 128 + b) * 3 + j) * 3072 + ch];
#pragma unroll
      for (int t = 0; t < 8; ++t) xw[3 + t] = bf2f(p.proj()[(size_t)(MP + b * 8 + t) * NPJ + ch]);
      float* dst = sect == 0 ? qs : (sect == 1 ? ks : vs);
#pragma unroll
      for (int t = 0; t < 8; ++t) dst[t * 128 + ci] = silu(xw[t] * cwv[0] + xw[t + 1] * cwv[1] + xw[t + 2] * cwv[2] + xw[t + 3] * cwv[3]);
    }
  }
  if (tid < 8) {
    const float* lg = p.logits() + (size_t)(MP + b * 8 + tid) * 16;
    const float x = lg[8 + h] + p.dt_bias[l * 8 + h];
    const float sp = softplus_f(x);
    sa[tid] = __expf(-__expf(p.a_log[l * 8 + h]) * sp);
    sbeta[tid] = sigm(lg[h]);
  }
  __syncthreads();
#pragma unroll
  for (int u = 0; u < 4; ++u) {
    const int t = wid * 2 + (u >> 1);
    float* arr = (u & 1) ? ks : qs;
    const float a0 = arr[t * 128 + lane], a1 = arr[t * 128 + 64 + lane];
    float ss = a0 * a0 + a1 * a1;
#pragma unroll
    for (int o = 1; o < 64; o <<= 1) ss += shx(ss, o, lane);
    float rn = rsqrtf(ss + EPS);
    if (!(u & 1)) rn *= 0.08838834764831845f;
    arr[t * 128 + lane] = a0 * rn;
    arr[t * 128 + 64 + lane] = a1 * rn;
  }
  __syncthreads();
#pragma unroll 1
  for (int t = 0; t < 8; ++t) {
    const float a = sa[t], bt = sbeta[t];
    float kv = 0.f;
#pragma unroll
    for (int k4 = 0; k4 < 16; ++k4) {
      const f32x4 kk = *(const f32x4*)(ks + t * 128 + half * 64 + k4 * 4);
      S[k4 * 4 + 0] *= a; S[k4 * 4 + 1] *= a; S[k4 * 4 + 2] *= a; S[k4 * 4 + 3] *= a;
      kv += S[k4 * 4 + 0] * kk.x + S[k4 * 4 + 1] * kk.y + S[k4 * 4 + 2] * kk.z + S[k4 * 4 + 3] * kk.w;
      if ((k4 & 3) == 3) asm volatile("" ::: "memory");
    }
    part[half * 128 + dv] = kv;
    __syncthreads();
    const float delta = bt * (vs[t * 128 + dv] - (part[dv] + part[128 + dv]));
    __syncthreads();
    float o = 0.f;
#pragma unroll
    for (int k4 = 0; k4 < 16; ++k4) {
      const f32x4 kk = *(const f32x4*)(ks + t * 128 + half * 64 + k4 * 4);
      const f32x4 qq = *(const f32x4*)(qs + t * 128 + half * 64 + k4 * 4);
      S[k4 * 4 + 0] += kk.x * delta; S[k4 * 4 + 1] += kk.y * delta; S[k4 * 4 + 2] += kk.z * delta; S[k4 * 4 + 3] += kk.w * delta;
      o += S[k4 * 4 + 0] * qq.x + S[k4 * 4 + 1] * qq.y + S[k4 * 4 + 2] * qq.z + S[k4 * 4 + 3] * qq.w;
      if ((k4 & 3) == 3) asm volatile("" ::: "memory");
    }
    part[half * 128 + dv] = o;
    __syncthreads();
    if (half == 0) p.ogdn()[(size_t)(MP + b * 8 + t) * DM + h * 128 + dv] = f2bf(part[dv] + part[128 + dv]);
    __syncthreads();
  }
  float* so = p.out + O_GDNS + ((size_t)(l * 128 + b) * 8 + h) * 16384 + opq(half * 8192 + dv);
#pragma unroll
  for (int k = 0; k < 64; ++k) so[k * 128] = S[k];
  __syncthreads();
}

__device__ void gdn_sample_pair(const Params& p, int l, int pair, unsigned char* smem) {
  const int tid = (opq(threadIdx.x) & 255), lane = tid & 63, wid = tid >> 6;
  const int sub = tid >> 7, dv = tid & 127;
  const int item = pair * 2 + sub, h = item & 7, b = item >> 3;
  float* qs = (float*)smem + sub * 3104;
  float* ks = qs + 1024;
  float* vs = qs + 2048;
  float* sbeta = qs + 3072;
  float* sa = qs + 3080;
  f32x2 S2[64];
  const float* s0 = p.state_gdn + ((size_t)(l * 128 + b) * 8 + h) * 16384 + dv;
#pragma unroll
  for (int k = 0; k < 64; ++k) { S2[k].x = s0[(2 * k) * 128]; S2[k].y = s0[(2 * k + 1) * 128]; }
#pragma unroll
  for (int sect = 0; sect < 3; ++sect) {
    const int ch = sect * 1024 + h * 128 + dv;
    float xw[11], cwv[4];
#pragma unroll
    for (int j = 0; j < 4; ++j) cwv[j] = p.conv_w[(size_t)(l * 4 + j) * 3072 + ch];
#pragma unroll
    for (int j = 0; j < 3; ++j) xw[j] = p.cache_conv[((size_t)(l * 128 + b) * 3 + j) * 3072 + ch];
#pragma unroll
    for (int t = 0; t < 8; ++t) xw[3 + t] = bf2f(p.proj()[(size_t)(MP + b * 8 + t) * NPJ + ch]);
    float* dst = sect == 0 ? qs : (sect == 1 ? ks : vs);
#pragma unroll
    for (int t = 0; t < 8; ++t) dst[t * 128 + dv] = silu(xw[t] * cwv[0] + xw[t + 1] * cwv[1] + xw[t + 2] * cwv[2] + xw[t + 3] * cwv[3]);
  }
  if (dv < 8) {
    const float* lg = p.logits() + (size_t)(MP + b * 8 + dv) * 16;
    const float x = lg[8 + h] + p.dt_bias[l * 8 + h];
    sa[dv] = __expf(-__expf(p.a_log[l * 8 + h]) * softplus_f(x));
    sbeta[dv] = sigm(lg[h]);
  }
  __syncthreads();
#pragma unroll
  for (int u = 0; u < 8; ++u) {
    const int t = (wid & 1) * 4 + (u >> 1);
    float* arr = (u & 1) ? ks : qs;
    const float a0 = arr[t * 128 + lane], a1 = arr[t * 128 + 64 + lane];
    float ss = a0 * a0 + a1 * a1;
#pragma unroll
    for (int o = 1; o < 64; o <<= 1) ss += shx(ss, o, lane);
    float rn = rsqrtf(ss + EPS);
    if (!(u & 1)) rn *= 0.08838834764831845f;
    arr[t * 128 + lane] = a0 * rn;
    arr[t * 128 + 64 + lane] = a1 * rn;
  }
  __syncthreads();
#pragma unroll 1
  for (int t = 0; t < 8; ++t) {
    const float a = sa[t], bt = sbeta[t];
    f32x2 kv2 = (f32x2){0.f, 0.f};
#pragma unroll
    for (int k4 = 0; k4 < 32; ++k4) {
      const f32x4 kk = *(const f32x4*)(ks + t * 128 + k4 * 4);
      kv2 += S2[2 * k4] * (f32x2){kk.x, kk.y};
      kv2 += S2[2 * k4 + 1] * (f32x2){kk.z, kk.w};
      if ((k4 & 3) == 3) asm volatile("" ::: "memory");
    }
    const float delta = bt * (vs[t * 128 + dv] - a * (kv2.x + kv2.y));
    const f32x2 a2 = (f32x2){a, a}, d2 = (f32x2){delta, delta};
    f32x2 o2 = (f32x2){0.f, 0.f};
#pragma unroll
    for (int k4 = 0; k4 < 32; ++k4) {
      const f32x4 kk = *(const f32x4*)(ks + t * 128 + k4 * 4);
      const f32x4 qq = *(const f32x4*)(qs + t * 128 + k4 * 4);
      S2[2 * k4] = S2[2 * k4] * a2 + (f32x2){kk.x, kk.y} * d2;
      S2[2 * k4 + 1] = S2[2 * k4 + 1] * a2 + (f32x2){kk.z, kk.w} * d2;
      o2 += S2[2 * k4] * (f32x2){qq.x, qq.y};
      o2 += S2[2 * k4 + 1] * (f32x2){qq.z, qq.w};
      if ((k4 & 3) == 3) asm volatile("" ::: "memory");
    }
    p.ogdn()[(size_t)(MP + b * 8 + t) * DM + h * 128 + dv] = f2bf(o2.x + o2.y);
  }
  float* so = p.out + O_GDNS + ((size_t)(l * 128 + b) * 8 + h) * 16384 + opq(dv);
#pragma unroll
  for (int k = 0; k < 64; ++k) { so[(2 * k) * 128] = S2[k].x; so[(2 * k + 1) * 128] = S2[k].y; }
  __syncthreads();
}

__device__ void swa_prompt_item(const Params& p, int l, int item, unsigned char* smem) {
  const int tid = (opq(threadIdx.x) & 255), lane = tid & 63, wid = tid >> 6, fr = lane & 15, fq = lane >> 4;
  const int kvh = item & 3, hb2 = (item >> 2) & 31, b = item >> 7;
  bf16_t* Ks = (bf16_t*)smem;
  bf16_t* VT = Ks + 208 * 72;
  bf16_t* Pw = VT + 64 * 216 + wid * 16 * 168;
  const int tk0 = hb2 * 64 - 128;
  u32x4 krw[7], vrw[7];
#pragma unroll
  for (int i = 0; i < 7; ++i) {
    const int pc = tid + i * NTHR, kj = pc >> 3, c8 = pc & 7, tk = tk0 + kj;
    krw[i] = (u32x4){0u, 0u, 0u, 0u}; vrw[i] = (u32x4){0u, 0u, 0u, 0u};
    if (pc < 208 * 8 && kj < 192 && tk >= 0) {
      const bf16_t* base = p.proj() + (size_t)(b * 2048 + tk) * NPJ + kvh * 64 + c8 * 8;
      krw[i] = *(const u32x4*)(base + C_SK); vrw[i] = *(const u32x4*)(base + C_SV);
    }
  }
#pragma unroll
  for (int i = 0; i < 7; ++i) {
    const int pc = tid + i * NTHR;
    if (pc >= 208 * 8) break;
    const int kj = pc >> 3, c8 = pc & 7, tk = tk0 + kj;
    const bool ok = kj < 192 && tk >= 0;
    float kf[8], vf[8];
    UNPACK8(krw[i], kf);
    UNPACK8(vrw[i], vf);
    float ss = 0.f;
#pragma unroll
    for (int c = 0; c < 8; ++c) ss += kf[c] * kf[c];
    ss += shx(ss, 1, lane); ss += shx(ss, 2, lane); ss += shx(ss, 4, lane);
    const float rn = rsqrtf(ss * (1.f / 64.f) + EPS);
    const f32x4 w0 = *(const f32x4*)(p.k_norm + l * 64 + c8 * 8), w1 = *(const f32x4*)(p.k_norm + l * 64 + c8 * 8 + 4);
    kf[0] *= rn * w0.x; kf[1] *= rn * w0.y; kf[2] *= rn * w0.z; kf[3] *= rn * w0.w;
    kf[4] *= rn * w1.x; kf[5] *= rn * w1.y; kf[6] *= rn * w1.z; kf[7] *= rn * w1.w;
    *(u32x4*)(Ks + kj * 72 + c8 * 8) = (u32x4){pk2(kf[0], kf[1]), pk2(kf[2], kf[3]), pk2(kf[4], kf[5]), pk2(kf[6], kf[7])};
#pragma unroll
    for (int c = 0; c < 8; ++c) VT[(c8 * 8 + c) * 216 + kj] = f2bf(vf[c]);
    if (ok && tk >= 1920 && kj >= 128) {
      float* ko = p.out + O_KP + (((size_t)(l * 8 + b) * 128 + (tk - 1920)) * 4 + kvh) * 64 + c8 * 8;
      float* vo = p.out + O_VP + (((size_t)(l * 8 + b) * 128 + (tk - 1920)) * 4 + kvh) * 64 + c8 * 8;
      *(f32x4*)ko = (f32x4){kf[0], kf[1], kf[2], kf[3]};
      *(f32x4*)(ko + 4) = (f32x4){kf[4], kf[5], kf[6], kf[7]};
      *(f32x4*)vo = (f32x4){vf[0], vf[1], vf[2], vf[3]};
      *(f32x4*)(vo + 4) = (f32x4){vf[4], vf[5], vf[6], vf[7]};
    }
  }
  __syncthreads();
  const int kbase = wid * 16;
  const int ql = wid * 16 + fr;
  const size_t qrow = (size_t)b * 2048 + hb2 * 64 + ql;
  u32x4 qraw[4][2];
#pragma unroll
  for (int g = 0; g < 4; ++g) {
    const bf16_t* qp = p.proj() + qrow * NPJ + C_SQ + (kvh * 4 + g) * 64 + fq * 8;
    qraw[g][0] = *(const u32x4*)qp; qraw[g][1] = *(const u32x4*)(qp + 32);
  }
#pragma unroll
  for (int g = 0; g < 4; ++g) {
    const int head = kvh * 4 + g;
    const float slope = exp2f(-0.5f * (float)(head + 1));
    const float sink = p.sinks[l * 16 + head];
    bf16x8 qf[2];
    {
      const u32x4 r0 = qraw[g][0], r1 = qraw[g][1];
      float f0[8], f1[8];
      UNPACK8(r0, f0);
      UNPACK8(r1, f1);
      float ss = 0.f;
#pragma unroll
      for (int c = 0; c < 8; ++c) ss += f0[c] * f0[c] + f1[c] * f1[c];
      ss += shx(ss, 16, lane); ss += shx(ss, 32, lane);
      const float rn = rsqrtf(ss * (1.f / 64.f) + EPS) * 0.125f;
      const float* qn = p.q_norm + l * 64 + fq * 8;
#pragma unroll
      for (int c = 0; c < 8; ++c) { f0[c] *= rn * qn[c]; f1[c] *= rn * qn[32 + c]; }
      qf[0] = as_bf((u32x4){pk2(f0[0], f0[1]), pk2(f0[2], f0[3]), pk2(f0[4], f0[5]), pk2(f0[6], f0[7])});
      qf[1] = as_bf((u32x4){pk2(f1[0], f1[1]), pk2(f1[2], f1[3]), pk2(f1[4], f1[5]), pk2(f1[6], f1[7])});
    }
    f32x4 sc[9];
    float mx = sink;
#pragma unroll
    for (int kt = 0; kt < 9; ++kt) {
      f32x4 a = (f32x4){0.f, 0.f, 0.f, 0.f};
#pragma unroll
      for (int ks = 0; ks < 2; ++ks) {
        const bf16x8 kf = *(const bf16x8*)(Ks + (kbase + kt * 16 + fr) * 72 + ks * 32 + fq * 8);
        a = mfma16(kf, qf[ks], a);
      }
#pragma unroll
      for (int jj = 0; jj < 4; ++jj) {
        const int kj = kbase + kt * 16 + fq * 4 + jj;
        const int dist = ql + 128 - kj;
        const bool ok = dist >= 0 && dist <= 128 && (tk0 + kj) >= 0;
        const float s = ok ? a[jj] - slope * (float)dist : -INFINITY;
        a[jj] = s;
        mx = fmaxf(mx, s);
      }
      sc[kt] = a;
    }
    mx = fmaxf(mx, shx(mx, 16, lane));
    mx = fmaxf(mx, shx(mx, 32, lane));
    float sum = 0.f;
#pragma unroll
    for (int kt = 0; kt < 9; ++kt) {
      f32x4 e;
#pragma unroll
      for (int jj = 0; jj < 4; ++jj) { e[jj] = __expf(sc[kt][jj] - mx); sum += e[jj]; }
      *(u32x2*)(Pw + fr * 168 + kt * 16 + fq * 4) = (u32x2){pk2(e.x, e.y), pk2(e.z, e.w)};
    }
    *(u32x2*)(Pw + fr * 168 + 144 + fq * 4) = (u32x2){0u, 0u};
    sum += shx(sum, 16, lane);
    sum += shx(sum, 32, lane);
    const float inv = 1.f / (sum + __expf(sink - mx));
    __builtin_amdgcn_wave_barrier();
#pragma unroll
    for (int dt = 0; dt < 4; ++dt) {
      f32x4 a = (f32x4){0.f, 0.f, 0.f, 0.f};
#pragma unroll
      for (int ks = 0; ks < 5; ++ks) {
        const bf16x8 vf = *(const bf16x8*)(VT + (dt * 16 + fr) * 216 + kbase + ks * 32 + fq * 8);
        const bf16x8 pf = *(const bf16x8*)(Pw + fr * 168 + ks * 32 + fq * 8);
        a = mfma16(vf, pf, a);
      }
      a *= inv;
      *(u32x2*)(p.oswa() + qrow * DM + head * 64 + dt * 16 + fq * 4) = (u32x2){pk2(a.x, a.y), pk2(a.z, a.w)};
    }
    __builtin_amdgcn_wave_barrier();
  }
  __syncthreads();
}

__device__ void swa_sample_item(const Params& p, int l, int item, unsigned char* smem) {
  const int tid = (opq(threadIdx.x) & 255), lane = tid & 63, wid = tid >> 6;
  const int kvh = item & 3, b = item >> 2;
  float* Ks = (float*)smem;
  float* Vs = Ks + 136 * 68;
  float* Qs = Vs + 136 * 64;
  float* Sc = Qs + 512;
  const size_t cbase = (size_t)(l * 128 + b) * 128;
  f32x4 kvr[8], vvr[8];
#pragma unroll
  for (int i = 0; i < 8; ++i) {
    const int idx = tid + i * NTHR, j = idx >> 4, c4 = idx & 15;
    kvr[i] = *(const f32x4*)(p.cache_k + ((cbase + j) * 4 + kvh) * 64 + c4 * 4);
    vvr[i] = *(const f32x4*)(p.cache_v + ((cbase + j) * 4 + kvh) * 64 + c4 * 4);
  }
  unsigned qrw[4];
#pragma unroll
  for (int g = 0; g < 4; ++g) qrw[g] = *(const unsigned*)(p.proj() + (size_t)(MP + b * 8 + (tid >> 5)) * NPJ + C_SQ + (kvh * 4 + g) * 64 + (tid & 31) * 2);
#pragma unroll
  for (int i = 0; i < 8; ++i) {
    const int idx = tid + i * NTHR, j = idx >> 4, c4 = idx & 15;
    const f32x4 kv = kvr[i], vv = vvr[i];
    *(f32x4*)(Ks + j * 68 + c4 * 4) = kv;
    *(f32x4*)(Vs + j * 64 + c4 * 4) = vv;
  }
  {
    const int t = tid >> 5, d = (tid & 31) * 2;
    const bf16_t* base = p.proj() + (size_t)(MP + b * 8 + t) * NPJ + kvh * 64 + d;
    const unsigned kr = *(const unsigned*)(base + C_SK), vr = *(const unsigned*)(base + C_SV);
    float k0 = lo2f(kr), k1 = hi2f(kr);
    float ss = k0 * k0 + k1 * k1;
#pragma unroll
    for (int o = 1; o < 32; o <<= 1) ss += shx(ss, o, lane);
    const float rn = rsqrtf(ss * (1.f / 64.f) + EPS);
    Ks[(128 + t) * 68 + d] = k0 * rn * p.k_norm[l * 64 + d];
    Ks[(128 + t) * 68 + d + 1] = k1 * rn * p.k_norm[l * 64 + d + 1];
    Vs[(128 + t) * 64 + d] = lo2f(vr);
    Vs[(128 + t) * 64 + d + 1] = hi2f(vr);
  }
  __syncthreads();
  for (int idx = tid; idx < 128 * 64; idx += NTHR) {
    const int j = idx >> 6, d = idx & 63;
    p.out[O_KS + ((cbase + j) * 4 + kvh) * 64 + d] = Ks[(j + 8) * 68 + d];
    p.out[O_VS + ((cbase + j) * 4 + kvh) * 64 + d] = Vs[(j + 8) * 64 + d];
  }
#pragma unroll
  for (int g = 0; g < 4; ++g) {
    const int head = kvh * 4 + g;
    const float slope = exp2f(-0.5f * (float)(head + 1));
    const float sink = p.sinks[l * 16 + head];
    {
      const int t = tid >> 5, d = (tid & 31) * 2;
      const unsigned qr = qrw[g];
      const float q0 = lo2f(qr), q1 = hi2f(qr);
      float ss = q0 * q0 + q1 * q1;
#pragma unroll
      for (int o = 1; o < 32; o <<= 1) ss += shx(ss, o, lane);
      const float rn = rsqrtf(ss * (1.f / 64.f) + EPS) * 0.125f;
      Qs[t * 64 + d] = q0 * rn * p.q_norm[l * 64 + d];
      Qs[t * 64 + d + 1] = q1 * rn * p.q_norm[l * 64 + d + 1];
    }
    __syncthreads();
    for (int idx = tid; idx < 8 * 136; idx += NTHR) {
      const int tq = idx / 136, j = idx % 136;
      float s = 0.f;
#pragma unroll
      for (int d4 = 0; d4 < 16; ++d4) {
        const f32x4 qv = *(const f32x4*)(Qs + tq * 64 + d4 * 4), kq = *(const f32x4*)(Ks + j * 68 + d4 * 4);
        s += (qv.x * kq.x + qv.y * kq.y) + (qv.z * kq.z + qv.w * kq.w);
      }
      const int dist = tq + 128 - j;
      Sc[tq * 136 + j] = (dist >= 0 && dist <= 128) ? s - slope * (float)dist : -INFINITY;
    }
    __syncthreads();
#pragma unroll
    for (int u = 0; u < 2; ++u) {
      const int tq = wid * 2 + u;
      const float s0 = Sc[tq * 136 + lane], s1 = Sc[tq * 136 + 64 + lane], s2 = lane < 8 ? Sc[tq * 136 + 128 + lane] : -INFINITY;
      float mx = fmaxf(fmaxf(s0, s1), fmaxf(s2, sink));
#pragma unroll
      for (int o = 1; o < 64; o <<= 1) mx = fmaxf(mx, shx(mx, o, lane));
      const float e0 = __expf(s0 - mx), e1 = __expf(s1 - mx), e2 = __expf(s2 - mx);
      float sum = e0 + e1 + e2;
#pragma unroll
      for (int o = 1; o < 64; o <<= 1) sum += shx(sum, o, lane);
      const float inv = 1.f / (sum + __expf(sink - mx));
      Sc[tq * 136 + lane] = e0 * inv;
      Sc[tq * 136 + 64 + lane] = e1 * inv;
      if (lane < 8) Sc[tq * 136 + 128 + lane] = e2 * inv;
    }
    __syncthreads();
    {
      const int tq = tid >> 5, d = (tid & 31) * 2;
      float o0 = 0.f, o1 = 0.f;
#pragma unroll 2
      for (int j4 = 0; j4 < 34; ++j4) {
        const f32x4 pj = *(const f32x4*)(Sc + tq * 136 + j4 * 4);
        const f32x2 va = *(const f32x2*)(Vs + (j4 * 4 + 0) * 64 + d), vb = *(const f32x2*)(Vs + (j4 * 4 + 1) * 64 + d);
        const f32x2 vc = *(const f32x2*)(Vs + (j4 * 4 + 2) * 64 + d), vd = *(const f32x2*)(Vs + (j4 * 4 + 3) * 64 + d);
        o0 += (pj.x * va.x + pj.y * vb.x) + (pj.z * vc.x + pj.w * vd.x);
        o1 += (pj.x * va.y + pj.y * vb.y) + (pj.z * vc.y + pj.w * vd.y);
      }
      *(unsigned*)(p.oswa() + (size_t)(MP + b * 8 + tq) * DM + head * 64 + d) = pk2(o0, o1);
    }
    __syncthreads();
  }
}

__device__ void phase_mix(const Params& p, int l) {
  const int tid = (opq(threadIdx.x) & 255), lane = tid & 63, wid = tid >> 6, fr = lane & 15, fq = lane >> 4;
  for (int it = VB; it < MTOK / 4; it += VG) {
    const size_t row = (size_t)it * 4 + wid;
#pragma unroll
    for (int ps = 0; ps < 2; ++ps) {
      const int ch = (ps * 4 + fq) * 128 + fr * 8;
      const u32x4 og = *(const u32x4*)(p.ogdn() + row * DM + ch);
      const u32x4 ob = *(const u32x4*)(p.oswa() + row * DM + ch);
      const u32x4 zz = *(const u32x4*)(p.proj() + row * NPJ + C_Z + ch);
      const u32x4 ga = *(const u32x4*)(p.proj() + row * NPJ + C_G + ch);
      const u32x4 gb = *(const u32x4*)(p.proj() + row * NPJ + C_G + 1024 + ch);
      float fo[8], fb[8], fz[8], fa[8], fg[8];
      UNPACK8(og, fo); UNPACK8(ob, fb); UNPACK8(zz, fz); UNPACK8(ga, fa); UNPACK8(gb, fg);
      float ss = 0.f;
#pragma unroll
      for (int c = 0; c < 8; ++c) ss += fo[c] * fo[c];
      ss += shx(ss, 1, lane); ss += shx(ss, 2, lane); ss += shx(ss, 4, lane); ss += shx(ss, 8, lane);
      const float rn = rsqrtf(ss * (1.f / 128.f) + EPS);
      const f32x4 w0 = *(const f32x4*)(p.gdn_norm + l * 128 + fr * 8), w1 = *(const f32x4*)(p.gdn_norm + l * 128 + fr * 8 + 4);
      const float wn[8] = {w0.x, w0.y, w0.z, w0.w, w1.x, w1.y, w1.z, w1.w};
      float m[8];
#pragma unroll
      for (int c = 0; c < 8; ++c) m[c] = sigm(fa[c]) * (fo[c] * rn * wn[c] * silu(fz[c])) + sigm(fg[c]) * fb[c];
      *(u32x4*)(p.mix() + row * DM + ch) = (u32x4){pk2(m[0], m[1]), pk2(m[2], m[3]), pk2(m[4], m[5]), pk2(m[6], m[7])};
    }
  }
  const int NC = (8 + 128) * 3 * 3072;
  for (int i = VB * NTHR + tid; i < NC; i += VG * NTHR) {
    const int c = i % 3072, r = (i / 3072) % 3, bb = i / 9216;
    if (bb < 8) p.out[O_CONVP + ((size_t)(l * 8 + bb) * 3 + r) * 3072 + c] = bf2f(p.proj()[(size_t)(bb * 2048 + 2045 + r) * NPJ + c]);
    else p.out[O_CONVS + ((size_t)(l * 128 + bb - 8) * 3 + r) * 3072 + c] = bf2f(p.proj()[(size_t)(MP + (bb - 8) * 8 + 5 + r) * NPJ + c]);
  }
}

#define XB_TMO      128
#define XB_XCNT(j)  (256  + 64 * (j))
#define XB_XSUB(j)  (1280 + 64 * (j))
#define XB_XGEN(j)  (2304 + 64 * (j))
#define XB_TOP      3328
#define XB_TOPGEN   3392
#define XCD_BAR_WORDS 3456
#define XB_SPIN_CAP (1u << 18)
#define LAS __attribute__((address_space(3)))

__device__ __forceinline__ unsigned xb_ld(unsigned* p)              { return __hip_atomic_load(p, __ATOMIC_RELAXED, __HIP_MEMORY_SCOPE_AGENT); }
__device__ __forceinline__ unsigned xb_add(unsigned* p, unsigned v) { return __hip_atomic_fetch_add(p, v, __ATOMIC_RELAXED, __HIP_MEMORY_SCOPE_AGENT); }
__device__ __forceinline__ unsigned xb_xcc_id() { return (unsigned)__builtin_amdgcn_s_getreg((3 << 11) | 20) & 0xFu; }
#define XB_SPIN(cond, bar) do { unsigned _sp = 0; while (cond) { __builtin_amdgcn_s_sleep(1); \
    if ((++_sp & 255u) == 0u) { if (xb_ld(&(bar)[XB_TMO])) break; if (_sp > XB_SPIN_CAP) { atomicAdd(&(bar)[XB_TMO], 1u); break; } } } } while (0)

struct XcdBarrier {
    unsigned* bar; unsigned x;
    volatile LAS unsigned* st;
};

__device__ __forceinline__ XcdBarrier xcd_barrier_post(unsigned* bar, volatile LAS unsigned* st) {
    XcdBarrier b; b.bar = bar; b.x = xb_xcc_id(); b.st = st;
    if (threadIdx.x == 0) (void)xb_add(&bar[XB_XCNT(b.x)], 1u);
    return b;
}
__device__ __forceinline__ void xcd_barrier_complete(unsigned* bar, unsigned x, unsigned& nloc, unsigned& nx) {
    const unsigned G = gridDim.x * gridDim.y * gridDim.z;
    unsigned sum, cnt, mine, sp = 0u;
    for (;;) {
        sum = 0u; cnt = 0u; mine = 0u;
#pragma unroll
        for (unsigned j = 0; j < 16; ++j) { const unsigned c = xb_ld(&bar[XB_XCNT(j)]); sum += c; cnt += (c > 0u) ? 1u : 0u; mine = (j == x) ? c : mine; }
        if (sum == G) break;
        __builtin_amdgcn_s_sleep(1);
        if ((++sp & 255u) == 0u) { if (xb_ld(&bar[XB_TMO])) break; if (sp > XB_SPIN_CAP) { atomicAdd(&bar[XB_TMO], 1u); break; } }
    }
    nloc = mine > 0u ? mine : 1u; nx = cnt > 0u ? cnt : 1u;
}

__device__ __forceinline__ void xcd_barrier(const XcdBarrier& b) {
    asm volatile("s_waitcnt vmcnt(0)" ::: "memory");
    __syncthreads();
    if (threadIdx.x == 0) {
        unsigned* bar = b.bar;
        __builtin_amdgcn_s_waitcnt(0);
        unsigned nloc = b.st[0], nx = b.st[1];
        if (nloc == 0u) { xcd_barrier_complete(bar, b.x, nloc, nx); b.st[0] = nloc; b.st[1] = nx; }
        const unsigned old = xb_add(&bar[XB_XSUB(b.x)], 1u);
        const unsigned gen = old / nloc;
        if (old + 1u == (gen + 1u) * nloc) {
            __builtin_amdgcn_fence(__ATOMIC_RELEASE, "agent");
            asm volatile("s_waitcnt vmcnt(0)" ::: "memory");
            const unsigned og = xb_add(&bar[XB_TOP], 1u);
            const unsigned tg = og / nx;
            if (og + 1u == (tg + 1u) * nx) xb_add(&bar[XB_TOPGEN], 1u);
            else XB_SPIN(xb_ld(&bar[XB_TOPGEN]) == tg, bar);
            __builtin_amdgcn_fence(__ATOMIC_ACQUIRE, "agent");
            xb_add(&bar[XB_XGEN(b.x)], 1u);
            asm volatile("s_waitcnt vmcnt(0)" ::: "memory");
        } else {
            XB_SPIN(xb_ld(&bar[XB_XGEN(b.x)]) == gen, bar);
            __builtin_amdgcn_fence(__ATOMIC_ACQUIRE, "agent");
            asm volatile("s_waitcnt vmcnt(0)" ::: "memory");
        }
    }
    __syncthreads();
}


#define NPHASE_PRE 2
#define NPHASE_L 8
constexpr int LDS_TOTAL = 2 * SMEM_BYTES;
__global__ void __launch_bounds__(512, 2) mega(Params p, int ph_lo, int ph_hi) {
  extern __shared__ __attribute__((aligned(16))) unsigned char lds_all[];
  if (ph_hi < 0) cg::this_grid().sync();
  __shared__ uint4 xb_words;
  if (threadIdx.x == 0) xb_words = make_uint4(0u, 0u, 0u, 0u);
  __syncthreads();
  XcdBarrier xb = xcd_barrier_post(p.bar(), (volatile LAS unsigned*)&xb_words);
  unsigned char* smem = lds_all + VHALF * SMEM_BYTES;
  for (int ph = ph_lo; ph < ph_hi; ++ph) {
    if (ph > ph_lo) xcd_barrier(xb);
    if (ph == 0) { phase_p0(p, smem); continue; }
    if (ph == 1) {
      {
        EpiArgs e{};
        e.obf = p.pp(); e.ldo = DM;
        DiagSched S; S.nLimit = 1024; S.G = gridDim.x; S.c = blockIdx.x;
        pg8::Gemm g; g.A = p.pb(); g.Bt = p.wt_proj(); g.M = NL * MTOK; g.N = NL * DM; g.K = PLE;
        BigEpi<EPI_PP> E; E.e = e;
        pg8::gemm_phase<BigEpi<EPI_PP>, DiagSched>((PG8_LAS unsigned char*)lds_all, g, S, E, nullptr);
        __syncthreads();
      }
      for (int st = VB; st < 64 * 16; st += VG) {
        const int L = 1024 + (st >> 4), sub = st & 15, l = L / 272, r = L - l * 272, pm = r >> 2, pn = r & 3;
        EpiArgs e{};
        e.obf = p.pp() + (size_t)l * MTOK * DM; e.ldo = DM;
        gemm_tile<1, 4, 4, 1, EPI_PP, 128>(p.pb() + (size_t)l * MTOK * PLE, PLE, p.wt_proj() + (size_t)l * DM * PLE, PLE, PLE, pm * 256 + (sub >> 2) * 64, pn * 256 + (sub & 3) * 64, (bf16_t*)smem, e);
      }
      continue;
    }
    const int l = (ph - NPHASE_PRE) / NPHASE_L, s = (ph - NPHASE_PRE) % NPHASE_L;
#ifndef REPMASK
#define REPMASK 0
#endif
    for (int rep = 0; rep < (((REPMASK >> s) & 1) ? 2 : 1); ++rep) {
    if (rep) xcd_barrier(xb);
    switch (s) {
      case 0: {
        EpiArgs e{};
        e.ssq_in = p.ssq0(); e.obf = p.proj(); e.ldo = NPJ; e.of32 = p.logits();
        const bf16_t* Bt = p.wt_in() + (size_t)l * NIN * DM;
        gemm_big_phase<EPI_PROJ>(p.hb(), Bt, DM, MTOK, NPJ, lds_all, smem, e);
        for (int t = VB; t < 272; t += VG)
          gemm_tile<1, 1, 4, 1, EPI_LOGIT, 128>(p.hb(), DM, Bt + (size_t)NPJ * DM, DM, DM, t * 64, 0, (bf16_t*)smem, e);
      } break;
      case 1: {
        const int nB1 = VG == 512 ? 3072 : 3584;
        for (int t = VB; t < nB1; t += VG) {
          if (t < 2048) gdn_prep_item(p, l, t, smem);
          else if (t < 3072) swa_prompt_item(p, l, t - 2048, smem);
          else swa_sample_item(p, l, t - 3072, smem);
        }
      } break;
      case 2: {
        if (VG == 512) {
          if (VB < 256) gdn_scan_item(p, l, VB, smem);
          else {
            gdn_sample_pair(p, l, VB - 256, smem); gdn_sample_pair(p, l, VB, smem);
            swa_sample_item(p, l, (VB - 256) * 2, smem); swa_sample_item(p, l, (VB - 256) * 2 + 1, smem);
          }
        } else {
          for (int t = VB; t < 256 + 512; t += VG) {
            if (t < 256) gdn_scan_item(p, l, t, smem);
            else gdn_sample_pair(p, l, t - 256, smem);
          }
        }
      } break;
      case 3: phase_mix(p, l); break;
      case 4: {
        EpiArgs e{};
        e.h = p.out; e.hb = p.hb2(); e.ssq_out = p.ssq1();
        gemm_big_phase<EPI_RESID>(p.mix(), p.wt_out() + (size_t)l * DM * DM, DM, MTOK, DM, lds_all, smem, e);
      } break;
      case 5: {
        EpiArgs e{};
        e.ssq_in = p.ssq1(); e.obf = p.proj(); e.ldo = DFF;
        gemm_big_phase<EPI_UP>(p.hb2(), p.wt_up() + (size_t)l * DFF * DM, DM, MTOK, DFF, lds_all, smem, e);
      } break;
      case 6: {
        EpiArgs e{};
        e.h = p.out; e.hb = p.hb2(); e.ssq_out = p.ssq2();
        gemm_big_phase<EPI_RESID>(p.proj(), p.wt_down() + (size_t)l * DM * DFF, DFF, MTOK, DM, lds_all, smem, e);
      } break;
      case 7: {
        EpiArgs e{};
        e.h = p.out; e.hb = p.hb(); e.ssq_in = p.ssq2(); e.ssq_out = p.ssq0(); e.pp = p.pp() + (size_t)l * MTOK * DM;
        gemm_big_phase<EPI_PLE>(p.hb2(), p.wt_gate() + (size_t)l * DM * DM, DM, MTOK, DM, lds_all, smem, e);
      } break;
    }
    }
  }
}

extern "C" void kernel_launch(void* const* d_in, const int* in_sizes, int n_in, void* d_out, int out_size, void* d_ws, size_t ws_size,
                              hipStream_t stream) {
  Params p{};
  const float* const* in = (const float* const*)d_in;
  p.x_prompt = in[0]; p.x_sample = in[1]; p.cache_conv = in[2]; p.state_gdn = in[3]; p.cache_k = in[4]; p.cache_v = in[5];
  p.p_prompt = in[6]; p.p_sample = in[7]; p.norm_mix = in[8]; p.w_in = in[9]; p.conv_w = in[10]; p.a_log = in[11]; p.dt_bias = in[12];
  p.gdn_norm = in[13]; p.q_norm = in[14]; p.k_norm = in[15]; p.sinks = in[16]; p.w_out = in[17]; p.norm_ffn = in[18]; p.w_up = in[19];
  p.w_down = in[20]; p.norm_ple = in[21]; p.w_gate = in[22]; p.w_proj = in[23];
  p.out = (float*)d_out;
  p.ws = (unsigned char*)d_ws;
  if (WS_TOTAL > ws_size) { fprintf(stderr, "workspace too small: need %zu have %zu\n", (size_t)WS_TOTAL, ws_size); return; }

  static int grid_blocks = 0;
  if (!grid_blocks) {
    int dev = 0, cus = 0, per_cu = 0;
    (void)hipGetDevice(&dev);
    (void)hipDeviceGetAttribute(&cus, hipDeviceAttributeMultiprocessorCount, dev);
    if (hipFuncSetAttribute((const void*)mega, hipFuncAttributeMaxDynamicSharedMemorySize, LDS_TOTAL) != hipSuccess) { fprintf(stderr, "hipFuncSetAttribute(dynamic LDS %d) failed\n", LDS_TOTAL); grid_blocks = -1; return; }
    (void)hipOccupancyMaxActiveBlocksPerMultiprocessor(&per_cu, (const void*)mega, 512, LDS_TOTAL);
    (void)hipGetLastError();
    grid_blocks = cus;
  }
  if (grid_blocks < 0) return;
  (void)hipMemsetAsync(p.ws + WO_bar, 0, (size_t)XCD_BAR_WORDS * 4, stream);
  int lo = 0, hi = NPHASE_PRE + NL * NPHASE_L;
  void* args[] = {&p, &lo, &hi};
  hipError_t e = hipLaunchCooperativeKernel((void*)mega, dim3(grid_blocks), dim3(512), args, LDS_TOTAL, stream);
  if (e != hipSuccess) fprintf(stderr, "cooperative launch failed: %s (grid %d)\n", hipGetErrorString(e), grid_blocks);
}
```

```cpp
#include <hip/hip_runtime.h>
#include <hip/hip_cooperative_groups.h>
#include <cstdio>
namespace cg = cooperative_groups;

typedef unsigned short bf16_t;
typedef short bf16x8 __attribute__((ext_vector_type(8)));
typedef float f32x4 __attribute__((ext_vector_type(4)));
typedef float f32x2 __attribute__((ext_vector_type(2)));
typedef unsigned u32x4 __attribute__((ext_vector_type(4)));
typedef unsigned u32x2 __attribute__((ext_vector_type(2)));

#define DEVI __device__ __forceinline__
DEVI int opq(int x) { asm volatile("" : "+v"(x)); return x; }

#define VHALF ((int)__builtin_amdgcn_readfirstlane((int)(threadIdx.x >> 8)))
#define VB ((int)blockIdx.x * 2 + VHALF)
#define VG ((int)gridDim.x * 2)
constexpr int NL = 4;
constexpr int MTOK = 17408, MP = 16384, MS = 1024;
constexpr int DM = 1024, NIN = 7696, NPJ = 7680, DFF = 4096, PLE = 256;
constexpr int C_Z = 3072, C_SQ = 4096, C_SK = 5120, C_SV = 5376, C_G = 5632;
constexpr float EPS = 1e-6f;
constexpr int NTHR = 256;
constexpr int SMEM_BYTES = 79872;
constexpr size_t SCR_ITEM = 73728;

constexpr size_t O_YP = 0, O_YS = 16777216, O_CONVP = 17825792, O_GDNP = 18120704, O_KP = 22315008, O_VP = 23363584,
                 O_CONVS = 24412160, O_GDNS = 29130752, O_KS = 96239616, O_VS = 113016832, O_END = 129794048;

constexpr size_t al256(size_t x) { return (x + 255) & ~(size_t)255; }
constexpr size_t WO_wt_in = 0;
constexpr size_t WO_wt_out = WO_wt_in + al256((size_t)NL * NIN * DM * 2);
constexpr size_t WO_wt_up = WO_wt_out + al256((size_t)NL * DM * DM * 2);
constexpr size_t WO_wt_down = WO_wt_up + al256((size_t)NL * DFF * DM * 2);
constexpr size_t WO_wt_gate = WO_wt_down + al256((size_t)NL * DM * DFF * 2);
constexpr size_t WO_wt_proj = WO_wt_gate + al256((size_t)NL * DM * DM * 2);
constexpr size_t WO_hb = WO_wt_proj + al256((size_t)NL * DM * PLE * 2);
constexpr size_t WO_hb2 = WO_hb + al256((size_t)MTOK * DM * 2);
constexpr size_t WO_proj = WO_hb2 + al256((size_t)MTOK * DM * 2);
constexpr size_t WO_scr = WO_proj + al256((size_t)MTOK * NPJ * 2);
constexpr size_t WO_ogdn = WO_scr + al256((size_t)2048 * SCR_ITEM);
constexpr size_t WO_oswa = WO_ogdn + al256((size_t)MTOK * DM * 2);
constexpr size_t WO_mix = WO_oswa + al256((size_t)MTOK * DM * 2);
constexpr size_t WO_pb = WO_mix + al256((size_t)MTOK * DM * 2);
constexpr size_t WO_pp = WO_pb + al256((size_t)NL * MTOK * PLE * 2);
constexpr size_t WO_ssq0 = WO_pp + al256((size_t)NL * MTOK * DM * 2);
constexpr size_t WO_ssq1 = WO_ssq0 + al256((size_t)MTOK * 16 * 4);
constexpr size_t WO_ssq2 = WO_ssq1 + al256((size_t)MTOK * 16 * 4);
constexpr size_t WO_logits = WO_ssq2 + al256((size_t)MTOK * 16 * 4);
constexpr size_t WO_gsc = WO_logits + al256((size_t)MTOK * 16 * 4);
constexpr size_t WO_bar = WO_gsc + al256((size_t)2048 * 4);
constexpr size_t WS_TOTAL = WO_bar + al256((size_t)3456 * 4);
struct Params {
  const float *x_prompt, *x_sample, *cache_conv, *state_gdn, *cache_k, *cache_v, *p_prompt, *p_sample;
  const float *norm_mix, *w_in, *conv_w, *a_log, *dt_bias, *gdn_norm, *q_norm, *k_norm, *sinks, *w_out, *norm_ffn, *w_up, *w_down,
      *norm_ple, *w_gate, *w_proj;
  float* out;
  unsigned char* ws;
  DEVI bf16_t* wt_in() const { return (bf16_t*)(ws + WO_wt_in); }
  DEVI bf16_t* wt_out() const { return (bf16_t*)(ws + WO_wt_out); }
  DEVI bf16_t* wt_up() const { return (bf16_t*)(ws + WO_wt_up); }
  DEVI bf16_t* wt_down() const { return (bf16_t*)(ws + WO_wt_down); }
  DEVI bf16_t* wt_gate() const { return (bf16_t*)(ws + WO_wt_gate); }
  DEVI bf16_t* wt_proj() const { return (bf16_t*)(ws + WO_wt_proj); }
  DEVI bf16_t* hb() const { return (bf16_t*)(ws + WO_hb); }
  DEVI bf16_t* hb2() const { return (bf16_t*)(ws + WO_hb2); }
  DEVI bf16_t* proj() const { return (bf16_t*)(ws + WO_proj); }
  DEVI bf16_t* scr() const { return (bf16_t*)(ws + WO_scr); }
  DEVI bf16_t* ogdn() const { return (bf16_t*)(ws + WO_ogdn); }
  DEVI bf16_t* oswa() const { return (bf16_t*)(ws + WO_oswa); }
  DEVI bf16_t* mix() const { return (bf16_t*)(ws + WO_mix); }
  DEVI bf16_t* pb() const { return (bf16_t*)(ws + WO_pb); }
  DEVI bf16_t* pp() const { return (bf16_t*)(ws + WO_pp); }
  DEVI float* ssq0() const { return (float*)(ws + WO_ssq0); }
  DEVI float* ssq1() const { return (float*)(ws + WO_ssq1); }
  DEVI float* ssq2() const { return (float*)(ws + WO_ssq2); }
  DEVI float* logits() const { return (float*)(ws + WO_logits); }
  DEVI float* gsc() const { return (float*)(ws + WO_gsc); }
  DEVI unsigned* bar() const { return (unsigned*)(ws + WO_bar); }
};

DEVI float shx(float v, int m, int ln) { return __builtin_bit_cast(float, __builtin_amdgcn_ds_bpermute((ln ^ m) << 2, __builtin_bit_cast(int, v))); }
DEVI float shup(float v, int o, int ln) { return __builtin_bit_cast(float, __builtin_amdgcn_ds_bpermute((ln >= o ? ln - o : ln) << 2, __builtin_bit_cast(int, v))); }
DEVI float lo2f(unsigned u) { return __uint_as_float(u << 16); }
DEVI float hi2f(unsigned u) { return __uint_as_float(u & 0xffff0000u); }
DEVI float bf2f(bf16_t v) { return __uint_as_float(((unsigned)v) << 16); }
typedef __bf16 bf16x2_t __attribute__((ext_vector_type(2)));
DEVI unsigned pk2(float lo, float hi) { const f32x2 v = {lo, hi}; const bf16x2_t r = __builtin_convertvector(v, bf16x2_t); return __builtin_bit_cast(unsigned, r); }
DEVI bf16_t f2bf(float f) { return (bf16_t)(pk2(f, 0.f) & 0xffffu); }
DEVI float sigm(float x) { return 1.f / (1.f + __expf(-x)); }
DEVI float silu(float x) { return x * sigm(x); }
DEVI float softplus_f(float x) {
  const float e = __expf(x);
  return x > 20.f ? x : (e < 0.01f ? e * (1.f - 0.5f * e + 0.33333334f * e * e) : __logf(1.f + e));
}
DEVI f32x4 mfma16(bf16x8 a, bf16x8 b, f32x4 c) { return __builtin_amdgcn_mfma_f32_16x16x32_bf16(a, b, c, 0, 0, 0); }
DEVI bf16x8 as_bf(u32x4 v) { return __builtin_bit_cast(bf16x8, v); }
#define UNPACK8(v, f) do { f[0] = lo2f(v.x); f[1] = hi2f(v.x); f[2] = lo2f(v.y); f[3] = hi2f(v.y); f[4] = lo2f(v.z); f[5] = hi2f(v.z); f[6] = lo2f(v.w); f[7] = hi2f(v.w); } while (0)

DEVI int inmap(int n) { return n < 4096 ? n : (n < 7680 ? n + 16 : n - 7680 + 4096); }

__device__ void wconv_tile(const float* __restrict__ src, int ldsrc, int K, int Nd, bf16_t* __restrict__ dst, const float* __restrict__ scale,
                           bool remap, int kt, int nt, float* sm) {
  const int tid = (opq(threadIdx.x) & 255);
  const int nl = tid & 63, kq = tid >> 6;
  const int n = nt * 64 + nl;
  const bool ok = n < Nd;
  const int sc = remap ? inmap(n) : n;
#pragma unroll 4
  for (int r = 0; r < 16; ++r) {
    const int kl = r * 4 + kq, k = kt * 64 + kl;
    float v = 0.f;
    if (ok) { v = src[(size_t)k * ldsrc + sc]; if (scale) v *= scale[k]; }
    sm[kl * 65 + nl] = v;
  }
  __syncthreads();
  const int nr = tid >> 2, ks = (tid & 3) * 16;
  if (nt * 64 + nr < Nd) {
    unsigned w[8];
#pragma unroll
    for (int i = 0; i < 8; ++i) w[i] = pk2(sm[(ks + 2 * i) * 65 + nr], sm[(ks + 2 * i + 1) * 65 + nr]);
    u32x4* d = (u32x4*)(dst + (size_t)(nt * 64 + nr) * K + kt * 64 + ks);
    d[0] = (u32x4){w[0], w[1], w[2], w[3]};
    d[1] = (u32x4){w[4], w[5], w[6], w[7]};
  }
  __syncthreads();
}

__device__ void phase_p0(const Params& p, unsigned char* smem) {
  float* sm = (float*)smem;
  const int tid = (opq(threadIdx.x) & 255), lane = tid & 63, wid = tid >> 6;
  constexpr int T_IN = 16 * 121, T_OUT = 256, T_UP = 1024, T_DOWN = 1024, T_GATE = 256, T_PROJ = 64;
  constexpr int T_L = T_IN + T_OUT + T_UP + T_DOWN + T_GATE + T_PROJ;
  for (int it = VB; it < NL * T_L; it += VG) {
    const int l = it / T_L;
    int r = it % T_L;
    if (r < T_IN) { wconv_tile(p.w_in + (size_t)l * DM * NIN, NIN, DM, NIN, p.wt_in() + (size_t)l * NIN * DM, p.norm_mix + l * DM, true, r % 16, r / 16, sm); continue; }
    r -= T_IN;
    if (r < T_OUT) { wconv_tile(p.w_out + (size_t)l * DM * DM, DM, DM, DM, p.wt_out() + (size_t)l * DM * DM, nullptr, false, r % 16, r / 16, sm); continue; }
    r -= T_OUT;
    if (r < T_UP) { wconv_tile(p.w_up + (size_t)l * DM * DFF, DFF, DM, DFF, p.wt_up() + (size_t)l * DFF * DM, p.norm_ffn + l * DM, false, r % 16, r / 16, sm); continue; }
    r -= T_UP;
    if (r < T_DOWN) { wconv_tile(p.w_down + (size_t)l * DFF * DM, DM, DFF, DM, p.wt_down() + (size_t)l * DM * DFF, nullptr, false, r % 64, r / 64, sm); continue; }
    r -= T_DOWN;
    if (r < T_GATE) { wconv_tile(p.w_gate + (size_t)l * DM * DM, DM, DM, DM, p.wt_gate() + (size_t)l * DM * DM, p.norm_ple + l * DM, false, r % 16, r / 16, sm); continue; }
    r -= T_GATE;
    wconv_tile(p.w_proj + (size_t)l * PLE * DM, DM, PLE, DM, p.wt_proj() + (size_t)l * DM * PLE, nullptr, false, r % 4, r / 4, sm);
  }
  for (int it = VB; it < MTOK / 4; it += VG) {
    const int row = it * 4 + wid;
    const float* src = row < MP ? p.x_prompt + (size_t)row * DM : p.x_sample + (size_t)(row - MP) * DM;
    float* hd = p.out + (size_t)row * DM;
    bf16_t* hbd = p.hb() + (size_t)row * DM;
    float ss = 0.f;
#pragma unroll
    for (int i = 0; i < 4; ++i) {
      const int c = i * 256 + lane * 4;
      const f32x4 v = *(const f32x4*)(src + c);
      ss += v.x * v.x + v.y * v.y + v.z * v.z + v.w * v.w;
      *(f32x4*)(hd + c) = v;
      *(u32x2*)(hbd + c) = (u32x2){pk2(v.x, v.y), pk2(v.z, v.w)};
    }
#pragma unroll
    for (int o = 1; o < 64; o <<= 1) ss += shx(ss, o, lane);
    if (lane < 16) p.ssq0()[(size_t)row * 16 + lane] = lane == 0 ? ss : 0.f;
  }
  const int G = NL * MTOK * 32;
  for (int g = VB * NTHR + tid; g < G; g += VG * NTHR) {
    const int l = g / (MTOK * 32), rem = g % (MTOK * 32), row = rem >> 5, c8 = rem & 31;
    const float* src = row < MP ? p.p_prompt + ((size_t)(l * MP + row) * PLE + c8 * 8) : p.p_sample + ((size_t)(l * MS + row - MP) * PLE + c8 * 8);
    const f32x4 a = *(const f32x4*)src, b = *(const f32x4*)(src + 4);
    *(u32x4*)(p.pb() + (size_t)g * 8) = (u32x4){pk2(a.x, a.y), pk2(a.z, a.w), pk2(b.x, b.y), pk2(b.z, b.w)};
  }
}

enum { EPI_PROJ = 0, EPI_LOGIT = 1, EPI_RESID = 2, EPI_UP = 3, EPI_PLE = 4, EPI_PP = 5 };
struct EpiArgs {
  const float* ssq_in; float* ssq_out; float* h; bf16_t* hb; bf16_t* obf; int ldo; float* of32; const bf16_t* pp;
};

template <int EPI>
DEVI float epi_rs(const EpiArgs& e, int row) {
  if (EPI == EPI_PROJ || EPI == EPI_LOGIT || EPI == EPI_UP || EPI == EPI_PLE) {
    const f32x4* sp = (const f32x4*)(e.ssq_in + (size_t)row * 16);
    const f32x4 a = sp[0], b = sp[1], c = sp[2], d = sp[3];
    const float s = ((a.x + a.y) + (a.z + a.w)) + ((b.x + b.y) + (b.z + b.w)) + ((c.x + c.y) + (c.z + c.w)) + ((d.x + d.y) + (d.z + d.w));
    return rsqrtf(s * (1.f / 1024.f) + EPS);
  }
  return 1.f;
}
template <int EPI>
DEVI void epi_elem(const EpiArgs& e, int row, int col, f32x4 v, float rs, float& sq) {
  if (EPI == EPI_PROJ) {
    v *= rs;
    *(u32x2*)(e.obf + (size_t)row * e.ldo + col) = (u32x2){pk2(v.x, v.y), pk2(v.z, v.w)};
  } else if (EPI == EPI_LOGIT) {
    v *= rs;
    *(f32x4*)(e.of32 + (size_t)row * 16 + col) = v;
  } else if (EPI == EPI_PP) {
    *(u32x2*)(e.obf + (size_t)row * e.ldo + (col & 1023)) = (u32x2){pk2(v.x, v.y), pk2(v.z, v.w)};
  } else if (EPI == EPI_UP) {
    v *= rs;
    v.x = fmaxf(v.x, 0.f); v.y = fmaxf(v.y, 0.f); v.z = fmaxf(v.z, 0.f); v.w = fmaxf(v.w, 0.f);
    v = v * v;
    *(u32x2*)(e.obf + (size_t)row * e.ldo + col) = (u32x2){pk2(v.x, v.y), pk2(v.z, v.w)};
  } else {
    float* hp = e.h + (size_t)row * DM + col;
    f32x4 hv = *(const f32x4*)hp;
    if (EPI == EPI_RESID) {
      hv += v;
    } else {
      const u32x2 pv = *(const u32x2*)(e.pp + (size_t)row * DM + col);
      hv.x += sigm(v.x * rs) * lo2f(pv.x); hv.y += sigm(v.y * rs) * hi2f(pv.x);
      hv.z += sigm(v.z * rs) * lo2f(pv.y); hv.w += sigm(v.w * rs) * hi2f(pv.y);
    }
    *(f32x4*)hp = hv;
    *(u32x2*)(e.hb + (size_t)row * DM + col) = (u32x2){pk2(hv.x, hv.y), pk2(hv.z, hv.w)};
    sq += hv.x * hv.x + hv.y * hv.y + hv.z * hv.z + hv.w * hv.w;
  }
}

template <int WMT, int WNT, int WGM, int WGN, int EPI, int BK = 32, bool KSPLIT = false>
__device__ __forceinline__ void gemm_tile(const bf16_t* __restrict__ A, int lda, const bf16_t* __restrict__ Bt, int ldb, int K, int m0, int n0,
                                          bf16_t* lds, const EpiArgs& e) {
  constexpr int BM = WGM * WMT * 16, BN = WGN * WNT * 16, LDR = BK + 8;
  constexpr int STAGE = (BM + BN) * LDR;
  constexpr int PPR = BK / 8, RPI = NTHR / PPR;
  constexpr int NA = BM / RPI, NB = (BN + RPI - 1) / RPI;
  const int tid = (opq(threadIdx.x) & 255), lane = tid & 63, wid = tid >> 6;
  const int wm = wid / WGN, wn = wid % WGN;
  const int fr = lane & 15, fq = lane >> 4;
  f32x4 acc[WMT][WNT];
#pragma unroll
  for (int i = 0; i < WMT; ++i)
#pragma unroll
    for (int j = 0; j < WNT; ++j) acc[i][j] = (f32x4){0.f, 0.f, 0.f, 0.f};
  u32x4 ra0[NA], rb0[NB], ra1[NA], rb1[NB];
  const int khalf = KSPLIT ? VHALF : 0;
  const int nk = (KSPLIT ? K / 2 : K) / BK;
  const int prow = tid / PPR, ppc = tid % PPR;
  const unsigned ta = (unsigned)(prow * lda + ppc * 8) * 2u, tb = (unsigned)(prow * ldb + ppc * 8) * 2u;
  const char* Au = (const char*)(A + (size_t)m0 * lda + (size_t)khalf * (K / 2));
  const char* Bu = (const char*)(Bt + (size_t)n0 * ldb + (size_t)khalf * (K / 2));
#define BGUARD(i) (BN >= RPI * ((i) + 1) || prow + (i) * RPI < BN)
#define GLOAD(kt, RA, RB) do { \
    _Pragma("unroll") for (int i = 0; i < NA; ++i) RA[i] = *(const u32x4*)(Au + ((size_t)i * RPI * lda + (size_t)(kt) * BK) * 2 + ta); \
    _Pragma("unroll") for (int i = 0; i < NB; ++i) if (BGUARD(i)) RB[i] = *(const u32x4*)(Bu + ((size_t)i * RPI * ldb + (size_t)(kt) * BK) * 2 + tb); \
  } while (0)
#define LSTORE(st, RA, RB) do { bf16_t* sA_ = lds + (st) * STAGE; bf16_t* sB_ = sA_ + BM * LDR; \
    _Pragma("unroll") for (int i = 0; i < NA; ++i) *(u32x4*)(sA_ + (prow + i * RPI) * LDR + ppc * 8) = RA[i]; \
    _Pragma("unroll") for (int i = 0; i < NB; ++i) if (BGUARD(i)) *(u32x4*)(sB_ + (prow + i * RPI) * LDR + ppc * 8) = RB[i]; \
  } while (0)
#define COMPUTE(st) do { const bf16_t* sA = lds + (st) * STAGE; const bf16_t* sB = sA + BM * LDR; \
    _Pragma("unroll") for (int kk = 0; kk < BK / 32; ++kk) { \
      bf16x8 bfr[WNT]; \
      _Pragma("unroll") for (int nt = 0; nt < WNT; ++nt) bfr[nt] = *(const bf16x8*)(sB + (wn * WNT * 16 + nt * 16 + fr) * LDR + kk * 32 + fq * 8); \
      _Pragma("unroll") for (int mt = 0; mt < WMT; ++mt) { \
        const bf16x8 af = *(const bf16x8*)(sA + (wm * WMT * 16 + mt * 16 + fr) * LDR + kk * 32 + fq * 8); \
        _Pragma("unroll") for (int nt = 0; nt < WNT; ++nt) acc[mt][nt] = mfma16(bfr[nt], af, acc[mt][nt]); } } \
  } while (0)
  GLOAD(0, ra0, rb0);
  GLOAD(1, ra1, rb1);
  LSTORE(0, ra0, rb0);
  __syncthreads();
  for (int kt = 0; kt < nk; kt += 2) {
    const int k2 = kt + 2 < nk ? kt + 2 : nk - 2;
    GLOAD(k2, ra0, rb0);
    COMPUTE(0);
    LSTORE(1, ra1, rb1);
    __syncthreads();
    GLOAD(k2 + 1, ra1, rb1);
    COMPUTE(1);
    LSTORE(0, ra0, rb0);
    __syncthreads();
  }
#undef BGUARD
#undef COMPUTE
#undef GLOAD
#undef LSTORE
  if (KSPLIT) {
    f32x4* red = (f32x4*)((unsigned char*)lds + (khalf ? 0 : SMEM_BYTES));
    if (khalf == 1) {
#pragma unroll
      for (int i = 0; i < WMT; ++i)
#pragma unroll
        for (int j = 0; j < WNT; ++j) red[((wid * WMT + i) * WNT + j) * 64 + lane] = acc[i][j];
    }
    __syncthreads();
    if (khalf == 0) {
#pragma unroll
      for (int i = 0; i < WMT; ++i)
#pragma unroll
        for (int j = 0; j < WNT; ++j) acc[i][j] += red[((wid * WMT + i) * WNT + j) * 64 + lane];
    }
  }
  if (!KSPLIT || khalf == 0) {
#pragma unroll
  for (int mt = 0; mt < WMT; ++mt) {
    const int row = m0 + wm * WMT * 16 + mt * 16 + fr;
    const float rs = epi_rs<EPI>(e, row);
    float sq = 0.f;
#pragma unroll
    for (int nt = 0; nt < WNT; ++nt) epi_elem<EPI>(e, row, n0 + wn * WNT * 16 + nt * 16 + fq * 4, acc[mt][nt], rs, sq);
    if (EPI == EPI_RESID || EPI == EPI_PLE) {
      sq += shx(sq, 16, lane);
      sq += shx(sq, 32, lane);
      if (fq == 0) e.ssq_out[(size_t)row * 16 + (n0 / BN) * WGN + wn] = sq;
    }
  }
  }
  if (KSPLIT) __syncthreads();
}

namespace pg8 {
#define PG8_LAS __attribute__((address_space(3)))
typedef unsigned short bf16_t;
typedef short bf16x8 __attribute__((ext_vector_type(8)));
typedef float f32x4 __attribute__((ext_vector_type(4)));
typedef unsigned u32x4 __attribute__((ext_vector_type(4)));
constexpr int BM = 256, BK = 64, HALF = 128, HTB = HALF * BK * 2  , STAGE_BYTES = 8 * HTB, NXCD = 8, WGM = 8;

__host__ __device__ __forceinline__ int lds_byte(int r, int c) { const int st = (r >> 4) * 2 + (c >> 5), rr = r & 15, cc = c & 31, ob = rr * 64 + cc * 2; return st * 1024 + (ob ^ (((ob >> 9) & 1) << 5)); }
__host__ __device__ __forceinline__ void stage_rc(int b, int& R, int& C) { const int st = b / 1024, sb = b % 1024, swz = sb ^ (((sb >> 9) & 1) << 5); R = (st >> 1) * 16 + swz / 64; C = (st & 1) * 32 + (swz % 64) / 2; }
__host__ __device__ __forceinline__ int perm32(int rho) { const int n = rho >> 4, i = rho & 15; return 8 * (i >> 2) + 4 * n + (i & 3); }

struct Unit { int pm, pn; };
struct Gemm { const bf16_t* A; const bf16_t* Bt; int M, N, K; };

template <class Epi, class Sched, bool STAMP = false>
__device__ __forceinline__ void gemm_phase(PG8_LAS unsigned char* lds, const Gemm g, const Sched& S, const Epi& E, unsigned long long* stamps) {
    const int tid = opq((int)threadIdx.x), wid = __builtin_amdgcn_readfirstlane(tid >> 6), lane = tid & 63, wr = wid >> 2, wc = wid & 3, fr = lane & 15, fq = lane >> 4;
    const int K = g.K, nt = K / BK;
    int ts_lo = 0, ts_hi = 0, nts = 0; const unsigned long long rt_entry = STAMP ? (unsigned long long)wall_clock64() : 0ull;
#define PG8_STAMP() do { if (STAMP && wid == 0 && nts < 64) { const unsigned long long _c = (unsigned long long)clock64(); \
        ts_lo = (lane == nts) ? (int)(unsigned)_c : ts_lo; ts_hi = (lane == nts) ? (int)(unsigned)(_c >> 32) : ts_hi; ++nts; } } while (0)
    PG8_STAMP();
    unsigned voffA[2], voffB[2];
#pragma unroll
    for (int i = 0; i < 2; ++i) { int R, C; stage_rc(tid * 16 + i * 8192, R, C); const int Rb = Epi::PERM ? ((R & ~31) + perm32(R & 31)) : R;
        voffA[i] = (unsigned)(R * K + C) * 2u; voffB[i] = (unsigned)(Rb * K + C) * 2u; }
    const size_t kstep = (size_t)(BK * 2);
    const size_t hstep = (size_t)HALF * K * 2;
    const size_t tstep = 2 * hstep;
    const unsigned ldsw = (unsigned)wid * 1024u;
    const int aoff = lds_byte(wr * 64 + fr, fq * 8), boff = lds_byte(wc * 32 + fr, fq * 8);
#define PG8_SA(b, h) (((b) * 2 + (h)) * HTB)
#define PG8_SB(b, h) ((4 + (b) * 2 + (h)) * HTB)
#define PG8_STAGE(bufoff, gbase, voff) do { _Pragma("unroll") for (int _i = 0; _i < 2; ++_i) \
        __builtin_amdgcn_global_load_lds((const unsigned*)((const char*)(gbase) + (voff)[_i]), (PG8_LAS unsigned*)(lds + (bufoff) + ldsw + _i * 8192), 16, 0, 0); } while (0)
#define PG8_LDA(dst, b, h) do { _Pragma("unroll") for (int m = 0; m < 4; ++m) _Pragma("unroll") for (int k = 0; k < 2; ++k) dst[m][k] = *(const PG8_LAS bf16x8*)(lds + PG8_SA(b, h) + aoff + m * 2048 + k * 1024); } while (0)
#define PG8_LDB(dst, b, h) do { _Pragma("unroll") for (int n = 0; n < 2; ++n) _Pragma("unroll") for (int k = 0; k < 2; ++k) dst[n][k] = *(const PG8_LAS bf16x8*)(lds + PG8_SB(b, h) + boff + n * 2048 + k * 1024); } while (0)
#define PG8_MMA(ai, bj, At, Bt) do { __builtin_amdgcn_s_setprio(1); _Pragma("unroll") for (int m = 0; m < 4; ++m) _Pragma("unroll") for (int n = 0; n < 2; ++n) _Pragma("unroll") for (int k = 0; k < 2; ++k) \
        acc[ai][bj][m][n] = __builtin_amdgcn_mfma_f32_16x16x32_bf16(Bt[n][k], At[m][k], acc[ai][bj][m][n], 0, 0, 0); __builtin_amdgcn_s_setprio(0); } while (0)
#define PG8_WAIT_V(n) asm volatile("s_waitcnt vmcnt(" #n ")" ::: "memory")
#define PG8_WAIT_L(n) asm volatile("s_waitcnt lgkmcnt(" #n ")" ::: "memory")
#define PG8_BAR __builtin_amdgcn_s_barrier()
#define PG8_SCHED __builtin_amdgcn_sched_barrier(0)
    Unit cur, nxt; int ui = 0;
    if (!S.next(0, cur)) return;
    f32x4 acc[2][2][4][2];
#pragma unroll
    for (int a = 0; a < 2; ++a)
#pragma unroll
        for (int b = 0; b < 2; ++b)
#pragma unroll
            for (int m = 0; m < 4; ++m)
#pragma unroll
                for (int n = 0; n < 2; ++n) acc[a][b][m][n] = (f32x4){0.f, 0.f, 0.f, 0.f};
    bf16x8 At[4][2], B0[2][2], B1[2][2];
    const char* cA = (const char*)g.A + (size_t)cur.pm * tstep; const char* cB = (const char*)g.Bt + (size_t)cur.pn * tstep;
    S.a_ready(cur);
    PG8_STAGE(PG8_SB(0, 0), cB, voffB); PG8_STAGE(PG8_SA(0, 0), cA, voffA); PG8_STAGE(PG8_SB(0, 1), cB + hstep, voffB); PG8_STAGE(PG8_SA(0, 1), cA + hstep, voffA);
    if (wr == 1) PG8_BAR;
    PG8_WAIT_V(4); PG8_BAR;
    PG8_STAGE(PG8_SB(1, 0), cB + kstep, voffB); PG8_STAGE(PG8_SA(1, 0), cA + kstep, voffA); PG8_STAGE(PG8_SB(1, 1), cB + hstep + kstep, voffB);
    PG8_WAIT_V(6); PG8_BAR;
    PG8_STAMP();
    for (;;) {
        const bool has_next = S.next(ui + 1, nxt);
        const char* nA = has_next ? (const char*)g.A + (size_t)nxt.pm * tstep : cA; const char* nB = has_next ? (const char*)g.Bt + (size_t)nxt.pn * tstep : cB;
        for (int t = 0; t < nt; t += 2) {
            const bool last = (t == nt - 2);
            const char* a1 = cA + (size_t)(t + 1) * kstep;
            const char* a2 = last ? nA : cA + (size_t)(t + 2) * kstep; const char* b2 = last ? nB : cB + (size_t)(t + 2) * kstep;
            const char* a3 = a2 + kstep; const char* b3 = b2 + kstep;
            if (last && has_next) S.a_ready(nxt);
            PG8_LDB(B0, 0, 0); PG8_SCHED; PG8_LDA(At, 0, 0); PG8_STAGE(PG8_SA(1, 1), a1 + hstep, voffA);
            PG8_WAIT_L(8); PG8_BAR; PG8_WAIT_L(0); PG8_MMA(0, 0, At, B0); PG8_BAR; PG8_SCHED;
            PG8_LDB(B1, 0, 1); PG8_STAGE(PG8_SB(0, 0), b2, voffB);
            PG8_BAR; PG8_WAIT_L(0); PG8_MMA(0, 1, At, B1); PG8_BAR;
            PG8_LDA(At, 0, 1); PG8_STAGE(PG8_SA(0, 0), a2, voffA);
            PG8_BAR; PG8_WAIT_L(0); PG8_MMA(1, 0, At, B0); PG8_BAR; PG8_SCHED;
            PG8_STAGE(PG8_SB(0, 1), b2 + hstep, voffB);
            PG8_WAIT_V(6); PG8_BAR; PG8_MMA(1, 1, At, B1); PG8_BAR;
            PG8_LDB(B0, 1, 0); PG8_SCHED; PG8_LDA(At, 1, 0); PG8_STAGE(PG8_SA(0, 1), a2 + hstep, voffA);
            PG8_WAIT_L(8); PG8_BAR; PG8_WAIT_L(0); PG8_MMA(0, 0, At, B0); PG8_BAR; PG8_SCHED;
            PG8_LDB(B1, 1, 1); PG8_STAGE(PG8_SB(1, 0), b3, voffB);
            PG8_BAR; PG8_WAIT_L(0); PG8_MMA(0, 1, At, B1); PG8_BAR;
            PG8_LDA(At, 1, 1); PG8_STAGE(PG8_SA(1, 0), a3, voffA);
            PG8_BAR; PG8_WAIT_L(0); PG8_MMA(1, 0, At, B0); PG8_BAR; PG8_SCHED;
            PG8_STAGE(PG8_SB(1, 1), b3 + hstep, voffB);
            PG8_WAIT_V(6); PG8_BAR; PG8_MMA(1, 1, At, B1); PG8_BAR;
        }
        PG8_STAMP();
        if constexpr (!Epi::AFTER_DRAIN) { E(acc, cur, wr, wc, fr, fq); S.done(cur); }
        PG8_STAMP();
        if (!has_next) break;
#pragma unroll
        for (int a = 0; a < 2; ++a)
#pragma unroll
            for (int b = 0; b < 2; ++b)
#pragma unroll
                for (int m = 0; m < 4; ++m)
#pragma unroll
                    for (int n = 0; n < 2; ++n) acc[a][b][m][n] = (f32x4){0.f, 0.f, 0.f, 0.f};
        cur = nxt; cA = nA; cB = nB; ++ui;
    }
    PG8_WAIT_V(0);
    if (wr == 0) PG8_BAR;
    PG8_BAR;
    if constexpr (Epi::AFTER_DRAIN) { E.fused(acc, cur, wr, wc, fr, fq, lds, wid, lane); S.done(cur); }
    PG8_STAMP();
    if (STAMP && wid == 0) { stamps[lane] = lane < nts ? (((unsigned long long)(unsigned)ts_hi << 32) | (unsigned)ts_lo) : 0ull;
        if (lane == 62) stamps[62] = rt_entry; if (lane == 63) stamps[63] = (unsigned long long)wall_clock64(); }
#undef PG8_STAMP
#undef PG8_SA
#undef PG8_SB
#undef PG8_STAGE
#undef PG8_LDA
#undef PG8_LDB
#undef PG8_MMA
#undef PG8_WAIT_V
#undef PG8_WAIT_L
#undef PG8_BAR
#undef PG8_SCHED
}
}

DEVI void unit_map(int L, int nM, int nN, int& pm, int& pn) {
  const int nwg = nM * nN, q = nwg / 8, r = nwg % 8, xcd = L % 8, off = L / 8;
  const int wgid = (xcd < r ? xcd * (q + 1) : r * (q + 1) + (xcd - r) * q) + off;
  const int nig = 8 * nN, gid = wgid / nig, fm = gid * 8, gsz = (nM - fm) < 8 ? (nM - fm) : 8, w = wgid - gid * nig;
  pm = fm + (w % gsz); pn = w / gsz;
}
struct RowSched {
  int nM, nN, nLimit, G, c;
  __device__ __forceinline__ bool next(int i, pg8::Unit& u) const { const int L = i * G + c; if (L >= nLimit) return false; unit_map(L, nM, nN, u.pm, u.pn); return true; }
  __device__ __forceinline__ void a_ready(const pg8::Unit&) const {}
  __device__ __forceinline__ void done(const pg8::Unit&) const {}
};
struct DiagSched {
  int nLimit, G, c;
  __device__ __forceinline__ bool next(int i, pg8::Unit& u) const { const int L = i * G + c; if (L >= nLimit) return false; const int l = L / 272, r = L - l * 272; u.pm = l * 68 + (r >> 2); u.pn = l * 4 + (r & 3); return true; }
  __device__ __forceinline__ void a_ready(const pg8::Unit&) const {}
  __device__ __forceinline__ void done(const pg8::Unit&) const {}
};
template <int EPI> struct BigEpi {
  static constexpr bool PERM = false, AFTER_DRAIN = false;
  EpiArgs e;
  __device__ __forceinline__ void operator()(const f32x4 (&acc)[2][2][4][2], const pg8::Unit& u, int wr, int wc, int fr, int fq) const {
    const int lane = fq * 16 + fr;
#pragma unroll
    for (int ai = 0; ai < 2; ++ai)
#pragma unroll
      for (int m = 0; m < 4; ++m) {
        const int row = u.pm * 256 + ai * 128 + wr * 64 + m * 16 + fr;
        const float rs = epi_rs<EPI>(e, row);
        float sq = 0.f;
#pragma unroll
        for (int bj = 0; bj < 2; ++bj)
#pragma unroll
          for (int n = 0; n < 2; ++n) epi_elem<EPI>(e, row, u.pn * 256 + bj * 128 + wc * 32 + n * 16 + fq * 4, acc[ai][bj][m][n], rs, sq);
        if (EPI == EPI_RESID || EPI == EPI_PLE) {
          sq += shx(sq, 16, lane);
          sq += shx(sq, 32, lane);
          if (fq == 0) e.ssq_out[(size_t)row * 16 + u.pn * 4 + wc] = sq;
        }
      }
  }
};

template <int EPI>
__device__ void gemm_big_phase(const bf16_t* A, const bf16_t* Bt, int K, int M, int N, unsigned char* lds_all, unsigned char* smem_half, const EpiArgs& e) {
  const int nM = M / 256, nN = N / 256, nU = nM * nN, G = gridDim.x;
  const int L = nU % G;
  const int nLimit = (L > 0 && L <= G / 4) ? nU - L : nU;
  RowSched S; S.nM = nM; S.nN = nN; S.nLimit = nLimit; S.G = G; S.c = blockIdx.x;
  pg8::Gemm g; g.A = A; g.Bt = Bt; g.M = M; g.N = N; g.K = K;
  BigEpi<EPI> E; E.e = e;
  pg8::gemm_phase<BigEpi<EPI>, RowSched>((PG8_LAS unsigned char*)lds_all, g, S, E, nullptr);
  __syncthreads();
  const int nSmall = (nU - nLimit) * 16;
  if (nSmall <= G && K >= 512) {
    for (int st = blockIdx.x; st < nSmall; st += G) {
      const int sub = st & 15; int pm, pn; unit_map(nLimit + (st >> 4), nM, nN, pm, pn);
      gemm_tile<1, 4, 4, 1, EPI, 128, true>(A, K, Bt, K, K, pm * 256 + (sub >> 2) * 64, pn * 256 + (sub & 3) * 64, (bf16_t*)smem_half, e);
    }
  } else {
    for (int st = VB; st < nSmall; st += VG) {
      const int sub = st & 15; int pm, pn; unit_map(nLimit + (st >> 4), nM, nN, pm, pn);
      gemm_tile<1, 4, 4, 1, EPI, 128>(A, K, Bt, K, K, pm * 256 + (sub >> 2) * 64, pn * 256 + (sub & 3) * 64, (bf16_t*)smem_half, e);
    }
  }
}


template <int I, int J4>
DEVI void solve_sub4(float& r, const float (&x)[64], const float* Am) {
  if constexpr (J4 * 4 < I) {
    const f32x4 a = *(const f32x4*)(Am + I * 64 + J4 * 4);
    if constexpr (J4 * 4 + 0 < I) r -= a.x * x[J4 * 4 + 0];
    if constexpr (J4 * 4 + 1 < I) r -= a.y * x[J4 * 4 + 1];
    if constexpr (J4 * 4 + 2 < I) r -= a.z * x[J4 * 4 + 2];
    if constexpr (J4 * 4 + 3 < I) r -= a.w * x[J4 * 4 + 3];
    solve_sub4<I, J4 + 1>(r, x, Am);
  }
}
template <int I>
DEVI void solve_rows(float (&x)[64], const float* Am, const bf16_t* src, const float* sc) {
  if constexpr (I < 64) {
    float r = bf2f(src[I * 136]) * sc[I];
    solve_sub4<I, 0>(r, x, Am);
    x[I] = r;
    asm volatile("" ::: "memory");
    solve_rows<I + 1>(x, Am, src, sc);
  }
}

__device__ void gdn_prep_item(const Params& p, int l, int item, unsigned char* smem) {
  const int tid = (opq(threadIdx.x) & 255), lane = tid & 63, wid = tid >> 6, fr = lane & 15, fq = lane >> 4;
  const int h = item & 7, n = (item >> 3) & 31, b = item >> 8;
  const int tok0 = b * 2048 + n * 64;
  bf16_t* qh = (bf16_t*)smem;
  bf16_t* kh = qh + 64 * 136;
  bf16_t* vh = kh + 64 * 136;
  float* Am = (float*)(vh + 64 * 136);
  float* sbeta = Am + 64 * 64;
  float* sgc = sbeta + 64;
  float* sbe = sgc + 64;
  unsigned char* scr = (unsigned char*)p.scr() + (size_t)item * SCR_ITEM;
  bf16_t* g_uT = (bf16_t*)scr;
  bf16_t* g_w = (bf16_t*)(scr + 16384);
  bf16_t* g_qg = (bf16_t*)(scr + 32768);
  bf16_t* g_kgT = (bf16_t*)(scr + 49152);
  bf16_t* g_qk = (bf16_t*)(scr + 65536);

  if (wid == 0) {
    const float* lg = p.logits() + (size_t)(tok0 + lane) * 16;
    const float bl = lg[h], al = lg[8 + h];
    const float x = al + p.dt_bias[l * 8 + h];
    const float sp = softplus_f(x);
    float g = -__expf(p.a_log[l * 8 + h]) * sp;
#pragma unroll
    for (int o = 1; o < 64; o <<= 1) { const float t = shup(g, o, lane); if (lane >= o) g += t; }
    sbeta[lane] = sigm(bl);
    sgc[lane] = g;
    sbe[lane] = sigm(bl) * __expf(g);
  }
  u32x4 rwall[3][7];
#pragma unroll
  for (int sect = 0; sect < 3; ++sect)
#pragma unroll
    for (int r = 0; r < 7; ++r) {
      const int tl = n * 64 + wid * 16 + fq * 4 - 3 + r;
      rwall[sect][r] = (u32x4){0u, 0u, 0u, 0u};
      if (tl >= 0) rwall[sect][r] = *(const u32x4*)(p.proj() + (size_t)(b * 2048 + tl) * NPJ + sect * 1024 + h * 128 + fr * 8);
    }
#pragma unroll
  for (int sect = 0; sect < 3; ++sect) {
    const int ch0 = sect * 1024 + h * 128 + fr * 8;
    float cw[4][8];
#pragma unroll
    for (int j = 0; j < 4; ++j) {
      const f32x4 a = *(const f32x4*)(p.conv_w + (size_t)(l * 4 + j) * 3072 + ch0), c = *(const f32x4*)(p.conv_w + (size_t)(l * 4 + j) * 3072 + ch0 + 4);
      cw[j][0] = a.x; cw[j][1] = a.y; cw[j][2] = a.z; cw[j][3] = a.w; cw[j][4] = c.x; cw[j][5] = c.y; cw[j][6] = c.z; cw[j][7] = c.w;
    }
    const int ib = wid * 16 + fq * 4;
#pragma unroll
    for (int it = 0; it < 4; ++it) {
      float o[8];
#pragma unroll
      for (int c = 0; c < 8; ++c) o[c] = 0.f;
#pragma unroll
      for (int j = 0; j < 4; ++j) {
        float f[8];
        UNPACK8(rwall[sect][it + j], f);
#pragma unroll
        for (int c = 0; c < 8; ++c) o[c] += f[c] * cw[j][c];
      }
      float ss = 0.f;
#pragma unroll
      for (int c = 0; c < 8; ++c) { o[c] = silu(o[c]); ss += o[c] * o[c]; }
      if (sect < 2) {
        ss += shx(ss, 1, lane); ss += shx(ss, 2, lane); ss += shx(ss, 4, lane); ss += shx(ss, 8, lane);
        float rn = rsqrtf(ss + EPS);
        if (sect == 0) rn *= 0.08838834764831845f;
#pragma unroll
        for (int c = 0; c < 8; ++c) o[c] *= rn;
      }
      const u32x4 pk = (u32x4){pk2(o[0], o[1]), pk2(o[2], o[3]), pk2(o[4], o[5]), pk2(o[6], o[7])};
      bf16_t* dst = sect == 0 ? qh + (ib + it) * 136 + fr * 8 : (sect == 1 ? kh + (ib + it) * 136 + fr * 8 : vh + (ib + it) * 136 + fr * 8);
      *(u32x4*)dst = pk;
    }
  }
  __syncthreads();
  {
    const int i = wid * 16 + fr;
    const float gi = sgc[i], bi = sbeta[i];
    bf16x8 kx[4], qx[4];
#pragma unroll
    for (int ks = 0; ks < 4; ++ks) {
      kx[ks] = *(const bf16x8*)(kh + i * 136 + ks * 32 + fq * 8);
      qx[ks] = *(const bf16x8*)(qh + i * 136 + ks * 32 + fq * 8);
    }
#pragma unroll
    for (int jt = 0; jt < 4; ++jt) {
      f32x4 akk = (f32x4){0.f, 0.f, 0.f, 0.f}, aqk = (f32x4){0.f, 0.f, 0.f, 0.f};
      if (jt <= wid) {
#pragma unroll
        for (int ks = 0; ks < 4; ++ks) {
          const bf16x8 kj = *(const bf16x8*)(kh + (jt * 16 + fr) * 136 + ks * 32 + fq * 8);
          akk = mfma16(kj, kx[ks], akk);
          aqk = mfma16(kj, qx[ks], aqk);
        }
      }
      const int j0 = jt * 16 + fq * 4;
      float av[4], qv[4];
#pragma unroll
      for (int jj = 0; jj < 4; ++jj) {
        const int j = j0 + jj;
        const float dec = j <= i ? __expf(gi - sgc[j]) : 0.f;
        av[jj] = j < i ? bi * akk[jj] * dec : 0.f;
        qv[jj] = aqk[jj] * dec;
      }
      *(f32x4*)(Am + i * 64 + j0) = (f32x4){av[0], av[1], av[2], av[3]};
      *(u32x2*)(g_qk + i * 64 + j0) = (u32x2){pk2(qv[0], qv[1]), pk2(qv[2], qv[3])};
    }
  }
  __syncthreads();
  {
    float x[64];
    const bool isu = tid < 128;
    const int cc = tid & 127;
    solve_rows<0>(x, Am, (isu ? vh : kh) + cc, isu ? sbeta : sbe);
    if (isu) {
      u32x4* d = (u32x4*)(g_uT + cc * 64);
#pragma unroll
      for (int q = 0; q < 8; ++q) d[q] = (u32x4){pk2(x[q * 8], x[q * 8 + 1]), pk2(x[q * 8 + 2], x[q * 8 + 3]), pk2(x[q * 8 + 4], x[q * 8 + 5]), pk2(x[q * 8 + 6], x[q * 8 + 7])};
    } else {
#pragma unroll
      for (int i = 0; i < 64; ++i) g_w[i * 128 + cc] = f2bf(x[i]);
    }
  }
  {
    const float gl = sgc[63];
#pragma unroll
    for (int q = 0; q < 4; ++q) {
      const int pc = tid + q * 256, i = pc >> 4, c8 = pc & 15;
      const u32x4 v = *(const u32x4*)(qh + i * 136 + c8 * 8);
      float f[8];
      UNPACK8(v, f);
      const float s = __expf(sgc[i]);
      *(u32x4*)(g_qg + i * 128 + c8 * 8) = (u32x4){pk2(f[0] * s, f[1] * s), pk2(f[2] * s, f[3] * s), pk2(f[4] * s, f[5] * s), pk2(f[6] * s, f[7] * s)};
    }
    if (tid >= 128) {
      const int dk = tid - 128;
      u32x4* d = (u32x4*)(g_kgT + dk * 64);
#pragma unroll
      for (int q = 0; q < 8; ++q) {
        float f[8];
#pragma unroll
        for (int c = 0; c < 8; ++c) { const int i = q * 8 + c; f[c] = bf2f(kh[i * 136 + dk]) * __expf(gl - sgc[i]); }
        d[q] = (u32x4){pk2(f[0], f[1]), pk2(f[2], f[3]), pk2(f[4], f[5]), pk2(f[6], f[7])};
      }
    }
    if (tid == 0) p.gsc()[item] = __expf(gl);
  }
  __syncthreads();
}

__device__ void gdn_scan_item(const Params& p, int l, int item, unsigned char* smem) {
  const int tid = (opq(threadIdx.x) & 255), lane = tid & 63, wid = tid >> 6, fr = lane & 15, fq = lane >> 4;
  const int dvs = item & 3, h = (item >> 2) & 7, b = item >> 5;
  bf16_t* ST = (bf16_t*)smem;
  bf16_t* VT = ST + 2 * 32 * 136;
  f32x4 S[2][2];
#pragma unroll
  for (int a = 0; a < 2; ++a)
#pragma unroll
    for (int c = 0; c < 2; ++c) S[a][c] = (f32x4){0.f, 0.f, 0.f, 0.f};
  __syncthreads();
  bf16x8 fw[4], fqg[4], fqk[2], fkg[2][2];
  u32x2 fu[2];
  float gs;
  bf16x8 nw[4], nqg[4], nqk[2], nkg[2][2];
  u32x2 nu[2];
  float ngs;
#define SCAN_LOAD(n_, W, QG, QK, KG, U, GS) do { \
    const int it_ = ((b * 32 + (n_)) << 3) + h; \
    const unsigned char* scr_ = (const unsigned char*)p.scr() + (size_t)it_ * SCR_ITEM; \
    const bf16_t* g_uT = (const bf16_t*)scr_; const bf16_t* g_w = (const bf16_t*)(scr_ + 16384); const bf16_t* g_qg = (const bf16_t*)(scr_ + 32768); \
    const bf16_t* g_kgT = (const bf16_t*)(scr_ + 49152); const bf16_t* g_qk = (const bf16_t*)(scr_ + 65536); \
    _Pragma("unroll") for (int ks = 0; ks < 4; ++ks) { \
      W[ks] = *(const bf16x8*)(g_w + (wid * 16 + fr) * 128 + ks * 32 + fq * 8); \
      QG[ks] = *(const bf16x8*)(g_qg + (wid * 16 + fr) * 128 + ks * 32 + fq * 8); } \
    _Pragma("unroll") for (int ks = 0; ks < 2; ++ks) { \
      QK[ks] = *(const bf16x8*)(g_qk + (wid * 16 + fr) * 64 + ks * 32 + fq * 8); \
      _Pragma("unroll") for (int mt = 0; mt < 2; ++mt) KG[mt][ks] = *(const bf16x8*)(g_kgT + ((2 * wid + mt) * 16 + fr) * 64 + ks * 32 + fq * 8); } \
    _Pragma("unroll") for (int nt = 0; nt < 2; ++nt) U[nt] = *(const u32x2*)(g_uT + (dvs * 32 + nt * 16 + fr) * 64 + wid * 16 + fq * 4); \
    GS = p.gsc()[it_]; } while (0)
  SCAN_LOAD(0, nw, nqg, nqk, nkg, nu, ngs);
  for (int n = 0; n < 32; ++n) {
#pragma unroll
    for (int ks = 0; ks < 4; ++ks) { fw[ks] = nw[ks]; fqg[ks] = nqg[ks]; }
#pragma unroll
    for (int ks = 0; ks < 2; ++ks) { fqk[ks] = nqk[ks]; fkg[0][ks] = nkg[0][ks]; fkg[1][ks] = nkg[1][ks]; }
    fu[0] = nu[0]; fu[1] = nu[1]; gs = ngs;
    if (n + 1 < 32) SCAN_LOAD(n + 1, nw, nqg, nqk, nkg, nu, ngs);
    bf16_t* STc = ST + (n & 1) * 32 * 136;
#pragma unroll
    for (int mt = 0; mt < 2; ++mt)
#pragma unroll
      for (int nt = 0; nt < 2; ++nt)
        *(u32x2*)(STc + (nt * 16 + fr) * 136 + (2 * wid + mt) * 16 + fq * 4) = (u32x2){pk2(S[mt][nt].x, S[mt][nt].y), pk2(S[mt][nt].z, S[mt][nt].w)};
    __syncthreads();
#pragma unroll
    for (int nt = 0; nt < 2; ++nt) {
      f32x4 a = (f32x4){0.f, 0.f, 0.f, 0.f};
#pragma unroll
      for (int ks = 0; ks < 4; ++ks) {
        const bf16x8 sb = *(const bf16x8*)(STc + (nt * 16 + fr) * 136 + ks * 32 + fq * 8);
        a = mfma16(fw[ks], sb, a);
      }
      const float v0 = lo2f(fu[nt].x) - a.x, v1 = hi2f(fu[nt].x) - a.y, v2 = lo2f(fu[nt].y) - a.z, v3 = hi2f(fu[nt].y) - a.w;
      *(u32x2*)(VT + (nt * 16 + fr) * 72 + wid * 16 + fq * 4) = (u32x2){pk2(v0, v1), pk2(v2, v3)};
    }
    __syncthreads();
#pragma unroll
    for (int mt = 0; mt < 2; ++mt) {
      f32x4 a = (f32x4){0.f, 0.f, 0.f, 0.f};
#pragma unroll
      for (int ks = 0; ks < 4; ++ks) {
        const bf16x8 sa = *(const bf16x8*)(STc + (mt * 16 + fr) * 136 + ks * 32 + fq * 8);
        a = mfma16(sa, fqg[ks], a);
      }
#pragma unroll
      for (int ks = 0; ks < 2; ++ks) {
        const bf16x8 va = *(const bf16x8*)(VT + (mt * 16 + fr) * 72 + ks * 32 + fq * 8);
        a = mfma16(va, fqk[ks], a);
      }
      const size_t row = (size_t)b * 2048 + n * 64 + wid * 16 + fr;
      *(u32x2*)(p.ogdn() + row * DM + h * 128 + dvs * 32 + mt * 16 + fq * 4) = (u32x2){pk2(a.x, a.y), pk2(a.z, a.w)};
    }
#pragma unroll
    for (int mt = 0; mt < 2; ++mt)
#pragma unroll
      for (int nt = 0; nt < 2; ++nt) {
        f32x4 a = S[mt][nt] * gs;
#pragma unroll
        for (int ks = 0; ks < 2; ++ks) {
          const bf16x8 vb = *(const bf16x8*)(VT + (nt * 16 + fr) * 72 + ks * 32 + fq * 8);
          a = mfma16(fkg[mt][ks], vb, a);
        }
        S[mt][nt] = a;
      }
  }
  float* so = p.out + O_GDNP + ((size_t)(l * 8 + b) * 8 + h) * 16384;
#pragma unroll
  for (int mt = 0; mt < 2; ++mt)
#pragma unroll
    for (int nt = 0; nt < 2; ++nt)
#pragma unroll
      for (int jj = 0; jj < 4; ++jj) so[((2 * wid + mt) * 16 + fq * 4 + jj) * 128 + dvs * 32 + nt * 16 + fr] = S[mt][nt][jj];
  __syncthreads();
#undef SCAN_LOAD
}

__device__ void gdn_sample_item(const Params& p, int l, int item, unsigned char* smem) {
  const int tid = (opq(threadIdx.x) & 255), lane = tid & 63, wid = tid >> 6;
  const int h = item & 7, b = item >> 3;
  float* qs = (float*)smem;
  float* ks = qs + 1024;
  float* vs = ks + 1024;
  float* part = vs + 1024;
  float* sbeta = part + 256;
  float* sa = sbeta + 8;
  const int dv = tid & 127, half = tid >> 7;
  float S[64];
  const float* s0 = p.state_gdn + ((size_t)(l * 128 + b) * 8 + h) * 16384 + (half * 8192 + dv);
#pragma unroll
  for (int k = 0; k < 64; ++k) S[k] = s0[k * 128];
#pragma unroll
  for (int ps = 0; ps < 2; ++ps) {
    const int c = tid + ps * 256;
    if (c < 384) {
      const int sect = c >> 7, ci = c & 127;
      const int ch = sect * 1024 + h * 128 + ci;
      float xw[11], cwv[4];
#pragma unroll
      for (int j = 0; j < 4; ++j) cwv[j] = p.conv_w[(size_t)(l * 4 + j) * 3072 + ch];
#pragma unroll
      for (int j = 0; j < 3; ++j) xw[j] = p.cache_conv[((size_t)(l * 128 + b) * 3 + j) * 3072 + ch];
#pragma unroll
      for (int t = 0; t < 8; ++t) xw[3 + t] = bf2f(p.proj()[(size_t)(MP + b * 8 + t) * NPJ + ch]);
      float* dst = sect == 0 ? qs : (sect == 1 ? ks : vs);
#pragma unroll
      for (int t = 0; t < 8; ++t) dst[t * 128 + ci] = silu(xw[t] * cwv[0] + xw[t + 1] * cwv[1] + xw[t + 2] * cwv[2] + xw[t + 3] * cwv[3]);
    }
  }
  if (tid < 8) {
    const float* lg = p.logits() + (size_t)(MP + b * 8 + tid) * 16;
    const float x = lg[8 + h] + p.dt_bias[l * 8 + h];
    const float sp = softplus_f(x);
    sa[tid] = __expf(-__expf(p.a_log[l * 8 + h]) * sp);
    sbeta[tid] = sigm(lg[h]);
  }
  __syncthreads();
#pragma unroll
  for (int u = 0; u < 4; ++u) {
    const int t = wid * 2 + (u >> 1);
    float* arr = (u & 1) ? ks : qs;
    const float a0 = arr[t * 128 + lane], a1 = arr[t * 128 + 64 + lane];
    float ss = a0 * a0 + a1 * a1;
#pragma unroll
    for (int o = 1; o < 64; o <<= 1) ss += shx(ss, o, lane);
    float rn = rsqrtf(ss + EPS);
    if (!(u & 1)) rn *= 0.08838834764831845f;
    arr[t * 128 + lane] = a0 * rn;
    arr[t * 128 + 64 + lane] = a1 * rn;
  }
  __syncthreads();
#pragma unroll 1
  for (int t = 0; t < 8; ++t) {
    const float a = sa[t], bt = sbeta[t];
    float kv = 0.f;
#pragma unroll
    for (int k4 = 0; k4 < 16; ++k4) {
      const f32x4 kk = *(const f32x4*)(ks + t * 128 + half * 64 + k4 * 4);
      S[k4 * 4 + 0] *= a; S[k4 * 4 + 1] *= a; S[k4 * 4 + 2] *= a; S[k4 * 4 + 3] *= a;
      kv += S[k4 * 4 + 0] * kk.x + S[k4 * 4 + 1] * kk.y + S[k4 * 4 + 2] * kk.z + S[k4 * 4 + 3] * kk.w;
      if ((k4 & 3) == 3) asm volatile("" ::: "memory");
    }
    part[half * 128 + dv] = kv;
    __syncthreads();
    const float delta = bt * (vs[t * 128 + dv] - (part[dv] + part[128 + dv]));
    __syncthreads();
    float o = 0.f;
#pragma unroll
    for (int k4 = 0; k4 < 16; ++k4) {
      const f32x4 kk = *(const f32x4*)(ks + t * 128 + half * 64 + k4 * 4);
      const f32x4 qq = *(const f32x4*)(qs + t * 128 + half * 64 + k4 * 4);
      S[k4 * 4 + 0] += kk.x * delta; S[k4 * 4 + 1] += kk.y * delta; S[k4 * 4 + 2] += kk.z * delta; S[k4 * 4 + 3] += kk.w * delta;
      o += S[k4 * 4 + 0] * qq.x + S[k4 * 4 + 1] * qq.y + S[k4 * 4 + 2] * qq.z + S[k4 * 4 + 3] * qq.w;
      if ((k4 & 3) == 3) asm volatile("" ::: "memory");
    }
    part[half * 128 + dv] = o;
    __syncthreads();
    if (half == 0) p.ogdn()[(size_t)(MP + b * 8 + t) * DM + h * 128 + dv] = f2bf(part[dv] + part[128 + dv]);
    __syncthreads();
  }
  float* so = p.out + O_GDNS + ((size_t)(l * 128 + b) * 8 + h) * 16384 + opq(half * 8192 + dv);
#pragma unroll
  for (int k = 0; k < 64; ++k) so[k * 128] = S[k];
  __syncthreads();
}

__device__ void gdn_sample_pair(const Params& p, int l, int pair, unsigned char* smem) {
  const int tid = (opq(threadIdx.x) & 255), lane = tid & 63, wid = tid >> 6;
  const int sub = tid >> 7, dv = tid & 127;
  const int item = pair * 2 + sub, h = item & 7, b = item >> 3;
  float* qs = (float*)smem + sub * 3104;
  float* ks = qs + 1024;
  float* vs = qs + 2048;
  float* sbeta = qs + 3072;
  float* sa = qs + 3080;
  f32x2 S2[64];
  const float* s0 = p.state_gdn + ((size_t)(l * 128 + b) * 8 + h) * 16384 + dv;
#pragma unroll
  for (int k = 0; k < 64; ++k) { S2[k].x = s0[(2 * k) * 128]; S2[k].y = s0[(2 * k + 1) * 128]; }
#pragma unroll
  for (int sect = 0; sect < 3; ++sect) {
    const int ch = sect * 1024 + h * 128 + dv;
    float xw[11], cwv[4];
#pragma unroll
    for (int j = 0; j < 4; ++j) cwv[j] = p.conv_w[(size_t)(l * 4 + j) * 3072 + ch];
#pragma unroll
    for (int j = 0; j < 3; ++j) xw[j] = p.cache_conv[((size_t)(l * 128 + b) * 3 + j) * 3072 + ch];
#pragma unroll
    for (int t = 0; t < 8; ++t) xw[3 + t] = bf2f(p.proj()[(size_t)(MP + b * 8 + t) * NPJ + ch]);
    float* dst = sect == 0 ? qs : (sect == 1 ? ks : vs);
#pragma unroll
    for (int t = 0; t < 8; ++t) dst[t * 128 + dv] = silu(xw[t] * cwv[0] + xw[t + 1] * cwv[1] + xw[t + 2] * cwv[2] + xw[t + 3] * cwv[3]);
  }
  if (dv < 8) {
    const float* lg = p.logits() + (size_t)(MP + b * 8 + dv) * 16;
    const float x = lg[8 + h] + p.dt_bias[l * 8 + h];
    sa[dv] = __expf(-__expf(p.a_log[l * 8 + h]) * softplus_f(x));
    sbeta[dv] = sigm(lg[h]);
  }
  __syncthreads();
#pragma unroll
  for (int u = 0; u < 8; ++u) {
    const int t = (wid & 1) * 4 + (u >> 1);
    float* arr = (u & 1) ? ks : qs;
    const float a0 = arr[t * 128 + lane], a1 = arr[t * 128 + 64 + lane];
    float ss = a0 * a0 + a1 * a1;
#pragma unroll
    for (int o = 1; o < 64; o <<= 1) ss += shx(ss, o, lane);
    float rn = rsqrtf(ss + EPS);
    if (!(u & 1)) rn *= 0.08838834764831845f;
    arr[t * 128 + lane] = a0 * rn;
    arr[t * 128 + 64 + lane] = a1 * rn;
  }
  __syncthreads();
#pragma unroll 1
  for (int t = 0; t < 8; ++t) {
    const float a = sa[t], bt = sbeta[t];
    f32x2 kv2 = (f32x2){0.f, 0.f};
#pragma unroll
    for (int k4 = 0; k4 < 32; ++k4) {
      const f32x4 kk = *(const f32x4*)(ks + t * 128 + k4 * 4);
      kv2 += S2[2 * k4] * (f32x2){kk.x, kk.y};
      kv2 += S2[2 * k4 + 1] * (f32x2){kk.z, kk.w};
      if ((k4 & 3) == 3) asm volatile("" ::: "memory");
    }
    const float delta = bt * (vs[t * 128 + dv] - a * (kv2.x + kv2.y));
    const f32x2 a2 = (f32x2){a, a}, d2 = (f32x2){delta, delta};
    f32x2 o2 = (f32x2){0.f, 0.f};
#pragma unroll
    for (int k4 = 0; k4 < 32; ++k4) {
      const f32x4 kk = *(const f32x4*)(ks + t * 128 + k4 * 4);
      const f32x4 qq = *(const f32x4*)(qs + t * 128 + k4 * 4);
      S2[2 * k4] = S2[2 * k4] * a2 + (f32x2){kk.x, kk.y} * d2;
      S2[2 * k4 + 1] = S2[2 * k4 + 1] * a2 + (f32x2){kk.z, kk.w} * d2;
      o2 += S2[2 * k4] * (f32x2){qq.x, qq.y};
      o2 += S2[2 * k4 + 1] * (f32x2){qq.z, qq.w};
      if ((k4 & 3) == 3) asm volatile("" ::: "memory");
    }
    p.ogdn()[(size_t)(MP + b * 8 + t) * DM + h * 128 + dv] = f2bf(o2.x + o2.y);
  }
  float* so = p.out + O_GDNS + ((size_t)(l * 128 + b) * 8 + h) * 16384 + opq(dv);
#pragma unroll
  for (int k = 0; k < 64; ++k) { so[(2 * k) * 128] = S2[k].x; so[(2 * k + 1) * 128] = S2[k].y; }
  __syncthreads();
}

__device__ void swa_prompt_item(const Params& p, int l, int item, unsigned char* smem) {
  const int tid = (opq(threadIdx.x) & 255), lane = tid & 63, wid = tid >> 6, fr = lane & 15, fq = lane >> 4;
  const int kvh = item & 3, hb2 = (item >> 2) & 31, b = item >> 7;
  bf16_t* Ks = (bf16_t*)smem;
  bf16_t* VT = Ks + 208 * 72;
  bf16_t* Pw = VT + 64 * 216 + wid * 16 * 168;
  const int tk0 = hb2 * 64 - 128;
  u32x4 krw[7], vrw[7];
#pragma unroll
  for (int i = 0; i < 7; ++i) {
    const int pc = tid + i * NTHR, kj = pc >> 3, c8 = pc & 7, tk = tk0 + kj;
    krw[i] = (u32x4){0u, 0u, 0u, 0u}; vrw[i] = (u32x4){0u, 0u, 0u, 0u};
    if (pc < 208 * 8 && kj < 192 && tk >= 0) {
      const bf16_t* base = p.proj() + (size_t)(b * 2048 + tk) * NPJ + kvh * 64 + c8 * 8;
      krw[i] = *(const u32x4*)(base + C_SK); vrw[i] = *(const u32x4*)(base + C_SV);
    }
  }
#pragma unroll
  for (int i = 0; i < 7; ++i) {
    const int pc = tid + i * NTHR;
    if (pc >= 208 * 8) break;
    const int kj = pc >> 3, c8 = pc & 7, tk = tk0 + kj;
    const bool ok = kj < 192 && tk >= 0;
    float kf[8], vf[8];
    UNPACK8(krw[i], kf);
    UNPACK8(vrw[i], vf);
    float ss = 0.f;
#pragma unroll
    for (int c = 0; c < 8; ++c) ss += kf[c] * kf[c];
    ss += shx(ss, 1, lane); ss += shx(ss, 2, lane); ss += shx(ss, 4, lane);
    const float rn = rsqrtf(ss * (1.f / 64.f) + EPS);
    const f32x4 w0 = *(const f32x4*)(p.k_norm + l * 64 + c8 * 8), w1 = *(const f32x4*)(p.k_norm + l * 64 + c8 * 8 + 4);
    kf[0] *= rn * w0.x; kf[1] *= rn * w0.y; kf[2] *= rn * w0.z; kf[3] *= rn * w0.w;
    kf[4] *= rn * w1.x; kf[5] *= rn * w1.y; kf[6] *= rn * w1.z; kf[7] *= rn * w1.w;
    *(u32x4*)(Ks + kj * 72 + c8 * 8) = (u32x4){pk2(kf[0], kf[1]), pk2(kf[2], kf[3]), pk2(kf[4], kf[5]), pk2(kf[6], kf[7])};
#pragma unroll
    for (int c = 0; c < 8; ++c) VT[(c8 * 8 + c) * 216 + kj] = f2bf(vf[c]);
    if (ok && tk >= 1920 && kj >= 128) {
      float* ko = p.out + O_KP + (((size_t)(l * 8 + b) * 128 + (tk - 1920)) * 4 + kvh) * 64 + c8 * 8;
      float* vo = p.out + O_VP + (((size_t)(l * 8 + b) * 128 + (tk - 1920)) * 4 + kvh) * 64 + c8 * 8;
      *(f32x4*)ko = (f32x4){kf[0], kf[1], kf[2], kf[3]};
      *(f32x4*)(ko + 4) = (f32x4){kf[4], kf[5], kf[6], kf[7]};
      *(f32x4*)vo = (f32x4){vf[0], vf[1], vf[2], vf[3]};
      *(f32x4*)(vo + 4) = (f32x4){vf[4], vf[5], vf[6], vf[7]};
    }
  }
  __syncthreads();
  const int kbase = wid * 16;
  const int ql = wid * 16 + fr;
  const size_t qrow = (size_t)b * 2048 + hb2 * 64 + ql;
  u32x4 qraw[4][2];
#pragma unroll
  for (int g = 0; g < 4; ++g) {
    const bf16_t* qp = p.proj() + qrow * NPJ + C_SQ + (kvh * 4 + g) * 64 + fq * 8;
    qraw[g][0] = *(const u32x4*)qp; qraw[g][1] = *(const u32x4*)(qp + 32);
  }
#pragma unroll
  for (int g = 0; g < 4; ++g) {
    const int head = kvh * 4 + g;
    const float slope = exp2f(-0.5f * (float)(head + 1));
    const float sink = p.sinks[l * 16 + head];
    bf16x8 qf[2];
    {
      const u32x4 r0 = qraw[g][0], r1 = qraw[g][1];
      float f0[8], f1[8];
      UNPACK8(r0, f0);
      UNPACK8(r1, f1);
      float ss = 0.f;
#pragma unroll
      for (int c = 0; c < 8; ++c) ss += f0[c] * f0[c] + f1[c] * f1[c];
      ss += shx(ss, 16, lane); ss += shx(ss, 32, lane);
      const float rn = rsqrtf(ss * (1.f / 64.f) + EPS) * 0.125f;
      const float* qn = p.q_norm + l * 64 + fq * 8;
#pragma unroll
      for (int c = 0; c < 8; ++c) { f0[c] *= rn * qn[c]; f1[c] *= rn * qn[32 + c]; }
      qf[0] = as_bf((u32x4){pk2(f0[0], f0[1]), pk2(f0[2], f0[3]), pk2(f0[4], f0[5]), pk2(f0[6], f0[7])});
      qf[1] = as_bf((u32x4){pk2(f1[0], f1[1]), pk2(f1[2], f1[3]), pk2(f1[4], f1[5]), pk2(f1[6], f1[7])});
    }
    f32x4 sc[9];
    float mx = sink;
#pragma unroll
    for (int kt = 0; kt < 9; ++kt) {
      f32x4 a = (f32x4){0.f, 0.f, 0.f, 0.f};
#pragma unroll
      for (int ks = 0; ks < 2; ++ks) {
        const bf16x8 kf = *(const bf16x8*)(Ks + (kbase + kt * 16 + fr) * 72 + ks * 32 + fq * 8);
        a = mfma16(kf, qf[ks], a);
      }
#pragma unroll
      for (int jj = 0; jj < 4; ++jj) {
        const int kj = kbase + kt * 16 + fq * 4 + jj;
        const int dist = ql + 128 - kj;
        const bool ok = dist >= 0 && dist <= 128 && (tk0 + kj) >= 0;
        const float s = ok ? a[jj] - slope * (float)dist : -INFINITY;
        a[jj] = s;
        mx = fmaxf(mx, s);
      }
      sc[kt] = a;
    }
    mx = fmaxf(mx, shx(mx, 16, lane));
    mx = fmaxf(mx, shx(mx, 32, lane));
    float sum = 0.f;
#pragma unroll
    for (int kt = 0; kt < 9; ++kt) {
      f32x4 e;
#pragma unroll
      for (int jj = 0; jj < 4; ++jj) { e[jj] = __expf(sc[kt][jj] - mx); sum += e[jj]; }
      *(u32x2*)(Pw + fr * 168 + kt * 16 + fq * 4) = (u32x2){pk2(e.x, e.y), pk2(e.z, e.w)};
    }
    *(u32x2*)(Pw + fr * 168 + 144 + fq * 4) = (u32x2){0u, 0u};
    sum += shx(sum, 16, lane);
    sum += shx(sum, 32, lane);
    const float inv = 1.f / (sum + __expf(sink - mx));
    __builtin_amdgcn_wave_barrier();
#pragma unroll
    for (int dt = 0; dt < 4; ++dt) {
      f32x4 a = (f32x4){0.f, 0.f, 0.f, 0.f};
#pragma unroll
      for (int ks = 0; ks < 5; ++ks) {
        const bf16x8 vf = *(const bf16x8*)(VT + (dt * 16 + fr) * 216 + kbase + ks * 32 + fq * 8);
        const bf16x8 pf = *(const bf16x8*)(Pw + fr * 168 + ks * 32 + fq * 8);
        a = mfma16(vf, pf, a);
      }
      a *= inv;
      *(u32x2*)(p.oswa() + qrow * DM + head * 64 + dt * 16 + fq * 4) = (u32x2){pk2(a.x, a.y), pk2(a.z, a.w)};
    }
    __builtin_amdgcn_wave_barrier();
  }
  __syncthreads();
}

__device__ void swa_sample_item(const Params& p, int l, int item, unsigned char* smem) {
  const int tid = (opq(threadIdx.x) & 255), lane = tid & 63, wid = tid >> 6;
  const int kvh = item & 3, b = item >> 2;
  float* Ks = (float*)smem;
  float* Vs = Ks + 136 * 68;
  float* Qs = Vs + 136 * 64;
  float* Sc = Qs + 512;
  const size_t cbase = (size_t)(l * 128 + b) * 128;
  f32x4 kvr[8], vvr[8];
#pragma unroll
  for (int i = 0; i < 8; ++i) {
    const int idx = tid + i * NTHR, j = idx >> 4, c4 = idx & 15;
    kvr[i] = *(const f32x4*)(p.cache_k + ((cbase + j) * 4 + kvh) * 64 + c4 * 4);
    vvr[i] = *(const f32x4*)(p.cache_v + ((cbase + j) * 4 + kvh) * 64 + c4 * 4);
  }
  unsigned qrw[4];
#pragma unroll
  for (int g = 0; g < 4; ++g) qrw[g] = *(const unsigned*)(p.proj() + (size_t)(MP + b * 8 + (tid >> 5)) * NPJ + C_SQ + (kvh * 4 + g) * 64 + (tid & 31) * 2);
#pragma unroll
  for (int i = 0; i < 8; ++i) {
    const int idx = tid + i * NTHR, j = idx >> 4, c4 = idx & 15;
    const f32x4 kv = kvr[i], vv = vvr[i];
    *(f32x4*)(Ks + j * 68 + c4 * 4) = kv;
    *(f32x4*)(Vs + j * 64 + c4 * 4) = vv;
  }
  {
    const int t = tid >> 5, d = (tid & 31) * 2;
    const bf16_t* base = p.proj() + (size_t)(MP + b * 8 + t) * NPJ + kvh * 64 + d;
    const unsigned kr = *(const unsigned*)(base + C_SK), vr = *(const unsigned*)(base + C_SV);
    float k0 = lo2f(kr), k1 = hi2f(kr);
    float ss = k0 * k0 + k1 * k1;
#pragma unroll
    for (int o = 1; o < 32; o <<= 1) ss += shx(ss, o, lane);
    const float rn = rsqrtf(ss * (1.f / 64.f) + EPS);
    Ks[(128 + t) * 68 + d] = k0 * rn * p.k_norm[l * 64 + d];
    Ks[(128 + t) * 68 + d + 1] = k1 * rn * p.k_norm[l * 64 + d + 1];
    Vs[(128 + t) * 64 + d] = lo2f(vr);
    Vs[(128 + t) * 64 + d + 1] = hi2f(vr);
  }
  __syncthreads();
  for (int idx = tid; idx < 128 * 64; idx += NTHR) {
    const int j = idx >> 6, d = idx & 63;
    p.out[O_KS + ((cbase + j) * 4 + kvh) * 64 + d] = Ks[(j + 8) * 68 + d];
    p.out[O_VS + ((cbase + j) * 4 + kvh) * 64 + d] = Vs[(j + 8) * 64 + d];
  }
#pragma unroll
  for (int g = 0; g < 4; ++g) {
    const int head = kvh * 4 + g;
    const float slope = exp2f(-0.5f * (float)(head + 1));
    const float sink = p.sinks[l * 16 + head];
    {
      const int t = tid >> 5, d = (tid & 31) * 2;
      const unsigned qr = qrw[g];
      const float q0 = lo2f(qr), q1 = hi2f(qr);
      float ss = q0 * q0 + q1 * q1;
#pragma unroll
      for (int o = 1; o < 32; o <<= 1) ss += shx(ss, o, lane);
      const float rn = rsqrtf(ss * (1.f / 64.f) + EPS) * 0.125f;
      Qs[t * 64 + d] = q0 * rn * p.q_norm[l * 64 + d];
      Qs[t * 64 + d + 1] = q1 * rn * p.q_norm[l * 64 + d + 1];
    }
    __syncthreads();
    for (int idx = tid; idx < 8 * 136; idx += NTHR) {
      const int tq = idx / 136, j = idx % 136;
      float s = 0.f;
#pragma unroll
      for (int d4 = 0; d4 < 16; ++d4) {
        const f32x4 qv = *(const f32x4*)(Qs + tq * 64 + d4 * 4), kq = *(const f32x4*)(Ks + j * 68 + d4 * 4);
        s += (qv.x * kq.x + qv.y * kq.y) + (qv.z * kq.z + qv.w * kq.w);
      }
      const int dist = tq + 128 - j;
      Sc[tq * 136 + j] = (dist >= 0 && dist <= 128) ? s - slope * (float)dist : -INFINITY;
    }
    __syncthreads();
#pragma unroll
    for (int u = 0; u < 2; ++u) {
      const int tq = wid * 2 + u;
      const float s0 = Sc[tq * 136 + lane], s1 = Sc[tq * 136 + 64 + lane], s2 = lane < 8 ? Sc[tq * 136 + 128 + lane] : -INFINITY;
      float mx = fmaxf(fmaxf(s0, s1), fmaxf(s2, sink));
#pragma unroll
      for (int o = 1; o < 64; o <<= 1) mx = fmaxf(mx, shx(mx, o, lane));
      const float e0 = __expf(s0 - mx), e1 = __expf(s1 - mx), e2 = __expf(s2 - mx);
      float sum = e0 + e1 + e2;
#pragma unroll
      for (int o = 1; o < 64; o <<= 1) sum += shx(sum, o, lane);
      const float inv = 1.f / (sum + __expf(sink - mx));
      Sc[tq * 136 + lane] = e0 * inv;
      Sc[tq * 136 + 64 + lane] = e1 * inv;
      if (lane < 8) Sc[tq * 136 + 128 + lane] = e2 * inv;
    }
    __syncthreads();
    {
      const int tq = tid >> 5, d = (tid & 31) * 2;
      float o0 = 0.f, o1 = 0.f;
#pragma unroll 2
      for (int j4 = 0; j4 < 34; ++j4) {
        const f32x4 pj = *(const f32x4*)(Sc + tq * 136 + j4 * 4);
        const f32x2 va = *(const f32x2*)(Vs + (j4 * 4 + 0) * 64 + d), vb = *(const f32x2*)(Vs + (j4 * 4 + 1) * 64 + d);
        const f32x2 vc = *(const f32x2*)(Vs + (j4 * 4 + 2) * 64 + d), vd = *(const f32x2*)(Vs + (j4 * 4 + 3) * 64 + d);
        o0 += (pj.x * va.x + pj.y * vb.x) + (pj.z * vc.x + pj.w * vd.x);
        o1 += (pj.x * va.y + pj.y * vb.y) + (pj.z * vc.y + pj.w * vd.y);
      }
      *(unsigned*)(p.oswa() + (size_t)(MP + b * 8 + tq) * DM + head * 64 + d) = pk2(o0, o1);
    }
    __syncthreads();
  }
}

__device__ void phase_mix(const Params& p, int l) {
  const int tid = (opq(threadIdx.x) & 255), lane = tid & 63, wid = tid >> 6, fr = lane & 15, fq = lane >> 4;
  for (int it = VB; it < MTOK / 4; it += VG) {
    const size_t row = (size_t)it * 4 + wid;
#pragma unroll
    for (int ps = 0; ps < 2; ++ps) {
      const int ch = (ps * 4 + fq) * 128 + fr * 8;
      const u32x4 og = *(const u32x4*)(p.ogdn() + row * DM + ch);
      const u32x4 ob = *(const u32x4*)(p.oswa() + row * DM + ch);
      const u32x4 zz = *(const u32x4*)(p.proj() + row * NPJ + C_Z + ch);
      const u32x4 ga = *(const u32x4*)(p.proj() + row * NPJ + C_G + ch);
      const u32x4 gb = *(const u32x4*)(p.proj() + row * NPJ + C_G + 1024 + ch);
      float fo[8], fb[8], fz[8], fa[8], fg[8];
      UNPACK8(og, fo); UNPACK8(ob, fb); UNPACK8(zz, fz); UNPACK8(ga, fa); UNPACK8(gb, fg);
      float ss = 0.f;
#pragma unroll
      for (int c = 0; c < 8; ++c) ss += fo[c] * fo[c];
      ss += shx(ss, 1, lane); ss += shx(ss, 2, lane); ss += shx(ss, 4, lane); ss += shx(ss, 8, lane);
      const float rn = rsqrtf(ss * (1.f / 128.f) + EPS);
      const f32x4 w0 = *(const f32x4*)(p.gdn_norm + l * 128 + fr * 8), w1 = *(const f32x4*)(p.gdn_norm + l * 128 + fr * 8 + 4);
      const float wn[8] = {w0.x, w0.y, w0.z, w0.w, w1.x, w1.y, w1.z, w1.w};
      float m[8];
#pragma unroll
      for (int c = 0; c < 8; ++c) m[c] = sigm(fa[c]) * (fo[c] * rn * wn[c] * silu(fz[c])) + sigm(fg[c]) * fb[c];
      *(u32x4*)(p.mix() + row * DM + ch) = (u32x4){pk2(m[0], m[1]), pk2(m[2], m[3]), pk2(m[4], m[5]), pk2(m[6], m[7])};
    }
  }
  const int NC = (8 + 128) * 3 * 3072;
  for (int i = VB * NTHR + tid; i < NC; i += VG * NTHR) {
    const int c = i % 3072, r = (i / 3072) % 3, bb = i / 9216;
    if (bb < 8) p.out[O_CONVP + ((size_t)(l * 8 + bb) * 3 + r) * 3072 + c] = bf2f(p.proj()[(size_t)(bb * 2048 + 2045 + r) * NPJ + c]);
    else p.out[O_CONVS + ((size_t)(l * 128 + bb - 8) * 3 + r) * 3072 + c] = bf2f(p.proj()[(size_t)(MP + (bb - 8) * 8 + 5 + r) * NPJ + c]);
  }
}

#define XB_TMO      128
#define XB_XCNT(j)  (256  + 64 * (j))
#define XB_XSUB(j)  (1280 + 64 * (j))
#define XB_XGEN(j)  (2304 + 64 * (j))
#define XB_TOP      3328
#define XB_TOPGEN   3392
#define XCD_BAR_WORDS 3456
#define XB_SPIN_CAP (1u << 18)
#define LAS __attribute__((address_space(3)))

__device__ __forceinline__ unsigned xb_ld(unsigned* p)              { return __hip_atomic_load(p, __ATOMIC_RELAXED, __HIP_MEMORY_SCOPE_AGENT); }
__device__ __forceinline__ unsigned xb_add(unsigned* p, unsigned v) { return __hip_atomic_fetch_add(p, v, __ATOMIC_RELAXED, __HIP_MEMORY_SCOPE_AGENT); }
__device__ __forceinline__ unsigned xb_xcc_id() { return (unsigned)__builtin_amdgcn_s_getreg((3 << 11) | 20) & 0xFu; }
#define XB_SPIN(cond, bar) do { unsigned _sp = 0; while (cond) { __builtin_amdgcn_s_sleep(1); \
    if ((++_sp & 255u) == 0u) { if (xb_ld(&(bar)[XB_TMO])) break; if (_sp > XB_SPIN_CAP) { atomicAdd(&(bar)[XB_TMO], 1u); break; } } } } while (0)

struct XcdBarrier {
    unsigned* bar; unsigned x;
    volatile LAS unsigned* st;
};

__device__ __forceinline__ XcdBarrier xcd_barrier_post(unsigned* bar, volatile LAS unsigned* st) {
    XcdBarrier b; b.bar = bar; b.x = xb_xcc_id(); b.st = st;
    if (threadIdx.x == 0) (void)xb_add(&bar[XB_XCNT(b.x)], 1u);
    return b;
}
__device__ __forceinline__ void xcd_barrier_complete(unsigned* bar, unsigned x, unsigned& nloc, unsigned& nx) {
    const unsigned G = gridDim.x * gridDim.y * gridDim.z;
    unsigned sum, cnt, mine, sp = 0u;
    for (;;) {
        sum = 0u; cnt = 0u; mine = 0u;
#pragma unroll
        for (unsigned j = 0; j < 16; ++j) { const unsigned c = xb_ld(&bar[XB_XCNT(j)]); sum += c; cnt += (c > 0u) ? 1u : 0u; mine = (j == x) ? c : mine; }
        if (sum == G) break;
        __builtin_amdgcn_s_sleep(1);
        if ((++sp & 255u) == 0u) { if (xb_ld(&bar[XB_TMO])) break; if (sp > XB_SPIN_CAP) { atomicAdd(&bar[XB_TMO], 1u); break; } }
    }
    nloc = mine > 0u ? mine : 1u; nx = cnt > 0u ? cnt : 1u;
}

__device__ __forceinline__ void xcd_barrier(const XcdBarrier& b) {
    asm volatile("s_waitcnt vmcnt(0)" ::: "memory");
    __syncthreads();
    if (threadIdx.x == 0) {
        unsigned* bar = b.bar;
        __builtin_amdgcn_s_waitcnt(0);
        unsigned nloc = b.st[0], nx = b.st[1];
        if (nloc == 0u) { xcd_barrier_complete(bar, b.x, nloc, nx); b.st[0] = nloc; b.st[1] = nx; }
        const unsigned old = xb_add(&bar[XB_XSUB(b.x)], 1u);
        const unsigned gen = old / nloc;
        if (old + 1u == (gen + 1u) * nloc) {
            __builtin_amdgcn_fence(__ATOMIC_RELEASE, "agent");
            asm volatile("s_waitcnt vmcnt(0)" ::: "memory");
            const unsigned og = xb_add(&bar[XB_TOP], 1u);
            const unsigned tg = og / nx;
            if (og + 1u == (tg + 1u) * nx) xb_add(&bar[XB_TOPGEN], 1u);
            else XB_SPIN(xb_ld(&bar[XB_TOPGEN]) == tg, bar);
            __builtin_amdgcn_fence(__ATOMIC_ACQUIRE, "agent");
            xb_add(&bar[XB_XGEN(b.x)], 1u);
            asm volatile("s_waitcnt vmcnt(0)" ::: "memory");
        } else {
            XB_SPIN(xb_ld(&bar[XB_XGEN(b.x)]) == gen, bar);
            __builtin_amdgcn_fence(__ATOMIC_ACQUIRE, "agent");
            asm volatile("s_waitcnt vmcnt(0)" ::: "memory");
        }
    }
    __syncthreads();
}


#define NPHASE_PRE 2
#define NPHASE_L 8
constexpr int LDS_TOTAL = 2 * SMEM_BYTES;
__global__ void __launch_bounds__(512, 2) mega(Params p, int ph_lo, int ph_hi) {
  extern __shared__ __attribute__((aligned(16))) unsigned char lds_all[];
  if (ph_hi < 0) cg::this_grid().sync();
  __shared__ uint4 xb_words;
  if (threadIdx.x == 0) xb_words = make_uint4(0u, 0u, 0u, 0u);
  __syncthreads();
  XcdBarrier xb = xcd_barrier_post(p.bar(), (volatile LAS unsigned*)&xb_words);
  unsigned char* smem = lds_all + VHALF * SMEM_BYTES;
  for (int ph = ph_lo; ph < ph_hi; ++ph) {
    if (ph > ph_lo) xcd_barrier(xb);
    if (ph == 0) { phase_p0(p, smem); continue; }
    if (ph == 1) {
      {
        EpiArgs e{};
        e.obf = p.pp(); e.ldo = DM;
        DiagSched S; S.nLimit = 1024; S.G = gridDim.x; S.c = blockIdx.x;
        pg8::Gemm g; g.A = p.pb(); g.Bt = p.wt_proj(); g.M = NL * MTOK; g.N = NL * DM; g.K = PLE;
        BigEpi<EPI_PP> E; E.e = e;
        pg8::gemm_phase<BigEpi<EPI_PP>, DiagSched>((PG8_LAS unsigned char*)lds_all, g, S, E, nullptr);
        __syncthreads();
      }
      for (int st = VB; st < 64 * 16; st += VG) {
        const int L = 1024 + (st >> 4), sub = st & 15, l = L / 272, r = L - l * 272, pm = r >> 2, pn = r & 3;
        EpiArgs e{};
        e.obf = p.pp() + (size_t)l * MTOK * DM; e.ldo = DM;
        gemm_tile<1, 4, 4, 1, EPI_PP, 128>(p.pb() + (size_t)l * MTOK * PLE, PLE, p.wt_proj() + (size_t)l * DM * PLE, PLE, PLE, pm * 256 + (sub >> 2) * 64, pn * 256 + (sub & 3) * 64, (bf16_t*)smem, e);
      }
      continue;
    }
    const int l = (ph - NPHASE_PRE) / NPHASE_L, s = (ph - NPHASE_PRE) % NPHASE_L;
#ifndef REPMASK
#define REPMASK 0
#endif
    for (int rep = 0; rep < (((REPMASK >> s) & 1) ? 2 : 1); ++rep) {
    if (rep) xcd_barrier(xb);
    switch (s) {
      case 0: {
        EpiArgs e{};
        e.ssq_in = p.ssq0(); e.obf = p.proj(); e.ldo = NPJ; e.of32 = p.logits();
        const bf16_t* Bt = p.wt_in() + (size_t)l * NIN * DM;
        gemm_big_phase<EPI_PROJ>(p.hb(), Bt, DM, MTOK, NPJ, lds_all, smem, e);
        for (int t = VB; t < 272; t += VG)
          gemm_tile<1, 1, 4, 1, EPI_LOGIT, 128>(p.hb(), DM, Bt + (size_t)NPJ * DM, DM, DM, t * 64, 0, (bf16_t*)smem, e);
      } break;
      case 1: {
        const int nB1 = VG == 512 ? 3072 : 3584;
        for (int t = VB; t < nB1; t += VG) {
          if (t < 2048) gdn_prep_item(p, l, t, smem);
          else if (t < 3072) swa_prompt_item(p, l, t - 2048, smem);
          else swa_sample_item(p, l, t - 3072, smem);
        }
      } break;
      case 2: {
        if (VG == 512) {
          if (VB < 256) gdn_scan_item(p, l, VB, smem);
          else {
            gdn_sample_pair(p, l, VB - 256, smem); gdn_sample_pair(p, l, VB, smem);
            swa_sample_item(p, l, (VB - 256) * 2, smem); swa_sample_item(p, l, (VB - 256) * 2 + 1, smem);
          }
        } else {
          for (int t = VB; t < 256 + 512; t += VG) {
            if (t < 256) gdn_scan_item(p, l, t, smem);
            else gdn_sample_pair(p, l, t - 256, smem);
          }
        }
      } break;
      case 3: phase_mix(p, l); break;
      case 4: {
        EpiArgs e{};
        e.h = p.out; e.hb = p.hb2(); e.ssq_out = p.ssq1();
        gemm_big_phase<EPI_RESID>(p.mix(), p.wt_out() + (size_t)l * DM * DM, DM, MTOK, DM, lds_all, smem, e);
      } break;
      case 5: {
        EpiArgs e{};
        e.ssq_in = p.ssq1(); e.obf = p.proj(); e.ldo = DFF;
        gemm_big_phase<EPI_UP>(p.hb2(), p.wt_up() + (size_t)l * DFF * DM, DM, MTOK, DFF, lds_all, smem, e);
      } break;
      case 6: {
        EpiArgs e{};
        e.h = p.out; e.hb = p.hb2(); e.ssq_out = p.ssq2();
        gemm_big_phase<EPI_RESID>(p.proj(), p.wt_down() + (size_t)l * DM * DFF, DFF, MTOK, DM, lds_all, smem, e);
      } break;
      case 7: {
        EpiArgs e{};
        e.h = p.out; e.hb = p.hb(); e.ssq_in = p.ssq2(); e.ssq_out = p.ssq0(); e.pp = p.pp() + (size_t)l * MTOK * DM;
        gemm_big_phase<EPI_PLE>(p.hb2(), p.wt_gate() + (size_t)l * DM * DM, DM, MTOK, DM, lds_all, smem, e);
      } break;
    }
    }
  }
}

extern "C" void kernel_launch(void* const* d_in, const int* in_sizes, int n_in, void* d_out, int out_size, void* d_ws, size_t ws_size,
                              hipStream_t stream) {
  Params p{};
  const float* const* in = (const float* const*)d_in;
  p.x_prompt = in[0]; p.x_sample = in[1]; p.cache_conv = in[2]; p.state_gdn = in[3]; p.cache_k = in[4]; p.cache_v = in[5];
  p.p_prompt = in[6]; p.p_sample = in[7]; p.norm_mix = in[8]; p.w_in = in[9]; p.conv_w = in[10]; p.a_log = in[11]; p.dt_bias = in[12];
  p.gdn_norm = in[13]; p.q_norm = in[14]; p.k_norm = in[15]; p.sinks = in[16]; p.w_out = in[17]; p.norm_ffn = in[18]; p.w_up = in[19];
  p.w_down = in[20]; p.norm_ple = in[21]; p.w_gate = in[22]; p.w_proj = in[23];
  p.out = (float*)d_out;
  p.ws = (unsigned char*)d_ws;
  if (WS_TOTAL > ws_size) { fprintf(stderr, "workspace too small: need %zu have %zu\n", (size_t)WS_TOTAL, ws_size); return; }

  static int grid_blocks = 0;
  if (!grid_blocks) {
    int dev = 0, cus = 0, per_cu = 0;
    (void)hipGetDevice(&dev);
    (void)hipDeviceGetAttribute(&cus, hipDeviceAttributeMultiprocessorCount, dev);
    if (hipFuncSetAttribute((const void*)mega, hipFuncAttributeMaxDynamicSharedMemorySize, LDS_TOTAL) != hipSuccess) { fprintf(stderr, "hipFuncSetAttribute(dynamic LDS %d) failed\n", LDS_TOTAL); grid_blocks = -1; return; }
    (void)hipOccupancyMaxActiveBlocksPerMultiprocessor(&per_cu, (const void*)mega, 512, LDS_TOTAL);
    (void)hipGetLastError();
    grid_blocks = cus;
  }
  if (grid_blocks < 0) return;
  (void)hipMemsetAsync(p.ws + WO_bar, 0, (size_t)XCD_BAR_WORDS * 4, stream);
  int lo = 0, hi = NPHASE_PRE + NL * NPHASE_L;
  void* args[] = {&p, &lo, &hi};
  hipError_t e = hipLaunchCooperativeKernel((void*)mega, dim3(grid_blocks), dim3(512), args, LDS_TOTAL, stream);
  if (e != hipSuccess) fprintf(stderr, "cooperative launch failed: %s (grid %d)\n", hipGetErrorString(e), grid_blocks);
}
```

```cpp
#include <hip/hip_runtime.h>
#include <hip/hip_cooperative_groups.h>
#include <cstdio>
namespace cg = cooperative_groups;

typedef unsigned short bf16_t;
typedef short bf16x8 __attribute__((ext_vector_type(8)));
typedef float f32x4 __attribute__((ext_vector_type(4)));
typedef float f32x2 __attribute__((ext_vector_type(2)));
typedef unsigned u32x4 __attribute__((ext_vector_type(4)));
typedef unsigned u32x2 __attribute__((ext_vector_type(2)));

#define DEVI __device__ __forceinline__
DEVI int opq(int x) { asm volatile("" : "+v"(x)); return x; }

#define VHALF ((int)__builtin_amdgcn_readfirstlane((int)(threadIdx.x >> 8)))
#define VB ((int)blockIdx.x * 2 + VHALF)
#define VG ((int)gridDim.x * 2)
constexpr int NL = 4;
constexpr int MTOK = 17408, MP = 16384, MS = 1024;
constexpr int DM = 1024, NIN = 7696, NPJ = 7680, DFF = 4096, PLE = 256;
constexpr int C_Z = 3072, C_SQ = 4096, C_SK = 5120, C_SV = 5376, C_G = 5632;
constexpr float EPS = 1e-6f;
constexpr int NTHR = 256;
constexpr int SMEM_BYTES = 79872;
constexpr size_t SCR_ITEM = 73728;

constexpr size_t O_YP = 0, O_YS = 16777216, O_CONVP = 17825792, O_GDNP = 18120704, O_KP = 22315008, O_VP = 23363584,
                 O_CONVS = 24412160, O_GDNS = 29130752, O_KS = 96239616, O_VS = 113016832, O_END = 129794048;

constexpr size_t al256(size_t x) { return (x + 255) & ~(size_t)255; }
constexpr size_t WO_wt_in = 0;
constexpr size_t WO_wt_out = WO_wt_in + al256((size_t)NL * NIN * DM * 2);
constexpr size_t WO_wt_up = WO_wt_out + al256((size_t)NL * DM * DM * 2);
constexpr size_t WO_wt_down = WO_wt_up + al256((size_t)NL * DFF * DM * 2);
constexpr size_t WO_wt_gate = WO_wt_down + al256((size_t)NL * DM * DFF * 2);
constexpr size_t WO_wt_proj = WO_wt_gate + al256((size_t)NL * DM * DM * 2);
constexpr size_t WO_hb = WO_wt_proj + al256((size_t)NL * DM * PLE * 2);
constexpr size_t WO_hb2 = WO_hb + al256((size_t)MTOK * DM * 2);
constexpr size_t WO_proj = WO_hb2 + al256((size_t)MTOK * DM * 2);
constexpr size_t WO_scr = WO_proj + al256((size_t)MTOK * NPJ * 2);
constexpr size_t WO_ogdn = WO_scr + al256((size_t)2048 * SCR_ITEM);
constexpr size_t WO_oswa = WO_ogdn + al256((size_t)MTOK * DM * 2);
constexpr size_t WO_mix = WO_oswa + al256((size_t)MTOK * DM * 2);
constexpr size_t WO_pb = WO_mix + al256((size_t)MTOK * DM * 2);
constexpr size_t WO_pp = WO_pb + al256((size_t)NL * MTOK * PLE * 2);
constexpr size_t WO_ssq0 = WO_pp + al256((size_t)NL * MTOK * DM * 2);
constexpr size_t WO_ssq1 = WO_ssq0 + al256((size_t)MTOK * 16 * 4);
constexpr size_t WO_ssq2 = WO_ssq1 + al256((size_t)MTOK * 16 * 4);
constexpr size_t WO_logits = WO_ssq2 + al256((size_t)MTOK * 16 * 4);
constexpr size_t WO_gsc = WO_logits + al256((size_t)MTOK * 16 * 4);
constexpr size_t WO_bar = WO_gsc + al256((size_t)2048 * 4);
constexpr size_t WS_TOTAL = WO_bar + al256((size_t)3456 * 4);
struct Params {
  const float *x_prompt, *x_sample, *cache_conv, *state_gdn, *cache_k, *cache_v, *p_prompt, *p_sample;
  const float *norm_mix, *w_in, *conv_w, *a_log, *dt_bias, *gdn_norm, *q_norm, *k_norm, *sinks, *w_out, *norm_ffn, *w_up, *w_down,
      *norm_ple, *w_gate, *w_proj;
  float* out;
  unsigned char* ws;
  DEVI bf16_t* wt_in() const { return (bf16_t*)(ws + WO_wt_in); }
  DEVI bf16_t* wt_out() const { return (bf16_t*)(ws + WO_wt_out); }
  DEVI bf16_t* wt_up() const { return (bf16_t*)(ws + WO_wt_up); }
  DEVI bf16_t* wt_down() const { return (bf16_t*)(ws + WO_wt_down); }
  DEVI bf16_t* wt_gate() const { return (bf16_t*)(ws + WO_wt_gate); }
  DEVI bf16_t* wt_proj() const { return (bf16_t*)(ws + WO_wt_proj); }
  DEVI bf16_t* hb() const { return (bf16_t*)(ws + WO_hb); }
  DEVI bf16_t* hb2() const { return (bf16_t*)(ws + WO_hb2); }
  DEVI bf16_t* proj() const { return (bf16_t*)(ws + WO_proj); }
  DEVI bf16_t* scr() const { return (bf16_t*)(ws + WO_scr); }
  DEVI bf16_t* ogdn() const { return (bf16_t*)(ws + WO_ogdn); }
  DEVI bf16_t* oswa() const { return (bf16_t*)(ws + WO_oswa); }
  DEVI bf16_t* mix() const { return (bf16_t*)(ws + WO_mix); }
  DEVI bf16_t* pb() const { return (bf16_t*)(ws + WO_pb); }
  DEVI bf16_t* pp() const { return (bf16_t*)(ws + WO_pp); }
  DEVI float* ssq0() const { return (float*)(ws + WO_ssq0); }
  DEVI float* ssq1() const { return (float*)(ws + WO_ssq1); }
  DEVI float* ssq2() const { return (float*)(ws + WO_ssq2); }
  DEVI float* logits() const { return (float*)(ws + WO_logits); }
  DEVI float* gsc() const { return (float*)(ws + WO_gsc); }
  DEVI unsigned* bar() const { return (unsigned*)(ws + WO_bar); }
};

DEVI float shx(float v, int m, int ln) { return __builtin_bit_cast(float, __builtin_amdgcn_ds_bpermute((ln ^ m) << 2, __builtin_bit_cast(int, v))); }
DEVI float shup(float v, int o, int ln) { return __builtin_bit_cast(float, __builtin_amdgcn_ds_bpermute((ln >= o ? ln - o : ln) << 2, __builtin_bit_cast(int, v))); }
DEVI float lo2f(unsigned u) { return __uint_as_float(u << 16); }
DEVI float hi2f(unsigned u) { return __uint_as_float(u & 0xffff0000u); }
DEVI float bf2f(bf16_t v) { return __uint_as_float(((unsigned)v) << 16); }
typedef __bf16 bf16x2_t __attribute__((ext_vector_type(2)));
DEVI unsigned pk2(float lo, float hi) { const f32x2 v = {lo, hi}; const bf16x2_t r = __builtin_convertvector(v, bf16x2_t); return __builtin_bit_cast(unsigned, r); }
DEVI bf16_t f2bf(float f) { return (bf16_t)(pk2(f, 0.f) & 0xffffu); }
DEVI float sigm(float x) { return 1.f / (1.f + __expf(-x)); }
DEVI float silu(float x) { return x * sigm(x); }
DEVI float softplus_f(float x) {
  const float e = __expf(x);
  return x > 20.f ? x : (e < 0.01f ? e * (1.f - 0.5f * e + 0.33333334f * e * e) : __logf(1.f + e));
}
DEVI f32x4 mfma16(bf16x8 a, bf16x8 b, f32x4 c) { return __builtin_amdgcn_mfma_f32_16x16x32_bf16(a, b, c, 0, 0, 0); }
DEVI bf16x8 as_bf(u32x4 v) { return __builtin_bit_cast(bf16x8, v); }
#define UNPACK8(v, f) do { f[0] = lo2f(v.x); f[1] = hi2f(v.x); f[2] = lo2f(v.y); f[3] = hi2f(v.y); f[4] = lo2f(v.z); f[5] = hi2f(v.z); f[6] = lo2f(v.w); f[7] = hi2f(v.w); } while (0)

DEVI int inmap(int n) { return n < 4096 ? n : (n < 7680 ? n + 16 : n - 7680 + 4096); }

__device__ void wconv_tile(const float* __restrict__ src, int ldsrc, int K, int Nd, bf16_t* __restrict__ dst, const float* __restrict__ scale,
                           bool remap, int kt, int nt, float* sm) {
  const int tid = (opq(threadIdx.x) & 255);
  const int nl = tid & 63, kq = tid >> 6;
  const int n = nt * 64 + nl;
  const bool ok = n < Nd;
  const int sc = remap ? inmap(n) : n;
#pragma unroll 4
  for (int r = 0; r < 16; ++r) {
    const int kl = r * 4 + kq, k = kt * 64 + kl;
    float v = 0.f;
    if (ok) { v = src[(size_t)k * ldsrc + sc]; if (scale) v *= scale[k]; }
    sm[kl * 65 + nl] = v;
  }
  __syncthreads();
  const int nr = tid >> 2, ks = (tid & 3) * 16;
  if (nt * 64 + nr < Nd) {
    unsigned w[8];
#pragma unroll
    for (int i = 0; i < 8; ++i) w[i] = pk2(sm[(ks + 2 * i) * 65 + nr], sm[(ks + 2 * i + 1) * 65 + nr]);
    u32x4* d = (u32x4*)(dst + (size_t)(nt * 64 + nr) * K + kt * 64 + ks);
    d[0] = (u32x4){w[0], w[1], w[2], w[3]};
    d[1] = (u32x4){w[4], w[5], w[6], w[7]};
  }
  __syncthreads();
}

__device__ void phase_p0(const Params& p, unsigned char* smem) {
  float* sm = (float*)smem;
  const int tid = (opq(threadIdx.x) & 255), lane = tid & 63, wid = tid >> 6;
  constexpr int T_IN = 16 * 121, T_OUT = 256, T_UP = 1024, T_DOWN = 1024, T_GATE = 256, T_PROJ = 64;
  constexpr int T_L = T_IN + T_OUT + T_UP + T_DOWN + T_GATE + T_PROJ;
  for (int it = VB; it < NL * T_L; it += VG) {
    const int l = it / T_L;
    int r = it % T_L;
    if (r < T_IN) { wconv_tile(p.w_in + (size_t)l * DM * NIN, NIN, DM, NIN, p.wt_in() + (size_t)l * NIN * DM, p.norm_mix + l * DM, true, r % 16, r / 16, sm); continue; }
    r -= T_IN;
    if (r < T_OUT) { wconv_tile(p.w_out + (size_t)l * DM * DM, DM, DM, DM, p.wt_out() + (size_t)l * DM * DM, nullptr, false, r % 16, r / 16, sm); continue; }
    r -= T_OUT;
    if (r < T_UP) { wconv_tile(p.w_up + (size_t)l * DM * DFF, DFF, DM, DFF, p.wt_up() + (size_t)l * DFF * DM, p.norm_ffn + l * DM, false, r % 16, r / 16, sm); continue; }
    r -= T_UP;
    if (r < T_DOWN) { wconv_tile(p.w_down + (size_t)l * DFF * DM, DM, DFF, DM, p.wt_down() + (size_t)l * DM * DFF, nullptr, false, r % 64, r / 64, sm); continue; }
    r -= T_DOWN;
    if (r < T_GATE) { wconv_tile(p.w_gate + (size_t)l * DM * DM, DM, DM, DM, p.wt_gate() + (size_t)l * DM * DM, p.norm_ple + l * DM, false, r % 16, r / 16, sm); continue; }
    r -= T_GATE;
    wconv_tile(p.w_proj + (size_t)l * PLE * DM, DM, PLE, DM, p.wt_proj() + (size_t)l * DM * PLE, nullptr, false, r % 4, r / 4, sm);
  }
  for (int it = VB; it < MTOK / 4; it += VG) {
    const int row = it * 4 + wid;
    const float* src = row < MP ? p.x_prompt + (size_t)row * DM : p.x_sample + (size_t)(row - MP) * DM;
    float* hd = p.out + (size_t)row * DM;
    bf16_t* hbd = p.hb() + (size_t)row * DM;
    float ss = 0.f;
#pragma unroll
    for (int i = 0; i < 4; ++i) {
      const int c = i * 256 + lane * 4;
      const f32x4 v = *(const f32x4*)(src + c);
      ss += v.x * v.x + v.y * v.y + v.z * v.z + v.w * v.w;
      *(f32x4*)(hd + c) = v;
      *(u32x2*)(hbd + c) = (u32x2){pk2(v.x, v.y), pk2(v.z, v.w)};
    }
#pragma unroll
    for (int o = 1; o < 64; o <<= 1) ss += shx(ss, o, lane);
    if (lane < 16) p.ssq0()[(size_t)row * 16 + lane] = lane == 0 ? ss : 0.f;
  }
  const int G = NL * MTOK * 32;
  for (int g = VB * NTHR + tid; g < G; g += VG * NTHR) {
    const int l = g / (MTOK * 32), rem = g % (MTOK * 32), row = rem >> 5, c8 = rem & 31;
    const float* src = row < MP ? p.p_prompt + ((size_t)(l * MP + row) * PLE + c8 * 8) : p.p_sample + ((size_t)(l * MS + row - MP) * PLE + c8 * 8);
    const f32x4 a = *(const f32x4*)src, b = *(const f32x4*)(src + 4);
    *(u32x4*)(p.pb() + (size_t)g * 8) = (u32x4){pk2(a.x, a.y), pk2(a.z, a.w), pk2(b.x, b.y), pk2(b.z, b.w)};
  }
}

enum { EPI_PROJ = 0, EPI_LOGIT = 1, EPI_RESID = 2, EPI_UP = 3, EPI_PLE = 4, EPI_PP = 5 };
struct EpiArgs {
  const float* ssq_in; float* ssq_out; float* h; bf16_t* hb; bf16_t* obf; int ldo; float* of32; const bf16_t* pp;
};

template <int EPI>
DEVI float epi_rs(const EpiArgs& e, int row) {
  if (EPI == EPI_PROJ || EPI == EPI_LOGIT || EPI == EPI_UP || EPI == EPI_PLE) {
    const f32x4* sp = (const f32x4*)(e.ssq_in + (size_t)row * 16);
    const f32x4 a = sp[0], b = sp[1], c = sp[2], d = sp[3];
    const float s = ((a.x + a.y) + (a.z + a.w)) + ((b.x + b.y) + (b.z + b.w)) + ((c.x + c.y) + (c.z + c.w)) + ((d.x + d.y) + (d.z + d.w));
    return rsqrtf(s * (1.f / 1024.f) + EPS);
  }
  return 1.f;
}
template <int EPI>
DEVI void epi_elem(const EpiArgs& e, int row, int col, f32x4 v, float rs, float& sq) {
  if (EPI == EPI_PROJ) {
    v *= rs;
    *(u32x2*)(e.obf + (size_t)row * e.ldo + col) = (u32x2){pk2(v.x, v.y), pk2(v.z, v.w)};
  } else if (EPI == EPI_LOGIT) {
    v *= rs;
    *(f32x4*)(e.of32 + (size_t)row * 16 + col) = v;
  } else if (EPI == EPI_PP) {
    *(u32x2*)(e.obf + (size_t)row * e.ldo + (col & 1023)) = (u32x2){pk2(v.x, v.y), pk2(v.z, v.w)};
  } else if (EPI == EPI_UP) {
    v *= rs;
    v.x = fmaxf(v.x, 0.f); v.y = fmaxf(v.y, 0.f); v.z = fmaxf(v.z, 0.f); v.w = fmaxf(v.w, 0.f);
    v = v * v;
    *(u32x2*)(e.obf + (size_t)row * e.ldo + col) = (u32x2){pk2(v.x, v.y), pk2(v.z, v.w)};
  } else {
    float* hp = e.h + (size_t)row * DM + col;
    f32x4 hv = *(const f32x4*)hp;
    if (EPI == EPI_RESID) {
      hv += v;
    } else {
      const u32x2 pv = *(const u32x2*)(e.pp + (size_t)row * DM + col);
      hv.x += sigm(v.x * rs) * lo2f(pv.x); hv.y += sigm(v.y * rs) * hi2f(pv.x);
      hv.z += sigm(v.z * rs) * lo2f(pv.y); hv.w += sigm(v.w * rs) * hi2f(pv.y);
    }
    *(f32x4*)hp = hv;
    *(u32x2*)(e.hb + (size_t)row * DM + col) = (u32x2){pk2(hv.x, hv.y), pk2(hv.z, hv.w)};
    sq += hv.x * hv.x + hv.y * hv.y + hv.z * hv.z + hv.w * hv.w;
  }
}

template <int EPI>
DEVI void epi_elem8(const EpiArgs& e, int row, int col, f32x4 v0, f32x4 v1, float rs, float& sq) {
  if (EPI == EPI_PROJ || EPI == EPI_UP || EPI == EPI_PP) {
    if (EPI != EPI_PP) { v0 *= rs; v1 *= rs; }
    if (EPI == EPI_UP) {
      v0.x = fmaxf(v0.x, 0.f); v0.y = fmaxf(v0.y, 0.f); v0.z = fmaxf(v0.z, 0.f); v0.w = fmaxf(v0.w, 0.f);
      v1.x = fmaxf(v1.x, 0.f); v1.y = fmaxf(v1.y, 0.f); v1.z = fmaxf(v1.z, 0.f); v1.w = fmaxf(v1.w, 0.f);
      v0 = v0 * v0; v1 = v1 * v1;
    }
    const int c = EPI == EPI_PP ? (col & 1023) : col;
    *(u32x4*)(e.obf + (size_t)row * e.ldo + c) = (u32x4){pk2(v0.x, v0.y), pk2(v0.z, v0.w), pk2(v1.x, v1.y), pk2(v1.z, v1.w)};
  } else {
    float* hp = e.h + (size_t)row * DM + col;
    f32x4 h0 = *(const f32x4*)hp, h1 = *(const f32x4*)(hp + 4);
    if (EPI == EPI_RESID) {
      h0 += v0; h1 += v1;
    } else {
      const u32x4 pv = *(const u32x4*)(e.pp + (size_t)row * DM + col);
      h0.x += sigm(v0.x * rs) * lo2f(pv.x); h0.y += sigm(v0.y * rs) * hi2f(pv.x);
      h0.z += sigm(v0.z * rs) * lo2f(pv.y); h0.w += sigm(v0.w * rs) * hi2f(pv.y);
      h1.x += sigm(v1.x * rs) * lo2f(pv.z); h1.y += sigm(v1.y * rs) * hi2f(pv.z);
      h1.z += sigm(v1.z * rs) * lo2f(pv.w); h1.w += sigm(v1.w * rs) * hi2f(pv.w);
    }
    *(f32x4*)hp = h0;
    *(f32x4*)(hp + 4) = h1;
    *(u32x4*)(e.hb + (size_t)row * DM + col) = (u32x4){pk2(h0.x, h0.y), pk2(h0.z, h0.w), pk2(h1.x, h1.y), pk2(h1.z, h1.w)};
    sq += (h0.x * h0.x + h0.y * h0.y + h0.z * h0.z + h0.w * h0.w) + (h1.x * h1.x + h1.y * h1.y + h1.z * h1.z + h1.w * h1.w);
  }
}

template <int WMT, int WNT, int WGM, int WGN, int EPI, int BK = 32, bool KSPLIT = false>
__device__ __forceinline__ void gemm_tile(const bf16_t* __restrict__ A, int lda, const bf16_t* __restrict__ Bt, int ldb, int K, int m0, int n0,
                                          bf16_t* lds, const EpiArgs& e) {
  constexpr int BM = WGM * WMT * 16, BN = WGN * WNT * 16, LDR = BK + 8;
  constexpr int STAGE = (BM + BN) * LDR;
  constexpr int PPR = BK / 8, RPI = NTHR / PPR;
  constexpr int NA = BM / RPI, NB = (BN + RPI - 1) / RPI;
  const int tid = (opq(threadIdx.x) & 255), lane = tid & 63, wid = tid >> 6;
  const int wm = wid / WGN, wn = wid % WGN;
  const int fr = lane & 15, fq = lane >> 4;
  f32x4 acc[WMT][WNT];
#pragma unroll
  for (int i = 0; i < WMT; ++i)
#pragma unroll
    for (int j = 0; j < WNT; ++j) acc[i][j] = (f32x4){0.f, 0.f, 0.f, 0.f};
  u32x4 ra0[NA], rb0[NB], ra1[NA], rb1[NB];
  const int khalf = KSPLIT ? VHALF : 0;
  const int nk = (KSPLIT ? K / 2 : K) / BK;
  const int prow = tid / PPR, ppc = tid % PPR;
  const unsigned ta = (unsigned)(prow * lda + ppc * 8) * 2u, tb = (unsigned)(prow * ldb + ppc * 8) * 2u;
  const char* Au = (const char*)(A + (size_t)m0 * lda + (size_t)khalf * (K / 2));
  const char* Bu = (const char*)(Bt + (size_t)n0 * ldb + (size_t)khalf * (K / 2));
#define BGUARD(i) (BN >= RPI * ((i) + 1) || prow + (i) * RPI < BN)
#define GLOAD(kt, RA, RB) do { \
    _Pragma("unroll") for (int i = 0; i < NA; ++i) RA[i] = *(const u32x4*)(Au + ((size_t)i * RPI * lda + (size_t)(kt) * BK) * 2 + ta); \
    _Pragma("unroll") for (int i = 0; i < NB; ++i) if (BGUARD(i)) RB[i] = *(const u32x4*)(Bu + ((size_t)i * RPI * ldb + (size_t)(kt) * BK) * 2 + tb); \
  } while (0)
#define LSTORE(st, RA, RB) do { bf16_t* sA_ = lds + (st) * STAGE; bf16_t* sB_ = sA_ + BM * LDR; \
    _Pragma("unroll") for (int i = 0; i < NA; ++i) *(u32x4*)(sA_ + (prow + i * RPI) * LDR + ppc * 8) = RA[i]; \
    _Pragma("unroll") for (int i = 0; i < NB; ++i) if (BGUARD(i)) *(u32x4*)(sB_ + (prow + i * RPI) * LDR + ppc * 8) = RB[i]; \
  } while (0)
#define COMPUTE(st) do { const bf16_t* sA = lds + (st) * STAGE; const bf16_t* sB = sA + BM * LDR; \
    _Pragma("unroll") for (int kk = 0; kk < BK / 32; ++kk) { \
      bf16x8 bfr[WNT]; \
      _Pragma("unroll") for (int nt = 0; nt < WNT; ++nt) bfr[nt] = *(const bf16x8*)(sB + (wn * WNT * 16 + nt * 16 + fr) * LDR + kk * 32 + fq * 8); \
      _Pragma("unroll") for (int mt = 0; mt < WMT; ++mt) { \
        const bf16x8 af = *(const bf16x8*)(sA + (wm * WMT * 16 + mt * 16 + fr) * LDR + kk * 32 + fq * 8); \
        _Pragma("unroll") for (int nt = 0; nt < WNT; ++nt) acc[mt][nt] = mfma16(bfr[nt], af, acc[mt][nt]); } } \
  } while (0)
  GLOAD(0, ra0, rb0);
  GLOAD(1, ra1, rb1);
  LSTORE(0, ra0, rb0);
  __syncthreads();
  for (int kt = 0; kt < nk; kt += 2) {
    const int k2 = kt + 2 < nk ? kt + 2 : nk - 2;
    GLOAD(k2, ra0, rb0);
    COMPUTE(0);
    LSTORE(1, ra1, rb1);
    __syncthreads();
    GLOAD(k2 + 1, ra1, rb1);
    COMPUTE(1);
    LSTORE(0, ra0, rb0);
    __syncthreads();
  }
#undef BGUARD
#undef COMPUTE
#undef GLOAD
#undef LSTORE
  if (KSPLIT) {
    f32x4* red = (f32x4*)((unsigned char*)lds + (khalf ? 0 : SMEM_BYTES));
    if (khalf == 1) {
#pragma unroll
      for (int i = 0; i < WMT; ++i)
#pragma unroll
        for (int j = 0; j < WNT; ++j) red[((wid * WMT + i) * WNT + j) * 64 + lane] = acc[i][j];
    }
    __syncthreads();
    if (khalf == 0) {
#pragma unroll
      for (int i = 0; i < WMT; ++i)
#pragma unroll
        for (int j = 0; j < WNT; ++j) acc[i][j] += red[((wid * WMT + i) * WNT + j) * 64 + lane];
    }
  }
  if (!KSPLIT || khalf == 0) {
#pragma unroll
  for (int mt = 0; mt < WMT; ++mt) {
    const int row = m0 + wm * WMT * 16 + mt * 16 + fr;
    const float rs = epi_rs<EPI>(e, row);
    float sq = 0.f;
#pragma unroll
    for (int nt = 0; nt < WNT; ++nt) epi_elem<EPI>(e, row, n0 + wn * WNT * 16 + nt * 16 + fq * 4, acc[mt][nt], rs, sq);
    if (EPI == EPI_RESID || EPI == EPI_PLE) {
      sq += shx(sq, 16, lane);
      sq += shx(sq, 32, lane);
      if (fq == 0) e.ssq_out[(size_t)row * 16 + (n0 / BN) * WGN + wn] = sq;
    }
  }
  }
  if (KSPLIT) __syncthreads();
}

namespace pg8 {
#define PG8_LAS __attribute__((address_space(3)))
typedef unsigned short bf16_t;
typedef short bf16x8 __attribute__((ext_vector_type(8)));
typedef float f32x4 __attribute__((ext_vector_type(4)));
typedef unsigned u32x4 __attribute__((ext_vector_type(4)));
constexpr int BM = 256, BK = 64, HALF = 128, HTB = HALF * BK * 2  , STAGE_BYTES = 8 * HTB, NXCD = 8, WGM = 8;

__host__ __device__ __forceinline__ int lds_byte(int r, int c) { const int st = (r >> 4) * 2 + (c >> 5), rr = r & 15, cc = c & 31, ob = rr * 64 + cc * 2; return st * 1024 + (ob ^ (((ob >> 9) & 1) << 5)); }
__host__ __device__ __forceinline__ void stage_rc(int b, int& R, int& C) { const int st = b / 1024, sb = b % 1024, swz = sb ^ (((sb >> 9) & 1) << 5); R = (st >> 1) * 16 + swz / 64; C = (st & 1) * 32 + (swz % 64) / 2; }
__host__ __device__ __forceinline__ int perm32(int rho) { const int n = rho >> 4, i = rho & 15; return 8 * (i >> 2) + 4 * n + (i & 3); }

struct Unit { int pm, pn; };
struct Gemm { const bf16_t* A; const bf16_t* Bt; int M, N, K; };

template <class Epi, class Sched, bool STAMP = false>
__device__ __forceinline__ void gemm_phase(PG8_LAS unsigned char* lds, const Gemm g, const Sched& S, const Epi& E, unsigned long long* stamps) {
    const int tid = opq((int)threadIdx.x), wid = __builtin_amdgcn_readfirstlane(tid >> 6), lane = tid & 63, wr = wid >> 2, wc = wid & 3, fr = lane & 15, fq = lane >> 4;
    const int K = g.K, nt = K / BK;
    int ts_lo = 0, ts_hi = 0, nts = 0; const unsigned long long rt_entry = STAMP ? (unsigned long long)wall_clock64() : 0ull;
#define PG8_STAMP() do { if (STAMP && wid == 0 && nts < 64) { const unsigned long long _c = (unsigned long long)clock64(); \
        ts_lo = (lane == nts) ? (int)(unsigned)_c : ts_lo; ts_hi = (lane == nts) ? (int)(unsigned)(_c >> 32) : ts_hi; ++nts; } } while (0)
    PG8_STAMP();
    unsigned voffA[2], voffB[2];
#pragma unroll
    for (int i = 0; i < 2; ++i) { int R, C; stage_rc(tid * 16 + i * 8192, R, C); const int Rb = Epi::PERM ? ((R & ~31) + perm32(R & 31)) : R;
        voffA[i] = (unsigned)(R * K + C) * 2u; voffB[i] = (unsigned)(Rb * K + C) * 2u; }
    const size_t kstep = (size_t)(BK * 2);
    const size_t hstep = (size_t)HALF * K * 2;
    const size_t tstep = 2 * hstep;
    const unsigned ldsw = (unsigned)wid * 1024u;
    const int aoff = lds_byte(wr * 64 + fr, fq * 8), boff = lds_byte(wc * 32 + fr, fq * 8);
#define PG8_SA(b, h) (((b) * 2 + (h)) * HTB)
#define PG8_SB(b, h) ((4 + (b) * 2 + (h)) * HTB)
#define PG8_STAGE(bufoff, gbase, voff) do { _Pragma("unroll") for (int _i = 0; _i < 2; ++_i) \
        __builtin_amdgcn_global_load_lds((const unsigned*)((const char*)(gbase) + (voff)[_i]), (PG8_LAS unsigned*)(lds + (bufoff) + ldsw + _i * 8192), 16, 0, 0); } while (0)
#define PG8_LDA(dst, b, h) do { _Pragma("unroll") for (int m = 0; m < 4; ++m) _Pragma("unroll") for (int k = 0; k < 2; ++k) dst[m][k] = *(const PG8_LAS bf16x8*)(lds + PG8_SA(b, h) + aoff + m * 2048 + k * 1024); } while (0)
#define PG8_LDB(dst, b, h) do { _Pragma("unroll") for (int n = 0; n < 2; ++n) _Pragma("unroll") for (int k = 0; k < 2; ++k) dst[n][k] = *(const PG8_LAS bf16x8*)(lds + PG8_SB(b, h) + boff + n * 2048 + k * 1024); } while (0)
#define PG8_MMA(ai, bj, At, Bt) do { __builtin_amdgcn_s_setprio(1); _Pragma("unroll") for (int m = 0; m < 4; ++m) _Pragma("unroll") for (int n = 0; n < 2; ++n) _Pragma("unroll") for (int k = 0; k < 2; ++k) \
        acc[ai][bj][m][n] = __builtin_amdgcn_mfma_f32_16x16x32_bf16(Bt[n][k], At[m][k], acc[ai][bj][m][n], 0, 0, 0); __builtin_amdgcn_s_setprio(0); } while (0)
#define PG8_WAIT_V(n) asm volatile("s_waitcnt vmcnt(" #n ")" ::: "memory")
#define PG8_WAIT_L(n) asm volatile("s_waitcnt lgkmcnt(" #n ")" ::: "memory")
#define PG8_BAR __builtin_amdgcn_s_barrier()
#define PG8_SCHED __builtin_amdgcn_sched_barrier(0)
    Unit cur, nxt; int ui = 0;
    if (!S.next(0, cur)) return;
    f32x4 acc[2][2][4][2];
#pragma unroll
    for (int a = 0; a < 2; ++a)
#pragma unroll
        for (int b = 0; b < 2; ++b)
#pragma unroll
            for (int m = 0; m < 4; ++m)
#pragma unroll
                for (int n = 0; n < 2; ++n) acc[a][b][m][n] = (f32x4){0.f, 0.f, 0.f, 0.f};
    bf16x8 At[4][2], B0[2][2], B1[2][2];
    const char* cA = (const char*)g.A + (size_t)cur.pm * tstep; const char* cB = (const char*)g.Bt + (size_t)cur.pn * tstep;
    S.a_ready(cur);
    PG8_STAGE(PG8_SB(0, 0), cB, voffB); PG8_STAGE(PG8_SA(0, 0), cA, voffA); PG8_STAGE(PG8_SB(0, 1), cB + hstep, voffB); PG8_STAGE(PG8_SA(0, 1), cA + hstep, voffA);
    if (wr == 1) PG8_BAR;
    PG8_WAIT_V(4); PG8_BAR;
    PG8_STAGE(PG8_SB(1, 0), cB + kstep, voffB); PG8_STAGE(PG8_SA(1, 0), cA + kstep, voffA); PG8_STAGE(PG8_SB(1, 1), cB + hstep + kstep, voffB);
    PG8_WAIT_V(6); PG8_BAR;
    PG8_STAMP();
    for (;;) {
        const bool has_next = S.next(ui + 1, nxt);
        const char* nA = has_next ? (const char*)g.A + (size_t)nxt.pm * tstep : cA; const char* nB = has_next ? (const char*)g.Bt + (size_t)nxt.pn * tstep : cB;
        for (int t = 0; t < nt; t += 2) {
            const bool last = (t == nt - 2);
            const char* a1 = cA + (size_t)(t + 1) * kstep;
            const char* a2 = last ? nA : cA + (size_t)(t + 2) * kstep; const char* b2 = last ? nB : cB + (size_t)(t + 2) * kstep;
            const char* a3 = a2 + kstep; const char* b3 = b2 + kstep;
            if (last && has_next) S.a_ready(nxt);
            PG8_LDB(B0, 0, 0); PG8_SCHED; PG8_LDA(At, 0, 0); PG8_STAGE(PG8_SA(1, 1), a1 + hstep, voffA);
            PG8_WAIT_L(8); PG8_BAR; PG8_WAIT_L(0); PG8_MMA(0, 0, At, B0); PG8_BAR; PG8_SCHED;
            PG8_LDB(B1, 0, 1); PG8_STAGE(PG8_SB(0, 0), b2, voffB);
            PG8_BAR; PG8_WAIT_L(0); PG8_MMA(0, 1, At, B1); PG8_BAR;
            PG8_LDA(At, 0, 1); PG8_STAGE(PG8_SA(0, 0), a2, voffA);
            PG8_BAR; PG8_WAIT_L(0); PG8_MMA(1, 0, At, B0); PG8_BAR; PG8_SCHED;
            PG8_STAGE(PG8_SB(0, 1), b2 + hstep, voffB);
            PG8_WAIT_V(6); PG8_BAR; PG8_MMA(1, 1, At, B1); PG8_BAR;
            PG8_LDB(B0, 1, 0); PG8_SCHED; PG8_LDA(At, 1, 0); PG8_STAGE(PG8_SA(0, 1), a2 + hstep, voffA);
            PG8_WAIT_L(8); PG8_BAR; PG8_WAIT_L(0); PG8_MMA(0, 0, At, B0); PG8_BAR; PG8_SCHED;
            PG8_LDB(B1, 1, 1); PG8_STAGE(PG8_SB(1, 0), b3, voffB);
            PG8_BAR; PG8_WAIT_L(0); PG8_MMA(0, 1, At, B1); PG8_BAR;
            PG8_LDA(At, 1, 1); PG8_STAGE(PG8_SA(1, 0), a3, voffA);
            PG8_BAR; PG8_WAIT_L(0); PG8_MMA(1, 0, At, B0); PG8_BAR; PG8_SCHED;
            PG8_STAGE(PG8_SB(1, 1), b3 + hstep, voffB);
            PG8_WAIT_V(6); PG8_BAR; PG8_MMA(1, 1, At, B1); PG8_BAR;
        }
        PG8_STAMP();
        if constexpr (!Epi::AFTER_DRAIN) { E(acc, cur, wr, wc, fr, fq); S.done(cur); }
        PG8_STAMP();
        if (!has_next) break;
#pragma unroll
        for (int a = 0; a < 2; ++a)
#pragma unroll
            for (int b = 0; b < 2; ++b)
#pragma unroll
                for (int m = 0; m < 4; ++m)
#pragma unroll
                    for (int n = 0; n < 2; ++n) acc[a][b][m][n] = (f32x4){0.f, 0.f, 0.f, 0.f};
        cur = nxt; cA = nA; cB = nB; ++ui;
    }
    PG8_WAIT_V(0);
    if (wr == 0) PG8_BAR;
    PG8_BAR;
    if constexpr (Epi::AFTER_DRAIN) { E.fused(acc, cur, wr, wc, fr, fq, lds, wid, lane); S.done(cur); }
    PG8_STAMP();
    if (STAMP && wid == 0) { stamps[lane] = lane < nts ? (((unsigned long long)(unsigned)ts_hi << 32) | (unsigned)ts_lo) : 0ull;
        if (lane == 62) stamps[62] = rt_entry; if (lane == 63) stamps[63] = (unsigned long long)wall_clock64(); }
#undef PG8_STAMP
#undef PG8_SA
#undef PG8_SB
#undef PG8_STAGE
#undef PG8_LDA
#undef PG8_LDB
#undef PG8_MMA
#undef PG8_WAIT_V
#undef PG8_WAIT_L
#undef PG8_BAR
#undef PG8_SCHED
}
}

DEVI void unit_map(int L, int nM, int nN, int& pm, int& pn) {
  const int nwg = nM * nN, q = nwg / 8, r = nwg % 8, xcd = L % 8, off = L / 8;
  const int wgid = (xcd < r ? xcd * (q + 1) : r * (q + 1) + (xcd - r) * q) + off;
  const int nig = 8 * nN, gid = wgid / nig, fm = gid * 8, gsz = (nM - fm) < 8 ? (nM - fm) : 8, w = wgid - gid * nig;
  pm = fm + (w % gsz); pn = w / gsz;
}
struct RowSched {
  int nM, nN, nLimit, G, c;
  __device__ __forceinline__ bool next(int i, pg8::Unit& u) const { const int L = i * G + c; if (L >= nLimit) return false; unit_map(L, nM, nN, u.pm, u.pn); return true; }
  __device__ __forceinline__ void a_ready(const pg8::Unit&) const {}
  __device__ __forceinline__ void done(const pg8::Unit&) const {}
};
struct DiagSched {
  int nLimit, G, c;
  __device__ __forceinline__ bool next(int i, pg8::Unit& u) const { const int L = i * G + c; if (L >= nLimit) return false; const int l = L / 272, r = L - l * 272; u.pm = l * 68 + (r >> 2); u.pn = l * 4 + (r & 3); return true; }
  __device__ __forceinline__ void a_ready(const pg8::Unit&) const {}
  __device__ __forceinline__ void done(const pg8::Unit&) const {}
};
template <int EPI> struct BigEpi {
  static constexpr bool PERM = true, AFTER_DRAIN = false;
  EpiArgs e;
  __device__ __forceinline__ void operator()(const f32x4 (&acc)[2][2][4][2], const pg8::Unit& u, int wr, int wc, int fr, int fq) const {
    const int lane = fq * 16 + fr;
#pragma unroll
    for (int ai = 0; ai < 2; ++ai)
#pragma unroll
      for (int m = 0; m < 4; ++m) {
        const int row = u.pm * 256 + ai * 128 + wr * 64 + m * 16 + fr;
        const float rs = epi_rs<EPI>(e, row);
        float sq = 0.f;
#pragma unroll
        for (int bj = 0; bj < 2; ++bj) epi_elem8<EPI>(e, row, u.pn * 256 + bj * 128 + wc * 32 + fq * 8, acc[ai][bj][m][0], acc[ai][bj][m][1], rs, sq);
        if (EPI == EPI_RESID || EPI == EPI_PLE) {
          sq += shx(sq, 16, lane);
          sq += shx(sq, 32, lane);
          if (fq == 0) e.ssq_out[(size_t)row * 16 + u.pn * 4 + wc] = sq;
        }
      }
  }
};

template <int EPI>
__device__ void gemm_big_phase(const bf16_t* A, const bf16_t* Bt, int K, int M, int N, unsigned char* lds_all, unsigned char* smem_half, const EpiArgs& e) {
  const int nM = M / 256, nN = N / 256, nU = nM * nN, G = gridDim.x;
  const int L = nU % G;
  const int nLimit = (L > 0 && L <= G / 4) ? nU - L : nU;
  RowSched S; S.nM = nM; S.nN = nN; S.nLimit = nLimit; S.G = G; S.c = blockIdx.x;
  pg8::Gemm g; g.A = A; g.Bt = Bt; g.M = M; g.N = N; g.K = K;
  BigEpi<EPI> E; E.e = e;
  pg8::gemm_phase<BigEpi<EPI>, RowSched>((PG8_LAS unsigned char*)lds_all, g, S, E, nullptr);
  __syncthreads();
  const int nSmall = (nU - nLimit) * 16;
  if (nSmall <= G && K >= 512) {
    for (int st = blockIdx.x; st < nSmall; st += G) {
      const int sub = st & 15; int pm, pn; unit_map(nLimit + (st >> 4), nM, nN, pm, pn);
      gemm_tile<1, 4, 4, 1, EPI, 128, true>(A, K, Bt, K, K, pm * 256 + (sub >> 2) * 64, pn * 256 + (sub & 3) * 64, (bf16_t*)smem_half, e);
    }
  } else {
    for (int st = VB; st < nSmall; st += VG) {
      const int sub = st & 15; int pm, pn; unit_map(nLimit + (st >> 4), nM, nN, pm, pn);
      gemm_tile<1, 4, 4, 1, EPI, 128>(A, K, Bt, K, K, pm * 256 + (sub >> 2) * 64, pn * 256 + (sub & 3) * 64, (bf16_t*)smem_half, e);
    }
  }
}


template <int I, int J4>
DEVI void solve_sub4(float& r, const float (&x)[64], const float* Am) {
  if constexpr (J4 * 4 < I) {
    const f32x4 a = *(const f32x4*)(Am + I * 64 + J4 * 4);
    if constexpr (J4 * 4 + 0 < I) r -= a.x * x[J4 * 4 + 0];
    if constexpr (J4 * 4 + 1 < I) r -= a.y * x[J4 * 4 + 1];
    if constexpr (J4 * 4 + 2 < I) r -= a.z * x[J4 * 4 + 2];
    if constexpr (J4 * 4 + 3 < I) r -= a.w * x[J4 * 4 + 3];
    solve_sub4<I, J4 + 1>(r, x, Am);
  }
}
template <int I>
DEVI void solve_rows(float (&x)[64], const float* Am, const bf16_t* src, const float* sc) {
  if constexpr (I < 64) {
    float r = bf2f(src[I * 136]) * sc[I];
    solve_sub4<I, 0>(r, x, Am);
    x[I] = r;
    asm volatile("" ::: "memory");
    solve_rows<I + 1>(x, Am, src, sc);
  }
}

__device__ void gdn_prep_item(const Params& p, int l, int item, unsigned char* smem) {
  const int tid = (opq(threadIdx.x) & 255), lane = tid & 63, wid = tid >> 6, fr = lane & 15, fq = lane >> 4;
  const int h = item & 7, n = (item >> 3) & 31, b = item >> 8;
  const int tok0 = b * 2048 + n * 64;
  bf16_t* qh = (bf16_t*)smem;
  bf16_t* kh = qh + 64 * 136;
  bf16_t* vh = kh + 64 * 136;
  float* Am = (float*)(vh + 64 * 136);
  float* sbeta = Am + 64 * 64;
  float* sgc = sbeta + 64;
  float* sbe = sgc + 64;
  unsigned char* scr = (unsigned char*)p.scr() + (size_t)item * SCR_ITEM;
  bf16_t* g_uT = (bf16_t*)scr;
  bf16_t* g_w = (bf16_t*)(scr + 16384);
  bf16_t* g_qg = (bf16_t*)(scr + 32768);
  bf16_t* g_kgT = (bf16_t*)(scr + 49152);
  bf16_t* g_qk = (bf16_t*)(scr + 65536);

  if (wid == 0) {
    const float* lg = p.logits() + (size_t)(tok0 + lane) * 16;
    const float bl = lg[h], al = lg[8 + h];
    const float x = al + p.dt_bias[l * 8 + h];
    const float sp = softplus_f(x);
    float g = -__expf(p.a_log[l * 8 + h]) * sp;
#pragma unroll
    for (int o = 1; o < 64; o <<= 1) { const float t = shup(g, o, lane); if (lane >= o) g += t; }
    sbeta[lane] = sigm(bl);
    sgc[lane] = g;
    sbe[lane] = sigm(bl) * __expf(g);
  }
  u32x4 rwall[3][7];
#pragma unroll
  for (int sect = 0; sect < 3; ++sect)
#pragma unroll
    for (int r = 0; r < 7; ++r) {
      const int tl = n * 64 + wid * 16 + fq * 4 - 3 + r;
      rwall[sect][r] = (u32x4){0u, 0u, 0u, 0u};
      if (tl >= 0) rwall[sect][r] = *(const u32x4*)(p.proj() + (size_t)(b * 2048 + tl) * NPJ + sect * 1024 + h * 128 + fr * 8);
    }
#pragma unroll
  for (int sect = 0; sect < 3; ++sect) {
    const int ch0 = sect * 1024 + h * 128 + fr * 8;
    float cw[4][8];
#pragma unroll
    for (int j = 0; j < 4; ++j) {
      const f32x4 a = *(const f32x4*)(p.conv_w + (size_t)(l * 4 + j) * 3072 + ch0), c = *(const f32x4*)(p.conv_w + (size_t)(l * 4 + j) * 3072 + ch0 + 4);
      cw[j][0] = a.x; cw[j][1] = a.y; cw[j][2] = a.z; cw[j][3] = a.w; cw[j][4] = c.x; cw[j][5] = c.y; cw[j][6] = c.z; cw[j][7] = c.w;
    }
    const int ib = wid * 16 + fq * 4;
#pragma unroll
    for (int it = 0; it < 4; ++it) {
      float o[8];
#pragma unroll
      for (int c = 0; c < 8; ++c) o[c] = 0.f;
#pragma unroll
      for (int j = 0; j < 4; ++j) {
        float f[8];
        UNPACK8(rwall[sect][it + j], f);
#pragma unroll
        for (int c = 0; c < 8; ++c) o[c] += f[c] * cw[j][c];
      }
      float ss = 0.f;
#pragma unroll
      for (int c = 0; c < 8; ++c) { o[c] = silu(o[c]); ss += o[c] * o[c]; }
      if (sect < 2) {
        ss += shx(ss, 1, lane); ss += shx(ss, 2, lane); ss += shx(ss, 4, lane); ss += shx(ss, 8, lane);
        float rn = rsqrtf(ss + EPS);
        if (sect == 0) rn *= 0.08838834764831845f;
#pragma unroll
        for (int c = 0; c < 8; ++c) o[c] *= rn;
      }
      const u32x4 pk = (u32x4){pk2(o[0], o[1]), pk2(o[2], o[3]), pk2(o[4], o[5]), pk2(o[6], o[7])};
      bf16_t* dst = sect == 0 ? qh + (ib + it) * 136 + fr * 8 : (sect == 1 ? kh + (ib + it) * 136 + fr * 8 : vh + (ib + it) * 136 + fr * 8);
      *(u32x4*)dst = pk;
    }
  }
  __syncthreads();
  {
    const int i = wid * 16 + fr;
    const float gi = sgc[i], bi = sbeta[i];
    bf16x8 kx[4], qx[4];
#pragma unroll
    for (int ks = 0; ks < 4; ++ks) {
      kx[ks] = *(const bf16x8*)(kh + i * 136 + ks * 32 + fq * 8);
      qx[ks] = *(const bf16x8*)(qh + i * 136 + ks * 32 + fq * 8);
    }
#pragma unroll
    for (int jt = 0; jt < 4; ++jt) {
      f32x4 akk = (f32x4){0.f, 0.f, 0.f, 0.f}, aqk = (f32x4){0.f, 0.f, 0.f, 0.f};
      if (jt <= wid) {
#pragma unroll
        for (int ks = 0; ks < 4; ++ks) {
          const bf16x8 kj = *(const bf16x8*)(kh + (jt * 16 + fr) * 136 + ks * 32 + fq * 8);
          akk = mfma16(kj, kx[ks], akk);
          aqk = mfma16(kj, qx[ks], aqk);
        }
      }
      const int j0 = jt * 16 + fq * 4;
      float av[4], qv[4];
#pragma unroll
      for (int jj = 0; jj < 4; ++jj) {
        const int j = j0 + jj;
        const float dec = j <= i ? __expf(gi - sgc[j]) : 0.f;
        av[jj] = j < i ? bi * akk[jj] * dec : 0.f;
        qv[jj] = aqk[jj] * dec;
      }
      *(f32x4*)(Am + i * 64 + j0) = (f32x4){av[0], av[1], av[2], av[3]};
      *(u32x2*)(g_qk + i * 64 + j0) = (u32x2){pk2(qv[0], qv[1]), pk2(qv[2], qv[3])};
    }
  }
  __syncthreads();
  {
    float x[64];
    const bool isu = tid < 128;
    const int cc = tid & 127;
    solve_rows<0>(x, Am, (isu ? vh : kh) + cc, isu ? sbeta : sbe);
    if (isu) {
      u32x4* d = (u32x4*)(g_uT + cc * 64);
#pragma unroll
      for (int q = 0; q < 8; ++q) d[q] = (u32x4){pk2(x[q * 8], x[q * 8 + 1]), pk2(x[q * 8 + 2], x[q * 8 + 3]), pk2(x[q * 8 + 4], x[q * 8 + 5]), pk2(x[q * 8 + 6], x[q * 8 + 7])};
    } else {
#pragma unroll
      for (int i = 0; i < 64; ++i) g_w[i * 128 + cc] = f2bf(x[i]);
    }
  }
  {
    const float gl = sgc[63];
#pragma unroll
    for (int q = 0; q < 4; ++q) {
      const int pc = tid + q * 256, i = pc >> 4, c8 = pc & 15;
      const u32x4 v = *(const u32x4*)(qh + i * 136 + c8 * 8);
      float f[8];
      UNPACK8(v, f);
      const float s = __expf(sgc[i]);
      *(u32x4*)(g_qg + i * 128 + c8 * 8) = (u32x4){pk2(f[0] * s, f[1] * s), pk2(f[2] * s, f[3] * s), pk2(f[4] * s, f[5] * s), pk2(f[6] * s, f[7] * s)};
    }
    if (tid >= 128) {
      const int dk = tid - 128;
      u32x4* d = (u32x4*)(g_kgT + dk * 64);
#pragma unroll
      for (int q = 0; q < 8; ++q) {
        float f[8];
#pragma unroll
        for (int c = 0; c < 8; ++c) { const int i = q * 8 + c; f[c] = bf2f(kh[i * 136 + dk]) * __expf(gl - sgc[i]); }
        d[q] = (u32x4){pk2(f[0], f[1]), pk2(f[2], f[3]), pk2(f[4], f[5]), pk2(f[6], f[7])};
      }
    }
    if (tid == 0) p.gsc()[item] = __expf(gl);
  }
  __syncthreads();
}

__device__ void gdn_scan_item(const Params& p, int l, int item, unsigned char* smem) {
  const int tid = (opq(threadIdx.x) & 255), lane = tid & 63, wid = tid >> 6, fr = lane & 15, fq = lane >> 4;
  const int dvs = item & 3, h = (item >> 2) & 7, b = item >> 5;
  bf16_t* ST = (bf16_t*)smem;
  bf16_t* VT = ST + 2 * 32 * 136;
  f32x4 S[2][2];
#pragma unroll
  for (int a = 0; a < 2; ++a)
#pragma unroll
    for (int c = 0; c < 2; ++c) S[a][c] = (f32x4){0.f, 0.f, 0.f, 0.f};
  __syncthreads();
  bf16x8 fw[4], fqg[4], fqk[2], fkg[2][2];
  u32x2 fu[2];
  float gs;
  bf16x8 nw[4], nqg[4], nqk[2], nkg[2][2];
  u32x2 nu[2];
  float ngs;
#define SCAN_LOAD(n_, W, QG, QK, KG, U, GS) do { \
    const int it_ = ((b * 32 + (n_)) << 3) + h; \
    const unsigned char* scr_ = (const unsigned char*)p.scr() + (size_t)it_ * SCR_ITEM; \
    const bf16_t* g_uT = (const bf16_t*)scr_; const bf16_t* g_w = (const bf16_t*)(scr_ + 16384); const bf16_t* g_qg = (const bf16_t*)(scr_ + 32768); \
    const bf16_t* g_kgT = (const bf16_t*)(scr_ + 49152); const bf16_t* g_qk = (const bf16_t*)(scr_ + 65536); \
    _Pragma("unroll") for (int ks = 0; ks < 4; ++ks) { \
      W[ks] = *(const bf16x8*)(g_w + (wid * 16 + fr) * 128 + ks * 32 + fq * 8); \
      QG[ks] = *(const bf16x8*)(g_qg + (wid * 16 + fr) * 128 + ks * 32 + fq * 8); } \
    _Pragma("unroll") for (int ks = 0; ks < 2; ++ks) { \
      QK[ks] = *(const bf16x8*)(g_qk + (wid * 16 + fr) * 64 + ks * 32 + fq * 8); \
      _Pragma("unroll") for (int mt = 0; mt < 2; ++mt) KG[mt][ks] = *(const bf16x8*)(g_kgT + ((2 * wid + mt) * 16 + fr) * 64 + ks * 32 + fq * 8); } \
    _Pragma("unroll") for (int nt = 0; nt < 2; ++nt) U[nt] = *(const u32x2*)(g_uT + (dvs * 32 + nt * 16 + fr) * 64 + wid * 16 + fq * 4); \
    GS = p.gsc()[it_]; } while (0)
  SCAN_LOAD(0, nw, nqg, nqk, nkg, nu, ngs);
  for (int n = 0; n < 32; ++n) {
#pragma unroll
    for (int ks = 0; ks < 4; ++ks) { fw[ks] = nw[ks]; fqg[ks] = nqg[ks]; }
#pragma unroll
    for (int ks = 0; ks < 2; ++ks) { fqk[ks] = nqk[ks]; fkg[0][ks] = nkg[0][ks]; fkg[1][ks] = nkg[1][ks]; }
    fu[0] = nu[0]; fu[1] = nu[1]; gs = ngs;
    if (n + 1 < 32) SCAN_LOAD(n + 1, nw, nqg, nqk, nkg, nu, ngs);
    bf16_t* STc = ST + (n & 1) * 32 * 136;
#pragma unroll
    for (int mt = 0; mt < 2; ++mt)
#pragma unroll
      for (int nt = 0; nt < 2; ++nt)
        *(u32x2*)(STc + (nt * 16 + fr) * 136 + (2 * wid + mt) * 16 + fq * 4) = (u32x2){pk2(S[mt][nt].x, S[mt][nt].y), pk2(S[mt][nt].z, S[mt][nt].w)};
    __syncthreads();
#pragma unroll
    for (int nt = 0; nt < 2; ++nt) {
      f32x4 a = (f32x4){0.f, 0.f, 0.f, 0.f};
#pragma unroll
      for (int ks = 0; ks < 4; ++ks) {
        const bf16x8 sb = *(const bf16x8*)(STc + (nt * 16 + fr) * 136 + ks * 32 + fq * 8);
        a = mfma16(fw[ks], sb, a);
      }
      const float v0 = lo2f(fu[nt].x) - a.x, v1 = hi2f(fu[nt].x) - a.y, v2 = lo2f(fu[nt].y) - a.z, v3 = hi2f(fu[nt].y) - a.w;
      *(u32x2*)(VT + (nt * 16 + fr) * 72 + wid * 16 + fq * 4) = (u32x2){pk2(v0, v1), pk2(v2, v3)};
    }
    __syncthreads();
#pragma unroll
    for (int mt = 0; mt < 2; ++mt) {
      f32x4 a = (f32x4){0.f, 0.f, 0.f, 0.f};
#pragma unroll
      for (int ks = 0; ks < 4; ++ks) {
        const bf16x8 sa = *(const bf16x8*)(STc + (mt * 16 + fr) * 136 + ks * 32 + fq * 8);
        a = mfma16(sa, fqg[ks], a);
      }
#pragma unroll
      for (int ks = 0; ks < 2; ++ks) {
        const bf16x8 va = *(const bf16x8*)(VT + (mt * 16 + fr) * 72 + ks * 32 + fq * 8);
        a = mfma16(va, fqk[ks], a);
      }
      const size_t row = (size_t)b * 2048 + n * 64 + wid * 16 + fr;
      *(u32x2*)(p.ogdn() + row * DM + h * 128 + dvs * 32 + mt * 16 + fq * 4) = (u32x2){pk2(a.x, a.y), pk2(a.z, a.w)};
    }
#pragma unroll
    for (int mt = 0; mt < 2; ++mt)
#pragma unroll
      for (int nt = 0; nt < 2; ++nt) {
        f32x4 a = S[mt][nt] * gs;
#pragma unroll
        for (int ks = 0; ks < 2; ++ks) {
          const bf16x8 vb = *(const bf16x8*)(VT + (nt * 16 + fr) * 72 + ks * 32 + fq * 8);
          a = mfma16(fkg[mt][ks], vb, a);
        }
        S[mt][nt] = a;
      }
  }
  float* so = p.out + O_GDNP + ((size_t)(l * 8 + b) * 8 + h) * 16384;
#pragma unroll
  for (int mt = 0; mt < 2; ++mt)
#pragma unroll
    for (int nt = 0; nt < 2; ++nt)
#pragma unroll
      for (int jj = 0; jj < 4; ++jj) so[((2 * wid + mt) * 16 + fq * 4 + jj) * 128 + dvs * 32 + nt * 16 + fr] = S[mt][nt][jj];
  __syncthreads();
#undef SCAN_LOAD
}

__device__ void gdn_sample_item(const Params& p, int l, int item, unsigned char* smem) {
  const int tid = (opq(threadIdx.x) & 255), lane = tid & 63, wid = tid >> 6;
  const int h = item & 7, b = item >> 3;
  float* qs = (float*)smem;
  float* ks = qs + 1024;
  float* vs = ks + 1024;
  float* part = vs + 1024;
  float* sbeta = part + 256;
  float* sa = sbeta + 8;
  const int dv = tid & 127, half = tid >> 7;
  float S[64];
  const float* s0 = p.state_gdn + ((size_t)(l * 128 + b) * 8 + h) * 16384 + (half * 8192 + dv);
#pragma unroll
  for (int k = 0; k < 64; ++k) S[k] = s0[k * 128];
#pragma unroll
  for (int ps = 0; ps < 2; ++ps) {
    const int c = tid + ps * 256;
    if (c < 384) {
      const int sect = c >> 7, ci = c & 127;
      const int ch = sect * 1024 + h * 128 + ci;
      float xw[11], cwv[4];
#pragma unroll
      for (int j = 0; j < 4; ++j) cwv[j] = p.conv_w[(size_t)(l * 4 + j) * 3072 + ch];
#pragma unroll
      for (int j = 0; j < 3; ++j) xw[j] = p.cache_conv[((size_t)(l * 128 + b) * 3 + j) * 3072 + ch];
#pragma unroll
      for (int t = 0; t < 8; ++t) xw[3 + t] = bf2f(p.proj()[(size_t)(MP + b * 8 + t) * NPJ + ch]);
      float* dst = sect == 0 ? qs : (sect == 1 ? ks : vs);
#pragma unroll
      for (int t = 0; t < 8; ++t) dst[t * 128 + ci] = silu(xw[t] * cwv[0] + xw[t + 1] * cwv[1] + xw[t + 2] * cwv[2] + xw[t + 3] * cwv[3]);
    }
  }
  if (tid < 8) {
    const float* lg = p.logits() + (size_t)(MP + b * 8 + tid) * 16;
    const float x = lg[8 + h] + p.dt_bias[l * 8 + h];
    const float sp = softplus_f(x);
    sa[tid] = __expf(-__expf(p.a_log[l * 8 + h]) * sp);
    sbeta[tid] = sigm(lg[h]);
  }
  __syncthreads();
#pragma unroll
  for (int u = 0; u < 4; ++u) {
    const int t = wid * 2 + (u >> 1);
    float* arr = (u & 1) ? ks : qs;
    const float a0 = arr[t * 128 + lane], a1 = arr[t * 128 + 64 + lane];
    float ss = a0 * a0 + a1 * a1;
#pragma unroll
    for (int o = 1; o < 64; o <<= 1) ss += shx(ss, o, lane);
    float rn = rsqrtf(ss + EPS);
    if (!(u & 1)) rn *= 0.08838834764831845f;
    arr[t * 128 + lane] = a0 * rn;
    arr[t * 128 + 64 + lane] = a1 * rn;
  }
  __syncthreads();
#pragma unroll 1
  for (int t = 0; t < 8; ++t) {
    const float a = sa[t], bt = sbeta[t];
    float kv = 0.f;
#pragma unroll
    for (int k4 = 0; k4 < 16; ++k4) {
      const f32x4 kk = *(const f32x4*)(ks + t * 128 + half * 64 + k4 * 4);
      S[k4 * 4 + 0] *= a; S[k4 * 4 + 1] *= a; S[k4 * 4 + 2] *= a; S[k4 * 4 + 3] *= a;
      kv += S[k4 * 4 + 0] * kk.x + S[k4 * 4 + 1] * kk.y + S[k4 * 4 + 2] * kk.z + S[k4 * 4 + 3] * kk.w;
      if ((k4 & 3) == 3) asm volatile("" ::: "memory");
    }
    part[half * 128 + dv] = kv;
    __syncthreads();
    const float delta = bt * (vs[t * 128 + dv] - (part[dv] + part[128 + dv]));
    __syncthreads();
    float o = 0.f;
#pragma unroll
    for (int k4 = 0; k4 < 16; ++k4) {
      const f32x4 kk = *(const f32x4*)(ks + t * 128 + half * 64 + k4 * 4);
      const f32x4 qq = *(const f32x4*)(qs + t * 128 + half * 64 + k4 * 4);
      S[k4 * 4 + 0] += kk.x * delta; S[k4 * 4 + 1] += kk.y * delta; S[k4 * 4 + 2] += kk.z * delta; S[k4 * 4 + 3] += kk.w * delta;
      o += S[k4 * 4 + 0] * qq.x + S[k4 * 4 + 1] * qq.y + S[k4 * 4 + 2] * qq.z + S[k4 * 4 + 3] * qq.w;
      if ((k4 & 3) == 3) asm volatile("" ::: "memory");
    }
    part[half * 128 + dv] = o;
    __syncthreads();
    if (half == 0) p.ogdn()[(size_t)(MP + b * 8 + t) * DM + h * 128 + dv] = f2bf(part[dv] + part[128 + dv]);
    __syncthreads();
  }
  float* so = p.out + O_GDNS + ((size_t)(l * 128 + b) * 8 + h) * 16384 + opq(half * 8192 + dv);
#pragma unroll
  for (int k = 0; k < 64; ++k) so[k * 128] = S[k];
  __syncthreads();
}

__device__ void gdn_sample_pair(const Params& p, int l, int pair, unsigned char* smem) {
  const int tid = (opq(threadIdx.x) & 255), lane = tid & 63, wid = tid >> 6;
  const int sub = tid >> 7, dv = tid & 127;
  const int item = pair * 2 + sub, h = item & 7, b = item >> 3;
  float* qs = (float*)smem + sub * 3104;
  float* ks = qs + 1024;
  float* vs = qs + 2048;
  float* sbeta = qs + 3072;
  float* sa = qs + 3080;
  f32x2 S2[64];
  const float* s0 = p.state_gdn + ((size_t)(l * 128 + b) * 8 + h) * 16384 + dv;
#pragma unroll
  for (int k = 0; k < 64; ++k) { S2[k].x = s0[(2 * k) * 128]; S2[k].y = s0[(2 * k + 1) * 128]; }
#pragma unroll
  for (int sect = 0; sect < 3; ++sect) {
    const int ch = sect * 1024 + h * 128 + dv;
    float xw[11], cwv[4];
#pragma unroll
    for (int j = 0; j < 4; ++j) cwv[j] = p.conv_w[(size_t)(l * 4 + j) * 3072 + ch];
#pragma unroll
    for (int j = 0; j < 3; ++j) xw[j] = p.cache_conv[((size_t)(l * 128 + b) * 3 + j) * 3072 + ch];
#pragma unroll
    for (int t = 0; t < 8; ++t) xw[3 + t] = bf2f(p.proj()[(size_t)(MP + b * 8 + t) * NPJ + ch]);
    float* dst = sect == 0 ? qs : (sect == 1 ? ks : vs);
#pragma unroll
    for (int t = 0; t < 8; ++t) dst[t * 128 + dv] = silu(xw[t] * cwv[0] + xw[t + 1] * cwv[1] + xw[t + 2] * cwv[2] + xw[t + 3] * cwv[3]);
  }
  if (dv < 8) {
    const float* lg = p.logits() + (size_t)(MP + b * 8 + dv) * 16;
    const float x = lg[8 + h] + p.dt_bias[l * 8 + h];
    sa[dv] = __expf(-__expf(p.a_log[l * 8 + h]) * softplus_f(x));
    sbeta[dv] = sigm(lg[h]);
  }
  __syncthreads();
#pragma unroll
  for (int u = 0; u < 8; ++u) {
    const int t = (wid & 1) * 4 + (u >> 1);
    float* arr = (u & 1) ? ks : qs;
    const float a0 = arr[t * 128 + lane], a1 = arr[t * 128 + 64 + lane];
    float ss = a0 * a0 + a1 * a1;
#pragma unroll
    for (int o = 1; o < 64; o <<= 1) ss += shx(ss, o, lane);
    float rn = rsqrtf(ss + EPS);
    if (!(u & 1)) rn *= 0.08838834764831845f;
    arr[t * 128 + lane] = a0 * rn;
    arr[t * 128 + 64 + lane] = a1 * rn;
  }
  __syncthreads();
#pragma unroll 1
  for (int t = 0; t < 8; ++t) {
    const float a = sa[t], bt = sbeta[t];
    f32x2 kv2 = (f32x2){0.f, 0.f};
#pragma unroll
    for (int k4 = 0; k4 < 32; ++k4) {
      const f32x4 kk = *(const f32x4*)(ks + t * 128 + k4 * 4);
      kv2 += S2[2 * k4] * (f32x2){kk.x, kk.y};
      kv2 += S2[2 * k4 + 1] * (f32x2){kk.z, kk.w};
      if ((k4 & 3) == 3) asm volatile("" ::: "memory");
    }
    const float delta = bt * (vs[t * 128 + dv] - a * (kv2.x + kv2.y));
    const f32x2 a2 = (f32x2){a, a}, d2 = (f32x2){delta, delta};
    f32x2 o2 = (f32x2){0.f, 0.f};
#pragma unroll
    for (int k4 = 0; k4 < 32; ++k4) {
      const f32x4 kk = *(const f32x4*)(ks + t * 128 + k4 * 4);
      const f32x4 qq = *(const f32x4*)(qs + t * 128 + k4 * 4);
      S2[2 * k4] = S2[2 * k4] * a2 + (f32x2){kk.x, kk.y} * d2;
      S2[2 * k4 + 1] = S2[2 * k4 + 1] * a2 + (f32x2){kk.z, kk.w} * d2;
      o2 += S2[2 * k4] * (f32x2){qq.x, qq.y};
      o2 += S2[2 * k4 + 1] * (f32x2){qq.z, qq.w};
      if ((k4 & 3) == 3) asm volatile("" ::: "memory");
    }
    p.ogdn()[(size_t)(MP + b * 8 + t) * DM + h * 128 + dv] = f2bf(o2.x + o2.y);
  }
  float* so = p.out + O_GDNS + ((size_t)(l * 128 + b) * 8 + h) * 16384 + opq(dv);
#pragma unroll
  for (int k = 0; k < 64; ++k) { so[(2 * k) * 128] = S2[k].x; so[(2 * k + 1) * 128] = S2[k].y; }
  __syncthreads();
}

__device__ void swa_prompt_item(const Params& p, int l, int item, unsigned char* smem) {
  const int tid = (opq(threadIdx.x) & 255), lane = tid & 63, wid = tid >> 6, fr = lane & 15, fq = lane >> 4;
  const int kvh = item & 3, hb2 = (item >> 2) & 31, b = item >> 7;
  bf16_t* Ks = (bf16_t*)smem;
  bf16_t* VT = Ks + 208 * 72;
  bf16_t* Pw = VT + 64 * 216 + wid * 16 * 168;
  const int tk0 = hb2 * 64 - 128;
  u32x4 krw[7], vrw[7];
#pragma unroll
  for (int i = 0; i < 7; ++i) {
    const int pc = tid + i * NTHR, kj = pc >> 3, c8 = pc & 7, tk = tk0 + kj;
    krw[i] = (u32x4){0u, 0u, 0u, 0u}; vrw[i] = (u32x4){0u, 0u, 0u, 0u};
    if (pc < 208 * 8 && kj < 192 && tk >= 0) {
      const bf16_t* base = p.proj() + (size_t)(b * 2048 + tk) * NPJ + kvh * 64 + c8 * 8;
      krw[i] = *(const u32x4*)(base + C_SK); vrw[i] = *(const u32x4*)(base + C_SV);
    }
  }
#pragma unroll
  for (int i = 0; i < 7; ++i) {
    const int pc = tid + i * NTHR;
    if (pc >= 208 * 8) break;
    const int kj = pc >> 3, c8 = pc & 7, tk = tk0 + kj;
    const bool ok = kj < 192 && tk >= 0;
    float kf[8], vf[8];
    UNPACK8(krw[i], kf);
    UNPACK8(vrw[i], vf);
    float ss = 0.f;
#pragma unroll
    for (int c = 0; c < 8; ++c) ss += kf[c] * kf[c];
    ss += shx(ss, 1, lane); ss += shx(ss, 2, lane); ss += shx(ss, 4, lane);
    const float rn = rsqrtf(ss * (1.f / 64.f) + EPS);
    const f32x4 w0 = *(const f32x4*)(p.k_norm + l * 64 + c8 * 8), w1 = *(const f32x4*)(p.k_norm + l * 64 + c8 * 8 + 4);
    kf[0] *= rn * w0.x; kf[1] *= rn * w0.y; kf[2] *= rn * w0.z; kf[3] *= rn * w0.w;
    kf[4] *= rn * w1.x; kf[5] *= rn * w1.y; kf[6] *= rn * w1.z; kf[7] *= rn * w1.w;
    *(u32x4*)(Ks + kj * 72 + c8 * 8) = (u32x4){pk2(kf[0], kf[1]), pk2(kf[2], kf[3]), pk2(kf[4], kf[5]), pk2(kf[6], kf[7])};
#pragma unroll
    for (int c = 0; c < 8; ++c) VT[(c8 * 8 + c) * 216 + kj] = f2bf(vf[c]);
    if (ok && tk >= 1920 && kj >= 128) {
      float* ko = p.out + O_KP + (((size_t)(l * 8 + b) * 128 + (tk - 1920)) * 4 + kvh) * 64 + c8 * 8;
      float* vo = p.out + O_VP + (((size_t)(l * 8 + b) * 128 + (tk - 1920)) * 4 + kvh) * 64 + c8 * 8;
      *(f32x4*)ko = (f32x4){kf[0], kf[1], kf[2], kf[3]};
      *(f32x4*)(ko + 4) = (f32x4){kf[4], kf[5], kf[6], kf[7]};
      *(f32x4*)vo = (f32x4){vf[0], vf[1], vf[2], vf[3]};
      *(f32x4*)(vo + 4) = (f32x4){vf[4], vf[5], vf[6], vf[7]};
    }
  }
  __syncthreads();
  const int kbase = wid * 16;
  const int ql = wid * 16 + fr;
  const size_t qrow = (size_t)b * 2048 + hb2 * 64 + ql;
  u32x4 qraw[4][2];
#pragma unroll
  for (int g = 0; g < 4; ++g) {
    const bf16_t* qp = p.proj() + qrow * NPJ + C_SQ + (kvh * 4 + g) * 64 + fq * 8;
    qraw[g][0] = *(const u32x4*)qp; qraw[g][1] = *(const u32x4*)(qp + 32);
  }
#pragma unroll
  for (int g = 0; g < 4; ++g) {
    const int head = kvh * 4 + g;
    const float slope = exp2f(-0.5f * (float)(head + 1));
    const float sink = p.sinks[l * 16 + head];
    bf16x8 qf[2];
    {
      const u32x4 r0 = qraw[g][0], r1 = qraw[g][1];
      float f0[8], f1[8];
      UNPACK8(r0, f0);
      UNPACK8(r1, f1);
      float ss = 0.f;
#pragma unroll
      for (int c = 0; c < 8; ++c) ss += f0[c] * f0[c] + f1[c] * f1[c];
      ss += shx(ss, 16, lane); ss += shx(ss, 32, lane);
      const float rn = rsqrtf(ss * (1.f / 64.f) + EPS) * 0.125f;
      const float* qn = p.q_norm + l * 64 + fq * 8;
#pragma unroll
      for (int c = 0; c < 8; ++c) { f0[c] *= rn * qn[c]; f1[c] *= rn * qn[32 + c]; }
      qf[0] = as_bf((u32x4){pk2(f0[0], f0[1]), pk2(f0[2], f0[3]), pk2(f0[4], f0[5]), pk2(f0[6], f0[7])});
      qf[1] = as_bf((u32x4){pk2(f1[0], f1[1]), pk2(f1[2], f1[3]), pk2(f1[4], f1[5]), pk2(f1[6], f1[7])});
    }
    f32x4 sc[9];
    float mx = sink;
#pragma unroll
    for (int kt = 0; kt < 9; ++kt) {
      f32x4 a = (f32x4){0.f, 0.f, 0.f, 0.f};
#pragma unroll
      for (int ks = 0; ks < 2; ++ks) {
        const bf16x8 kf = *(const bf16x8*)(Ks + (kbase + kt * 16 + fr) * 72 + ks * 32 + fq * 8);
        a = mfma16(kf, qf[ks], a);
      }
#pragma unroll
      for (int jj = 0; jj < 4; ++jj) {
        const int kj = kbase + kt * 16 + fq * 4 + jj;
        const int dist = ql + 128 - kj;
        const bool ok = dist >= 0 && dist <= 128 && (tk0 + kj) >= 0;
        const float s = ok ? a[jj] - slope * (float)dist : -INFINITY;
        a[jj] = s;
        mx = fmaxf(mx, s);
      }
      sc[kt] = a;
    }
    mx = fmaxf(mx, shx(mx, 16, lane));
    mx = fmaxf(mx, shx(mx, 32, lane));
    float sum = 0.f;
#pragma unroll
    for (int kt = 0; kt < 9; ++kt) {
      f32x4 e;
#pragma unroll
      for (int jj = 0; jj < 4; ++jj) { e[jj] = __expf(sc[kt][jj] - mx); sum += e[jj]; }
      *(u32x2*)(Pw + fr * 168 + kt * 16 + fq * 4) = (u32x2){pk2(e.x, e.y), pk2(e.z, e.w)};
    }
    *(u32x2*)(Pw + fr * 168 + 144 + fq * 4) = (u32x2){0u, 0u};
    sum += shx(sum, 16, lane);
    sum += shx(sum, 32, lane);
    const float inv = 1.f / (sum + __expf(sink - mx));
    __builtin_amdgcn_wave_barrier();
#pragma unroll
    for (int dt = 0; dt < 4; ++dt) {
      f32x4 a = (f32x4){0.f, 0.f, 0.f, 0.f};
#pragma unroll
      for (int ks = 0; ks < 5; ++ks) {
        const bf16x8 vf = *(const bf16x8*)(VT + (dt * 16 + fr) * 216 + kbase + ks * 32 + fq * 8);
        const bf16x8 pf = *(const bf16x8*)(Pw + fr * 168 + ks * 32 + fq * 8);
        a = mfma16(vf, pf, a);
      }
      a *= inv;
      *(u32x2*)(p.oswa() + qrow * DM + head * 64 + dt * 16 + fq * 4) = (u32x2){pk2(a.x, a.y), pk2(a.z, a.w)};
    }
    __builtin_amdgcn_wave_barrier();
  }
  __syncthreads();
}

__device__ void swa_sample_item(const Params& p, int l, int item, unsigned char* smem) {
  const int tid = (opq(threadIdx.x) & 255), lane = tid & 63, wid = tid >> 6;
  const int kvh = item & 3, b = item >> 2;
  float* Ks = (float*)smem;
  float* Vs = Ks + 136 * 68;
  float* Qs = Vs + 136 * 64;
  float* Sc = Qs + 512;
  const size_t cbase = (size_t)(l * 128 + b) * 128;
  f32x4 kvr[8], vvr[8];
#pragma unroll
  for (int i = 0; i < 8; ++i) {
    const int idx = tid + i * NTHR, j = idx >> 4, c4 = idx & 15;
    kvr[i] = *(const f32x4*)(p.cache_k + ((cbase + j) * 4 + kvh) * 64 + c4 * 4);
    vvr[i] = *(const f32x4*)(p.cache_v + ((cbase + j) * 4 + kvh) * 64 + c4 * 4);
  }
  unsigned qrw[4];
#pragma unroll
  for (int g = 0; g < 4; ++g) qrw[g] = *(const unsigned*)(p.proj() + (size_t)(MP + b * 8 + (tid >> 5)) * NPJ + C_SQ + (kvh * 4 + g) * 64 + (tid & 31) * 2);
#pragma unroll
  for (int i = 0; i < 8; ++i) {
    const int idx = tid + i * NTHR, j = idx >> 4, c4 = idx & 15;
    const f32x4 kv = kvr[i], vv = vvr[i];
    *(f32x4*)(Ks + j * 68 + c4 * 4) = kv;
    *(f32x4*)(Vs + j * 64 + c4 * 4) = vv;
  }
  {
    const int t = tid >> 5, d = (tid & 31) * 2;
    const bf16_t* base = p.proj() + (size_t)(MP + b * 8 + t) * NPJ + kvh * 64 + d;
    const unsigned kr = *(const unsigned*)(base + C_SK), vr = *(const unsigned*)(base + C_SV);
    float k0 = lo2f(kr), k1 = hi2f(kr);
    float ss = k0 * k0 + k1 * k1;
#pragma unroll
    for (int o = 1; o < 32; o <<= 1) ss += shx(ss, o, lane);
    const float rn = rsqrtf(ss * (1.f / 64.f) + EPS);
    Ks[(128 + t) * 68 + d] = k0 * rn * p.k_norm[l * 64 + d];
    Ks[(128 + t) * 68 + d + 1] = k1 * rn * p.k_norm[l * 64 + d + 1];
    Vs[(128 + t) * 64 + d] = lo2f(vr);
    Vs[(128 + t) * 64 + d + 1] = hi2f(vr);
  }
  __syncthreads();
  for (int idx = tid; idx < 128 * 64; idx += NTHR) {
    const int j = idx >> 6, d = idx & 63;
    p.out[O_KS + ((cbase + j) * 4 + kvh) * 64 + d] = Ks[(j + 8) * 68 + d];
    p.out[O_VS + ((cbase + j) * 4 + kvh) * 64 + d] = Vs[(j + 8) * 64 + d];
  }
#pragma unroll
  for (int g = 0; g < 4; ++g) {
    const int head = kvh * 4 + g;
    const float slope = exp2f(-0.5f * (float)(head + 1));
    const float sink = p.sinks[l * 16 + head];
    {
      const int t = tid >> 5, d = (tid & 31) * 2;
      const unsigned qr = qrw[g];
      const float q0 = lo2f(qr), q1 = hi2f(qr);
      float ss = q0 * q0 + q1 * q1;
#pragma unroll
      for (int o = 1; o < 32; o <<= 1) ss += shx(ss, o, lane);
      const float rn = rsqrtf(ss * (1.f / 64.f) + EPS) * 0.125f;
      Qs[t * 64 + d] = q0 * rn * p.q_norm[l * 64 + d];
      Qs[t * 64 + d + 1] = q1 * rn * p.q_norm[l * 64 + d + 1];
    }
    __syncthreads();
    for (int idx = tid; idx < 8 * 136; idx += NTHR) {
      const int tq = idx / 136, j = idx % 136;
      float s = 0.f;
#pragma unroll
      for (int d4 = 0; d4 < 16; ++d4) {
        const f32x4 qv = *(const f32x4*)(Qs + tq * 64 + d4 * 4), kq = *(const f32x4*)(Ks + j * 68 + d4 * 4);
        s += (qv.x * kq.x + qv.y * kq.y) + (qv.z * kq.z + qv.w * kq.w);
      }
      const int dist = tq + 128 - j;
      Sc[tq * 136 + j] = (dist >= 0 && dist <= 128) ? s - slope * (float)dist : -INFINITY;
    }
    __syncthreads();
#pragma unroll
    for (int u = 0; u < 2; ++u) {
      const int tq = wid * 2 + u;
      const float s0 = Sc[tq * 136 + lane], s1 = Sc[tq * 136 + 64 + lane], s2 = lane < 8 ? Sc[tq * 136 + 128 + lane] : -INFINITY;
      float mx = fmaxf(fmaxf(s0, s1), fmaxf(s2, sink));
#pragma unroll
      for (int o = 1; o < 64; o <<= 1) mx = fmaxf(mx, shx(mx, o, lane));
      const float e0 = __expf(s0 - mx), e1 = __expf(s1 - mx), e2 = __expf(s2 - mx);
      float sum = e0 + e1 + e2;
#pragma unroll
      for (int o = 1; o < 64; o <<= 1) sum += shx(sum, o, lane);
      const float inv = 1.f / (sum + __expf(sink - mx));
      Sc[tq * 136 + lane] = e0 * inv;
      Sc[tq * 136 + 64 + lane] = e1 * inv;
      if (lane < 8) Sc[tq * 136 + 128 + lane] = e2 * inv;
    }
    __syncthreads();
    {
      const int tq = tid >> 5, d = (tid & 31) * 2;
      float o0 = 0.f, o1 = 0.f;
#pragma unroll 2
      for (int j4 = 0; j4 < 34; ++j4) {
        const f32x4 pj = *(const f32x4*)(Sc + tq * 136 + j4 * 4);
        const f32x2 va = *(const f32x2*)(Vs + (j4 * 4 + 0) * 64 + d), vb = *(const f32x2*)(Vs + (j4 * 4 + 1) * 64 + d);
        const f32x2 vc = *(const f32x2*)(Vs + (j4 * 4 + 2) * 64 + d), vd = *(const f32x2*)(Vs + (j4 * 4 + 3) * 64 + d);
        o0 += (pj.x * va.x + pj.y * vb.x) + (pj.z * vc.x + pj.w * vd.x);
        o1 += (pj.x * va.y + pj.y * vb.y) + (pj.z * vc.y + pj.w * vd.y);
      }
      *(unsigned*)(p.oswa() + (size_t)(MP + b * 8 + tq) * DM + head * 64 + d) = pk2(o0, o1);
    }
    __syncthreads();
  }
}

__device__ void phase_mix(const Params& p, int l) {
  const int tid = (opq(threadIdx.x) & 255), lane = tid & 63, wid = tid >> 6, fr = lane & 15, fq = lane >> 4;
  for (int it = VB; it < MTOK / 4; it += VG) {
    const size_t row = (size_t)it * 4 + wid;
#pragma unroll
    for (int ps = 0; ps < 2; ++ps) {
      const int ch = (ps * 4 + fq) * 128 + fr * 8;
      const u32x4 og = *(const u32x4*)(p.ogdn() + row * DM + ch);
      const u32x4 ob = *(const u32x4*)(p.oswa() + row * DM + ch);
      const u32x4 zz = *(const u32x4*)(p.proj() + row * NPJ + C_Z + ch);
      const u32x4 ga = *(const u32x4*)(p.proj() + row * NPJ + C_G + ch);
      const u32x4 gb = *(const u32x4*)(p.proj() + row * NPJ + C_G + 1024 + ch);
      float fo[8], fb[8], fz[8], fa[8], fg[8];
      UNPACK8(og, fo); UNPACK8(ob, fb); UNPACK8(zz, fz); UNPACK8(ga, fa); UNPACK8(gb, fg);
      float ss = 0.f;
#pragma unroll
      for (int c = 0; c < 8; ++c) ss += fo[c] * fo[c];
      ss += shx(ss, 1, lane); ss += shx(ss, 2, lane); ss += shx(ss, 4, lane); ss += shx(ss, 8, lane);
      const float rn = rsqrtf(ss * (1.f / 128.f) + EPS);
      const f32x4 w0 = *(const f32x4*)(p.gdn_norm + l * 128 + fr * 8), w1 = *(const f32x4*)(p.gdn_norm + l * 128 + fr * 8 + 4);
      const float wn[8] = {w0.x, w0.y, w0.z, w0.w, w1.x, w1.y, w1.z, w1.w};
      float m[8];
#pragma unroll
      for (int c = 0; c < 8; ++c) m[c] = sigm(fa[c]) * (fo[c] * rn * wn[c] * silu(fz[c])) + sigm(fg[c]) * fb[c];
      *(u32x4*)(p.mix() + row * DM + ch) = (u32x4){pk2(m[0], m[1]), pk2(m[2], m[3]), pk2(m[4], m[5]), pk2(m[6], m[7])};
    }
  }
  const int NC = (8 + 128) * 3 * 3072;
  for (int i = VB * NTHR + tid; i < NC; i += VG * NTHR) {
    const int c = i % 3072, r = (i / 3072) % 3, bb = i / 9216;
    if (bb < 8) p.out[O_CONVP + ((size_t)(l * 8 + bb) * 3 + r) * 3072 + c] = bf2f(p.proj()[(size_t)(bb * 2048 + 2045 + r) * NPJ + c]);
    else p.out[O_CONVS + ((size_t)(l * 128 + bb - 8) * 3 + r) * 3072 + c] = bf2f(p.proj()[(size_t)(MP + (bb - 8) * 8 + 5 + r) * NPJ + c]);
  }
}

#define XB_TMO      128
#define XB_XCNT(j)  (256  + 64 * (j))
#define XB_XSUB(j)  (1280 + 64 * (j))
#define XB_XGEN(j)  (2304 + 64 * (j))
#define XB_TOP      3328
#define XB_TOPGEN   3392
#define XCD_BAR_WORDS 3456
#define XB_SPIN_CAP (1u << 18)
#define LAS __attribute__((address_space(3)))

__device__ __forceinline__ unsigned xb_ld(unsigned* p)              { return __hip_atomic_load(p, __ATOMIC_RELAXED, __HIP_MEMORY_SCOPE_AGENT); }
__device__ __forceinline__ unsigned xb_add(unsigned* p, unsigned v) { return __hip_atomic_fetch_add(p, v, __ATOMIC_RELAXED, __HIP_MEMORY_SCOPE_AGENT); }
__device__ __forceinline__ unsigned xb_xcc_id() { return (unsigned)__builtin_amdgcn_s_getreg((3 << 11) | 20) & 0xFu; }
#define XB_SPIN(cond, bar) do { unsigned _sp = 0; while (cond) { __builtin_amdgcn_s_sleep(1); \
    if ((++_sp & 255u) == 0u) { if (xb_ld(&(bar)[XB_TMO])) break; if (_sp > XB_SPIN_CAP) { atomicAdd(&(bar)[XB_TMO], 1u); break; } } } } while (0)

struct XcdBarrier {
    unsigned* bar; unsigned x;
    volatile LAS unsigned* st;
};

__device__ __forceinline__ XcdBarrier xcd_barrier_post(unsigned* bar, volatile LAS unsigned* st) {
    XcdBarrier b; b.bar = bar; b.x = xb_xcc_id(); b.st = st;
    if (threadIdx.x == 0) (void)xb_add(&bar[XB_XCNT(b.x)], 1u);
    return b;
}
__device__ __forceinline__ void xcd_barrier_complete(unsigned* bar, unsigned x, unsigned& nloc, unsigned& nx) {
    const unsigned G = gridDim.x * gridDim.y * gridDim.z;
    unsigned sum, cnt, mine, sp = 0u;
    for (;;) {
        sum = 0u; cnt = 0u; mine = 0u;
#pragma unroll
        for (unsigned j = 0; j < 16; ++j) { const unsigned c = xb_ld(&bar[XB_XCNT(j)]); sum += c; cnt += (c > 0u) ? 1u : 0u; mine = (j == x) ? c : mine; }
        if (sum == G) break;
        __builtin_amdgcn_s_sleep(1);
        if ((++sp & 255u) == 0u) { if (xb_ld(&bar[XB_TMO])) break; if (sp > XB_SPIN_CAP) { atomicAdd(&bar[XB_TMO], 1u); break; } }
    }
    nloc = mine > 0u ? mine : 1u; nx = cnt > 0u ? cnt : 1u;
}

__device__ __forceinline__ void xcd_barrier(const XcdBarrier& b) {
    asm volatile("s_waitcnt vmcnt(0)" ::: "memory");
    __syncthreads();
    if (threadIdx.x == 0) {
        unsigned* bar = b.bar;
        __builtin_amdgcn_s_waitcnt(0);
        unsigned nloc = b.st[0], nx = b.st[1];
        if (nloc == 0u) { xcd_barrier_complete(bar, b.x, nloc, nx); b.st[0] = nloc; b.st[1] = nx; }
        const unsigned old = xb_add(&bar[XB_XSUB(b.x)], 1u);
        const unsigned gen = old / nloc;
        if (old + 1u == (gen + 1u) * nloc) {
            __builtin_amdgcn_fence(__ATOMIC_RELEASE, "agent");
            asm volatile("s_waitcnt vmcnt(0)" ::: "memory");
            const unsigned og = xb_add(&bar[XB_TOP], 1u);
            const unsigned tg = og / nx;
            if (og + 1u == (tg + 1u) * nx) xb_add(&bar[XB_TOPGEN], 1u);
            else XB_SPIN(xb_ld(&bar[XB_TOPGEN]) == tg, bar);
            __builtin_amdgcn_fence(__ATOMIC_ACQUIRE, "agent");
            xb_add(&bar[XB_XGEN(b.x)], 1u);
            asm volatile("s_waitcnt vmcnt(0)" ::: "memory");
        } else {
            XB_SPIN(xb_ld(&bar[XB_XGEN(b.x)]) == gen, bar);
            __builtin_amdgcn_fence(__ATOMIC_ACQUIRE, "agent");
            asm volatile("s_waitcnt vmcnt(0)" ::: "memory");
        }
    }
    __syncthreads();
}


#define NPHASE_PRE 2
#define NPHASE_L 8
constexpr int LDS_TOTAL = 2 * SMEM_BYTES;
__global__ void __launch_bounds__(512, 2) mega(Params p, int ph_lo, int ph_hi) {
  extern __shared__ __attribute__((aligned(16))) unsigned char lds_all[];
  if (ph_hi < 0) cg::this_grid().sync();
  __shared__ uint4 xb_words;
  if (threadIdx.x == 0) xb_words = make_uint4(0u, 0u, 0u, 0u);
  __syncthreads();
  XcdBarrier xb = xcd_barrier_post(p.bar(), (volatile LAS unsigned*)&xb_words);
  unsigned char* smem = lds_all + VHALF * SMEM_BYTES;
  for (int ph = ph_lo; ph < ph_hi; ++ph) {
    if (ph > ph_lo) xcd_barrier(xb);
    if (ph == 0) { phase_p0(p, smem); continue; }
    if (ph == 1) {
      {
        EpiArgs e{};
        e.obf = p.pp(); e.ldo = DM;
        DiagSched S; S.nLimit = 1024; S.G = gridDim.x; S.c = blockIdx.x;
        pg8::Gemm g; g.A = p.pb(); g.Bt = p.wt_proj(); g.M = NL * MTOK; g.N = NL * DM; g.K = PLE;
        BigEpi<EPI_PP> E; E.e = e;
        pg8::gemm_phase<BigEpi<EPI_PP>, DiagSched>((PG8_LAS unsigned char*)lds_all, g, S, E, nullptr);
        __syncthreads();
      }
      for (int st = VB; st < 64 * 16; st += VG) {
        const int L = 1024 + (st >> 4), sub = st & 15, l = L / 272, r = L - l * 272, pm = r >> 2, pn = r & 3;
        EpiArgs e{};
        e.obf = p.pp() + (size_t)l * MTOK * DM; e.ldo = DM;
        gemm_tile<1, 4, 4, 1, EPI_PP, 128>(p.pb() + (size_t)l * MTOK * PLE, PLE, p.wt_proj() + (size_t)l * DM * PLE, PLE, PLE, pm * 256 + (sub >> 2) * 64, pn * 256 + (sub & 3) * 64, (bf16_t*)smem, e);
      }
      continue;
    }
    const int l = (ph - NPHASE_PRE) / NPHASE_L, s = (ph - NPHASE_PRE) % NPHASE_L;
#ifndef REPMASK
#define REPMASK 0
#endif
    for (int rep = 0; rep < (((REPMASK >> s) & 1) ? 2 : 1); ++rep) {
    if (rep) xcd_barrier(xb);
    switch (s) {
      case 0: {
        EpiArgs e{};
        e.ssq_in = p.ssq0(); e.obf = p.proj(); e.ldo = NPJ; e.of32 = p.logits();
        const bf16_t* Bt = p.wt_in() + (size_t)l * NIN * DM;
        gemm_big_phase<EPI_PROJ>(p.hb(), Bt, DM, MTOK, NPJ, lds_all, smem, e);
        for (int t = VB; t < 272; t += VG)
          gemm_tile<1, 1, 4, 1, EPI_LOGIT, 128>(p.hb(), DM, Bt + (size_t)NPJ * DM, DM, DM, t * 64, 0, (bf16_t*)smem, e);
      } break;
      case 1: {
        const int nB1 = VG == 512 ? 3072 : 3584;
        for (int t = VB; t < nB1; t += VG) {
          if (t < 2048) gdn_prep_item(p, l, t, smem);
          else if (t < 3072) swa_prompt_item(p, l, t - 2048, smem);
          else swa_sample_item(p, l, t - 3072, smem);
        }
      } break;
      case 2: {
        if (VG == 512) {
          if (VB < 256) gdn_scan_item(p, l, VB, smem);
          else {
            gdn_sample_pair(p, l, VB - 256, smem); gdn_sample_pair(p, l, VB, smem);
            swa_sample_item(p, l, (VB - 256) * 2, smem); swa_sample_item(p, l, (VB - 256) * 2 + 1, smem);
          }
        } else {
          for (int t = VB; t < 256 + 512; t += VG) {
            if (t < 256) gdn_scan_item(p, l, t, smem);
            else gdn_sample_pair(p, l, t - 256, smem);
          }
        }
      } break;
      case 3: phase_mix(p, l); break;
      case 4: {
        EpiArgs e{};
        e.h = p.out; e.hb = p.hb2(); e.ssq_out = p.ssq1();
        gemm_big_phase<EPI_RESID>(p.mix(), p.wt_out() + (size_t)l * DM * DM, DM, MTOK, DM, lds_all, smem, e);
      } break;
      case 5: {
        EpiArgs e{};
        e.ssq_in = p.ssq1(); e.obf = p.proj(); e.ldo = DFF;
        gemm_big_phase<EPI_UP>(p.hb2(), p.wt_up() + (size_t)l * DFF * DM, DM, MTOK, DFF, lds_all, smem, e);
      } break;
      case 6: {
        EpiArgs e{};
        e.h = p.out; e.hb = p.hb2(); e.ssq_out = p.ssq2();
        gemm_big_phase<EPI_RESID>(p.proj(), p.wt_down() + (size_t)l * DM * DFF, DFF, MTOK, DM, lds_all, smem, e);
      } break;
      case 7: {
        EpiArgs e{};
        e.h = p.out; e.hb = p.hb(); e.ssq_in = p.ssq2(); e.ssq_out = p.ssq0(); e.pp = p.pp() + (size_t)l * MTOK * DM;
        gemm_big_phase<EPI_PLE>(p.hb2(), p.wt_gate() + (size_t)l * DM * DM, DM, MTOK, DM, lds_all, smem, e);
      } break;
    }
    }
  }
}

extern "C" void kernel_launch(void* const* d_in, const int* in_sizes, int n_in, void* d_out, int out_size, void* d_ws, size_t ws_size,
                              hipStream_t stream) {
  Params p{};
  const float* const* in = (const float* const*)d_in;
  p.x_prompt = in[0]; p.x_sample = in[1]; p.cache_conv = in[2]; p.state_gdn = in[3]; p.cache_k = in[4]; p.cache_v = in[5];
  p.p_prompt = in[6]; p.p_sample = in[7]; p.norm_mix = in[8]; p.w_in = in[9]; p.conv_w = in[10]; p.a_log = in[11]; p.dt_bias = in[12];
  p.gdn_norm = in[13]; p.q_norm = in[14]; p.k_norm = in[15]; p.sinks = in[16]; p.w_out = in[17]; p.norm_ffn = in[18]; p.w_up = in[19];
  p.w_down = in[20]; p.norm_ple = in[21]; p.w_gate = in[22]; p.w_proj = in[23];
  p.out = (float*)d_out;
  p.ws = (unsigned char*)d_ws;
  if (WS_TOTAL > ws_size) { fprintf(stderr, "workspace too small: need %zu have %zu\n", (size_t)WS_TOTAL, ws_size); return; }

  static int grid_blocks = 0;
  if (!grid_blocks) {
    int dev = 0, cus = 0, per_cu = 0;
    (void)hipGetDevice(&dev);
    (void)hipDeviceGetAttribute(&cus, hipDeviceAttributeMultiprocessorCount, dev);
    if (hipFuncSetAttribute((const void*)mega, hipFuncAttributeMaxDynamicSharedMemorySize, LDS_TOTAL) != hipSuccess) { fprintf(stderr, "hipFuncSetAttribute(dynamic LDS %d) failed\n", LDS_TOTAL); grid_blocks = -1; return; }
    (void)hipOccupancyMaxActiveBlocksPerMultiprocessor(&per_cu, (const void*)mega, 512, LDS_TOTAL);
    (void)hipGetLastError();
    grid_blocks = cus;
  }
  if (grid_blocks < 0) return;
  (void)hipMemsetAsync(p.ws + WO_bar, 0, (size_t)XCD_BAR_WORDS * 4, stream);
  int lo = 0, hi = NPHASE_PRE + NL * NPHASE_L;
  void* args[] = {&p, &lo, &hi};
  hipError_t e = hipLaunchCooperativeKernel((void*)mega, dim3(grid_blocks), dim3(512), args, LDS_TOTAL, stream);
  if (e != hipSuccess) fprintf(stderr, "cooperative launch failed: %s (grid %d)\n", hipGetErrorString(e), grid_blocks);
}
```

```cpp
#include <hip/hip_runtime.h>
#include <hip/hip_cooperative_groups.h>
#include <cstdio>
namespace cg = cooperative_groups;

typedef unsigned short bf16_t;
typedef short bf16x8 __attribute__((ext_vector_type(8)));
typedef float f32x4 __attribute__((ext_vector_type(4)));
typedef float f32x2 __attribute__((ext_vector_type(2)));
typedef unsigned u32x4 __attribute__((ext_vector_type(4)));
typedef unsigned u32x2 __attribute__((ext_vector_type(2)));

#define DEVI __device__ __forceinline__
DEVI int opq(int x) { asm volatile("" : "+v"(x)); return x; }

#define VHALF ((int)__builtin_amdgcn_readfirstlane((int)(threadIdx.x >> 8)))
#define VB ((int)blockIdx.x * 2 + VHALF)
#define VG ((int)gridDim.x * 2)
constexpr int NL = 4;
constexpr int MTOK = 17408, MP = 16384, MS = 1024;
constexpr int DM = 1024, NIN = 7696, NPJ = 7680, DFF = 4096, PLE = 256;
constexpr int C_Z = 3072, C_SQ = 4096, C_SK = 5120, C_SV = 5376, C_G = 5632;
constexpr float EPS = 1e-6f;
constexpr int NTHR = 256;
constexpr int SMEM_BYTES = 79872;
constexpr size_t SCR_ITEM = 73728;

constexpr size_t O_YP = 0, O_YS = 16777216, O_CONVP = 17825792, O_GDNP = 18120704, O_KP = 22315008, O_VP = 23363584,
                 O_CONVS = 24412160, O_GDNS = 29130752, O_KS = 96239616, O_VS = 113016832, O_END = 129794048;

constexpr size_t al256(size_t x) { return (x + 255) & ~(size_t)255; }
constexpr size_t WO_wt_in = 0;
constexpr size_t WO_wt_out = WO_wt_in + al256((size_t)NL * NIN * DM * 2);
constexpr size_t WO_wt_up = WO_wt_out + al256((size_t)NL * DM * DM * 2);
constexpr size_t WO_wt_down = WO_wt_up + al256((size_t)NL * DFF * DM * 2);
constexpr size_t WO_wt_gate = WO_wt_down + al256((size_t)NL * DM * DFF * 2);
constexpr size_t WO_wt_proj = WO_wt_gate + al256((size_t)NL * DM * DM * 2);
constexpr size_t WO_hb = WO_wt_proj + al256((size_t)NL * DM * PLE * 2);
constexpr size_t WO_hb2 = WO_hb + al256((size_t)MTOK * DM * 2);
constexpr size_t WO_proj = WO_hb2 + al256((size_t)MTOK * DM * 2);
constexpr size_t WO_scr = WO_proj + al256((size_t)MTOK * NPJ * 2);
constexpr size_t WO_ogdn = WO_scr + al256((size_t)2048 * SCR_ITEM);
constexpr size_t WO_oswa = WO_ogdn + al256((size_t)MTOK * DM * 2);
constexpr size_t WO_mix = WO_oswa + al256((size_t)MTOK * DM * 2);
constexpr size_t WO_pb = WO_mix + al256((size_t)MTOK * DM * 2);
constexpr size_t WO_pp = WO_pb + al256((size_t)NL * MTOK * PLE * 2);
constexpr size_t WO_ssq0 = WO_pp + al256((size_t)NL * MTOK * DM * 2);
constexpr size_t WO_ssq1 = WO_ssq0 + al256((size_t)MTOK * 16 * 4);
constexpr size_t WO_ssq2 = WO_ssq1 + al256((size_t)MTOK * 16 * 4);
constexpr size_t WO_logits = WO_ssq2 + al256((size_t)MTOK * 16 * 4);
constexpr size_t WO_gsc = WO_logits + al256((size_t)MTOK * 16 * 4);
constexpr size_t WO_bar = WO_gsc + al256((size_t)2048 * 4);
constexpr size_t WS_TOTAL = WO_bar + al256((size_t)3456 * 4);
struct Params {
  const float *x_prompt, *x_sample, *cache_conv, *state_gdn, *cache_k, *cache_v, *p_prompt, *p_sample;
  const float *norm_mix, *w_in, *conv_w, *a_log, *dt_bias, *gdn_norm, *q_norm, *k_norm, *sinks, *w_out, *norm_ffn, *w_up, *w_down,
      *norm_ple, *w_gate, *w_proj;
  float* out;
  unsigned char* ws;
  DEVI bf16_t* wt_in() const { return (bf16_t*)(ws + WO_wt_in); }
  DEVI bf16_t* wt_out() const { return (bf16_t*)(ws + WO_wt_out); }
  DEVI bf16_t* wt_up() const { return (bf16_t*)(ws + WO_wt_up); }
  DEVI bf16_t* wt_down() const { return (bf16_t*)(ws + WO_wt_down); }
  DEVI bf16_t* wt_gate() const { return (bf16_t*)(ws + WO_wt_gate); }
  DEVI bf16_t* wt_proj() const { return (bf16_t*)(ws + WO_wt_proj); }
  DEVI bf16_t* hb() const { return (bf16_t*)(ws + WO_hb); }
  DEVI bf16_t* hb2() const { return (bf16_t*)(ws + WO_hb2); }
  DEVI bf16_t* proj() const { return (bf16_t*)(ws + WO_proj); }
  DEVI bf16_t* scr() const { return (bf16_t*)(ws + WO_scr); }
  DEVI bf16_t* ogdn() const { return (bf16_t*)(ws + WO_ogdn); }
  DEVI bf16_t* oswa() const { return (bf16_t*)(ws + WO_oswa); }
  DEVI bf16_t* mix() const { return (bf16_t*)(ws + WO_mix); }
  DEVI bf16_t* pb() const { return (bf16_t*)(ws + WO_pb); }
  DEVI bf16_t* pp() const { return (bf16_t*)(ws + WO_pp); }
  DEVI float* ssq0() const { return (float*)(ws + WO_ssq0); }
  DEVI float* ssq1() const { return (float*)(ws + WO_ssq1); }
  DEVI float* ssq2() const { return (float*)(ws + WO_ssq2); }
  DEVI float* logits() const { return (float*)(ws + WO_logits); }
  DEVI float* gsc() const { return (float*)(ws + WO_gsc); }
  DEVI unsigned* bar() const { return (unsigned*)(ws + WO_bar); }
};

DEVI float shx(float v, int m, int ln) { return __builtin_bit_cast(float, __builtin_amdgcn_ds_bpermute((ln ^ m) << 2, __builtin_bit_cast(int, v))); }
DEVI float shup(float v, int o, int ln) { return __builtin_bit_cast(float, __builtin_amdgcn_ds_bpermute((ln >= o ? ln - o : ln) << 2, __builtin_bit_cast(int, v))); }
DEVI float lo2f(unsigned u) { return __uint_as_float(u << 16); }
DEVI float hi2f(unsigned u) { return __uint_as_float(u & 0xffff0000u); }
DEVI float bf2f(bf16_t v) { return __uint_as_float(((unsigned)v) << 16); }
typedef __bf16 bf16x2_t __attribute__((ext_vector_type(2)));
DEVI unsigned pk2(float lo, float hi) { const f32x2 v = {lo, hi}; const bf16x2_t r = __builtin_convertvector(v, bf16x2_t); return __builtin_bit_cast(unsigned, r); }
DEVI bf16_t f2bf(float f) { return (bf16_t)(pk2(f, 0.f) & 0xffffu); }
DEVI float sigm(float x) { return 1.f / (1.f + __expf(-x)); }
DEVI float silu(float x) { return x * sigm(x); }
DEVI float softplus_f(float x) {
  const float e = __expf(x);
  return x > 20.f ? x : (e < 0.01f ? e * (1.f - 0.5f * e + 0.33333334f * e * e) : __logf(1.f + e));
}
DEVI f32x4 mfma16(bf16x8 a, bf16x8 b, f32x4 c) { return __builtin_amdgcn_mfma_f32_16x16x32_bf16(a, b, c, 0, 0, 0); }
DEVI bf16x8 as_bf(u32x4 v) { return __builtin_bit_cast(bf16x8, v); }
#define UNPACK8(v, f) do { f[0] = lo2f(v.x); f[1] = hi2f(v.x); f[2] = lo2f(v.y); f[3] = hi2f(v.y); f[4] = lo2f(v.z); f[5] = hi2f(v.z); f[6] = lo2f(v.w); f[7] = hi2f(v.w); } while (0)

DEVI int inmap(int n) { return n < 4096 ? n : (n < 7680 ? n + 16 : n - 7680 + 4096); }

struct WTile { const float* src; const float* scale; bf16_t* dst; int ldsrc, K, Nd, kt, nt, flags; };
DEVI WTile wtile_decode(const Params& p, int it) {
  constexpr int T_IN = 16 * 121, T_OUT = 256, T_UP = 1024, T_DOWN = 1024, T_GATE = 256, T_PROJ = 64;
  constexpr int T_L = T_IN + T_OUT + T_UP + T_DOWN + T_GATE + T_PROJ;
  const int l = it / T_L;
  int r = it % T_L;
  WTile t;
  t.scale = p.norm_mix;
  if (r < T_IN) { t.src = p.w_in + (size_t)l * DM * NIN; t.ldsrc = NIN; t.K = DM; t.Nd = NIN; t.dst = p.wt_in() + (size_t)l * NIN * DM; t.scale = p.norm_mix + l * DM; t.flags = 3; t.kt = r % 16; t.nt = r / 16; return t; }
  r -= T_IN;
  if (r < T_OUT) { t.src = p.w_out + (size_t)l * DM * DM; t.ldsrc = DM; t.K = DM; t.Nd = DM; t.dst = p.wt_out() + (size_t)l * DM * DM; t.flags = 0; t.kt = r % 16; t.nt = r / 16; return t; }
  r -= T_OUT;
  if (r < T_UP) { t.src = p.w_up + (size_t)l * DM * DFF; t.ldsrc = DFF; t.K = DM; t.Nd = DFF; t.dst = p.wt_up() + (size_t)l * DFF * DM; t.scale = p.norm_ffn + l * DM; t.flags = 2; t.kt = r % 16; t.nt = r / 16; return t; }
  r -= T_UP;
  if (r < T_DOWN) { t.src = p.w_down + (size_t)l * DFF * DM; t.ldsrc = DM; t.K = DFF; t.Nd = DM; t.dst = p.wt_down() + (size_t)l * DM * DFF; t.flags = 0; t.kt = r % 64; t.nt = r / 64; return t; }
  r -= T_DOWN;
  if (r < T_GATE) { t.src = p.w_gate + (size_t)l * DM * DM; t.ldsrc = DM; t.K = DM; t.Nd = DM; t.dst = p.wt_gate() + (size_t)l * DM * DM; t.scale = p.norm_ple + l * DM; t.flags = 2; t.kt = r % 16; t.nt = r / 16; return t; }
  r -= T_GATE;
  t.src = p.w_proj + (size_t)l * PLE * DM; t.ldsrc = DM; t.K = PLE; t.Nd = DM; t.dst = p.wt_proj() + (size_t)l * DM * PLE; t.flags = 0; t.kt = r % 4; t.nt = r / 4;
  return t;
}
DEVI void wtile_load(const WTile& t, float (&v)[16], float (&sv)[16], int tid) {
  const int nl = tid & 63, kq = tid >> 6;
  const int n = t.nt * 64 + nl, nc = n < t.Nd ? n : t.Nd - 1;
  const int sc = (t.flags & 1) ? inmap(nc) : nc;
  const int ksc = (t.flags & 2) ? 1 : 0;
#pragma unroll
  for (int r = 0; r < 16; ++r) {
    const int k = t.kt * 64 + r * 4 + kq;
    v[r] = t.src[(size_t)k * t.ldsrc + sc];
    sv[r] = t.scale[(k & 1023) * ksc];
  }
}
DEVI void wtile_store(const WTile& t, const float (&v)[16], const float (&sv)[16], float* sm, int tid) {
  const int nl = tid & 63, kq = tid >> 6;
  const bool ok = t.nt * 64 + nl < t.Nd;
  const bool has = (t.flags & 2) != 0;
#pragma unroll
  for (int r = 0; r < 16; ++r) sm[(r * 4 + kq) * 65 + nl] = ok ? v[r] * (has ? sv[r] : 1.f) : 0.f;
  __syncthreads();
  const int nr = tid >> 2, ks = (tid & 3) * 16;
  if (t.nt * 64 + nr < t.Nd) {
    unsigned w[8];
#pragma unroll
    for (int i = 0; i < 8; ++i) w[i] = pk2(sm[(ks + 2 * i) * 65 + nr], sm[(ks + 2 * i + 1) * 65 + nr]);
    u32x4* d = (u32x4*)(t.dst + (size_t)(t.nt * 64 + nr) * t.K + t.kt * 64 + ks);
    d[0] = (u32x4){w[0], w[1], w[2], w[3]};
    d[1] = (u32x4){w[4], w[5], w[6], w[7]};
  }
  __syncthreads();
}

__device__ void phase_p0(const Params& p, unsigned char* smem) {
  float* sm = (float*)smem;
  const int tid = (opq(threadIdx.x) & 255), lane = tid & 63, wid = tid >> 6;
  {
    constexpr int NT = NL * (16 * 121 + 256 + 1024 + 1024 + 256 + 64);
    float v0[16], s0[16], v1[16], s1[16];
    int it = VB;
    WTile t0 = wtile_decode(p, it < NT ? it : 0);
    wtile_load(t0, v0, s0, tid);
    for (; it < NT; it += VG) {
      const int itn = it + VG < NT ? it + VG : it;
      const WTile t1 = wtile_decode(p, itn);
      wtile_load(t1, v1, s1, tid);
      wtile_store(t0, v0, s0, sm, tid);
      t0 = t1;
#pragma unroll
      for (int r = 0; r < 16; ++r) { v0[r] = v1[r]; s0[r] = s1[r]; }
    }
  }
  for (int it = VB; it < MTOK / 4; it += VG) {
    const int row = it * 4 + wid;
    const float* src = row < MP ? p.x_prompt + (size_t)row * DM : p.x_sample + (size_t)(row - MP) * DM;
    float* hd = p.out + (size_t)row * DM;
    bf16_t* hbd = p.hb() + (size_t)row * DM;
    float ss = 0.f;
#pragma unroll
    for (int i = 0; i < 4; ++i) {
      const int c = i * 256 + lane * 4;
      const f32x4 v = *(const f32x4*)(src + c);
      ss += v.x * v.x + v.y * v.y + v.z * v.z + v.w * v.w;
      *(f32x4*)(hd + c) = v;
      *(u32x2*)(hbd + c) = (u32x2){pk2(v.x, v.y), pk2(v.z, v.w)};
    }
#pragma unroll
    for (int o = 1; o < 64; o <<= 1) ss += shx(ss, o, lane);
    if (lane < 16) p.ssq0()[(size_t)row * 16 + lane] = lane == 0 ? ss : 0.f;
  }
  const int G = NL * MTOK * 32;
  for (int g = VB * NTHR + tid; g < G; g += VG * NTHR) {
    const int l = g / (MTOK * 32), rem = g % (MTOK * 32), row = rem >> 5, c8 = rem & 31;
    const float* src = row < MP ? p.p_prompt + ((size_t)(l * MP + row) * PLE + c8 * 8) : p.p_sample + ((size_t)(l * MS + row - MP) * PLE + c8 * 8);
    const f32x4 a = *(const f32x4*)src, b = *(const f32x4*)(src + 4);
    *(u32x4*)(p.pb() + (size_t)g * 8) = (u32x4){pk2(a.x, a.y), pk2(a.z, a.w), pk2(b.x, b.y), pk2(b.z, b.w)};
  }
}

enum { EPI_PROJ = 0, EPI_LOGIT = 1, EPI_RESID = 2, EPI_UP = 3, EPI_PLE = 4, EPI_PP = 5 };
struct EpiArgs {
  const float* ssq_in; float* ssq_out; float* h; bf16_t* hb; bf16_t* obf; int ldo; float* of32; const bf16_t* pp;
};

template <int EPI>
DEVI float epi_rs(const EpiArgs& e, int row) {
  if (EPI == EPI_PROJ || EPI == EPI_LOGIT || EPI == EPI_UP || EPI == EPI_PLE) {
    const f32x4* sp = (const f32x4*)(e.ssq_in + (size_t)row * 16);
    const f32x4 a = sp[0], b = sp[1], c = sp[2], d = sp[3];
    const float s = ((a.x + a.y) + (a.z + a.w)) + ((b.x + b.y) + (b.z + b.w)) + ((c.x + c.y) + (c.z + c.w)) + ((d.x + d.y) + (d.z + d.w));
    return rsqrtf(s * (1.f / 1024.f) + EPS);
  }
  return 1.f;
}
template <int EPI>
DEVI void epi_elem(const EpiArgs& e, int row, int col, f32x4 v, float rs, float& sq) {
  if (EPI == EPI_PROJ) {
    v *= rs;
    *(u32x2*)(e.obf + (size_t)row * e.ldo + col) = (u32x2){pk2(v.x, v.y), pk2(v.z, v.w)};
  } else if (EPI == EPI_LOGIT) {
    v *= rs;
    *(f32x4*)(e.of32 + (size_t)row * 16 + col) = v;
  } else if (EPI == EPI_PP) {
    *(u32x2*)(e.obf + (size_t)row * e.ldo + (col & 1023)) = (u32x2){pk2(v.x, v.y), pk2(v.z, v.w)};
  } else if (EPI == EPI_UP) {
    v *= rs;
    v.x = fmaxf(v.x, 0.f); v.y = fmaxf(v.y, 0.f); v.z = fmaxf(v.z, 0.f); v.w = fmaxf(v.w, 0.f);
    v = v * v;
    *(u32x2*)(e.obf + (size_t)row * e.ldo + col) = (u32x2){pk2(v.x, v.y), pk2(v.z, v.w)};
  } else {
    float* hp = e.h + (size_t)row * DM + col;
    f32x4 hv = *(const f32x4*)hp;
    if (EPI == EPI_RESID) {
      hv += v;
    } else {
      const u32x2 pv = *(const u32x2*)(e.pp + (size_t)row * DM + col);
      hv.x += sigm(v.x * rs) * lo2f(pv.x); hv.y += sigm(v.y * rs) * hi2f(pv.x);
      hv.z += sigm(v.z * rs) * lo2f(pv.y); hv.w += sigm(v.w * rs) * hi2f(pv.y);
    }
    *(f32x4*)hp = hv;
    *(u32x2*)(e.hb + (size_t)row * DM + col) = (u32x2){pk2(hv.x, hv.y), pk2(hv.z, hv.w)};
    sq += hv.x * hv.x + hv.y * hv.y + hv.z * hv.z + hv.w * hv.w;
  }
}

template <int EPI>
DEVI void epi_elem8(const EpiArgs& e, int row, int col, f32x4 v0, f32x4 v1, float rs, float& sq) {
  if (EPI == EPI_PROJ || EPI == EPI_UP || EPI == EPI_PP) {
    if (EPI != EPI_PP) { v0 *= rs; v1 *= rs; }
    if (EPI == EPI_UP) {
      v0.x = fmaxf(v0.x, 0.f); v0.y = fmaxf(v0.y, 0.f); v0.z = fmaxf(v0.z, 0.f); v0.w = fmaxf(v0.w, 0.f);
      v1.x = fmaxf(v1.x, 0.f); v1.y = fmaxf(v1.y, 0.f); v1.z = fmaxf(v1.z, 0.f); v1.w = fmaxf(v1.w, 0.f);
      v0 = v0 * v0; v1 = v1 * v1;
    }
    const int c = EPI == EPI_PP ? (col & 1023) : col;
    *(u32x4*)(e.obf + (size_t)row * e.ldo + c) = (u32x4){pk2(v0.x, v0.y), pk2(v0.z, v0.w), pk2(v1.x, v1.y), pk2(v1.z, v1.w)};
  } else {
    float* hp = e.h + (size_t)row * DM + col;
    f32x4 h0 = *(const f32x4*)hp, h1 = *(const f32x4*)(hp + 4);
    if (EPI == EPI_RESID) {
      h0 += v0; h1 += v1;
    } else {
      const u32x4 pv = *(const u32x4*)(e.pp + (size_t)row * DM + col);
      h0.x += sigm(v0.x * rs) * lo2f(pv.x); h0.y += sigm(v0.y * rs) * hi2f(pv.x);
      h0.z += sigm(v0.z * rs) * lo2f(pv.y); h0.w += sigm(v0.w * rs) * hi2f(pv.y);
      h1.x += sigm(v1.x * rs) * lo2f(pv.z); h1.y += sigm(v1.y * rs) * hi2f(pv.z);
      h1.z += sigm(v1.z * rs) * lo2f(pv.w); h1.w += sigm(v1.w * rs) * hi2f(pv.w);
    }
    *(f32x4*)hp = h0;
    *(f32x4*)(hp + 4) = h1;
    *(u32x4*)(e.hb + (size_t)row * DM + col) = (u32x4){pk2(h0.x, h0.y), pk2(h0.z, h0.w), pk2(h1.x, h1.y), pk2(h1.z, h1.w)};
    sq += (h0.x * h0.x + h0.y * h0.y + h0.z * h0.z + h0.w * h0.w) + (h1.x * h1.x + h1.y * h1.y + h1.z * h1.z + h1.w * h1.w);
  }
}

template <int WMT, int WNT, int WGM, int WGN, int EPI, int BK = 32, bool KSPLIT = false>
__device__ __forceinline__ void gemm_tile(const bf16_t* __restrict__ A, int lda, const bf16_t* __restrict__ Bt, int ldb, int K, int m0, int n0,
                                          bf16_t* lds, const EpiArgs& e) {
  constexpr int BM = WGM * WMT * 16, BN = WGN * WNT * 16, LDR = BK + 8;
  constexpr int STAGE = (BM + BN) * LDR;
  constexpr int PPR = BK / 8, RPI = NTHR / PPR;
  constexpr int NA = BM / RPI, NB = (BN + RPI - 1) / RPI;
  const int tid = (opq(threadIdx.x) & 255), lane = tid & 63, wid = tid >> 6;
  const int wm = wid / WGN, wn = wid % WGN;
  const int fr = lane & 15, fq = lane >> 4;
  f32x4 acc[WMT][WNT];
#pragma unroll
  for (int i = 0; i < WMT; ++i)
#pragma unroll
    for (int j = 0; j < WNT; ++j) acc[i][j] = (f32x4){0.f, 0.f, 0.f, 0.f};
  u32x4 ra0[NA], rb0[NB], ra1[NA], rb1[NB];
  const int khalf = KSPLIT ? VHALF : 0;
  const int nk = (KSPLIT ? K / 2 : K) / BK;
  const int prow = tid / PPR, ppc = tid % PPR;
  const unsigned ta = (unsigned)(prow * lda + ppc * 8) * 2u, tb = (unsigned)(prow * ldb + ppc * 8) * 2u;
  const char* Au = (const char*)(A + (size_t)m0 * lda + (size_t)khalf * (K / 2));
  const char* Bu = (const char*)(Bt + (size_t)n0 * ldb + (size_t)khalf * (K / 2));
#define BGUARD(i) (BN >= RPI * ((i) + 1) || prow + (i) * RPI < BN)
#define GLOAD(kt, RA, RB) do { \
    _Pragma("unroll") for (int i = 0; i < NA; ++i) RA[i] = *(const u32x4*)(Au + ((size_t)i * RPI * lda + (size_t)(kt) * BK) * 2 + ta); \
    _Pragma("unroll") for (int i = 0; i < NB; ++i) if (BGUARD(i)) RB[i] = *(const u32x4*)(Bu + ((size_t)i * RPI * ldb + (size_t)(kt) * BK) * 2 + tb); \
  } while (0)
#define LSTORE(st, RA, RB) do { bf16_t* sA_ = lds + (st) * STAGE; bf16_t* sB_ = sA_ + BM * LDR; \
    _Pragma("unroll") for (int i = 0; i < NA; ++i) *(u32x4*)(sA_ + (prow + i * RPI) * LDR + ppc * 8) = RA[i]; \
    _Pragma("unroll") for (int i = 0; i < NB; ++i) if (BGUARD(i)) *(u32x4*)(sB_ + (prow + i * RPI) * LDR + ppc * 8) = RB[i]; \
  } while (0)
#define COMPUTE(st) do { const bf16_t* sA = lds + (st) * STAGE; const bf16_t* sB = sA + BM * LDR; \
    _Pragma("unroll") for (int kk = 0; kk < BK / 32; ++kk) { \
      bf16x8 bfr[WNT]; \
      _Pragma("unroll") for (int nt = 0; nt < WNT; ++nt) bfr[nt] = *(const bf16x8*)(sB + (wn * WNT * 16 + nt * 16 + fr) * LDR + kk * 32 + fq * 8); \
      _Pragma("unroll") for (int mt = 0; mt < WMT; ++mt) { \
        const bf16x8 af = *(const bf16x8*)(sA + (wm * WMT * 16 + mt * 16 + fr) * LDR + kk * 32 + fq * 8); \
        _Pragma("unroll") for (int nt = 0; nt < WNT; ++nt) acc[mt][nt] = mfma16(bfr[nt], af, acc[mt][nt]); } } \
  } while (0)
  GLOAD(0, ra0, rb0);
  GLOAD(1, ra1, rb1);
  LSTORE(0, ra0, rb0);
  __syncthreads();
  for (int kt = 0; kt < nk; kt += 2) {
    const int k2 = kt + 2 < nk ? kt + 2 : nk - 2;
    GLOAD(k2, ra0, rb0);
    COMPUTE(0);
    LSTORE(1, ra1, rb1);
    __syncthreads();
    GLOAD(k2 + 1, ra1, rb1);
    COMPUTE(1);
    LSTORE(0, ra0, rb0);
    __syncthreads();
  }
#undef BGUARD
#undef COMPUTE
#undef GLOAD
#undef LSTORE
  if (KSPLIT) {
    f32x4* red = (f32x4*)((unsigned char*)lds + (khalf ? 0 : SMEM_BYTES));
    if (khalf == 1) {
#pragma unroll
      for (int i = 0; i < WMT; ++i)
#pragma unroll
        for (int j = 0; j < WNT; ++j) red[((wid * WMT + i) * WNT + j) * 64 + lane] = acc[i][j];
    }
    __syncthreads();
    if (khalf == 0) {
#pragma unroll
      for (int i = 0; i < WMT; ++i)
#pragma unroll
        for (int j = 0; j < WNT; ++j) acc[i][j] += red[((wid * WMT + i) * WNT + j) * 64 + lane];
    }
  }
  if (!KSPLIT || khalf == 0) {
#pragma unroll
  for (int mt = 0; mt < WMT; ++mt) {
    const int row = m0 + wm * WMT * 16 + mt * 16 + fr;
    const float rs = epi_rs<EPI>(e, row);
    float sq = 0.f;
#pragma unroll
    for (int nt = 0; nt < WNT; ++nt) epi_elem<EPI>(e, row, n0 + wn * WNT * 16 + nt * 16 + fq * 4, acc[mt][nt], rs, sq);
    if (EPI == EPI_RESID || EPI == EPI_PLE) {
      sq += shx(sq, 16, lane);
      sq += shx(sq, 32, lane);
      if (fq == 0) e.ssq_out[(size_t)row * 16 + (n0 / BN) * WGN + wn] = sq;
    }
  }
  }
  if (KSPLIT) __syncthreads();
}

namespace pg8 {
#define PG8_LAS __attribute__((address_space(3)))
typedef unsigned short bf16_t;
typedef short bf16x8 __attribute__((ext_vector_type(8)));
typedef float f32x4 __attribute__((ext_vector_type(4)));
typedef unsigned u32x4 __attribute__((ext_vector_type(4)));
constexpr int BM = 256, BK = 64, HALF = 128, HTB = HALF * BK * 2  , STAGE_BYTES = 8 * HTB, NXCD = 8, WGM = 8;

__host__ __device__ __forceinline__ int lds_byte(int r, int c) { const int st = (r >> 4) * 2 + (c >> 5), rr = r & 15, cc = c & 31, ob = rr * 64 + cc * 2; return st * 1024 + (ob ^ (((ob >> 9) & 1) << 5)); }
__host__ __device__ __forceinline__ void stage_rc(int b, int& R, int& C) { const int st = b / 1024, sb = b % 1024, swz = sb ^ (((sb >> 9) & 1) << 5); R = (st >> 1) * 16 + swz / 64; C = (st & 1) * 32 + (swz % 64) / 2; }
__host__ __device__ __forceinline__ int perm32(int rho) { const int n = rho >> 4, i = rho & 15; return 8 * (i >> 2) + 4 * n + (i & 3); }

struct Unit { int pm, pn; };
struct Gemm { const bf16_t* A; const bf16_t* Bt; int M, N, K; };

template <class Epi, class Sched, bool STAMP = false>
__device__ __forceinline__ void gemm_phase(PG8_LAS unsigned char* lds, const Gemm g, const Sched& S, const Epi& E, unsigned long long* stamps) {
    const int tid = opq((int)threadIdx.x), wid = __builtin_amdgcn_readfirstlane(tid >> 6), lane = tid & 63, wr = wid >> 2, wc = wid & 3, fr = lane & 15, fq = lane >> 4;
    const int K = g.K, nt = K / BK;
    int ts_lo = 0, ts_hi = 0, nts = 0; const unsigned long long rt_entry = STAMP ? (unsigned long long)wall_clock64() : 0ull;
#define PG8_STAMP() do { if (STAMP && wid == 0 && nts < 64) { const unsigned long long _c = (unsigned long long)clock64(); \
        ts_lo = (lane == nts) ? (int)(unsigned)_c : ts_lo; ts_hi = (lane == nts) ? (int)(unsigned)(_c >> 32) : ts_hi; ++nts; } } while (0)
    PG8_STAMP();
    unsigned voffA[2], voffB[2];
#pragma unroll
    for (int i = 0; i < 2; ++i) { int R, C; stage_rc(tid * 16 + i * 8192, R, C); const int Rb = Epi::PERM ? ((R & ~31) + perm32(R & 31)) : R;
        voffA[i] = (unsigned)(R * K + C) * 2u; voffB[i] = (unsigned)(Rb * K + C) * 2u; }
    const size_t kstep = (size_t)(BK * 2);
    const size_t hstep = (size_t)HALF * K * 2;
    const size_t tstep = 2 * hstep;
    const unsigned ldsw = (unsigned)wid * 1024u;
    const int aoff = lds_byte(wr * 64 + fr, fq * 8), boff = lds_byte(wc * 32 + fr, fq * 8);
#define PG8_SA(b, h) (((b) * 2 + (h)) * HTB)
#define PG8_SB(b, h) ((4 + (b) * 2 + (h)) * HTB)
#define PG8_STAGE(bufoff, gbase, voff) do { _Pragma("unroll") for (int _i = 0; _i < 2; ++_i) \
        __builtin_amdgcn_global_load_lds((const unsigned*)((const char*)(gbase) + (voff)[_i]), (PG8_LAS unsigned*)(lds + (bufoff) + ldsw + _i * 8192), 16, 0, 0); } while (0)
#define PG8_LDA(dst, b, h) do { _Pragma("unroll") for (int m = 0; m < 4; ++m) _Pragma("unroll") for (int k = 0; k < 2; ++k) dst[m][k] = *(const PG8_LAS bf16x8*)(lds + PG8_SA(b, h) + aoff + m * 2048 + k * 1024); } while (0)
#define PG8_LDB(dst, b, h) do { _Pragma("unroll") for (int n = 0; n < 2; ++n) _Pragma("unroll") for (int k = 0; k < 2; ++k) dst[n][k] = *(const PG8_LAS bf16x8*)(lds + PG8_SB(b, h) + boff + n * 2048 + k * 1024); } while (0)
#define PG8_MMA(ai, bj, At, Bt) do { __builtin_amdgcn_s_setprio(1); _Pragma("unroll") for (int m = 0; m < 4; ++m) _Pragma("unroll") for (int n = 0; n < 2; ++n) _Pragma("unroll") for (int k = 0; k < 2; ++k) \
        acc[ai][bj][m][n] = __builtin_amdgcn_mfma_f32_16x16x32_bf16(Bt[n][k], At[m][k], acc[ai][bj][m][n], 0, 0, 0); __builtin_amdgcn_s_setprio(0); } while (0)
#define PG8_WAIT_V(n) asm volatile("s_waitcnt vmcnt(" #n ")" ::: "memory")
#define PG8_WAIT_L(n) asm volatile("s_waitcnt lgkmcnt(" #n ")" ::: "memory")
#define PG8_BAR __builtin_amdgcn_s_barrier()
#define PG8_SCHED __builtin_amdgcn_sched_barrier(0)
    Unit cur, nxt; int ui = 0;
    if (!S.next(0, cur)) return;
    f32x4 acc[2][2][4][2];
#pragma unroll
    for (int a = 0; a < 2; ++a)
#pragma unroll
        for (int b = 0; b < 2; ++b)
#pragma unroll
            for (int m = 0; m < 4; ++m)
#pragma unroll
                for (int n = 0; n < 2; ++n) acc[a][b][m][n] = (f32x4){0.f, 0.f, 0.f, 0.f};
    bf16x8 At[4][2], B0[2][2], B1[2][2];
    const char* cA = (const char*)g.A + (size_t)cur.pm * tstep; const char* cB = (const char*)g.Bt + (size_t)cur.pn * tstep;
    S.a_ready(cur);
    PG8_STAGE(PG8_SB(0, 0), cB, voffB); PG8_STAGE(PG8_SA(0, 0), cA, voffA); PG8_STAGE(PG8_SB(0, 1), cB + hstep, voffB); PG8_STAGE(PG8_SA(0, 1), cA + hstep, voffA);
    if (wr == 1) PG8_BAR;
    PG8_WAIT_V(4); PG8_BAR;
    PG8_STAGE(PG8_SB(1, 0), cB + kstep, voffB); PG8_STAGE(PG8_SA(1, 0), cA + kstep, voffA); PG8_STAGE(PG8_SB(1, 1), cB + hstep + kstep, voffB);
    PG8_WAIT_V(6); PG8_BAR;
    PG8_STAMP();
    for (;;) {
        const bool has_next = S.next(ui + 1, nxt);
        const char* nA = has_next ? (const char*)g.A + (size_t)nxt.pm * tstep : cA; const char* nB = has_next ? (const char*)g.Bt + (size_t)nxt.pn * tstep : cB;
        for (int t = 0; t < nt; t += 2) {
            const bool last = (t == nt - 2);
            const char* a1 = cA + (size_t)(t + 1) * kstep;
            const char* a2 = last ? nA : cA + (size_t)(t + 2) * kstep; const char* b2 = last ? nB : cB + (size_t)(t + 2) * kstep;
            const char* a3 = a2 + kstep; const char* b3 = b2 + kstep;
            if (last && has_next) S.a_ready(nxt);
            PG8_LDB(B0, 0, 0); PG8_SCHED; PG8_LDA(At, 0, 0); PG8_STAGE(PG8_SA(1, 1), a1 + hstep, voffA);
            PG8_WAIT_L(8); PG8_BAR; PG8_WAIT_L(0); PG8_MMA(0, 0, At, B0); PG8_BAR; PG8_SCHED;
            PG8_LDB(B1, 0, 1); PG8_STAGE(PG8_SB(0, 0), b2, voffB);
            PG8_BAR; PG8_WAIT_L(0); PG8_MMA(0, 1, At, B1); PG8_BAR;
            PG8_LDA(At, 0, 1); PG8_STAGE(PG8_SA(0, 0), a2, voffA);
            PG8_BAR; PG8_WAIT_L(0); PG8_MMA(1, 0, At, B0); PG8_BAR; PG8_SCHED;
            PG8_STAGE(PG8_SB(0, 1), b2 + hstep, voffB);
            PG8_WAIT_V(6); PG8_BAR; PG8_MMA(1, 1, At, B1); PG8_BAR;
            PG8_LDB(B0, 1, 0); PG8_SCHED; PG8_LDA(At, 1, 0); PG8_STAGE(PG8_SA(0, 1), a2 + hstep, voffA);
            PG8_WAIT_L(8); PG8_BAR; PG8_WAIT_L(0); PG8_MMA(0, 0, At, B0); PG8_BAR; PG8_SCHED;
            PG8_LDB(B1, 1, 1); PG8_STAGE(PG8_SB(1, 0), b3, voffB);
            PG8_BAR; PG8_WAIT_L(0); PG8_MMA(0, 1, At, B1); PG8_BAR;
            PG8_LDA(At, 1, 1); PG8_STAGE(PG8_SA(1, 0), a3, voffA);
            PG8_BAR; PG8_WAIT_L(0); PG8_MMA(1, 0, At, B0); PG8_BAR; PG8_SCHED;
            PG8_STAGE(PG8_SB(1, 1), b3 + hstep, voffB);
            PG8_WAIT_V(6); PG8_BAR; PG8_MMA(1, 1, At, B1); PG8_BAR;
        }
        PG8_STAMP();
        if constexpr (!Epi::AFTER_DRAIN) { E(acc, cur, wr, wc, fr, fq); S.done(cur); }
        PG8_STAMP();
        if (!has_next) break;
#pragma unroll
        for (int a = 0; a < 2; ++a)
#pragma unroll
            for (int b = 0; b < 2; ++b)
#pragma unroll
                for (int m = 0; m < 4; ++m)
#pragma unroll
                    for (int n = 0; n < 2; ++n) acc[a][b][m][n] = (f32x4){0.f, 0.f, 0.f, 0.f};
        cur = nxt; cA = nA; cB = nB; ++ui;
    }
    PG8_WAIT_V(0);
    if (wr == 0) PG8_BAR;
    PG8_BAR;
    if constexpr (Epi::AFTER_DRAIN) { E.fused(acc, cur, wr, wc, fr, fq, lds, wid, lane); S.done(cur); }
    PG8_STAMP();
    if (STAMP && wid == 0) { stamps[lane] = lane < nts ? (((unsigned long long)(unsigned)ts_hi << 32) | (unsigned)ts_lo) : 0ull;
        if (lane == 62) stamps[62] = rt_entry; if (lane == 63) stamps[63] = (unsigned long long)wall_clock64(); }
#undef PG8_STAMP
#undef PG8_SA
#undef PG8_SB
#undef PG8_STAGE
#undef PG8_LDA
#undef PG8_LDB
#undef PG8_MMA
#undef PG8_WAIT_V
#undef PG8_WAIT_L
#undef PG8_BAR
#undef PG8_SCHED
}
}

DEVI void unit_map(int L, int nM, int nN, int& pm, int& pn) {
  const int nwg = nM * nN, q = nwg / 8, r = nwg % 8, xcd = L % 8, off = L / 8;
  const int wgid = (xcd < r ? xcd * (q + 1) : r * (q + 1) + (xcd - r) * q) + off;
  const int nig = 8 * nN, gid = wgid / nig, fm = gid * 8, gsz = (nM - fm) < 8 ? (nM - fm) : 8, w = wgid - gid * nig;
  pm = fm + (w % gsz); pn = w / gsz;
}
struct RowSched {
  int nM, nN, nLimit, G, c;
  __device__ __forceinline__ bool next(int i, pg8::Unit& u) const { const int L = i * G + c; if (L >= nLimit) return false; unit_map(L, nM, nN, u.pm, u.pn); return true; }
  __device__ __forceinline__ void a_ready(const pg8::Unit&) const {}
  __device__ __forceinline__ void done(const pg8::Unit&) const {}
};
struct DiagSched {
  int nLimit, G, c;
  __device__ __forceinline__ bool next(int i, pg8::Unit& u) const { const int L = i * G + c; if (L >= nLimit) return false; const int l = L / 272, r = L - l * 272; u.pm = l * 68 + (r >> 2); u.pn = l * 4 + (r & 3); return true; }
  __device__ __forceinline__ void a_ready(const pg8::Unit&) const {}
  __device__ __forceinline__ void done(const pg8::Unit&) const {}
};
template <int EPI> struct BigEpi {
  static constexpr bool PERM = true, AFTER_DRAIN = false;
  EpiArgs e;
  __device__ __forceinline__ void operator()(const f32x4 (&acc)[2][2][4][2], const pg8::Unit& u, int wr, int wc, int fr, int fq) const {
    const int lane = fq * 16 + fr;
#pragma unroll
    for (int ai = 0; ai < 2; ++ai)
#pragma unroll
      for (int m = 0; m < 4; ++m) {
        const int row = u.pm * 256 + ai * 128 + wr * 64 + m * 16 + fr;
        const float rs = epi_rs<EPI>(e, row);
        float sq = 0.f;
#pragma unroll
        for (int bj = 0; bj < 2; ++bj) epi_elem8<EPI>(e, row, u.pn * 256 + bj * 128 + wc * 32 + fq * 8, acc[ai][bj][m][0], acc[ai][bj][m][1], rs, sq);
        if (EPI == EPI_RESID || EPI == EPI_PLE) {
          sq += shx(sq, 16, lane);
          sq += shx(sq, 32, lane);
          if (fq == 0) e.ssq_out[(size_t)row * 16 + u.pn * 4 + wc] = sq;
        }
      }
  }
};

template <int EPI>
__device__ void gemm_big_phase(const bf16_t* A, const bf16_t* Bt, int K, int M, int N, unsigned char* lds_all, unsigned char* smem_half, const EpiArgs& e) {
  const int nM = M / 256, nN = N / 256, nU = nM * nN, G = gridDim.x;
  const int L = nU % G;
  const int nLimit = (L > 0 && L <= G / 4) ? nU - L : nU;
  RowSched S; S.nM = nM; S.nN = nN; S.nLimit = nLimit; S.G = G; S.c = blockIdx.x;
  pg8::Gemm g; g.A = A; g.Bt = Bt; g.M = M; g.N = N; g.K = K;
  BigEpi<EPI> E; E.e = e;
  pg8::gemm_phase<BigEpi<EPI>, RowSched>((PG8_LAS unsigned char*)lds_all, g, S, E, nullptr);
  __syncthreads();
  const int nSmall = (nU - nLimit) * 16;
  if (nSmall <= G && K >= 512) {
    for (int st = blockIdx.x; st < nSmall; st += G) {
      const int sub = st & 15; int pm, pn; unit_map(nLimit + (st >> 4), nM, nN, pm, pn);
      gemm_tile<1, 4, 4, 1, EPI, 128, true>(A, K, Bt, K, K, pm * 256 + (sub >> 2) * 64, pn * 256 + (sub & 3) * 64, (bf16_t*)smem_half, e);
    }
  } else {
    for (int st = VB; st < nSmall; st += VG) {
      const int sub = st & 15; int pm, pn; unit_map(nLimit + (st >> 4), nM, nN, pm, pn);
      gemm_tile<1, 4, 4, 1, EPI, 128>(A, K, Bt, K, K, pm * 256 + (sub >> 2) * 64, pn * 256 + (sub & 3) * 64, (bf16_t*)smem_half, e);
    }
  }
}


template <int I, int J4>
DEVI void solve_sub4(float& r, const float (&x)[64], const float* Am) {
  if constexpr (J4 * 4 < I) {
    const f32x4 a = *(const f32x4*)(Am + I * 64 + J4 * 4);
    if constexpr (J4 * 4 + 0 < I) r -= a.x * x[J4 * 4 + 0];
    if constexpr (J4 * 4 + 1 < I) r -= a.y * x[J4 * 4 + 1];
    if constexpr (J4 * 4 + 2 < I) r -= a.z * x[J4 * 4 + 2];
    if constexpr (J4 * 4 + 3 < I) r -= a.w * x[J4 * 4 + 3];
    solve_sub4<I, J4 + 1>(r, x, Am);
  }
}
template <int I>
DEVI void solve_rows(float (&x)[64], const float* Am, const bf16_t* src, const float* sc) {
  if constexpr (I < 64) {
    float r = bf2f(src[I * 136]) * sc[I];
    solve_sub4<I, 0>(r, x, Am);
    x[I] = r;
    asm volatile("" ::: "memory");
    solve_rows<I + 1>(x, Am, src, sc);
  }
}

__device__ void gdn_prep_item(const Params& p, int l, int item, unsigned char* smem) {
  const int tid = (opq(threadIdx.x) & 255), lane = tid & 63, wid = tid >> 6, fr = lane & 15, fq = lane >> 4;
  const int h = item & 7, n = (item >> 3) & 31, b = item >> 8;
  const int tok0 = b * 2048 + n * 64;
  bf16_t* qh = (bf16_t*)smem;
  bf16_t* kh = qh + 64 * 136;
  bf16_t* vh = kh + 64 * 136;
  float* Am = (float*)(vh + 64 * 136);
  float* sbeta = Am + 64 * 64;
  float* sgc = sbeta + 64;
  float* sbe = sgc + 64;
  unsigned char* scr = (unsigned char*)p.scr() + (size_t)item * SCR_ITEM;
  bf16_t* g_uT = (bf16_t*)scr;
  bf16_t* g_w = (bf16_t*)(scr + 16384);
  bf16_t* g_qg = (bf16_t*)(scr + 32768);
  bf16_t* g_kgT = (bf16_t*)(scr + 49152);
  bf16_t* g_qk = (bf16_t*)(scr + 65536);

  if (wid == 0) {
    const float* lg = p.logits() + (size_t)(tok0 + lane) * 16;
    const float bl = lg[h], al = lg[8 + h];
    const float x = al + p.dt_bias[l * 8 + h];
    const float sp = softplus_f(x);
    float g = -__expf(p.a_log[l * 8 + h]) * sp;
#pragma unroll
    for (int o = 1; o < 64; o <<= 1) { const float t = shup(g, o, lane); if (lane >= o) g += t; }
    sbeta[lane] = sigm(bl);
    sgc[lane] = g;
    sbe[lane] = sigm(bl) * __expf(g);
  }
  u32x4 rwall[3][7];
#pragma unroll
  for (int sect = 0; sect < 3; ++sect)
#pragma unroll
    for (int r = 0; r < 7; ++r) {
      const int tl = n * 64 + wid * 16 + fq * 4 - 3 + r;
      rwall[sect][r] = (u32x4){0u, 0u, 0u, 0u};
      if (tl >= 0) rwall[sect][r] = *(const u32x4*)(p.proj() + (size_t)(b * 2048 + tl) * NPJ + sect * 1024 + h * 128 + fr * 8);
    }
#pragma unroll
  for (int sect = 0; sect < 3; ++sect) {
    const int ch0 = sect * 1024 + h * 128 + fr * 8;
    float cw[4][8];
#pragma unroll
    for (int j = 0; j < 4; ++j) {
      const f32x4 a = *(const f32x4*)(p.conv_w + (size_t)(l * 4 + j) * 3072 + ch0), c = *(const f32x4*)(p.conv_w + (size_t)(l * 4 + j) * 3072 + ch0 + 4);
      cw[j][0] = a.x; cw[j][1] = a.y; cw[j][2] = a.z; cw[j][3] = a.w; cw[j][4] = c.x; cw[j][5] = c.y; cw[j][6] = c.z; cw[j][7] = c.w;
    }
    const int ib = wid * 16 + fq * 4;
#pragma unroll
    for (int it = 0; it < 4; ++it) {
      float o[8];
#pragma unroll
      for (int c = 0; c < 8; ++c) o[c] = 0.f;
#pragma unroll
      for (int j = 0; j < 4; ++j) {
        float f[8];
        UNPACK8(rwall[sect][it + j], f);
#pragma unroll
        for (int c = 0; c < 8; ++c) o[c] += f[c] * cw[j][c];
      }
      float ss = 0.f;
#pragma unroll
      for (int c = 0; c < 8; ++c) { o[c] = silu(o[c]); ss += o[c] * o[c]; }
      if (sect < 2) {
        ss += shx(ss, 1, lane); ss += shx(ss, 2, lane); ss += shx(ss, 4, lane); ss += shx(ss, 8, lane);
        float rn = rsqrtf(ss + EPS);
        if (sect == 0) rn *= 0.08838834764831845f;
#pragma unroll
        for (int c = 0; c < 8; ++c) o[c] *= rn;
      }
      const u32x4 pk = (u32x4){pk2(o[0], o[1]), pk2(o[2], o[3]), pk2(o[4], o[5]), pk2(o[6], o[7])};
      bf16_t* dst = sect == 0 ? qh + (ib + it) * 136 + fr * 8 : (sect == 1 ? kh + (ib + it) * 136 + fr * 8 : vh + (ib + it) * 136 + fr * 8);
      *(u32x4*)dst = pk;
    }
  }
  __syncthreads();
  {
    const int i = wid * 16 + fr;
    const float gi = sgc[i], bi = sbeta[i];
    bf16x8 kx[4], qx[4];
#pragma unroll
    for (int ks = 0; ks < 4; ++ks) {
      kx[ks] = *(const bf16x8*)(kh + i * 136 + ks * 32 + fq * 8);
      qx[ks] = *(const bf16x8*)(qh + i * 136 + ks * 32 + fq * 8);
    }
#pragma unroll
    for (int jt = 0; jt < 4; ++jt) {
      f32x4 akk = (f32x4){0.f, 0.f, 0.f, 0.f}, aqk = (f32x4){0.f, 0.f, 0.f, 0.f};
      if (jt <= wid) {
#pragma unroll
        for (int ks = 0; ks < 4; ++ks) {
          const bf16x8 kj = *(const bf16x8*)(kh + (jt * 16 + fr) * 136 + ks * 32 + fq * 8);
          akk = mfma16(kj, kx[ks], akk);
          aqk = mfma16(kj, qx[ks], aqk);
        }
      }
      const int j0 = jt * 16 + fq * 4;
      float av[4], qv[4];
#pragma unroll
      for (int jj = 0; jj < 4; ++jj) {
        const int j = j0 + jj;
        const float dec = j <= i ? __expf(gi - sgc[j]) : 0.f;
        av[jj] = j < i ? bi * akk[jj] * dec : 0.f;
        qv[jj] = aqk[jj] * dec;
      }
      *(f32x4*)(Am + i * 64 + j0) = (f32x4){av[0], av[1], av[2], av[3]};
      *(u32x2*)(g_qk + i * 64 + j0) = (u32x2){pk2(qv[0], qv[1]), pk2(qv[2], qv[3])};
    }
  }
  __syncthreads();
  {
    float x[64];
    const bool isu = tid < 128;
    const int cc = tid & 127;
    solve_rows<0>(x, Am, (isu ? vh : kh) + cc, isu ? sbeta : sbe);
    if (isu) {
      u32x4* d = (u32x4*)(g_uT + cc * 64);
#pragma unroll
      for (int q = 0; q < 8; ++q) d[q] = (u32x4){pk2(x[q * 8], x[q * 8 + 1]), pk2(x[q * 8 + 2], x[q * 8 + 3]), pk2(x[q * 8 + 4], x[q * 8 + 5]), pk2(x[q * 8 + 6], x[q * 8 + 7])};
    } else {
#pragma unroll
      for (int i = 0; i < 64; ++i) g_w[i * 128 + cc] = f2bf(x[i]);
    }
  }
  {
    const float gl = sgc[63];
#pragma unroll
    for (int q = 0; q < 4; ++q) {
      const int pc = tid + q * 256, i = pc >> 4, c8 = pc & 15;
      const u32x4 v = *(const u32x4*)(qh + i * 136 + c8 * 8);
      float f[8];
      UNPACK8(v, f);
      const float s = __expf(sgc[i]);
      *(u32x4*)(g_qg + i * 128 + c8 * 8) = (u32x4){pk2(f[0] * s, f[1] * s), pk2(f[2] * s, f[3] * s), pk2(f[4] * s, f[5] * s), pk2(f[6] * s, f[7] * s)};
    }
    if (tid >= 128) {
      const int dk = tid - 128;
      u32x4* d = (u32x4*)(g_kgT + dk * 64);
#pragma unroll
      for (int q = 0; q < 8; ++q) {
        float f[8];
#pragma unroll
        for (int c = 0; c < 8; ++c) { const int i = q * 8 + c; f[c] = bf2f(kh[i * 136 + dk]) * __expf(gl - sgc[i]); }
        d[q] = (u32x4){pk2(f[0], f[1]), pk2(f[2], f[3]), pk2(f[4], f[5]), pk2(f[6], f[7])};
      }
    }
    if (tid == 0) p.gsc()[item] = __expf(gl);
  }
  __syncthreads();
}

__device__ void gdn_scan_item(const Params& p, int l, int item, unsigned char* smem) {
  const int tid = (opq(threadIdx.x) & 255), lane = tid & 63, wid = tid >> 6, fr = lane & 15, fq = lane >> 4;
  const int dvs = item & 3, h = (item >> 2) & 7, b = item >> 5;
  bf16_t* ST = (bf16_t*)smem;
  bf16_t* VT = ST + 2 * 32 * 136;
  f32x4 S[2][2];
#pragma unroll
  for (int a = 0; a < 2; ++a)
#pragma unroll
    for (int c = 0; c < 2; ++c) S[a][c] = (f32x4){0.f, 0.f, 0.f, 0.f};
  __syncthreads();
  bf16x8 fw[4], fqg[4], fqk[2], fkg[2][2];
  u32x2 fu[2];
  float gs;
  bf16x8 nw[4], nqg[4], nqk[2], nkg[2][2];
  u32x2 nu[2];
  float ngs;
#define SCAN_LOAD(n_, W, QG, QK, KG, U, GS) do { \
    const int it_ = ((b * 32 + (n_)) << 3) + h; \
    const unsigned char* scr_ = (const unsigned char*)p.scr() + (size_t)it_ * SCR_ITEM; \
    const bf16_t* g_uT = (const bf16_t*)scr_; const bf16_t* g_w = (const bf16_t*)(scr_ + 16384); const bf16_t* g_qg = (const bf16_t*)(scr_ + 32768); \
    const bf16_t* g_kgT = (const bf16_t*)(scr_ + 49152); const bf16_t* g_qk = (const bf16_t*)(scr_ + 65536); \
    _Pragma("unroll") for (int ks = 0; ks < 4; ++ks) { \
      W[ks] = *(const bf16x8*)(g_w + (wid * 16 + fr) * 128 + ks * 32 + fq * 8); \
      QG[ks] = *(const bf16x8*)(g_qg + (wid * 16 + fr) * 128 + ks * 32 + fq * 8); } \
    _Pragma("unroll") for (int ks = 0; ks < 2; ++ks) { \
      QK[ks] = *(const bf16x8*)(g_qk + (wid * 16 + fr) * 64 + ks * 32 + fq * 8); \
      _Pragma("unroll") for (int mt = 0; mt < 2; ++mt) KG[mt][ks] = *(const bf16x8*)(g_kgT + ((2 * wid + mt) * 16 + fr) * 64 + ks * 32 + fq * 8); } \
    _Pragma("unroll") for (int nt = 0; nt < 2; ++nt) U[nt] = *(const u32x2*)(g_uT + (dvs * 32 + nt * 16 + fr) * 64 + wid * 16 + fq * 4); \
    GS = p.gsc()[it_]; } while (0)
  SCAN_LOAD(0, nw, nqg, nqk, nkg, nu, ngs);
  for (int n = 0; n < 32; ++n) {
#pragma unroll
    for (int ks = 0; ks < 4; ++ks) { fw[ks] = nw[ks]; fqg[ks] = nqg[ks]; }
#pragma unroll
    for (int ks = 0; ks < 2; ++ks) { fqk[ks] = nqk[ks]; fkg[0][ks] = nkg[0][ks]; fkg[1][ks] = nkg[1][ks]; }
    fu[0] = nu[0]; fu[1] = nu[1]; gs = ngs;
    if (n + 1 < 32) SCAN_LOAD(n + 1, nw, nqg, nqk, nkg, nu, ngs);
    bf16_t* STc = ST + (n & 1) * 32 * 136;
#pragma unroll
    for (int mt = 0; mt < 2; ++mt)
#pragma unroll
      for (int nt = 0; nt < 2; ++nt)
        *(u32x2*)(STc + (nt * 16 + fr) * 136 + (2 * wid + mt) * 16 + fq * 4) = (u32x2){pk2(S[mt][nt].x, S[mt][nt].y), pk2(S[mt][nt].z, S[mt][nt].w)};
    __syncthreads();
#pragma unroll
    for (int nt = 0; nt < 2; ++nt) {
      f32x4 a = (f32x4){0.f, 0.f, 0.f, 0.f};
#pragma unroll
      for (int ks = 0; ks < 4; ++ks) {
        const bf16x8 sb = *(const bf16x8*)(STc + (nt * 16 + fr) * 136 + ks * 32 + fq * 8);
        a = mfma16(fw[ks], sb, a);
      }
      const float v0 = lo2f(fu[nt].x) - a.x, v1 = hi2f(fu[nt].x) - a.y, v2 = lo2f(fu[nt].y) - a.z, v3 = hi2f(fu[nt].y) - a.w;
      *(u32x2*)(VT + (nt * 16 + fr) * 72 + wid * 16 + fq * 4) = (u32x2){pk2(v0, v1), pk2(v2, v3)};
    }
    __syncthreads();
#pragma unroll
    for (int mt = 0; mt < 2; ++mt) {
      f32x4 a = (f32x4){0.f, 0.f, 0.f, 0.f};
#pragma unroll
      for (int ks = 0; ks < 4; ++ks) {
        const bf16x8 sa = *(const bf16x8*)(STc + (mt * 16 + fr) * 136 + ks * 32 + fq * 8);
        a = mfma16(sa, fqg[ks], a);
      }
#pragma unroll
      for (int ks = 0; ks < 2; ++ks) {
        const bf16x8 va = *(const bf16x8*)(VT + (mt * 16 + fr) * 72 + ks * 32 + fq * 8);
        a = mfma16(va, fqk[ks], a);
      }
      const size_t row = (size_t)b * 2048 + n * 64 + wid * 16 + fr;
      *(u32x2*)(p.ogdn() + row * DM + h * 128 + dvs * 32 + mt * 16 + fq * 4) = (u32x2){pk2(a.x, a.y), pk2(a.z, a.w)};
    }
#pragma unroll
    for (int mt = 0; mt < 2; ++mt)
#pragma unroll
      for (int nt = 0; nt < 2; ++nt) {
        f32x4 a = S[mt][nt] * gs;
#pragma unroll
        for (int ks = 0; ks < 2; ++ks) {
          const bf16x8 vb = *(const bf16x8*)(VT + (nt * 16 + fr) * 72 + ks * 32 + fq * 8);
          a = mfma16(fkg[mt][ks], vb, a);
        }
        S[mt][nt] = a;
      }
  }
  float* so = p.out + O_GDNP + ((size_t)(l * 8 + b) * 8 + h) * 16384;
#pragma unroll
  for (int mt = 0; mt < 2; ++mt)
#pragma unroll
    for (int nt = 0; nt < 2; ++nt)
#pragma unroll
      for (int jj = 0; jj < 4; ++jj) so[((2 * wid + mt) * 16 + fq * 4 + jj) * 128 + dvs * 32 + nt * 16 + fr] = S[mt][nt][jj];
  __syncthreads();
#undef SCAN_LOAD
}

__device__ void gdn_sample_item(const Params& p, int l, int item, unsigned char* smem) {
  const int tid = (opq(threadIdx.x) & 255), lane = tid & 63, wid = tid >> 6;
  const int h = item & 7, b = item >> 3;
  float* qs = (float*)smem;
  float* ks = qs + 1024;
  float* vs = ks + 1024;
  float* part = vs + 1024;
  float* sbeta = part + 256;
  float* sa = sbeta + 8;
  const int dv = tid & 127, half = tid >> 7;
  float S[64];
  const float* s0 = p.state_gdn + ((size_t)(l * 128 + b) * 8 + h) * 16384 + (half * 8192 + dv);
#pragma unroll
  for (int k = 0; k < 64; ++k) S[k] = s0[k * 128];
#pragma unroll
  for (int ps = 0; ps < 2; ++ps) {
    const int c = tid + ps * 256;
    if (c < 384) {
      const int sect = c >> 7, ci = c & 127;
      const int ch = sect * 1024 + h * 128 + ci;
      float xw[11], cwv[4];
#pragma unroll
      for (int j = 0; j < 4; ++j) cwv[j] = p.conv_w[(size_t)(l * 4 + j) * 3072 + ch];
#pragma unroll
      for (int j = 0; j < 3; ++j) xw[j] = p.cache_conv[((size_t)(l * 128 + b) * 3 + j) * 3072 + ch];
#pragma unroll
      for (int t = 0; t < 8; ++t) xw[3 + t] = bf2f(p.proj()[(size_t)(MP + b * 8 + t) * NPJ + ch]);
      float* dst = sect == 0 ? qs : (sect == 1 ? ks : vs);
#pragma unroll
      for (int t = 0; t < 8; ++t) dst[t * 128 + ci] = silu(xw[t] * cwv[0] + xw[t + 1] * cwv[1] + xw[t + 2] * cwv[2] + xw[t + 3] * cwv[3]);
    }
  }
  if (tid < 8) {
    const float* lg = p.logits() + (size_t)(MP + b * 8 + tid) * 16;
    const float x = lg[8 + h] + p.dt_bias[l * 8 + h];
    const float sp = softplus_f(x);
    sa[tid] = __expf(-__expf(p.a_log[l * 8 + h]) * sp);
    sbeta[tid] = sigm(lg[h]);
  }
  __syncthreads();
#pragma unroll
  for (int u = 0; u < 4; ++u) {
    const int t = wid * 2 + (u >> 1);
    float* arr = (u & 1) ? ks : qs;
    const float a0 = arr[t * 128 + lane], a1 = arr[t * 128 + 64 + lane];
    float ss = a0 * a0 + a1 * a1;
#pragma unroll
    for (int o = 1; o < 64; o <<= 1) ss += shx(ss, o, lane);
    float rn = rsqrtf(ss + EPS);
    if (!(u & 1)) rn *= 0.08838834764831845f;
    arr[t * 128 + lane] = a0 * rn;
    arr[t * 128 + 64 + lane] = a1 * rn;
  }
  __syncthreads();
#pragma unroll 1
  for (int t = 0; t < 8; ++t) {
    const float a = sa[t], bt = sbeta[t];
    float kv = 0.f;
#pragma unroll
    for (int k4 = 0; k4 < 16; ++k4) {
      const f32x4 kk = *(const f32x4*)(ks + t * 128 + half * 64 + k4 * 4);
      S[k4 * 4 + 0] *= a; S[k4 * 4 + 1] *= a; S[k4 * 4 + 2] *= a; S[k4 * 4 + 3] *= a;
      kv += S[k4 * 4 + 0] * kk.x + S[k4 * 4 + 1] * kk.y + S[k4 * 4 + 2] * kk.z + S[k4 * 4 + 3] * kk.w;
      if ((k4 & 3) == 3) asm volatile("" ::: "memory");
    }
    part[half * 128 + dv] = kv;
    __syncthreads();
    const float delta = bt * (vs[t * 128 + dv] - (part[dv] + part[128 + dv]));
    __syncthreads();
    float o = 0.f;
#pragma unroll
    for (int k4 = 0; k4 < 16; ++k4) {
      const f32x4 kk = *(const f32x4*)(ks + t * 128 + half * 64 + k4 * 4);
      const f32x4 qq = *(const f32x4*)(qs + t * 128 + half * 64 + k4 * 4);
      S[k4 * 4 + 0] += kk.x * delta; S[k4 * 4 + 1] += kk.y * delta; S[k4 * 4 + 2] += kk.z * delta; S[k4 * 4 + 3] += kk.w * delta;
      o += S[k4 * 4 + 0] * qq.x + S[k4 * 4 + 1] * qq.y + S[k4 * 4 + 2] * qq.z + S[k4 * 4 + 3] * qq.w;
      if ((k4 & 3) == 3) asm volatile("" ::: "memory");
    }
    part[half * 128 + dv] = o;
    __syncthreads();
    if (half == 0) p.ogdn()[(size_t)(MP + b * 8 + t) * DM + h * 128 + dv] = f2bf(part[dv] + part[128 + dv]);
    __syncthreads();
  }
  float* so = p.out + O_GDNS + ((size_t)(l * 128 + b) * 8 + h) * 16384 + opq(half * 8192 + dv);
#pragma unroll
  for (int k = 0; k < 64; ++k) so[k * 128] = S[k];
  __syncthreads();
}

__device__ void gdn_sample_pair(const Params& p, int l, int pair, unsigned char* smem) {
  const int tid = (opq(threadIdx.x) & 255), lane = tid & 63, wid = tid >> 6;
  const int sub = tid >> 7, dv = tid & 127;
  const int item = pair * 2 + sub, h = item & 7, b = item >> 3;
  float* qs = (float*)smem + sub * 3104;
  float* ks = qs + 1024;
  float* vs = qs + 2048;
  float* sbeta = qs + 3072;
  float* sa = qs + 3080;
  f32x2 S2[64];
  const float* s0 = p.state_gdn + ((size_t)(l * 128 + b) * 8 + h) * 16384 + dv;
#pragma unroll
  for (int k = 0; k < 64; ++k) { S2[k].x = s0[(2 * k) * 128]; S2[k].y = s0[(2 * k + 1) * 128]; }
#pragma unroll
  for (int sect = 0; sect < 3; ++sect) {
    const int ch = sect * 1024 + h * 128 + dv;
    float xw[11], cwv[4];
#pragma unroll
    for (int j = 0; j < 4; ++j) cwv[j] = p.conv_w[(size_t)(l * 4 + j) * 3072 + ch];
#pragma unroll
    for (int j = 0; j < 3; ++j) xw[j] = p.cache_conv[((size_t)(l * 128 + b) * 3 + j) * 3072 + ch];
#pragma unroll
    for (int t = 0; t < 8; ++t) xw[3 + t] = bf2f(p.proj()[(size_t)(MP + b * 8 + t) * NPJ + ch]);
    float* dst = sect == 0 ? qs : (sect == 1 ? ks : vs);
#pragma unroll
    for (int t = 0; t < 8; ++t) dst[t * 128 + dv] = silu(xw[t] * cwv[0] + xw[t + 1] * cwv[1] + xw[t + 2] * cwv[2] + xw[t + 3] * cwv[3]);
  }
  if (dv < 8) {
    const float* lg = p.logits() + (size_t)(MP + b * 8 + dv) * 16;
    const float x = lg[8 + h] + p.dt_bias[l * 8 + h];
    sa[dv] = __expf(-__expf(p.a_log[l * 8 + h]) * softplus_f(x));
    sbeta[dv] = sigm(lg[h]);
  }
  __syncthreads();
#pragma unroll
  for (int u = 0; u < 8; ++u) {
    const int t = (wid & 1) * 4 + (u >> 1);
    float* arr = (u & 1) ? ks : qs;
    const float a0 = arr[t * 128 + lane], a1 = arr[t * 128 + 64 + lane];
    float ss = a0 * a0 + a1 * a1;
#pragma unroll
    for (int o = 1; o < 64; o <<= 1) ss += shx(ss, o, lane);
    float rn = rsqrtf(ss + EPS);
    if (!(u & 1)) rn *= 0.08838834764831845f;
    arr[t * 128 + lane] = a0 * rn;
    arr[t * 128 + 64 + lane] = a1 * rn;
  }
  __syncthreads();
#pragma unroll 1
  for (int t = 0; t < 8; ++t) {
    const float a = sa[t], bt = sbeta[t];
    f32x2 kv2 = (f32x2){0.f, 0.f};
#pragma unroll
    for (int k4 = 0; k4 < 32; ++k4) {
      const f32x4 kk = *(const f32x4*)(ks + t * 128 + k4 * 4);
      kv2 += S2[2 * k4] * (f32x2){kk.x, kk.y};
      kv2 += S2[2 * k4 + 1] * (f32x2){kk.z, kk.w};
      if ((k4 & 3) == 3) asm volatile("" ::: "memory");
    }
    const float delta = bt * (vs[t * 128 + dv] - a * (kv2.x + kv2.y));
    const f32x2 a2 = (f32x2){a, a}, d2 = (f32x2){delta, delta};
    f32x2 o2 = (f32x2){0.f, 0.f};
#pragma unroll
    for (int k4 = 0; k4 < 32; ++k4) {
      const f32x4 kk = *(const f32x4*)(ks + t * 128 + k4 * 4);
      const f32x4 qq = *(const f32x4*)(qs + t * 128 + k4 * 4);
      S2[2 * k4] = S2[2 * k4] * a2 + (f32x2){kk.x, kk.y} * d2;
      S2[2 * k4 + 1] = S2[2 * k4 + 1] * a2 + (f32x2){kk.z, kk.w} * d2;
      o2 += S2[2 * k4] * (f32x2){qq.x, qq.y};
      o2 += S2[2 * k4 + 1] * (f32x2){qq.z, qq.w};
      if ((k4 & 3) == 3) asm volatile("" ::: "memory");
    }
    p.ogdn()[(size_t)(MP + b * 8 + t) * DM + h * 128 + dv] = f2bf(o2.x + o2.y);
  }
  float* so = p.out + O_GDNS + ((size_t)(l * 128 + b) * 8 + h) * 16384 + opq(dv);
#pragma unroll
  for (int k = 0; k < 64; ++k) { so[(2 * k) * 128] = S2[k].x; so[(2 * k + 1) * 128] = S2[k].y; }
  __syncthreads();
}

__device__ void swa_prompt_item(const Params& p, int l, int item, unsigned char* smem) {
  const int tid = (opq(threadIdx.x) & 255), lane = tid & 63, wid = tid >> 6, fr = lane & 15, fq = lane >> 4;
  const int kvh = item & 3, hb2 = (item >> 2) & 31, b = item >> 7;
  bf16_t* Ks = (bf16_t*)smem;
  bf16_t* VT = Ks + 208 * 72;
  bf16_t* Pw = VT + 64 * 216 + wid * 16 * 168;
  const int tk0 = hb2 * 64 - 128;
  u32x4 krw[7], vrw[7];
#pragma unroll
  for (int i = 0; i < 7; ++i) {
    const int pc = tid + i * NTHR, kj = pc >> 3, c8 = pc & 7, tk = tk0 + kj;
    krw[i] = (u32x4){0u, 0u, 0u, 0u}; vrw[i] = (u32x4){0u, 0u, 0u, 0u};
    if (pc < 208 * 8 && kj < 192 && tk >= 0) {
      const bf16_t* base = p.proj() + (size_t)(b * 2048 + tk) * NPJ + kvh * 64 + c8 * 8;
      krw[i] = *(const u32x4*)(base + C_SK); vrw[i] = *(const u32x4*)(base + C_SV);
    }
  }
#pragma unroll
  for (int i = 0; i < 7; ++i) {
    const int pc = tid + i * NTHR;
    if (pc >= 208 * 8) break;
    const int kj = pc >> 3, c8 = pc & 7, tk = tk0 + kj;
    const bool ok = kj < 192 && tk >= 0;
    float kf[8], vf[8];
    UNPACK8(krw[i], kf);
    UNPACK8(vrw[i], vf);
    float ss = 0.f;
#pragma unroll
    for (int c = 0; c < 8; ++c) ss += kf[c] * kf[c];
    ss += shx(ss, 1, lane); ss += shx(ss, 2, lane); ss += shx(ss, 4, lane);
    const float rn = rsqrtf(ss * (1.f / 64.f) + EPS);
    const f32x4 w0 = *(const f32x4*)(p.k_norm + l * 64 + c8 * 8), w1 = *(const f32x4*)(p.k_norm + l * 64 + c8 * 8 + 4);
    kf[0] *= rn * w0.x; kf[1] *= rn * w0.y; kf[2] *= rn * w0.z; kf[3] *= rn * w0.w;
    kf[4] *= rn * w1.x; kf[5] *= rn * w1.y; kf[6] *= rn * w1.z; kf[7] *= rn * w1.w;
    *(u32x4*)(Ks + kj * 72 + c8 * 8) = (u32x4){pk2(kf[0], kf[1]), pk2(kf[2], kf[3]), pk2(kf[4], kf[5]), pk2(kf[6], kf[7])};
#pragma unroll
    for (int c = 0; c < 8; ++c) VT[(c8 * 8 + c) * 216 + kj] = f2bf(vf[c]);
    if (ok && tk >= 1920 && kj >= 128) {
      float* ko = p.out + O_KP + (((size_t)(l * 8 + b) * 128 + (tk - 1920)) * 4 + kvh) * 64 + c8 * 8;
      float* vo = p.out + O_VP + (((size_t)(l * 8 + b) * 128 + (tk - 1920)) * 4 + kvh) * 64 + c8 * 8;
      *(f32x4*)ko = (f32x4){kf[0], kf[1], kf[2], kf[3]};
      *(f32x4*)(ko + 4) = (f32x4){kf[4], kf[5], kf[6], kf[7]};
      *(f32x4*)vo = (f32x4){vf[0], vf[1], vf[2], vf[3]};
      *(f32x4*)(vo + 4) = (f32x4){vf[4], vf[5], vf[6], vf[7]};
    }
  }
  __syncthreads();
  const int kbase = wid * 16;
  const int ql = wid * 16 + fr;
  const size_t qrow = (size_t)b * 2048 + hb2 * 64 + ql;
  u32x4 qraw[4][2];
#pragma unroll
  for (int g = 0; g < 4; ++g) {
    const bf16_t* qp = p.proj() + qrow * NPJ + C_SQ + (kvh * 4 + g) * 64 + fq * 8;
    qraw[g][0] = *(const u32x4*)qp; qraw[g][1] = *(const u32x4*)(qp + 32);
  }
#pragma unroll
  for (int g = 0; g < 4; ++g) {
    const int head = kvh * 4 + g;
    const float slope = exp2f(-0.5f * (float)(head + 1));
    const float sink = p.sinks[l * 16 + head];
    bf16x8 qf[2];
    {
      const u32x4 r0 = qraw[g][0], r1 = qraw[g][1];
      float f0[8], f1[8];
      UNPACK8(r0, f0);
      UNPACK8(r1, f1);
      float ss = 0.f;
#pragma unroll
      for (int c = 0; c < 8; ++c) ss += f0[c] * f0[c] + f1[c] * f1[c];
      ss += shx(ss, 16, lane); ss += shx(ss, 32, lane);
      const float rn = rsqrtf(ss * (1.f / 64.f) + EPS) * 0.125f;
      const float* qn = p.q_norm + l * 64 + fq * 8;
#pragma unroll
      for (int c = 0; c < 8; ++c) { f0[c] *= rn * qn[c]; f1[c] *= rn * qn[32 + c]; }
      qf[0] = as_bf((u32x4){pk2(f0[0], f0[1]), pk2(f0[2], f0[3]), pk2(f0[4], f0[5]), pk2(f0[6], f0[7])});
      qf[1] = as_bf((u32x4){pk2(f1[0], f1[1]), pk2(f1[2], f1[3]), pk2(f1[4], f1[5]), pk2(f1[6], f1[7])});
    }
    f32x4 sc[9];
    float mx = sink;
#pragma unroll
    for (int kt = 0; kt < 9; ++kt) {
      f32x4 a = (f32x4){0.f, 0.f, 0.f, 0.f};
#pragma unroll
      for (int ks = 0; ks < 2; ++ks) {
        const bf16x8 kf = *(const bf16x8*)(Ks + (kbase + kt * 16 + fr) * 72 + ks * 32 + fq * 8);
        a = mfma16(kf, qf[ks], a);
      }
#pragma unroll
      for (int jj = 0; jj < 4; ++jj) {
        const int kj = kbase + kt * 16 + fq * 4 + jj;
        const int dist = ql + 128 - kj;
        const bool ok = dist >= 0 && dist <= 128 && (tk0 + kj) >= 0;
        const float s = ok ? a[jj] - slope * (float)dist : -INFINITY;
        a[jj] = s;
        mx = fmaxf(mx, s);
      }
      sc[kt] = a;
    }
    mx = fmaxf(mx, shx(mx, 16, lane));
    mx = fmaxf(mx, shx(mx, 32, lane));
    float sum = 0.f;
#pragma unroll
    for (int kt = 0; kt < 9; ++kt) {
      f32x4 e;
#pragma unroll
      for (int jj = 0; jj < 4; ++jj) { e[jj] = __expf(sc[kt][jj] - mx); sum += e[jj]; }
      *(u32x2*)(Pw + fr * 168 + kt * 16 + fq * 4) = (u32x2){pk2(e.x, e.y), pk2(e.z, e.w)};
    }
    *(u32x2*)(Pw + fr * 168 + 144 + fq * 4) = (u32x2){0u, 0u};
    sum += shx(sum, 16, lane);
    sum += shx(sum, 32, lane);
    const float inv = 1.f / (sum + __expf(sink - mx));
    __builtin_amdgcn_wave_barrier();
#pragma unroll
    for (int dt = 0; dt < 4; ++dt) {
      f32x4 a = (f32x4){0.f, 0.f, 0.f, 0.f};
#pragma unroll
      for (int ks = 0; ks < 5; ++ks) {
        const bf16x8 vf = *(const bf16x8*)(VT + (dt * 16 + fr) * 216 + kbase + ks * 32 + fq * 8);
        const bf16x8 pf = *(const bf16x8*)(Pw + fr * 168 + ks * 32 + fq * 8);
        a = mfma16(vf, pf, a);
      }
      a *= inv;
      *(u32x2*)(p.oswa() + qrow * DM + head * 64 + dt * 16 + fq * 4) = (u32x2){pk2(a.x, a.y), pk2(a.z, a.w)};
    }
    __builtin_amdgcn_wave_barrier();
  }
  __syncthreads();
}

__device__ void swa_sample_item(const Params& p, int l, int item, unsigned char* smem) {
  const int tid = (opq(threadIdx.x) & 255), lane = tid & 63, wid = tid >> 6;
  const int kvh = item & 3, b = item >> 2;
  float* Ks = (float*)smem;
  float* Vs = Ks + 136 * 68;
  float* Qs = Vs + 136 * 64;
  float* Sc = Qs + 512;
  const size_t cbase = (size_t)(l * 128 + b) * 128;
  f32x4 kvr[8], vvr[8];
#pragma unroll
  for (int i = 0; i < 8; ++i) {
    const int idx = tid + i * NTHR, j = idx >> 4, c4 = idx & 15;
    kvr[i] = *(const f32x4*)(p.cache_k + ((cbase + j) * 4 + kvh) * 64 + c4 * 4);
    vvr[i] = *(const f32x4*)(p.cache_v + ((cbase + j) * 4 + kvh) * 64 + c4 * 4);
  }
  unsigned qrw[4];
#pragma unroll
  for (int g = 0; g < 4; ++g) qrw[g] = *(const unsigned*)(p.proj() + (size_t)(MP + b * 8 + (tid >> 5)) * NPJ + C_SQ + (kvh * 4 + g) * 64 + (tid & 31) * 2);
#pragma unroll
  for (int i = 0; i < 8; ++i) {
    const int idx = tid + i * NTHR, j = idx >> 4, c4 = idx & 15;
    const f32x4 kv = kvr[i], vv = vvr[i];
    *(f32x4*)(Ks + j * 68 + c4 * 4) = kv;
    *(f32x4*)(Vs + j * 64 + c4 * 4) = vv;
  }
  {
    const int t = tid >> 5, d = (tid & 31) * 2;
    const bf16_t* base = p.proj() + (size_t)(MP + b * 8 + t) * NPJ + kvh * 64 + d;
    const unsigned kr = *(const unsigned*)(base + C_SK), vr = *(const unsigned*)(base + C_SV);
    float k0 = lo2f(kr), k1 = hi2f(kr);
    float ss = k0 * k0 + k1 * k1;
#pragma unroll
    for (int o = 1; o < 32; o <<= 1) ss += shx(ss, o, lane);
    const float rn = rsqrtf(ss * (1.f / 64.f) + EPS);
    Ks[(128 + t) * 68 + d] = k0 * rn * p.k_norm[l * 64 + d];
    Ks[(128 + t) * 68 + d + 1] = k1 * rn * p.k_norm[l * 64 + d + 1];
    Vs[(128 + t) * 64 + d] = lo2f(vr);
    Vs[(128 + t) * 64 + d + 1] = hi2f(vr);
  }
  __syncthreads();
  for (int idx = tid; idx < 128 * 64; idx += NTHR) {
    const int j = idx >> 6, d = idx & 63;
    p.out[O_KS + ((cbase + j) * 4 + kvh) * 64 + d] = Ks[(j + 8) * 68 + d];
    p.out[O_VS + ((cbase + j) * 4 + kvh) * 64 + d] = Vs[(j + 8) * 64 + d];
  }
#pragma unroll
  for (int g = 0; g < 4; ++g) {
    const int head = kvh * 4 + g;
    const float slope = exp2f(-0.5f * (float)(head + 1));
    const float sink = p.sinks[l * 16 + head];
    {
      const int t = tid >> 5, d = (tid & 31) * 2;
      const unsigned qr = qrw[g];
      const float q0 = lo2f(qr), q1 = hi2f(qr);
      float ss = q0 * q0 + q1 * q1;
#pragma unroll
      for (int o = 1; o < 32; o <<= 1) ss += shx(ss, o, lane);
      const float rn = rsqrtf(ss * (1.f / 64.f) + EPS) * 0.125f;
      Qs[t * 64 + d] = q0 * rn * p.q_norm[l * 64 + d];
      Qs[t * 64 + d + 1] = q1 * rn * p.q_norm[l * 64 + d + 1];
    }
    __syncthreads();
    for (int idx = tid; idx < 8 * 136; idx += NTHR) {
      const int tq = idx / 136, j = idx % 136;
      float s = 0.f;
#pragma unroll
      for (int d4 = 0; d4 < 16; ++d4) {
        const f32x4 qv = *(const f32x4*)(Qs + tq * 64 + d4 * 4), kq = *(const f32x4*)(Ks + j * 68 + d4 * 4);
        s += (qv.x * kq.x + qv.y * kq.y) + (qv.z * kq.z + qv.w * kq.w);
      }
      const int dist = tq + 128 - j;
      Sc[tq * 136 + j] = (dist >= 0 && dist <= 128) ? s - slope * (float)dist : -INFINITY;
    }
    __syncthreads();
#pragma unroll
    for (int u = 0; u < 2; ++u) {
      const int tq = wid * 2 + u;
      const float s0 = Sc[tq * 136 + lane], s1 = Sc[tq * 136 + 64 + lane], s2 = lane < 8 ? Sc[tq * 136 + 128 + lane] : -INFINITY;
      float mx = fmaxf(fmaxf(s0, s1), fmaxf(s2, sink));
#pragma unroll
      for (int o = 1; o < 64; o <<= 1) mx = fmaxf(mx, shx(mx, o, lane));
      const float e0 = __expf(s0 - mx), e1 = __expf(s1 - mx), e2 = __expf(s2 - mx);
      float sum = e0 + e1 + e2;
#pragma unroll
      for (int o = 1; o < 64; o <<= 1) sum += shx(sum, o, lane);
      const float inv = 1.f / (sum + __expf(sink - mx));
      Sc[tq * 136 + lane] = e0 * inv;
      Sc[tq * 136 + 64 + lane] = e1 * inv;
      if (lane < 8) Sc[tq * 136 + 128 + lane] = e2 * inv;
    }
    __syncthreads();
    {
      const int tq = tid >> 5, d = (tid & 31) * 2;
      float o0 = 0.f, o1 = 0.f;
#pragma unroll 2
      for (int j4 = 0; j4 < 34; ++j4) {
        const f32x4 pj = *(const f32x4*)(Sc + tq * 136 + j4 * 4);
        const f32x2 va = *(const f32x2*)(Vs + (j4 * 4 + 0) * 64 + d), vb = *(const f32x2*)(Vs + (j4 * 4 + 1) * 64 + d);
        const f32x2 vc = *(const f32x2*)(Vs + (j4 * 4 + 2) * 64 + d), vd = *(const f32x2*)(Vs + (j4 * 4 + 3) * 64 + d);
        o0 += (pj.x * va.x + pj.y * vb.x) + (pj.z * vc.x + pj.w * vd.x);
        o1 += (pj.x * va.y + pj.y * vb.y) + (pj.z * vc.y + pj.w * vd.y);
      }
      *(unsigned*)(p.oswa() + (size_t)(MP + b * 8 + tq) * DM + head * 64 + d) = pk2(o0, o1);
    }
    __syncthreads();
  }
}

__device__ void phase_mix(const Params& p, int l) {
  const int tid = (opq(threadIdx.x) & 255), lane = tid & 63, wid = tid >> 6, fr = lane & 15, fq = lane >> 4;
  for (int it = VB; it < MTOK / 4; it += VG) {
    const size_t row = (size_t)it * 4 + wid;
#pragma unroll
    for (int ps = 0; ps < 2; ++ps) {
      const int ch = (ps * 4 + fq) * 128 + fr * 8;
      const u32x4 og = *(const u32x4*)(p.ogdn() + row * DM + ch);
      const u32x4 ob = *(const u32x4*)(p.oswa() + row * DM + ch);
      const u32x4 zz = *(const u32x4*)(p.proj() + row * NPJ + C_Z + ch);
      const u32x4 ga = *(const u32x4*)(p.proj() + row * NPJ + C_G + ch);
      const u32x4 gb = *(const u32x4*)(p.proj() + row * NPJ + C_G + 1024 + ch);
      float fo[8], fb[8], fz[8], fa[8], fg[8];
      UNPACK8(og, fo); UNPACK8(ob, fb); UNPACK8(zz, fz); UNPACK8(ga, fa); UNPACK8(gb, fg);
      float ss = 0.f;
#pragma unroll
      for (int c = 0; c < 8; ++c) ss += fo[c] * fo[c];
      ss += shx(ss, 1, lane); ss += shx(ss, 2, lane); ss += shx(ss, 4, lane); ss += shx(ss, 8, lane);
      const float rn = rsqrtf(ss * (1.f / 128.f) + EPS);
      const f32x4 w0 = *(const f32x4*)(p.gdn_norm + l * 128 + fr * 8), w1 = *(const f32x4*)(p.gdn_norm + l * 128 + fr * 8 + 4);
      const float wn[8] = {w0.x, w0.y, w0.z, w0.w, w1.x, w1.y, w1.z, w1.w};
      float m[8];
#pragma unroll
      for (int c = 0; c < 8; ++c) m[c] = sigm(fa[c]) * (fo[c] * rn * wn[c] * silu(fz[c])) + sigm(fg[c]) * fb[c];
      *(u32x4*)(p.mix() + row * DM + ch) = (u32x4){pk2(m[0], m[1]), pk2(m[2], m[3]), pk2(m[4], m[5]), pk2(m[6], m[7])};
    }
  }
  const int NC = (8 + 128) * 3 * 3072;
  for (int i = VB * NTHR + tid; i < NC; i += VG * NTHR) {
    const int c = i % 3072, r = (i / 3072) % 3, bb = i / 9216;
    if (bb < 8) p.out[O_CONVP + ((size_t)(l * 8 + bb) * 3 + r) * 3072 + c] = bf2f(p.proj()[(size_t)(bb * 2048 + 2045 + r) * NPJ + c]);
    else p.out[O_CONVS + ((size_t)(l * 128 + bb - 8) * 3 + r) * 3072 + c] = bf2f(p.proj()[(size_t)(MP + (bb - 8) * 8 + 5 + r) * NPJ + c]);
  }
}

#define XB_TMO      128
#define XB_XCNT(j)  (256  + 64 * (j))
#define XB_XSUB(j)  (1280 + 64 * (j))
#define XB_XGEN(j)  (2304 + 64 * (j))
#define XB_TOP      3328
#define XB_TOPGEN   3392
#define XCD_BAR_WORDS 3456
#define XB_SPIN_CAP (1u << 18)
#define LAS __attribute__((address_space(3)))

__device__ __forceinline__ unsigned xb_ld(unsigned* p)              { return __hip_atomic_load(p, __ATOMIC_RELAXED, __HIP_MEMORY_SCOPE_AGENT); }
__device__ __forceinline__ unsigned xb_add(unsigned* p, unsigned v) { return __hip_atomic_fetch_add(p, v, __ATOMIC_RELAXED, __HIP_MEMORY_SCOPE_AGENT); }
__device__ __forceinline__ unsigned xb_xcc_id() { return (unsigned)__builtin_amdgcn_s_getreg((3 << 11) | 20) & 0xFu; }
#define XB_SPIN(cond, bar) do { unsigned _sp = 0; while (cond) { __builtin_amdgcn_s_sleep(1); \
    if ((++_sp & 255u) == 0u) { if (xb_ld(&(bar)[XB_TMO])) break; if (_sp > XB_SPIN_CAP) { atomicAdd(&(bar)[XB_TMO], 1u); break; } } } } while (0)

struct XcdBarrier {
    unsigned* bar; unsigned x;
    volatile LAS unsigned* st;
};

__device__ __forceinline__ XcdBarrier xcd_barrier_post(unsigned* bar, volatile LAS unsigned* st) {
    XcdBarrier b; b.bar = bar; b.x = xb_xcc_id(); b.st = st;
    if (threadIdx.x == 0) (void)xb_add(&bar[XB_XCNT(b.x)], 1u);
    return b;
}
__device__ __forceinline__ void xcd_barrier_complete(unsigned* bar, unsigned x, unsigned& nloc, unsigned& nx) {
    const unsigned G = gridDim.x * gridDim.y * gridDim.z;
    unsigned sum, cnt, mine, sp = 0u;
    for (;;) {
        sum = 0u; cnt = 0u; mine = 0u;
#pragma unroll
        for (unsigned j = 0; j < 16; ++j) { const unsigned c = xb_ld(&bar[XB_XCNT(j)]); sum += c; cnt += (c > 0u) ? 1u : 0u; mine = (j == x) ? c : mine; }
        if (sum == G) break;
        __builtin_amdgcn_s_sleep(1);
        if ((++sp & 255u) == 0u) { if (xb_ld(&bar[XB_TMO])) break; if (sp > XB_SPIN_CAP) { atomicAdd(&bar[XB_TMO], 1u); break; } }
    }
    nloc = mine > 0u ? mine : 1u; nx = cnt > 0u ? cnt : 1u;
}

__device__ __forceinline__ void xcd_barrier(const XcdBarrier& b) {
    asm volatile("s_waitcnt vmcnt(0)" ::: "memory");
    __syncthreads();
    if (threadIdx.x == 0) {
        unsigned* bar = b.bar;
        __builtin_amdgcn_s_waitcnt(0);
        unsigned nloc = b.st[0], nx = b.st[1];
        if (nloc == 0u) { xcd_barrier_complete(bar, b.x, nloc, nx); b.st[0] = nloc; b.st[1] = nx; }
        const unsigned old = xb_add(&bar[XB_XSUB(b.x)], 1u);
        const unsigned gen = old / nloc;
        if (old + 1u == (gen + 1u) * nloc) {
            __builtin_amdgcn_fence(__ATOMIC_RELEASE, "agent");
            asm volatile("s_waitcnt vmcnt(0)" ::: "memory");
            const unsigned og = xb_add(&bar[XB_TOP], 1u);
            const unsigned tg = og / nx;
            if (og + 1u == (tg + 1u) * nx) xb_add(&bar[XB_TOPGEN], 1u);
            else XB_SPIN(xb_ld(&bar[XB_TOPGEN]) == tg, bar);
            __builtin_amdgcn_fence(__ATOMIC_ACQUIRE, "agent");
            xb_add(&bar[XB_XGEN(b.x)], 1u);
            asm volatile("s_waitcnt vmcnt(0)" ::: "memory");
        } else {
            XB_SPIN(xb_ld(&bar[XB_XGEN(b.x)]) == gen, bar);
            __builtin_amdgcn_fence(__ATOMIC_ACQUIRE, "agent");
            asm volatile("s_waitcnt vmcnt(0)" ::: "memory");
        }
    }
    __syncthreads();
}


#define NPHASE_PRE 2
#define NPHASE_L 8
constexpr int LDS_TOTAL = 2 * SMEM_BYTES;
__global__ void __launch_bounds__(512, 2) mega(Params p, int ph_lo, int ph_hi) {
  extern __shared__ __attribute__((aligned(16))) unsigned char lds_all[];
  if (ph_hi < 0) cg::this_grid().sync();
  __shared__ uint4 xb_words;
  if (threadIdx.x == 0) xb_words = make_uint4(0u, 0u, 0u, 0u);
  __syncthreads();
  XcdBarrier xb = xcd_barrier_post(p.bar(), (volatile LAS unsigned*)&xb_words);
  unsigned char* smem = lds_all + VHALF * SMEM_BYTES;
  for (int ph = ph_lo; ph < ph_hi; ++ph) {
    if (ph > ph_lo) xcd_barrier(xb);
    if (ph == 0) { phase_p0(p, smem); continue; }
    if (ph == 1) {
      {
        EpiArgs e{};
        e.obf = p.pp(); e.ldo = DM;
        DiagSched S; S.nLimit = 1024; S.G = gridDim.x; S.c = blockIdx.x;
        pg8::Gemm g; g.A = p.pb(); g.Bt = p.wt_proj(); g.M = NL * MTOK; g.N = NL * DM; g.K = PLE;
        BigEpi<EPI_PP> E; E.e = e;
        pg8::gemm_phase<BigEpi<EPI_PP>, DiagSched>((PG8_LAS unsigned char*)lds_all, g, S, E, nullptr);
        __syncthreads();
      }
      for (int st = VB; st < 64 * 16; st += VG) {
        const int L = 1024 + (st >> 4), sub = st & 15, l = L / 272, r = L - l * 272, pm = r >> 2, pn = r & 3;
        EpiArgs e{};
        e.obf = p.pp() + (size_t)l * MTOK * DM; e.ldo = DM;
        gemm_tile<1, 4, 4, 1, EPI_PP, 128>(p.pb() + (size_t)l * MTOK * PLE, PLE, p.wt_proj() + (size_t)l * DM * PLE, PLE, PLE, pm * 256 + (sub >> 2) * 64, pn * 256 + (sub & 3) * 64, (bf16_t*)smem, e);
      }
      continue;
    }
    const int l = (ph - NPHASE_PRE) / NPHASE_L, s = (ph - NPHASE_PRE) % NPHASE_L;
#ifndef REPMASK
#define REPMASK 0
#endif
    for (int rep = 0; rep < (((REPMASK >> s) & 1) ? 2 : 1); ++rep) {
    if (rep) xcd_barrier(xb);
    switch (s) {
      case 0: {
        EpiArgs e{};
        e.ssq_in = p.ssq0(); e.obf = p.proj(); e.ldo = NPJ; e.of32 = p.logits();
        const bf16_t* Bt = p.wt_in() + (size_t)l * NIN * DM;
        gemm_big_phase<EPI_PROJ>(p.hb(), Bt, DM, MTOK, NPJ, lds_all, smem, e);
        for (int t = VB; t < 272; t += VG)
          gemm_tile<1, 1, 4, 1, EPI_LOGIT, 128>(p.hb(), DM, Bt + (size_t)NPJ * DM, DM, DM, t * 64, 0, (bf16_t*)smem, e);
      } break;
      case 1: {
        const int nB1 = VG == 512 ? 3072 : 3584;
        for (int t = VB; t < nB1; t += VG) {
          if (t < 2048) gdn_prep_item(p, l, t, smem);
          else if (t < 3072) swa_prompt_item(p, l, t - 2048, smem);
          else swa_sample_item(p, l, t - 3072, smem);
        }
      } break;
      case 2: {
        if (VG == 512) {
          if (VB < 256) gdn_scan_item(p, l, VB, smem);
          else {
            gdn_sample_pair(p, l, VB - 256, smem); gdn_sample_pair(p, l, VB, smem);
            swa_sample_item(p, l, (VB - 256) * 2, smem); swa_sample_item(p, l, (VB - 256) * 2 + 1, smem);
          }
        } else {
          for (int t = VB; t < 256 + 512; t += VG) {
            if (t < 256) gdn_scan_item(p, l, t, smem);
            else gdn_sample_pair(p, l, t - 256, smem);
          }
        }
      } break;
      case 3: phase_mix(p, l); break;
      case 4: {
        EpiArgs e{};
        e.h = p.out; e.hb = p.hb2(); e.ssq_out = p.ssq1();
        gemm_big_phase<EPI_RESID>(p.mix(), p.wt_out() + (size_t)l * DM * DM, DM, MTOK, DM, lds_all, smem, e);
      } break;
      case 5: {
        EpiArgs e{};
        e.ssq_in = p.ssq1(); e.obf = p.proj(); e.ldo = DFF;
        gemm_big_phase<EPI_UP>(p.hb2(), p.wt_up() + (size_t)l * DFF * DM, DM, MTOK, DFF, lds_all, smem, e);
      } break;
      case 6: {
        EpiArgs e{};
        e.h = p.out; e.hb = p.hb2(); e.ssq_out = p.ssq2();
        gemm_big_phase<EPI_RESID>(p.proj(), p.wt_down() + (size_t)l * DM * DFF, DFF, MTOK, DM, lds_all, smem, e);
      } break;
      case 7: {
        EpiArgs e{};
        e.h = p.out; e.hb = p.hb(); e.ssq_in = p.ssq2(); e.ssq_out = p.ssq0(); e.pp = p.pp() + (size_t)l * MTOK * DM;
        gemm_big_phase<EPI_PLE>(p.hb2(), p.wt_gate() + (size_t)l * DM * DM, DM, MTOK, DM, lds_all, smem, e);
      } break;
    }
    }
  }
}

extern "C" void kernel_launch(void* const* d_in, const int* in_sizes, int n_in, void* d_out, int out_size, void* d_ws, size_t ws_size,
                              hipStream_t stream) {
  Params p{};
  const float* const* in = (const float* const*)d_in;
  p.x_prompt = in[0]; p.x_sample = in[1]; p.cache_conv = in[2]; p.state_gdn = in[3]; p.cache_k = in[4]; p.cache_v = in[5];
  p.p_prompt = in[6]; p.p_sample = in[7]; p.norm_mix = in[8]; p.w_in = in[9]; p.conv_w = in[10]; p.a_log = in[11]; p.dt_bias = in[12];
  p.gdn_norm = in[13]; p.q_norm = in[14]; p.k_norm = in[15]; p.sinks = in[16]; p.w_out = in[17]; p.norm_ffn = in[18]; p.w_up = in[19];
  p.w_down = in[20]; p.norm_ple = in[21]; p.w_gate = in[22]; p.w_proj = in[23];
  p.out = (float*)d_out;
  p.ws = (unsigned char*)d_ws;
  if (WS_TOTAL > ws_size) { fprintf(stderr, "workspace too small: need %zu have %zu\n", (size_t)WS_TOTAL, ws_size); return; }

  static int grid_blocks = 0;
  if (!grid_blocks) {
    int dev = 0, cus = 0, per_cu = 0;
    (void)hipGetDevice(&dev);
    (void)hipDeviceGetAttribute(&cus, hipDeviceAttributeMultiprocessorCount, dev);
    if (hipFuncSetAttribute((const void*)mega, hipFuncAttributeMaxDynamicSharedMemorySize, LDS_TOTAL) != hipSuccess) { fprintf(stderr, "hipFuncSetAttribute(dynamic LDS %d) failed\n", LDS_TOTAL); grid_blocks = -1; return; }
    (void)hipOccupancyMaxActiveBlocksPerMultiprocessor(&per_cu, (const void*)mega, 512, LDS_TOTAL);
    (void)hipGetLastError();
    grid_blocks = cus;
  }
  if (grid_blocks < 0) return;
  (void)hipMemsetAsync(p.ws + WO_bar, 0, (size_t)XCD_BAR_WORDS * 4, stream);
  int lo = 0, hi = NPHASE_PRE + NL * NPHASE_L;
  void* args[] = {&p, &lo, &hi};
  hipError_t e = hipLaunchCooperativeKernel((void*)mega, dim3(grid_blocks), dim3(512), args, LDS_TOTAL, stream);
  if (e != hipSuccess) fprintf(stderr, "cooperative launch failed: %s (grid %d)\n", hipGetErrorString(e), grid_blocks);
}
```

```cpp
#include <hip/hip_runtime.h>
#include <hip/hip_cooperative_groups.h>
#include <cstdio>
namespace cg = cooperative_groups;

typedef unsigned short bf16_t;
typedef short bf16x8 __attribute__((ext_vector_type(8)));
typedef float f32x4 __attribute__((ext_vector_type(4)));
typedef float f32x2 __attribute__((ext_vector_type(2)));
typedef unsigned u32x4 __attribute__((ext_vector_type(4)));
typedef unsigned u32x2 __attribute__((ext_vector_type(2)));

#define DEVI __device__ __forceinline__
DEVI int opq(int x) { asm volatile("" : "+v"(x)); return x; }

#define VHALF ((int)__builtin_amdgcn_readfirstlane((int)(threadIdx.x >> 8)))
#define VB ((int)blockIdx.x * 2 + VHALF)
#define VG ((int)gridDim.x * 2)
constexpr int NL = 4;
constexpr int MTOK = 17408, MP = 16384, MS = 1024;
constexpr int DM = 1024, NIN = 7696, NPJ = 7680, DFF = 4096, PLE = 256;
constexpr int C_Z = 3072, C_SQ = 4096, C_SK = 5120, C_SV = 5376, C_G = 5632;
constexpr float EPS = 1e-6f;
constexpr int NTHR = 256;
constexpr int SMEM_BYTES = 79872;
constexpr size_t SCR_ITEM = 73728;

constexpr size_t O_YP = 0, O_YS = 16777216, O_CONVP = 17825792, O_GDNP = 18120704, O_KP = 22315008, O_VP = 23363584,
                 O_CONVS = 24412160, O_GDNS = 29130752, O_KS = 96239616, O_VS = 113016832, O_END = 129794048;

constexpr size_t al256(size_t x) { return (x + 255) & ~(size_t)255; }
constexpr size_t WO_wt_in = 0;
constexpr size_t WO_wt_out = WO_wt_in + al256((size_t)NL * NIN * DM * 2);
constexpr size_t WO_wt_up = WO_wt_out + al256((size_t)NL * DM * DM * 2);
constexpr size_t WO_wt_down = WO_wt_up + al256((size_t)NL * DFF * DM * 2);
constexpr size_t WO_wt_gate = WO_wt_down + al256((size_t)NL * DM * DFF * 2);
constexpr size_t WO_wt_proj = WO_wt_gate + al256((size_t)NL * DM * DM * 2);
constexpr size_t WO_hb = WO_wt_proj + al256((size_t)NL * DM * PLE * 2);
constexpr size_t WO_hb2 = WO_hb + al256((size_t)MTOK * DM * 2);
constexpr size_t WO_proj = WO_hb2 + al256((size_t)MTOK * DM * 2);
constexpr size_t WO_scr = WO_proj + al256((size_t)MTOK * NPJ * 2);
constexpr size_t WO_ogdn = WO_scr + al256((size_t)2048 * SCR_ITEM);
constexpr size_t WO_oswa = WO_ogdn + al256((size_t)MTOK * DM * 2);
constexpr size_t WO_mix = WO_oswa + al256((size_t)MTOK * DM * 2);
constexpr size_t WO_pb = WO_mix + al256((size_t)MTOK * DM * 2);
constexpr size_t WO_pp = WO_pb + al256((size_t)NL * MTOK * PLE * 2);
constexpr size_t WO_ssq0 = WO_pp + al256((size_t)NL * MTOK * DM * 2);
constexpr size_t WO_ssq1 = WO_ssq0 + al256((size_t)MTOK * 16 * 4);
constexpr size_t WO_ssq2 = WO_ssq1 + al256((size_t)MTOK * 16 * 4);
constexpr size_t WO_logits = WO_ssq2 + al256((size_t)MTOK * 16 * 4);
constexpr size_t WO_gsc = WO_logits + al256((size_t)MTOK * 16 * 4);
constexpr size_t WO_bar = WO_gsc + al256((size_t)2048 * 4);
constexpr size_t WS_TOTAL = WO_bar + al256((size_t)3456 * 4);
struct Params {
  const float *x_prompt, *x_sample, *cache_conv, *state_gdn, *cache_k, *cache_v, *p_prompt, *p_sample;
  const float *norm_mix, *w_in, *conv_w, *a_log, *dt_bias, *gdn_norm, *q_norm, *k_norm, *sinks, *w_out, *norm_ffn, *w_up, *w_down,
      *norm_ple, *w_gate, *w_proj;
  float* out;
  unsigned char* ws;
  DEVI bf16_t* wt_in() const { return (bf16_t*)(ws + WO_wt_in); }
  DEVI bf16_t* wt_out() const { return (bf16_t*)(ws + WO_wt_out); }
  DEVI bf16_t* wt_up() const { return (bf16_t*)(ws + WO_wt_up); }
  DEVI bf16_t* wt_down() const { return (bf16_t*)(ws + WO_wt_down); }
  DEVI bf16_t* wt_gate() const { return (bf16_t*)(ws + WO_wt_gate); }
  DEVI bf16_t* wt_proj() const { return (bf16_t*)(ws + WO_wt_proj); }
  DEVI bf16_t* hb() const { return (bf16_t*)(ws + WO_hb); }
  DEVI bf16_t* hb2() const { return (bf16_t*)(ws + WO_hb2); }
  DEVI bf16_t* proj() const { return (bf16_t*)(ws + WO_proj); }
  DEVI bf16_t* scr() const { return (bf16_t*)(ws + WO_scr); }
  DEVI bf16_t* ogdn() const { return (bf16_t*)(ws + WO_ogdn); }
  DEVI bf16_t* oswa() const { return (bf16_t*)(ws + WO_oswa); }
  DEVI bf16_t* mix() const { return (bf16_t*)(ws + WO_mix); }
  DEVI bf16_t* pb() const { return (bf16_t*)(ws + WO_pb); }
  DEVI bf16_t* pp() const { return (bf16_t*)(ws + WO_pp); }
  DEVI float* ssq0() const { return (float*)(ws + WO_ssq0); }
  DEVI float* ssq1() const { return (float*)(ws + WO_ssq1); }
  DEVI float* ssq2() const { return (float*)(ws + WO_ssq2); }
  DEVI float* logits() const { return (float*)(ws + WO_logits); }
  DEVI float* gsc() const { return (float*)(ws + WO_gsc); }
  DEVI unsigned* bar() const { return (unsigned*)(ws + WO_bar); }
};

DEVI float shx(float v, int m, int ln) { return __builtin_bit_cast(float, __builtin_amdgcn_ds_bpermute((ln ^ m) << 2, __builtin_bit_cast(int, v))); }
DEVI float shup(float v, int o, int ln) { return __builtin_bit_cast(float, __builtin_amdgcn_ds_bpermute((ln >= o ? ln - o : ln) << 2, __builtin_bit_cast(int, v))); }
DEVI float lo2f(unsigned u) { return __uint_as_float(u << 16); }
DEVI float hi2f(unsigned u) { return __uint_as_float(u & 0xffff0000u); }
DEVI float bf2f(bf16_t v) { return __uint_as_float(((unsigned)v) << 16); }
typedef __bf16 bf16x2_t __attribute__((ext_vector_type(2)));
DEVI unsigned pk2(float lo, float hi) { const f32x2 v = {lo, hi}; const bf16x2_t r = __builtin_convertvector(v, bf16x2_t); return __builtin_bit_cast(unsigned, r); }
DEVI bf16_t f2bf(float f) { return (bf16_t)(pk2(f, 0.f) & 0xffffu); }
DEVI float sigm(float x) { return 1.f / (1.f + __expf(-x)); }
DEVI float silu(float x) { return x * sigm(x); }
DEVI float softplus_f(float x) {
  const float e = __expf(x);
  return x > 20.f ? x : (e < 0.01f ? e * (1.f - 0.5f * e + 0.33333334f * e * e) : __logf(1.f + e));
}
DEVI f32x4 mfma16(bf16x8 a, bf16x8 b, f32x4 c) { return __builtin_amdgcn_mfma_f32_16x16x32_bf16(a, b, c, 0, 0, 0); }
DEVI bf16x8 as_bf(u32x4 v) { return __builtin_bit_cast(bf16x8, v); }
#define UNPACK8(v, f) do { f[0] = lo2f(v.x); f[1] = hi2f(v.x); f[2] = lo2f(v.y); f[3] = hi2f(v.y); f[4] = lo2f(v.z); f[5] = hi2f(v.z); f[6] = lo2f(v.w); f[7] = hi2f(v.w); } while (0)

DEVI int inmap(int n) { return n < 4096 ? n : (n < 7680 ? n + 16 : n - 7680 + 4096); }

struct WTile { const float* src; const float* scale; bf16_t* dst; int ldsrc, K, Nd, kt, nt, flags; };
DEVI WTile wtile_decode(const Params& p, int it) {
  constexpr int T_IN = 16 * 121, T_OUT = 256, T_UP = 1024, T_DOWN = 1024, T_GATE = 256, T_PROJ = 64;
  constexpr int T_L = T_IN + T_OUT + T_UP + T_DOWN + T_GATE + T_PROJ;
  const int l = it / T_L;
  int r = it % T_L;
  WTile t;
  t.scale = p.norm_mix;
  if (r < T_IN) { t.src = p.w_in + (size_t)l * DM * NIN; t.ldsrc = NIN; t.K = DM; t.Nd = NIN; t.dst = p.wt_in() + (size_t)l * NIN * DM; t.scale = p.norm_mix + l * DM; t.flags = 3; t.kt = r % 16; t.nt = r / 16; return t; }
  r -= T_IN;
  if (r < T_OUT) { t.src = p.w_out + (size_t)l * DM * DM; t.ldsrc = DM; t.K = DM; t.Nd = DM; t.dst = p.wt_out() + (size_t)l * DM * DM; t.flags = 0; t.kt = r % 16; t.nt = r / 16; return t; }
  r -= T_OUT;
  if (r < T_UP) { t.src = p.w_up + (size_t)l * DM * DFF; t.ldsrc = DFF; t.K = DM; t.Nd = DFF; t.dst = p.wt_up() + (size_t)l * DFF * DM; t.scale = p.norm_ffn + l * DM; t.flags = 2; t.kt = r % 16; t.nt = r / 16; return t; }
  r -= T_UP;
  if (r < T_DOWN) { t.src = p.w_down + (size_t)l * DFF * DM; t.ldsrc = DM; t.K = DFF; t.Nd = DM; t.dst = p.wt_down() + (size_t)l * DM * DFF; t.flags = 0; t.kt = r % 64; t.nt = r / 64; return t; }
  r -= T_DOWN;
  if (r < T_GATE) { t.src = p.w_gate + (size_t)l * DM * DM; t.ldsrc = DM; t.K = DM; t.Nd = DM; t.dst = p.wt_gate() + (size_t)l * DM * DM; t.scale = p.norm_ple + l * DM; t.flags = 2; t.kt = r % 16; t.nt = r / 16; return t; }
  r -= T_GATE;
  t.src = p.w_proj + (size_t)l * PLE * DM; t.ldsrc = DM; t.K = PLE; t.Nd = DM; t.dst = p.wt_proj() + (size_t)l * DM * PLE; t.flags = 0; t.kt = r % 4; t.nt = r / 4;
  return t;
}
DEVI void wtile_load(const WTile& t, float (&v)[16], float (&sv)[16], int tid) {
  const int nl = tid & 63, kq = tid >> 6;
  const int n = t.nt * 64 + nl, nc = n < t.Nd ? n : t.Nd - 1;
  const int sc = (t.flags & 1) ? inmap(nc) : nc;
  const int ksc = (t.flags & 2) ? 1 : 0;
#pragma unroll
  for (int r = 0; r < 16; ++r) {
    const int k = t.kt * 64 + r * 4 + kq;
    v[r] = t.src[(size_t)k * t.ldsrc + sc];
    sv[r] = t.scale[(k & 1023) * ksc];
  }
}
DEVI void wtile_store(const WTile& t, const float (&v)[16], const float (&sv)[16], float* sm, int tid) {
  const int nl = tid & 63, kq = tid >> 6;
  const bool ok = t.nt * 64 + nl < t.Nd;
  const bool has = (t.flags & 2) != 0;
#pragma unroll
  for (int r = 0; r < 16; ++r) sm[(r * 4 + kq) * 65 + nl] = ok ? v[r] * (has ? sv[r] : 1.f) : 0.f;
  __syncthreads();
  const int nr = tid >> 2, ks = (tid & 3) * 16;
  if (t.nt * 64 + nr < t.Nd) {
    unsigned w[8];
#pragma unroll
    for (int i = 0; i < 8; ++i) w[i] = pk2(sm[(ks + 2 * i) * 65 + nr], sm[(ks + 2 * i + 1) * 65 + nr]);
    u32x4* d = (u32x4*)(t.dst + (size_t)(t.nt * 64 + nr) * t.K + t.kt * 64 + ks);
    d[0] = (u32x4){w[0], w[1], w[2], w[3]};
    d[1] = (u32x4){w[4], w[5], w[6], w[7]};
  }
  __syncthreads();
}

__device__ void phase_p0(const Params& p, unsigned char* smem) {
  float* sm = (float*)smem;
  const int tid = (opq(threadIdx.x) & 255), lane = tid & 63, wid = tid >> 6;
  {
    constexpr int NT = NL * (16 * 121 + 256 + 1024 + 1024 + 256 + 64);
    const int vb = VB, vg = VG;
    const int nj = (NT - vb + vg - 1) / vg;
#define WT_IDX(j) (vb + ((j) < nj ? (j) : nj - 1) * vg)
    float va[16], sa[16], vb_[16], sb[16], vc[16], sc[16];
    WTile ta = wtile_decode(p, WT_IDX(0));
    wtile_load(ta, va, sa, tid);
    WTile tb = wtile_decode(p, WT_IDX(1));
    wtile_load(tb, vb_, sb, tid);
    for (int j = 0; j < nj; j += 3) {
      const WTile tc = wtile_decode(p, WT_IDX(j + 2));
      wtile_load(tc, vc, sc, tid);
      wtile_store(ta, va, sa, sm, tid);
      ta = wtile_decode(p, WT_IDX(j + 3));
      wtile_load(ta, va, sa, tid);
      if (j + 1 < nj) wtile_store(tb, vb_, sb, sm, tid);
      tb = wtile_decode(p, WT_IDX(j + 4));
      wtile_load(tb, vb_, sb, tid);
      if (j + 2 < nj) wtile_store(tc, vc, sc, sm, tid);
    }
#undef WT_IDX
  }
  for (int it = VB; it < MTOK / 4; it += VG) {
    const int row = it * 4 + wid;
    const float* src = row < MP ? p.x_prompt + (size_t)row * DM : p.x_sample + (size_t)(row - MP) * DM;
    float* hd = p.out + (size_t)row * DM;
    bf16_t* hbd = p.hb() + (size_t)row * DM;
    float ss = 0.f;
#pragma unroll
    for (int i = 0; i < 4; ++i) {
      const int c = i * 256 + lane * 4;
      const f32x4 v = *(const f32x4*)(src + c);
      ss += v.x * v.x + v.y * v.y + v.z * v.z + v.w * v.w;
      *(f32x4*)(hd + c) = v;
      *(u32x2*)(hbd + c) = (u32x2){pk2(v.x, v.y), pk2(v.z, v.w)};
    }
#pragma unroll
    for (int o = 1; o < 64; o <<= 1) ss += shx(ss, o, lane);
    if (lane < 16) p.ssq0()[(size_t)row * 16 + lane] = lane == 0 ? ss : 0.f;
  }
  const int G = NL * MTOK * 32;
  for (int g = VB * NTHR + tid; g < G; g += VG * NTHR) {
    const int l = g / (MTOK * 32), rem = g % (MTOK * 32), row = rem >> 5, c8 = rem & 31;
    const float* src = row < MP ? p.p_prompt + ((size_t)(l * MP + row) * PLE + c8 * 8) : p.p_sample + ((size_t)(l * MS + row - MP) * PLE + c8 * 8);
    const f32x4 a = *(const f32x4*)src, b = *(const f32x4*)(src + 4);
    *(u32x4*)(p.pb() + (size_t)g * 8) = (u32x4){pk2(a.x, a.y), pk2(a.z, a.w), pk2(b.x, b.y), pk2(b.z, b.w)};
  }
}

enum { EPI_PROJ = 0, EPI_LOGIT = 1, EPI_RESID = 2, EPI_UP = 3, EPI_PLE = 4, EPI_PP = 5 };
struct EpiArgs {
  const float* ssq_in; float* ssq_out; float* h; bf16_t* hb; bf16_t* obf; int ldo; float* of32; const bf16_t* pp;
};

template <int EPI>
DEVI float epi_rs(const EpiArgs& e, int row) {
  if (EPI == EPI_PROJ || EPI == EPI_LOGIT || EPI == EPI_UP || EPI == EPI_PLE) {
    const f32x4* sp = (const f32x4*)(e.ssq_in + (size_t)row * 16);
    const f32x4 a = sp[0], b = sp[1], c = sp[2], d = sp[3];
    const float s = ((a.x + a.y) + (a.z + a.w)) + ((b.x + b.y) + (b.z + b.w)) + ((c.x + c.y) + (c.z + c.w)) + ((d.x + d.y) + (d.z + d.w));
    return rsqrtf(s * (1.f / 1024.f) + EPS);
  }
  return 1.f;
}
template <int EPI>
DEVI void epi_elem(const EpiArgs& e, int row, int col, f32x4 v, float rs, float& sq) {
  if (EPI == EPI_PROJ) {
    v *= rs;
    *(u32x2*)(e.obf + (size_t)row * e.ldo + col) = (u32x2){pk2(v.x, v.y), pk2(v.z, v.w)};
  } else if (EPI == EPI_LOGIT) {
    v *= rs;
    *(f32x4*)(e.of32 + (size_t)row * 16 + col) = v;
  } else if (EPI == EPI_PP) {
    *(u32x2*)(e.obf + (size_t)row * e.ldo + (col & 1023)) = (u32x2){pk2(v.x, v.y), pk2(v.z, v.w)};
  } else if (EPI == EPI_UP) {
    v *= rs;
    v.x = fmaxf(v.x, 0.f); v.y = fmaxf(v.y, 0.f); v.z = fmaxf(v.z, 0.f); v.w = fmaxf(v.w, 0.f);
    v = v * v;
    *(u32x2*)(e.obf + (size_t)row * e.ldo + col) = (u32x2){pk2(v.x, v.y), pk2(v.z, v.w)};
  } else {
    float* hp = e.h + (size_t)row * DM + col;
    f32x4 hv = *(const f32x4*)hp;
    if (EPI == EPI_RESID) {
      hv += v;
    } else {
      const u32x2 pv = *(const u32x2*)(e.pp + (size_t)row * DM + col);
      hv.x += sigm(v.x * rs) * lo2f(pv.x); hv.y += sigm(v.y * rs) * hi2f(pv.x);
      hv.z += sigm(v.z * rs) * lo2f(pv.y); hv.w += sigm(v.w * rs) * hi2f(pv.y);
    }
    *(f32x4*)hp = hv;
    *(u32x2*)(e.hb + (size_t)row * DM + col) = (u32x2){pk2(hv.x, hv.y), pk2(hv.z, hv.w)};
    sq += hv.x * hv.x + hv.y * hv.y + hv.z * hv.z + hv.w * hv.w;
  }
}

template <int EPI>
DEVI void epi_elem8(const EpiArgs& e, int row, int col, f32x4 v0, f32x4 v1, float rs, float& sq) {
  if (EPI == EPI_PROJ || EPI == EPI_UP || EPI == EPI_PP) {
    if (EPI != EPI_PP) { v0 *= rs; v1 *= rs; }
    if (EPI == EPI_UP) {
      v0.x = fmaxf(v0.x, 0.f); v0.y = fmaxf(v0.y, 0.f); v0.z = fmaxf(v0.z, 0.f); v0.w = fmaxf(v0.w, 0.f);
      v1.x = fmaxf(v1.x, 0.f); v1.y = fmaxf(v1.y, 0.f); v1.z = fmaxf(v1.z, 0.f); v1.w = fmaxf(v1.w, 0.f);
      v0 = v0 * v0; v1 = v1 * v1;
    }
    const int c = EPI == EPI_PP ? (col & 1023) : col;
    *(u32x4*)(e.obf + (size_t)row * e.ldo + c) = (u32x4){pk2(v0.x, v0.y), pk2(v0.z, v0.w), pk2(v1.x, v1.y), pk2(v1.z, v1.w)};
  } else {
    float* hp = e.h + (size_t)row * DM + col;
    f32x4 h0 = *(const f32x4*)hp, h1 = *(const f32x4*)(hp + 4);
    if (EPI == EPI_RESID) {
      h0 += v0; h1 += v1;
    } else {
      const u32x4 pv = *(const u32x4*)(e.pp + (size_t)row * DM + col);
      h0.x += sigm(v0.x * rs) * lo2f(pv.x); h0.y += sigm(v0.y * rs) * hi2f(pv.x);
      h0.z += sigm(v0.z * rs) * lo2f(pv.y); h0.w += sigm(v0.w * rs) * hi2f(pv.y);
      h1.x += sigm(v1.x * rs) * lo2f(pv.z); h1.y += sigm(v1.y * rs) * hi2f(pv.z);
      h1.z += sigm(v1.z * rs) * lo2f(pv.w); h1.w += sigm(v1.w * rs) * hi2f(pv.w);
    }
    *(f32x4*)hp = h0;
    *(f32x4*)(hp + 4) = h1;
    *(u32x4*)(e.hb + (size_t)row * DM + col) = (u32x4){pk2(h0.x, h0.y), pk2(h0.z, h0.w), pk2(h1.x, h1.y), pk2(h1.z, h1.w)};
    sq += (h0.x * h0.x + h0.y * h0.y + h0.z * h0.z + h0.w * h0.w) + (h1.x * h1.x + h1.y * h1.y + h1.z * h1.z + h1.w * h1.w);
  }
}

template <int WMT, int WNT, int WGM, int WGN, int EPI, int BK = 32, bool KSPLIT = false>
__device__ __forceinline__ void gemm_tile(const bf16_t* __restrict__ A, int lda, const bf16_t* __restrict__ Bt, int ldb, int K, int m0, int n0,
                                          bf16_t* lds, const EpiArgs& e) {
  constexpr int BM = WGM * WMT * 16, BN = WGN * WNT * 16, LDR = BK + 8;
  constexpr int STAGE = (BM + BN) * LDR;
  constexpr int PPR = BK / 8, RPI = NTHR / PPR;
  constexpr int NA = BM / RPI, NB = (BN + RPI - 1) / RPI;
  const int tid = (opq(threadIdx.x) & 255), lane = tid & 63, wid = tid >> 6;
  const int wm = wid / WGN, wn = wid % WGN;
  const int fr = lane & 15, fq = lane >> 4;
  f32x4 acc[WMT][WNT];
#pragma unroll
  for (int i = 0; i < WMT; ++i)
#pragma unroll
    for (int j = 0; j < WNT; ++j) acc[i][j] = (f32x4){0.f, 0.f, 0.f, 0.f};
  u32x4 ra0[NA], rb0[NB], ra1[NA], rb1[NB];
  const int khalf = KSPLIT ? VHALF : 0;
  const int nk = (KSPLIT ? K / 2 : K) / BK;
  const int prow = tid / PPR, ppc = tid % PPR;
  const unsigned ta = (unsigned)(prow * lda + ppc * 8) * 2u, tb = (unsigned)(prow * ldb + ppc * 8) * 2u;
  const char* Au = (const char*)(A + (size_t)m0 * lda + (size_t)khalf * (K / 2));
  const char* Bu = (const char*)(Bt + (size_t)n0 * ldb + (size_t)khalf * (K / 2));
#define BGUARD(i) (BN >= RPI * ((i) + 1) || prow + (i) * RPI < BN)
#define GLOAD(kt, RA, RB) do { \
    _Pragma("unroll") for (int i = 0; i < NA; ++i) RA[i] = *(const u32x4*)(Au + ((size_t)i * RPI * lda + (size_t)(kt) * BK) * 2 + ta); \
    _Pragma("unroll") for (int i = 0; i < NB; ++i) if (BGUARD(i)) RB[i] = *(const u32x4*)(Bu + ((size_t)i * RPI * ldb + (size_t)(kt) * BK) * 2 + tb); \
  } while (0)
#define LSTORE(st, RA, RB) do { bf16_t* sA_ = lds + (st) * STAGE; bf16_t* sB_ = sA_ + BM * LDR; \
    _Pragma("unroll") for (int i = 0; i < NA; ++i) *(u32x4*)(sA_ + (prow + i * RPI) * LDR + ppc * 8) = RA[i]; \
    _Pragma("unroll") for (int i = 0; i < NB; ++i) if (BGUARD(i)) *(u32x4*)(sB_ + (prow + i * RPI) * LDR + ppc * 8) = RB[i]; \
  } while (0)
#define COMPUTE(st) do { const bf16_t* sA = lds + (st) * STAGE; const bf16_t* sB = sA + BM * LDR; \
    _Pragma("unroll") for (int kk = 0; kk < BK / 32; ++kk) { \
      bf16x8 bfr[WNT]; \
      _Pragma("unroll") for (int nt = 0; nt < WNT; ++nt) bfr[nt] = *(const bf16x8*)(sB + (wn * WNT * 16 + nt * 16 + fr) * LDR + kk * 32 + fq * 8); \
      _Pragma("unroll") for (int mt = 0; mt < WMT; ++mt) { \
        const bf16x8 af = *(const bf16x8*)(sA + (wm * WMT * 16 + mt * 16 + fr) * LDR + kk * 32 + fq * 8); \
        _Pragma("unroll") for (int nt = 0; nt < WNT; ++nt) acc[mt][nt] = mfma16(bfr[nt], af, acc[mt][nt]); } } \
  } while (0)
  GLOAD(0, ra0, rb0);
  GLOAD(1, ra1, rb1);
  LSTORE(0, ra0, rb0);
  __syncthreads();
  for (int kt = 0; kt < nk; kt += 2) {
    const int k2 = kt + 2 < nk ? kt + 2 : nk - 2;
    GLOAD(k2, ra0, rb0);
    COMPUTE(0);
    LSTORE(1, ra1, rb1);
    __syncthreads();
    GLOAD(k2 + 1, ra1, rb1);
    COMPUTE(1);
    LSTORE(0, ra0, rb0);
    __syncthreads();
  }
#undef BGUARD
#undef COMPUTE
#undef GLOAD
#undef LSTORE
  if (KSPLIT) {
    f32x4* red = (f32x4*)((unsigned char*)lds + (khalf ? 0 : SMEM_BYTES));
    if (khalf == 1) {
#pragma unroll
      for (int i = 0; i < WMT; ++i)
#pragma unroll
        for (int j = 0; j < WNT; ++j) red[((wid * WMT + i) * WNT + j) * 64 + lane] = acc[i][j];
    }
    __syncthreads();
    if (khalf == 0) {
#pragma unroll
      for (int i = 0; i < WMT; ++i)
#pragma unroll
        for (int j = 0; j < WNT; ++j) acc[i][j] += red[((wid * WMT + i) * WNT + j) * 64 + lane];
    }
  }
  if (!KSPLIT || khalf == 0) {
#pragma unroll
  for (int mt = 0; mt < WMT; ++mt) {
    const int row = m0 + wm * WMT * 16 + mt * 16 + fr;
    const float rs = epi_rs<EPI>(e, row);
    float sq = 0.f;
#pragma unroll
    for (int nt = 0; nt < WNT; ++nt) epi_elem<EPI>(e, row, n0 + wn * WNT * 16 + nt * 16 + fq * 4, acc[mt][nt], rs, sq);
    if (EPI == EPI_RESID || EPI == EPI_PLE) {
      sq += shx(sq, 16, lane);
      sq += shx(sq, 32, lane);
      if (fq == 0) e.ssq_out[(size_t)row * 16 + (n0 / BN) * WGN + wn] = sq;
    }
  }
  }
  if (KSPLIT) __syncthreads();
}

namespace pg8 {
#define PG8_LAS __attribute__((address_space(3)))
typedef unsigned short bf16_t;
typedef short bf16x8 __attribute__((ext_vector_type(8)));
typedef float f32x4 __attribute__((ext_vector_type(4)));
typedef unsigned u32x4 __attribute__((ext_vector_type(4)));
constexpr int BM = 256, BK = 64, HALF = 128, HTB = HALF * BK * 2  , STAGE_BYTES = 8 * HTB, NXCD = 8, WGM = 8;

__host__ __device__ __forceinline__ int lds_byte(int r, int c) { const int st = (r >> 4) * 2 + (c >> 5), rr = r & 15, cc = c & 31, ob = rr * 64 + cc * 2; return st * 1024 + (ob ^ (((ob >> 9) & 1) << 5)); }
__host__ __device__ __forceinline__ void stage_rc(int b, int& R, int& C) { const int st = b / 1024, sb = b % 1024, swz = sb ^ (((sb >> 9) & 1) << 5); R = (st >> 1) * 16 + swz / 64; C = (st & 1) * 32 + (swz % 64) / 2; }
__host__ __device__ __forceinline__ int perm32(int rho) { const int n = rho >> 4, i = rho & 15; return 8 * (i >> 2) + 4 * n + (i & 3); }

struct Unit { int pm, pn; };
struct Gemm { const bf16_t* A; const bf16_t* Bt; int M, N, K; };

template <class Epi, class Sched, bool STAMP = false>
__device__ __forceinline__ void gemm_phase(PG8_LAS unsigned char* lds, const Gemm g, const Sched& S, const Epi& E, unsigned long long* stamps) {
    const int tid = opq((int)threadIdx.x), wid = __builtin_amdgcn_readfirstlane(tid >> 6), lane = tid & 63, wr = wid >> 2, wc = wid & 3, fr = lane & 15, fq = lane >> 4;
    const int K = g.K, nt = K / BK;
    int ts_lo = 0, ts_hi = 0, nts = 0; const unsigned long long rt_entry = STAMP ? (unsigned long long)wall_clock64() : 0ull;
#define PG8_STAMP() do { if (STAMP && wid == 0 && nts < 64) { const unsigned long long _c = (unsigned long long)clock64(); \
        ts_lo = (lane == nts) ? (int)(unsigned)_c : ts_lo; ts_hi = (lane == nts) ? (int)(unsigned)(_c >> 32) : ts_hi; ++nts; } } while (0)
    PG8_STAMP();
    unsigned voffA[2], voffB[2];
#pragma unroll
    for (int i = 0; i < 2; ++i) { int R, C; stage_rc(tid * 16 + i * 8192, R, C); const int Rb = Epi::PERM ? ((R & ~31) + perm32(R & 31)) : R;
        voffA[i] = (unsigned)(R * K + C) * 2u; voffB[i] = (unsigned)(Rb * K + C) * 2u; }
    const size_t kstep = (size_t)(BK * 2);
    const size_t hstep = (size_t)HALF * K * 2;
    const size_t tstep = 2 * hstep;
    const unsigned ldsw = (unsigned)wid * 1024u;
    const int aoff = lds_byte(wr * 64 + fr, fq * 8), boff = lds_byte(wc * 32 + fr, fq * 8);
#define PG8_SA(b, h) (((b) * 2 + (h)) * HTB)
#define PG8_SB(b, h) ((4 + (b) * 2 + (h)) * HTB)
#define PG8_STAGE(bufoff, gbase, voff) do { _Pragma("unroll") for (int _i = 0; _i < 2; ++_i) \
        __builtin_amdgcn_global_load_lds((const unsigned*)((const char*)(gbase) + (voff)[_i]), (PG8_LAS unsigned*)(lds + (bufoff) + ldsw + _i * 8192), 16, 0, 0); } while (0)
#define PG8_LDA(dst, b, h) do { _Pragma("unroll") for (int m = 0; m < 4; ++m) _Pragma("unroll") for (int k = 0; k < 2; ++k) dst[m][k] = *(const PG8_LAS bf16x8*)(lds + PG8_SA(b, h) + aoff + m * 2048 + k * 1024); } while (0)
#define PG8_LDB(dst, b, h) do { _Pragma("unroll") for (int n = 0; n < 2; ++n) _Pragma("unroll") for (int k = 0; k < 2; ++k) dst[n][k] = *(const PG8_LAS bf16x8*)(lds + PG8_SB(b, h) + boff + n * 2048 + k * 1024); } while (0)
#define PG8_MMA(ai, bj, At, Bt) do { __builtin_amdgcn_s_setprio(1); _Pragma("unroll") for (int m = 0; m < 4; ++m) _Pragma("unroll") for (int n = 0; n < 2; ++n) _Pragma("unroll") for (int k = 0; k < 2; ++k) \
        acc[ai][bj][m][n] = __builtin_amdgcn_mfma_f32_16x16x32_bf16(Bt[n][k], At[m][k], acc[ai][bj][m][n], 0, 0, 0); __builtin_amdgcn_s_setprio(0); } while (0)
#define PG8_WAIT_V(n) asm volatile("s_waitcnt vmcnt(" #n ")" ::: "memory")
#define PG8_WAIT_L(n) asm volatile("s_waitcnt lgkmcnt(" #n ")" ::: "memory")
#define PG8_BAR __builtin_amdgcn_s_barrier()
#define PG8_SCHED __builtin_amdgcn_sched_barrier(0)
    Unit cur, nxt; int ui = 0;
    if (!S.next(0, cur)) return;
    f32x4 acc[2][2][4][2];
#pragma unroll
    for (int a = 0; a < 2; ++a)
#pragma unroll
        for (int b = 0; b < 2; ++b)
#pragma unroll
            for (int m = 0; m < 4; ++m)
#pragma unroll
                for (int n = 0; n < 2; ++n) acc[a][b][m][n] = (f32x4){0.f, 0.f, 0.f, 0.f};
    bf16x8 At[4][2], B0[2][2], B1[2][2];
    const char* cA = (const char*)g.A + (size_t)cur.pm * tstep; const char* cB = (const char*)g.Bt + (size_t)cur.pn * tstep;
    S.a_ready(cur);
    PG8_STAGE(PG8_SB(0, 0), cB, voffB); PG8_STAGE(PG8_SA(0, 0), cA, voffA); PG8_STAGE(PG8_SB(0, 1), cB + hstep, voffB); PG8_STAGE(PG8_SA(0, 1), cA + hstep, voffA);
    if (wr == 1) PG8_BAR;
    PG8_WAIT_V(4); PG8_BAR;
    PG8_STAGE(PG8_SB(1, 0), cB + kstep, voffB); PG8_STAGE(PG8_SA(1, 0), cA + kstep, voffA); PG8_STAGE(PG8_SB(1, 1), cB + hstep + kstep, voffB);
    PG8_WAIT_V(6); PG8_BAR;
    PG8_STAMP();
    for (;;) {
        const bool has_next = S.next(ui + 1, nxt);
        const char* nA = has_next ? (const char*)g.A + (size_t)nxt.pm * tstep : cA; const char* nB = has_next ? (const char*)g.Bt + (size_t)nxt.pn * tstep : cB;
        for (int t = 0; t < nt; t += 2) {
            const bool last = (t == nt - 2);
            const char* a1 = cA + (size_t)(t + 1) * kstep;
            const char* a2 = last ? nA : cA + (size_t)(t + 2) * kstep; const char* b2 = last ? nB : cB + (size_t)(t + 2) * kstep;
            const char* a3 = a2 + kstep; const char* b3 = b2 + kstep;
            if (last && has_next) S.a_ready(nxt);
            PG8_LDB(B0, 0, 0); PG8_SCHED; PG8_LDA(At, 0, 0); PG8_STAGE(PG8_SA(1, 1), a1 + hstep, voffA);
            PG8_WAIT_L(8); PG8_BAR; PG8_WAIT_L(0); PG8_MMA(0, 0, At, B0); PG8_BAR; PG8_SCHED;
            PG8_LDB(B1, 0, 1); PG8_STAGE(PG8_SB(0, 0), b2, voffB);
            PG8_BAR; PG8_WAIT_L(0); PG8_MMA(0, 1, At, B1); PG8_BAR;
            PG8_LDA(At, 0, 1); PG8_STAGE(PG8_SA(0, 0), a2, voffA);
            PG8_BAR; PG8_WAIT_L(0); PG8_MMA(1, 0, At, B0); PG8_BAR; PG8_SCHED;
            PG8_STAGE(PG8_SB(0, 1), b2 + hstep, voffB);
            PG8_WAIT_V(6); PG8_BAR; PG8_MMA(1, 1, At, B1); PG8_BAR;
            PG8_LDB(B0, 1, 0); PG8_SCHED; PG8_LDA(At, 1, 0); PG8_STAGE(PG8_SA(0, 1), a2 + hstep, voffA);
            PG8_WAIT_L(8); PG8_BAR; PG8_WAIT_L(0); PG8_MMA(0, 0, At, B0); PG8_BAR; PG8_SCHED;
            PG8_LDB(B1, 1, 1); PG8_STAGE(PG8_SB(1, 0), b3, voffB);
            PG8_BAR; PG8_WAIT_L(0); PG8_MMA(0, 1, At, B1); PG8_BAR;
            PG8_LDA(At, 1, 1); PG8_STAGE(PG8_SA(1, 0), a3, voffA);
            PG8_BAR; PG8_WAIT_L(0); PG8_MMA(1, 0, At, B0); PG8_BAR; PG8_SCHED;
            PG8_STAGE(PG8_SB(1, 1), b3 + hstep, voffB);
            PG8_WAIT_V(6); PG8_BAR; PG8_MMA(1, 1, At, B1); PG8_BAR;
        }
        PG8_STAMP();
        if constexpr (!Epi::AFTER_DRAIN) { E(acc, cur, wr, wc, fr, fq); S.done(cur); }
        PG8_STAMP();
        if (!has_next) break;
#pragma unroll
        for (int a = 0; a < 2; ++a)
#pragma unroll
            for (int b = 0; b < 2; ++b)
#pragma unroll
                for (int m = 0; m < 4; ++m)
#pragma unroll
                    for (int n = 0; n < 2; ++n) acc[a][b][m][n] = (f32x4){0.f, 0.f, 0.f, 0.f};
        cur = nxt; cA = nA; cB = nB; ++ui;
    }
    PG8_WAIT_V(0);
    if (wr == 0) PG8_BAR;
    PG8_BAR;
    if constexpr (Epi::AFTER_DRAIN) { E.fused(acc, cur, wr, wc, fr, fq, lds, wid, lane); S.done(cur); }
    PG8_STAMP();
    if (STAMP && wid == 0) { stamps[lane] = lane < nts ? (((unsigned long long)(unsigned)ts_hi << 32) | (unsigned)ts_lo) : 0ull;
        if (lane == 62) stamps[62] = rt_entry; if (lane == 63) stamps[63] = (unsigned long long)wall_clock64(); }
#undef PG8_STAMP
#undef PG8_SA
#undef PG8_SB
#undef PG8_STAGE
#undef PG8_LDA
#undef PG8_LDB
#undef PG8_MMA
#undef PG8_WAIT_V
#undef PG8_WAIT_L
#undef PG8_BAR
#undef PG8_SCHED
}
}

DEVI void unit_map(int L, int nM, int nN, int& pm, int& pn) {
  const int nwg = nM * nN, q = nwg / 8, r = nwg % 8, xcd = L % 8, off = L / 8;
  const int wgid = (xcd < r ? xcd * (q + 1) : r * (q + 1) + (xcd - r) * q) + off;
  const int nig = 8 * nN, gid = wgid / nig, fm = gid * 8, gsz = (nM - fm) < 8 ? (nM - fm) : 8, w = wgid - gid * nig;
  pm = fm + (w % gsz); pn = w / gsz;
}
struct RowSched {
  int nM, nN, nLimit, G, c;
  __device__ __forceinline__ bool next(int i, pg8::Unit& u) const { const int L = i * G + c; if (L >= nLimit) return false; unit_map(L, nM, nN, u.pm, u.pn); return true; }
  __device__ __forceinline__ void a_ready(const pg8::Unit&) const {}
  __device__ __forceinline__ void done(const pg8::Unit&) const {}
};
struct DiagSched {
  int nLimit, G, c;
  __device__ __forceinline__ bool next(int i, pg8::Unit& u) const { const int L = i * G + c; if (L >= nLimit) return false; const int l = L / 272, r = L - l * 272; u.pm = l * 68 + (r >> 2); u.pn = l * 4 + (r & 3); return true; }
  __device__ __forceinline__ void a_ready(const pg8::Unit&) const {}
  __device__ __forceinline__ void done(const pg8::Unit&) const {}
};
template <int EPI> struct BigEpi {
  static constexpr bool PERM = true, AFTER_DRAIN = false;
  EpiArgs e;
  __device__ __forceinline__ void operator()(const f32x4 (&acc)[2][2][4][2], const pg8::Unit& u, int wr, int wc, int fr, int fq) const {
    const int lane = fq * 16 + fr;
#pragma unroll
    for (int ai = 0; ai < 2; ++ai)
#pragma unroll
      for (int m = 0; m < 4; ++m) {
        const int row = u.pm * 256 + ai * 128 + wr * 64 + m * 16 + fr;
        const float rs = epi_rs<EPI>(e, row);
        float sq = 0.f;
#pragma unroll
        for (int bj = 0; bj < 2; ++bj) epi_elem8<EPI>(e, row, u.pn * 256 + bj * 128 + wc * 32 + fq * 8, acc[ai][bj][m][0], acc[ai][bj][m][1], rs, sq);
        if (EPI == EPI_RESID || EPI == EPI_PLE) {
          sq += shx(sq, 16, lane);
          sq += shx(sq, 32, lane);
          if (fq == 0) e.ssq_out[(size_t)row * 16 + u.pn * 4 + wc] = sq;
        }
      }
  }
};

template <int EPI>
__device__ void gemm_big_phase(const bf16_t* A, const bf16_t* Bt, int K, int M, int N, unsigned char* lds_all, unsigned char* smem_half, const EpiArgs& e) {
  const int nM = M / 256, nN = N / 256, nU = nM * nN, G = gridDim.x;
  const int L = nU % G;
  const int nLimit = (L > 0 && L <= G / 4) ? nU - L : nU;
  RowSched S; S.nM = nM; S.nN = nN; S.nLimit = nLimit; S.G = G; S.c = blockIdx.x;
  pg8::Gemm g; g.A = A; g.Bt = Bt; g.M = M; g.N = N; g.K = K;
  BigEpi<EPI> E; E.e = e;
  pg8::gemm_phase<BigEpi<EPI>, RowSched>((PG8_LAS unsigned char*)lds_all, g, S, E, nullptr);
  __syncthreads();
  const int nSmall = (nU - nLimit) * 16;
  if (nSmall <= G && K >= 512) {
    for (int st = blockIdx.x; st < nSmall; st += G) {
      const int sub = st & 15; int pm, pn; unit_map(nLimit + (st >> 4), nM, nN, pm, pn);
      gemm_tile<1, 4, 4, 1, EPI, 128, true>(A, K, Bt, K, K, pm * 256 + (sub >> 2) * 64, pn * 256 + (sub & 3) * 64, (bf16_t*)smem_half, e);
    }
  } else {
    for (int st = VB; st < nSmall; st += VG) {
      const int sub = st & 15; int pm, pn; unit_map(nLimit + (st >> 4), nM, nN, pm, pn);
      gemm_tile<1, 4, 4, 1, EPI, 128>(A, K, Bt, K, K, pm * 256 + (sub >> 2) * 64, pn * 256 + (sub & 3) * 64, (bf16_t*)smem_half, e);
    }
  }
}


template <int I, int J4>
DEVI void solve_sub4(float& r, const float (&x)[64], const float* Am) {
  if constexpr (J4 * 4 < I) {
    const f32x4 a = *(const f32x4*)(Am + I * 64 + J4 * 4);
    if constexpr (J4 * 4 + 0 < I) r -= a.x * x[J4 * 4 + 0];
    if constexpr (J4 * 4 + 1 < I) r -= a.y * x[J4 * 4 + 1];
    if constexpr (J4 * 4 + 2 < I) r -= a.z * x[J4 * 4 + 2];
    if constexpr (J4 * 4 + 3 < I) r -= a.w * x[J4 * 4 + 3];
    solve_sub4<I, J4 + 1>(r, x, Am);
  }
}
template <int I>
DEVI void solve_rows(float (&x)[64], const float* Am, const bf16_t* src, const float* sc) {
  if constexpr (I < 64) {
    float r = bf2f(src[I * 136]) * sc[I];
    solve_sub4<I, 0>(r, x, Am);
    x[I] = r;
    asm volatile("" ::: "memory");
    solve_rows<I + 1>(x, Am, src, sc);
  }
}

__device__ void gdn_prep_item(const Params& p, int l, int item, unsigned char* smem) {
  const int tid = (opq(threadIdx.x) & 255), lane = tid & 63, wid = tid >> 6, fr = lane & 15, fq = lane >> 4;
  const int h = item & 7, n = (item >> 3) & 31, b = item >> 8;
  const int tok0 = b * 2048 + n * 64;
  bf16_t* qh = (bf16_t*)smem;
  bf16_t* kh = qh + 64 * 136;
  bf16_t* vh = kh + 64 * 136;
  float* Am = (float*)(vh + 64 * 136);
  float* sbeta = Am + 64 * 64;
  float* sgc = sbeta + 64;
  float* sbe = sgc + 64;
  unsigned char* scr = (unsigned char*)p.scr() + (size_t)item * SCR_ITEM;
  bf16_t* g_uT = (bf16_t*)scr;
  bf16_t* g_w = (bf16_t*)(scr + 16384);
  bf16_t* g_qg = (bf16_t*)(scr + 32768);
  bf16_t* g_kgT = (bf16_t*)(scr + 49152);
  bf16_t* g_qk = (bf16_t*)(scr + 65536);

  if (wid == 0) {
    const float* lg = p.logits() + (size_t)(tok0 + lane) * 16;
    const float bl = lg[h], al = lg[8 + h];
    const float x = al + p.dt_bias[l * 8 + h];
    const float sp = softplus_f(x);
    float g = -__expf(p.a_log[l * 8 + h]) * sp;
#pragma unroll
    for (int o = 1; o < 64; o <<= 1) { const float t = shup(g, o, lane); if (lane >= o) g += t; }
    sbeta[lane] = sigm(bl);
    sgc[lane] = g;
    sbe[lane] = sigm(bl) * __expf(g);
  }
  u32x4 rwall[3][7];
#pragma unroll
  for (int sect = 0; sect < 3; ++sect)
#pragma unroll
    for (int r = 0; r < 7; ++r) {
      const int tl = n * 64 + wid * 16 + fq * 4 - 3 + r;
      rwall[sect][r] = (u32x4){0u, 0u, 0u, 0u};
      if (tl >= 0) rwall[sect][r] = *(const u32x4*)(p.proj() + (size_t)(b * 2048 + tl) * NPJ + sect * 1024 + h * 128 + fr * 8);
    }
#pragma unroll
  for (int sect = 0; sect < 3; ++sect) {
    const int ch0 = sect * 1024 + h * 128 + fr * 8;
    float cw[4][8];
#pragma unroll
    for (int j = 0; j < 4; ++j) {
      const f32x4 a = *(const f32x4*)(p.conv_w + (size_t)(l * 4 + j) * 3072 + ch0), c = *(const f32x4*)(p.conv_w + (size_t)(l * 4 + j) * 3072 + ch0 + 4);
      cw[j][0] = a.x; cw[j][1] = a.y; cw[j][2] = a.z; cw[j][3] = a.w; cw[j][4] = c.x; cw[j][5] = c.y; cw[j][6] = c.z; cw[j][7] = c.w;
    }
    const int ib = wid * 16 + fq * 4;
#pragma unroll
    for (int it = 0; it < 4; ++it) {
      float o[8];
#pragma unroll
      for (int c = 0; c < 8; ++c) o[c] = 0.f;
#pragma unroll
      for (int j = 0; j < 4; ++j) {
        float f[8];
        UNPACK8(rwall[sect][it + j], f);
#pragma unroll
        for (int c = 0; c < 8; ++c) o[c] += f[c] * cw[j][c];
      }
      float ss = 0.f;
#pragma unroll
      for (int c = 0; c < 8; ++c) { o[c] = silu(o[c]); ss += o[c] * o[c]; }
      if (sect < 2) {
        ss += shx(ss, 1, lane); ss += shx(ss, 2, lane); ss += shx(ss, 4, lane); ss += shx(ss, 8, lane);
        float rn = rsqrtf(ss + EPS);
        if (sect == 0) rn *= 0.08838834764831845f;
#pragma unroll
        for (int c = 0; c < 8; ++c) o[c] *= rn;
      }
      const u32x4 pk = (u32x4){pk2(o[0], o[1]), pk2(o[2], o[3]), pk2(o[4], o[5]), pk2(o[6], o[7])};
      bf16_t* dst = sect == 0 ? qh + (ib + it) * 136 + fr * 8 : (sect == 1 ? kh + (ib + it) * 136 + fr * 8 : vh + (ib + it) * 136 + fr * 8);
      *(u32x4*)dst = pk;
    }
  }
  __syncthreads();
  {
    const int i = wid * 16 + fr;
    const float gi = sgc[i], bi = sbeta[i];
    bf16x8 kx[4], qx[4];
#pragma unroll
    for (int ks = 0; ks < 4; ++ks) {
      kx[ks] = *(const bf16x8*)(kh + i * 136 + ks * 32 + fq * 8);
      qx[ks] = *(const bf16x8*)(qh + i * 136 + ks * 32 + fq * 8);
    }
#pragma unroll
    for (int jt = 0; jt < 4; ++jt) {
      f32x4 akk = (f32x4){0.f, 0.f, 0.f, 0.f}, aqk = (f32x4){0.f, 0.f, 0.f, 0.f};
      if (jt <= wid) {
#pragma unroll
        for (int ks = 0; ks < 4; ++ks) {
          const bf16x8 kj = *(const bf16x8*)(kh + (jt * 16 + fr) * 136 + ks * 32 + fq * 8);
          akk = mfma16(kj, kx[ks], akk);
          aqk = mfma16(kj, qx[ks], aqk);
        }
      }
      const int j0 = jt * 16 + fq * 4;
      float av[4], qv[4];
#pragma unroll
      for (int jj = 0; jj < 4; ++jj) {
        const int j = j0 + jj;
        const float dec = j <= i ? __expf(gi - sgc[j]) : 0.f;
        av[jj] = j < i ? bi * akk[jj] * dec : 0.f;
        qv[jj] = aqk[jj] * dec;
      }
      *(f32x4*)(Am + i * 64 + j0) = (f32x4){av[0], av[1], av[2], av[3]};
      *(u32x2*)(g_qk + i * 64 + j0) = (u32x2){pk2(qv[0], qv[1]), pk2(qv[2], qv[3])};
    }
  }
  __syncthreads();
  {
    float x[64];
    const bool isu = tid < 128;
    const int cc = tid & 127;
    solve_rows<0>(x, Am, (isu ? vh : kh) + cc, isu ? sbeta : sbe);
    if (isu) {
      u32x4* d = (u32x4*)(g_uT + cc * 64);
#pragma unroll
      for (int q = 0; q < 8; ++q) d[q] = (u32x4){pk2(x[q * 8], x[q * 8 + 1]), pk2(x[q * 8 + 2], x[q * 8 + 3]), pk2(x[q * 8 + 4], x[q * 8 + 5]), pk2(x[q * 8 + 6], x[q * 8 + 7])};
    } else {
#pragma unroll
      for (int i = 0; i < 64; ++i) g_w[i * 128 + cc] = f2bf(x[i]);
    }
  }
  {
    const float gl = sgc[63];
#pragma unroll
    for (int q = 0; q < 4; ++q) {
      const int pc = tid + q * 256, i = pc >> 4, c8 = pc & 15;
      const u32x4 v = *(const u32x4*)(qh + i * 136 + c8 * 8);
      float f[8];
      UNPACK8(v, f);
      const float s = __expf(sgc[i]);
      *(u32x4*)(g_qg + i * 128 + c8 * 8) = (u32x4){pk2(f[0] * s, f[1] * s), pk2(f[2] * s, f[3] * s), pk2(f[4] * s, f[5] * s), pk2(f[6] * s, f[7] * s)};
    }
    if (tid >= 128) {
      const int dk = tid - 128;
      u32x4* d = (u32x4*)(g_kgT + dk * 64);
#pragma unroll
      for (int q = 0; q < 8; ++q) {
        float f[8];
#pragma unroll
        for (int c = 0; c < 8; ++c) { const int i = q * 8 + c; f[c] = bf2f(kh[i * 136 + dk]) * __expf(gl - sgc[i]); }
        d[q] = (u32x4){pk2(f[0], f[1]), pk2(f[2], f[3]), pk2(f[4], f[5]), pk2(f[6], f[7])};
      }
    }
    if (tid == 0) p.gsc()[item] = __expf(gl);
  }
  __syncthreads();
}

__device__ void gdn_scan_item(const Params& p, int l, int item, unsigned char* smem) {
  const int tid = (opq(threadIdx.x) & 255), lane = tid & 63, wid = tid >> 6, fr = lane & 15, fq = lane >> 4;
  const int dvs = item & 3, h = (item >> 2) & 7, b = item >> 5;
  bf16_t* ST = (bf16_t*)smem;
  bf16_t* VT = ST + 2 * 32 * 136;
  f32x4 S[2][2];
#pragma unroll
  for (int a = 0; a < 2; ++a)
#pragma unroll
    for (int c = 0; c < 2; ++c) S[a][c] = (f32x4){0.f, 0.f, 0.f, 0.f};
  __syncthreads();
  bf16x8 fw[4], fqg[4], fqk[2], fkg[2][2];
  u32x2 fu[2];
  float gs;
  bf16x8 nw[4], nqg[4], nqk[2], nkg[2][2];
  u32x2 nu[2];
  float ngs;
#define SCAN_LOAD(n_, W, QG, QK, KG, U, GS) do { \
    const int it_ = ((b * 32 + (n_)) << 3) + h; \
    const unsigned char* scr_ = (const unsigned char*)p.scr() + (size_t)it_ * SCR_ITEM; \
    const bf16_t* g_uT = (const bf16_t*)scr_; const bf16_t* g_w = (const bf16_t*)(scr_ + 16384); const bf16_t* g_qg = (const bf16_t*)(scr_ + 32768); \
    const bf16_t* g_kgT = (const bf16_t*)(scr_ + 49152); const bf16_t* g_qk = (const bf16_t*)(scr_ + 65536); \
    _Pragma("unroll") for (int ks = 0; ks < 4; ++ks) { \
      W[ks] = *(const bf16x8*)(g_w + (wid * 16 + fr) * 128 + ks * 32 + fq * 8); \
      QG[ks] = *(const bf16x8*)(g_qg + (wid * 16 + fr) * 128 + ks * 32 + fq * 8); } \
    _Pragma("unroll") for (int ks = 0; ks < 2; ++ks) { \
      QK[ks] = *(const bf16x8*)(g_qk + (wid * 16 + fr) * 64 + ks * 32 + fq * 8); \
      _Pragma("unroll") for (int mt = 0; mt < 2; ++mt) KG[mt][ks] = *(const bf16x8*)(g_kgT + ((2 * wid + mt) * 16 + fr) * 64 + ks * 32 + fq * 8); } \
    _Pragma("unroll") for (int nt = 0; nt < 2; ++nt) U[nt] = *(const u32x2*)(g_uT + (dvs * 32 + nt * 16 + fr) * 64 + wid * 16 + fq * 4); \
    GS = p.gsc()[it_]; } while (0)
  SCAN_LOAD(0, nw, nqg, nqk, nkg, nu, ngs);
  for (int n = 0; n < 32; ++n) {
#pragma unroll
    for (int ks = 0; ks < 4; ++ks) { fw[ks] = nw[ks]; fqg[ks] = nqg[ks]; }
#pragma unroll
    for (int ks = 0; ks < 2; ++ks) { fqk[ks] = nqk[ks]; fkg[0][ks] = nkg[0][ks]; fkg[1][ks] = nkg[1][ks]; }
    fu[0] = nu[0]; fu[1] = nu[1]; gs = ngs;
    if (n + 1 < 32) SCAN_LOAD(n + 1, nw, nqg, nqk, nkg, nu, ngs);
    bf16_t* STc = ST + (n & 1) * 32 * 136;
#pragma unroll
    for (int mt = 0; mt < 2; ++mt)
#pragma unroll
      for (int nt = 0; nt < 2; ++nt)
        *(u32x2*)(STc + (nt * 16 + fr) * 136 + (2 * wid + mt) * 16 + fq * 4) = (u32x2){pk2(S[mt][nt].x, S[mt][nt].y), pk2(S[mt][nt].z, S[mt][nt].w)};
    __syncthreads();
#pragma unroll
    for (int nt = 0; nt < 2; ++nt) {
      f32x4 a = (f32x4){0.f, 0.f, 0.f, 0.f};
#pragma unroll
      for (int ks = 0; ks < 4; ++ks) {
        const bf16x8 sb = *(const bf16x8*)(STc + (nt * 16 + fr) * 136 + ks * 32 + fq * 8);
        a = mfma16(fw[ks], sb, a);
      }
      const float v0 = lo2f(fu[nt].x) - a.x, v1 = hi2f(fu[nt].x) - a.y, v2 = lo2f(fu[nt].y) - a.z, v3 = hi2f(fu[nt].y) - a.w;
      *(u32x2*)(VT + (nt * 16 + fr) * 72 + wid * 16 + fq * 4) = (u32x2){pk2(v0, v1), pk2(v2, v3)};
    }
    __syncthreads();
#pragma unroll
    for (int mt = 0; mt < 2; ++mt) {
      f32x4 a = (f32x4){0.f, 0.f, 0.f, 0.f};
#pragma unroll
      for (int ks = 0; ks < 4; ++ks) {
        const bf16x8 sa = *(const bf16x8*)(STc + (mt * 16 + fr) * 136 + ks * 32 + fq * 8);
        a = mfma16(sa, fqg[ks], a);
      }
#pragma unroll
      for (int ks = 0; ks < 2; ++ks) {
        const bf16x8 va = *(const bf16x8*)(VT + (mt * 16 + fr) * 72 + ks * 32 + fq * 8);
        a = mfma16(va, fqk[ks], a);
      }
      const size_t row = (size_t)b * 2048 + n * 64 + wid * 16 + fr;
      *(u32x2*)(p.ogdn() + row * DM + h * 128 + dvs * 32 + mt * 16 + fq * 4) = (u32x2){pk2(a.x, a.y), pk2(a.z, a.w)};
    }
#pragma unroll
    for (int mt = 0; mt < 2; ++mt)
#pragma unroll
      for (int nt = 0; nt < 2; ++nt) {
        f32x4 a = S[mt][nt] * gs;
#pragma unroll
        for (int ks = 0; ks < 2; ++ks) {
          const bf16x8 vb = *(const bf16x8*)(VT + (nt * 16 + fr) * 72 + ks * 32 + fq * 8);
          a = mfma16(fkg[mt][ks], vb, a);
        }
        S[mt][nt] = a;
      }
  }
  float* so = p.out + O_GDNP + ((size_t)(l * 8 + b) * 8 + h) * 16384;
#pragma unroll
  for (int mt = 0; mt < 2; ++mt)
#pragma unroll
    for (int nt = 0; nt < 2; ++nt)
#pragma unroll
      for (int jj = 0; jj < 4; ++jj) so[((2 * wid + mt) * 16 + fq * 4 + jj) * 128 + dvs * 32 + nt * 16 + fr] = S[mt][nt][jj];
  __syncthreads();
#undef SCAN_LOAD
}

__device__ void gdn_sample_item(const Params& p, int l, int item, unsigned char* smem) {
  const int tid = (opq(threadIdx.x) & 255), lane = tid & 63, wid = tid >> 6;
  const int h = item & 7, b = item >> 3;
  float* qs = (float*)smem;
  float* ks = qs + 1024;
  float* vs = ks + 1024;
  float* part = vs + 1024;
  float* sbeta = part + 256;
  float* sa = sbeta + 8;
  const int dv = tid & 127, half = tid >> 7;
  float S[64];
  const float* s0 = p.state_gdn + ((size_t)(l * 128 + b) * 8 + h) * 16384 + (half * 8192 + dv);
#pragma unroll
  for (int k = 0; k < 64; ++k) S[k] = s0[k * 128];
#pragma unroll
  for (int ps = 0; ps < 2; ++ps) {
    const int c = tid + ps * 256;
    if (c < 384) {
      const int sect = c >> 7, ci = c & 127;
      const int ch = sect * 1024 + h * 128 + ci;
      float xw[11], cwv[4];
#pragma unroll
      for (int j = 0; j < 4; ++j) cwv[j] = p.conv_w[(size_t)(l * 4 + j) * 3072 + ch];
#pragma unroll
      for (int j = 0; j < 3; ++j) xw[j] = p.cache_conv[((size_t)(l * 128 + b) * 3 + j) * 3072 + ch];
#pragma unroll
      for (int t = 0; t < 8; ++t) xw[3 + t] = bf2f(p.proj()[(size_t)(MP + b * 8 + t) * NPJ + ch]);
      float* dst = sect == 0 ? qs : (sect == 1 ? ks : vs);
#pragma unroll
      for (int t = 0; t < 8; ++t) dst[t * 128 + ci] = silu(xw[t] * cwv[0] + xw[t + 1] * cwv[1] + xw[t + 2] * cwv[2] + xw[t + 3] * cwv[3]);
    }
  }
  if (tid < 8) {
    const float* lg = p.logits() + (size_t)(MP + b * 8 + tid) * 16;
    const float x = lg[8 + h] + p.dt_bias[l * 8 + h];
    const float sp = softplus_f(x);
    sa[tid] = __expf(-__expf(p.a_log[l * 8 + h]) * sp);
    sbeta[tid] = sigm(lg[h]);
  }
  __syncthreads();
#pragma unroll
  for (int u = 0; u < 4; ++u) {
    const int t = wid * 2 + (u >> 1);
    float* arr = (u & 1) ? ks : qs;
    const float a0 = arr[t * 128 + lane], a1 = arr[t * 128 + 64 + lane];
    float ss = a0 * a0 + a1 * a1;
#pragma unroll
    for (int o = 1; o < 64; o <<= 1) ss += shx(ss, o, lane);
    float rn = rsqrtf(ss + EPS);
    if (!(u & 1)) rn *= 0.08838834764831845f;
    arr[t * 128 + lane] = a0 * rn;
    arr[t * 128 + 64 + lane] = a1 * rn;
  }
  __syncthreads();
#pragma unroll 1
  for (int t = 0; t < 8; ++t) {
    const float a = sa[t], bt = sbeta[t];
    float kv = 0.f;
#pragma unroll
    for (int k4 = 0; k4 < 16; ++k4) {
      const f32x4 kk = *(const f32x4*)(ks + t * 128 + half * 64 + k4 * 4);
      S[k4 * 4 + 0] *= a; S[k4 * 4 + 1] *= a; S[k4 * 4 + 2] *= a; S[k4 * 4 + 3] *= a;
      kv += S[k4 * 4 + 0] * kk.x + S[k4 * 4 + 1] * kk.y + S[k4 * 4 + 2] * kk.z + S[k4 * 4 + 3] * kk.w;
      if ((k4 & 3) == 3) asm volatile("" ::: "memory");
    }
    part[half * 128 + dv] = kv;
    __syncthreads();
    const float delta = bt * (vs[t * 128 + dv] - (part[dv] + part[128 + dv]));
    __syncthreads();
    float o = 0.f;
#pragma unroll
    for (int k4 = 0; k4 < 16; ++k4) {
      const f32x4 kk = *(const f32x4*)(ks + t * 128 + half * 64 + k4 * 4);
      const f32x4 qq = *(const f32x4*)(qs + t * 128 + half * 64 + k4 * 4);
      S[k4 * 4 + 0] += kk.x * delta; S[k4 * 4 + 1] += kk.y * delta; S[k4 * 4 + 2] += kk.z * delta; S[k4 * 4 + 3] += kk.w * delta;
      o += S[k4 * 4 + 0] * qq.x + S[k4 * 4 + 1] * qq.y + S[k4 * 4 + 2] * qq.z + S[k4 * 4 + 3] * qq.w;
      if ((k4 & 3) == 3) asm volatile("" ::: "memory");
    }
    part[half * 128 + dv] = o;
    __syncthreads();
    if (half == 0) p.ogdn()[(size_t)(MP + b * 8 + t) * DM + h * 128 + dv] = f2bf(part[dv] + part[128 + dv]);
    __syncthreads();
  }
  float* so = p.out + O_GDNS + ((size_t)(l * 128 + b) * 8 + h) * 16384 + opq(half * 8192 + dv);
#pragma unroll
  for (int k = 0; k < 64; ++k) so[k * 128] = S[k];
  __syncthreads();
}

__device__ void gdn_sample_pair(const Params& p, int l, int pair, unsigned char* smem) {
  const int tid = (opq(threadIdx.x) & 255), lane = tid & 63, wid = tid >> 6;
  const int sub = tid >> 7, dv = tid & 127;
  const int item = pair * 2 + sub, h = item & 7, b = item >> 3;
  float* qs = (float*)smem + sub * 3104;
  float* ks = qs + 1024;
  float* vs = qs + 2048;
  float* sbeta = qs + 3072;
  float* sa = qs + 3080;
  f32x2 S2[64];
  const float* s0 = p.state_gdn + ((size_t)(l * 128 + b) * 8 + h) * 16384 + dv;
#pragma unroll
  for (int k = 0; k < 64; ++k) { S2[k].x = s0[(2 * k) * 128]; S2[k].y = s0[(2 * k + 1) * 128]; }
#pragma unroll
  for (int sect = 0; sect < 3; ++sect) {
    const int ch = sect * 1024 + h * 128 + dv;
    float xw[11], cwv[4];
#pragma unroll
    for (int j = 0; j < 4; ++j) cwv[j] = p.conv_w[(size_t)(l * 4 + j) * 3072 + ch];
#pragma unroll
    for (int j = 0; j < 3; ++j) xw[j] = p.cache_conv[((size_t)(l * 128 + b) * 3 + j) * 3072 + ch];
#pragma unroll
    for (int t = 0; t < 8; ++t) xw[3 + t] = bf2f(p.proj()[(size_t)(MP + b * 8 + t) * NPJ + ch]);
    float* dst = sect == 0 ? qs : (sect == 1 ? ks : vs);
#pragma unroll
    for (int t = 0; t < 8; ++t) dst[t * 128 + dv] = silu(xw[t] * cwv[0] + xw[t + 1] * cwv[1] + xw[t + 2] * cwv[2] + xw[t + 3] * cwv[3]);
  }
  if (dv < 8) {
    const float* lg = p.logits() + (size_t)(MP + b * 8 + dv) * 16;
    const float x = lg[8 + h] + p.dt_bias[l * 8 + h];
    sa[dv] = __expf(-__expf(p.a_log[l * 8 + h]) * softplus_f(x));
    sbeta[dv] = sigm(lg[h]);
  }
  __syncthreads();
#pragma unroll
  for (int u = 0; u < 8; ++u) {
    const int t = (wid & 1) * 4 + (u >> 1);
    float* arr = (u & 1) ? ks : qs;
    const float a0 = arr[t * 128 + lane], a1 = arr[t * 128 + 64 + lane];
    float ss = a0 * a0 + a1 * a1;
#pragma unroll
    for (int o = 1; o < 64; o <<= 1) ss += shx(ss, o, lane);
    float rn = rsqrtf(ss + EPS);
    if (!(u & 1)) rn *= 0.08838834764831845f;
    arr[t * 128 + lane] = a0 * rn;
    arr[t * 128 + 64 + lane] = a1 * rn;
  }
  __syncthreads();
#pragma unroll 1
  for (int t = 0; t < 8; ++t) {
    const float a = sa[t], bt = sbeta[t];
    f32x2 kv2 = (f32x2){0.f, 0.f};
#pragma unroll
    for (int k4 = 0; k4 < 32; ++k4) {
      const f32x4 kk = *(const f32x4*)(ks + t * 128 + k4 * 4);
      kv2 += S2[2 * k4] * (f32x2){kk.x, kk.y};
      kv2 += S2[2 * k4 + 1] * (f32x2){kk.z, kk.w};
      if ((k4 & 3) == 3) asm volatile("" ::: "memory");
    }
    const float delta = bt * (vs[t * 128 + dv] - a * (kv2.x + kv2.y));
    const f32x2 a2 = (f32x2){a, a}, d2 = (f32x2){delta, delta};
    f32x2 o2 = (f32x2){0.f, 0.f};
#pragma unroll
    for (int k4 = 0; k4 < 32; ++k4) {
      const f32x4 kk = *(const f32x4*)(ks + t * 128 + k4 * 4);
      const f32x4 qq = *(const f32x4*)(qs + t * 128 + k4 * 4);
      S2[2 * k4] = S2[2 * k4] * a2 + (f32x2){kk.x, kk.y} * d2;
      S2[2 * k4 + 1] = S2[2 * k4 + 1] * a2 + (f32x2){kk.z, kk.w} * d2;
      o2 += S2[2 * k4] * (f32x2){qq.x, qq.y};
      o2 += S2[2 * k4 + 1] * (f32x2){qq.z, qq.w};
      if ((k4 & 3) == 3) asm volatile("" ::: "memory");
    }
    p.ogdn()[(size_t)(MP + b * 8 + t) * DM + h * 128 + dv] = f2bf(o2.x + o2.y);
  }
  float* so = p.out + O_GDNS + ((size_t)(l * 128 + b) * 8 + h) * 16384 + opq(dv);
#pragma unroll
  for (int k = 0; k < 64; ++k) { so[(2 * k) * 128] = S2[k].x; so[(2 * k + 1) * 128] = S2[k].y; }
  __syncthreads();
}

__device__ void swa_prompt_item(const Params& p, int l, int item, unsigned char* smem) {
  const int tid = (opq(threadIdx.x) & 255), lane = tid & 63, wid = tid >> 6, fr = lane & 15, fq = lane >> 4;
  const int kvh = item & 3, hb2 = (item >> 2) & 31, b = item >> 7;
  bf16_t* Ks = (bf16_t*)smem;
  bf16_t* VT = Ks + 208 * 72;
  bf16_t* Pw = VT + 64 * 216 + wid * 16 * 168;
  const int tk0 = hb2 * 64 - 128;
  u32x4 krw[7], vrw[7];
#pragma unroll
  for (int i = 0; i < 7; ++i) {
    const int pc = tid + i * NTHR, kj = pc >> 3, c8 = pc & 7, tk = tk0 + kj;
    krw[i] = (u32x4){0u, 0u, 0u, 0u}; vrw[i] = (u32x4){0u, 0u, 0u, 0u};
    if (pc < 208 * 8 && kj < 192 && tk >= 0) {
      const bf16_t* base = p.proj() + (size_t)(b * 2048 + tk) * NPJ + kvh * 64 + c8 * 8;
      krw[i] = *(const u32x4*)(base + C_SK); vrw[i] = *(const u32x4*)(base + C_SV);
    }
  }
#pragma unroll
  for (int i = 0; i < 7; ++i) {
    const int pc = tid + i * NTHR;
    if (pc >= 208 * 8) break;
    const int kj = pc >> 3, c8 = pc & 7, tk = tk0 + kj;
    const bool ok = kj < 192 && tk >= 0;
    float kf[8], vf[8];
    UNPACK8(krw[i], kf);
    UNPACK8(vrw[i], vf);
    float ss = 0.f;
#pragma unroll
    for (int c = 0; c < 8; ++c) ss += kf[c] * kf[c];
    ss += shx(ss, 1, lane); ss += shx(ss, 2, lane); ss += shx(ss, 4, lane);
    const float rn = rsqrtf(ss * (1.f / 64.f) + EPS);
    const f32x4 w0 = *(const f32x4*)(p.k_norm + l * 64 + c8 * 8), w1 = *(const f32x4*)(p.k_norm + l * 64 + c8 * 8 + 4);
    kf[0] *= rn * w0.x; kf[1] *= rn * w0.y; kf[2] *= rn * w0.z; kf[3] *= rn * w0.w;
    kf[4] *= rn * w1.x; kf[5] *= rn * w1.y; kf[6] *= rn * w1.z; kf[7] *= rn * w1.w;
    *(u32x4*)(Ks + kj * 72 + c8 * 8) = (u32x4){pk2(kf[0], kf[1]), pk2(kf[2], kf[3]), pk2(kf[4], kf[5]), pk2(kf[6], kf[7])};
#pragma unroll
    for (int c = 0; c < 8; ++c) VT[(c8 * 8 + c) * 216 + kj] = f2bf(vf[c]);
    if (ok && tk >= 1920 && kj >= 128) {
      float* ko = p.out + O_KP + (((size_t)(l * 8 + b) * 128 + (tk - 1920)) * 4 + kvh) * 64 + c8 * 8;
      float* vo = p.out + O_VP + (((size_t)(l * 8 + b) * 128 + (tk - 1920)) * 4 + kvh) * 64 + c8 * 8;
      *(f32x4*)ko = (f32x4){kf[0], kf[1], kf[2], kf[3]};
      *(f32x4*)(ko + 4) = (f32x4){kf[4], kf[5], kf[6], kf[7]};
      *(f32x4*)vo = (f32x4){vf[0], vf[1], vf[2], vf[3]};
      *(f32x4*)(vo + 4) = (f32x4){vf[4], vf[5], vf[6], vf[7]};
    }
  }
  __syncthreads();
  const int kbase = wid * 16;
  const int ql = wid * 16 + fr;
  const size_t qrow = (size_t)b * 2048 + hb2 * 64 + ql;
  u32x4 qraw[4][2];
#pragma unroll
  for (int g = 0; g < 4; ++g) {
    const bf16_t* qp = p.proj() + qrow * NPJ + C_SQ + (kvh * 4 + g) * 64 + fq * 8;
    qraw[g][0] = *(const u32x4*)qp; qraw[g][1] = *(const u32x4*)(qp + 32);
  }
#pragma unroll
  for (int g = 0; g < 4; ++g) {
    const int head = kvh * 4 + g;
    const float slope = exp2f(-0.5f * (float)(head + 1));
    const float sink = p.sinks[l * 16 + head];
    bf16x8 qf[2];
    {
      const u32x4 r0 = qraw[g][0], r1 = qraw[g][1];
      float f0[8], f1[8];
      UNPACK8(r0, f0);
      UNPACK8(r1, f1);
      float ss = 0.f;
#pragma unroll
      for (int c = 0; c < 8; ++c) ss += f0[c] * f0[c] + f1[c] * f1[c];
      ss += shx(ss, 16, lane); ss += shx(ss, 32, lane);
      const float rn = rsqrtf(ss * (1.f / 64.f) + EPS) * 0.125f;
      const float* qn = p.q_norm + l * 64 + fq * 8;
#pragma unroll
      for (int c = 0; c < 8; ++c) { f0[c] *= rn * qn[c]; f1[c] *= rn * qn[32 + c]; }
      qf[0] = as_bf((u32x4){pk2(f0[0], f0[1]), pk2(f0[2], f0[3]), pk2(f0[4], f0[5]), pk2(f0[6], f0[7])});
      qf[1] = as_bf((u32x4){pk2(f1[0], f1[1]), pk2(f1[2], f1[3]), pk2(f1[4], f1[5]), pk2(f1[6], f1[7])});
    }
    f32x4 sc[9];
    float mx = sink;
#pragma unroll
    for (int kt = 0; kt < 9; ++kt) {
      f32x4 a = (f32x4){0.f, 0.f, 0.f, 0.f};
#pragma unroll
      for (int ks = 0; ks < 2; ++ks) {
        const bf16x8 kf = *(const bf16x8*)(Ks + (kbase + kt * 16 + fr) * 72 + ks * 32 + fq * 8);
        a = mfma16(kf, qf[ks], a);
      }
#pragma unroll
      for (int jj = 0; jj < 4; ++jj) {
        const int kj = kbase + kt * 16 + fq * 4 + jj;
        const int dist = ql + 128 - kj;
        const bool ok = dist >= 0 && dist <= 128 && (tk0 + kj) >= 0;
        const float s = ok ? a[jj] - slope * (float)dist : -INFINITY;
        a[jj] = s;
        mx = fmaxf(mx, s);
      }
      sc[kt] = a;
    }
    mx = fmaxf(mx, shx(mx, 16, lane));
    mx = fmaxf(mx, shx(mx, 32, lane));
    float sum = 0.f;
#pragma unroll
    for (int kt = 0; kt < 9; ++kt) {
      f32x4 e;
#pragma unroll
      for (int jj = 0; jj < 4; ++jj) { e[jj] = __expf(sc[kt][jj] - mx); sum += e[jj]; }
      *(u32x2*)(Pw + fr * 168 + kt * 16 + fq * 4) = (u32x2){pk2(e.x, e.y), pk2(e.z, e.w)};
    }
    *(u32x2*)(Pw + fr * 168 + 144 + fq * 4) = (u32x2){0u, 0u};
    sum += shx(sum, 16, lane);
    sum += shx(sum, 32, lane);
    const float inv = 1.f / (sum + __expf(sink - mx));
    __builtin_amdgcn_wave_barrier();
#pragma unroll
    for (int dt = 0; dt < 4; ++dt) {
      f32x4 a = (f32x4){0.f, 0.f, 0.f, 0.f};
#pragma unroll
      for (int ks = 0; ks < 5; ++ks) {
        const bf16x8 vf = *(const bf16x8*)(VT + (dt * 16 + fr) * 216 + kbase + ks * 32 + fq * 8);
        const bf16x8 pf = *(const bf16x8*)(Pw + fr * 168 + ks * 32 + fq * 8);
        a = mfma16(vf, pf, a);
      }
      a *= inv;
      *(u32x2*)(p.oswa() + qrow * DM + head * 64 + dt * 16 + fq * 4) = (u32x2){pk2(a.x, a.y), pk2(a.z, a.w)};
    }
    __builtin_amdgcn_wave_barrier();
  }
  __syncthreads();
}

__device__ void swa_sample_item(const Params& p, int l, int item, unsigned char* smem) {
  const int tid = (opq(threadIdx.x) & 255), lane = tid & 63, wid = tid >> 6;
  const int kvh = item & 3, b = item >> 2;
  float* Ks = (float*)smem;
  float* Vs = Ks + 136 * 68;
  float* Qs = Vs + 136 * 64;
  float* Sc = Qs + 512;
  const size_t cbase = (size_t)(l * 128 + b) * 128;
  f32x4 kvr[8], vvr[8];
#pragma unroll
  for (int i = 0; i < 8; ++i) {
    const int idx = tid + i * NTHR, j = idx >> 4, c4 = idx & 15;
    kvr[i] = *(const f32x4*)(p.cache_k + ((cbase + j) * 4 + kvh) * 64 + c4 * 4);
    vvr[i] = *(const f32x4*)(p.cache_v + ((cbase + j) * 4 + kvh) * 64 + c4 * 4);
  }
  unsigned qrw[4];
#pragma unroll
  for (int g = 0; g < 4; ++g) qrw[g] = *(const unsigned*)(p.proj() + (size_t)(MP + b * 8 + (tid >> 5)) * NPJ + C_SQ + (kvh * 4 + g) * 64 + (tid & 31) * 2);
#pragma unroll
  for (int i = 0; i < 8; ++i) {
    const int idx = tid + i * NTHR, j = idx >> 4, c4 = idx & 15;
    const f32x4 kv = kvr[i], vv = vvr[i];
    *(f32x4*)(Ks + j * 68 + c4 * 4) = kv;
    *(f32x4*)(Vs + j * 64 + c4 * 4) = vv;
  }
  {
    const int t = tid >> 5, d = (tid & 31) * 2;
    const bf16_t* base = p.proj() + (size_t)(MP + b * 8 + t) * NPJ + kvh * 64 + d;
    const unsigned kr = *(const unsigned*)(base + C_SK), vr = *(const unsigned*)(base + C_SV);
    float k0 = lo2f(kr), k1 = hi2f(kr);
    float ss = k0 * k0 + k1 * k1;
#pragma unroll
    for (int o = 1; o < 32; o <<= 1) ss += shx(ss, o, lane);
    const float rn = rsqrtf(ss * (1.f / 64.f) + EPS);
    Ks[(128 + t) * 68 + d] = k0 * rn * p.k_norm[l * 64 + d];
    Ks[(128 + t) * 68 + d + 1] = k1 * rn * p.k_norm[l * 64 + d + 1];
    Vs[(128 + t) * 64 + d] = lo2f(vr);
    Vs[(128 + t) * 64 + d + 1] = hi2f(vr);
  }
  __syncthreads();
  for (int idx = tid; idx < 128 * 64; idx += NTHR) {
    const int j = idx >> 6, d = idx & 63;
    p.out[O_KS + ((cbase + j) * 4 + kvh) * 64 + d] = Ks[(j + 8) * 68 + d];
    p.out[O_VS + ((cbase + j) * 4 + kvh) * 64 + d] = Vs[(j + 8) * 64 + d];
  }
#pragma unroll
  for (int g = 0; g < 4; ++g) {
    const int head = kvh * 4 + g;
    const float slope = exp2f(-0.5f * (float)(head + 1));
    const float sink = p.sinks[l * 16 + head];
    {
      const int t = tid >> 5, d = (tid & 31) * 2;
      const unsigned qr = qrw[g];
      const float q0 = lo2f(qr), q1 = hi2f(qr);
      float ss = q0 * q0 + q1 * q1;
#pragma unroll
      for (int o = 1; o < 32; o <<= 1) ss += shx(ss, o, lane);
      const float rn = rsqrtf(ss * (1.f / 64.f) + EPS) * 0.125f;
      Qs[t * 64 + d] = q0 * rn * p.q_norm[l * 64 + d];
      Qs[t * 64 + d + 1] = q1 * rn * p.q_norm[l * 64 + d + 1];
    }
    __syncthreads();
    for (int idx = tid; idx < 8 * 136; idx += NTHR) {
      const int tq = idx / 136, j = idx % 136;
      float s = 0.f;
#pragma unroll
      for (int d4 = 0; d4 < 16; ++d4) {
        const f32x4 qv = *(const f32x4*)(Qs + tq * 64 + d4 * 4), kq = *(const f32x4*)(Ks + j * 68 + d4 * 4);
        s += (qv.x * kq.x + qv.y * kq.y) + (qv.z * kq.z + qv.w * kq.w);
      }
      const int dist = tq + 128 - j;
      Sc[tq * 136 + j] = (dist >= 0 && dist <= 128) ? s - slope * (float)dist : -INFINITY;
    }
    __syncthreads();
#pragma unroll
    for (int u = 0; u < 2; ++u) {
      const int tq = wid * 2 + u;
      const float s0 = Sc[tq * 136 + lane], s1 = Sc[tq * 136 + 64 + lane], s2 = lane < 8 ? Sc[tq * 136 + 128 + lane] : -INFINITY;
      float mx = fmaxf(fmaxf(s0, s1), fmaxf(s2, sink));
#pragma unroll
      for (int o = 1; o < 64; o <<= 1) mx = fmaxf(mx, shx(mx, o, lane));
      const float e0 = __expf(s0 - mx), e1 = __expf(s1 - mx), e2 = __expf(s2 - mx);
      float sum = e0 + e1 + e2;
#pragma unroll
      for (int o = 1; o < 64; o <<= 1) sum += shx(sum, o, lane);
      const float inv = 1.f / (sum + __expf(sink - mx));
      Sc[tq * 136 + lane] = e0 * inv;
      Sc[tq * 136 + 64 + lane] = e1 * inv;
      if (lane < 8) Sc[tq * 136 + 128 + lane] = e2 * inv;
    }
    __syncthreads();
    {
      const int tq = tid >> 5, d = (tid & 31) * 2;
      float o0 = 0.f, o1 = 0.f;
#pragma unroll 2
      for (int j4 = 0; j4 < 34; ++j4) {
        const f32x4 pj = *(const f32x4*)(Sc + tq * 136 + j4 * 4);
        const f32x2 va = *(const f32x2*)(Vs + (j4 * 4 + 0) * 64 + d), vb = *(const f32x2*)(Vs + (j4 * 4 + 1) * 64 + d);
        const f32x2 vc = *(const f32x2*)(Vs + (j4 * 4 + 2) * 64 + d), vd = *(const f32x2*)(Vs + (j4 * 4 + 3) * 64 + d);
        o0 += (pj.x * va.x + pj.y * vb.x) + (pj.z * vc.x + pj.w * vd.x);
        o1 += (pj.x * va.y + pj.y * vb.y) + (pj.z * vc.y + pj.w * vd.y);
      }
      *(unsigned*)(p.oswa() + (size_t)(MP + b * 8 + tq) * DM + head * 64 + d) = pk2(o0, o1);
    }
    __syncthreads();
  }
}

__device__ void phase_mix(const Params& p, int l) {
  const int tid = (opq(threadIdx.x) & 255), lane = tid & 63, wid = tid >> 6, fr = lane & 15, fq = lane >> 4;
  for (int it = VB; it < MTOK / 4; it += VG) {
    const size_t row = (size_t)it * 4 + wid;
#pragma unroll
    for (int ps = 0; ps < 2; ++ps) {
      const int ch = (ps * 4 + fq) * 128 + fr * 8;
      const u32x4 og = *(const u32x4*)(p.ogdn() + row * DM + ch);
      const u32x4 ob = *(const u32x4*)(p.oswa() + row * DM + ch);
      const u32x4 zz = *(const u32x4*)(p.proj() + row * NPJ + C_Z + ch);
      const u32x4 ga = *(const u32x4*)(p.proj() + row * NPJ + C_G + ch);
      const u32x4 gb = *(const u32x4*)(p.proj() + row * NPJ + C_G + 1024 + ch);
      float fo[8], fb[8], fz[8], fa[8], fg[8];
      UNPACK8(og, fo); UNPACK8(ob, fb); UNPACK8(zz, fz); UNPACK8(ga, fa); UNPACK8(gb, fg);
      float ss = 0.f;
#pragma unroll
      for (int c = 0; c < 8; ++c) ss += fo[c] * fo[c];
      ss += shx(ss, 1, lane); ss += shx(ss, 2, lane); ss += shx(ss, 4, lane); ss += shx(ss, 8, lane);
      const float rn = rsqrtf(ss * (1.f / 128.f) + EPS);
      const f32x4 w0 = *(const f32x4*)(p.gdn_norm + l * 128 + fr * 8), w1 = *(const f32x4*)(p.gdn_norm + l * 128 + fr * 8 + 4);
      const float wn[8] = {w0.x, w0.y, w0.z, w0.w, w1.x, w1.y, w1.z, w1.w};
      float m[8];
#pragma unroll
      for (int c = 0; c < 8; ++c) m[c] = sigm(fa[c]) * (fo[c] * rn * wn[c] * silu(fz[c])) + sigm(fg[c]) * fb[c];
      *(u32x4*)(p.mix() + row * DM + ch) = (u32x4){pk2(m[0], m[1]), pk2(m[2], m[3]), pk2(m[4], m[5]), pk2(m[6], m[7])};
    }
  }
  const int NC = (8 + 128) * 3 * 3072;
  for (int i = VB * NTHR + tid; i < NC; i += VG * NTHR) {
    const int c = i % 3072, r = (i / 3072) % 3, bb = i / 9216;
    if (bb < 8) p.out[O_CONVP + ((size_t)(l * 8 + bb) * 3 + r) * 3072 + c] = bf2f(p.proj()[(size_t)(bb * 2048 + 2045 + r) * NPJ + c]);
    else p.out[O_CONVS + ((size_t)(l * 128 + bb - 8) * 3 + r) * 3072 + c] = bf2f(p.proj()[(size_t)(MP + (bb - 8) * 8 + 5 + r) * NPJ + c]);
  }
}

#define XB_TMO      128
#define XB_XCNT(j)  (256  + 64 * (j))
#define XB_XSUB(j)  (1280 + 64 * (j))
#define XB_XGEN(j)  (2304 + 64 * (j))
#define XB_TOP      3328
#define XB_TOPGEN   3392
#define XCD_BAR_WORDS 3456
#define XB_SPIN_CAP (1u << 18)
#define LAS __attribute__((address_space(3)))

__device__ __forceinline__ unsigned xb_ld(unsigned* p)              { return __hip_atomic_load(p, __ATOMIC_RELAXED, __HIP_MEMORY_SCOPE_AGENT); }
__device__ __forceinline__ unsigned xb_add(unsigned* p, unsigned v) { return __hip_atomic_fetch_add(p, v, __ATOMIC_RELAXED, __HIP_MEMORY_SCOPE_AGENT); }
__device__ __forceinline__ unsigned xb_xcc_id() { return (unsigned)__builtin_amdgcn_s_getreg((3 << 11) | 20) & 0xFu; }
#define XB_SPIN(cond, bar) do { unsigned _sp = 0; while (cond) { __builtin_amdgcn_s_sleep(1); \
    if ((++_sp & 255u) == 0u) { if (xb_ld(&(bar)[XB_TMO])) break; if (_sp > XB_SPIN_CAP) { atomicAdd(&(bar)[XB_TMO], 1u); break; } } } } while (0)

struct XcdBarrier {
    unsigned* bar; unsigned x;
    volatile LAS unsigned* st;
};

__device__ __forceinline__ XcdBarrier xcd_barrier_post(unsigned* bar, volatile LAS unsigned* st) {
    XcdBarrier b; b.bar = bar; b.x = xb_xcc_id(); b.st = st;
    if (threadIdx.x == 0) (void)xb_add(&bar[XB_XCNT(b.x)], 1u);
    return b;
}
__device__ __forceinline__ void xcd_barrier_complete(unsigned* bar, unsigned x, unsigned& nloc, unsigned& nx) {
    const unsigned G = gridDim.x * gridDim.y * gridDim.z;
    unsigned sum, cnt, mine, sp = 0u;
    for (;;) {
        sum = 0u; cnt = 0u; mine = 0u;
#pragma unroll
        for (unsigned j = 0; j < 16; ++j) { const unsigned c = xb_ld(&bar[XB_XCNT(j)]); sum += c; cnt += (c > 0u) ? 1u : 0u; mine = (j == x) ? c : mine; }
        if (sum == G) break;
        __builtin_amdgcn_s_sleep(1);
        if ((++sp & 255u) == 0u) { if (xb_ld(&bar[XB_TMO])) break; if (sp > XB_SPIN_CAP) { atomicAdd(&bar[XB_TMO], 1u); break; } }
    }
    nloc = mine > 0u ? mine : 1u; nx = cnt > 0u ? cnt : 1u;
}

__device__ __forceinline__ void xcd_barrier(const XcdBarrier& b) {
    asm volatile("s_waitcnt vmcnt(0)" ::: "memory");
    __syncthreads();
    if (threadIdx.x == 0) {
        unsigned* bar = b.bar;
        __builtin_amdgcn_s_waitcnt(0);
        unsigned nloc = b.st[0], nx = b.st[1];
        if (nloc == 0u) { xcd_barrier_complete(bar, b.x, nloc, nx); b.st[0] = nloc; b.st[1] = nx; }
        const unsigned old = xb_add(&bar[XB_XSUB(b.x)], 1u);
        const unsigned gen = old / nloc;
        if (old + 1u == (gen + 1u) * nloc) {
            __builtin_amdgcn_fence(__ATOMIC_RELEASE, "agent");
            asm volatile("s_waitcnt vmcnt(0)" ::: "memory");
            const unsigned og = xb_add(&bar[XB_TOP], 1u);
            const unsigned tg = og / nx;
            if (og + 1u == (tg + 1u) * nx) xb_add(&bar[XB_TOPGEN], 1u);
            else XB_SPIN(xb_ld(&bar[XB_TOPGEN]) == tg, bar);
            __builtin_amdgcn_fence(__ATOMIC_ACQUIRE, "agent");
            xb_add(&bar[XB_XGEN(b.x)], 1u);
            asm volatile("s_waitcnt vmcnt(0)" ::: "memory");
        } else {
            XB_SPIN(xb_ld(&bar[XB_XGEN(b.x)]) == gen, bar);
            __builtin_amdgcn_fence(__ATOMIC_ACQUIRE, "agent");
            asm volatile("s_waitcnt vmcnt(0)" ::: "memory");
        }
    }
    __syncthreads();
}


#define NPHASE_PRE 2
#define NPHASE_L 8
constexpr int LDS_TOTAL = 2 * SMEM_BYTES;
__global__ void __launch_bounds__(512, 2) mega(Params p, int ph_lo, int ph_hi) {
  extern __shared__ __attribute__((aligned(16))) unsigned char lds_all[];
  if (ph_hi < 0) cg::this_grid().sync();
  __shared__ uint4 xb_words;
  if (threadIdx.x == 0) xb_words = make_uint4(0u, 0u, 0u, 0u);
  __syncthreads();
  XcdBarrier xb = xcd_barrier_post(p.bar(), (volatile LAS unsigned*)&xb_words);
  unsigned char* smem = lds_all + VHALF * SMEM_BYTES;
  for (int ph = ph_lo; ph < ph_hi; ++ph) {
    if (ph > ph_lo) xcd_barrier(xb);
    if (ph == 0) { phase_p0(p, smem); continue; }
    if (ph == 1) {
      {
        EpiArgs e{};
        e.obf = p.pp(); e.ldo = DM;
        DiagSched S; S.nLimit = 1024; S.G = gridDim.x; S.c = blockIdx.x;
        pg8::Gemm g; g.A = p.pb(); g.Bt = p.wt_proj(); g.M = NL * MTOK; g.N = NL * DM; g.K = PLE;
        BigEpi<EPI_PP> E; E.e = e;
        pg8::gemm_phase<BigEpi<EPI_PP>, DiagSched>((PG8_LAS unsigned char*)lds_all, g, S, E, nullptr);
        __syncthreads();
      }
      for (int st = VB; st < 64 * 16; st += VG) {
        const int L = 1024 + (st >> 4), sub = st & 15, l = L / 272, r = L - l * 272, pm = r >> 2, pn = r & 3;
        EpiArgs e{};
        e.obf = p.pp() + (size_t)l * MTOK * DM; e.ldo = DM;
        gemm_tile<1, 4, 4, 1, EPI_PP, 128>(p.pb() + (size_t)l * MTOK * PLE, PLE, p.wt_proj() + (size_t)l * DM * PLE, PLE, PLE, pm * 256 + (sub >> 2) * 64, pn * 256 + (sub & 3) * 64, (bf16_t*)smem, e);
      }
      continue;
    }
    const int l = (ph - NPHASE_PRE) / NPHASE_L, s = (ph - NPHASE_PRE) % NPHASE_L;
#ifndef REPMASK
#define REPMASK 0
#endif
    for (int rep = 0; rep < (((REPMASK >> s) & 1) ? 2 : 1); ++rep) {
    if (rep) xcd_barrier(xb);
    switch (s) {
      case 0: {
        EpiArgs e{};
        e.ssq_in = p.ssq0(); e.obf = p.proj(); e.ldo = NPJ; e.of32 = p.logits();
        const bf16_t* Bt = p.wt_in() + (size_t)l * NIN * DM;
        gemm_big_phase<EPI_PROJ>(p.hb(), Bt, DM, MTOK, NPJ, lds_all, smem, e);
        for (int t = VB; t < 272; t += VG)
          gemm_tile<1, 1, 4, 1, EPI_LOGIT, 128>(p.hb(), DM, Bt + (size_t)NPJ * DM, DM, DM, t * 64, 0, (bf16_t*)smem, e);
      } break;
      case 1: {
        const int nB1 = VG == 512 ? 3072 : 3584;
        for (int t = VB; t < nB1; t += VG) {
          if (t < 2048) gdn_prep_item(p, l, t, smem);
          else if (t < 3072) swa_prompt_item(p, l, t - 2048, smem);
          else swa_sample_item(p, l, t - 3072, smem);
        }
      } break;
      case 2: {
        if (VG == 512) {
          if (VB < 256) gdn_scan_item(p, l, VB, smem);
          else {
            gdn_sample_pair(p, l, VB - 256, smem); gdn_sample_pair(p, l, VB, smem);
            swa_sample_item(p, l, (VB - 256) * 2, smem); swa_sample_item(p, l, (VB - 256) * 2 + 1, smem);
          }
        } else {
          for (int t = VB; t < 256 + 512; t += VG) {
            if (t < 256) gdn_scan_item(p, l, t, smem);
            else gdn_sample_pair(p, l, t - 256, smem);
          }
        }
      } break;
      case 3: phase_mix(p, l); break;
      case 4: {
        EpiArgs e{};
        e.h = p.out; e.hb = p.hb2(); e.ssq_out = p.ssq1();
        gemm_big_phase<EPI_RESID>(p.mix(), p.wt_out() + (size_t)l * DM * DM, DM, MTOK, DM, lds_all, smem, e);
      } break;
      case 5: {
        EpiArgs e{};
        e.ssq_in = p.ssq1(); e.obf = p.proj(); e.ldo = DFF;
        gemm_big_phase<EPI_UP>(p.hb2(), p.wt_up() + (size_t)l * DFF * DM, DM, MTOK, DFF, lds_all, smem, e);
      } break;
      case 6: {
        EpiArgs e{};
        e.h = p.out; e.hb = p.hb2(); e.ssq_out = p.ssq2();
        gemm_big_phase<EPI_RESID>(p.proj(), p.wt_down() + (size_t)l * DM * DFF, DFF, MTOK, DM, lds_all, smem, e);
      } break;
      case 7: {
        EpiArgs e{};
        e.h = p.out; e.hb = p.hb(); e.ssq_in = p.ssq2(); e.ssq_out = p.ssq0(); e.pp = p.pp() + (size_t)l * MTOK * DM;
        gemm_big_phase<EPI_PLE>(p.hb2(), p.wt_gate() + (size_t)l * DM * DM, DM, MTOK, DM, lds_all, smem, e);
      } break;
    }
    }
  }
}

extern "C" void kernel_launch(void* const* d_in, const int* in_sizes, int n_in, void* d_out, int out_size, void* d_ws, size_t ws_size,
                              hipStream_t stream) {
  Params p{};
  const float* const* in = (const float* const*)d_in;
  p.x_prompt = in[0]; p.x_sample = in[1]; p.cache_conv = in[2]; p.state_gdn = in[3]; p.cache_k = in[4]; p.cache_v = in[5];
  p.p_prompt = in[6]; p.p_sample = in[7]; p.norm_mix = in[8]; p.w_in = in[9]; p.conv_w = in[10]; p.a_log = in[11]; p.dt_bias = in[12];
  p.gdn_norm = in[13]; p.q_norm = in[14]; p.k_norm = in[15]; p.sinks = in[16]; p.w_out = in[17]; p.norm_ffn = in[18]; p.w_up = in[19];
  p.w_down = in[20]; p.norm_ple = in[21]; p.w_gate = in[22]; p.w_proj = in[23];
  p.out = (float*)d_out;
  p.ws = (unsigned char*)d_ws;
  if (WS_TOTAL > ws_size) { fprintf(stderr, "workspace too small: need %zu have %zu\n", (size_t)WS_TOTAL, ws_size); return; }

  static int grid_blocks = 0;
  if (!grid_blocks) {
    int dev = 0, cus = 0, per_cu = 0;
    (void)hipGetDevice(&dev);
    (void)hipDeviceGetAttribute(&cus, hipDeviceAttributeMultiprocessorCount, dev);
    if (hipFuncSetAttribute((const void*)mega, hipFuncAttributeMaxDynamicSharedMemorySize, LDS_TOTAL) != hipSuccess) { fprintf(stderr, "hipFuncSetAttribute(dynamic LDS %d) failed\n", LDS_TOTAL); grid_blocks = -1; return; }
    (void)hipOccupancyMaxActiveBlocksPerMultiprocessor(&per_cu, (const void*)mega, 512, LDS_TOTAL);
    (void)hipGetLastError();
    grid_blocks = cus;
  }
  if (grid_blocks < 0) return;
  (void)hipMemsetAsync(p.ws + WO_bar, 0, (size_t)XCD_BAR_WORDS * 4, stream);
  int lo = 0, hi = NPHASE_PRE + NL * NPHASE_L;
  void* args[] = {&p, &lo, &hi};
  hipError_t e = hipLaunchCooperativeKernel((void*)mega, dim3(grid_blocks), dim3(512), args, LDS_TOTAL, stream);
  if (e != hipSuccess) fprintf(stderr, "cooperative launch failed: %s (grid %d)\n", hipGetErrorString(e), grid_blocks);
}
```

```cpp
#include <hip/hip_runtime.h>
#include <hip/hip_cooperative_groups.h>
#include <cstdio>
namespace cg = cooperative_groups;

typedef unsigned short bf16_t;
typedef short bf16x8 __attribute__((ext_vector_type(8)));
typedef float f32x4 __attribute__((ext_vector_type(4)));
typedef float f32x2 __attribute__((ext_vector_type(2)));
typedef unsigned u32x4 __attribute__((ext_vector_type(4)));
typedef unsigned u32x2 __attribute__((ext_vector_type(2)));

#define DEVI __device__ __forceinline__
DEVI int opq(int x) { asm volatile("" : "+v"(x)); return x; }

#define VHALF ((int)__builtin_amdgcn_readfirstlane((int)(threadIdx.x >> 8)))
#define VB ((int)blockIdx.x * 2 + VHALF)
#define VG ((int)gridDim.x * 2)
constexpr int NL = 4;
constexpr int MTOK = 17408, MP = 16384, MS = 1024;
constexpr int DM = 1024, NIN = 7696, NPJ = 7680, DFF = 4096, PLE = 256;
constexpr int C_Z = 3072, C_SQ = 4096, C_SK = 5120, C_SV = 5376, C_G = 5632;
constexpr float EPS = 1e-6f;
constexpr int NTHR = 256;
constexpr int SMEM_BYTES = 79872;
constexpr size_t SCR_ITEM = 73728;

constexpr size_t O_YP = 0, O_YS = 16777216, O_CONVP = 17825792, O_GDNP = 18120704, O_KP = 22315008, O_VP = 23363584,
                 O_CONVS = 24412160, O_GDNS = 29130752, O_KS = 96239616, O_VS = 113016832, O_END = 129794048;

constexpr size_t al256(size_t x) { return (x + 255) & ~(size_t)255; }
constexpr size_t WO_wt_in = 0;
constexpr size_t WO_wt_out = WO_wt_in + al256((size_t)NL * NIN * DM * 2);
constexpr size_t WO_wt_up = WO_wt_out + al256((size_t)NL * DM * DM * 2);
constexpr size_t WO_wt_down = WO_wt_up + al256((size_t)NL * DFF * DM * 2);
constexpr size_t WO_wt_gate = WO_wt_down + al256((size_t)NL * DM * DFF * 2);
constexpr size_t WO_wt_proj = WO_wt_gate + al256((size_t)NL * DM * DM * 2);
constexpr size_t WO_hb = WO_wt_proj + al256((size_t)NL * DM * PLE * 2);
constexpr size_t WO_hb2 = WO_hb + al256((size_t)MTOK * DM * 2);
constexpr size_t WO_proj = WO_hb2 + al256((size_t)MTOK * DM * 2);
constexpr size_t WO_scr = WO_proj + al256((size_t)MTOK * NPJ * 2);
constexpr size_t WO_ogdn = WO_scr + al256((size_t)2048 * SCR_ITEM);
constexpr size_t WO_oswa = WO_ogdn + al256((size_t)MTOK * DM * 2);
constexpr size_t WO_mix = WO_oswa + al256((size_t)MTOK * DM * 2);
constexpr size_t WO_pb = WO_mix + al256((size_t)MTOK * DM * 2);
constexpr size_t WO_pp = WO_pb + al256((size_t)NL * MTOK * PLE * 2);
constexpr size_t WO_ssq0 = WO_pp + al256((size_t)NL * MTOK * DM * 2);
constexpr size_t WO_ssq1 = WO_ssq0 + al256((size_t)MTOK * 16 * 4);
constexpr size_t WO_ssq2 = WO_ssq1 + al256((size_t)MTOK * 16 * 4);
constexpr size_t WO_logits = WO_ssq2 + al256((size_t)MTOK * 16 * 4);
constexpr size_t WO_gsc = WO_logits + al256((size_t)MTOK * 16 * 4);
constexpr size_t WO_bar = WO_gsc + al256((size_t)2048 * 4);
constexpr size_t WS_TOTAL = WO_bar + al256((size_t)3456 * 4);
struct Params {
  const float *x_prompt, *x_sample, *cache_conv, *state_gdn, *cache_k, *cache_v, *p_prompt, *p_sample;
  const float *norm_mix, *w_in, *conv_w, *a_log, *dt_bias, *gdn_norm, *q_norm, *k_norm, *sinks, *w_out, *norm_ffn, *w_up, *w_down,
      *norm_ple, *w_gate, *w_proj;
  float* out;
  unsigned char* ws;
  DEVI bf16_t* wt_in() const { return (bf16_t*)(ws + WO_wt_in); }
  DEVI bf16_t* wt_out() const { return (bf16_t*)(ws + WO_wt_out); }
  DEVI bf16_t* wt_up() const { return (bf16_t*)(ws + WO_wt_up); }
  DEVI bf16_t* wt_down() const { return (bf16_t*)(ws + WO_wt_down); }
  DEVI bf16_t* wt_gate() const { return (bf16_t*)(ws + WO_wt_gate); }
  DEVI bf16_t* wt_proj() const { return (bf16_t*)(ws + WO_wt_proj); }
  DEVI bf16_t* hb() const { return (bf16_t*)(ws + WO_hb); }
  DEVI bf16_t* hb2() const { return (bf16_t*)(ws + WO_hb2); }
  DEVI bf16_t* proj() const { return (bf16_t*)(ws + WO_proj); }
  DEVI bf16_t* scr() const { return (bf16_t*)(ws + WO_scr); }
  DEVI bf16_t* ogdn() const { return (bf16_t*)(ws + WO_ogdn); }
  DEVI bf16_t* oswa() const { return (bf16_t*)(ws + WO_oswa); }
  DEVI bf16_t* mix() const { return (bf16_t*)(ws + WO_mix); }
  DEVI bf16_t* pb() const { return (bf16_t*)(ws + WO_pb); }
  DEVI bf16_t* pp() const { return (bf16_t*)(ws + WO_pp); }
  DEVI float* ssq0() const { return (float*)(ws + WO_ssq0); }
  DEVI float* ssq1() const { return (float*)(ws + WO_ssq1); }
  DEVI float* ssq2() const { return (float*)(ws + WO_ssq2); }
  DEVI float* logits() const { return (float*)(ws + WO_logits); }
  DEVI float* gsc() const { return (float*)(ws + WO_gsc); }
  DEVI unsigned* bar() const { return (unsigned*)(ws + WO_bar); }
};

DEVI float shx(float v, int m, int ln) { return __builtin_bit_cast(float, __builtin_amdgcn_ds_bpermute((ln ^ m) << 2, __builtin_bit_cast(int, v))); }
DEVI float shup(float v, int o, int ln) { return __builtin_bit_cast(float, __builtin_amdgcn_ds_bpermute((ln >= o ? ln - o : ln) << 2, __builtin_bit_cast(int, v))); }
DEVI float lo2f(unsigned u) { return __uint_as_float(u << 16); }
DEVI float hi2f(unsigned u) { return __uint_as_float(u & 0xffff0000u); }
DEVI float bf2f(bf16_t v) { return __uint_as_float(((unsigned)v) << 16); }
typedef __bf16 bf16x2_t __attribute__((ext_vector_type(2)));
DEVI unsigned pk2(float lo, float hi) { const f32x2 v = {lo, hi}; const bf16x2_t r = __builtin_convertvector(v, bf16x2_t); return __builtin_bit_cast(unsigned, r); }
DEVI bf16_t f2bf(float f) { return (bf16_t)(pk2(f, 0.f) & 0xffffu); }
DEVI float sigm(float x) { return __builtin_amdgcn_rcpf(1.f + __expf(-x)); }
DEVI float silu(float x) { return x * sigm(x); }
DEVI float softplus_f(float x) {
  const float e = __expf(x);
  return x > 20.f ? x : (e < 0.01f ? e * (1.f - 0.5f * e + 0.33333334f * e * e) : __logf(1.f + e));
}
DEVI f32x4 mfma16(bf16x8 a, bf16x8 b, f32x4 c) { return __builtin_amdgcn_mfma_f32_16x16x32_bf16(a, b, c, 0, 0, 0); }
DEVI bf16x8 as_bf(u32x4 v) { return __builtin_bit_cast(bf16x8, v); }
#define UNPACK8(v, f) do { f[0] = lo2f(v.x); f[1] = hi2f(v.x); f[2] = lo2f(v.y); f[3] = hi2f(v.y); f[4] = lo2f(v.z); f[5] = hi2f(v.z); f[6] = lo2f(v.w); f[7] = hi2f(v.w); } while (0)

DEVI int inmap(int n) { return n < 4096 ? n : (n < 7680 ? n + 16 : n - 7680 + 4096); }

struct WTile { const float* src; const float* scale; bf16_t* dst; int ldsrc, K, Nd, kt, nt, flags; };
DEVI WTile wtile_decode(const Params& p, int it) {
  constexpr int T_IN = 16 * 121, T_OUT = 256, T_UP = 1024, T_DOWN = 1024, T_GATE = 256, T_PROJ = 64;
  constexpr int T_L = T_IN + T_OUT + T_UP + T_DOWN + T_GATE + T_PROJ;
  const int l = it / T_L;
  int r = it % T_L;
  WTile t;
  t.scale = p.norm_mix;
  if (r < T_IN) { t.src = p.w_in + (size_t)l * DM * NIN; t.ldsrc = NIN; t.K = DM; t.Nd = NIN; t.dst = p.wt_in() + (size_t)l * NIN * DM; t.scale = p.norm_mix + l * DM; t.flags = 3; t.kt = r % 16; t.nt = r / 16; return t; }
  r -= T_IN;
  if (r < T_OUT) { t.src = p.w_out + (size_t)l * DM * DM; t.ldsrc = DM; t.K = DM; t.Nd = DM; t.dst = p.wt_out() + (size_t)l * DM * DM; t.flags = 0; t.kt = r % 16; t.nt = r / 16; return t; }
  r -= T_OUT;
  if (r < T_UP) { t.src = p.w_up + (size_t)l * DM * DFF; t.ldsrc = DFF; t.K = DM; t.Nd = DFF; t.dst = p.wt_up() + (size_t)l * DFF * DM; t.scale = p.norm_ffn + l * DM; t.flags = 2; t.kt = r % 16; t.nt = r / 16; return t; }
  r -= T_UP;
  if (r < T_DOWN) { t.src = p.w_down + (size_t)l * DFF * DM; t.ldsrc = DM; t.K = DFF; t.Nd = DM; t.dst = p.wt_down() + (size_t)l * DM * DFF; t.flags = 0; t.kt = r % 64; t.nt = r / 64; return t; }
  r -= T_DOWN;
  if (r < T_GATE) { t.src = p.w_gate + (size_t)l * DM * DM; t.ldsrc = DM; t.K = DM; t.Nd = DM; t.dst = p.wt_gate() + (size_t)l * DM * DM; t.scale = p.norm_ple + l * DM; t.flags = 2; t.kt = r % 16; t.nt = r / 16; return t; }
  r -= T_GATE;
  t.src = p.w_proj + (size_t)l * PLE * DM; t.ldsrc = DM; t.K = PLE; t.Nd = DM; t.dst = p.wt_proj() + (size_t)l * DM * PLE; t.flags = 0; t.kt = r % 4; t.nt = r / 4;
  return t;
}
DEVI void wtile_load(const WTile& t, float (&v)[16], float (&sv)[16], int tid) {
  const int nl = tid & 63, kq = tid >> 6;
  const int n = t.nt * 64 + nl, nc = n < t.Nd ? n : t.Nd - 1;
  const int sc = (t.flags & 1) ? inmap(nc) : nc;
  const int ksc = (t.flags & 2) ? 1 : 0;
#pragma unroll
  for (int r = 0; r < 16; ++r) {
    const int k = t.kt * 64 + r * 4 + kq;
    v[r] = t.src[(size_t)k * t.ldsrc + sc];
    sv[r] = t.scale[(k & 1023) * ksc];
  }
}
DEVI void wtile_store(const WTile& t, const float (&v)[16], const float (&sv)[16], float* sm, int tid) {
  const int nl = tid & 63, kq = tid >> 6;
  const bool ok = t.nt * 64 + nl < t.Nd;
  const bool has = (t.flags & 2) != 0;
#pragma unroll
  for (int r = 0; r < 16; ++r) sm[(r * 4 + kq) * 65 + nl] = ok ? v[r] * (has ? sv[r] : 1.f) : 0.f;
  __syncthreads();
  const int nr = tid >> 2, ks = (tid & 3) * 16;
  if (t.nt * 64 + nr < t.Nd) {
    unsigned w[8];
#pragma unroll
    for (int i = 0; i < 8; ++i) w[i] = pk2(sm[(ks + 2 * i) * 65 + nr], sm[(ks + 2 * i + 1) * 65 + nr]);
    u32x4* d = (u32x4*)(t.dst + (size_t)(t.nt * 64 + nr) * t.K + t.kt * 64 + ks);
    d[0] = (u32x4){w[0], w[1], w[2], w[3]};
    d[1] = (u32x4){w[4], w[5], w[6], w[7]};
  }
  __syncthreads();
}

__device__ void phase_p0(const Params& p, unsigned char* smem) {
  float* sm = (float*)smem;
  const int tid = (opq(threadIdx.x) & 255), lane = tid & 63, wid = tid >> 6;
  {
    constexpr int NT = NL * (16 * 121 + 256 + 1024 + 1024 + 256 + 64);
    const int vb = VB, vg = VG;
    const int nj = (NT - vb + vg - 1) / vg;
#define WT_IDX(j) (vb + ((j) < nj ? (j) : nj - 1) * vg)
    float va[16], sa[16], vb_[16], sb[16], vc[16], sc[16];
    WTile ta = wtile_decode(p, WT_IDX(0));
    wtile_load(ta, va, sa, tid);
    WTile tb = wtile_decode(p, WT_IDX(1));
    wtile_load(tb, vb_, sb, tid);
    for (int j = 0; j < nj; j += 3) {
      const WTile tc = wtile_decode(p, WT_IDX(j + 2));
      wtile_load(tc, vc, sc, tid);
      wtile_store(ta, va, sa, sm, tid);
      ta = wtile_decode(p, WT_IDX(j + 3));
      wtile_load(ta, va, sa, tid);
      if (j + 1 < nj) wtile_store(tb, vb_, sb, sm, tid);
      tb = wtile_decode(p, WT_IDX(j + 4));
      wtile_load(tb, vb_, sb, tid);
      if (j + 2 < nj) wtile_store(tc, vc, sc, sm, tid);
    }
#undef WT_IDX
  }
  for (int it = VB; it < MTOK / 4; it += VG) {
    const int row = it * 4 + wid;
    const float* src = row < MP ? p.x_prompt + (size_t)row * DM : p.x_sample + (size_t)(row - MP) * DM;
    float* hd = p.out + (size_t)row * DM;
    bf16_t* hbd = p.hb() + (size_t)row * DM;
    float ss = 0.f;
#pragma unroll
    for (int i = 0; i < 4; ++i) {
      const int c = i * 256 + lane * 4;
      const f32x4 v = *(const f32x4*)(src + c);
      ss += v.x * v.x + v.y * v.y + v.z * v.z + v.w * v.w;
      *(f32x4*)(hd + c) = v;
      *(u32x2*)(hbd + c) = (u32x2){pk2(v.x, v.y), pk2(v.z, v.w)};
    }
#pragma unroll
    for (int o = 1; o < 64; o <<= 1) ss += shx(ss, o, lane);
    if (lane < 16) p.ssq0()[(size_t)row * 16 + lane] = lane == 0 ? ss : 0.f;
  }
  const int G = NL * MTOK * 32;
  for (int g = VB * NTHR + tid; g < G; g += VG * NTHR) {
    const int l = g / (MTOK * 32), rem = g % (MTOK * 32), row = rem >> 5, c8 = rem & 31;
    const float* src = row < MP ? p.p_prompt + ((size_t)(l * MP + row) * PLE + c8 * 8) : p.p_sample + ((size_t)(l * MS + row - MP) * PLE + c8 * 8);
    const f32x4 a = *(const f32x4*)src, b = *(const f32x4*)(src + 4);
    *(u32x4*)(p.pb() + (size_t)g * 8) = (u32x4){pk2(a.x, a.y), pk2(a.z, a.w), pk2(b.x, b.y), pk2(b.z, b.w)};
  }
}

enum { EPI_PROJ = 0, EPI_LOGIT = 1, EPI_RESID = 2, EPI_UP = 3, EPI_PLE = 4, EPI_PP = 5 };
struct EpiArgs {
  const float* ssq_in; float* ssq_out; float* h; bf16_t* hb; bf16_t* obf; int ldo; float* of32; const bf16_t* pp;
};

template <int EPI>
DEVI float epi_rs(const EpiArgs& e, int row) {
  if (EPI == EPI_PROJ || EPI == EPI_LOGIT || EPI == EPI_UP || EPI == EPI_PLE) {
    const f32x4* sp = (const f32x4*)(e.ssq_in + (size_t)row * 16);
    const f32x4 a = sp[0], b = sp[1], c = sp[2], d = sp[3];
    const float s = ((a.x + a.y) + (a.z + a.w)) + ((b.x + b.y) + (b.z + b.w)) + ((c.x + c.y) + (c.z + c.w)) + ((d.x + d.y) + (d.z + d.w));
    return rsqrtf(s * (1.f / 1024.f) + EPS);
  }
  return 1.f;
}
template <int EPI>
DEVI void epi_elem(const EpiArgs& e, int row, int col, f32x4 v, float rs, float& sq) {
  if (EPI == EPI_PROJ) {
    v *= rs;
    *(u32x2*)(e.obf + (size_t)row * e.ldo + col) = (u32x2){pk2(v.x, v.y), pk2(v.z, v.w)};
  } else if (EPI == EPI_LOGIT) {
    v *= rs;
    *(f32x4*)(e.of32 + (size_t)row * 16 + col) = v;
  } else if (EPI == EPI_PP) {
    *(u32x2*)(e.obf + (size_t)row * e.ldo + (col & 1023)) = (u32x2){pk2(v.x, v.y), pk2(v.z, v.w)};
  } else if (EPI == EPI_UP) {
    v *= rs;
    v.x = fmaxf(v.x, 0.f); v.y = fmaxf(v.y, 0.f); v.z = fmaxf(v.z, 0.f); v.w = fmaxf(v.w, 0.f);
    v = v * v;
    *(u32x2*)(e.obf + (size_t)row * e.ldo + col) = (u32x2){pk2(v.x, v.y), pk2(v.z, v.w)};
  } else {
    float* hp = e.h + (size_t)row * DM + col;
    f32x4 hv = *(const f32x4*)hp;
    if (EPI == EPI_RESID) {
      hv += v;
    } else {
      const u32x2 pv = *(const u32x2*)(e.pp + (size_t)row * DM + col);
      hv.x += sigm(v.x * rs) * lo2f(pv.x); hv.y += sigm(v.y * rs) * hi2f(pv.x);
      hv.z += sigm(v.z * rs) * lo2f(pv.y); hv.w += sigm(v.w * rs) * hi2f(pv.y);
    }
    *(f32x4*)hp = hv;
    *(u32x2*)(e.hb + (size_t)row * DM + col) = (u32x2){pk2(hv.x, hv.y), pk2(hv.z, hv.w)};
    sq += hv.x * hv.x + hv.y * hv.y + hv.z * hv.z + hv.w * hv.w;
  }
}

template <int EPI>
DEVI void epi_elem8(const EpiArgs& e, int row, int col, f32x4 v0, f32x4 v1, float rs, float& sq) {
  if (EPI == EPI_PROJ || EPI == EPI_UP || EPI == EPI_PP) {
    if (EPI != EPI_PP) { v0 *= rs; v1 *= rs; }
    if (EPI == EPI_UP) {
      v0.x = fmaxf(v0.x, 0.f); v0.y = fmaxf(v0.y, 0.f); v0.z = fmaxf(v0.z, 0.f); v0.w = fmaxf(v0.w, 0.f);
      v1.x = fmaxf(v1.x, 0.f); v1.y = fmaxf(v1.y, 0.f); v1.z = fmaxf(v1.z, 0.f); v1.w = fmaxf(v1.w, 0.f);
      v0 = v0 * v0; v1 = v1 * v1;
    }
    const int c = EPI == EPI_PP ? (col & 1023) : col;
    *(u32x4*)(e.obf + (size_t)row * e.ldo + c) = (u32x4){pk2(v0.x, v0.y), pk2(v0.z, v0.w), pk2(v1.x, v1.y), pk2(v1.z, v1.w)};
  } else {
    float* hp = e.h + (size_t)row * DM + col;
    f32x4 h0 = *(const f32x4*)hp, h1 = *(const f32x4*)(hp + 4);
    if (EPI == EPI_RESID) {
      h0 += v0; h1 += v1;
    } else {
      const u32x4 pv = *(const u32x4*)(e.pp + (size_t)row * DM + col);
      h0.x += sigm(v0.x * rs) * lo2f(pv.x); h0.y += sigm(v0.y * rs) * hi2f(pv.x);
      h0.z += sigm(v0.z * rs) * lo2f(pv.y); h0.w += sigm(v0.w * rs) * hi2f(pv.y);
      h1.x += sigm(v1.x * rs) * lo2f(pv.z); h1.y += sigm(v1.y * rs) * hi2f(pv.z);
      h1.z += sigm(v1.z * rs) * lo2f(pv.w); h1.w += sigm(v1.w * rs) * hi2f(pv.w);
    }
    *(f32x4*)hp = h0;
    *(f32x4*)(hp + 4) = h1;
    *(u32x4*)(e.hb + (size_t)row * DM + col) = (u32x4){pk2(h0.x, h0.y), pk2(h0.z, h0.w), pk2(h1.x, h1.y), pk2(h1.z, h1.w)};
    sq += (h0.x * h0.x + h0.y * h0.y + h0.z * h0.z + h0.w * h0.w) + (h1.x * h1.x + h1.y * h1.y + h1.z * h1.z + h1.w * h1.w);
  }
}

template <int WMT, int WNT, int WGM, int WGN, int EPI, int BK = 32, bool KSPLIT = false>
__device__ __forceinline__ void gemm_tile(const bf16_t* __restrict__ A, int lda, const bf16_t* __restrict__ Bt, int ldb, int K, int m0, int n0,
                                          bf16_t* lds, const EpiArgs& e) {
  constexpr int BM = WGM * WMT * 16, BN = WGN * WNT * 16, LDR = BK + 8;
  constexpr int STAGE = (BM + BN) * LDR;
  constexpr int PPR = BK / 8, RPI = NTHR / PPR;
  constexpr int NA = BM / RPI, NB = (BN + RPI - 1) / RPI;
  const int tid = (opq(threadIdx.x) & 255), lane = tid & 63, wid = tid >> 6;
  const int wm = wid / WGN, wn = wid % WGN;
  const int fr = lane & 15, fq = lane >> 4;
  f32x4 acc[WMT][WNT];
#pragma unroll
  for (int i = 0; i < WMT; ++i)
#pragma unroll
    for (int j = 0; j < WNT; ++j) acc[i][j] = (f32x4){0.f, 0.f, 0.f, 0.f};
  u32x4 ra0[NA], rb0[NB], ra1[NA], rb1[NB];
  const int khalf = KSPLIT ? VHALF : 0;
  const int nk = (KSPLIT ? K / 2 : K) / BK;
  const int prow = tid / PPR, ppc = tid % PPR;
  const unsigned ta = (unsigned)(prow * lda + ppc * 8) * 2u, tb = (unsigned)(prow * ldb + ppc * 8) * 2u;
  const char* Au = (const char*)(A + (size_t)m0 * lda + (size_t)khalf * (K / 2));
  const char* Bu = (const char*)(Bt + (size_t)n0 * ldb + (size_t)khalf * (K / 2));
#define BGUARD(i) (BN >= RPI * ((i) + 1) || prow + (i) * RPI < BN)
#define GLOAD(kt, RA, RB) do { \
    _Pragma("unroll") for (int i = 0; i < NA; ++i) RA[i] = *(const u32x4*)(Au + ((size_t)i * RPI * lda + (size_t)(kt) * BK) * 2 + ta); \
    _Pragma("unroll") for (int i = 0; i < NB; ++i) if (BGUARD(i)) RB[i] = *(const u32x4*)(Bu + ((size_t)i * RPI * ldb + (size_t)(kt) * BK) * 2 + tb); \
  } while (0)
#define LSTORE(st, RA, RB) do { bf16_t* sA_ = lds + (st) * STAGE; bf16_t* sB_ = sA_ + BM * LDR; \
    _Pragma("unroll") for (int i = 0; i < NA; ++i) *(u32x4*)(sA_ + (prow + i * RPI) * LDR + ppc * 8) = RA[i]; \
    _Pragma("unroll") for (int i = 0; i < NB; ++i) if (BGUARD(i)) *(u32x4*)(sB_ + (prow + i * RPI) * LDR + ppc * 8) = RB[i]; \
  } while (0)
#define COMPUTE(st) do { const bf16_t* sA = lds + (st) * STAGE; const bf16_t* sB = sA + BM * LDR; \
    _Pragma("unroll") for (int kk = 0; kk < BK / 32; ++kk) { \
      bf16x8 bfr[WNT]; \
      _Pragma("unroll") for (int nt = 0; nt < WNT; ++nt) bfr[nt] = *(const bf16x8*)(sB + (wn * WNT * 16 + nt * 16 + fr) * LDR + kk * 32 + fq * 8); \
      _Pragma("unroll") for (int mt = 0; mt < WMT; ++mt) { \
        const bf16x8 af = *(const bf16x8*)(sA + (wm * WMT * 16 + mt * 16 + fr) * LDR + kk * 32 + fq * 8); \
        _Pragma("unroll") for (int nt = 0; nt < WNT; ++nt) acc[mt][nt] = mfma16(bfr[nt], af, acc[mt][nt]); } } \
  } while (0)
  GLOAD(0, ra0, rb0);
  GLOAD(1, ra1, rb1);
  LSTORE(0, ra0, rb0);
  __syncthreads();
  for (int kt = 0; kt < nk; kt += 2) {
    const int k2 = kt + 2 < nk ? kt + 2 : nk - 2;
    GLOAD(k2, ra0, rb0);
    COMPUTE(0);
    LSTORE(1, ra1, rb1);
    __syncthreads();
    GLOAD(k2 + 1, ra1, rb1);
    COMPUTE(1);
    LSTORE(0, ra0, rb0);
    __syncthreads();
  }
#undef BGUARD
#undef COMPUTE
#undef GLOAD
#undef LSTORE
  if (KSPLIT) {
    f32x4* red = (f32x4*)((unsigned char*)lds + (khalf ? 0 : SMEM_BYTES));
    if (khalf == 1) {
#pragma unroll
      for (int i = 0; i < WMT; ++i)
#pragma unroll
        for (int j = 0; j < WNT; ++j) red[((wid * WMT + i) * WNT + j) * 64 + lane] = acc[i][j];
    }
    __syncthreads();
    if (khalf == 0) {
#pragma unroll
      for (int i = 0; i < WMT; ++i)
#pragma unroll
        for (int j = 0; j < WNT; ++j) acc[i][j] += red[((wid * WMT + i) * WNT + j) * 64 + lane];
    }
  }
  if (!KSPLIT || khalf == 0) {
#pragma unroll
  for (int mt = 0; mt < WMT; ++mt) {
    const int row = m0 + wm * WMT * 16 + mt * 16 + fr;
    const float rs = epi_rs<EPI>(e, row);
    float sq = 0.f;
#pragma unroll
    for (int nt = 0; nt < WNT; ++nt) epi_elem<EPI>(e, row, n0 + wn * WNT * 16 + nt * 16 + fq * 4, acc[mt][nt], rs, sq);
    if (EPI == EPI_RESID || EPI == EPI_PLE) {
      sq += shx(sq, 16, lane);
      sq += shx(sq, 32, lane);
      if (fq == 0) e.ssq_out[(size_t)row * 16 + (n0 / BN) * WGN + wn] = sq;
    }
  }
  }
  if (KSPLIT) __syncthreads();
}

namespace pg8 {
#define PG8_LAS __attribute__((address_space(3)))
typedef unsigned short bf16_t;
typedef short bf16x8 __attribute__((ext_vector_type(8)));
typedef float f32x4 __attribute__((ext_vector_type(4)));
typedef unsigned u32x4 __attribute__((ext_vector_type(4)));
constexpr int BM = 256, BK = 64, HALF = 128, HTB = HALF * BK * 2  , STAGE_BYTES = 8 * HTB, NXCD = 8, WGM = 8;

__host__ __device__ __forceinline__ int lds_byte(int r, int c) { const int st = (r >> 4) * 2 + (c >> 5), rr = r & 15, cc = c & 31, ob = rr * 64 + cc * 2; return st * 1024 + (ob ^ (((ob >> 9) & 1) << 5)); }
__host__ __device__ __forceinline__ void stage_rc(int b, int& R, int& C) { const int st = b / 1024, sb = b % 1024, swz = sb ^ (((sb >> 9) & 1) << 5); R = (st >> 1) * 16 + swz / 64; C = (st & 1) * 32 + (swz % 64) / 2; }
__host__ __device__ __forceinline__ int perm32(int rho) { const int n = rho >> 4, i = rho & 15; return 8 * (i >> 2) + 4 * n + (i & 3); }

struct Unit { int pm, pn; };
struct Gemm { const bf16_t* A; const bf16_t* Bt; int M, N, K; };

template <class Epi, class Sched, bool STAMP = false>
__device__ __forceinline__ void gemm_phase(PG8_LAS unsigned char* lds, const Gemm g, const Sched& S, const Epi& E, unsigned long long* stamps) {
    const int tid = opq((int)threadIdx.x), wid = __builtin_amdgcn_readfirstlane(tid >> 6), lane = tid & 63, wr = wid >> 2, wc = wid & 3, fr = lane & 15, fq = lane >> 4;
    const int K = g.K, nt = K / BK;
    int ts_lo = 0, ts_hi = 0, nts = 0; const unsigned long long rt_entry = STAMP ? (unsigned long long)wall_clock64() : 0ull;
#define PG8_STAMP() do { if (STAMP && wid == 0 && nts < 64) { const unsigned long long _c = (unsigned long long)clock64(); \
        ts_lo = (lane == nts) ? (int)(unsigned)_c : ts_lo; ts_hi = (lane == nts) ? (int)(unsigned)(_c >> 32) : ts_hi; ++nts; } } while (0)
    PG8_STAMP();
    unsigned voffA[2], voffB[2];
#pragma unroll
    for (int i = 0; i < 2; ++i) { int R, C; stage_rc(tid * 16 + i * 8192, R, C); const int Rb = Epi::PERM ? ((R & ~31) + perm32(R & 31)) : R;
        voffA[i] = (unsigned)(R * K + C) * 2u; voffB[i] = (unsigned)(Rb * K + C) * 2u; }
    const size_t kstep = (size_t)(BK * 2);
    const size_t hstep = (size_t)HALF * K * 2;
    const size_t tstep = 2 * hstep;
    const unsigned ldsw = (unsigned)wid * 1024u;
    const int aoff = lds_byte(wr * 64 + fr, fq * 8), boff = lds_byte(wc * 32 + fr, fq * 8);
#define PG8_SA(b, h) (((b) * 2 + (h)) * HTB)
#define PG8_SB(b, h) ((4 + (b) * 2 + (h)) * HTB)
#define PG8_STAGE(bufoff, gbase, voff) do { _Pragma("unroll") for (int _i = 0; _i < 2; ++_i) \
        __builtin_amdgcn_global_load_lds((const unsigned*)((const char*)(gbase) + (voff)[_i]), (PG8_LAS unsigned*)(lds + (bufoff) + ldsw + _i * 8192), 16, 0, 0); } while (0)
#define PG8_LDA(dst, b, h) do { _Pragma("unroll") for (int m = 0; m < 4; ++m) _Pragma("unroll") for (int k = 0; k < 2; ++k) dst[m][k] = *(const PG8_LAS bf16x8*)(lds + PG8_SA(b, h) + aoff + m * 2048 + k * 1024); } while (0)
#define PG8_LDB(dst, b, h) do { _Pragma("unroll") for (int n = 0; n < 2; ++n) _Pragma("unroll") for (int k = 0; k < 2; ++k) dst[n][k] = *(const PG8_LAS bf16x8*)(lds + PG8_SB(b, h) + boff + n * 2048 + k * 1024); } while (0)
#define PG8_MMA(ai, bj, At, Bt) do { __builtin_amdgcn_s_setprio(1); _Pragma("unroll") for (int m = 0; m < 4; ++m) _Pragma("unroll") for (int n = 0; n < 2; ++n) _Pragma("unroll") for (int k = 0; k < 2; ++k) \
        acc[ai][bj][m][n] = __builtin_amdgcn_mfma_f32_16x16x32_bf16(Bt[n][k], At[m][k], acc[ai][bj][m][n], 0, 0, 0); __builtin_amdgcn_s_setprio(0); } while (0)
#define PG8_WAIT_V(n) asm volatile("s_waitcnt vmcnt(" #n ")" ::: "memory")
#define PG8_WAIT_L(n) asm volatile("s_waitcnt lgkmcnt(" #n ")" ::: "memory")
#define PG8_BAR __builtin_amdgcn_s_barrier()
#define PG8_SCHED __builtin_amdgcn_sched_barrier(0)
    Unit cur, nxt; int ui = 0;
    if (!S.next(0, cur)) return;
    f32x4 acc[2][2][4][2];
#pragma unroll
    for (int a = 0; a < 2; ++a)
#pragma unroll
        for (int b = 0; b < 2; ++b)
#pragma unroll
            for (int m = 0; m < 4; ++m)
#pragma unroll
                for (int n = 0; n < 2; ++n) acc[a][b][m][n] = (f32x4){0.f, 0.f, 0.f, 0.f};
    bf16x8 At[4][2], B0[2][2], B1[2][2];
    const char* cA = (const char*)g.A + (size_t)cur.pm * tstep; const char* cB = (const char*)g.Bt + (size_t)cur.pn * tstep;
    S.a_ready(cur);
    PG8_STAGE(PG8_SB(0, 0), cB, voffB); PG8_STAGE(PG8_SA(0, 0), cA, voffA); PG8_STAGE(PG8_SB(0, 1), cB + hstep, voffB); PG8_STAGE(PG8_SA(0, 1), cA + hstep, voffA);
    if (wr == 1) PG8_BAR;
    PG8_WAIT_V(4); PG8_BAR;
    PG8_STAGE(PG8_SB(1, 0), cB + kstep, voffB); PG8_STAGE(PG8_SA(1, 0), cA + kstep, voffA); PG8_STAGE(PG8_SB(1, 1), cB + hstep + kstep, voffB);
    PG8_WAIT_V(6); PG8_BAR;
    PG8_STAMP();
    for (;;) {
        const bool has_next = S.next(ui + 1, nxt);
        const char* nA = has_next ? (const char*)g.A + (size_t)nxt.pm * tstep : cA; const char* nB = has_next ? (const char*)g.Bt + (size_t)nxt.pn * tstep : cB;
        for (int t = 0; t < nt; t += 2) {
            const bool last = (t == nt - 2);
            const char* a1 = cA + (size_t)(t + 1) * kstep;
            const char* a2 = last ? nA : cA + (size_t)(t + 2) * kstep; const char* b2 = last ? nB : cB + (size_t)(t + 2) * kstep;
            const char* a3 = a2 + kstep; const char* b3 = b2 + kstep;
            if (last && has_next) S.a_ready(nxt);
            PG8_LDB(B0, 0, 0); PG8_SCHED; PG8_LDA(At, 0, 0); PG8_STAGE(PG8_SA(1, 1), a1 + hstep, voffA);
            PG8_WAIT_L(8); PG8_BAR; PG8_WAIT_L(0); PG8_MMA(0, 0, At, B0); PG8_BAR; PG8_SCHED;
            PG8_LDB(B1, 0, 1); PG8_STAGE(PG8_SB(0, 0), b2, voffB);
            PG8_BAR; PG8_WAIT_L(0); PG8_MMA(0, 1, At, B1); PG8_BAR;
            PG8_LDA(At, 0, 1); PG8_STAGE(PG8_SA(0, 0), a2, voffA);
            PG8_BAR; PG8_WAIT_L(0); PG8_MMA(1, 0, At, B0); PG8_BAR; PG8_SCHED;
            PG8_STAGE(PG8_SB(0, 1), b2 + hstep, voffB);
            PG8_WAIT_V(6); PG8_BAR; PG8_MMA(1, 1, At, B1); PG8_BAR;
            PG8_LDB(B0, 1, 0); PG8_SCHED; PG8_LDA(At, 1, 0); PG8_STAGE(PG8_SA(0, 1), a2 + hstep, voffA);
            PG8_WAIT_L(8); PG8_BAR; PG8_WAIT_L(0); PG8_MMA(0, 0, At, B0); PG8_BAR; PG8_SCHED;
            PG8_LDB(B1, 1, 1); PG8_STAGE(PG8_SB(1, 0), b3, voffB);
            PG8_BAR; PG8_WAIT_L(0); PG8_MMA(0, 1, At, B1); PG8_BAR;
            PG8_LDA(At, 1, 1); PG8_STAGE(PG8_SA(1, 0), a3, voffA);
            PG8_BAR; PG8_WAIT_L(0); PG8_MMA(1, 0, At, B0); PG8_BAR; PG8_SCHED;
            PG8_STAGE(PG8_SB(1, 1), b3 + hstep, voffB);
            PG8_WAIT_V(6); PG8_BAR; PG8_MMA(1, 1, At, B1); PG8_BAR;
        }
        PG8_STAMP();
        if constexpr (!Epi::AFTER_DRAIN) { E(acc, cur, wr, wc, fr, fq); S.done(cur); }
        PG8_STAMP();
        if (!has_next) break;
#pragma unroll
        for (int a = 0; a < 2; ++a)
#pragma unroll
            for (int b = 0; b < 2; ++b)
#pragma unroll
                for (int m = 0; m < 4; ++m)
#pragma unroll
                    for (int n = 0; n < 2; ++n) acc[a][b][m][n] = (f32x4){0.f, 0.f, 0.f, 0.f};
        cur = nxt; cA = nA; cB = nB; ++ui;
    }
    PG8_WAIT_V(0);
    if (wr == 0) PG8_BAR;
    PG8_BAR;
    if constexpr (Epi::AFTER_DRAIN) { E.fused(acc, cur, wr, wc, fr, fq, lds, wid, lane); S.done(cur); }
    PG8_STAMP();
    if (STAMP && wid == 0) { stamps[lane] = lane < nts ? (((unsigned long long)(unsigned)ts_hi << 32) | (unsigned)ts_lo) : 0ull;
        if (lane == 62) stamps[62] = rt_entry; if (lane == 63) stamps[63] = (unsigned long long)wall_clock64(); }
#undef PG8_STAMP
#undef PG8_SA
#undef PG8_SB
#undef PG8_STAGE
#undef PG8_LDA
#undef PG8_LDB
#undef PG8_MMA
#undef PG8_WAIT_V
#undef PG8_WAIT_L
#undef PG8_BAR
#undef PG8_SCHED
}
}

DEVI void unit_map(int L, int nM, int nN, int& pm, int& pn) {
  const int nwg = nM * nN, q = nwg / 8, r = nwg % 8, xcd = L % 8, off = L / 8;
  const int wgid = (xcd < r ? xcd * (q + 1) : r * (q + 1) + (xcd - r) * q) + off;
  const int nig = 8 * nN, gid = wgid / nig, fm = gid * 8, gsz = (nM - fm) < 8 ? (nM - fm) : 8, w = wgid - gid * nig;
  pm = fm + (w % gsz); pn = w / gsz;
}
struct RowSched {
  int nM, nN, nLimit, G, c;
  __device__ __forceinline__ bool next(int i, pg8::Unit& u) const { const int L = i * G + c; if (L >= nLimit) return false; unit_map(L, nM, nN, u.pm, u.pn); return true; }
  __device__ __forceinline__ void a_ready(const pg8::Unit&) const {}
  __device__ __forceinline__ void done(const pg8::Unit&) const {}
};
struct DiagSched {
  int nLimit, G, c;
  __device__ __forceinline__ bool next(int i, pg8::Unit& u) const { const int L = i * G + c; if (L >= nLimit) return false; const int l = L / 272, r = L - l * 272; u.pm = l * 68 + (r >> 2); u.pn = l * 4 + (r & 3); return true; }
  __device__ __forceinline__ void a_ready(const pg8::Unit&) const {}
  __device__ __forceinline__ void done(const pg8::Unit&) const {}
};
template <int EPI> struct BigEpi {
  static constexpr bool PERM = true, AFTER_DRAIN = false;
  EpiArgs e;
  __device__ __forceinline__ void operator()(const f32x4 (&acc)[2][2][4][2], const pg8::Unit& u, int wr, int wc, int fr, int fq) const {
    const int lane = fq * 16 + fr;
#pragma unroll
    for (int ai = 0; ai < 2; ++ai)
#pragma unroll
      for (int m = 0; m < 4; ++m) {
        const int row = u.pm * 256 + ai * 128 + wr * 64 + m * 16 + fr;
        const float rs = epi_rs<EPI>(e, row);
        float sq = 0.f;
#pragma unroll
        for (int bj = 0; bj < 2; ++bj) epi_elem8<EPI>(e, row, u.pn * 256 + bj * 128 + wc * 32 + fq * 8, acc[ai][bj][m][0], acc[ai][bj][m][1], rs, sq);
        if (EPI == EPI_RESID || EPI == EPI_PLE) {
          sq += shx(sq, 16, lane);
          sq += shx(sq, 32, lane);
          if (fq == 0) e.ssq_out[(size_t)row * 16 + u.pn * 4 + wc] = sq;
        }
      }
  }
};

template <int EPI>
__device__ void gemm_big_phase(const bf16_t* A, const bf16_t* Bt, int K, int M, int N, unsigned char* lds_all, unsigned char* smem_half, const EpiArgs& e) {
  const int nM = M / 256, nN = N / 256, nU = nM * nN, G = gridDim.x;
  const int L = nU % G;
  const int nLimit = (L > 0 && L <= G / 4) ? nU - L : nU;
  RowSched S; S.nM = nM; S.nN = nN; S.nLimit = nLimit; S.G = G; S.c = blockIdx.x;
  pg8::Gemm g; g.A = A; g.Bt = Bt; g.M = M; g.N = N; g.K = K;
  BigEpi<EPI> E; E.e = e;
  pg8::gemm_phase<BigEpi<EPI>, RowSched>((PG8_LAS unsigned char*)lds_all, g, S, E, nullptr);
  __syncthreads();
  const int nSmall = (nU - nLimit) * 16;
  if (nSmall <= G && K >= 512) {
    for (int st = blockIdx.x; st < nSmall; st += G) {
      const int sub = st & 15; int pm, pn; unit_map(nLimit + (st >> 4), nM, nN, pm, pn);
      gemm_tile<1, 4, 4, 1, EPI, 128, true>(A, K, Bt, K, K, pm * 256 + (sub >> 2) * 64, pn * 256 + (sub & 3) * 64, (bf16_t*)smem_half, e);
    }
  } else {
    for (int st = VB; st < nSmall; st += VG) {
      const int sub = st & 15; int pm, pn; unit_map(nLimit + (st >> 4), nM, nN, pm, pn);
      gemm_tile<1, 4, 4, 1, EPI, 128>(A, K, Bt, K, K, pm * 256 + (sub >> 2) * 64, pn * 256 + (sub & 3) * 64, (bf16_t*)smem_half, e);
    }
  }
}


template <int I, int J4>
DEVI void solve_sub4(float& r, const float (&x)[64], const float* Am) {
  if constexpr (J4 * 4 < I) {
    const f32x4 a = *(const f32x4*)(Am + I * 64 + J4 * 4);
    if constexpr (J4 * 4 + 0 < I) r -= a.x * x[J4 * 4 + 0];
    if constexpr (J4 * 4 + 1 < I) r -= a.y * x[J4 * 4 + 1];
    if constexpr (J4 * 4 + 2 < I) r -= a.z * x[J4 * 4 + 2];
    if constexpr (J4 * 4 + 3 < I) r -= a.w * x[J4 * 4 + 3];
    solve_sub4<I, J4 + 1>(r, x, Am);
  }
}
template <int I>
DEVI void solve_rows(float (&x)[64], const float* Am, const bf16_t* src, const float* sc) {
  if constexpr (I < 64) {
    float r = bf2f(src[I * 136]) * sc[I];
    solve_sub4<I, 0>(r, x, Am);
    x[I] = r;
    asm volatile("" ::: "memory");
    solve_rows<I + 1>(x, Am, src, sc);
  }
}

__device__ void gdn_prep_item(const Params& p, int l, int item, unsigned char* smem) {
  const int tid = (opq(threadIdx.x) & 255), lane = tid & 63, wid = tid >> 6, fr = lane & 15, fq = lane >> 4;
  const int h = item & 7, n = (item >> 3) & 31, b = item >> 8;
  const int tok0 = b * 2048 + n * 64;
  bf16_t* qh = (bf16_t*)smem;
  bf16_t* kh = qh + 64 * 136;
  bf16_t* vh = kh + 64 * 136;
  float* Am = (float*)(vh + 64 * 136);
  float* sbeta = Am + 64 * 64;
  float* sgc = sbeta + 64;
  float* sbe = sgc + 64;
  unsigned char* scr = (unsigned char*)p.scr() + (size_t)item * SCR_ITEM;
  bf16_t* g_uT = (bf16_t*)scr;
  bf16_t* g_w = (bf16_t*)(scr + 16384);
  bf16_t* g_qg = (bf16_t*)(scr + 32768);
  bf16_t* g_kgT = (bf16_t*)(scr + 49152);
  bf16_t* g_qk = (bf16_t*)(scr + 65536);

  if (wid == 0) {
    const float* lg = p.logits() + (size_t)(tok0 + lane) * 16;
    const float bl = lg[h], al = lg[8 + h];
    const float x = al + p.dt_bias[l * 8 + h];
    const float sp = softplus_f(x);
    float g = -__expf(p.a_log[l * 8 + h]) * sp;
#pragma unroll
    for (int o = 1; o < 64; o <<= 1) { const float t = shup(g, o, lane); if (lane >= o) g += t; }
    sbeta[lane] = sigm(bl);
    sgc[lane] = g;
    sbe[lane] = sigm(bl) * __expf(g);
  }
  u32x4 rwall[3][7];
#pragma unroll
  for (int sect = 0; sect < 3; ++sect)
#pragma unroll
    for (int r = 0; r < 7; ++r) {
      const int tl = n * 64 + wid * 16 + fq * 4 - 3 + r;
      rwall[sect][r] = (u32x4){0u, 0u, 0u, 0u};
      if (tl >= 0) rwall[sect][r] = *(const u32x4*)(p.proj() + (size_t)(b * 2048 + tl) * NPJ + sect * 1024 + h * 128 + fr * 8);
    }
#pragma unroll
  for (int sect = 0; sect < 3; ++sect) {
    const int ch0 = sect * 1024 + h * 128 + fr * 8;
    float cw[4][8];
#pragma unroll
    for (int j = 0; j < 4; ++j) {
      const f32x4 a = *(const f32x4*)(p.conv_w + (size_t)(l * 4 + j) * 3072 + ch0), c = *(const f32x4*)(p.conv_w + (size_t)(l * 4 + j) * 3072 + ch0 + 4);
      cw[j][0] = a.x; cw[j][1] = a.y; cw[j][2] = a.z; cw[j][3] = a.w; cw[j][4] = c.x; cw[j][5] = c.y; cw[j][6] = c.z; cw[j][7] = c.w;
    }
    const int ib = wid * 16 + fq * 4;
#pragma unroll
    for (int it = 0; it < 4; ++it) {
      float o[8];
#pragma unroll
      for (int c = 0; c < 8; ++c) o[c] = 0.f;
#pragma unroll
      for (int j = 0; j < 4; ++j) {
        float f[8];
        UNPACK8(rwall[sect][it + j], f);
#pragma unroll
        for (int c = 0; c < 8; ++c) o[c] += f[c] * cw[j][c];
      }
      float ss = 0.f;
#pragma unroll
      for (int c = 0; c < 8; ++c) { o[c] = silu(o[c]); ss += o[c] * o[c]; }
      if (sect < 2) {
        ss += shx(ss, 1, lane); ss += shx(ss, 2, lane); ss += shx(ss, 4, lane); ss += shx(ss, 8, lane);
        float rn = rsqrtf(ss + EPS);
        if (sect == 0) rn *= 0.08838834764831845f;
#pragma unroll
        for (int c = 0; c < 8; ++c) o[c] *= rn;
      }
      const u32x4 pk = (u32x4){pk2(o[0], o[1]), pk2(o[2], o[3]), pk2(o[4], o[5]), pk2(o[6], o[7])};
      bf16_t* dst = sect == 0 ? qh + (ib + it) * 136 + fr * 8 : (sect == 1 ? kh + (ib + it) * 136 + fr * 8 : vh + (ib + it) * 136 + fr * 8);
      *(u32x4*)dst = pk;
    }
  }
  __syncthreads();
  {
    const int i = wid * 16 + fr;
    const float gi = sgc[i], bi = sbeta[i];
    bf16x8 kx[4], qx[4];
#pragma unroll
    for (int ks = 0; ks < 4; ++ks) {
      kx[ks] = *(const bf16x8*)(kh + i * 136 + ks * 32 + fq * 8);
      qx[ks] = *(const bf16x8*)(qh + i * 136 + ks * 32 + fq * 8);
    }
#pragma unroll
    for (int jt = 0; jt < 4; ++jt) {
      f32x4 akk = (f32x4){0.f, 0.f, 0.f, 0.f}, aqk = (f32x4){0.f, 0.f, 0.f, 0.f};
      if (jt <= wid) {
#pragma unroll
        for (int ks = 0; ks < 4; ++ks) {
          const bf16x8 kj = *(const bf16x8*)(kh + (jt * 16 + fr) * 136 + ks * 32 + fq * 8);
          akk = mfma16(kj, kx[ks], akk);
          aqk = mfma16(kj, qx[ks], aqk);
        }
      }
      const int j0 = jt * 16 + fq * 4;
      float av[4], qv[4];
#pragma unroll
      for (int jj = 0; jj < 4; ++jj) {
        const int j = j0 + jj;
        const float dec = j <= i ? __expf(gi - sgc[j]) : 0.f;
        av[jj] = j < i ? bi * akk[jj] * dec : 0.f;
        qv[jj] = aqk[jj] * dec;
      }
      *(f32x4*)(Am + i * 64 + j0) = (f32x4){av[0], av[1], av[2], av[3]};
      *(u32x2*)(g_qk + i * 64 + j0) = (u32x2){pk2(qv[0], qv[1]), pk2(qv[2], qv[3])};
    }
  }
  __syncthreads();
  {
    float x[64];
    const bool isu = tid < 128;
    const int cc = tid & 127;
    solve_rows<0>(x, Am, (isu ? vh : kh) + cc, isu ? sbeta : sbe);
    if (isu) {
      u32x4* d = (u32x4*)(g_uT + cc * 64);
#pragma unroll
      for (int q = 0; q < 8; ++q) d[q] = (u32x4){pk2(x[q * 8], x[q * 8 + 1]), pk2(x[q * 8 + 2], x[q * 8 + 3]), pk2(x[q * 8 + 4], x[q * 8 + 5]), pk2(x[q * 8 + 6], x[q * 8 + 7])};
    } else {
#pragma unroll
      for (int i = 0; i < 64; ++i) g_w[i * 128 + cc] = f2bf(x[i]);
    }
  }
  {
    const float gl = sgc[63];
#pragma unroll
    for (int q = 0; q < 4; ++q) {
      const int pc = tid + q * 256, i = pc >> 4, c8 = pc & 15;
      const u32x4 v = *(const u32x4*)(qh + i * 136 + c8 * 8);
      float f[8];
      UNPACK8(v, f);
      const float s = __expf(sgc[i]);
      *(u32x4*)(g_qg + i * 128 + c8 * 8) = (u32x4){pk2(f[0] * s, f[1] * s), pk2(f[2] * s, f[3] * s), pk2(f[4] * s, f[5] * s), pk2(f[6] * s, f[7] * s)};
    }
    if (tid >= 128) {
      const int dk = tid - 128;
      u32x4* d = (u32x4*)(g_kgT + dk * 64);
#pragma unroll
      for (int q = 0; q < 8; ++q) {
        float f[8];
#pragma unroll
        for (int c = 0; c < 8; ++c) { const int i = q * 8 + c; f[c] = bf2f(kh[i * 136 + dk]) * __expf(gl - sgc[i]); }
        d[q] = (u32x4){pk2(f[0], f[1]), pk2(f[2], f[3]), pk2(f[4], f[5]), pk2(f[6], f[7])};
      }
    }
    if (tid == 0) p.gsc()[item] = __expf(gl);
  }
  __syncthreads();
}

__device__ void gdn_scan_item(const Params& p, int l, int item, unsigned char* smem) {
  const int tid = (opq(threadIdx.x) & 255), lane = tid & 63, wid = tid >> 6, fr = lane & 15, fq = lane >> 4;
  const int dvs = item & 3, h = (item >> 2) & 7, b = item >> 5;
  bf16_t* ST = (bf16_t*)smem;
  bf16_t* VT = ST + 2 * 32 * 136;
  f32x4 S[2][2];
#pragma unroll
  for (int a = 0; a < 2; ++a)
#pragma unroll
    for (int c = 0; c < 2; ++c) S[a][c] = (f32x4){0.f, 0.f, 0.f, 0.f};
  __syncthreads();
  bf16x8 fw[4], fqg[4], fqk[2], fkg[2][2];
  u32x2 fu[2];
  float gs;
  bf16x8 nw[4], nqg[4], nqk[2], nkg[2][2];
  u32x2 nu[2];
  float ngs;
#define SCAN_LOAD(n_, W, QG, QK, KG, U, GS) do { \
    const int it_ = ((b * 32 + (n_)) << 3) + h; \
    const unsigned char* scr_ = (const unsigned char*)p.scr() + (size_t)it_ * SCR_ITEM; \
    const bf16_t* g_uT = (const bf16_t*)scr_; const bf16_t* g_w = (const bf16_t*)(scr_ + 16384); const bf16_t* g_qg = (const bf16_t*)(scr_ + 32768); \
    const bf16_t* g_kgT = (const bf16_t*)(scr_ + 49152); const bf16_t* g_qk = (const bf16_t*)(scr_ + 65536); \
    _Pragma("unroll") for (int ks = 0; ks < 4; ++ks) { \
      W[ks] = *(const bf16x8*)(g_w + (wid * 16 + fr) * 128 + ks * 32 + fq * 8); \
      QG[ks] = *(const bf16x8*)(g_qg + (wid * 16 + fr) * 128 + ks * 32 + fq * 8); } \
    _Pragma("unroll") for (int ks = 0; ks < 2; ++ks) { \
      QK[ks] = *(const bf16x8*)(g_qk + (wid * 16 + fr) * 64 + ks * 32 + fq * 8); \
      _Pragma("unroll") for (int mt = 0; mt < 2; ++mt) KG[mt][ks] = *(const bf16x8*)(g_kgT + ((2 * wid + mt) * 16 + fr) * 64 + ks * 32 + fq * 8); } \
    _Pragma("unroll") for (int nt = 0; nt < 2; ++nt) U[nt] = *(const u32x2*)(g_uT + (dvs * 32 + nt * 16 + fr) * 64 + wid * 16 + fq * 4); \
    GS = p.gsc()[it_]; } while (0)
  SCAN_LOAD(0, nw, nqg, nqk, nkg, nu, ngs);
  for (int n = 0; n < 32; ++n) {
#pragma unroll
    for (int ks = 0; ks < 4; ++ks) { fw[ks] = nw[ks]; fqg[ks] = nqg[ks]; }
#pragma unroll
    for (int ks = 0; ks < 2; ++ks) { fqk[ks] = nqk[ks]; fkg[0][ks] = nkg[0][ks]; fkg[1][ks] = nkg[1][ks]; }
    fu[0] = nu[0]; fu[1] = nu[1]; gs = ngs;
    if (n + 1 < 32) SCAN_LOAD(n + 1, nw, nqg, nqk, nkg, nu, ngs);
    bf16_t* STc = ST + (n & 1) * 32 * 136;
#pragma unroll
    for (int mt = 0; mt < 2; ++mt)
#pragma unroll
      for (int nt = 0; nt < 2; ++nt)
        *(u32x2*)(STc + (nt * 16 + fr) * 136 + (2 * wid + mt) * 16 + fq * 4) = (u32x2){pk2(S[mt][nt].x, S[mt][nt].y), pk2(S[mt][nt].z, S[mt][nt].w)};
    __syncthreads();
#pragma unroll
    for (int nt = 0; nt < 2; ++nt) {
      f32x4 a = (f32x4){0.f, 0.f, 0.f, 0.f};
#pragma unroll
      for (int ks = 0; ks < 4; ++ks) {
        const bf16x8 sb = *(const bf16x8*)(STc + (nt * 16 + fr) * 136 + ks * 32 + fq * 8);
        a = mfma16(fw[ks], sb, a);
      }
      const float v0 = lo2f(fu[nt].x) - a.x, v1 = hi2f(fu[nt].x) - a.y, v2 = lo2f(fu[nt].y) - a.z, v3 = hi2f(fu[nt].y) - a.w;
      *(u32x2*)(VT + (nt * 16 + fr) * 72 + wid * 16 + fq * 4) = (u32x2){pk2(v0, v1), pk2(v2, v3)};
    }
    __syncthreads();
#pragma unroll
    for (int mt = 0; mt < 2; ++mt) {
      f32x4 a = (f32x4){0.f, 0.f, 0.f, 0.f};
#pragma unroll
      for (int ks = 0; ks < 4; ++ks) {
        const bf16x8 sa = *(const bf16x8*)(STc + (mt * 16 + fr) * 136 + ks * 32 + fq * 8);
        a = mfma16(sa, fqg[ks], a);
      }
#pragma unroll
      for (int ks = 0; ks < 2; ++ks) {
        const bf16x8 va = *(const bf16x8*)(VT + (mt * 16 + fr) * 72 + ks * 32 + fq * 8);
        a = mfma16(va, fqk[ks], a);
      }
      const size_t row = (size_t)b * 2048 + n * 64 + wid * 16 + fr;
      *(u32x2*)(p.ogdn() + row * DM + h * 128 + dvs * 32 + mt * 16 + fq * 4) = (u32x2){pk2(a.x, a.y), pk2(a.z, a.w)};
    }
#pragma unroll
    for (int mt = 0; mt < 2; ++mt)
#pragma unroll
      for (int nt = 0; nt < 2; ++nt) {
        f32x4 a = S[mt][nt] * gs;
#pragma unroll
        for (int ks = 0; ks < 2; ++ks) {
          const bf16x8 vb = *(const bf16x8*)(VT + (nt * 16 + fr) * 72 + ks * 32 + fq * 8);
          a = mfma16(fkg[mt][ks], vb, a);
        }
        S[mt][nt] = a;
      }
  }
  float* so = p.out + O_GDNP + ((size_t)(l * 8 + b) * 8 + h) * 16384;
#pragma unroll
  for (int mt = 0; mt < 2; ++mt)
#pragma unroll
    for (int nt = 0; nt < 2; ++nt)
#pragma unroll
      for (int jj = 0; jj < 4; ++jj) so[((2 * wid + mt) * 16 + fq * 4 + jj) * 128 + dvs * 32 + nt * 16 + fr] = S[mt][nt][jj];
  __syncthreads();
#undef SCAN_LOAD
}

__device__ void gdn_sample_item(const Params& p, int l, int item, unsigned char* smem) {
  const int tid = (opq(threadIdx.x) & 255), lane = tid & 63, wid = tid >> 6;
  const int h = item & 7, b = item >> 3;
  float* qs = (float*)smem;
  float* ks = qs + 1024;
  float* vs = ks + 1024;
  float* part = vs + 1024;
  float* sbeta = part + 256;
  float* sa = sbeta + 8;
  const int dv = tid & 127, half = tid >> 7;
  float S[64];
  const float* s0 = p.state_gdn + ((size_t)(l * 128 + b) * 8 + h) * 16384 + (half * 8192 + dv);
#pragma unroll
  for (int k = 0; k < 64; ++k) S[k] = s0[k * 128];
#pragma unroll
  for (int ps = 0; ps < 2; ++ps) {
    const int c = tid + ps * 256;
    if (c < 384) {
      const int sect = c >> 7, ci = c & 127;
      const int ch = sect * 1024 + h * 128 + ci;
      float xw[11], cwv[4];
#pragma unroll
      for (int j = 0; j < 4; ++j) cwv[j] = p.conv_w[(size_t)(l * 4 + j) * 3072 + ch];
#pragma unroll
      for (int j = 0; j < 3; ++j) xw[j] = p.cache_conv[((size_t)(l * 128 + b) * 3 + j) * 3072 + ch];
#pragma unroll
      for (int t = 0; t < 8; ++t) xw[3 + t] = bf2f(p.proj()[(size_t)(MP + b * 8 + t) * NPJ + ch]);
      float* dst = sect == 0 ? qs : (sect == 1 ? ks : vs);
#pragma unroll
      for (int t = 0; t < 8; ++t) dst[t * 128 + ci] = silu(xw[t] * cwv[0] + xw[t + 1] * cwv[1] + xw[t + 2] * cwv[2] + xw[t + 3] * cwv[3]);
    }
  }
  if (tid < 8) {
    const float* lg = p.logits() + (size_t)(MP + b * 8 + tid) * 16;
    const float x = lg[8 + h] + p.dt_bias[l * 8 + h];
    const float sp = softplus_f(x);
    sa[tid] = __expf(-__expf(p.a_log[l * 8 + h]) * sp);
    sbeta[tid] = sigm(lg[h]);
  }
  __syncthreads();
#pragma unroll
  for (int u = 0; u < 4; ++u) {
    const int t = wid * 2 + (u >> 1);
    float* arr = (u & 1) ? ks : qs;
    const float a0 = arr[t * 128 + lane], a1 = arr[t * 128 + 64 + lane];
    float ss = a0 * a0 + a1 * a1;
#pragma unroll
    for (int o = 1; o < 64; o <<= 1) ss += shx(ss, o, lane);
    float rn = rsqrtf(ss + EPS);
    if (!(u & 1)) rn *= 0.08838834764831845f;
    arr[t * 128 + lane] = a0 * rn;
    arr[t * 128 + 64 + lane] = a1 * rn;
  }
  __syncthreads();
#pragma unroll 1
  for (int t = 0; t < 8; ++t) {
    const float a = sa[t], bt = sbeta[t];
    float kv = 0.f;
#pragma unroll
    for (int k4 = 0; k4 < 16; ++k4) {
      const f32x4 kk = *(const f32x4*)(ks + t * 128 + half * 64 + k4 * 4);
      S[k4 * 4 + 0] *= a; S[k4 * 4 + 1] *= a; S[k4 * 4 + 2] *= a; S[k4 * 4 + 3] *= a;
      kv += S[k4 * 4 + 0] * kk.x + S[k4 * 4 + 1] * kk.y + S[k4 * 4 + 2] * kk.z + S[k4 * 4 + 3] * kk.w;
      if ((k4 & 3) == 3) asm volatile("" ::: "memory");
    }
    part[half * 128 + dv] = kv;
    __syncthreads();
    const float delta = bt * (vs[t * 128 + dv] - (part[dv] + part[128 + dv]));
    __syncthreads();
    float o = 0.f;
#pragma unroll
    for (int k4 = 0; k4 < 16; ++k4) {
      const f32x4 kk = *(const f32x4*)(ks + t * 128 + half * 64 + k4 * 4);
      const f32x4 qq = *(const f32x4*)(qs + t * 128 + half * 64 + k4 * 4);
      S[k4 * 4 + 0] += kk.x * delta; S[k4 * 4 + 1] += kk.y * delta; S[k4 * 4 + 2] += kk.z * delta; S[k4 * 4 + 3] += kk.w * delta;
      o += S[k4 * 4 + 0] * qq.x + S[k4 * 4 + 1] * qq.y + S[k4 * 4 + 2] * qq.z + S[k4 * 4 + 3] * qq.w;
      if ((k4 & 3) == 3) asm volatile("" ::: "memory");
    }
    part[half * 128 + dv] = o;
    __syncthreads();
    if (half == 0) p.ogdn()[(size_t)(MP + b * 8 + t) * DM + h * 128 + dv] = f2bf(part[dv] + part[128 + dv]);
    __syncthreads();
  }
  float* so = p.out + O_GDNS + ((size_t)(l * 128 + b) * 8 + h) * 16384 + opq(half * 8192 + dv);
#pragma unroll
  for (int k = 0; k < 64; ++k) so[k * 128] = S[k];
  __syncthreads();
}

__device__ void gdn_sample_pair(const Params& p, int l, int pair, unsigned char* smem) {
  const int tid = (opq(threadIdx.x) & 255), lane = tid & 63, wid = tid >> 6;
  const int sub = tid >> 7, dv = tid & 127;
  const int item = pair * 2 + sub, h = item & 7, b = item >> 3;
  float* qs = (float*)smem + sub * 3104;
  float* ks = qs + 1024;
  float* vs = qs + 2048;
  float* sbeta = qs + 3072;
  float* sa = qs + 3080;
  f32x2 S2[64];
  const float* s0 = p.state_gdn + ((size_t)(l * 128 + b) * 8 + h) * 16384 + dv;
#pragma unroll
  for (int k = 0; k < 64; ++k) { S2[k].x = s0[(2 * k) * 128]; S2[k].y = s0[(2 * k + 1) * 128]; }
#pragma unroll
  for (int sect = 0; sect < 3; ++sect) {
    const int ch = sect * 1024 + h * 128 + dv;
    float xw[11], cwv[4];
#pragma unroll
    for (int j = 0; j < 4; ++j) cwv[j] = p.conv_w[(size_t)(l * 4 + j) * 3072 + ch];
#pragma unroll
    for (int j = 0; j < 3; ++j) xw[j] = p.cache_conv[((size_t)(l * 128 + b) * 3 + j) * 3072 + ch];
#pragma unroll
    for (int t = 0; t < 8; ++t) xw[3 + t] = bf2f(p.proj()[(size_t)(MP + b * 8 + t) * NPJ + ch]);
    float* dst = sect == 0 ? qs : (sect == 1 ? ks : vs);
#pragma unroll
    for (int t = 0; t < 8; ++t) dst[t * 128 + dv] = silu(xw[t] * cwv[0] + xw[t + 1] * cwv[1] + xw[t + 2] * cwv[2] + xw[t + 3] * cwv[3]);
  }
  if (dv < 8) {
    const float* lg = p.logits() + (size_t)(MP + b * 8 + dv) * 16;
    const float x = lg[8 + h] + p.dt_bias[l * 8 + h];
    sa[dv] = __expf(-__expf(p.a_log[l * 8 + h]) * softplus_f(x));
    sbeta[dv] = sigm(lg[h]);
  }
  __syncthreads();
#pragma unroll
  for (int u = 0; u < 8; ++u) {
    const int t = (wid & 1) * 4 + (u >> 1);
    float* arr = (u & 1) ? ks : qs;
    const float a0 = arr[t * 128 + lane], a1 = arr[t * 128 + 64 + lane];
    float ss = a0 * a0 + a1 * a1;
#pragma unroll
    for (int o = 1; o < 64; o <<= 1) ss += shx(ss, o, lane);
    float rn = rsqrtf(ss + EPS);
    if (!(u & 1)) rn *= 0.08838834764831845f;
    arr[t * 128 + lane] = a0 * rn;
    arr[t * 128 + 64 + lane] = a1 * rn;
  }
  __syncthreads();
#pragma unroll 1
  for (int t = 0; t < 8; ++t) {
    const float a = sa[t], bt = sbeta[t];
    f32x2 kv2 = (f32x2){0.f, 0.f};
#pragma unroll
    for (int k4 = 0; k4 < 32; ++k4) {
      const f32x4 kk = *(const f32x4*)(ks + t * 128 + k4 * 4);
      kv2 += S2[2 * k4] * (f32x2){kk.x, kk.y};
      kv2 += S2[2 * k4 + 1] * (f32x2){kk.z, kk.w};
      if ((k4 & 3) == 3) asm volatile("" ::: "memory");
    }
    const float delta = bt * (vs[t * 128 + dv] - a * (kv2.x + kv2.y));
    const f32x2 a2 = (f32x2){a, a}, d2 = (f32x2){delta, delta};
    f32x2 o2 = (f32x2){0.f, 0.f};
#pragma unroll
    for (int k4 = 0; k4 < 32; ++k4) {
      const f32x4 kk = *(const f32x4*)(ks + t * 128 + k4 * 4);
      const f32x4 qq = *(const f32x4*)(qs + t * 128 + k4 * 4);
      S2[2 * k4] = S2[2 * k4] * a2 + (f32x2){kk.x, kk.y} * d2;
      S2[2 * k4 + 1] = S2[2 * k4 + 1] * a2 + (f32x2){kk.z, kk.w} * d2;
      o2 += S2[2 * k4] * (f32x2){qq.x, qq.y};
      o2 += S2[2 * k4 + 1] * (f32x2){qq.z, qq.w};
      if ((k4 & 3) == 3) asm volatile("" ::: "memory");
    }
    p.ogdn()[(size_t)(MP + b * 8 + t) * DM + h * 128 + dv] = f2bf(o2.x + o2.y);
  }
  float* so = p.out + O_GDNS + ((size_t)(l * 128 + b) * 8 + h) * 16384 + opq(dv);
#pragma unroll
  for (int k = 0; k < 64; ++k) { so[(2 * k) * 128] = S2[k].x; so[(2 * k + 1) * 128] = S2[k].y; }
  __syncthreads();
}

__device__ void swa_prompt_item(const Params& p, int l, int item, unsigned char* smem) {
  const int tid = (opq(threadIdx.x) & 255), lane = tid & 63, wid = tid >> 6, fr = lane & 15, fq = lane >> 4;
  const int kvh = item & 3, hb2 = (item >> 2) & 31, b = item >> 7;
  bf16_t* Ks = (bf16_t*)smem;
  bf16_t* VT = Ks + 208 * 72;
  bf16_t* Pw = VT + 64 * 216 + wid * 16 * 168;
  const int tk0 = hb2 * 64 - 128;
  u32x4 krw[7], vrw[7];
#pragma unroll
  for (int i = 0; i < 7; ++i) {
    const int pc = tid + i * NTHR, kj = pc >> 3, c8 = pc & 7, tk = tk0 + kj;
    krw[i] = (u32x4){0u, 0u, 0u, 0u}; vrw[i] = (u32x4){0u, 0u, 0u, 0u};
    if (pc < 208 * 8 && kj < 192 && tk >= 0) {
      const bf16_t* base = p.proj() + (size_t)(b * 2048 + tk) * NPJ + kvh * 64 + c8 * 8;
      krw[i] = *(const u32x4*)(base + C_SK); vrw[i] = *(const u32x4*)(base + C_SV);
    }
  }
#pragma unroll
  for (int i = 0; i < 7; ++i) {
    const int pc = tid + i * NTHR;
    if (pc >= 208 * 8) break;
    const int kj = pc >> 3, c8 = pc & 7, tk = tk0 + kj;
    const bool ok = kj < 192 && tk >= 0;
    float kf[8], vf[8];
    UNPACK8(krw[i], kf);
    UNPACK8(vrw[i], vf);
    float ss = 0.f;
#pragma unroll
    for (int c = 0; c < 8; ++c) ss += kf[c] * kf[c];
    ss += shx(ss, 1, lane); ss += shx(ss, 2, lane); ss += shx(ss, 4, lane);
    const float rn = rsqrtf(ss * (1.f / 64.f) + EPS);
    const f32x4 w0 = *(const f32x4*)(p.k_norm + l * 64 + c8 * 8), w1 = *(const f32x4*)(p.k_norm + l * 64 + c8 * 8 + 4);
    kf[0] *= rn * w0.x; kf[1] *= rn * w0.y; kf[2] *= rn * w0.z; kf[3] *= rn * w0.w;
    kf[4] *= rn * w1.x; kf[5] *= rn * w1.y; kf[6] *= rn * w1.z; kf[7] *= rn * w1.w;
    *(u32x4*)(Ks + kj * 72 + c8 * 8) = (u32x4){pk2(kf[0], kf[1]), pk2(kf[2], kf[3]), pk2(kf[4], kf[5]), pk2(kf[6], kf[7])};
#pragma unroll
    for (int c = 0; c < 8; ++c) VT[(c8 * 8 + c) * 216 + kj] = f2bf(vf[c]);
    if (ok && tk >= 1920 && kj >= 128) {
      float* ko = p.out + O_KP + (((size_t)(l * 8 + b) * 128 + (tk - 1920)) * 4 + kvh) * 64 + c8 * 8;
      float* vo = p.out + O_VP + (((size_t)(l * 8 + b) * 128 + (tk - 1920)) * 4 + kvh) * 64 + c8 * 8;
      *(f32x4*)ko = (f32x4){kf[0], kf[1], kf[2], kf[3]};
      *(f32x4*)(ko + 4) = (f32x4){kf[4], kf[5], kf[6], kf[7]};
      *(f32x4*)vo = (f32x4){vf[0], vf[1], vf[2], vf[3]};
      *(f32x4*)(vo + 4) = (f32x4){vf[4], vf[5], vf[6], vf[7]};
    }
  }
  __syncthreads();
  const int kbase = wid * 16;
  const int ql = wid * 16 + fr;
  const size_t qrow = (size_t)b * 2048 + hb2 * 64 + ql;
  u32x4 qraw[4][2];
#pragma unroll
  for (int g = 0; g < 4; ++g) {
    const bf16_t* qp = p.proj() + qrow * NPJ + C_SQ + (kvh * 4 + g) * 64 + fq * 8;
    qraw[g][0] = *(const u32x4*)qp; qraw[g][1] = *(const u32x4*)(qp + 32);
  }
#pragma unroll
  for (int g = 0; g < 4; ++g) {
    const int head = kvh * 4 + g;
    const float slope = exp2f(-0.5f * (float)(head + 1));
    const float sink = p.sinks[l * 16 + head];
    bf16x8 qf[2];
    {
      const u32x4 r0 = qraw[g][0], r1 = qraw[g][1];
      float f0[8], f1[8];
      UNPACK8(r0, f0);
      UNPACK8(r1, f1);
      float ss = 0.f;
#pragma unroll
      for (int c = 0; c < 8; ++c) ss += f0[c] * f0[c] + f1[c] * f1[c];
      ss += shx(ss, 16, lane); ss += shx(ss, 32, lane);
      const float rn = rsqrtf(ss * (1.f / 64.f) + EPS) * 0.125f;
      const float* qn = p.q_norm + l * 64 + fq * 8;
#pragma unroll
      for (int c = 0; c < 8; ++c) { f0[c] *= rn * qn[c]; f1[c] *= rn * qn[32 + c]; }
      qf[0] = as_bf((u32x4){pk2(f0[0], f0[1]), pk2(f0[2], f0[3]), pk2(f0[4], f0[5]), pk2(f0[6], f0[7])});
      qf[1] = as_bf((u32x4){pk2(f1[0], f1[1]), pk2(f1[2], f1[3]), pk2(f1[4], f1[5]), pk2(f1[6], f1[7])});
    }
    f32x4 sc[9];
    float mx = sink;
#pragma unroll
    for (int kt = 0; kt < 9; ++kt) {
      f32x4 a = (f32x4){0.f, 0.f, 0.f, 0.f};
#pragma unroll
      for (int ks = 0; ks < 2; ++ks) {
        const bf16x8 kf = *(const bf16x8*)(Ks + (kbase + kt * 16 + fr) * 72 + ks * 32 + fq * 8);
        a = mfma16(kf, qf[ks], a);
      }
#pragma unroll
      for (int jj = 0; jj < 4; ++jj) {
        const int kj = kbase + kt * 16 + fq * 4 + jj;
        const int dist = ql + 128 - kj;
        const bool ok = dist >= 0 && dist <= 128 && (tk0 + kj) >= 0;
        const float s = ok ? a[jj] - slope * (float)dist : -INFINITY;
        a[jj] = s;
        mx = fmaxf(mx, s);
      }
      sc[kt] = a;
    }
    mx = fmaxf(mx, shx(mx, 16, lane));
    mx = fmaxf(mx, shx(mx, 32, lane));
    float sum = 0.f;
#pragma unroll
    for (int kt = 0; kt < 9; ++kt) {
      f32x4 e;
#pragma unroll
      for (int jj = 0; jj < 4; ++jj) { e[jj] = __expf(sc[kt][jj] - mx); sum += e[jj]; }
      *(u32x2*)(Pw + fr * 168 + kt * 16 + fq * 4) = (u32x2){pk2(e.x, e.y), pk2(e.z, e.w)};
    }
    *(u32x2*)(Pw + fr * 168 + 144 + fq * 4) = (u32x2){0u, 0u};
    sum += shx(sum, 16, lane);
    sum += shx(sum, 32, lane);
    const float inv = __builtin_amdgcn_rcpf(sum + __expf(sink - mx));
    __builtin_amdgcn_wave_barrier();
#pragma unroll
    for (int dt = 0; dt < 4; ++dt) {
      f32x4 a = (f32x4){0.f, 0.f, 0.f, 0.f};
#pragma unroll
      for (int ks = 0; ks < 5; ++ks) {
        const bf16x8 vf = *(const bf16x8*)(VT + (dt * 16 + fr) * 216 + kbase + ks * 32 + fq * 8);
        const bf16x8 pf = *(const bf16x8*)(Pw + fr * 168 + ks * 32 + fq * 8);
        a = mfma16(vf, pf, a);
      }
      a *= inv;
      *(u32x2*)(p.oswa() + qrow * DM + head * 64 + dt * 16 + fq * 4) = (u32x2){pk2(a.x, a.y), pk2(a.z, a.w)};
    }
    __builtin_amdgcn_wave_barrier();
  }
  __syncthreads();
}

__device__ void swa_sample_item(const Params& p, int l, int item, unsigned char* smem) {
  const int tid = (opq(threadIdx.x) & 255), lane = tid & 63, wid = tid >> 6;
  const int kvh = item & 3, b = item >> 2;
  float* Ks = (float*)smem;
  float* Vs = Ks + 136 * 68;
  float* Qs = Vs + 136 * 64;
  float* Sc = Qs + 512;
  const size_t cbase = (size_t)(l * 128 + b) * 128;
  f32x4 kvr[8], vvr[8];
#pragma unroll
  for (int i = 0; i < 8; ++i) {
    const int idx = tid + i * NTHR, j = idx >> 4, c4 = idx & 15;
    kvr[i] = *(const f32x4*)(p.cache_k + ((cbase + j) * 4 + kvh) * 64 + c4 * 4);
    vvr[i] = *(const f32x4*)(p.cache_v + ((cbase + j) * 4 + kvh) * 64 + c4 * 4);
  }
  unsigned qrw[4];
#pragma unroll
  for (int g = 0; g < 4; ++g) qrw[g] = *(const unsigned*)(p.proj() + (size_t)(MP + b * 8 + (tid >> 5)) * NPJ + C_SQ + (kvh * 4 + g) * 64 + (tid & 31) * 2);
#pragma unroll
  for (int i = 0; i < 8; ++i) {
    const int idx = tid + i * NTHR, j = idx >> 4, c4 = idx & 15;
    const f32x4 kv = kvr[i], vv = vvr[i];
    *(f32x4*)(Ks + j * 68 + c4 * 4) = kv;
    *(f32x4*)(Vs + j * 64 + c4 * 4) = vv;
  }
  {
    const int t = tid >> 5, d = (tid & 31) * 2;
    const bf16_t* base = p.proj() + (size_t)(MP + b * 8 + t) * NPJ + kvh * 64 + d;
    const unsigned kr = *(const unsigned*)(base + C_SK), vr = *(const unsigned*)(base + C_SV);
    float k0 = lo2f(kr), k1 = hi2f(kr);
    float ss = k0 * k0 + k1 * k1;
#pragma unroll
    for (int o = 1; o < 32; o <<= 1) ss += shx(ss, o, lane);
    const float rn = rsqrtf(ss * (1.f / 64.f) + EPS);
    Ks[(128 + t) * 68 + d] = k0 * rn * p.k_norm[l * 64 + d];
    Ks[(128 + t) * 68 + d + 1] = k1 * rn * p.k_norm[l * 64 + d + 1];
    Vs[(128 + t) * 64 + d] = lo2f(vr);
    Vs[(128 + t) * 64 + d + 1] = hi2f(vr);
  }
  __syncthreads();
  for (int idx = tid; idx < 128 * 64; idx += NTHR) {
    const int j = idx >> 6, d = idx & 63;
    p.out[O_KS + ((cbase + j) * 4 + kvh) * 64 + d] = Ks[(j + 8) * 68 + d];
    p.out[O_VS + ((cbase + j) * 4 + kvh) * 64 + d] = Vs[(j + 8) * 64 + d];
  }
#pragma unroll
  for (int g = 0; g < 4; ++g) {
    const int head = kvh * 4 + g;
    const float slope = exp2f(-0.5f * (float)(head + 1));
    const float sink = p.sinks[l * 16 + head];
    {
      const int t = tid >> 5, d = (tid & 31) * 2;
      const unsigned qr = qrw[g];
      const float q0 = lo2f(qr), q1 = hi2f(qr);
      float ss = q0 * q0 + q1 * q1;
#pragma unroll
      for (int o = 1; o < 32; o <<= 1) ss += shx(ss, o, lane);
      const float rn = rsqrtf(ss * (1.f / 64.f) + EPS) * 0.125f;
      Qs[t * 64 + d] = q0 * rn * p.q_norm[l * 64 + d];
      Qs[t * 64 + d + 1] = q1 * rn * p.q_norm[l * 64 + d + 1];
    }
    __syncthreads();
    for (int idx = tid; idx < 8 * 136; idx += NTHR) {
      const int tq = idx / 136, j = idx % 136;
      float s = 0.f;
#pragma unroll
      for (int d4 = 0; d4 < 16; ++d4) {
        const f32x4 qv = *(const f32x4*)(Qs + tq * 64 + d4 * 4), kq = *(const f32x4*)(Ks + j * 68 + d4 * 4);
        s += (qv.x * kq.x + qv.y * kq.y) + (qv.z * kq.z + qv.w * kq.w);
      }
      const int dist = tq + 128 - j;
      Sc[tq * 136 + j] = (dist >= 0 && dist <= 128) ? s - slope * (float)dist : -INFINITY;
    }
    __syncthreads();
#pragma unroll
    for (int u = 0; u < 2; ++u) {
      const int tq = wid * 2 + u;
      const float s0 = Sc[tq * 136 + lane], s1 = Sc[tq * 136 + 64 + lane], s2 = lane < 8 ? Sc[tq * 136 + 128 + lane] : -INFINITY;
      float mx = fmaxf(fmaxf(s0, s1), fmaxf(s2, sink));
#pragma unroll
      for (int o = 1; o < 64; o <<= 1) mx = fmaxf(mx, shx(mx, o, lane));
      const float e0 = __expf(s0 - mx), e1 = __expf(s1 - mx), e2 = __expf(s2 - mx);
      float sum = e0 + e1 + e2;
#pragma unroll
      for (int o = 1; o < 64; o <<= 1) sum += shx(sum, o, lane);
      const float inv = __builtin_amdgcn_rcpf(sum + __expf(sink - mx));
      Sc[tq * 136 + lane] = e0 * inv;
      Sc[tq * 136 + 64 + lane] = e1 * inv;
      if (lane < 8) Sc[tq * 136 + 128 + lane] = e2 * inv;
    }
    __syncthreads();
    {
      const int tq = tid >> 5, d = (tid & 31) * 2;
      float o0 = 0.f, o1 = 0.f;
#pragma unroll 2
      for (int j4 = 0; j4 < 34; ++j4) {
        const f32x4 pj = *(const f32x4*)(Sc + tq * 136 + j4 * 4);
        const f32x2 va = *(const f32x2*)(Vs + (j4 * 4 + 0) * 64 + d), vb = *(const f32x2*)(Vs + (j4 * 4 + 1) * 64 + d);
        const f32x2 vc = *(const f32x2*)(Vs + (j4 * 4 + 2) * 64 + d), vd = *(const f32x2*)(Vs + (j4 * 4 + 3) * 64 + d);
        o0 += (pj.x * va.x + pj.y * vb.x) + (pj.z * vc.x + pj.w * vd.x);
        o1 += (pj.x * va.y + pj.y * vb.y) + (pj.z * vc.y + pj.w * vd.y);
      }
      *(unsigned*)(p.oswa() + (size_t)(MP + b * 8 + tq) * DM + head * 64 + d) = pk2(o0, o1);
    }
    __syncthreads();
  }
}

__device__ void phase_mix(const Params& p, int l) {
  const int tid = (opq(threadIdx.x) & 255), lane = tid & 63, wid = tid >> 6, fr = lane & 15, fq = lane >> 4;
  for (int it = VB; it < MTOK / 4; it += VG) {
    const size_t row = (size_t)it * 4 + wid;
#pragma unroll
    for (int ps = 0; ps < 2; ++ps) {
      const int ch = (ps * 4 + fq) * 128 + fr * 8;
      const u32x4 og = *(const u32x4*)(p.ogdn() + row * DM + ch);
      const u32x4 ob = *(const u32x4*)(p.oswa() + row * DM + ch);
      const u32x4 zz = *(const u32x4*)(p.proj() + row * NPJ + C_Z + ch);
      const u32x4 ga = *(const u32x4*)(p.proj() + row * NPJ + C_G + ch);
      const u32x4 gb = *(const u32x4*)(p.proj() + row * NPJ + C_G + 1024 + ch);
      float fo[8], fb[8], fz[8], fa[8], fg[8];
      UNPACK8(og, fo); UNPACK8(ob, fb); UNPACK8(zz, fz); UNPACK8(ga, fa); UNPACK8(gb, fg);
      float ss = 0.f;
#pragma unroll
      for (int c = 0; c < 8; ++c) ss += fo[c] * fo[c];
      ss += shx(ss, 1, lane); ss += shx(ss, 2, lane); ss += shx(ss, 4, lane); ss += shx(ss, 8, lane);
      const float rn = rsqrtf(ss * (1.f / 128.f) + EPS);
      const f32x4 w0 = *(const f32x4*)(p.gdn_norm + l * 128 + fr * 8), w1 = *(const f32x4*)(p.gdn_norm + l * 128 + fr * 8 + 4);
      const float wn[8] = {w0.x, w0.y, w0.z, w0.w, w1.x, w1.y, w1.z, w1.w};
      float m[8];
#pragma unroll
      for (int c = 0; c < 8; ++c) m[c] = sigm(fa[c]) * (fo[c] * rn * wn[c] * silu(fz[c])) + sigm(fg[c]) * fb[c];
      *(u32x4*)(p.mix() + row * DM + ch) = (u32x4){pk2(m[0], m[1]), pk2(m[2], m[3]), pk2(m[4], m[5]), pk2(m[6], m[7])};
    }
  }
  const int NC = (8 + 128) * 3 * 3072;
  for (int i = VB * NTHR + tid; i < NC; i += VG * NTHR) {
    const int c = i % 3072, r = (i / 3072) % 3, bb = i / 9216;
    if (bb < 8) p.out[O_CONVP + ((size_t)(l * 8 + bb) * 3 + r) * 3072 + c] = bf2f(p.proj()[(size_t)(bb * 2048 + 2045 + r) * NPJ + c]);
    else p.out[O_CONVS + ((size_t)(l * 128 + bb - 8) * 3 + r) * 3072 + c] = bf2f(p.proj()[(size_t)(MP + (bb - 8) * 8 + 5 + r) * NPJ + c]);
  }
}

#define XB_TMO      128
#define XB_XCNT(j)  (256  + 64 * (j))
#define XB_XSUB(j)  (1280 + 64 * (j))
#define XB_XGEN(j)  (2304 + 64 * (j))
#define XB_TOP      3328
#define XB_TOPGEN   3392
#define XCD_BAR_WORDS 3456
#define XB_SPIN_CAP (1u << 18)
#define LAS __attribute__((address_space(3)))

__device__ __forceinline__ unsigned xb_ld(unsigned* p)              { return __hip_atomic_load(p, __ATOMIC_RELAXED, __HIP_MEMORY_SCOPE_AGENT); }
__device__ __forceinline__ unsigned xb_add(unsigned* p, unsigned v) { return __hip_atomic_fetch_add(p, v, __ATOMIC_RELAXED, __HIP_MEMORY_SCOPE_AGENT); }
__device__ __forceinline__ unsigned xb_xcc_id() { return (unsigned)__builtin_amdgcn_s_getreg((3 << 11) | 20) & 0xFu; }
#define XB_SPIN(cond, bar) do { unsigned _sp = 0; while (cond) { __builtin_amdgcn_s_sleep(1); \
    if ((++_sp & 255u) == 0u) { if (xb_ld(&(bar)[XB_TMO])) break; if (_sp > XB_SPIN_CAP) { atomicAdd(&(bar)[XB_TMO], 1u); break; } } } } while (0)

struct XcdBarrier {
    unsigned* bar; unsigned x;
    volatile LAS unsigned* st;
};

__device__ __forceinline__ XcdBarrier xcd_barrier_post(unsigned* bar, volatile LAS unsigned* st) {
    XcdBarrier b; b.bar = bar; b.x = xb_xcc_id(); b.st = st;
    if (threadIdx.x == 0) (void)xb_add(&bar[XB_XCNT(b.x)], 1u);
    return b;
}
__device__ __forceinline__ void xcd_barrier_complete(unsigned* bar, unsigned x, unsigned& nloc, unsigned& nx) {
    const unsigned G = gridDim.x * gridDim.y * gridDim.z;
    unsigned sum, cnt, mine, sp = 0u;
    for (;;) {
        sum = 0u; cnt = 0u; mine = 0u;
#pragma unroll
        for (unsigned j = 0; j < 16; ++j) { const unsigned c = xb_ld(&bar[XB_XCNT(j)]); sum += c; cnt += (c > 0u) ? 1u : 0u; mine = (j == x) ? c : mine; }
        if (sum == G) break;
        __builtin_amdgcn_s_sleep(1);
        if ((++sp & 255u) == 0u) { if (xb_ld(&bar[XB_TMO])) break; if (sp > XB_SPIN_CAP) { atomicAdd(&bar[XB_TMO], 1u); break; } }
    }
    nloc = mine > 0u ? mine : 1u; nx = cnt > 0u ? cnt : 1u;
}

__device__ __forceinline__ void xcd_barrier(const XcdBarrier& b) {
    asm volatile("s_waitcnt vmcnt(0)" ::: "memory");
    __syncthreads();
    if (threadIdx.x == 0) {
        unsigned* bar = b.bar;
        __builtin_amdgcn_s_waitcnt(0);
        unsigned nloc = b.st[0], nx = b.st[1];
        if (nloc == 0u) { xcd_barrier_complete(bar, b.x, nloc, nx); b.st[0] = nloc; b.st[1] = nx; }
        const unsigned old = xb_add(&bar[XB_XSUB(b.x)], 1u);
        const unsigned gen = old / nloc;
        if (old + 1u == (gen + 1u) * nloc) {
            __builtin_amdgcn_fence(__ATOMIC_RELEASE, "agent");
            asm volatile("s_waitcnt vmcnt(0)" ::: "memory");
            const unsigned og = xb_add(&bar[XB_TOP], 1u);
            const unsigned tg = og / nx;
            if (og + 1u == (tg + 1u) * nx) xb_add(&bar[XB_TOPGEN], 1u);
            else XB_SPIN(xb_ld(&bar[XB_TOPGEN]) == tg, bar);
            __builtin_amdgcn_fence(__ATOMIC_ACQUIRE, "agent");
            xb_add(&bar[XB_XGEN(b.x)], 1u);
            asm volatile("s_waitcnt vmcnt(0)" ::: "memory");
        } else {
            XB_SPIN(xb_ld(&bar[XB_XGEN(b.x)]) == gen, bar);
            __builtin_amdgcn_fence(__ATOMIC_ACQUIRE, "agent");
            asm volatile("s_waitcnt vmcnt(0)" ::: "memory");
        }
    }
    __syncthreads();
}


#define NPHASE_PRE 2
#define NPHASE_L 8
constexpr int LDS_TOTAL = 2 * SMEM_BYTES;
__global__ void __launch_bounds__(512, 2) mega(Params p, int ph_lo, int ph_hi) {
  extern __shared__ __attribute__((aligned(16))) unsigned char lds_all[];
  if (ph_hi < 0) cg::this_grid().sync();
  __shared__ uint4 xb_words;
  if (threadIdx.x == 0) xb_words = make_uint4(0u, 0u, 0u, 0u);
  __syncthreads();
  XcdBarrier xb = xcd_barrier_post(p.bar(), (volatile LAS unsigned*)&xb_words);
  unsigned char* smem = lds_all + VHALF * SMEM_BYTES;
  for (int ph = ph_lo; ph < ph_hi; ++ph) {
    if (ph > ph_lo) xcd_barrier(xb);
    if (ph == 0) { phase_p0(p, smem); continue; }
    if (ph == 1) {
      {
        EpiArgs e{};
        e.obf = p.pp(); e.ldo = DM;
        DiagSched S; S.nLimit = 1024; S.G = gridDim.x; S.c = blockIdx.x;
        pg8::Gemm g; g.A = p.pb(); g.Bt = p.wt_proj(); g.M = NL * MTOK; g.N = NL * DM; g.K = PLE;
        BigEpi<EPI_PP> E; E.e = e;
        pg8::gemm_phase<BigEpi<EPI_PP>, DiagSched>((PG8_LAS unsigned char*)lds_all, g, S, E, nullptr);
        __syncthreads();
      }
      for (int st = VB; st < 64 * 16; st += VG) {
        const int L = 1024 + (st >> 4), sub = st & 15, l = L / 272, r = L - l * 272, pm = r >> 2, pn = r & 3;
        EpiArgs e{};
        e.obf = p.pp() + (size_t)l * MTOK * DM; e.ldo = DM;
        gemm_tile<1, 4, 4, 1, EPI_PP, 128>(p.pb() + (size_t)l * MTOK * PLE, PLE, p.wt_proj() + (size_t)l * DM * PLE, PLE, PLE, pm * 256 + (sub >> 2) * 64, pn * 256 + (sub & 3) * 64, (bf16_t*)smem, e);
      }
      continue;
    }
    const int l = (ph - NPHASE_PRE) / NPHASE_L, s = (ph - NPHASE_PRE) % NPHASE_L;
#ifndef REPMASK
#define REPMASK 0
#endif
    for (int rep = 0; rep < (((REPMASK >> s) & 1) ? 2 : 1); ++rep) {
    if (rep) xcd_barrier(xb);
    switch (s) {
      case 0: {
        EpiArgs e{};
        e.ssq_in = p.ssq0(); e.obf = p.proj(); e.ldo = NPJ; e.of32 = p.logits();
        const bf16_t* Bt = p.wt_in() + (size_t)l * NIN * DM;
        gemm_big_phase<EPI_PROJ>(p.hb(), Bt, DM, MTOK, NPJ, lds_all, smem, e);
        for (int t = VB; t < 272; t += VG)
          gemm_tile<1, 1, 4, 1, EPI_LOGIT, 128>(p.hb(), DM, Bt + (size_t)NPJ * DM, DM, DM, t * 64, 0, (bf16_t*)smem, e);
      } break;
      case 1: {
        const int nB1 = VG == 512 ? 3072 : 3584;
        for (int t = VB; t < nB1; t += VG) {
          if (t < 2048) gdn_prep_item(p, l, t, smem);
          else if (t < 3072) swa_prompt_item(p, l, t - 2048, smem);
          else swa_sample_item(p, l, t - 3072, smem);
        }
      } break;
      case 2: {
        if (VG == 512) {
          if (VB < 256) gdn_scan_item(p, l, VB, smem);
          else {
            gdn_sample_pair(p, l, VB - 256, smem); gdn_sample_pair(p, l, VB, smem);
            swa_sample_item(p, l, (VB - 256) * 2, smem); swa_sample_item(p, l, (VB - 256) * 2 + 1, smem);
          }
        } else {
          for (int t = VB; t < 256 + 512; t += VG) {
            if (t < 256) gdn_scan_item(p, l, t, smem);
            else gdn_sample_pair(p, l, t - 256, smem);
          }
        }
      } break;
      case 3: phase_mix(p, l); break;
      case 4: {
        EpiArgs e{};
        e.h = p.out; e.hb = p.hb2(); e.ssq_out = p.ssq1();
        gemm_big_phase<EPI_RESID>(p.mix(), p.wt_out() + (size_t)l * DM * DM, DM, MTOK, DM, lds_all, smem, e);
      } break;
      case 5: {
        EpiArgs e{};
        e.ssq_in = p.ssq1(); e.obf = p.proj(); e.ldo = DFF;
        gemm_big_phase<EPI_UP>(p.hb2(), p.wt_up() + (size_t)l * DFF * DM, DM, MTOK, DFF, lds_all, smem, e);
      } break;
      case 6: {
        EpiArgs e{};
        e.h = p.out; e.hb = p.hb2(); e.ssq_out = p.ssq2();
        gemm_big_phase<EPI_RESID>(p.proj(), p.wt_down() + (size_t)l * DM * DFF, DFF, MTOK, DM, lds_all, smem, e);
      } break;
      case 7: {
        EpiArgs e{};
        e.h = p.out; e.hb = p.hb(); e.ssq_in = p.ssq2(); e.ssq_out = p.ssq0(); e.pp = p.pp() + (size_t)l * MTOK * DM;
        gemm_big_phase<EPI_PLE>(p.hb2(), p.wt_gate() + (size_t)l * DM * DM, DM, MTOK, DM, lds_all, smem, e);
      } break;
    }
    }
  }
}

extern "C" void kernel_launch(void* const* d_in, const int* in_sizes, int n_in, void* d_out, int out_size, void* d_ws, size_t ws_size,
                              hipStream_t stream) {
  Params p{};
  const float* const* in = (const float* const*)d_in;
  p.x_prompt = in[0]; p.x_sample = in[1]; p.cache_conv = in[2]; p.state_gdn = in[3]; p.cache_k = in[4]; p.cache_v = in[5];
  p.p_prompt = in[6]; p.p_sample = in[7]; p.norm_mix = in[8]; p.w_in = in[9]; p.conv_w = in[10]; p.a_log = in[11]; p.dt_bias = in[12];
  p.gdn_norm = in[13]; p.q_norm = in[14]; p.k_norm = in[15]; p.sinks = in[16]; p.w_out = in[17]; p.norm_ffn = in[18]; p.w_up = in[19];
  p.w_down = in[20]; p.norm_ple = in[21]; p.w_gate = in[22]; p.w_proj = in[23];
  p.out = (float*)d_out;
  p.ws = (unsigned char*)d_ws;
  if (WS_TOTAL > ws_size) { fprintf(stderr, "workspace too small: need %zu have %zu\n", (size_t)WS_TOTAL, ws_size); return; }

  static int grid_blocks = 0;
  if (!grid_blocks) {
    int dev = 0, cus = 0, per_cu = 0;
    (void)hipGetDevice(&dev);
    (void)hipDeviceGetAttribute(&cus, hipDeviceAttributeMultiprocessorCount, dev);
    if (hipFuncSetAttribute((const void*)mega, hipFuncAttributeMaxDynamicSharedMemorySize, LDS_TOTAL) != hipSuccess) { fprintf(stderr, "hipFuncSetAttribute(dynamic LDS %d) failed\n", LDS_TOTAL); grid_blocks = -1; return; }
    (void)hipOccupancyMaxActiveBlocksPerMultiprocessor(&per_cu, (const void*)mega, 512, LDS_TOTAL);
    (void)hipGetLastError();
    grid_blocks = cus;
  }
  if (grid_blocks < 0) return;
  (void)hipMemsetAsync(p.ws + WO_bar, 0, (size_t)XCD_BAR_WORDS * 4, stream);
  int lo = 0, hi = NPHASE_PRE + NL * NPHASE_L;
  void* args[] = {&p, &lo, &hi};
  hipError_t e = hipLaunchCooperativeKernel((void*)mega, dim3(grid_blocks), dim3(512), args, LDS_TOTAL, stream);
  if (e != hipSuccess) fprintf(stderr, "cooperative launch failed: %s (grid %d)\n", hipGetErrorString(e), grid_blocks);
}
```

```cpp
#include <hip/hip_runtime.h>
#include <hip/hip_cooperative_groups.h>
#include <cstdio>
namespace cg = cooperative_groups;

typedef unsigned short bf16_t;
typedef short bf16x8 __attribute__((ext_vector_type(8)));
typedef float f32x4 __attribute__((ext_vector_type(4)));
typedef float f32x2 __attribute__((ext_vector_type(2)));
typedef unsigned u32x4 __attribute__((ext_vector_type(4)));
typedef unsigned u32x2 __attribute__((ext_vector_type(2)));

#define DEVI __device__ __forceinline__
DEVI int opq(int x) { asm volatile("" : "+v"(x)); return x; }

#define VHALF ((int)__builtin_amdgcn_readfirstlane((int)(threadIdx.x >> 8)))
#define VB ((int)blockIdx.x * 2 + VHALF)
#define VG ((int)gridDim.x * 2)
constexpr int NL = 4;
constexpr int MTOK = 17408, MP = 16384, MS = 1024;
constexpr int DM = 1024, NIN = 7696, NPJ = 7680, DFF = 4096, PLE = 256;
constexpr int C_Z = 3072, C_SQ = 4096, C_SK = 5120, C_SV = 5376, C_G = 5632;
constexpr float EPS = 1e-6f;
constexpr int NTHR = 256;
constexpr int SMEM_BYTES = 79872;
constexpr size_t SCR_ITEM = 73728;

constexpr size_t O_YP = 0, O_YS = 16777216, O_CONVP = 17825792, O_GDNP = 18120704, O_KP = 22315008, O_VP = 23363584,
                 O_CONVS = 24412160, O_GDNS = 29130752, O_KS = 96239616, O_VS = 113016832, O_END = 129794048;

constexpr size_t al256(size_t x) { return (x + 255) & ~(size_t)255; }
constexpr size_t WO_wt_in = 0;
constexpr size_t WO_wt_out = WO_wt_in + al256((size_t)NL * NIN * DM * 2);
constexpr size_t WO_wt_up = WO_wt_out + al256((size_t)NL * DM * DM * 2);
constexpr size_t WO_wt_down = WO_wt_up + al256((size_t)NL * DFF * DM * 2);
constexpr size_t WO_wt_gate = WO_wt_down + al256((size_t)NL * DM * DFF * 2);
constexpr size_t WO_wt_proj = WO_wt_gate + al256((size_t)NL * DM * DM * 2);
constexpr size_t WO_hb = WO_wt_proj + al256((size_t)NL * DM * PLE * 2);
constexpr size_t WO_hb2 = WO_hb + al256((size_t)MTOK * DM * 2);
constexpr size_t WO_proj = WO_hb2 + al256((size_t)MTOK * DM * 2);
constexpr size_t WO_scr = WO_proj + al256((size_t)MTOK * NPJ * 2);
constexpr size_t WO_ogdn = WO_scr + al256((size_t)2048 * SCR_ITEM);
constexpr size_t WO_oswa = WO_ogdn + al256((size_t)MTOK * DM * 2);
constexpr size_t WO_mix = WO_oswa + al256((size_t)MTOK * DM * 2);
constexpr size_t WO_pb = WO_mix + al256((size_t)MTOK * DM * 2);
constexpr size_t WO_pp = WO_pb + al256((size_t)NL * MTOK * PLE * 2);
constexpr size_t WO_ssq0 = WO_pp + al256((size_t)NL * MTOK * DM * 2);
constexpr size_t WO_ssq1 = WO_ssq0 + al256((size_t)MTOK * 16 * 4);
constexpr size_t WO_ssq2 = WO_ssq1 + al256((size_t)MTOK * 16 * 4);
constexpr size_t WO_logits = WO_ssq2 + al256((size_t)MTOK * 16 * 4);
constexpr size_t WO_gsc = WO_logits + al256((size_t)MTOK * 16 * 4);
constexpr size_t WO_bar = WO_gsc + al256((size_t)2048 * 4);
constexpr size_t WS_TOTAL = WO_bar + al256((size_t)3456 * 4);
struct Params {
  const float *x_prompt, *x_sample, *cache_conv, *state_gdn, *cache_k, *cache_v, *p_prompt, *p_sample;
  const float *norm_mix, *w_in, *conv_w, *a_log, *dt_bias, *gdn_norm, *q_norm, *k_norm, *sinks, *w_out, *norm_ffn, *w_up, *w_down,
      *norm_ple, *w_gate, *w_proj;
  float* out;
  unsigned char* ws;
  DEVI bf16_t* wt_in() const { return (bf16_t*)(ws + WO_wt_in); }
  DEVI bf16_t* wt_out() const { return (bf16_t*)(ws + WO_wt_out); }
  DEVI bf16_t* wt_up() const { return (bf16_t*)(ws + WO_wt_up); }
  DEVI bf16_t* wt_down() const { return (bf16_t*)(ws + WO_wt_down); }
  DEVI bf16_t* wt_gate() const { return (bf16_t*)(ws + WO_wt_gate); }
  DEVI bf16_t* wt_proj() const { return (bf16_t*)(ws + WO_wt_proj); }
  DEVI bf16_t* hb() const { return (bf16_t*)(ws + WO_hb); }
  DEVI bf16_t* hb2() const { return (bf16_t*)(ws + WO_hb2); }
  DEVI bf16_t* proj() const { return (bf16_t*)(ws + WO_proj); }
  DEVI bf16_t* scr() const { return (bf16_t*)(ws + WO_scr); }
  DEVI bf16_t* ogdn() const { return (bf16_t*)(ws + WO_ogdn); }
  DEVI bf16_t* oswa() const { return (bf16_t*)(ws + WO_oswa); }
  DEVI bf16_t* mix() const { return (bf16_t*)(ws + WO_mix); }
  DEVI bf16_t* pb() const { return (bf16_t*)(ws + WO_pb); }
  DEVI bf16_t* pp() const { return (bf16_t*)(ws + WO_pp); }
  DEVI float* ssq0() const { return (float*)(ws + WO_ssq0); }
  DEVI float* ssq1() const { return (float*)(ws + WO_ssq1); }
  DEVI float* ssq2() const { return (float*)(ws + WO_ssq2); }
  DEVI float* logits() const { return (float*)(ws + WO_logits); }
  DEVI float* gsc() const { return (float*)(ws + WO_gsc); }
  DEVI unsigned* bar() const { return (unsigned*)(ws + WO_bar); }
};

DEVI float shx(float v, int m, int ln) { return __builtin_bit_cast(float, __builtin_amdgcn_ds_bpermute((ln ^ m) << 2, __builtin_bit_cast(int, v))); }
DEVI float shup(float v, int o, int ln) { return __builtin_bit_cast(float, __builtin_amdgcn_ds_bpermute((ln >= o ? ln - o : ln) << 2, __builtin_bit_cast(int, v))); }
DEVI float lo2f(unsigned u) { return __uint_as_float(u << 16); }
DEVI float hi2f(unsigned u) { return __uint_as_float(u & 0xffff0000u); }
DEVI float bf2f(bf16_t v) { return __uint_as_float(((unsigned)v) << 16); }
typedef __bf16 bf16x2_t __attribute__((ext_vector_type(2)));
DEVI unsigned pk2(float lo, float hi) { const f32x2 v = {lo, hi}; const bf16x2_t r = __builtin_convertvector(v, bf16x2_t); return __builtin_bit_cast(unsigned, r); }
DEVI bf16_t f2bf(float f) { return (bf16_t)(pk2(f, 0.f) & 0xffffu); }
DEVI float sigm(float x) { return __builtin_amdgcn_rcpf(1.f + __expf(-x)); }
DEVI float silu(float x) { return x * sigm(x); }
DEVI float softplus_f(float x) {
  const float e = __expf(x);
  return x > 20.f ? x : (e < 0.01f ? e * (1.f - 0.5f * e + 0.33333334f * e * e) : __logf(1.f + e));
}
DEVI f32x4 mfma16(bf16x8 a, bf16x8 b, f32x4 c) { return __builtin_amdgcn_mfma_f32_16x16x32_bf16(a, b, c, 0, 0, 0); }
DEVI bf16x8 as_bf(u32x4 v) { return __builtin_bit_cast(bf16x8, v); }
#define UNPACK8(v, f) do { f[0] = lo2f(v.x); f[1] = hi2f(v.x); f[2] = lo2f(v.y); f[3] = hi2f(v.y); f[4] = lo2f(v.z); f[5] = hi2f(v.z); f[6] = lo2f(v.w); f[7] = hi2f(v.w); } while (0)

DEVI int inmap(int n) { return n < 4096 ? n : (n < 7680 ? n + 16 : n - 7680 + 4096); }

struct WTile { const float* src; const float* scale; bf16_t* dst; int ldsrc, K, Nd, kt, nt, flags; };
DEVI WTile wtile_decode(const Params& p, int it) {
  constexpr int T_IN = 16 * 121, T_OUT = 256, T_UP = 1024, T_DOWN = 1024, T_GATE = 256, T_PROJ = 64;
  constexpr int T_L = T_IN + T_OUT + T_UP + T_DOWN + T_GATE + T_PROJ;
  const int l = it / T_L;
  int r = it % T_L;
  WTile t;
  t.scale = p.norm_mix;
  if (r < T_IN) { t.src = p.w_in + (size_t)l * DM * NIN; t.ldsrc = NIN; t.K = DM; t.Nd = NIN; t.dst = p.wt_in() + (size_t)l * NIN * DM; t.scale = p.norm_mix + l * DM; t.flags = 3; t.kt = r % 16; t.nt = r / 16; return t; }
  r -= T_IN;
  if (r < T_OUT) { t.src = p.w_out + (size_t)l * DM * DM; t.ldsrc = DM; t.K = DM; t.Nd = DM; t.dst = p.wt_out() + (size_t)l * DM * DM; t.flags = 0; t.kt = r % 16; t.nt = r / 16; return t; }
  r -= T_OUT;
  if (r < T_UP) { t.src = p.w_up + (size_t)l * DM * DFF; t.ldsrc = DFF; t.K = DM; t.Nd = DFF; t.dst = p.wt_up() + (size_t)l * DFF * DM; t.scale = p.norm_ffn + l * DM; t.flags = 2; t.kt = r % 16; t.nt = r / 16; return t; }
  r -= T_UP;
  if (r < T_DOWN) { t.src = p.w_down + (size_t)l * DFF * DM; t.ldsrc = DM; t.K = DFF; t.Nd = DM; t.dst = p.wt_down() + (size_t)l * DM * DFF; t.flags = 0; t.kt = r % 64; t.nt = r / 64; return t; }
  r -= T_DOWN;
  if (r < T_GATE) { t.src = p.w_gate + (size_t)l * DM * DM; t.ldsrc = DM; t.K = DM; t.Nd = DM; t.dst = p.wt_gate() + (size_t)l * DM * DM; t.scale = p.norm_ple + l * DM; t.flags = 2; t.kt = r % 16; t.nt = r / 16; return t; }
  r -= T_GATE;
  t.src = p.w_proj + (size_t)l * PLE * DM; t.ldsrc = DM; t.K = PLE; t.Nd = DM; t.dst = p.wt_proj() + (size_t)l * DM * PLE; t.flags = 0; t.kt = r % 4; t.nt = r / 4;
  return t;
}
DEVI void wtile_load(const WTile& t, float (&v)[16], float (&sv)[16], int tid) {
  const int nl = tid & 63, kq = tid >> 6;
  const int n = t.nt * 64 + nl, nc = n < t.Nd ? n : t.Nd - 1;
  const int sc = (t.flags & 1) ? inmap(nc) : nc;
  const int ksc = (t.flags & 2) ? 1 : 0;
#pragma unroll
  for (int r = 0; r < 16; ++r) {
    const int k = t.kt * 64 + r * 4 + kq;
    v[r] = t.src[(size_t)k * t.ldsrc + sc];
    sv[r] = t.scale[(k & 1023) * ksc];
  }
}
DEVI void wtile_store(const WTile& t, const float (&v)[16], const float (&sv)[16], float* sm, int tid) {
  const int nl = tid & 63, kq = tid >> 6;
  const bool ok = t.nt * 64 + nl < t.Nd;
  const bool has = (t.flags & 2) != 0;
#pragma unroll
  for (int r = 0; r < 16; ++r) sm[(r * 4 + kq) * 65 + nl] = ok ? v[r] * (has ? sv[r] : 1.f) : 0.f;
  __syncthreads();
  const int nr = tid >> 2, ks = (tid & 3) * 16;
  if (t.nt * 64 + nr < t.Nd) {
    unsigned w[8];
#pragma unroll
    for (int i = 0; i < 8; ++i) w[i] = pk2(sm[(ks + 2 * i) * 65 + nr], sm[(ks + 2 * i + 1) * 65 + nr]);
    u32x4* d = (u32x4*)(t.dst + (size_t)(t.nt * 64 + nr) * t.K + t.kt * 64 + ks);
    d[0] = (u32x4){w[0], w[1], w[2], w[3]};
    d[1] = (u32x4){w[4], w[5], w[6], w[7]};
  }
  __syncthreads();
}

__device__ void phase_p0(const Params& p, unsigned char* smem) {
  float* sm = (float*)smem;
  const int tid = (opq(threadIdx.x) & 255), lane = tid & 63, wid = tid >> 6;
  {
    constexpr int NT = NL * (16 * 121 + 256 + 1024 + 1024 + 256 + 64);
    const int vb = VB, vg = VG;
    const int nj = (NT - vb + vg - 1) / vg;
#define WT_IDX(j) (vb + ((j) < nj ? (j) : nj - 1) * vg)
    float va[16], sa[16], vb_[16], sb[16], vc[16], sc[16];
    WTile ta = wtile_decode(p, WT_IDX(0));
    wtile_load(ta, va, sa, tid);
    WTile tb = wtile_decode(p, WT_IDX(1));
    wtile_load(tb, vb_, sb, tid);
    for (int j = 0; j < nj; j += 3) {
      const WTile tc = wtile_decode(p, WT_IDX(j + 2));
      wtile_load(tc, vc, sc, tid);
      wtile_store(ta, va, sa, sm, tid);
      ta = wtile_decode(p, WT_IDX(j + 3));
      wtile_load(ta, va, sa, tid);
      if (j + 1 < nj) wtile_store(tb, vb_, sb, sm, tid);
      tb = wtile_decode(p, WT_IDX(j + 4));
      wtile_load(tb, vb_, sb, tid);
      if (j + 2 < nj) wtile_store(tc, vc, sc, sm, tid);
    }
#undef WT_IDX
  }
  for (int it = VB; it < MTOK / 4; it += VG) {
    const int row = it * 4 + wid;
    const float* src = row < MP ? p.x_prompt + (size_t)row * DM : p.x_sample + (size_t)(row - MP) * DM;
    float* hd = p.out + (size_t)row * DM;
    bf16_t* hbd = p.hb() + (size_t)row * DM;
    float ss = 0.f;
#pragma unroll
    for (int i = 0; i < 4; ++i) {
      const int c = i * 256 + lane * 4;
      const f32x4 v = *(const f32x4*)(src + c);
      ss += v.x * v.x + v.y * v.y + v.z * v.z + v.w * v.w;
      *(f32x4*)(hd + c) = v;
      *(u32x2*)(hbd + c) = (u32x2){pk2(v.x, v.y), pk2(v.z, v.w)};
    }
#pragma unroll
    for (int o = 1; o < 64; o <<= 1) ss += shx(ss, o, lane);
    if (lane < 16) p.ssq0()[(size_t)row * 16 + lane] = lane == 0 ? ss : 0.f;
  }
  const int G = NL * MTOK * 32;
  for (int g = VB * NTHR + tid; g < G; g += VG * NTHR) {
    const int l = g / (MTOK * 32), rem = g % (MTOK * 32), row = rem >> 5, c8 = rem & 31;
    const float* src = row < MP ? p.p_prompt + ((size_t)(l * MP + row) * PLE + c8 * 8) : p.p_sample + ((size_t)(l * MS + row - MP) * PLE + c8 * 8);
    const f32x4 a = *(const f32x4*)src, b = *(const f32x4*)(src + 4);
    *(u32x4*)(p.pb() + (size_t)g * 8) = (u32x4){pk2(a.x, a.y), pk2(a.z, a.w), pk2(b.x, b.y), pk2(b.z, b.w)};
  }
}

enum { EPI_PROJ = 0, EPI_LOGIT = 1, EPI_RESID = 2, EPI_UP = 3, EPI_PLE = 4, EPI_PP = 5 };
struct EpiArgs {
  const float* ssq_in; float* ssq_out; float* h; bf16_t* hb; bf16_t* obf; int ldo; float* of32; const bf16_t* pp;
};

template <int EPI>
DEVI float epi_rs(const EpiArgs& e, int row) {
  if (EPI == EPI_PROJ || EPI == EPI_LOGIT || EPI == EPI_UP || EPI == EPI_PLE) {
    const f32x4* sp = (const f32x4*)(e.ssq_in + (size_t)row * 16);
    const f32x4 a = sp[0], b = sp[1], c = sp[2], d = sp[3];
    const float s = ((a.x + a.y) + (a.z + a.w)) + ((b.x + b.y) + (b.z + b.w)) + ((c.x + c.y) + (c.z + c.w)) + ((d.x + d.y) + (d.z + d.w));
    return __builtin_amdgcn_rsqf(s * (1.f / 1024.f) + EPS);
  }
  return 1.f;
}
template <int EPI>
DEVI void epi_elem(const EpiArgs& e, int row, int col, f32x4 v, float rs, float& sq) {
  if (EPI == EPI_PROJ) {
    v *= rs;
    *(u32x2*)(e.obf + (size_t)row * e.ldo + col) = (u32x2){pk2(v.x, v.y), pk2(v.z, v.w)};
  } else if (EPI == EPI_LOGIT) {
    v *= rs;
    *(f32x4*)(e.of32 + (size_t)row * 16 + col) = v;
  } else if (EPI == EPI_PP) {
    *(u32x2*)(e.obf + (size_t)row * e.ldo + (col & 1023)) = (u32x2){pk2(v.x, v.y), pk2(v.z, v.w)};
  } else if (EPI == EPI_UP) {
    v *= rs;
    v.x = fmaxf(v.x, 0.f); v.y = fmaxf(v.y, 0.f); v.z = fmaxf(v.z, 0.f); v.w = fmaxf(v.w, 0.f);
    v = v * v;
    *(u32x2*)(e.obf + (size_t)row * e.ldo + col) = (u32x2){pk2(v.x, v.y), pk2(v.z, v.w)};
  } else {
    float* hp = e.h + (size_t)row * DM + col;
    f32x4 hv = *(const f32x4*)hp;
    if (EPI == EPI_RESID) {
      hv += v;
    } else {
      const u32x2 pv = *(const u32x2*)(e.pp + (size_t)row * DM + col);
      hv.x += sigm(v.x * rs) * lo2f(pv.x); hv.y += sigm(v.y * rs) * hi2f(pv.x);
      hv.z += sigm(v.z * rs) * lo2f(pv.y); hv.w += sigm(v.w * rs) * hi2f(pv.y);
    }
    *(f32x4*)hp = hv;
    *(u32x2*)(e.hb + (size_t)row * DM + col) = (u32x2){pk2(hv.x, hv.y), pk2(hv.z, hv.w)};
    sq += hv.x * hv.x + hv.y * hv.y + hv.z * hv.z + hv.w * hv.w;
  }
}

template <int EPI>
DEVI void epi_elem8(const EpiArgs& e, int row, int col, f32x4 v0, f32x4 v1, float rs, float& sq) {
  if (EPI == EPI_PROJ || EPI == EPI_UP || EPI == EPI_PP) {
    if (EPI != EPI_PP) { v0 *= rs; v1 *= rs; }
    if (EPI == EPI_UP) {
      v0.x = fmaxf(v0.x, 0.f); v0.y = fmaxf(v0.y, 0.f); v0.z = fmaxf(v0.z, 0.f); v0.w = fmaxf(v0.w, 0.f);
      v1.x = fmaxf(v1.x, 0.f); v1.y = fmaxf(v1.y, 0.f); v1.z = fmaxf(v1.z, 0.f); v1.w = fmaxf(v1.w, 0.f);
      v0 = v0 * v0; v1 = v1 * v1;
    }
    const int c = EPI == EPI_PP ? (col & 1023) : col;
    *(u32x4*)(e.obf + (size_t)row * e.ldo + c) = (u32x4){pk2(v0.x, v0.y), pk2(v0.z, v0.w), pk2(v1.x, v1.y), pk2(v1.z, v1.w)};
  } else {
    float* hp = e.h + (size_t)row * DM + col;
    f32x4 h0 = *(const f32x4*)hp, h1 = *(const f32x4*)(hp + 4);
    if (EPI == EPI_RESID) {
      h0 += v0; h1 += v1;
    } else {
      const u32x4 pv = *(const u32x4*)(e.pp + (size_t)row * DM + col);
      h0.x += sigm(v0.x * rs) * lo2f(pv.x); h0.y += sigm(v0.y * rs) * hi2f(pv.x);
      h0.z += sigm(v0.z * rs) * lo2f(pv.y); h0.w += sigm(v0.w * rs) * hi2f(pv.y);
      h1.x += sigm(v1.x * rs) * lo2f(pv.z); h1.y += sigm(v1.y * rs) * hi2f(pv.z);
      h1.z += sigm(v1.z * rs) * lo2f(pv.w); h1.w += sigm(v1.w * rs) * hi2f(pv.w);
    }
    *(f32x4*)hp = h0;
    *(f32x4*)(hp + 4) = h1;
    *(u32x4*)(e.hb + (size_t)row * DM + col) = (u32x4){pk2(h0.x, h0.y), pk2(h0.z, h0.w), pk2(h1.x, h1.y), pk2(h1.z, h1.w)};
    sq += (h0.x * h0.x + h0.y * h0.y + h0.z * h0.z + h0.w * h0.w) + (h1.x * h1.x + h1.y * h1.y + h1.z * h1.z + h1.w * h1.w);
  }
}

template <int WMT, int WNT, int WGM, int WGN, int EPI, int BK = 32, bool KSPLIT = false>
__device__ __forceinline__ void gemm_tile(const bf16_t* __restrict__ A, int lda, const bf16_t* __restrict__ Bt, int ldb, int K, int m0, int n0,
                                          bf16_t* lds, const EpiArgs& e) {
  constexpr int BM = WGM * WMT * 16, BN = WGN * WNT * 16, LDR = BK + 8;
  constexpr int STAGE = (BM + BN) * LDR;
  constexpr int PPR = BK / 8, RPI = NTHR / PPR;
  constexpr int NA = BM / RPI, NB = (BN + RPI - 1) / RPI;
  const int tid = (opq(threadIdx.x) & 255), lane = tid & 63, wid = tid >> 6;
  const int wm = wid / WGN, wn = wid % WGN;
  const int fr = lane & 15, fq = lane >> 4;
  f32x4 acc[WMT][WNT];
#pragma unroll
  for (int i = 0; i < WMT; ++i)
#pragma unroll
    for (int j = 0; j < WNT; ++j) acc[i][j] = (f32x4){0.f, 0.f, 0.f, 0.f};
  u32x4 ra0[NA], rb0[NB], ra1[NA], rb1[NB];
  const int khalf = KSPLIT ? VHALF : 0;
  const int nk = (KSPLIT ? K / 2 : K) / BK;
  const int prow = tid / PPR, ppc = tid % PPR;
  const unsigned ta = (unsigned)(prow * lda + ppc * 8) * 2u, tb = (unsigned)(prow * ldb + ppc * 8) * 2u;
  const char* Au = (const char*)(A + (size_t)m0 * lda + (size_t)khalf * (K / 2));
  const char* Bu = (const char*)(Bt + (size_t)n0 * ldb + (size_t)khalf * (K / 2));
#define BGUARD(i) (BN >= RPI * ((i) + 1) || prow + (i) * RPI < BN)
#define GLOAD(kt, RA, RB) do { \
    _Pragma("unroll") for (int i = 0; i < NA; ++i) RA[i] = *(const u32x4*)(Au + ((size_t)i * RPI * lda + (size_t)(kt) * BK) * 2 + ta); \
    _Pragma("unroll") for (int i = 0; i < NB; ++i) if (BGUARD(i)) RB[i] = *(const u32x4*)(Bu + ((size_t)i * RPI * ldb + (size_t)(kt) * BK) * 2 + tb); \
  } while (0)
#define LSTORE(st, RA, RB) do { bf16_t* sA_ = lds + (st) * STAGE; bf16_t* sB_ = sA_ + BM * LDR; \
    _Pragma("unroll") for (int i = 0; i < NA; ++i) *(u32x4*)(sA_ + (prow + i * RPI) * LDR + ppc * 8) = RA[i]; \
    _Pragma("unroll") for (int i = 0; i < NB; ++i) if (BGUARD(i)) *(u32x4*)(sB_ + (prow + i * RPI) * LDR + ppc * 8) = RB[i]; \
  } while (0)
#define COMPUTE(st) do { const bf16_t* sA = lds + (st) * STAGE; const bf16_t* sB = sA + BM * LDR; \
    _Pragma("unroll") for (int kk = 0; kk < BK / 32; ++kk) { \
      bf16x8 bfr[WNT]; \
      _Pragma("unroll") for (int nt = 0; nt < WNT; ++nt) bfr[nt] = *(const bf16x8*)(sB + (wn * WNT * 16 + nt * 16 + fr) * LDR + kk * 32 + fq * 8); \
      _Pragma("unroll") for (int mt = 0; mt < WMT; ++mt) { \
        const bf16x8 af = *(const bf16x8*)(sA + (wm * WMT * 16 + mt * 16 + fr) * LDR + kk * 32 + fq * 8); \
        _Pragma("unroll") for (int nt = 0; nt < WNT; ++nt) acc[mt][nt] = mfma16(bfr[nt], af, acc[mt][nt]); } } \
  } while (0)
  GLOAD(0, ra0, rb0);
  GLOAD(1, ra1, rb1);
  LSTORE(0, ra0, rb0);
  __syncthreads();
  for (int kt = 0; kt < nk; kt += 2) {
    const int k2 = kt + 2 < nk ? kt + 2 : nk - 2;
    GLOAD(k2, ra0, rb0);
    COMPUTE(0);
    LSTORE(1, ra1, rb1);
    __syncthreads();
    GLOAD(k2 + 1, ra1, rb1);
    COMPUTE(1);
    LSTORE(0, ra0, rb0);
    __syncthreads();
  }
#undef BGUARD
#undef COMPUTE
#undef GLOAD
#undef LSTORE
  if (KSPLIT) {
    f32x4* red = (f32x4*)((unsigned char*)lds + (khalf ? 0 : SMEM_BYTES));
    if (khalf == 1) {
#pragma unroll
      for (int i = 0; i < WMT; ++i)
#pragma unroll
        for (int j = 0; j < WNT; ++j) red[((wid * WMT + i) * WNT + j) * 64 + lane] = acc[i][j];
    }
    __syncthreads();
    if (khalf == 0) {
#pragma unroll
      for (int i = 0; i < WMT; ++i)
#pragma unroll
        for (int j = 0; j < WNT; ++j) acc[i][j] += red[((wid * WMT + i) * WNT + j) * 64 + lane];
    }
  }
  if (!KSPLIT || khalf == 0) {
#pragma unroll
  for (int mt = 0; mt < WMT; ++mt) {
    const int row = m0 + wm * WMT * 16 + mt * 16 + fr;
    const float rs = epi_rs<EPI>(e, row);
    float sq = 0.f;
#pragma unroll
    for (int nt = 0; nt < WNT; ++nt) epi_elem<EPI>(e, row, n0 + wn * WNT * 16 + nt * 16 + fq * 4, acc[mt][nt], rs, sq);
    if (EPI == EPI_RESID || EPI == EPI_PLE) {
      sq += shx(sq, 16, lane);
      sq += shx(sq, 32, lane);
      if (fq == 0) e.ssq_out[(size_t)row * 16 + (n0 / BN) * WGN + wn] = sq;
    }
  }
  }
  if (KSPLIT) __syncthreads();
}

namespace pg8 {
#define PG8_LAS __attribute__((address_space(3)))
typedef unsigned short bf16_t;
typedef short bf16x8 __attribute__((ext_vector_type(8)));
typedef float f32x4 __attribute__((ext_vector_type(4)));
typedef unsigned u32x4 __attribute__((ext_vector_type(4)));
constexpr int BM = 256, BK = 64, HALF = 128, HTB = HALF * BK * 2  , STAGE_BYTES = 8 * HTB, NXCD = 8, WGM = 8;

__host__ __device__ __forceinline__ int lds_byte(int r, int c) { const int st = (r >> 4) * 2 + (c >> 5), rr = r & 15, cc = c & 31, ob = rr * 64 + cc * 2; return st * 1024 + (ob ^ (((ob >> 9) & 1) << 5)); }
__host__ __device__ __forceinline__ void stage_rc(int b, int& R, int& C) { const int st = b / 1024, sb = b % 1024, swz = sb ^ (((sb >> 9) & 1) << 5); R = (st >> 1) * 16 + swz / 64; C = (st & 1) * 32 + (swz % 64) / 2; }
__host__ __device__ __forceinline__ int perm32(int rho) { const int n = rho >> 4, i = rho & 15; return 8 * (i >> 2) + 4 * n + (i & 3); }

struct Unit { int pm, pn; };
struct Gemm { const bf16_t* A; const bf16_t* Bt; int M, N, K; };

template <class Epi, class Sched, bool STAMP = false>
__device__ __forceinline__ void gemm_phase(PG8_LAS unsigned char* lds, const Gemm g, const Sched& S, const Epi& E, unsigned long long* stamps) {
    const int tid = opq((int)threadIdx.x), wid = __builtin_amdgcn_readfirstlane(tid >> 6), lane = tid & 63, wr = wid >> 2, wc = wid & 3, fr = lane & 15, fq = lane >> 4;
    const int K = g.K, nt = K / BK;
    int ts_lo = 0, ts_hi = 0, nts = 0; const unsigned long long rt_entry = STAMP ? (unsigned long long)wall_clock64() : 0ull;
#define PG8_STAMP() do { if (STAMP && wid == 0 && nts < 64) { const unsigned long long _c = (unsigned long long)clock64(); \
        ts_lo = (lane == nts) ? (int)(unsigned)_c : ts_lo; ts_hi = (lane == nts) ? (int)(unsigned)(_c >> 32) : ts_hi; ++nts; } } while (0)
    PG8_STAMP();
    unsigned voffA[2], voffB[2];
#pragma unroll
    for (int i = 0; i < 2; ++i) { int R, C; stage_rc(tid * 16 + i * 8192, R, C); const int Rb = Epi::PERM ? ((R & ~31) + perm32(R & 31)) : R;
        voffA[i] = (unsigned)(R * K + C) * 2u; voffB[i] = (unsigned)(Rb * K + C) * 2u; }
    const size_t kstep = (size_t)(BK * 2);
    const size_t hstep = (size_t)HALF * K * 2;
    const size_t tstep = 2 * hstep;
    const unsigned ldsw = (unsigned)wid * 1024u;
    const int aoff = lds_byte(wr * 64 + fr, fq * 8), boff = lds_byte(wc * 32 + fr, fq * 8);
#define PG8_SA(b, h) (((b) * 2 + (h)) * HTB)
#define PG8_SB(b, h) ((4 + (b) * 2 + (h)) * HTB)
#define PG8_STAGE(bufoff, gbase, voff) do { _Pragma("unroll") for (int _i = 0; _i < 2; ++_i) \
        __builtin_amdgcn_global_load_lds((const unsigned*)((const char*)(gbase) + (voff)[_i]), (PG8_LAS unsigned*)(lds + (bufoff) + ldsw + _i * 8192), 16, 0, 0); } while (0)
#define PG8_LDA(dst, b, h) do { _Pragma("unroll") for (int m = 0; m < 4; ++m) _Pragma("unroll") for (int k = 0; k < 2; ++k) dst[m][k] = *(const PG8_LAS bf16x8*)(lds + PG8_SA(b, h) + aoff + m * 2048 + k * 1024); } while (0)
#define PG8_LDB(dst, b, h) do { _Pragma("unroll") for (int n = 0; n < 2; ++n) _Pragma("unroll") for (int k = 0; k < 2; ++k) dst[n][k] = *(const PG8_LAS bf16x8*)(lds + PG8_SB(b, h) + boff + n * 2048 + k * 1024); } while (0)
#define PG8_MMA(ai, bj, At, Bt) do { __builtin_amdgcn_s_setprio(1); _Pragma("unroll") for (int m = 0; m < 4; ++m) _Pragma("unroll") for (int n = 0; n < 2; ++n) _Pragma("unroll") for (int k = 0; k < 2; ++k) \
        acc[ai][bj][m][n] = __builtin_amdgcn_mfma_f32_16x16x32_bf16(Bt[n][k], At[m][k], acc[ai][bj][m][n], 0, 0, 0); __builtin_amdgcn_s_setprio(0); } while (0)
#define PG8_WAIT_V(n) asm volatile("s_waitcnt vmcnt(" #n ")" ::: "memory")
#define PG8_WAIT_L(n) asm volatile("s_waitcnt lgkmcnt(" #n ")" ::: "memory")
#define PG8_BAR __builtin_amdgcn_s_barrier()
#define PG8_SCHED __builtin_amdgcn_sched_barrier(0)
    Unit cur, nxt; int ui = 0;
    if (!S.next(0, cur)) return;
    f32x4 acc[2][2][4][2];
#pragma unroll
    for (int a = 0; a < 2; ++a)
#pragma unroll
        for (int b = 0; b < 2; ++b)
#pragma unroll
            for (int m = 0; m < 4; ++m)
#pragma unroll
                for (int n = 0; n < 2; ++n) acc[a][b][m][n] = (f32x4){0.f, 0.f, 0.f, 0.f};
    bf16x8 At[4][2], B0[2][2], B1[2][2];
    const char* cA = (const char*)g.A + (size_t)cur.pm * tstep; const char* cB = (const char*)g.Bt + (size_t)cur.pn * tstep;
    S.a_ready(cur);
    PG8_STAGE(PG8_SB(0, 0), cB, voffB); PG8_STAGE(PG8_SA(0, 0), cA, voffA); PG8_STAGE(PG8_SB(0, 1), cB + hstep, voffB); PG8_STAGE(PG8_SA(0, 1), cA + hstep, voffA);
    if (wr == 1) PG8_BAR;
    PG8_WAIT_V(4); PG8_BAR;
    PG8_STAGE(PG8_SB(1, 0), cB + kstep, voffB); PG8_STAGE(PG8_SA(1, 0), cA + kstep, voffA); PG8_STAGE(PG8_SB(1, 1), cB + hstep + kstep, voffB);
    PG8_WAIT_V(6); PG8_BAR;
    PG8_STAMP();
    for (;;) {
        const bool has_next = S.next(ui + 1, nxt);
        const char* nA = has_next ? (const char*)g.A + (size_t)nxt.pm * tstep : cA; const char* nB = has_next ? (const char*)g.Bt + (size_t)nxt.pn * tstep : cB;
        for (int t = 0; t < nt; t += 2) {
            const bool last = (t == nt - 2);
            const char* a1 = cA + (size_t)(t + 1) * kstep;
            const char* a2 = last ? nA : cA + (size_t)(t + 2) * kstep; const char* b2 = last ? nB : cB + (size_t)(t + 2) * kstep;
            const char* a3 = a2 + kstep; const char* b3 = b2 + kstep;
            if (last && has_next) S.a_ready(nxt);
            PG8_LDB(B0, 0, 0); PG8_SCHED; PG8_LDA(At, 0, 0); PG8_STAGE(PG8_SA(1, 1), a1 + hstep, voffA);
            PG8_WAIT_L(8); PG8_BAR; PG8_WAIT_L(0); PG8_MMA(0, 0, At, B0); PG8_BAR; PG8_SCHED;
            PG8_LDB(B1, 0, 1); PG8_STAGE(PG8_SB(0, 0), b2, voffB);
            PG8_BAR; PG8_WAIT_L(0); PG8_MMA(0, 1, At, B1); PG8_BAR;
            PG8_LDA(At, 0, 1); PG8_STAGE(PG8_SA(0, 0), a2, voffA);
            PG8_BAR; PG8_WAIT_L(0); PG8_MMA(1, 0, At, B0); PG8_BAR; PG8_SCHED;
            PG8_STAGE(PG8_SB(0, 1), b2 + hstep, voffB);
            PG8_WAIT_V(6); PG8_BAR; PG8_MMA(1, 1, At, B1); PG8_BAR;
            PG8_LDB(B0, 1, 0); PG8_SCHED; PG8_LDA(At, 1, 0); PG8_STAGE(PG8_SA(0, 1), a2 + hstep, voffA);
            PG8_WAIT_L(8); PG8_BAR; PG8_WAIT_L(0); PG8_MMA(0, 0, At, B0); PG8_BAR; PG8_SCHED;
            PG8_LDB(B1, 1, 1); PG8_STAGE(PG8_SB(1, 0), b3, voffB);
            PG8_BAR; PG8_WAIT_L(0); PG8_MMA(0, 1, At, B1); PG8_BAR;
            PG8_LDA(At, 1, 1); PG8_STAGE(PG8_SA(1, 0), a3, voffA);
            PG8_BAR; PG8_WAIT_L(0); PG8_MMA(1, 0, At, B0); PG8_BAR; PG8_SCHED;
            PG8_STAGE(PG8_SB(1, 1), b3 + hstep, voffB);
            PG8_WAIT_V(6); PG8_BAR; PG8_MMA(1, 1, At, B1); PG8_BAR;
        }
        PG8_STAMP();
        if constexpr (!Epi::AFTER_DRAIN) { E(acc, cur, wr, wc, fr, fq); S.done(cur); }
        PG8_STAMP();
        if (!has_next) break;
#pragma unroll
        for (int a = 0; a < 2; ++a)
#pragma unroll
            for (int b = 0; b < 2; ++b)
#pragma unroll
                for (int m = 0; m < 4; ++m)
#pragma unroll
                    for (int n = 0; n < 2; ++n) acc[a][b][m][n] = (f32x4){0.f, 0.f, 0.f, 0.f};
        cur = nxt; cA = nA; cB = nB; ++ui;
    }
    PG8_WAIT_V(0);
    if (wr == 0) PG8_BAR;
    PG8_BAR;
    if constexpr (Epi::AFTER_DRAIN) { E.fused(acc, cur, wr, wc, fr, fq, lds, wid, lane); S.done(cur); }
    PG8_STAMP();
    if (STAMP && wid == 0) { stamps[lane] = lane < nts ? (((unsigned long long)(unsigned)ts_hi << 32) | (unsigned)ts_lo) : 0ull;
        if (lane == 62) stamps[62] = rt_entry; if (lane == 63) stamps[63] = (unsigned long long)wall_clock64(); }
#undef PG8_STAMP
#undef PG8_SA
#undef PG8_SB
#undef PG8_STAGE
#undef PG8_LDA
#undef PG8_LDB
#undef PG8_MMA
#undef PG8_WAIT_V
#undef PG8_WAIT_L
#undef PG8_BAR
#undef PG8_SCHED
}
}

DEVI void unit_map(int L, int nM, int nN, int& pm, int& pn) {
  const int nwg = nM * nN, q = nwg / 8, r = nwg % 8, xcd = L % 8, off = L / 8;
  const int wgid = (xcd < r ? xcd * (q + 1) : r * (q + 1) + (xcd - r) * q) + off;
  const int nig = 8 * nN, gid = wgid / nig, fm = gid * 8, gsz = (nM - fm) < 8 ? (nM - fm) : 8, w = wgid - gid * nig;
  pm = fm + (w % gsz); pn = w / gsz;
}
struct RowSched {
  int nM, nN, nLimit, G, c;
  __device__ __forceinline__ bool next(int i, pg8::Unit& u) const { const int L = i * G + c; if (L >= nLimit) return false; unit_map(L, nM, nN, u.pm, u.pn); return true; }
  __device__ __forceinline__ void a_ready(const pg8::Unit&) const {}
  __device__ __forceinline__ void done(const pg8::Unit&) const {}
};
struct DiagSched {
  int nLimit, G, c;
  __device__ __forceinline__ bool next(int i, pg8::Unit& u) const { const int L = i * G + c; if (L >= nLimit) return false; const int l = L / 272, r = L - l * 272; u.pm = l * 68 + (r >> 2); u.pn = l * 4 + (r & 3); return true; }
  __device__ __forceinline__ void a_ready(const pg8::Unit&) const {}
  __device__ __forceinline__ void done(const pg8::Unit&) const {}
};
template <int EPI> struct BigEpi {
  static constexpr bool PERM = true, AFTER_DRAIN = false;
  EpiArgs e;
  __device__ __forceinline__ void operator()(const f32x4 (&acc)[2][2][4][2], const pg8::Unit& u, int wr, int wc, int fr, int fq) const {
    const int lane = fq * 16 + fr;
#pragma unroll
    for (int ai = 0; ai < 2; ++ai)
#pragma unroll
      for (int m = 0; m < 4; ++m) {
        const int row = u.pm * 256 + ai * 128 + wr * 64 + m * 16 + fr;
        const float rs = epi_rs<EPI>(e, row);
        float sq = 0.f;
#pragma unroll
        for (int bj = 0; bj < 2; ++bj) epi_elem8<EPI>(e, row, u.pn * 256 + bj * 128 + wc * 32 + fq * 8, acc[ai][bj][m][0], acc[ai][bj][m][1], rs, sq);
        if (EPI == EPI_RESID || EPI == EPI_PLE) {
          sq += shx(sq, 16, lane);
          sq += shx(sq, 32, lane);
          if (fq == 0) e.ssq_out[(size_t)row * 16 + u.pn * 4 + wc] = sq;
        }
      }
  }
};

template <int EPI>
__device__ void gemm_big_phase(const bf16_t* A, const bf16_t* Bt, int K, int M, int N, unsigned char* lds_all, unsigned char* smem_half, const EpiArgs& e) {
  const int nM = M / 256, nN = N / 256, nU = nM * nN, G = gridDim.x;
  const int L = nU % G;
  const int nLimit = (L > 0 && L <= G / 4) ? nU - L : nU;
  RowSched S; S.nM = nM; S.nN = nN; S.nLimit = nLimit; S.G = G; S.c = blockIdx.x;
  pg8::Gemm g; g.A = A; g.Bt = Bt; g.M = M; g.N = N; g.K = K;
  BigEpi<EPI> E; E.e = e;
  pg8::gemm_phase<BigEpi<EPI>, RowSched>((PG8_LAS unsigned char*)lds_all, g, S, E, nullptr);
  __syncthreads();
  const int nSmall = (nU - nLimit) * 16;
  if (nSmall <= G && K >= 512) {
    for (int st = blockIdx.x; st < nSmall; st += G) {
      const int sub = st & 15; int pm, pn; unit_map(nLimit + (st >> 4), nM, nN, pm, pn);
      gemm_tile<1, 4, 4, 1, EPI, 128, true>(A, K, Bt, K, K, pm * 256 + (sub >> 2) * 64, pn * 256 + (sub & 3) * 64, (bf16_t*)smem_half, e);
    }
  } else {
    for (int st = VB; st < nSmall; st += VG) {
      const int sub = st & 15; int pm, pn; unit_map(nLimit + (st >> 4), nM, nN, pm, pn);
      gemm_tile<1, 4, 4, 1, EPI, 128>(A, K, Bt, K, K, pm * 256 + (sub >> 2) * 64, pn * 256 + (sub & 3) * 64, (bf16_t*)smem_half, e);
    }
  }
}


template <int I, int J4>
DEVI void solve_sub4(float& r, const float (&x)[64], const float* Am) {
  if constexpr (J4 * 4 < I) {
    const f32x4 a = *(const f32x4*)(Am + I * 64 + J4 * 4);
    if constexpr (J4 * 4 + 0 < I) r -= a.x * x[J4 * 4 + 0];
    if constexpr (J4 * 4 + 1 < I) r -= a.y * x[J4 * 4 + 1];
    if constexpr (J4 * 4 + 2 < I) r -= a.z * x[J4 * 4 + 2];
    if constexpr (J4 * 4 + 3 < I) r -= a.w * x[J4 * 4 + 3];
    solve_sub4<I, J4 + 1>(r, x, Am);
  }
}
template <int I>
DEVI void solve_rows(float (&x)[64], const float* Am, const bf16_t* src, const float* sc) {
  if constexpr (I < 64) {
    float r = bf2f(src[I * 136]) * sc[I];
    solve_sub4<I, 0>(r, x, Am);
    x[I] = r;
    asm volatile("" ::: "memory");
    solve_rows<I + 1>(x, Am, src, sc);
  }
}

__device__ void gdn_prep_item(const Params& p, int l, int item, unsigned char* smem) {
  const int tid = (opq(threadIdx.x) & 255), lane = tid & 63, wid = tid >> 6, fr = lane & 15, fq = lane >> 4;
  const int h = item & 7, n = (item >> 3) & 31, b = item >> 8;
  const int tok0 = b * 2048 + n * 64;
  bf16_t* qh = (bf16_t*)smem;
  bf16_t* kh = qh + 64 * 136;
  bf16_t* vh = kh + 64 * 136;
  float* Am = (float*)(vh + 64 * 136);
  float* sbeta = Am + 64 * 64;
  float* sgc = sbeta + 64;
  float* sbe = sgc + 64;
  float* seg = sbe + 64;
  float* sek = seg + 64;
  unsigned char* scr = (unsigned char*)p.scr() + (size_t)item * SCR_ITEM;
  bf16_t* g_uT = (bf16_t*)scr;
  bf16_t* g_w = (bf16_t*)(scr + 16384);
  bf16_t* g_qg = (bf16_t*)(scr + 32768);
  bf16_t* g_kgT = (bf16_t*)(scr + 49152);
  bf16_t* g_qk = (bf16_t*)(scr + 65536);

  if (wid == 0) {
    const float* lg = p.logits() + (size_t)(tok0 + lane) * 16;
    const float bl = lg[h], al = lg[8 + h];
    const float x = al + p.dt_bias[l * 8 + h];
    const float sp = softplus_f(x);
    float g = -__expf(p.a_log[l * 8 + h]) * sp;
#pragma unroll
    for (int o = 1; o < 64; o <<= 1) { const float t = shup(g, o, lane); if (lane >= o) g += t; }
    sbeta[lane] = sigm(bl);
    sgc[lane] = g;
    sbe[lane] = sigm(bl) * __expf(g);
    seg[lane] = __expf(g);
    const float glast = __builtin_bit_cast(float, __builtin_amdgcn_readlane(__builtin_bit_cast(int, g), 63));
    sek[lane] = __expf(glast - g);
  }
  u32x4 rwall[3][7];
#pragma unroll
  for (int sect = 0; sect < 3; ++sect)
#pragma unroll
    for (int r = 0; r < 7; ++r) {
      const int tl = n * 64 + wid * 16 + fq * 4 - 3 + r;
      rwall[sect][r] = (u32x4){0u, 0u, 0u, 0u};
      if (tl >= 0) rwall[sect][r] = *(const u32x4*)(p.proj() + (size_t)(b * 2048 + tl) * NPJ + sect * 1024 + h * 128 + fr * 8);
    }
#pragma unroll
  for (int sect = 0; sect < 3; ++sect) {
    const int ch0 = sect * 1024 + h * 128 + fr * 8;
    float cw[4][8];
#pragma unroll
    for (int j = 0; j < 4; ++j) {
      const f32x4 a = *(const f32x4*)(p.conv_w + (size_t)(l * 4 + j) * 3072 + ch0), c = *(const f32x4*)(p.conv_w + (size_t)(l * 4 + j) * 3072 + ch0 + 4);
      cw[j][0] = a.x; cw[j][1] = a.y; cw[j][2] = a.z; cw[j][3] = a.w; cw[j][4] = c.x; cw[j][5] = c.y; cw[j][6] = c.z; cw[j][7] = c.w;
    }
    const int ib = wid * 16 + fq * 4;
#pragma unroll
    for (int it = 0; it < 4; ++it) {
      float o[8];
#pragma unroll
      for (int c = 0; c < 8; ++c) o[c] = 0.f;
#pragma unroll
      for (int j = 0; j < 4; ++j) {
        float f[8];
        UNPACK8(rwall[sect][it + j], f);
#pragma unroll
        for (int c = 0; c < 8; ++c) o[c] += f[c] * cw[j][c];
      }
      float ss = 0.f;
#pragma unroll
      for (int c = 0; c < 8; ++c) { o[c] = silu(o[c]); ss += o[c] * o[c]; }
      if (sect < 2) {
        ss += shx(ss, 1, lane); ss += shx(ss, 2, lane); ss += shx(ss, 4, lane); ss += shx(ss, 8, lane);
        float rn = __builtin_amdgcn_rsqf(ss + EPS);
        if (sect == 0) rn *= 0.08838834764831845f;
#pragma unroll
        for (int c = 0; c < 8; ++c) o[c] *= rn;
      }
      const u32x4 pk = (u32x4){pk2(o[0], o[1]), pk2(o[2], o[3]), pk2(o[4], o[5]), pk2(o[6], o[7])};
      bf16_t* dst = sect == 0 ? qh + (ib + it) * 136 + fr * 8 : (sect == 1 ? kh + (ib + it) * 136 + fr * 8 : vh + (ib + it) * 136 + fr * 8);
      *(u32x4*)dst = pk;
    }
  }
  __syncthreads();
  {
    const int i = wid * 16 + fr;
    const float gi = sgc[i], bi = sbeta[i];
    bf16x8 kx[4], qx[4];
#pragma unroll
    for (int ks = 0; ks < 4; ++ks) {
      kx[ks] = *(const bf16x8*)(kh + i * 136 + ks * 32 + fq * 8);
      qx[ks] = *(const bf16x8*)(qh + i * 136 + ks * 32 + fq * 8);
    }
#pragma unroll
    for (int jt = 0; jt < 4; ++jt) {
      f32x4 akk = (f32x4){0.f, 0.f, 0.f, 0.f}, aqk = (f32x4){0.f, 0.f, 0.f, 0.f};
      if (jt <= wid) {
#pragma unroll
        for (int ks = 0; ks < 4; ++ks) {
          const bf16x8 kj = *(const bf16x8*)(kh + (jt * 16 + fr) * 136 + ks * 32 + fq * 8);
          akk = mfma16(kj, kx[ks], akk);
          aqk = mfma16(kj, qx[ks], aqk);
        }
      }
      const int j0 = jt * 16 + fq * 4;
      float av[4], qv[4];
#pragma unroll
      for (int jj = 0; jj < 4; ++jj) {
        const int j = j0 + jj;
        const float dec = j <= i ? __expf(gi - sgc[j]) : 0.f;
        av[jj] = j < i ? bi * akk[jj] * dec : 0.f;
        qv[jj] = aqk[jj] * dec;
      }
      *(f32x4*)(Am + i * 64 + j0) = (f32x4){av[0], av[1], av[2], av[3]};
      *(u32x2*)(g_qk + i * 64 + j0) = (u32x2){pk2(qv[0], qv[1]), pk2(qv[2], qv[3])};
    }
  }
  __syncthreads();
  {
    float x[64];
    const bool isu = tid < 128;
    const int cc = tid & 127;
    solve_rows<0>(x, Am, (isu ? vh : kh) + cc, isu ? sbeta : sbe);
    if (isu) {
      u32x4* d = (u32x4*)(g_uT + cc * 64);
#pragma unroll
      for (int q = 0; q < 8; ++q) d[q] = (u32x4){pk2(x[q * 8], x[q * 8 + 1]), pk2(x[q * 8 + 2], x[q * 8 + 3]), pk2(x[q * 8 + 4], x[q * 8 + 5]), pk2(x[q * 8 + 6], x[q * 8 + 7])};
    } else {
#pragma unroll
      for (int i = 0; i < 64; ++i) g_w[i * 128 + cc] = f2bf(x[i]);
    }
  }
  {
    const float gl = sgc[63];
#pragma unroll
    for (int q = 0; q < 4; ++q) {
      const int pc = tid + q * 256, i = pc >> 4, c8 = pc & 15;
      const u32x4 v = *(const u32x4*)(qh + i * 136 + c8 * 8);
      float f[8];
      UNPACK8(v, f);
      const float s = seg[i];
      *(u32x4*)(g_qg + i * 128 + c8 * 8) = (u32x4){pk2(f[0] * s, f[1] * s), pk2(f[2] * s, f[3] * s), pk2(f[4] * s, f[5] * s), pk2(f[6] * s, f[7] * s)};
    }
    if (tid >= 128) {
      const int dk = tid - 128;
      u32x4* d = (u32x4*)(g_kgT + dk * 64);
#pragma unroll
      for (int q = 0; q < 8; ++q) {
        float f[8];
#pragma unroll
        for (int c = 0; c < 8; ++c) { const int i = q * 8 + c; f[c] = bf2f(kh[i * 136 + dk]) * sek[i]; }
        d[q] = (u32x4){pk2(f[0], f[1]), pk2(f[2], f[3]), pk2(f[4], f[5]), pk2(f[6], f[7])};
      }
    }
    if (tid == 0) p.gsc()[item] = __expf(gl);
  }
  __syncthreads();
}

__device__ void gdn_scan_item(const Params& p, int l, int item, unsigned char* smem) {
  const int tid = (opq(threadIdx.x) & 255), lane = tid & 63, wid = tid >> 6, fr = lane & 15, fq = lane >> 4;
  const int dvs = item & 3, h = (item >> 2) & 7, b = item >> 5;
  bf16_t* ST = (bf16_t*)smem;
  bf16_t* VT = ST + 2 * 32 * 136;
  f32x4 S[2][2];
#pragma unroll
  for (int a = 0; a < 2; ++a)
#pragma unroll
    for (int c = 0; c < 2; ++c) S[a][c] = (f32x4){0.f, 0.f, 0.f, 0.f};
  __syncthreads();
  bf16x8 fw[4], fqg[4], fqk[2], fkg[2][2];
  u32x2 fu[2];
  float gs;
  bf16x8 nw[4], nqg[4], nqk[2], nkg[2][2];
  u32x2 nu[2];
  float ngs;
#define SCAN_LOAD(n_, W, QG, QK, KG, U, GS) do { \
    const int it_ = ((b * 32 + (n_)) << 3) + h; \
    const unsigned char* scr_ = (const unsigned char*)p.scr() + (size_t)it_ * SCR_ITEM; \
    const bf16_t* g_uT = (const bf16_t*)scr_; const bf16_t* g_w = (const bf16_t*)(scr_ + 16384); const bf16_t* g_qg = (const bf16_t*)(scr_ + 32768); \
    const bf16_t* g_kgT = (const bf16_t*)(scr_ + 49152); const bf16_t* g_qk = (const bf16_t*)(scr_ + 65536); \
    _Pragma("unroll") for (int ks = 0; ks < 4; ++ks) { \
      W[ks] = *(const bf16x8*)(g_w + (wid * 16 + fr) * 128 + ks * 32 + fq * 8); \
      QG[ks] = *(const bf16x8*)(g_qg + (wid * 16 + fr) * 128 + ks * 32 + fq * 8); } \
    _Pragma("unroll") for (int ks = 0; ks < 2; ++ks) { \
      QK[ks] = *(const bf16x8*)(g_qk + (wid * 16 + fr) * 64 + ks * 32 + fq * 8); \
      _Pragma("unroll") for (int mt = 0; mt < 2; ++mt) KG[mt][ks] = *(const bf16x8*)(g_kgT + ((2 * wid + mt) * 16 + fr) * 64 + ks * 32 + fq * 8); } \
    _Pragma("unroll") for (int nt = 0; nt < 2; ++nt) U[nt] = *(const u32x2*)(g_uT + (dvs * 32 + nt * 16 + fr) * 64 + wid * 16 + fq * 4); \
    GS = p.gsc()[it_]; } while (0)
  SCAN_LOAD(0, nw, nqg, nqk, nkg, nu, ngs);
  for (int n = 0; n < 32; ++n) {
#pragma unroll
    for (int ks = 0; ks < 4; ++ks) { fw[ks] = nw[ks]; fqg[ks] = nqg[ks]; }
#pragma unroll
    for (int ks = 0; ks < 2; ++ks) { fqk[ks] = nqk[ks]; fkg[0][ks] = nkg[0][ks]; fkg[1][ks] = nkg[1][ks]; }
    fu[0] = nu[0]; fu[1] = nu[1]; gs = ngs;
    if (n + 1 < 32) SCAN_LOAD(n + 1, nw, nqg, nqk, nkg, nu, ngs);
    bf16_t* STc = ST + (n & 1) * 32 * 136;
#pragma unroll
    for (int mt = 0; mt < 2; ++mt)
#pragma unroll
      for (int nt = 0; nt < 2; ++nt)
        *(u32x2*)(STc + (nt * 16 + fr) * 136 + (2 * wid + mt) * 16 + fq * 4) = (u32x2){pk2(S[mt][nt].x, S[mt][nt].y), pk2(S[mt][nt].z, S[mt][nt].w)};
    __syncthreads();
#pragma unroll
    for (int nt = 0; nt < 2; ++nt) {
      f32x4 a = (f32x4){0.f, 0.f, 0.f, 0.f};
#pragma unroll
      for (int ks = 0; ks < 4; ++ks) {
        const bf16x8 sb = *(const bf16x8*)(STc + (nt * 16 + fr) * 136 + ks * 32 + fq * 8);
        a = mfma16(fw[ks], sb, a);
      }
      const float v0 = lo2f(fu[nt].x) - a.x, v1 = hi2f(fu[nt].x) - a.y, v2 = lo2f(fu[nt].y) - a.z, v3 = hi2f(fu[nt].y) - a.w;
      *(u32x2*)(VT + (nt * 16 + fr) * 72 + wid * 16 + fq * 4) = (u32x2){pk2(v0, v1), pk2(v2, v3)};
    }
    __syncthreads();
#pragma unroll
    for (int mt = 0; mt < 2; ++mt) {
      f32x4 a = (f32x4){0.f, 0.f, 0.f, 0.f};
#pragma unroll
      for (int ks = 0; ks < 4; ++ks) {
        const bf16x8 sa = *(const bf16x8*)(STc + (mt * 16 + fr) * 136 + ks * 32 + fq * 8);
        a = mfma16(sa, fqg[ks], a);
      }
#pragma unroll
      for (int ks = 0; ks < 2; ++ks) {
        const bf16x8 va = *(const bf16x8*)(VT + (mt * 16 + fr) * 72 + ks * 32 + fq * 8);
        a = mfma16(va, fqk[ks], a);
      }
      const size_t row = (size_t)b * 2048 + n * 64 + wid * 16 + fr;
      *(u32x2*)(p.ogdn() + row * DM + h * 128 + dvs * 32 + mt * 16 + fq * 4) = (u32x2){pk2(a.x, a.y), pk2(a.z, a.w)};
    }
#pragma unroll
    for (int mt = 0; mt < 2; ++mt)
#pragma unroll
      for (int nt = 0; nt < 2; ++nt) {
        f32x4 a = S[mt][nt] * gs;
#pragma unroll
        for (int ks = 0; ks < 2; ++ks) {
          const bf16x8 vb = *(const bf16x8*)(VT + (nt * 16 + fr) * 72 + ks * 32 + fq * 8);
          a = mfma16(fkg[mt][ks], vb, a);
        }
        S[mt][nt] = a;
      }
  }
  float* so = p.out + O_GDNP + ((size_t)(l * 8 + b) * 8 + h) * 16384;
#pragma unroll
  for (int mt = 0; mt < 2; ++mt)
#pragma unroll
    for (int nt = 0; nt < 2; ++nt)
#pragma unroll
      for (int jj = 0; jj < 4; ++jj) so[((2 * wid + mt) * 16 + fq * 4 + jj) * 128 + dvs * 32 + nt * 16 + fr] = S[mt][nt][jj];
  __syncthreads();
#undef SCAN_LOAD
}

__device__ void gdn_sample_item(const Params& p, int l, int item, unsigned char* smem) {
  const int tid = (opq(threadIdx.x) & 255), lane = tid & 63, wid = tid >> 6;
  const int h = item & 7, b = item >> 3;
  float* qs = (float*)smem;
  float* ks = qs + 1024;
  float* vs = ks + 1024;
  float* part = vs + 1024;
  float* sbeta = part + 256;
  float* sa = sbeta + 8;
  const int dv = tid & 127, half = tid >> 7;
  float S[64];
  const float* s0 = p.state_gdn + ((size_t)(l * 128 + b) * 8 + h) * 16384 + (half * 8192 + dv);
#pragma unroll
  for (int k = 0; k < 64; ++k) S[k] = s0[k * 128];
#pragma unroll
  for (int ps = 0; ps < 2; ++ps) {
    const int c = tid + ps * 256;
    if (c < 384) {
      const int sect = c >> 7, ci = c & 127;
      const int ch = sect * 1024 + h * 128 + ci;
      float xw[11], cwv[4];
#pragma unroll
      for (int j = 0; j < 4; ++j) cwv[j] = p.conv_w[(size_t)(l * 4 + j) * 3072 + ch];
#pragma unroll
      for (int j = 0; j < 3; ++j) xw[j] = p.cache_conv[((size_t)(l * 128 + b) * 3 + j) * 3072 + ch];
#pragma unroll
      for (int t = 0; t < 8; ++t) xw[3 + t] = bf2f(p.proj()[(size_t)(MP + b * 8 + t) * NPJ + ch]);
      float* dst = sect == 0 ? qs : (sect == 1 ? ks : vs);
#pragma unroll
      for (int t = 0; t < 8; ++t) dst[t * 128 + ci] = silu(xw[t] * cwv[0] + xw[t + 1] * cwv[1] + xw[t + 2] * cwv[2] + xw[t + 3] * cwv[3]);
    }
  }
  if (tid < 8) {
    const float* lg = p.logits() + (size_t)(MP + b * 8 + tid) * 16;
    const float x = lg[8 + h] + p.dt_bias[l * 8 + h];
    const float sp = softplus_f(x);
    sa[tid] = __expf(-__expf(p.a_log[l * 8 + h]) * sp);
    sbeta[tid] = sigm(lg[h]);
  }
  __syncthreads();
#pragma unroll
  for (int u = 0; u < 4; ++u) {
    const int t = wid * 2 + (u >> 1);
    float* arr = (u & 1) ? ks : qs;
    const float a0 = arr[t * 128 + lane], a1 = arr[t * 128 + 64 + lane];
    float ss = a0 * a0 + a1 * a1;
#pragma unroll
    for (int o = 1; o < 64; o <<= 1) ss += shx(ss, o, lane);
    float rn = __builtin_amdgcn_rsqf(ss + EPS);
    if (!(u & 1)) rn *= 0.08838834764831845f;
    arr[t * 128 + lane] = a0 * rn;
    arr[t * 128 + 64 + lane] = a1 * rn;
  }
  __syncthreads();
#pragma unroll 1
  for (int t = 0; t < 8; ++t) {
    const float a = sa[t], bt = sbeta[t];
    float kv = 0.f;
#pragma unroll
    for (int k4 = 0; k4 < 16; ++k4) {
      const f32x4 kk = *(const f32x4*)(ks + t * 128 + half * 64 + k4 * 4);
      S[k4 * 4 + 0] *= a; S[k4 * 4 + 1] *= a; S[k4 * 4 + 2] *= a; S[k4 * 4 + 3] *= a;
      kv += S[k4 * 4 + 0] * kk.x + S[k4 * 4 + 1] * kk.y + S[k4 * 4 + 2] * kk.z + S[k4 * 4 + 3] * kk.w;
      if ((k4 & 3) == 3) asm volatile("" ::: "memory");
    }
    part[half * 128 + dv] = kv;
    __syncthreads();
    const float delta = bt * (vs[t * 128 + dv] - (part[dv] + part[128 + dv]));
    __syncthreads();
    float o = 0.f;
#pragma unroll
    for (int k4 = 0; k4 < 16; ++k4) {
      const f32x4 kk = *(const f32x4*)(ks + t * 128 + half * 64 + k4 * 4);
      const f32x4 qq = *(const f32x4*)(qs + t * 128 + half * 64 + k4 * 4);
      S[k4 * 4 + 0] += kk.x * delta; S[k4 * 4 + 1] += kk.y * delta; S[k4 * 4 + 2] += kk.z * delta; S[k4 * 4 + 3] += kk.w * delta;
      o += S[k4 * 4 + 0] * qq.x + S[k4 * 4 + 1] * qq.y + S[k4 * 4 + 2] * qq.z + S[k4 * 4 + 3] * qq.w;
      if ((k4 & 3) == 3) asm volatile("" ::: "memory");
    }
    part[half * 128 + dv] = o;
    __syncthreads();
    if (half == 0) p.ogdn()[(size_t)(MP + b * 8 + t) * DM + h * 128 + dv] = f2bf(part[dv] + part[128 + dv]);
    __syncthreads();
  }
  float* so = p.out + O_GDNS + ((size_t)(l * 128 + b) * 8 + h) * 16384 + opq(half * 8192 + dv);
#pragma unroll
  for (int k = 0; k < 64; ++k) so[k * 128] = S[k];
  __syncthreads();
}

__device__ void gdn_sample_pair(const Params& p, int l, int pair, unsigned char* smem) {
  const int tid = (opq(threadIdx.x) & 255), lane = tid & 63, wid = tid >> 6;
  const int sub = tid >> 7, dv = tid & 127;
  const int item = pair * 2 + sub, h = item & 7, b = item >> 3;
  float* qs = (float*)smem + sub * 3104;
  float* ks = qs + 1024;
  float* vs = qs + 2048;
  float* sbeta = qs + 3072;
  float* sa = qs + 3080;
  f32x2 S2[64];
  const float* s0 = p.state_gdn + ((size_t)(l * 128 + b) * 8 + h) * 16384 + dv;
#pragma unroll
  for (int k = 0; k < 64; ++k) { S2[k].x = s0[(2 * k) * 128]; S2[k].y = s0[(2 * k + 1) * 128]; }
#pragma unroll
  for (int sect = 0; sect < 3; ++sect) {
    const int ch = sect * 1024 + h * 128 + dv;
    float xw[11], cwv[4];
#pragma unroll
    for (int j = 0; j < 4; ++j) cwv[j] = p.conv_w[(size_t)(l * 4 + j) * 3072 + ch];
#pragma unroll
    for (int j = 0; j < 3; ++j) xw[j] = p.cache_conv[((size_t)(l * 128 + b) * 3 + j) * 3072 + ch];
#pragma unroll
    for (int t = 0; t < 8; ++t) xw[3 + t] = bf2f(p.proj()[(size_t)(MP + b * 8 + t) * NPJ + ch]);
    float* dst = sect == 0 ? qs : (sect == 1 ? ks : vs);
#pragma unroll
    for (int t = 0; t < 8; ++t) dst[t * 128 + dv] = silu(xw[t] * cwv[0] + xw[t + 1] * cwv[1] + xw[t + 2] * cwv[2] + xw[t + 3] * cwv[3]);
  }
  if (dv < 8) {
    const float* lg = p.logits() + (size_t)(MP + b * 8 + dv) * 16;
    const float x = lg[8 + h] + p.dt_bias[l * 8 + h];
    sa[dv] = __expf(-__expf(p.a_log[l * 8 + h]) * softplus_f(x));
    sbeta[dv] = sigm(lg[h]);
  }
  __syncthreads();
#pragma unroll
  for (int u = 0; u < 8; ++u) {
    const int t = (wid & 1) * 4 + (u >> 1);
    float* arr = (u & 1) ? ks : qs;
    const float a0 = arr[t * 128 + lane], a1 = arr[t * 128 + 64 + lane];
    float ss = a0 * a0 + a1 * a1;
#pragma unroll
    for (int o = 1; o < 64; o <<= 1) ss += shx(ss, o, lane);
    float rn = __builtin_amdgcn_rsqf(ss + EPS);
    if (!(u & 1)) rn *= 0.08838834764831845f;
    arr[t * 128 + lane] = a0 * rn;
    arr[t * 128 + 64 + lane] = a1 * rn;
  }
  __syncthreads();
#pragma unroll 1
  for (int t = 0; t < 8; ++t) {
    const float a = sa[t], bt = sbeta[t];
    f32x2 kv2 = (f32x2){0.f, 0.f};
#pragma unroll
    for (int k4 = 0; k4 < 32; ++k4) {
      const f32x4 kk = *(const f32x4*)(ks + t * 128 + k4 * 4);
      kv2 += S2[2 * k4] * (f32x2){kk.x, kk.y};
      kv2 += S2[2 * k4 + 1] * (f32x2){kk.z, kk.w};
      if ((k4 & 3) == 3) asm volatile("" ::: "memory");
    }
    const float delta = bt * (vs[t * 128 + dv] - a * (kv2.x + kv2.y));
    const f32x2 a2 = (f32x2){a, a}, d2 = (f32x2){delta, delta};
    f32x2 o2 = (f32x2){0.f, 0.f};
#pragma unroll
    for (int k4 = 0; k4 < 32; ++k4) {
      const f32x4 kk = *(const f32x4*)(ks + t * 128 + k4 * 4);
      const f32x4 qq = *(const f32x4*)(qs + t * 128 + k4 * 4);
      S2[2 * k4] = S2[2 * k4] * a2 + (f32x2){kk.x, kk.y} * d2;
      S2[2 * k4 + 1] = S2[2 * k4 + 1] * a2 + (f32x2){kk.z, kk.w} * d2;
      o2 += S2[2 * k4] * (f32x2){qq.x, qq.y};
      o2 += S2[2 * k4 + 1] * (f32x2){qq.z, qq.w};
      if ((k4 & 3) == 3) asm volatile("" ::: "memory");
    }
    p.ogdn()[(size_t)(MP + b * 8 + t) * DM + h * 128 + dv] = f2bf(o2.x + o2.y);
  }
  float* so = p.out + O_GDNS + ((size_t)(l * 128 + b) * 8 + h) * 16384 + opq(dv);
#pragma unroll
  for (int k = 0; k < 64; ++k) { so[(2 * k) * 128] = S2[k].x; so[(2 * k + 1) * 128] = S2[k].y; }
  __syncthreads();
}

__device__ void swa_prompt_item(const Params& p, int l, int item, unsigned char* smem) {
  const int tid = (opq(threadIdx.x) & 255), lane = tid & 63, wid = tid >> 6, fr = lane & 15, fq = lane >> 4;
  const int kvh = item & 3, hb2 = (item >> 2) & 31, b = item >> 7;
  bf16_t* Ks = (bf16_t*)smem;
  bf16_t* VT = Ks + 208 * 72;
  bf16_t* Pw = VT + 64 * 216 + wid * 16 * 168;
  const int tk0 = hb2 * 64 - 128;
  u32x4 krw[7], vrw[7];
#pragma unroll
  for (int i = 0; i < 7; ++i) {
    const int pc = tid + i * NTHR, kj = pc >> 3, c8 = pc & 7, tk = tk0 + kj;
    krw[i] = (u32x4){0u, 0u, 0u, 0u}; vrw[i] = (u32x4){0u, 0u, 0u, 0u};
    if (pc < 208 * 8 && kj < 192 && tk >= 0) {
      const bf16_t* base = p.proj() + (size_t)(b * 2048 + tk) * NPJ + kvh * 64 + c8 * 8;
      krw[i] = *(const u32x4*)(base + C_SK); vrw[i] = *(const u32x4*)(base + C_SV);
    }
  }
#pragma unroll
  for (int i = 0; i < 7; ++i) {
    const int pc = tid + i * NTHR;
    if (pc >= 208 * 8) break;
    const int kj = pc >> 3, c8 = pc & 7, tk = tk0 + kj;
    const bool ok = kj < 192 && tk >= 0;
    float kf[8], vf[8];
    UNPACK8(krw[i], kf);
    UNPACK8(vrw[i], vf);
    float ss = 0.f;
#pragma unroll
    for (int c = 0; c < 8; ++c) ss += kf[c] * kf[c];
    ss += shx(ss, 1, lane); ss += shx(ss, 2, lane); ss += shx(ss, 4, lane);
    const float rn = __builtin_amdgcn_rsqf(ss * (1.f / 64.f) + EPS);
    const f32x4 w0 = *(const f32x4*)(p.k_norm + l * 64 + c8 * 8), w1 = *(const f32x4*)(p.k_norm + l * 64 + c8 * 8 + 4);
    kf[0] *= rn * w0.x; kf[1] *= rn * w0.y; kf[2] *= rn * w0.z; kf[3] *= rn * w0.w;
    kf[4] *= rn * w1.x; kf[5] *= rn * w1.y; kf[6] *= rn * w1.z; kf[7] *= rn * w1.w;
    *(u32x4*)(Ks + kj * 72 + c8 * 8) = (u32x4){pk2(kf[0], kf[1]), pk2(kf[2], kf[3]), pk2(kf[4], kf[5]), pk2(kf[6], kf[7])};
#pragma unroll
    for (int c = 0; c < 8; ++c) VT[(c8 * 8 + c) * 216 + kj] = f2bf(vf[c]);
    if (ok && tk >= 1920 && kj >= 128) {
      float* ko = p.out + O_KP + (((size_t)(l * 8 + b) * 128 + (tk - 1920)) * 4 + kvh) * 64 + c8 * 8;
      float* vo = p.out + O_VP + (((size_t)(l * 8 + b) * 128 + (tk - 1920)) * 4 + kvh) * 64 + c8 * 8;
      *(f32x4*)ko = (f32x4){kf[0], kf[1], kf[2], kf[3]};
      *(f32x4*)(ko + 4) = (f32x4){kf[4], kf[5], kf[6], kf[7]};
      *(f32x4*)vo = (f32x4){vf[0], vf[1], vf[2], vf[3]};
      *(f32x4*)(vo + 4) = (f32x4){vf[4], vf[5], vf[6], vf[7]};
    }
  }
  __syncthreads();
  const int kbase = wid * 16;
  const int ql = wid * 16 + fr;
  const size_t qrow = (size_t)b * 2048 + hb2 * 64 + ql;
  u32x4 qraw[4][2];
#pragma unroll
  for (int g = 0; g < 4; ++g) {
    const bf16_t* qp = p.proj() + qrow * NPJ + C_SQ + (kvh * 4 + g) * 64 + fq * 8;
    qraw[g][0] = *(const u32x4*)qp; qraw[g][1] = *(const u32x4*)(qp + 32);
  }
#pragma unroll
  for (int g = 0; g < 4; ++g) {
    const int head = kvh * 4 + g;
    const float slope = exp2f(-0.5f * (float)(head + 1));
    const float sink = p.sinks[l * 16 + head];
    bf16x8 qf[2];
    {
      const u32x4 r0 = qraw[g][0], r1 = qraw[g][1];
      float f0[8], f1[8];
      UNPACK8(r0, f0);
      UNPACK8(r1, f1);
      float ss = 0.f;
#pragma unroll
      for (int c = 0; c < 8; ++c) ss += f0[c] * f0[c] + f1[c] * f1[c];
      ss += shx(ss, 16, lane); ss += shx(ss, 32, lane);
      const float rn = __builtin_amdgcn_rsqf(ss * (1.f / 64.f) + EPS) * 0.125f;
      const float* qn = p.q_norm + l * 64 + fq * 8;
#pragma unroll
      for (int c = 0; c < 8; ++c) { f0[c] *= rn * qn[c]; f1[c] *= rn * qn[32 + c]; }
      qf[0] = as_bf((u32x4){pk2(f0[0], f0[1]), pk2(f0[2], f0[3]), pk2(f0[4], f0[5]), pk2(f0[6], f0[7])});
      qf[1] = as_bf((u32x4){pk2(f1[0], f1[1]), pk2(f1[2], f1[3]), pk2(f1[4], f1[5]), pk2(f1[6], f1[7])});
    }
    f32x4 sc[9];
    float mx = sink;
#pragma unroll
    for (int kt = 0; kt < 9; ++kt) {
      f32x4 a = (f32x4){0.f, 0.f, 0.f, 0.f};
#pragma unroll
      for (int ks = 0; ks < 2; ++ks) {
        const bf16x8 kf = *(const bf16x8*)(Ks + (kbase + kt * 16 + fr) * 72 + ks * 32 + fq * 8);
        a = mfma16(kf, qf[ks], a);
      }
#pragma unroll
      for (int jj = 0; jj < 4; ++jj) {
        const int kj = kbase + kt * 16 + fq * 4 + jj;
        const int dist = ql + 128 - kj;
        const bool ok = dist >= 0 && dist <= 128 && (tk0 + kj) >= 0;
        const float s = ok ? a[jj] - slope * (float)dist : -INFINITY;
        a[jj] = s;
        mx = fmaxf(mx, s);
      }
      sc[kt] = a;
    }
    mx = fmaxf(mx, shx(mx, 16, lane));
    mx = fmaxf(mx, shx(mx, 32, lane));
    float sum = 0.f;
#pragma unroll
    for (int kt = 0; kt < 9; ++kt) {
      f32x4 e;
#pragma unroll
      for (int jj = 0; jj < 4; ++jj) { e[jj] = __expf(sc[kt][jj] - mx); sum += e[jj]; }
      *(u32x2*)(Pw + fr * 168 + kt * 16 + fq * 4) = (u32x2){pk2(e.x, e.y), pk2(e.z, e.w)};
    }
    *(u32x2*)(Pw + fr * 168 + 144 + fq * 4) = (u32x2){0u, 0u};
    sum += shx(sum, 16, lane);
    sum += shx(sum, 32, lane);
    const float inv = __builtin_amdgcn_rcpf(sum + __expf(sink - mx));
    __builtin_amdgcn_wave_barrier();
#pragma unroll
    for (int dt = 0; dt < 4; ++dt) {
      f32x4 a = (f32x4){0.f, 0.f, 0.f, 0.f};
#pragma unroll
      for (int ks = 0; ks < 5; ++ks) {
        const bf16x8 vf = *(const bf16x8*)(VT + (dt * 16 + fr) * 216 + kbase + ks * 32 + fq * 8);
        const bf16x8 pf = *(const bf16x8*)(Pw + fr * 168 + ks * 32 + fq * 8);
        a = mfma16(vf, pf, a);
      }
      a *= inv;
      *(u32x2*)(p.oswa() + qrow * DM + head * 64 + dt * 16 + fq * 4) = (u32x2){pk2(a.x, a.y), pk2(a.z, a.w)};
    }
    __builtin_amdgcn_wave_barrier();
  }
  __syncthreads();
}

__device__ void swa_sample_item(const Params& p, int l, int item, unsigned char* smem) {
  const int tid = (opq(threadIdx.x) & 255), lane = tid & 63, wid = tid >> 6;
  const int kvh = item & 3, b = item >> 2;
  float* Ks = (float*)smem;
  float* Vs = Ks + 136 * 68;
  float* Qs = Vs + 136 * 64;
  float* Sc = Qs + 512;
  const size_t cbase = (size_t)(l * 128 + b) * 128;
  f32x4 kvr[8], vvr[8];
#pragma unroll
  for (int i = 0; i < 8; ++i) {
    const int idx = tid + i * NTHR, j = idx >> 4, c4 = idx & 15;
    kvr[i] = *(const f32x4*)(p.cache_k + ((cbase + j) * 4 + kvh) * 64 + c4 * 4);
    vvr[i] = *(const f32x4*)(p.cache_v + ((cbase + j) * 4 + kvh) * 64 + c4 * 4);
  }
  unsigned qrw[4];
#pragma unroll
  for (int g = 0; g < 4; ++g) qrw[g] = *(const unsigned*)(p.proj() + (size_t)(MP + b * 8 + (tid >> 5)) * NPJ + C_SQ + (kvh * 4 + g) * 64 + (tid & 31) * 2);
#pragma unroll
  for (int i = 0; i < 8; ++i) {
    const int idx = tid + i * NTHR, j = idx >> 4, c4 = idx & 15;
    const f32x4 kv = kvr[i], vv = vvr[i];
    *(f32x4*)(Ks + j * 68 + c4 * 4) = kv;
    *(f32x4*)(Vs + j * 64 + c4 * 4) = vv;
  }
  {
    const int t = tid >> 5, d = (tid & 31) * 2;
    const bf16_t* base = p.proj() + (size_t)(MP + b * 8 + t) * NPJ + kvh * 64 + d;
    const unsigned kr = *(const unsigned*)(base + C_SK), vr = *(const unsigned*)(base + C_SV);
    float k0 = lo2f(kr), k1 = hi2f(kr);
    float ss = k0 * k0 + k1 * k1;
#pragma unroll
    for (int o = 1; o < 32; o <<= 1) ss += shx(ss, o, lane);
    const float rn = __builtin_amdgcn_rsqf(ss * (1.f / 64.f) + EPS);
    Ks[(128 + t) * 68 + d] = k0 * rn * p.k_norm[l * 64 + d];
    Ks[(128 + t) * 68 + d + 1] = k1 * rn * p.k_norm[l * 64 + d + 1];
    Vs[(128 + t) * 64 + d] = lo2f(vr);
    Vs[(128 + t) * 64 + d + 1] = hi2f(vr);
  }
  __syncthreads();
  for (int idx = tid; idx < 128 * 64; idx += NTHR) {
    const int j = idx >> 6, d = idx & 63;
    p.out[O_KS + ((cbase + j) * 4 + kvh) * 64 + d] = Ks[(j + 8) * 68 + d];
    p.out[O_VS + ((cbase + j) * 4 + kvh) * 64 + d] = Vs[(j + 8) * 64 + d];
  }
#pragma unroll
  for (int g = 0; g < 4; ++g) {
    const int head = kvh * 4 + g;
    const float slope = exp2f(-0.5f * (float)(head + 1));
    const float sink = p.sinks[l * 16 + head];
    {
      const int t = tid >> 5, d = (tid & 31) * 2;
      const unsigned qr = qrw[g];
      const float q0 = lo2f(qr), q1 = hi2f(qr);
      float ss = q0 * q0 + q1 * q1;
#pragma unroll
      for (int o = 1; o < 32; o <<= 1) ss += shx(ss, o, lane);
      const float rn = __builtin_amdgcn_rsqf(ss * (1.f / 64.f) + EPS) * 0.125f;
      Qs[t * 64 + d] = q0 * rn * p.q_norm[l * 64 + d];
      Qs[t * 64 + d + 1] = q1 * rn * p.q_norm[l * 64 + d + 1];
    }
    __syncthreads();
    for (int idx = tid; idx < 8 * 136; idx += NTHR) {
      const int tq = idx / 136, j = idx % 136;
      float s = 0.f;
#pragma unroll
      for (int d4 = 0; d4 < 16; ++d4) {
        const f32x4 qv = *(const f32x4*)(Qs + tq * 64 + d4 * 4), kq = *(const f32x4*)(Ks + j * 68 + d4 * 4);
        s += (qv.x * kq.x + qv.y * kq.y) + (qv.z * kq.z + qv.w * kq.w);
      }
      const int dist = tq + 128 - j;
      Sc[tq * 136 + j] = (dist >= 0 && dist <= 128) ? s - slope * (float)dist : -INFINITY;
    }
    __syncthreads();
#pragma unroll
    for (int u = 0; u < 2; ++u) {
      const int tq = wid * 2 + u;
      const float s0 = Sc[tq * 136 + lane], s1 = Sc[tq * 136 + 64 + lane], s2 = lane < 8 ? Sc[tq * 136 + 128 + lane] : -INFINITY;
      float mx = fmaxf(fmaxf(s0, s1), fmaxf(s2, sink));
#pragma unroll
      for (int o = 1; o < 64; o <<= 1) mx = fmaxf(mx, shx(mx, o, lane));
      const float e0 = __expf(s0 - mx), e1 = __expf(s1 - mx), e2 = __expf(s2 - mx);
      float sum = e0 + e1 + e2;
#pragma unroll
      for (int o = 1; o < 64; o <<= 1) sum += shx(sum, o, lane);
      const float inv = __builtin_amdgcn_rcpf(sum + __expf(sink - mx));
      Sc[tq * 136 + lane] = e0 * inv;
      Sc[tq * 136 + 64 + lane] = e1 * inv;
      if (lane < 8) Sc[tq * 136 + 128 + lane] = e2 * inv;
    }
    __syncthreads();
    {
      const int tq = tid >> 5, d = (tid & 31) * 2;
      float o0 = 0.f, o1 = 0.f;
#pragma unroll 2
      for (int j4 = 0; j4 < 34; ++j4) {
        const f32x4 pj = *(const f32x4*)(Sc + tq * 136 + j4 * 4);
        const f32x2 va = *(const f32x2*)(Vs + (j4 * 4 + 0) * 64 + d), vb = *(const f32x2*)(Vs + (j4 * 4 + 1) * 64 + d);
        const f32x2 vc = *(const f32x2*)(Vs + (j4 * 4 + 2) * 64 + d), vd = *(const f32x2*)(Vs + (j4 * 4 + 3) * 64 + d);
        o0 += (pj.x * va.x + pj.y * vb.x) + (pj.z * vc.x + pj.w * vd.x);
        o1 += (pj.x * va.y + pj.y * vb.y) + (pj.z * vc.y + pj.w * vd.y);
      }
      *(unsigned*)(p.oswa() + (size_t)(MP + b * 8 + tq) * DM + head * 64 + d) = pk2(o0, o1);
    }
    __syncthreads();
  }
}

__device__ void phase_mix(const Params& p, int l) {
  const int tid = (opq(threadIdx.x) & 255), lane = tid & 63, wid = tid >> 6, fr = lane & 15, fq = lane >> 4;
  for (int it = VB; it < MTOK / 4; it += VG) {
    const size_t row = (size_t)it * 4 + wid;
#pragma unroll
    for (int ps = 0; ps < 2; ++ps) {
      const int ch = (ps * 4 + fq) * 128 + fr * 8;
      const u32x4 og = *(const u32x4*)(p.ogdn() + row * DM + ch);
      const u32x4 ob = *(const u32x4*)(p.oswa() + row * DM + ch);
      const u32x4 zz = *(const u32x4*)(p.proj() + row * NPJ + C_Z + ch);
      const u32x4 ga = *(const u32x4*)(p.proj() + row * NPJ + C_G + ch);
      const u32x4 gb = *(const u32x4*)(p.proj() + row * NPJ + C_G + 1024 + ch);
      float fo[8], fb[8], fz[8], fa[8], fg[8];
      UNPACK8(og, fo); UNPACK8(ob, fb); UNPACK8(zz, fz); UNPACK8(ga, fa); UNPACK8(gb, fg);
      float ss = 0.f;
#pragma unroll
      for (int c = 0; c < 8; ++c) ss += fo[c] * fo[c];
      ss += shx(ss, 1, lane); ss += shx(ss, 2, lane); ss += shx(ss, 4, lane); ss += shx(ss, 8, lane);
      const float rn = __builtin_amdgcn_rsqf(ss * (1.f / 128.f) + EPS);
      const f32x4 w0 = *(const f32x4*)(p.gdn_norm + l * 128 + fr * 8), w1 = *(const f32x4*)(p.gdn_norm + l * 128 + fr * 8 + 4);
      const float wn[8] = {w0.x, w0.y, w0.z, w0.w, w1.x, w1.y, w1.z, w1.w};
      float m[8];
#pragma unroll
      for (int c = 0; c < 8; ++c) m[c] = sigm(fa[c]) * (fo[c] * rn * wn[c] * silu(fz[c])) + sigm(fg[c]) * fb[c];
      *(u32x4*)(p.mix() + row * DM + ch) = (u32x4){pk2(m[0], m[1]), pk2(m[2], m[3]), pk2(m[4], m[5]), pk2(m[6], m[7])};
    }
  }
  const int NC = (8 + 128) * 3 * 3072;
  for (int i = VB * NTHR + tid; i < NC; i += VG * NTHR) {
    const int c = i % 3072, r = (i / 3072) % 3, bb = i / 9216;
    if (bb < 8) p.out[O_CONVP + ((size_t)(l * 8 + bb) * 3 + r) * 3072 + c] = bf2f(p.proj()[(size_t)(bb * 2048 + 2045 + r) * NPJ + c]);
    else p.out[O_CONVS + ((size_t)(l * 128 + bb - 8) * 3 + r) * 3072 + c] = bf2f(p.proj()[(size_t)(MP + (bb - 8) * 8 + 5 + r) * NPJ + c]);
  }
}

#define XB_TMO      128
#define XB_XCNT(j)  (256  + 64 * (j))
#define XB_XSUB(j)  (1280 + 64 * (j))
#define XB_XGEN(j)  (2304 + 64 * (j))
#define XB_TOP      3328
#define XB_TOPGEN   3392
#define XCD_BAR_WORDS 3456
#define XB_SPIN_CAP (1u << 18)
#define LAS __attribute__((address_space(3)))

__device__ __forceinline__ unsigned xb_ld(unsigned* p)              { return __hip_atomic_load(p, __ATOMIC_RELAXED, __HIP_MEMORY_SCOPE_AGENT); }
__device__ __forceinline__ unsigned xb_add(unsigned* p, unsigned v) { return __hip_atomic_fetch_add(p, v, __ATOMIC_RELAXED, __HIP_MEMORY_SCOPE_AGENT); }
__device__ __forceinline__ unsigned xb_xcc_id() { return (unsigned)__builtin_amdgcn_s_getreg((3 << 11) | 20) & 0xFu; }
#define XB_SPIN(cond, bar) do { unsigned _sp = 0; while (cond) { __builtin_amdgcn_s_sleep(1); \
    if ((++_sp & 255u) == 0u) { if (xb_ld(&(bar)[XB_TMO])) break; if (_sp > XB_SPIN_CAP) { atomicAdd(&(bar)[XB_TMO], 1u); break; } } } } while (0)

struct XcdBarrier {
    unsigned* bar; unsigned x;
    volatile LAS unsigned* st;
};

__device__ __forceinline__ XcdBarrier xcd_barrier_post(unsigned* bar, volatile LAS unsigned* st) {
    XcdBarrier b; b.bar = bar; b.x = xb_xcc_id(); b.st = st;
    if (threadIdx.x == 0) (void)xb_add(&bar[XB_XCNT(b.x)], 1u);
    return b;
}
__device__ __forceinline__ void xcd_barrier_complete(unsigned* bar, unsigned x, unsigned& nloc, unsigned& nx) {
    const unsigned G = gridDim.x * gridDim.y * gridDim.z;
    unsigned sum, cnt, mine, sp = 0u;
    for (;;) {
        sum = 0u; cnt = 0u; mine = 0u;
#pragma unroll
        for (unsigned j = 0; j < 16; ++j) { const unsigned c = xb_ld(&bar[XB_XCNT(j)]); sum += c; cnt += (c > 0u) ? 1u : 0u; mine = (j == x) ? c : mine; }
        if (sum == G) break;
        __builtin_amdgcn_s_sleep(1);
        if ((++sp & 255u) == 0u) { if (xb_ld(&bar[XB_TMO])) break; if (sp > XB_SPIN_CAP) { atomicAdd(&bar[XB_TMO], 1u); break; } }
    }
    nloc = mine > 0u ? mine : 1u; nx = cnt > 0u ? cnt : 1u;
}

__device__ __forceinline__ void xcd_barrier(const XcdBarrier& b) {
    asm volatile("s_waitcnt vmcnt(0)" ::: "memory");
    __syncthreads();
    if (threadIdx.x == 0) {
        unsigned* bar = b.bar;
        __builtin_amdgcn_s_waitcnt(0);
        unsigned nloc = b.st[0], nx = b.st[1];
        if (nloc == 0u) { xcd_barrier_complete(bar, b.x, nloc, nx); b.st[0] = nloc; b.st[1] = nx; }
        const unsigned old = xb_add(&bar[XB_XSUB(b.x)], 1u);
        const unsigned gen = old / nloc;
        if (old + 1u == (gen + 1u) * nloc) {
            __builtin_amdgcn_fence(__ATOMIC_RELEASE, "agent");
            asm volatile("s_waitcnt vmcnt(0)" ::: "memory");
            const unsigned og = xb_add(&bar[XB_TOP], 1u);
            const unsigned tg = og / nx;
            if (og + 1u == (tg + 1u) * nx) xb_add(&bar[XB_TOPGEN], 1u);
            else XB_SPIN(xb_ld(&bar[XB_TOPGEN]) == tg, bar);
            __builtin_amdgcn_fence(__ATOMIC_ACQUIRE, "agent");
            xb_add(&bar[XB_XGEN(b.x)], 1u);
            asm volatile("s_waitcnt vmcnt(0)" ::: "memory");
        } else {
            XB_SPIN(xb_ld(&bar[XB_XGEN(b.x)]) == gen, bar);
            __builtin_amdgcn_fence(__ATOMIC_ACQUIRE, "agent");
            asm volatile("s_waitcnt vmcnt(0)" ::: "memory");
        }
    }
    __syncthreads();
}


#define NPHASE_PRE 2
#define NPHASE_L 8
constexpr int LDS_TOTAL = 2 * SMEM_BYTES;
__global__ void __launch_bounds__(512, 2) mega(Params p, int ph_lo, int ph_hi) {
  extern __shared__ __attribute__((aligned(16))) unsigned char lds_all[];
  if (ph_hi < 0) cg::this_grid().sync();
  __shared__ uint4 xb_words;
  if (threadIdx.x == 0) xb_words = make_uint4(0u, 0u, 0u, 0u);
  __syncthreads();
  XcdBarrier xb = xcd_barrier_post(p.bar(), (volatile LAS unsigned*)&xb_words);
  unsigned char* smem = lds_all + VHALF * SMEM_BYTES;
  for (int ph = ph_lo; ph < ph_hi; ++ph) {
    if (ph > ph_lo) xcd_barrier(xb);
    if (ph == 0) { phase_p0(p, smem); continue; }
    if (ph == 1) {
      {
        EpiArgs e{};
        e.obf = p.pp(); e.ldo = DM;
        DiagSched S; S.nLimit = 1024; S.G = gridDim.x; S.c = blockIdx.x;
        pg8::Gemm g; g.A = p.pb(); g.Bt = p.wt_proj(); g.M = NL * MTOK; g.N = NL * DM; g.K = PLE;
        BigEpi<EPI_PP> E; E.e = e;
        pg8::gemm_phase<BigEpi<EPI_PP>, DiagSched>((PG8_LAS unsigned char*)lds_all, g, S, E, nullptr);
        __syncthreads();
      }
      for (int st = VB; st < 64 * 16; st += VG) {
        const int L = 1024 + (st >> 4), sub = st & 15, l = L / 272, r = L - l * 272, pm = r >> 2, pn = r & 3;
        EpiArgs e{};
        e.obf = p.pp() + (size_t)l * MTOK * DM; e.ldo = DM;
        gemm_tile<1, 4, 4, 1, EPI_PP, 128>(p.pb() + (size_t)l * MTOK * PLE, PLE, p.wt_proj() + (size_t)l * DM * PLE, PLE, PLE, pm * 256 + (sub >> 2) * 64, pn * 256 + (sub & 3) * 64, (bf16_t*)smem, e);
      }
      continue;
    }
    const int l = (ph - NPHASE_PRE) / NPHASE_L, s = (ph - NPHASE_PRE) % NPHASE_L;
#ifndef REPMASK
#define REPMASK 0
#endif
    for (int rep = 0; rep < (((REPMASK >> s) & 1) ? 2 : 1); ++rep) {
    if (rep) xcd_barrier(xb);
    switch (s) {
      case 0: {
        EpiArgs e{};
        e.ssq_in = p.ssq0(); e.obf = p.proj(); e.ldo = NPJ; e.of32 = p.logits();
        const bf16_t* Bt = p.wt_in() + (size_t)l * NIN * DM;
        gemm_big_phase<EPI_PROJ>(p.hb(), Bt, DM, MTOK, NPJ, lds_all, smem, e);
        for (int t = VB; t < 272; t += VG)
          gemm_tile<1, 1, 4, 1, EPI_LOGIT, 128>(p.hb(), DM, Bt + (size_t)NPJ * DM, DM, DM, t * 64, 0, (bf16_t*)smem, e);
      } break;
      case 1: {
        const int nB1 = VG == 512 ? 3072 : 3584;
        for (int t = VB; t < nB1; t += VG) {
          if (t < 2048) gdn_prep_item(p, l, t, smem);
          else if (t < 3072) swa_prompt_item(p, l, t - 2048, smem);
          else swa_sample_item(p, l, t - 3072, smem);
        }
      } break;
      case 2: {
        if (VG == 512) {
          if (VB < 256) gdn_scan_item(p, l, VB, smem);
          else {
            gdn_sample_pair(p, l, VB - 256, smem); gdn_sample_pair(p, l, VB, smem);
            swa_sample_item(p, l, (VB - 256) * 2, smem); swa_sample_item(p, l, (VB - 256) * 2 + 1, smem);
          }
        } else {
          for (int t = VB; t < 256 + 512; t += VG) {
            if (t < 256) gdn_scan_item(p, l, t, smem);
            else gdn_sample_pair(p, l, t - 256, smem);
          }
        }
      } break;
      case 3: phase_mix(p, l); break;
      case 4: {
        EpiArgs e{};
        e.h = p.out; e.hb = p.hb2(); e.ssq_out = p.ssq1();
        gemm_big_phase<EPI_RESID>(p.mix(), p.wt_out() + (size_t)l * DM * DM, DM, MTOK, DM, lds_all, smem, e);
      } break;
      case 5: {
        EpiArgs e{};
        e.ssq_in = p.ssq1(); e.obf = p.proj(); e.ldo = DFF;
        gemm_big_phase<EPI_UP>(p.hb2(), p.wt_up() + (size_t)l * DFF * DM, DM, MTOK, DFF, lds_all, smem, e);
      } break;
      case 6: {
        EpiArgs e{};
        e.h = p.out; e.hb = p.hb2(); e.ssq_out = p.ssq2();
        gemm_big_phase<EPI_RESID>(p.proj(), p.wt_down() + (size_t)l * DM * DFF, DFF, MTOK, DM, lds_all, smem, e);
      } break;
      case 7: {
        EpiArgs e{};
        e.h = p.out; e.hb = p.hb(); e.ssq_in = p.ssq2(); e.ssq_out = p.ssq0(); e.pp = p.pp() + (size_t)l * MTOK * DM;
        gemm_big_phase<EPI_PLE>(p.hb2(), p.wt_gate() + (size_t)l * DM * DM, DM, MTOK, DM, lds_all, smem, e);
      } break;
    }
    }
  }
}

extern "C" void kernel_launch(void* const* d_in, const int* in_sizes, int n_in, void* d_out, int out_size, void* d_ws, size_t ws_size,
                              hipStream_t stream) {
  Params p{};
  const float* const* in = (const float* const*)d_in;
  p.x_prompt = in[0]; p.x_sample = in[1]; p.cache_conv = in[2]; p.state_gdn = in[3]; p.cache_k = in[4]; p.cache_v = in[5];
  p.p_prompt = in[6]; p.p_sample = in[7]; p.norm_mix = in[8]; p.w_in = in[9]; p.conv_w = in[10]; p.a_log = in[11]; p.dt_bias = in[12];
  p.gdn_norm = in[13]; p.q_norm = in[14]; p.k_norm = in[15]; p.sinks = in[16]; p.w_out = in[17]; p.norm_ffn = in[18]; p.w_up = in[19];
  p.w_down = in[20]; p.norm_ple = in[21]; p.w_gate = in[22]; p.w_proj = in[23];
  p.out = (float*)d_out;
  p.ws = (unsigned char*)d_ws;
  if (WS_TOTAL > ws_size) { fprintf(stderr, "workspace too small: need %zu have %zu\n", (size_t)WS_TOTAL, ws_size); return; }

  static int grid_blocks = 0;
  if (!grid_blocks) {
    int dev = 0, cus = 0, per_cu = 0;
    (void)hipGetDevice(&dev);
    (void)hipDeviceGetAttribute(&cus, hipDeviceAttributeMultiprocessorCount, dev);
    if (hipFuncSetAttribute((const void*)mega, hipFuncAttributeMaxDynamicSharedMemorySize, LDS_TOTAL) != hipSuccess) { fprintf(stderr, "hipFuncSetAttribute(dynamic LDS %d) failed\n", LDS_TOTAL); grid_blocks = -1; return; }
    (void)hipOccupancyMaxActiveBlocksPerMultiprocessor(&per_cu, (const void*)mega, 512, LDS_TOTAL);
    (void)hipGetLastError();
    grid_blocks = cus;
  }
  if (grid_blocks < 0) return;
  (void)hipMemsetAsync(p.ws + WO_bar, 0, (size_t)XCD_BAR_WORDS * 4, stream);
  int lo = 0, hi = NPHASE_PRE + NL * NPHASE_L;
  void* args[] = {&p, &lo, &hi};
  hipError_t e = hipLaunchCooperativeKernel((void*)mega, dim3(grid_blocks), dim3(512), args, LDS_TOTAL, stream);
  if (e != hipSuccess) fprintf(stderr, "cooperative launch failed: %s (grid %d)\n", hipGetErrorString(e), grid_blocks);
}
```

```cpp
#include <hip/hip_runtime.h>
#include <hip/hip_cooperative_groups.h>
#include <cstdio>
namespace cg = cooperative_groups;

typedef unsigned short bf16_t;
typedef short bf16x8 __attribute__((ext_vector_type(8)));
typedef float f32x4 __attribute__((ext_vector_type(4)));
typedef float f32x2 __attribute__((ext_vector_type(2)));
typedef unsigned u32x4 __attribute__((ext_vector_type(4)));
typedef unsigned u32x2 __attribute__((ext_vector_type(2)));

#define DEVI __device__ __forceinline__
DEVI int opq(int x) { asm volatile("" : "+v"(x)); return x; }

#define VHALF ((int)__builtin_amdgcn_readfirstlane((int)(threadIdx.x >> 8)))
#define VB ((int)blockIdx.x * 2 + VHALF)
#define VG ((int)gridDim.x * 2)
constexpr int NL = 4;
constexpr int MTOK = 17408, MP = 16384, MS = 1024;
constexpr int DM = 1024, NIN = 7696, NPJ = 7680, DFF = 4096, PLE = 256;
constexpr int C_Z = 3072, C_SQ = 4096, C_SK = 5120, C_SV = 5376, C_G = 5632;
constexpr float EPS = 1e-6f;
constexpr int NTHR = 256;
constexpr int SMEM_BYTES = 79872;
constexpr size_t SCR_ITEM = 73728;

constexpr size_t O_YP = 0, O_YS = 16777216, O_CONVP = 17825792, O_GDNP = 18120704, O_KP = 22315008, O_VP = 23363584,
                 O_CONVS = 24412160, O_GDNS = 29130752, O_KS = 96239616, O_VS = 113016832, O_END = 129794048;

constexpr size_t al256(size_t x) { return (x + 255) & ~(size_t)255; }
constexpr size_t WO_wt_in = 0;
constexpr size_t WO_wt_out = WO_wt_in + al256((size_t)NL * NIN * DM * 2);
constexpr size_t WO_wt_up = WO_wt_out + al256((size_t)NL * DM * DM * 2);
constexpr size_t WO_wt_down = WO_wt_up + al256((size_t)NL * DFF * DM * 2);
constexpr size_t WO_wt_gate = WO_wt_down + al256((size_t)NL * DM * DFF * 2);
constexpr size_t WO_wt_proj = WO_wt_gate + al256((size_t)NL * DM * DM * 2);
constexpr size_t WO_hb = WO_wt_proj + al256((size_t)NL * DM * PLE * 2);
constexpr size_t WO_hb2 = WO_hb + al256((size_t)MTOK * DM * 2);
constexpr size_t WO_proj = WO_hb2 + al256((size_t)MTOK * DM * 2);
constexpr size_t WO_scr = WO_proj + al256((size_t)MTOK * NPJ * 2);
constexpr size_t WO_ogdn = WO_scr + al256((size_t)2048 * SCR_ITEM);
constexpr size_t WO_oswa = WO_ogdn + al256((size_t)MTOK * DM * 2);
constexpr size_t WO_mix = WO_oswa + al256((size_t)MTOK * DM * 2);
constexpr size_t WO_pb = WO_mix + al256((size_t)MTOK * DM * 2);
constexpr size_t WO_pp = WO_pb + al256((size_t)NL * MTOK * PLE * 2);
constexpr size_t WO_ssq0 = WO_pp + al256((size_t)NL * MTOK * DM * 2);
constexpr size_t WO_ssq1 = WO_ssq0 + al256((size_t)MTOK * 16 * 4);
constexpr size_t WO_ssq2 = WO_ssq1 + al256((size_t)MTOK * 16 * 4);
constexpr size_t WO_logits = WO_ssq2 + al256((size_t)MTOK * 16 * 4);
constexpr size_t WO_gsc = WO_logits + al256((size_t)MTOK * 16 * 4);
constexpr size_t WO_bar = WO_gsc + al256((size_t)2048 * 4);
constexpr size_t WS_TOTAL = WO_bar + al256((size_t)3456 * 4);
struct Params {
  const float *x_prompt, *x_sample, *cache_conv, *state_gdn, *cache_k, *cache_v, *p_prompt, *p_sample;
  const float *norm_mix, *w_in, *conv_w, *a_log, *dt_bias, *gdn_norm, *q_norm, *k_norm, *sinks, *w_out, *norm_ffn, *w_up, *w_down,
      *norm_ple, *w_gate, *w_proj;
  float* out;
  unsigned char* ws;
  DEVI bf16_t* wt_in() const { return (bf16_t*)(ws + WO_wt_in); }
  DEVI bf16_t* wt_out() const { return (bf16_t*)(ws + WO_wt_out); }
  DEVI bf16_t* wt_up() const { return (bf16_t*)(ws + WO_wt_up); }
  DEVI bf16_t* wt_down() const { return (bf16_t*)(ws + WO_wt_down); }
  DEVI bf16_t* wt_gate() const { return (bf16_t*)(ws + WO_wt_gate); }
  DEVI bf16_t* wt_proj() const { return (bf16_t*)(ws + WO_wt_proj); }
  DEVI bf16_t* hb() const { return (bf16_t*)(ws + WO_hb); }
  DEVI bf16_t* hb2() const { return (bf16_t*)(ws + WO_hb2); }
  DEVI bf16_t* proj() const { return (bf16_t*)(ws + WO_proj); }
  DEVI bf16_t* scr() const { return (bf16_t*)(ws + WO_scr); }
  DEVI bf16_t* ogdn() const { return (bf16_t*)(ws + WO_ogdn); }
  DEVI bf16_t* oswa() const { return (bf16_t*)(ws + WO_oswa); }
  DEVI bf16_t* mix() const { return (bf16_t*)(ws + WO_mix); }
  DEVI bf16_t* pb() const { return (bf16_t*)(ws + WO_pb); }
  DEVI bf16_t* pp() const { return (bf16_t*)(ws + WO_pp); }
  DEVI float* ssq0() const { return (float*)(ws + WO_ssq0); }
  DEVI float* ssq1() const { return (float*)(ws + WO_ssq1); }
  DEVI float* ssq2() const { return (float*)(ws + WO_ssq2); }
  DEVI float* logits() const { return (float*)(ws + WO_logits); }
  DEVI float* gsc() const { return (float*)(ws + WO_gsc); }
  DEVI unsigned* bar() const { return (unsigned*)(ws + WO_bar); }
};

DEVI float shx(float v, int m, int ln) { return __builtin_bit_cast(float, __builtin_amdgcn_ds_bpermute((ln ^ m) << 2, __builtin_bit_cast(int, v))); }
DEVI float shup(float v, int o, int ln) { return __builtin_bit_cast(float, __builtin_amdgcn_ds_bpermute((ln >= o ? ln - o : ln) << 2, __builtin_bit_cast(int, v))); }
DEVI float lo2f(unsigned u) { return __uint_as_float(u << 16); }
DEVI float hi2f(unsigned u) { return __uint_as_float(u & 0xffff0000u); }
DEVI float bf2f(bf16_t v) { return __uint_as_float(((unsigned)v) << 16); }
typedef __bf16 bf16x2_t __attribute__((ext_vector_type(2)));
DEVI unsigned pk2(float lo, float hi) { const f32x2 v = {lo, hi}; const bf16x2_t r = __builtin_convertvector(v, bf16x2_t); return __builtin_bit_cast(unsigned, r); }
DEVI bf16_t f2bf(float f) { return (bf16_t)(pk2(f, 0.f) & 0xffffu); }
DEVI float sigm(float x) { return __builtin_amdgcn_rcpf(1.f + __expf(-x)); }
DEVI float silu(float x) { return x * sigm(x); }
DEVI float softplus_f(float x) {
  const float e = __expf(x);
  return x > 20.f ? x : (e < 0.01f ? e * (1.f - 0.5f * e + 0.33333334f * e * e) : __logf(1.f + e));
}
DEVI f32x4 mfma16(bf16x8 a, bf16x8 b, f32x4 c) { return __builtin_amdgcn_mfma_f32_16x16x32_bf16(a, b, c, 0, 0, 0); }
DEVI bf16x8 as_bf(u32x4 v) { return __builtin_bit_cast(bf16x8, v); }
#define UNPACK8(v, f) do { f[0] = lo2f(v.x); f[1] = hi2f(v.x); f[2] = lo2f(v.y); f[3] = hi2f(v.y); f[4] = lo2f(v.z); f[5] = hi2f(v.z); f[6] = lo2f(v.w); f[7] = hi2f(v.w); } while (0)

DEVI int inmap(int n) { return n < 4096 ? n : (n < 7680 ? n + 16 : n - 7680 + 4096); }

struct WTile { const float* src; const float* scale; bf16_t* dst; int ldsrc, K, Nd, kt, nt, flags; };
DEVI WTile wtile_decode(const Params& p, int it) {
  constexpr int T_IN = 16 * 121, T_OUT = 256, T_UP = 1024, T_DOWN = 1024, T_GATE = 256, T_PROJ = 64;
  constexpr int T_L = T_IN + T_OUT + T_UP + T_DOWN + T_GATE + T_PROJ;
  const int l = it / T_L;
  int r = it % T_L;
  WTile t;
  t.scale = p.norm_mix;
  if (r < T_IN) { t.src = p.w_in + (size_t)l * DM * NIN; t.ldsrc = NIN; t.K = DM; t.Nd = NIN; t.dst = p.wt_in() + (size_t)l * NIN * DM; t.scale = p.norm_mix + l * DM; t.flags = 3; t.kt = r % 16; t.nt = r / 16; return t; }
  r -= T_IN;
  if (r < T_OUT) { t.src = p.w_out + (size_t)l * DM * DM; t.ldsrc = DM; t.K = DM; t.Nd = DM; t.dst = p.wt_out() + (size_t)l * DM * DM; t.flags = 0; t.kt = r % 16; t.nt = r / 16; return t; }
  r -= T_OUT;
  if (r < T_UP) { t.src = p.w_up + (size_t)l * DM * DFF; t.ldsrc = DFF; t.K = DM; t.Nd = DFF; t.dst = p.wt_up() + (size_t)l * DFF * DM; t.scale = p.norm_ffn + l * DM; t.flags = 2; t.kt = r % 16; t.nt = r / 16; return t; }
  r -= T_UP;
  if (r < T_DOWN) { t.src = p.w_down + (size_t)l * DFF * DM; t.ldsrc = DM; t.K = DFF; t.Nd = DM; t.dst = p.wt_down() + (size_t)l * DM * DFF; t.flags = 0; t.kt = r % 64; t.nt = r / 64; return t; }
  r -= T_DOWN;
  if (r < T_GATE) { t.src = p.w_gate + (size_t)l * DM * DM; t.ldsrc = DM; t.K = DM; t.Nd = DM; t.dst = p.wt_gate() + (size_t)l * DM * DM; t.scale = p.norm_ple + l * DM; t.flags = 2; t.kt = r % 16; t.nt = r / 16; return t; }
  r -= T_GATE;
  t.src = p.w_proj + (size_t)l * PLE * DM; t.ldsrc = DM; t.K = PLE; t.Nd = DM; t.dst = p.wt_proj() + (size_t)l * DM * PLE; t.flags = 0; t.kt = r % 4; t.nt = r / 4;
  return t;
}
DEVI void wtile_load(const WTile& t, float (&v)[16], float (&sv)[16], int tid) {
  const int nl = tid & 63, kq = tid >> 6;
  const int n = t.nt * 64 + nl, nc = n < t.Nd ? n : t.Nd - 1;
  const int sc = (t.flags & 1) ? inmap(nc) : nc;
  const int ksc = (t.flags & 2) ? 1 : 0;
#pragma unroll
  for (int r = 0; r < 16; ++r) {
    const int k = t.kt * 64 + r * 4 + kq;
    v[r] = t.src[(size_t)k * t.ldsrc + sc];
    sv[r] = t.scale[(k & 1023) * ksc];
  }
}
DEVI void wtile_store(const WTile& t, const float (&v)[16], const float (&sv)[16], float* sm, int tid) {
  const int nl = tid & 63, kq = tid >> 6;
  const bool ok = t.nt * 64 + nl < t.Nd;
  const bool has = (t.flags & 2) != 0;
#pragma unroll
  for (int r = 0; r < 16; ++r) sm[(r * 4 + kq) * 65 + nl] = ok ? v[r] * (has ? sv[r] : 1.f) : 0.f;
  __syncthreads();
  const int nr = tid >> 2, ks = (tid & 3) * 16;
  if (t.nt * 64 + nr < t.Nd) {
    unsigned w[8];
#pragma unroll
    for (int i = 0; i < 8; ++i) w[i] = pk2(sm[(ks + 2 * i) * 65 + nr], sm[(ks + 2 * i + 1) * 65 + nr]);
    u32x4* d = (u32x4*)(t.dst + (size_t)(t.nt * 64 + nr) * t.K + t.kt * 64 + ks);
    d[0] = (u32x4){w[0], w[1], w[2], w[3]};
    d[1] = (u32x4){w[4], w[5], w[6], w[7]};
  }
  __syncthreads();
}

__device__ void phase_p0(const Params& p, unsigned char* smem) {
  float* sm = (float*)smem;
  const int tid = (opq(threadIdx.x) & 255), lane = tid & 63, wid = tid >> 6;
  {
    constexpr int NT = NL * (16 * 121 + 256 + 1024 + 1024 + 256 + 64);
    const int vb = VB, vg = VG;
    const int nj = (NT - vb + vg - 1) / vg;
#define WT_IDX(j) (vb + ((j) < nj ? (j) : nj - 1) * vg)
    float va[16], sa[16], vb_[16], sb[16], vc[16], sc[16];
    WTile ta = wtile_decode(p, WT_IDX(0));
    wtile_load(ta, va, sa, tid);
    WTile tb = wtile_decode(p, WT_IDX(1));
    wtile_load(tb, vb_, sb, tid);
    for (int j = 0; j < nj; j += 3) {
      const WTile tc = wtile_decode(p, WT_IDX(j + 2));
      wtile_load(tc, vc, sc, tid);
      wtile_store(ta, va, sa, sm, tid);
      ta = wtile_decode(p, WT_IDX(j + 3));
      wtile_load(ta, va, sa, tid);
      if (j + 1 < nj) wtile_store(tb, vb_, sb, sm, tid);
      tb = wtile_decode(p, WT_IDX(j + 4));
      wtile_load(tb, vb_, sb, tid);
      if (j + 2 < nj) wtile_store(tc, vc, sc, sm, tid);
    }
#undef WT_IDX
  }
  for (int it = VB; it < MTOK / 4; it += VG) {
    const int row = it * 4 + wid;
    const float* src = row < MP ? p.x_prompt + (size_t)row * DM : p.x_sample + (size_t)(row - MP) * DM;
    float* hd = p.out + (size_t)row * DM;
    bf16_t* hbd = p.hb() + (size_t)row * DM;
    float ss = 0.f;
#pragma unroll
    for (int i = 0; i < 4; ++i) {
      const int c = i * 256 + lane * 4;
      const f32x4 v = *(const f32x4*)(src + c);
      ss += v.x * v.x + v.y * v.y + v.z * v.z + v.w * v.w;
      *(f32x4*)(hd + c) = v;
      *(u32x2*)(hbd + c) = (u32x2){pk2(v.x, v.y), pk2(v.z, v.w)};
    }
#pragma unroll
    for (int o = 1; o < 64; o <<= 1) ss += shx(ss, o, lane);
    if (lane < 16) p.ssq0()[(size_t)row * 16 + lane] = lane == 0 ? ss : 0.f;
  }
  const int G = NL * MTOK * 32;
  for (int g = VB * NTHR + tid; g < G; g += VG * NTHR) {
    const int l = g / (MTOK * 32), rem = g % (MTOK * 32), row = rem >> 5, c8 = rem & 31;
    const float* src = row < MP ? p.p_prompt + ((size_t)(l * MP + row) * PLE + c8 * 8) : p.p_sample + ((size_t)(l * MS + row - MP) * PLE + c8 * 8);
    const f32x4 a = *(const f32x4*)src, b = *(const f32x4*)(src + 4);
    *(u32x4*)(p.pb() + (size_t)g * 8) = (u32x4){pk2(a.x, a.y), pk2(a.z, a.w), pk2(b.x, b.y), pk2(b.z, b.w)};
  }
}

enum { EPI_PROJ = 0, EPI_LOGIT = 1, EPI_RESID = 2, EPI_UP = 3, EPI_PLE = 4, EPI_PP = 5 };
struct EpiArgs {
  const float* ssq_in; float* ssq_out; float* h; bf16_t* hb; bf16_t* obf; int ldo; float* of32; const bf16_t* pp;
};

template <int EPI>
DEVI float epi_rs(const EpiArgs& e, int row) {
  if (EPI == EPI_PROJ || EPI == EPI_LOGIT || EPI == EPI_UP || EPI == EPI_PLE) {
    const f32x4* sp = (const f32x4*)(e.ssq_in + (size_t)row * 16);
    const f32x4 a = sp[0], b = sp[1], c = sp[2], d = sp[3];
    const float s = ((a.x + a.y) + (a.z + a.w)) + ((b.x + b.y) + (b.z + b.w)) + ((c.x + c.y) + (c.z + c.w)) + ((d.x + d.y) + (d.z + d.w));
    return __builtin_amdgcn_rsqf(s * (1.f / 1024.f) + EPS);
  }
  return 1.f;
}
template <int EPI>
DEVI void epi_elem(const EpiArgs& e, int row, int col, f32x4 v, float rs, float& sq) {
  if (EPI == EPI_PROJ) {
    v *= rs;
    *(u32x2*)(e.obf + (size_t)row * e.ldo + col) = (u32x2){pk2(v.x, v.y), pk2(v.z, v.w)};
  } else if (EPI == EPI_LOGIT) {
    v *= rs;
    *(f32x4*)(e.of32 + (size_t)row * 16 + col) = v;
  } else if (EPI == EPI_PP) {
    *(u32x2*)(e.obf + (size_t)row * e.ldo + (col & 1023)) = (u32x2){pk2(v.x, v.y), pk2(v.z, v.w)};
  } else if (EPI == EPI_UP) {
    v *= rs;
    v.x = fmaxf(v.x, 0.f); v.y = fmaxf(v.y, 0.f); v.z = fmaxf(v.z, 0.f); v.w = fmaxf(v.w, 0.f);
    v = v * v;
    *(u32x2*)(e.obf + (size_t)row * e.ldo + col) = (u32x2){pk2(v.x, v.y), pk2(v.z, v.w)};
  } else {
    float* hp = e.h + (size_t)row * DM + col;
    f32x4 hv = *(const f32x4*)hp;
    if (EPI == EPI_RESID) {
      hv += v;
    } else {
      const u32x2 pv = *(const u32x2*)(e.pp + (size_t)row * DM + col);
      hv.x += sigm(v.x * rs) * lo2f(pv.x); hv.y += sigm(v.y * rs) * hi2f(pv.x);
      hv.z += sigm(v.z * rs) * lo2f(pv.y); hv.w += sigm(v.w * rs) * hi2f(pv.y);
    }
    *(f32x4*)hp = hv;
    *(u32x2*)(e.hb + (size_t)row * DM + col) = (u32x2){pk2(hv.x, hv.y), pk2(hv.z, hv.w)};
    sq += hv.x * hv.x + hv.y * hv.y + hv.z * hv.z + hv.w * hv.w;
  }
}

template <int EPI>
DEVI void epi_elem8(const EpiArgs& e, int row, int col, f32x4 v0, f32x4 v1, float rs, float& sq) {
  if (EPI == EPI_PROJ || EPI == EPI_UP || EPI == EPI_PP) {
    if (EPI != EPI_PP) { v0 *= rs; v1 *= rs; }
    if (EPI == EPI_UP) {
      v0.x = fmaxf(v0.x, 0.f); v0.y = fmaxf(v0.y, 0.f); v0.z = fmaxf(v0.z, 0.f); v0.w = fmaxf(v0.w, 0.f);
      v1.x = fmaxf(v1.x, 0.f); v1.y = fmaxf(v1.y, 0.f); v1.z = fmaxf(v1.z, 0.f); v1.w = fmaxf(v1.w, 0.f);
      v0 = v0 * v0; v1 = v1 * v1;
    }
    const int c = EPI == EPI_PP ? (col & 1023) : col;
    *(u32x4*)(e.obf + (size_t)row * e.ldo + c) = (u32x4){pk2(v0.x, v0.y), pk2(v0.z, v0.w), pk2(v1.x, v1.y), pk2(v1.z, v1.w)};
  } else {
    float* hp = e.h + (size_t)row * DM + col;
    f32x4 h0 = *(const f32x4*)hp, h1 = *(const f32x4*)(hp + 4);
    if (EPI == EPI_RESID) {
      h0 += v0; h1 += v1;
    } else {
      const u32x4 pv = *(const u32x4*)(e.pp + (size_t)row * DM + col);
      h0.x += sigm(v0.x * rs) * lo2f(pv.x); h0.y += sigm(v0.y * rs) * hi2f(pv.x);
      h0.z += sigm(v0.z * rs) * lo2f(pv.y); h0.w += sigm(v0.w * rs) * hi2f(pv.y);
      h1.x += sigm(v1.x * rs) * lo2f(pv.z); h1.y += sigm(v1.y * rs) * hi2f(pv.z);
      h1.z += sigm(v1.z * rs) * lo2f(pv.w); h1.w += sigm(v1.w * rs) * hi2f(pv.w);
    }
    *(f32x4*)hp = h0;
    *(f32x4*)(hp + 4) = h1;
    *(u32x4*)(e.hb + (size_t)row * DM + col) = (u32x4){pk2(h0.x, h0.y), pk2(h0.z, h0.w), pk2(h1.x, h1.y), pk2(h1.z, h1.w)};
    sq += (h0.x * h0.x + h0.y * h0.y + h0.z * h0.z + h0.w * h0.w) + (h1.x * h1.x + h1.y * h1.y + h1.z * h1.z + h1.w * h1.w);
  }
}

template <int WMT, int WNT, int WGM, int WGN, int EPI, int BK = 32, bool KSPLIT = false>
__device__ __forceinline__ void gemm_tile(const bf16_t* __restrict__ A, int lda, const bf16_t* __restrict__ Bt, int ldb, int K, int m0, int n0,
                                          bf16_t* lds, const EpiArgs& e) {
  constexpr int BM = WGM * WMT * 16, BN = WGN * WNT * 16, LDR = BK + 8;
  constexpr int STAGE = (BM + BN) * LDR;
  constexpr int PPR = BK / 8, RPI = NTHR / PPR;
  constexpr int NA = BM / RPI, NB = (BN + RPI - 1) / RPI;
  const int tid = (opq(threadIdx.x) & 255), lane = tid & 63, wid = tid >> 6;
  const int wm = wid / WGN, wn = wid % WGN;
  const int fr = lane & 15, fq = lane >> 4;
  f32x4 acc[WMT][WNT];
#pragma unroll
  for (int i = 0; i < WMT; ++i)
#pragma unroll
    for (int j = 0; j < WNT; ++j) acc[i][j] = (f32x4){0.f, 0.f, 0.f, 0.f};
  u32x4 ra0[NA], rb0[NB], ra1[NA], rb1[NB];
  const int khalf = KSPLIT ? VHALF : 0;
  const int nk = (KSPLIT ? K / 2 : K) / BK;
  const int prow = tid / PPR, ppc = tid % PPR;
  const unsigned ta = (unsigned)(prow * lda + ppc * 8) * 2u, tb = (unsigned)(prow * ldb + ppc * 8) * 2u;
  const char* Au = (const char*)(A + (size_t)m0 * lda + (size_t)khalf * (K / 2));
  const char* Bu = (const char*)(Bt + (size_t)n0 * ldb + (size_t)khalf * (K / 2));
#define BGUARD(i) (BN >= RPI * ((i) + 1) || prow + (i) * RPI < BN)
#define GLOAD(kt, RA, RB) do { \
    _Pragma("unroll") for (int i = 0; i < NA; ++i) RA[i] = *(const u32x4*)(Au + ((size_t)i * RPI * lda + (size_t)(kt) * BK) * 2 + ta); \
    _Pragma("unroll") for (int i = 0; i < NB; ++i) if (BGUARD(i)) RB[i] = *(const u32x4*)(Bu + ((size_t)i * RPI * ldb + (size_t)(kt) * BK) * 2 + tb); \
  } while (0)
#define LSTORE(st, RA, RB) do { bf16_t* sA_ = lds + (st) * STAGE; bf16_t* sB_ = sA_ + BM * LDR; \
    _Pragma("unroll") for (int i = 0; i < NA; ++i) *(u32x4*)(sA_ + (prow + i * RPI) * LDR + ppc * 8) = RA[i]; \
    _Pragma("unroll") for (int i = 0; i < NB; ++i) if (BGUARD(i)) *(u32x4*)(sB_ + (prow + i * RPI) * LDR + ppc * 8) = RB[i]; \
  } while (0)
#define COMPUTE(st) do { const bf16_t* sA = lds + (st) * STAGE; const bf16_t* sB = sA + BM * LDR; \
    _Pragma("unroll") for (int kk = 0; kk < BK / 32; ++kk) { \
      bf16x8 bfr[WNT]; \
      _Pragma("unroll") for (int nt = 0; nt < WNT; ++nt) bfr[nt] = *(const bf16x8*)(sB + (wn * WNT * 16 + nt * 16 + fr) * LDR + kk * 32 + fq * 8); \
      _Pragma("unroll") for (int mt = 0; mt < WMT; ++mt) { \
        const bf16x8 af = *(const bf16x8*)(sA + (wm * WMT * 16 + mt * 16 + fr) * LDR + kk * 32 + fq * 8); \
        _Pragma("unroll") for (int nt = 0; nt < WNT; ++nt) acc[mt][nt] = mfma16(bfr[nt], af, acc[mt][nt]); } } \
  } while (0)
  GLOAD(0, ra0, rb0);
  GLOAD(1, ra1, rb1);
  LSTORE(0, ra0, rb0);
  __syncthreads();
  for (int kt = 0; kt < nk; kt += 2) {
    const int k2 = kt + 2 < nk ? kt + 2 : nk - 2;
    GLOAD(k2, ra0, rb0);
    COMPUTE(0);
    LSTORE(1, ra1, rb1);
    __syncthreads();
    GLOAD(k2 + 1, ra1, rb1);
    COMPUTE(1);
    LSTORE(0, ra0, rb0);
    __syncthreads();
  }
#undef BGUARD
#undef COMPUTE
#undef GLOAD
#undef LSTORE
  if (KSPLIT) {
    f32x4* red = (f32x4*)((unsigned char*)lds + (khalf ? 0 : SMEM_BYTES));
    if (khalf == 1) {
#pragma unroll
      for (int i = 0; i < WMT; ++i)
#pragma unroll
        for (int j = 0; j < WNT; ++j) red[((wid * WMT + i) * WNT + j) * 64 + lane] = acc[i][j];
    }
    __syncthreads();
    if (khalf == 0) {
#pragma unroll
      for (int i = 0; i < WMT; ++i)
#pragma unroll
        for (int j = 0; j < WNT; ++j) acc[i][j] += red[((wid * WMT + i) * WNT + j) * 64 + lane];
    }
  }
  if (!KSPLIT || khalf == 0) {
#pragma unroll
  for (int mt = 0; mt < WMT; ++mt) {
    const int row = m0 + wm * WMT * 16 + mt * 16 + fr;
    const float rs = epi_rs<EPI>(e, row);
    float sq = 0.f;
#pragma unroll
    for (int nt = 0; nt < WNT; ++nt) epi_elem<EPI>(e, row, n0 + wn * WNT * 16 + nt * 16 + fq * 4, acc[mt][nt], rs, sq);
    if (EPI == EPI_RESID || EPI == EPI_PLE) {
      sq += shx(sq, 16, lane);
      sq += shx(sq, 32, lane);
      if (fq == 0) e.ssq_out[(size_t)row * 16 + (n0 / BN) * WGN + wn] = sq;
    }
  }
  }
  if (KSPLIT) __syncthreads();
}

namespace pg8 {
#define PG8_LAS __attribute__((address_space(3)))
typedef unsigned short bf16_t;
typedef short bf16x8 __attribute__((ext_vector_type(8)));
typedef float f32x4 __attribute__((ext_vector_type(4)));
typedef unsigned u32x4 __attribute__((ext_vector_type(4)));
constexpr int BM = 256, BK = 64, HALF = 128, HTB = HALF * BK * 2  , STAGE_BYTES = 8 * HTB, NXCD = 8, WGM = 8;

__host__ __device__ __forceinline__ int lds_byte(int r, int c) { const int st = (r >> 4) * 2 + (c >> 5), rr = r & 15, cc = c & 31, ob = rr * 64 + cc * 2; return st * 1024 + (ob ^ (((ob >> 9) & 1) << 5)); }
__host__ __device__ __forceinline__ void stage_rc(int b, int& R, int& C) { const int st = b / 1024, sb = b % 1024, swz = sb ^ (((sb >> 9) & 1) << 5); R = (st >> 1) * 16 + swz / 64; C = (st & 1) * 32 + (swz % 64) / 2; }
__host__ __device__ __forceinline__ int perm32(int rho) { const int n = rho >> 4, i = rho & 15; return 8 * (i >> 2) + 4 * n + (i & 3); }

struct Unit { int pm, pn; };
struct Gemm { const bf16_t* A; const bf16_t* Bt; int M, N, K; };

template <class Epi, class Sched, bool STAMP = false>
__device__ __forceinline__ void gemm_phase(PG8_LAS unsigned char* lds, const Gemm g, const Sched& S, const Epi& E, unsigned long long* stamps) {
    const int tid = opq((int)threadIdx.x), wid = __builtin_amdgcn_readfirstlane(tid >> 6), lane = tid & 63, wr = wid >> 2, wc = wid & 3, fr = lane & 15, fq = lane >> 4;
    const int K = g.K, nt = K / BK;
    int ts_lo = 0, ts_hi = 0, nts = 0; const unsigned long long rt_entry = STAMP ? (unsigned long long)wall_clock64() : 0ull;
#define PG8_STAMP() do { if (STAMP && wid == 0 && nts < 64) { const unsigned long long _c = (unsigned long long)clock64(); \
        ts_lo = (lane == nts) ? (int)(unsigned)_c : ts_lo; ts_hi = (lane == nts) ? (int)(unsigned)(_c >> 32) : ts_hi; ++nts; } } while (0)
    PG8_STAMP();
    unsigned voffA[2], voffB[2];
#pragma unroll
    for (int i = 0; i < 2; ++i) { int R, C; stage_rc(tid * 16 + i * 8192, R, C); const int Rb = Epi::PERM ? ((R & ~31) + perm32(R & 31)) : R;
        voffA[i] = (unsigned)(R * K + C) * 2u; voffB[i] = (unsigned)(Rb * K + C) * 2u; }
    const size_t kstep = (size_t)(BK * 2);
    const size_t hstep = (size_t)HALF * K * 2;
    const size_t tstep = 2 * hstep;
    const unsigned ldsw = (unsigned)wid * 1024u;
    const int aoff = lds_byte(wr * 64 + fr, fq * 8), boff = lds_byte(wc * 32 + fr, fq * 8);
#define PG8_SA(b, h) (((b) * 2 + (h)) * HTB)
#define PG8_SB(b, h) ((4 + (b) * 2 + (h)) * HTB)
#define PG8_STAGE(bufoff, gbase, voff) do { _Pragma("unroll") for (int _i = 0; _i < 2; ++_i) \
        __builtin_amdgcn_global_load_lds((const unsigned*)((const char*)(gbase) + (voff)[_i]), (PG8_LAS unsigned*)(lds + (bufoff) + ldsw + _i * 8192), 16, 0, 0); } while (0)
#define PG8_LDA(dst, b, h) do { _Pragma("unroll") for (int m = 0; m < 4; ++m) _Pragma("unroll") for (int k = 0; k < 2; ++k) dst[m][k] = *(const PG8_LAS bf16x8*)(lds + PG8_SA(b, h) + aoff + m * 2048 + k * 1024); } while (0)
#define PG8_LDB(dst, b, h) do { _Pragma("unroll") for (int n = 0; n < 2; ++n) _Pragma("unroll") for (int k = 0; k < 2; ++k) dst[n][k] = *(const PG8_LAS bf16x8*)(lds + PG8_SB(b, h) + boff + n * 2048 + k * 1024); } while (0)
#define PG8_MMA(ai, bj, At, Bt) do { __builtin_amdgcn_s_setprio(1); _Pragma("unroll") for (int m = 0; m < 4; ++m) _Pragma("unroll") for (int n = 0; n < 2; ++n) _Pragma("unroll") for (int k = 0; k < 2; ++k) \
        acc[ai][bj][m][n] = __builtin_amdgcn_mfma_f32_16x16x32_bf16(Bt[n][k], At[m][k], acc[ai][bj][m][n], 0, 0, 0); __builtin_amdgcn_s_setprio(0); } while (0)
#define PG8_WAIT_V(n) asm volatile("s_waitcnt vmcnt(" #n ")" ::: "memory")
#define PG8_WAIT_L(n) asm volatile("s_waitcnt lgkmcnt(" #n ")" ::: "memory")
#define PG8_BAR __builtin_amdgcn_s_barrier()
#define PG8_SCHED __builtin_amdgcn_sched_barrier(0)
    Unit cur, nxt; int ui = 0;
    if (!S.next(0, cur)) return;
    f32x4 acc[2][2][4][2];
#pragma unroll
    for (int a = 0; a < 2; ++a)
#pragma unroll
        for (int b = 0; b < 2; ++b)
#pragma unroll
            for (int m = 0; m < 4; ++m)
#pragma unroll
                for (int n = 0; n < 2; ++n) acc[a][b][m][n] = (f32x4){0.f, 0.f, 0.f, 0.f};
    bf16x8 At[4][2], B0[2][2], B1[2][2];
    const char* cA = (const char*)g.A + (size_t)cur.pm * tstep; const char* cB = (const char*)g.Bt + (size_t)cur.pn * tstep;
    S.a_ready(cur);
    PG8_STAGE(PG8_SB(0, 0), cB, voffB); PG8_STAGE(PG8_SA(0, 0), cA, voffA); PG8_STAGE(PG8_SB(0, 1), cB + hstep, voffB); PG8_STAGE(PG8_SA(0, 1), cA + hstep, voffA);
    if (wr == 1) PG8_BAR;
    PG8_WAIT_V(4); PG8_BAR;
    PG8_STAGE(PG8_SB(1, 0), cB + kstep, voffB); PG8_STAGE(PG8_SA(1, 0), cA + kstep, voffA); PG8_STAGE(PG8_SB(1, 1), cB + hstep + kstep, voffB);
    PG8_WAIT_V(6); PG8_BAR;
    PG8_STAMP();
    for (;;) {
        const bool has_next = S.next(ui + 1, nxt);
        const char* nA = has_next ? (const char*)g.A + (size_t)nxt.pm * tstep : cA; const char* nB = has_next ? (const char*)g.Bt + (size_t)nxt.pn * tstep : cB;
        for (int t = 0; t < nt; t += 2) {
            const bool last = (t == nt - 2);
            const char* a1 = cA + (size_t)(t + 1) * kstep;
            const char* a2 = last ? nA : cA + (size_t)(t + 2) * kstep; const char* b2 = last ? nB : cB + (size_t)(t + 2) * kstep;
            const char* a3 = a2 + kstep; const char* b3 = b2 + kstep;
            if (last && has_next) S.a_ready(nxt);
            PG8_LDB(B0, 0, 0); PG8_SCHED; PG8_LDA(At, 0, 0); PG8_STAGE(PG8_SA(1, 1), a1 + hstep, voffA);
            PG8_WAIT_L(8); PG8_BAR; PG8_WAIT_L(0); PG8_MMA(0, 0, At, B0); PG8_BAR; PG8_SCHED;
            PG8_LDB(B1, 0, 1); PG8_STAGE(PG8_SB(0, 0), b2, voffB);
            PG8_BAR; PG8_WAIT_L(0); PG8_MMA(0, 1, At, B1); PG8_BAR;
            PG8_LDA(At, 0, 1); PG8_STAGE(PG8_SA(0, 0), a2, voffA);
            PG8_BAR; PG8_WAIT_L(0); PG8_MMA(1, 0, At, B0); PG8_BAR; PG8_SCHED;
            PG8_STAGE(PG8_SB(0, 1), b2 + hstep, voffB);
            PG8_WAIT_V(6); PG8_BAR; PG8_MMA(1, 1, At, B1); PG8_BAR;
            PG8_LDB(B0, 1, 0); PG8_SCHED; PG8_LDA(At, 1, 0); PG8_STAGE(PG8_SA(0, 1), a2 + hstep, voffA);
            PG8_WAIT_L(8); PG8_BAR; PG8_WAIT_L(0); PG8_MMA(0, 0, At, B0); PG8_BAR; PG8_SCHED;
            PG8_LDB(B1, 1, 1); PG8_STAGE(PG8_SB(1, 0), b3, voffB);
            PG8_BAR; PG8_WAIT_L(0); PG8_MMA(0, 1, At, B1); PG8_BAR;
            PG8_LDA(At, 1, 1); PG8_STAGE(PG8_SA(1, 0), a3, voffA);
            PG8_BAR; PG8_WAIT_L(0); PG8_MMA(1, 0, At, B0); PG8_BAR; PG8_SCHED;
            PG8_STAGE(PG8_SB(1, 1), b3 + hstep, voffB);
            PG8_WAIT_V(6); PG8_BAR; PG8_MMA(1, 1, At, B1); PG8_BAR;
        }
        PG8_STAMP();
        if constexpr (!Epi::AFTER_DRAIN) { E(acc, cur, wr, wc, fr, fq); S.done(cur); }
        PG8_STAMP();
        if (!has_next) break;
#pragma unroll
        for (int a = 0; a < 2; ++a)
#pragma unroll
            for (int b = 0; b < 2; ++b)
#pragma unroll
                for (int m = 0; m < 4; ++m)
#pragma unroll
                    for (int n = 0; n < 2; ++n) acc[a][b][m][n] = (f32x4){0.f, 0.f, 0.f, 0.f};
        cur = nxt; cA = nA; cB = nB; ++ui;
    }
    PG8_WAIT_V(0);
    if (wr == 0) PG8_BAR;
    PG8_BAR;
    if constexpr (Epi::AFTER_DRAIN) { E.fused(acc, cur, wr, wc, fr, fq, lds, wid, lane); S.done(cur); }
    PG8_STAMP();
    if (STAMP && wid == 0) { stamps[lane] = lane < nts ? (((unsigned long long)(unsigned)ts_hi << 32) | (unsigned)ts_lo) : 0ull;
        if (lane == 62) stamps[62] = rt_entry; if (lane == 63) stamps[63] = (unsigned long long)wall_clock64(); }
#undef PG8_STAMP
#undef PG8_SA
#undef PG8_SB
#undef PG8_STAGE
#undef PG8_LDA
#undef PG8_LDB
#undef PG8_MMA
#undef PG8_WAIT_V
#undef PG8_WAIT_L
#undef PG8_BAR
#undef PG8_SCHED
}
}

DEVI void unit_map(int L, int nM, int nN, int& pm, int& pn) {
  const int nwg = nM * nN, q = nwg / 8, r = nwg % 8, xcd = L % 8, off = L / 8;
  const int wgid = (xcd < r ? xcd * (q + 1) : r * (q + 1) + (xcd - r) * q) + off;
  const int nig = 8 * nN, gid = wgid / nig, fm = gid * 8, gsz = (nM - fm) < 8 ? (nM - fm) : 8, w = wgid - gid * nig;
  pm = fm + (w % gsz); pn = w / gsz;
}
struct RowSched {
  int nM, nN, nLimit, G, c;
  __device__ __forceinline__ bool next(int i, pg8::Unit& u) const { const int L = i * G + c; if (L >= nLimit) return false; unit_map(L, nM, nN, u.pm, u.pn); return true; }
  __device__ __forceinline__ void a_ready(const pg8::Unit&) const {}
  __device__ __forceinline__ void done(const pg8::Unit&) const {}
};
struct DiagSched {
  int nLimit, G, c;
  __device__ __forceinline__ bool next(int i, pg8::Unit& u) const { const int L = i * G + c; if (L >= nLimit) return false; const int l = L / 272, r = L - l * 272; u.pm = l * 68 + (r >> 2); u.pn = l * 4 + (r & 3); return true; }
  __device__ __forceinline__ void a_ready(const pg8::Unit&) const {}
  __device__ __forceinline__ void done(const pg8::Unit&) const {}
};
template <int EPI> struct BigEpi {
  static constexpr bool PERM = true, AFTER_DRAIN = false;
  EpiArgs e;
  __device__ __forceinline__ void operator()(const f32x4 (&acc)[2][2][4][2], const pg8::Unit& u, int wr, int wc, int fr, int fq) const {
    const int lane = fq * 16 + fr;
#pragma unroll
    for (int ai = 0; ai < 2; ++ai)
#pragma unroll
      for (int m = 0; m < 4; ++m) {
        const int row = u.pm * 256 + ai * 128 + wr * 64 + m * 16 + fr;
        const float rs = epi_rs<EPI>(e, row);
        float sq = 0.f;
#pragma unroll
        for (int bj = 0; bj < 2; ++bj) epi_elem8<EPI>(e, row, u.pn * 256 + bj * 128 + wc * 32 + fq * 8, acc[ai][bj][m][0], acc[ai][bj][m][1], rs, sq);
        if (EPI == EPI_RESID || EPI == EPI_PLE) {
          sq += shx(sq, 16, lane);
          sq += shx(sq, 32, lane);
          if (fq == 0) e.ssq_out[(size_t)row * 16 + u.pn * 4 + wc] = sq;
        }
      }
  }
};

template <int EPI>
__device__ void gemm_big_phase(const bf16_t* A, const bf16_t* Bt, int K, int M, int N, unsigned char* lds_all, unsigned char* smem_half, const EpiArgs& e) {
  const int nM = M / 256, nN = N / 256, nU = nM * nN, G = gridDim.x;
  const int L = nU % G;
  const int nLimit = (L > 0 && L <= G / 4) ? nU - L : nU;
  RowSched S; S.nM = nM; S.nN = nN; S.nLimit = nLimit; S.G = G; S.c = blockIdx.x;
  pg8::Gemm g; g.A = A; g.Bt = Bt; g.M = M; g.N = N; g.K = K;
  BigEpi<EPI> E; E.e = e;
  pg8::gemm_phase<BigEpi<EPI>, RowSched>((PG8_LAS unsigned char*)lds_all, g, S, E, nullptr);
  __syncthreads();
  const int nSmall = (nU - nLimit) * 16;
  if (nSmall <= G && K >= 512) {
    for (int st = blockIdx.x; st < nSmall; st += G) {
      const int sub = st & 15; int pm, pn; unit_map(nLimit + (st >> 4), nM, nN, pm, pn);
      gemm_tile<1, 4, 4, 1, EPI, 128, true>(A, K, Bt, K, K, pm * 256 + (sub >> 2) * 64, pn * 256 + (sub & 3) * 64, (bf16_t*)smem_half, e);
    }
  } else {
    for (int st = VB; st < nSmall; st += VG) {
      const int sub = st & 15; int pm, pn; unit_map(nLimit + (st >> 4), nM, nN, pm, pn);
      gemm_tile<1, 4, 4, 1, EPI, 128>(A, K, Bt, K, K, pm * 256 + (sub >> 2) * 64, pn * 256 + (sub & 3) * 64, (bf16_t*)smem_half, e);
    }
  }
}


template <int I, int J4>
DEVI void solve_sub4(float& r, const float (&x)[64], const float* Am) {
  if constexpr (J4 * 4 < I) {
    const f32x4 a = *(const f32x4*)(Am + I * 64 + J4 * 4);
    if constexpr (J4 * 4 + 0 < I) r -= a.x * x[J4 * 4 + 0];
    if constexpr (J4 * 4 + 1 < I) r -= a.y * x[J4 * 4 + 1];
    if constexpr (J4 * 4 + 2 < I) r -= a.z * x[J4 * 4 + 2];
    if constexpr (J4 * 4 + 3 < I) r -= a.w * x[J4 * 4 + 3];
    solve_sub4<I, J4 + 1>(r, x, Am);
  }
}
template <int I>
DEVI void solve_rows(float (&x)[64], const float* Am, const bf16_t* src, const float* sc) {
  if constexpr (I < 64) {
    float r = bf2f(src[I * 136]) * sc[I];
    solve_sub4<I, 0>(r, x, Am);
    x[I] = r;
    asm volatile("" ::: "memory");
    solve_rows<I + 1>(x, Am, src, sc);
  }
}

__device__ void gdn_prep_item(const Params& p, int l, int item, unsigned char* smem) {
  const int tid = (opq(threadIdx.x) & 255), lane = tid & 63, wid = tid >> 6, fr = lane & 15, fq = lane >> 4;
  const int h = item & 7, n = (item >> 3) & 31, b = item >> 8;
  const int tok0 = b * 2048 + n * 64;
  bf16_t* qh = (bf16_t*)smem;
  bf16_t* kh = qh + 64 * 136;
  bf16_t* vh = kh + 64 * 136;
  float* Am = (float*)(vh + 64 * 136);
  float* sbeta = Am + 64 * 64;
  float* sgc = sbeta + 64;
  float* sbe = sgc + 64;
  float* seg = sbe + 64;
  float* sek = seg + 64;
  unsigned char* scr = (unsigned char*)p.scr() + (size_t)item * SCR_ITEM;
  bf16_t* g_uT = (bf16_t*)scr;
  bf16_t* g_w = (bf16_t*)(scr + 16384);
  bf16_t* g_qg = (bf16_t*)(scr + 32768);
  bf16_t* g_kgT = (bf16_t*)(scr + 49152);
  bf16_t* g_qk = (bf16_t*)(scr + 65536);

  if (wid == 0) {
    const float* lg = p.logits() + (size_t)(tok0 + lane) * 16;
    const float bl = lg[h], al = lg[8 + h];
    const float x = al + p.dt_bias[l * 8 + h];
    const float sp = softplus_f(x);
    float g = -__expf(p.a_log[l * 8 + h]) * sp;
#pragma unroll
    for (int o = 1; o < 64; o <<= 1) { const float t = shup(g, o, lane); if (lane >= o) g += t; }
    sbeta[lane] = sigm(bl);
    sgc[lane] = g;
    sbe[lane] = sigm(bl) * __expf(g);
    seg[lane] = __expf(g);
    const float glast = __builtin_bit_cast(float, __builtin_amdgcn_readlane(__builtin_bit_cast(int, g), 63));
    sek[lane] = __expf(glast - g);
  }
  u32x4 rwall[3][7];
#pragma unroll
  for (int sect = 0; sect < 3; ++sect)
#pragma unroll
    for (int r = 0; r < 7; ++r) {
      const int tl = n * 64 + wid * 16 + fq * 4 - 3 + r;
      rwall[sect][r] = (u32x4){0u, 0u, 0u, 0u};
      if (tl >= 0) rwall[sect][r] = *(const u32x4*)(p.proj() + (size_t)(b * 2048 + tl) * NPJ + sect * 1024 + h * 128 + fr * 8);
    }
#pragma unroll
  for (int sect = 0; sect < 3; ++sect) {
    const int ch0 = sect * 1024 + h * 128 + fr * 8;
    float cw[4][8];
#pragma unroll
    for (int j = 0; j < 4; ++j) {
      const f32x4 a = *(const f32x4*)(p.conv_w + (size_t)(l * 4 + j) * 3072 + ch0), c = *(const f32x4*)(p.conv_w + (size_t)(l * 4 + j) * 3072 + ch0 + 4);
      cw[j][0] = a.x; cw[j][1] = a.y; cw[j][2] = a.z; cw[j][3] = a.w; cw[j][4] = c.x; cw[j][5] = c.y; cw[j][6] = c.z; cw[j][7] = c.w;
    }
    const int ib = wid * 16 + fq * 4;
#pragma unroll
    for (int it = 0; it < 4; ++it) {
      float o[8];
#pragma unroll
      for (int c = 0; c < 8; ++c) o[c] = 0.f;
#pragma unroll
      for (int j = 0; j < 4; ++j) {
        float f[8];
        UNPACK8(rwall[sect][it + j], f);
#pragma unroll
        for (int c = 0; c < 8; ++c) o[c] += f[c] * cw[j][c];
      }
      float ss = 0.f;
#pragma unroll
      for (int c = 0; c < 8; ++c) { o[c] = silu(o[c]); ss += o[c] * o[c]; }
      if (sect < 2) {
        ss += shx(ss, 1, lane); ss += shx(ss, 2, lane); ss += shx(ss, 4, lane); ss += shx(ss, 8, lane);
        float rn = __builtin_amdgcn_rsqf(ss + EPS);
        if (sect == 0) rn *= 0.08838834764831845f;
#pragma unroll
        for (int c = 0; c < 8; ++c) o[c] *= rn;
      }
      const u32x4 pk = (u32x4){pk2(o[0], o[1]), pk2(o[2], o[3]), pk2(o[4], o[5]), pk2(o[6], o[7])};
      bf16_t* dst = sect == 0 ? qh + (ib + it) * 136 + fr * 8 : (sect == 1 ? kh + (ib + it) * 136 + fr * 8 : vh + (ib + it) * 136 + fr * 8);
      *(u32x4*)dst = pk;
    }
  }
  __syncthreads();
  {
    const int i = wid * 16 + fr;
    const float gi = sgc[i], bi = sbeta[i];
    bf16x8 kx[4], qx[4];
#pragma unroll
    for (int ks = 0; ks < 4; ++ks) {
      kx[ks] = *(const bf16x8*)(kh + i * 136 + ks * 32 + fq * 8);
      qx[ks] = *(const bf16x8*)(qh + i * 136 + ks * 32 + fq * 8);
    }
#pragma unroll
    for (int jt = 0; jt < 4; ++jt) {
      f32x4 akk = (f32x4){0.f, 0.f, 0.f, 0.f}, aqk = (f32x4){0.f, 0.f, 0.f, 0.f};
      if (jt <= wid) {
#pragma unroll
        for (int ks = 0; ks < 4; ++ks) {
          const bf16x8 kj = *(const bf16x8*)(kh + (jt * 16 + fr) * 136 + ks * 32 + fq * 8);
          akk = mfma16(kj, kx[ks], akk);
          aqk = mfma16(kj, qx[ks], aqk);
        }
      }
      const int j0 = jt * 16 + fq * 4;
      float av[4], qv[4];
#pragma unroll
      for (int jj = 0; jj < 4; ++jj) {
        const int j = j0 + jj;
        const float dec = j <= i ? __expf(gi - sgc[j]) : 0.f;
        av[jj] = j < i ? bi * akk[jj] * dec : 0.f;
        qv[jj] = aqk[jj] * dec;
      }
      *(f32x4*)(Am + i * 64 + j0) = (f32x4){av[0], av[1], av[2], av[3]};
      *(u32x2*)(g_qk + i * 64 + j0) = (u32x2){pk2(qv[0], qv[1]), pk2(qv[2], qv[3])};
    }
  }
  __syncthreads();
  {
    float x[64];
    const bool isu = tid < 128;
    const int cc = tid & 127;
    solve_rows<0>(x, Am, (isu ? vh : kh) + cc, isu ? sbeta : sbe);
    if (isu) {
      u32x4* d = (u32x4*)(g_uT + cc * 64);
#pragma unroll
      for (int q = 0; q < 8; ++q) d[q] = (u32x4){pk2(x[q * 8], x[q * 8 + 1]), pk2(x[q * 8 + 2], x[q * 8 + 3]), pk2(x[q * 8 + 4], x[q * 8 + 5]), pk2(x[q * 8 + 6], x[q * 8 + 7])};
    } else {
#pragma unroll
      for (int i = 0; i < 64; ++i) g_w[i * 128 + cc] = f2bf(x[i]);
    }
  }
  {
    const float gl = sgc[63];
#pragma unroll
    for (int q = 0; q < 4; ++q) {
      const int pc = tid + q * 256, i = pc >> 4, c8 = pc & 15;
      const u32x4 v = *(const u32x4*)(qh + i * 136 + c8 * 8);
      float f[8];
      UNPACK8(v, f);
      const float s = seg[i];
      *(u32x4*)(g_qg + i * 128 + c8 * 8) = (u32x4){pk2(f[0] * s, f[1] * s), pk2(f[2] * s, f[3] * s), pk2(f[4] * s, f[5] * s), pk2(f[6] * s, f[7] * s)};
    }
    if (tid >= 128) {
      const int dk = tid - 128;
      u32x4* d = (u32x4*)(g_kgT + dk * 64);
#pragma unroll
      for (int q = 0; q < 8; ++q) {
        float f[8];
#pragma unroll
        for (int c = 0; c < 8; ++c) { const int i = q * 8 + c; f[c] = bf2f(kh[i * 136 + dk]) * sek[i]; }
        d[q] = (u32x4){pk2(f[0], f[1]), pk2(f[2], f[3]), pk2(f[4], f[5]), pk2(f[6], f[7])};
      }
    }
    if (tid == 0) p.gsc()[item] = __expf(gl);
  }
  __syncthreads();
}

__device__ void gdn_scan_item(const Params& p, int l, int item, unsigned char* smem) {
  const int tid = (opq(threadIdx.x) & 255), lane = tid & 63, wid = tid >> 6, fr = lane & 15, fq = lane >> 4;
  const int dvs = item & 3, h = (item >> 2) & 7, b = item >> 5;
  bf16_t* ST = (bf16_t*)smem;
  bf16_t* VT = ST + 2 * 32 * 136;
  f32x4 S[2][2];
#pragma unroll
  for (int a = 0; a < 2; ++a)
#pragma unroll
    for (int c = 0; c < 2; ++c) S[a][c] = (f32x4){0.f, 0.f, 0.f, 0.f};
  __syncthreads();
  bf16x8 fw[4], fqg[4], fqk[2], fkg[2][2];
  u32x2 fu[2];
  float gs;
  bf16x8 nw[4], nqg[4], nqk[2], nkg[2][2];
  u32x2 nu[2];
  float ngs;
#define SCAN_LOAD(n_, W, QG, QK, KG, U, GS) do { \
    const int it_ = ((b * 32 + (n_)) << 3) + h; \
    const unsigned char* scr_ = (const unsigned char*)p.scr() + (size_t)it_ * SCR_ITEM; \
    const bf16_t* g_uT = (const bf16_t*)scr_; const bf16_t* g_w = (const bf16_t*)(scr_ + 16384); const bf16_t* g_qg = (const bf16_t*)(scr_ + 32768); \
    const bf16_t* g_kgT = (const bf16_t*)(scr_ + 49152); const bf16_t* g_qk = (const bf16_t*)(scr_ + 65536); \
    _Pragma("unroll") for (int ks = 0; ks < 4; ++ks) { \
      W[ks] = *(const bf16x8*)(g_w + (wid * 16 + fr) * 128 + ks * 32 + fq * 8); \
      QG[ks] = *(const bf16x8*)(g_qg + (wid * 16 + fr) * 128 + ks * 32 + fq * 8); } \
    _Pragma("unroll") for (int ks = 0; ks < 2; ++ks) { \
      QK[ks] = *(const bf16x8*)(g_qk + (wid * 16 + fr) * 64 + ks * 32 + fq * 8); \
      _Pragma("unroll") for (int mt = 0; mt < 2; ++mt) KG[mt][ks] = *(const bf16x8*)(g_kgT + ((2 * wid + mt) * 16 + fr) * 64 + ks * 32 + fq * 8); } \
    _Pragma("unroll") for (int nt = 0; nt < 2; ++nt) U[nt] = *(const u32x2*)(g_uT + (dvs * 32 + nt * 16 + fr) * 64 + wid * 16 + fq * 4); \
    GS = p.gsc()[it_]; } while (0)
  SCAN_LOAD(0, nw, nqg, nqk, nkg, nu, ngs);
  for (int n = 0; n < 32; ++n) {
#pragma unroll
    for (int ks = 0; ks < 4; ++ks) { fw[ks] = nw[ks]; fqg[ks] = nqg[ks]; }
#pragma unroll
    for (int ks = 0; ks < 2; ++ks) { fqk[ks] = nqk[ks]; fkg[0][ks] = nkg[0][ks]; fkg[1][ks] = nkg[1][ks]; }
    fu[0] = nu[0]; fu[1] = nu[1]; gs = ngs;
    { const int n1 = n + 1 < 32 ? n + 1 : 31; SCAN_LOAD(n1, nw, nqg, nqk, nkg, nu, ngs); }
    bf16_t* STc = ST + (n & 1) * 32 * 136;
#pragma unroll
    for (int mt = 0; mt < 2; ++mt)
#pragma unroll
      for (int nt = 0; nt < 2; ++nt)
        *(u32x2*)(STc + (nt * 16 + fr) * 136 + (2 * wid + mt) * 16 + fq * 4) = (u32x2){pk2(S[mt][nt].x, S[mt][nt].y), pk2(S[mt][nt].z, S[mt][nt].w)};
    __syncthreads();
#pragma unroll
    for (int nt = 0; nt < 2; ++nt) {
      f32x4 a = (f32x4){0.f, 0.f, 0.f, 0.f};
#pragma unroll
      for (int ks = 0; ks < 4; ++ks) {
        const bf16x8 sb = *(const bf16x8*)(STc + (nt * 16 + fr) * 136 + ks * 32 + fq * 8);
        a = mfma16(fw[ks], sb, a);
      }
      const float v0 = lo2f(fu[nt].x) - a.x, v1 = hi2f(fu[nt].x) - a.y, v2 = lo2f(fu[nt].y) - a.z, v3 = hi2f(fu[nt].y) - a.w;
      *(u32x2*)(VT + (nt * 16 + fr) * 72 + wid * 16 + fq * 4) = (u32x2){pk2(v0, v1), pk2(v2, v3)};
    }
    __syncthreads();
#pragma unroll
    for (int mt = 0; mt < 2; ++mt) {
      f32x4 a = (f32x4){0.f, 0.f, 0.f, 0.f};
#pragma unroll
      for (int ks = 0; ks < 4; ++ks) {
        const bf16x8 sa = *(const bf16x8*)(STc + (mt * 16 + fr) * 136 + ks * 32 + fq * 8);
        a = mfma16(sa, fqg[ks], a);
      }
#pragma unroll
      for (int ks = 0; ks < 2; ++ks) {
        const bf16x8 va = *(const bf16x8*)(VT + (mt * 16 + fr) * 72 + ks * 32 + fq * 8);
        a = mfma16(va, fqk[ks], a);
      }
      const size_t row = (size_t)b * 2048 + n * 64 + wid * 16 + fr;
      *(u32x2*)(p.ogdn() + row * DM + h * 128 + dvs * 32 + mt * 16 + fq * 4) = (u32x2){pk2(a.x, a.y), pk2(a.z, a.w)};
    }
#pragma unroll
    for (int mt = 0; mt < 2; ++mt)
#pragma unroll
      for (int nt = 0; nt < 2; ++nt) {
        f32x4 a = S[mt][nt] * gs;
#pragma unroll
        for (int ks = 0; ks < 2; ++ks) {
          const bf16x8 vb = *(const bf16x8*)(VT + (nt * 16 + fr) * 72 + ks * 32 + fq * 8);
          a = mfma16(fkg[mt][ks], vb, a);
        }
        S[mt][nt] = a;
      }
  }
  float* so = p.out + O_GDNP + ((size_t)(l * 8 + b) * 8 + h) * 16384;
#pragma unroll
  for (int mt = 0; mt < 2; ++mt)
#pragma unroll
    for (int nt = 0; nt < 2; ++nt)
#pragma unroll
      for (int jj = 0; jj < 4; ++jj) so[((2 * wid + mt) * 16 + fq * 4 + jj) * 128 + dvs * 32 + nt * 16 + fr] = S[mt][nt][jj];
  __syncthreads();
#undef SCAN_LOAD
}

__device__ void gdn_sample_item(const Params& p, int l, int item, unsigned char* smem) {
  const int tid = (opq(threadIdx.x) & 255), lane = tid & 63, wid = tid >> 6;
  const int h = item & 7, b = item >> 3;
  float* qs = (float*)smem;
  float* ks = qs + 1024;
  float* vs = ks + 1024;
  float* part = vs + 1024;
  float* sbeta = part + 256;
  float* sa = sbeta + 8;
  const int dv = tid & 127, half = tid >> 7;
  float S[64];
  const float* s0 = p.state_gdn + ((size_t)(l * 128 + b) * 8 + h) * 16384 + (half * 8192 + dv);
#pragma unroll
  for (int k = 0; k < 64; ++k) S[k] = s0[k * 128];
#pragma unroll
  for (int ps = 0; ps < 2; ++ps) {
    const int c = tid + ps * 256;
    if (c < 384) {
      const int sect = c >> 7, ci = c & 127;
      const int ch = sect * 1024 + h * 128 + ci;
      float xw[11], cwv[4];
#pragma unroll
      for (int j = 0; j < 4; ++j) cwv[j] = p.conv_w[(size_t)(l * 4 + j) * 3072 + ch];
#pragma unroll
      for (int j = 0; j < 3; ++j) xw[j] = p.cache_conv[((size_t)(l * 128 + b) * 3 + j) * 3072 + ch];
#pragma unroll
      for (int t = 0; t < 8; ++t) xw[3 + t] = bf2f(p.proj()[(size_t)(MP + b * 8 + t) * NPJ + ch]);
      float* dst = sect == 0 ? qs : (sect == 1 ? ks : vs);
#pragma unroll
      for (int t = 0; t < 8; ++t) dst[t * 128 + ci] = silu(xw[t] * cwv[0] + xw[t + 1] * cwv[1] + xw[t + 2] * cwv[2] + xw[t + 3] * cwv[3]);
    }
  }
  if (tid < 8) {
    const float* lg = p.logits() + (size_t)(MP + b * 8 + tid) * 16;
    const float x = lg[8 + h] + p.dt_bias[l * 8 + h];
    const float sp = softplus_f(x);
    sa[tid] = __expf(-__expf(p.a_log[l * 8 + h]) * sp);
    sbeta[tid] = sigm(lg[h]);
  }
  __syncthreads();
#pragma unroll
  for (int u = 0; u < 4; ++u) {
    const int t = wid * 2 + (u >> 1);
    float* arr = (u & 1) ? ks : qs;
    const float a0 = arr[t * 128 + lane], a1 = arr[t * 128 + 64 + lane];
    float ss = a0 * a0 + a1 * a1;
#pragma unroll
    for (int o = 1; o < 64; o <<= 1) ss += shx(ss, o, lane);
    float rn = __builtin_amdgcn_rsqf(ss + EPS);
    if (!(u & 1)) rn *= 0.08838834764831845f;
    arr[t * 128 + lane] = a0 * rn;
    arr[t * 128 + 64 + lane] = a1 * rn;
  }
  __syncthreads();
#pragma unroll 1
  for (int t = 0; t < 8; ++t) {
    const float a = sa[t], bt = sbeta[t];
    float kv = 0.f;
#pragma unroll
    for (int k4 = 0; k4 < 16; ++k4) {
      const f32x4 kk = *(const f32x4*)(ks + t * 128 + half * 64 + k4 * 4);
      S[k4 * 4 + 0] *= a; S[k4 * 4 + 1] *= a; S[k4 * 4 + 2] *= a; S[k4 * 4 + 3] *= a;
      kv += S[k4 * 4 + 0] * kk.x + S[k4 * 4 + 1] * kk.y + S[k4 * 4 + 2] * kk.z + S[k4 * 4 + 3] * kk.w;
      if ((k4 & 3) == 3) asm volatile("" ::: "memory");
    }
    part[half * 128 + dv] = kv;
    __syncthreads();
    const float delta = bt * (vs[t * 128 + dv] - (part[dv] + part[128 + dv]));
    __syncthreads();
    float o = 0.f;
#pragma unroll
    for (int k4 = 0; k4 < 16; ++k4) {
      const f32x4 kk = *(const f32x4*)(ks + t * 128 + half * 64 + k4 * 4);
      const f32x4 qq = *(const f32x4*)(qs + t * 128 + half * 64 + k4 * 4);
      S[k4 * 4 + 0] += kk.x * delta; S[k4 * 4 + 1] += kk.y * delta; S[k4 * 4 + 2] += kk.z * delta; S[k4 * 4 + 3] += kk.w * delta;
      o += S[k4 * 4 + 0] * qq.x + S[k4 * 4 + 1] * qq.y + S[k4 * 4 + 2] * qq.z + S[k4 * 4 + 3] * qq.w;
      if ((k4 & 3) == 3) asm volatile("" ::: "memory");
    }
    part[half * 128 + dv] = o;
    __syncthreads();
    if (half == 0) p.ogdn()[(size_t)(MP + b * 8 + t) * DM + h * 128 + dv] = f2bf(part[dv] + part[128 + dv]);
    __syncthreads();
  }
  float* so = p.out + O_GDNS + ((size_t)(l * 128 + b) * 8 + h) * 16384 + opq(half * 8192 + dv);
#pragma unroll
  for (int k = 0; k < 64; ++k) so[k * 128] = S[k];
  __syncthreads();
}

__device__ void gdn_sample_pair(const Params& p, int l, int pair, unsigned char* smem) {
  const int tid = (opq(threadIdx.x) & 255), lane = tid & 63, wid = tid >> 6;
  const int sub = tid >> 7, dv = tid & 127;
  const int item = pair * 2 + sub, h = item & 7, b = item >> 3;
  float* qs = (float*)smem + sub * 3104;
  float* ks = qs + 1024;
  float* vs = qs + 2048;
  float* sbeta = qs + 3072;
  float* sa = qs + 3080;
  f32x2 S2[64];
  const float* s0 = p.state_gdn + ((size_t)(l * 128 + b) * 8 + h) * 16384 + dv;
#pragma unroll
  for (int k = 0; k < 64; ++k) { S2[k].x = s0[(2 * k) * 128]; S2[k].y = s0[(2 * k + 1) * 128]; }
#pragma unroll
  for (int sect = 0; sect < 3; ++sect) {
    const int ch = sect * 1024 + h * 128 + dv;
    float xw[11], cwv[4];
#pragma unroll
    for (int j = 0; j < 4; ++j) cwv[j] = p.conv_w[(size_t)(l * 4 + j) * 3072 + ch];
#pragma unroll
    for (int j = 0; j < 3; ++j) xw[j] = p.cache_conv[((size_t)(l * 128 + b) * 3 + j) * 3072 + ch];
#pragma unroll
    for (int t = 0; t < 8; ++t) xw[3 + t] = bf2f(p.proj()[(size_t)(MP + b * 8 + t) * NPJ + ch]);
    float* dst = sect == 0 ? qs : (sect == 1 ? ks : vs);
#pragma unroll
    for (int t = 0; t < 8; ++t) dst[t * 128 + dv] = silu(xw[t] * cwv[0] + xw[t + 1] * cwv[1] + xw[t + 2] * cwv[2] + xw[t + 3] * cwv[3]);
  }
  if (dv < 8) {
    const float* lg = p.logits() + (size_t)(MP + b * 8 + dv) * 16;
    const float x = lg[8 + h] + p.dt_bias[l * 8 + h];
    sa[dv] = __expf(-__expf(p.a_log[l * 8 + h]) * softplus_f(x));
    sbeta[dv] = sigm(lg[h]);
  }
  __syncthreads();
#pragma unroll
  for (int u = 0; u < 8; ++u) {
    const int t = (wid & 1) * 4 + (u >> 1);
    float* arr = (u & 1) ? ks : qs;
    const float a0 = arr[t * 128 + lane], a1 = arr[t * 128 + 64 + lane];
    float ss = a0 * a0 + a1 * a1;
#pragma unroll
    for (int o = 1; o < 64; o <<= 1) ss += shx(ss, o, lane);
    float rn = __builtin_amdgcn_rsqf(ss + EPS);
    if (!(u & 1)) rn *= 0.08838834764831845f;
    arr[t * 128 + lane] = a0 * rn;
    arr[t * 128 + 64 + lane] = a1 * rn;
  }
  __syncthreads();
#pragma unroll 1
  for (int t = 0; t < 8; ++t) {
    const float a = sa[t], bt = sbeta[t];
    f32x2 kv2 = (f32x2){0.f, 0.f};
#pragma unroll
    for (int k4 = 0; k4 < 32; ++k4) {
      const f32x4 kk = *(const f32x4*)(ks + t * 128 + k4 * 4);
      kv2 += S2[2 * k4] * (f32x2){kk.x, kk.y};
      kv2 += S2[2 * k4 + 1] * (f32x2){kk.z, kk.w};
      if ((k4 & 3) == 3) asm volatile("" ::: "memory");
    }
    const float delta = bt * (vs[t * 128 + dv] - a * (kv2.x + kv2.y));
    const f32x2 a2 = (f32x2){a, a}, d2 = (f32x2){delta, delta};
    f32x2 o2 = (f32x2){0.f, 0.f};
#pragma unroll
    for (int k4 = 0; k4 < 32; ++k4) {
      const f32x4 kk = *(const f32x4*)(ks + t * 128 + k4 * 4);
      const f32x4 qq = *(const f32x4*)(qs + t * 128 + k4 * 4);
      S2[2 * k4] = S2[2 * k4] * a2 + (f32x2){kk.x, kk.y} * d2;
      S2[2 * k4 + 1] = S2[2 * k4 + 1] * a2 + (f32x2){kk.z, kk.w} * d2;
      o2 += S2[2 * k4] * (f32x2){qq.x, qq.y};
      o2 += S2[2 * k4 + 1] * (f32x2){qq.z, qq.w};
      if ((k4 & 3) == 3) asm volatile("" ::: "memory");
    }
    p.ogdn()[(size_t)(MP + b * 8 + t) * DM + h * 128 + dv] = f2bf(o2.x + o2.y);
  }
  float* so = p.out + O_GDNS + ((size_t)(l * 128 + b) * 8 + h) * 16384 + opq(dv);
#pragma unroll
  for (int k = 0; k < 64; ++k) { so[(2 * k) * 128] = S2[k].x; so[(2 * k + 1) * 128] = S2[k].y; }
  __syncthreads();
}

__device__ void swa_prompt_item(const Params& p, int l, int item, unsigned char* smem) {
  const int tid = (opq(threadIdx.x) & 255), lane = tid & 63, wid = tid >> 6, fr = lane & 15, fq = lane >> 4;
  const int kvh = item & 3, hb2 = (item >> 2) & 31, b = item >> 7;
  bf16_t* Ks = (bf16_t*)smem;
  bf16_t* VT = Ks + 208 * 72;
  bf16_t* Pw = VT + 64 * 216 + wid * 16 * 168;
  const int tk0 = hb2 * 64 - 128;
  u32x4 krw[7], vrw[7];
#pragma unroll
  for (int i = 0; i < 7; ++i) {
    const int pc = tid + i * NTHR, kj = pc >> 3, c8 = pc & 7, tk = tk0 + kj;
    krw[i] = (u32x4){0u, 0u, 0u, 0u}; vrw[i] = (u32x4){0u, 0u, 0u, 0u};
    if (pc < 208 * 8 && kj < 192 && tk >= 0) {
      const bf16_t* base = p.proj() + (size_t)(b * 2048 + tk) * NPJ + kvh * 64 + c8 * 8;
      krw[i] = *(const u32x4*)(base + C_SK); vrw[i] = *(const u32x4*)(base + C_SV);
    }
  }
#pragma unroll
  for (int i = 0; i < 7; ++i) {
    const int pc = tid + i * NTHR;
    if (pc >= 208 * 8) break;
    const int kj = pc >> 3, c8 = pc & 7, tk = tk0 + kj;
    const bool ok = kj < 192 && tk >= 0;
    float kf[8], vf[8];
    UNPACK8(krw[i], kf);
    UNPACK8(vrw[i], vf);
    float ss = 0.f;
#pragma unroll
    for (int c = 0; c < 8; ++c) ss += kf[c] * kf[c];
    ss += shx(ss, 1, lane); ss += shx(ss, 2, lane); ss += shx(ss, 4, lane);
    const float rn = __builtin_amdgcn_rsqf(ss * (1.f / 64.f) + EPS);
    const f32x4 w0 = *(const f32x4*)(p.k_norm + l * 64 + c8 * 8), w1 = *(const f32x4*)(p.k_norm + l * 64 + c8 * 8 + 4);
    kf[0] *= rn * w0.x; kf[1] *= rn * w0.y; kf[2] *= rn * w0.z; kf[3] *= rn * w0.w;
    kf[4] *= rn * w1.x; kf[5] *= rn * w1.y; kf[6] *= rn * w1.z; kf[7] *= rn * w1.w;
    *(u32x4*)(Ks + kj * 72 + c8 * 8) = (u32x4){pk2(kf[0], kf[1]), pk2(kf[2], kf[3]), pk2(kf[4], kf[5]), pk2(kf[6], kf[7])};
#pragma unroll
    for (int c = 0; c < 8; ++c) VT[(c8 * 8 + c) * 216 + kj] = f2bf(vf[c]);
    if (ok && tk >= 1920 && kj >= 128) {
      float* ko = p.out + O_KP + (((size_t)(l * 8 + b) * 128 + (tk - 1920)) * 4 + kvh) * 64 + c8 * 8;
      float* vo = p.out + O_VP + (((size_t)(l * 8 + b) * 128 + (tk - 1920)) * 4 + kvh) * 64 + c8 * 8;
      *(f32x4*)ko = (f32x4){kf[0], kf[1], kf[2], kf[3]};
      *(f32x4*)(ko + 4) = (f32x4){kf[4], kf[5], kf[6], kf[7]};
      *(f32x4*)vo = (f32x4){vf[0], vf[1], vf[2], vf[3]};
      *(f32x4*)(vo + 4) = (f32x4){vf[4], vf[5], vf[6], vf[7]};
    }
  }
  __syncthreads();
  const int kbase = wid * 16;
  const int ql = wid * 16 + fr;
  const size_t qrow = (size_t)b * 2048 + hb2 * 64 + ql;
  u32x4 qraw[4][2];
#pragma unroll
  for (int g = 0; g < 4; ++g) {
    const bf16_t* qp = p.proj() + qrow * NPJ + C_SQ + (kvh * 4 + g) * 64 + fq * 8;
    qraw[g][0] = *(const u32x4*)qp; qraw[g][1] = *(const u32x4*)(qp + 32);
  }
#pragma unroll
  for (int g = 0; g < 4; ++g) {
    const int head = kvh * 4 + g;
    const float slope = exp2f(-0.5f * (float)(head + 1));
    const float sink = p.sinks[l * 16 + head];
    bf16x8 qf[2];
    {
      const u32x4 r0 = qraw[g][0], r1 = qraw[g][1];
      float f0[8], f1[8];
      UNPACK8(r0, f0);
      UNPACK8(r1, f1);
      float ss = 0.f;
#pragma unroll
      for (int c = 0; c < 8; ++c) ss += f0[c] * f0[c] + f1[c] * f1[c];
      ss += shx(ss, 16, lane); ss += shx(ss, 32, lane);
      const float rn = __builtin_amdgcn_rsqf(ss * (1.f / 64.f) + EPS) * 0.125f;
      const float* qn = p.q_norm + l * 64 + fq * 8;
#pragma unroll
      for (int c = 0; c < 8; ++c) { f0[c] *= rn * qn[c]; f1[c] *= rn * qn[32 + c]; }
      qf[0] = as_bf((u32x4){pk2(f0[0], f0[1]), pk2(f0[2], f0[3]), pk2(f0[4], f0[5]), pk2(f0[6], f0[7])});
      qf[1] = as_bf((u32x4){pk2(f1[0], f1[1]), pk2(f1[2], f1[3]), pk2(f1[4], f1[5]), pk2(f1[6], f1[7])});
    }
    f32x4 sc[9];
    float mx = sink;
#pragma unroll
    for (int kt = 0; kt < 9; ++kt) {
      f32x4 a = (f32x4){0.f, 0.f, 0.f, 0.f};
#pragma unroll
      for (int ks = 0; ks < 2; ++ks) {
        const bf16x8 kf = *(const bf16x8*)(Ks + (kbase + kt * 16 + fr) * 72 + ks * 32 + fq * 8);
        a = mfma16(kf, qf[ks], a);
      }
#pragma unroll
      for (int jj = 0; jj < 4; ++jj) {
        const int kj = kbase + kt * 16 + fq * 4 + jj;
        const int dist = ql + 128 - kj;
        const bool ok = dist >= 0 && dist <= 128 && (tk0 + kj) >= 0;
        const float s = ok ? a[jj] - slope * (float)dist : -INFINITY;
        a[jj] = s;
        mx = fmaxf(mx, s);
      }
      sc[kt] = a;
    }
    mx = fmaxf(mx, shx(mx, 16, lane));
    mx = fmaxf(mx, shx(mx, 32, lane));
    float sum = 0.f;
#pragma unroll
    for (int kt = 0; kt < 9; ++kt) {
      f32x4 e;
#pragma unroll
      for (int jj = 0; jj < 4; ++jj) { e[jj] = __expf(sc[kt][jj] - mx); sum += e[jj]; }
      *(u32x2*)(Pw + fr * 168 + kt * 16 + fq * 4) = (u32x2){pk2(e.x, e.y), pk2(e.z, e.w)};
    }
    *(u32x2*)(Pw + fr * 168 + 144 + fq * 4) = (u32x2){0u, 0u};
    sum += shx(sum, 16, lane);
    sum += shx(sum, 32, lane);
    const float inv = __builtin_amdgcn_rcpf(sum + __expf(sink - mx));
    __builtin_amdgcn_wave_barrier();
#pragma unroll
    for (int dt = 0; dt < 4; ++dt) {
      f32x4 a = (f32x4){0.f, 0.f, 0.f, 0.f};
#pragma unroll
      for (int ks = 0; ks < 5; ++ks) {
        const bf16x8 vf = *(const bf16x8*)(VT + (dt * 16 + fr) * 216 + kbase + ks * 32 + fq * 8);
        const bf16x8 pf = *(const bf16x8*)(Pw + fr * 168 + ks * 32 + fq * 8);
        a = mfma16(vf, pf, a);
      }
      a *= inv;
      *(u32x2*)(p.oswa() + qrow * DM + head * 64 + dt * 16 + fq * 4) = (u32x2){pk2(a.x, a.y), pk2(a.z, a.w)};
    }
    __builtin_amdgcn_wave_barrier();
  }
  __syncthreads();
}

__device__ void swa_sample_item(const Params& p, int l, int item, unsigned char* smem) {
  const int tid = (opq(threadIdx.x) & 255), lane = tid & 63, wid = tid >> 6;
  const int kvh = item & 3, b = item >> 2;
  float* Ks = (float*)smem;
  float* Vs = Ks + 136 * 68;
  float* Qs = Vs + 136 * 64;
  float* Sc = Qs + 512;
  const size_t cbase = (size_t)(l * 128 + b) * 128;
  f32x4 kvr[8], vvr[8];
#pragma unroll
  for (int i = 0; i < 8; ++i) {
    const int idx = tid + i * NTHR, j = idx >> 4, c4 = idx & 15;
    kvr[i] = *(const f32x4*)(p.cache_k + ((cbase + j) * 4 + kvh) * 64 + c4 * 4);
    vvr[i] = *(const f32x4*)(p.cache_v + ((cbase + j) * 4 + kvh) * 64 + c4 * 4);
  }
  unsigned qrw[4];
#pragma unroll
  for (int g = 0; g < 4; ++g) qrw[g] = *(const unsigned*)(p.proj() + (size_t)(MP + b * 8 + (tid >> 5)) * NPJ + C_SQ + (kvh * 4 + g) * 64 + (tid & 31) * 2);
#pragma unroll
  for (int i = 0; i < 8; ++i) {
    const int idx = tid + i * NTHR, j = idx >> 4, c4 = idx & 15;
    const f32x4 kv = kvr[i], vv = vvr[i];
    *(f32x4*)(Ks + j * 68 + c4 * 4) = kv;
    *(f32x4*)(Vs + j * 64 + c4 * 4) = vv;
  }
  {
    const int t = tid >> 5, d = (tid & 31) * 2;
    const bf16_t* base = p.proj() + (size_t)(MP + b * 8 + t) * NPJ + kvh * 64 + d;
    const unsigned kr = *(const unsigned*)(base + C_SK), vr = *(const unsigned*)(base + C_SV);
    float k0 = lo2f(kr), k1 = hi2f(kr);
    float ss = k0 * k0 + k1 * k1;
#pragma unroll
    for (int o = 1; o < 32; o <<= 1) ss += shx(ss, o, lane);
    const float rn = __builtin_amdgcn_rsqf(ss * (1.f / 64.f) + EPS);
    Ks[(128 + t) * 68 + d] = k0 * rn * p.k_norm[l * 64 + d];
    Ks[(128 + t) * 68 + d + 1] = k1 * rn * p.k_norm[l * 64 + d + 1];
    Vs[(128 + t) * 64 + d] = lo2f(vr);
    Vs[(128 + t) * 64 + d + 1] = hi2f(vr);
  }
  __syncthreads();
  for (int idx = tid; idx < 128 * 64; idx += NTHR) {
    const int j = idx >> 6, d = idx & 63;
    p.out[O_KS + ((cbase + j) * 4 + kvh) * 64 + d] = Ks[(j + 8) * 68 + d];
    p.out[O_VS + ((cbase + j) * 4 + kvh) * 64 + d] = Vs[(j + 8) * 64 + d];
  }
#pragma unroll
  for (int g = 0; g < 4; ++g) {
    const int head = kvh * 4 + g;
    const float slope = exp2f(-0.5f * (float)(head + 1));
    const float sink = p.sinks[l * 16 + head];
    {
      const int t = tid >> 5, d = (tid & 31) * 2;
      const unsigned qr = qrw[g];
      const float q0 = lo2f(qr), q1 = hi2f(qr);
      float ss = q0 * q0 + q1 * q1;
#pragma unroll
      for (int o = 1; o < 32; o <<= 1) ss += shx(ss, o, lane);
      const float rn = __builtin_amdgcn_rsqf(ss * (1.f / 64.f) + EPS) * 0.125f;
      Qs[t * 64 + d] = q0 * rn * p.q_norm[l * 64 + d];
      Qs[t * 64 + d + 1] = q1 * rn * p.q_norm[l * 64 + d + 1];
    }
    __syncthreads();
    for (int idx = tid; idx < 8 * 136; idx += NTHR) {
      const int tq = idx / 136, j = idx % 136;
      float s = 0.f;
#pragma unroll
      for (int d4 = 0; d4 < 16; ++d4) {
        const f32x4 qv = *(const f32x4*)(Qs + tq * 64 + d4 * 4), kq = *(const f32x4*)(Ks + j * 68 + d4 * 4);
        s += (qv.x * kq.x + qv.y * kq.y) + (qv.z * kq.z + qv.w * kq.w);
      }
      const int dist = tq + 128 - j;
      Sc[tq * 136 + j] = (dist >= 0 && dist <= 128) ? s - slope * (float)dist : -INFINITY;
    }
    __syncthreads();
#pragma unroll
    for (int u = 0; u < 2; ++u) {
      const int tq = wid * 2 + u;
      const float s0 = Sc[tq * 136 + lane], s1 = Sc[tq * 136 + 64 + lane], s2 = lane < 8 ? Sc[tq * 136 + 128 + lane] : -INFINITY;
      float mx = fmaxf(fmaxf(s0, s1), fmaxf(s2, sink));
#pragma unroll
      for (int o = 1; o < 64; o <<= 1) mx = fmaxf(mx, shx(mx, o, lane));
      const float e0 = __expf(s0 - mx), e1 = __expf(s1 - mx), e2 = __expf(s2 - mx);
      float sum = e0 + e1 + e2;
#pragma unroll
      for (int o = 1; o < 64; o <<= 1) sum += shx(sum, o, lane);
      const float inv = __builtin_amdgcn_rcpf(sum + __expf(sink - mx));
      Sc[tq * 136 + lane] = e0 * inv;
      Sc[tq * 136 + 64 + lane] = e1 * inv;
      if (lane < 8) Sc[tq * 136 + 128 + lane] = e2 * inv;
    }
    __syncthreads();
    {
      const int tq = tid >> 5, d = (tid & 31) * 2;
      float o0 = 0.f, o1 = 0.f;
#pragma unroll 2
      for (int j4 = 0; j4 < 34; ++j4) {
        const f32x4 pj = *(const f32x4*)(Sc + tq * 136 + j4 * 4);
        const f32x2 va = *(const f32x2*)(Vs + (j4 * 4 + 0) * 64 + d), vb = *(const f32x2*)(Vs + (j4 * 4 + 1) * 64 + d);
        const f32x2 vc = *(const f32x2*)(Vs + (j4 * 4 + 2) * 64 + d), vd = *(const f32x2*)(Vs + (j4 * 4 + 3) * 64 + d);
        o0 += (pj.x * va.x + pj.y * vb.x) + (pj.z * vc.x + pj.w * vd.x);
        o1 += (pj.x * va.y + pj.y * vb.y) + (pj.z * vc.y + pj.w * vd.y);
      }
      *(unsigned*)(p.oswa() + (size_t)(MP + b * 8 + tq) * DM + head * 64 + d) = pk2(o0, o1);
    }
    __syncthreads();
  }
}

__device__ void phase_mix(const Params& p, int l) {
  const int tid = (opq(threadIdx.x) & 255), lane = tid & 63, wid = tid >> 6, fr = lane & 15, fq = lane >> 4;
  for (int it = VB; it < MTOK / 4; it += VG) {
    const size_t row = (size_t)it * 4 + wid;
#pragma unroll
    for (int ps = 0; ps < 2; ++ps) {
      const int ch = (ps * 4 + fq) * 128 + fr * 8;
      const u32x4 og = *(const u32x4*)(p.ogdn() + row * DM + ch);
      const u32x4 ob = *(const u32x4*)(p.oswa() + row * DM + ch);
      const u32x4 zz = *(const u32x4*)(p.proj() + row * NPJ + C_Z + ch);
      const u32x4 ga = *(const u32x4*)(p.proj() + row * NPJ + C_G + ch);
      const u32x4 gb = *(const u32x4*)(p.proj() + row * NPJ + C_G + 1024 + ch);
      float fo[8], fb[8], fz[8], fa[8], fg[8];
      UNPACK8(og, fo); UNPACK8(ob, fb); UNPACK8(zz, fz); UNPACK8(ga, fa); UNPACK8(gb, fg);
      float ss = 0.f;
#pragma unroll
      for (int c = 0; c < 8; ++c) ss += fo[c] * fo[c];
      ss += shx(ss, 1, lane); ss += shx(ss, 2, lane); ss += shx(ss, 4, lane); ss += shx(ss, 8, lane);
      const float rn = __builtin_amdgcn_rsqf(ss * (1.f / 128.f) + EPS);
      const f32x4 w0 = *(const f32x4*)(p.gdn_norm + l * 128 + fr * 8), w1 = *(const f32x4*)(p.gdn_norm + l * 128 + fr * 8 + 4);
      const float wn[8] = {w0.x, w0.y, w0.z, w0.w, w1.x, w1.y, w1.z, w1.w};
      float m[8];
#pragma unroll
      for (int c = 0; c < 8; ++c) m[c] = sigm(fa[c]) * (fo[c] * rn * wn[c] * silu(fz[c])) + sigm(fg[c]) * fb[c];
      *(u32x4*)(p.mix() + row * DM + ch) = (u32x4){pk2(m[0], m[1]), pk2(m[2], m[3]), pk2(m[4], m[5]), pk2(m[6], m[7])};
    }
  }
  const int NC = (8 + 128) * 3 * 3072;
  for (int i = VB * NTHR + tid; i < NC; i += VG * NTHR) {
    const int c = i % 3072, r = (i / 3072) % 3, bb = i / 9216;
    if (bb < 8) p.out[O_CONVP + ((size_t)(l * 8 + bb) * 3 + r) * 3072 + c] = bf2f(p.proj()[(size_t)(bb * 2048 + 2045 + r) * NPJ + c]);
    else p.out[O_CONVS + ((size_t)(l * 128 + bb - 8) * 3 + r) * 3072 + c] = bf2f(p.proj()[(size_t)(MP + (bb - 8) * 8 + 5 + r) * NPJ + c]);
  }
}

#define XB_TMO      128
#define XB_XCNT(j)  (256  + 64 * (j))
#define XB_XSUB(j)  (1280 + 64 * (j))
#define XB_XGEN(j)  (2304 + 64 * (j))
#define XB_TOP      3328
#define XB_TOPGEN   3392
#define XCD_BAR_WORDS 3456
#define XB_SPIN_CAP (1u << 18)
#define LAS __attribute__((address_space(3)))

__device__ __forceinline__ unsigned xb_ld(unsigned* p)              { return __hip_atomic_load(p, __ATOMIC_RELAXED, __HIP_MEMORY_SCOPE_AGENT); }
__device__ __forceinline__ unsigned xb_add(unsigned* p, unsigned v) { return __hip_atomic_fetch_add(p, v, __ATOMIC_RELAXED, __HIP_MEMORY_SCOPE_AGENT); }
__device__ __forceinline__ unsigned xb_xcc_id() { return (unsigned)__builtin_amdgcn_s_getreg((3 << 11) | 20) & 0xFu; }
#define XB_SPIN(cond, bar) do { unsigned _sp = 0; while (cond) { __builtin_amdgcn_s_sleep(1); \
    if ((++_sp & 255u) == 0u) { if (xb_ld(&(bar)[XB_TMO])) break; if (_sp > XB_SPIN_CAP) { atomicAdd(&(bar)[XB_TMO], 1u); break; } } } } while (0)

struct XcdBarrier {
    unsigned* bar; unsigned x;
    volatile LAS unsigned* st;
};

__device__ __forceinline__ XcdBarrier xcd_barrier_post(unsigned* bar, volatile LAS unsigned* st) {
    XcdBarrier b; b.bar = bar; b.x = xb_xcc_id(); b.st = st;
    if (threadIdx.x == 0) (void)xb_add(&bar[XB_XCNT(b.x)], 1u);
    return b;
}
__device__ __forceinline__ void xcd_barrier_complete(unsigned* bar, unsigned x, unsigned& nloc, unsigned& nx) {
    const unsigned G = gridDim.x * gridDim.y * gridDim.z;
    unsigned sum, cnt, mine, sp = 0u;
    for (;;) {
        sum = 0u; cnt = 0u; mine = 0u;
#pragma unroll
        for (unsigned j = 0; j < 16; ++j) { const unsigned c = xb_ld(&bar[XB_XCNT(j)]); sum += c; cnt += (c > 0u) ? 1u : 0u; mine = (j == x) ? c : mine; }
        if (sum == G) break;
        __builtin_amdgcn_s_sleep(1);
        if ((++sp & 255u) == 0u) { if (xb_ld(&bar[XB_TMO])) break; if (sp > XB_SPIN_CAP) { atomicAdd(&bar[XB_TMO], 1u); break; } }
    }
    nloc = mine > 0u ? mine : 1u; nx = cnt > 0u ? cnt : 1u;
}

__device__ __forceinline__ void xcd_barrier(const XcdBarrier& b) {
    asm volatile("s_waitcnt vmcnt(0)" ::: "memory");
    __syncthreads();
    if (threadIdx.x == 0) {
        unsigned* bar = b.bar;
        __builtin_amdgcn_s_waitcnt(0);
        unsigned nloc = b.st[0], nx = b.st[1];
        if (nloc == 0u) { xcd_barrier_complete(bar, b.x, nloc, nx); b.st[0] = nloc; b.st[1] = nx; }
        const unsigned old = xb_add(&bar[XB_XSUB(b.x)], 1u);
        const unsigned gen = old / nloc;
        if (old + 1u == (gen + 1u) * nloc) {
            __builtin_amdgcn_fence(__ATOMIC_RELEASE, "agent");
            asm volatile("s_waitcnt vmcnt(0)" ::: "memory");
            const unsigned og = xb_add(&bar[XB_TOP], 1u);
            const unsigned tg = og / nx;
            if (og + 1u == (tg + 1u) * nx) xb_add(&bar[XB_TOPGEN], 1u);
            else XB_SPIN(xb_ld(&bar[XB_TOPGEN]) == tg, bar);
            __builtin_amdgcn_fence(__ATOMIC_ACQUIRE, "agent");
            xb_add(&bar[XB_XGEN(b.x)], 1u);
            asm volatile("s_waitcnt vmcnt(0)" ::: "memory");
        } else {
            XB_SPIN(xb_ld(&bar[XB_XGEN(b.x)]) == gen, bar);
            __builtin_amdgcn_fence(__ATOMIC_ACQUIRE, "agent");
            asm volatile("s_waitcnt vmcnt(0)" ::: "memory");
        }
    }
    __syncthreads();
}


#define NPHASE_PRE 2
#define NPHASE_L 8
constexpr int LDS_TOTAL = 2 * SMEM_BYTES;
__global__ void __launch_bounds__(512, 2) mega(Params p, int ph_lo, int ph_hi) {
  extern __shared__ __attribute__((aligned(16))) unsigned char lds_all[];
  if (ph_hi < 0) cg::this_grid().sync();
  __shared__ uint4 xb_words;
  if (threadIdx.x == 0) xb_words = make_uint4(0u, 0u, 0u, 0u);
  __syncthreads();
  XcdBarrier xb = xcd_barrier_post(p.bar(), (volatile LAS unsigned*)&xb_words);
  unsigned char* smem = lds_all + VHALF * SMEM_BYTES;
  for (int ph = ph_lo; ph < ph_hi; ++ph) {
    if (ph > ph_lo) xcd_barrier(xb);
    if (ph == 0) { phase_p0(p, smem); continue; }
    if (ph == 1) {
      {
        EpiArgs e{};
        e.obf = p.pp(); e.ldo = DM;
        DiagSched S; S.nLimit = 1024; S.G = gridDim.x; S.c = blockIdx.x;
        pg8::Gemm g; g.A = p.pb(); g.Bt = p.wt_proj(); g.M = NL * MTOK; g.N = NL * DM; g.K = PLE;
        BigEpi<EPI_PP> E; E.e = e;
        pg8::gemm_phase<BigEpi<EPI_PP>, DiagSched>((PG8_LAS unsigned char*)lds_all, g, S, E, nullptr);
        __syncthreads();
      }
      for (int st = VB; st < 64 * 16; st += VG) {
        const int L = 1024 + (st >> 4), sub = st & 15, l = L / 272, r = L - l * 272, pm = r >> 2, pn = r & 3;
        EpiArgs e{};
        e.obf = p.pp() + (size_t)l * MTOK * DM; e.ldo = DM;
        gemm_tile<1, 4, 4, 1, EPI_PP, 128>(p.pb() + (size_t)l * MTOK * PLE, PLE, p.wt_proj() + (size_t)l * DM * PLE, PLE, PLE, pm * 256 + (sub >> 2) * 64, pn * 256 + (sub & 3) * 64, (bf16_t*)smem, e);
      }
      continue;
    }
    const int l = (ph - NPHASE_PRE) / NPHASE_L, s = (ph - NPHASE_PRE) % NPHASE_L;
#ifndef REPMASK
#define REPMASK 0
#endif
    for (int rep = 0; rep < (((REPMASK >> s) & 1) ? 2 : 1); ++rep) {
    if (rep) xcd_barrier(xb);
    switch (s) {
      case 0: {
        EpiArgs e{};
        e.ssq_in = p.ssq0(); e.obf = p.proj(); e.ldo = NPJ; e.of32 = p.logits();
        const bf16_t* Bt = p.wt_in() + (size_t)l * NIN * DM;
        gemm_big_phase<EPI_PROJ>(p.hb(), Bt, DM, MTOK, NPJ, lds_all, smem, e);
        for (int t = VB; t < 272; t += VG)
          gemm_tile<1, 1, 4, 1, EPI_LOGIT, 128>(p.hb(), DM, Bt + (size_t)NPJ * DM, DM, DM, t * 64, 0, (bf16_t*)smem, e);
      } break;
      case 1: {
        const int nB1 = VG == 512 ? 3072 : 3584;
        for (int t = VB; t < nB1; t += VG) {
          if (t < 2048) gdn_prep_item(p, l, t, smem);
          else if (t < 3072) swa_prompt_item(p, l, t - 2048, smem);
          else swa_sample_item(p, l, t - 3072, smem);
        }
      } break;
      case 2: {
        if (VG == 512) {
          if (VB < 256) gdn_scan_item(p, l, VB, smem);
          else {
            gdn_sample_pair(p, l, VB - 256, smem); gdn_sample_pair(p, l, VB, smem);
            swa_sample_item(p, l, (VB - 256) * 2, smem); swa_sample_item(p, l, (VB - 256) * 2 + 1, smem);
          }
        } else {
          for (int t = VB; t < 256 + 512; t += VG) {
            if (t < 256) gdn_scan_item(p, l, t, smem);
            else gdn_sample_pair(p, l, t - 256, smem);
          }
        }
      } break;
      case 3: phase_mix(p, l); break;
      case 4: {
        EpiArgs e{};
        e.h = p.out; e.hb = p.hb2(); e.ssq_out = p.ssq1();
        gemm_big_phase<EPI_RESID>(p.mix(), p.wt_out() + (size_t)l * DM * DM, DM, MTOK, DM, lds_all, smem, e);
      } break;
      case 5: {
        EpiArgs e{};
        e.ssq_in = p.ssq1(); e.obf = p.proj(); e.ldo = DFF;
        gemm_big_phase<EPI_UP>(p.hb2(), p.wt_up() + (size_t)l * DFF * DM, DM, MTOK, DFF, lds_all, smem, e);
      } break;
      case 6: {
        EpiArgs e{};
        e.h = p.out; e.hb = p.hb2(); e.ssq_out = p.ssq2();
        gemm_big_phase<EPI_RESID>(p.proj(), p.wt_down() + (size_t)l * DM * DFF, DFF, MTOK, DM, lds_all, smem, e);
      } break;
      case 7: {
        EpiArgs e{};
        e.h = p.out; e.hb = p.hb(); e.ssq_in = p.ssq2(); e.ssq_out = p.ssq0(); e.pp = p.pp() + (size_t)l * MTOK * DM;
        gemm_big_phase<EPI_PLE>(p.hb2(), p.wt_gate() + (size_t)l * DM * DM, DM, MTOK, DM, lds_all, smem, e);
      } break;
    }
    }
  }
}

extern "C" void kernel_launch(void* const* d_in, const int* in_sizes, int n_in, void* d_out, int out_size, void* d_ws, size_t ws_size,
                              hipStream_t stream) {
  Params p{};
  const float* const* in = (const float* const*)d_in;
  p.x_prompt = in[0]; p.x_sample = in[1]; p.cache_conv = in[2]; p.state_gdn = in[3]; p.cache_k = in[4]; p.cache_v = in[5];
  p.p_prompt = in[6]; p.p_sample = in[7]; p.norm_mix = in[8]; p.w_in = in[9]; p.conv_w = in[10]; p.a_log = in[11]; p.dt_bias = in[12];
  p.gdn_norm = in[13]; p.q_norm = in[14]; p.k_norm = in[15]; p.sinks = in[16]; p.w_out = in[17]; p.norm_ffn = in[18]; p.w_up = in[19];
  p.w_down = in[20]; p.norm_ple = in[21]; p.w_gate = in[22]; p.w_proj = in[23];
  p.out = (float*)d_out;
  p.ws = (unsigned char*)d_ws;
  if (WS_TOTAL > ws_size) { fprintf(stderr, "workspace too small: need %zu have %zu\n", (size_t)WS_TOTAL, ws_size); return; }

  static int grid_blocks = 0;
  if (!grid_blocks) {
    int dev = 0, cus = 0, per_cu = 0;
    (void)hipGetDevice(&dev);
    (void)hipDeviceGetAttribute(&cus, hipDeviceAttributeMultiprocessorCount, dev);
    if (hipFuncSetAttribute((const void*)mega, hipFuncAttributeMaxDynamicSharedMemorySize, LDS_TOTAL) != hipSuccess) { fprintf(stderr, "hipFuncSetAttribute(dynamic LDS %d) failed\n", LDS_TOTAL); grid_blocks = -1; return; }
    (void)hipOccupancyMaxActiveBlocksPerMultiprocessor(&per_cu, (const void*)mega, 512, LDS_TOTAL);
    (void)hipGetLastError();
    grid_blocks = cus;
  }
  if (grid_blocks < 0) return;
  (void)hipMemsetAsync(p.ws + WO_bar, 0, (size_t)XCD_BAR_WORDS * 4, stream);
  int lo = 0, hi = NPHASE_PRE + NL * NPHASE_L;
  void* args[] = {&p, &lo, &hi};
  hipError_t e = hipLaunchCooperativeKernel((void*)mega, dim3(grid_blocks), dim3(512), args, LDS_TOTAL, stream);
  if (e != hipSuccess) fprintf(stderr, "cooperative launch failed: %s (grid %d)\n", hipGetErrorString(e), grid_blocks);
}
```

```cpp
#include <hip/hip_runtime.h>
#include <hip/hip_cooperative_groups.h>
#include <cstdio>
namespace cg = cooperative_groups;

typedef unsigned short bf16_t;
typedef short bf16x8 __attribute__((ext_vector_type(8)));
typedef float f32x4 __attribute__((ext_vector_type(4)));
typedef float f32x2 __attribute__((ext_vector_type(2)));
typedef unsigned u32x4 __attribute__((ext_vector_type(4)));
typedef unsigned u32x2 __attribute__((ext_vector_type(2)));

#define DEVI __device__ __forceinline__
DEVI int opq(int x) { asm volatile("" : "+v"(x)); return x; }

#define VHALF ((int)__builtin_amdgcn_readfirstlane((int)(threadIdx.x >> 8)))
#define VB ((int)blockIdx.x * 2 + VHALF)
#define VG ((int)gridDim.x * 2)
constexpr int NL = 4;
constexpr int MTOK = 17408, MP = 16384, MS = 1024;
constexpr int DM = 1024, NIN = 7696, NPJ = 7680, DFF = 4096, PLE = 256;
constexpr int C_Z = 3072, C_SQ = 4096, C_SK = 5120, C_SV = 5376, C_G = 5632;
constexpr float EPS = 1e-6f;
constexpr int NTHR = 256;
constexpr int SMEM_BYTES = 79872;
constexpr size_t SCR_ITEM = 73728;

constexpr size_t O_YP = 0, O_YS = 16777216, O_CONVP = 17825792, O_GDNP = 18120704, O_KP = 22315008, O_VP = 23363584,
                 O_CONVS = 24412160, O_GDNS = 29130752, O_KS = 96239616, O_VS = 113016832, O_END = 129794048;

constexpr size_t al256(size_t x) { return (x + 255) & ~(size_t)255; }
constexpr size_t WO_wt_in = 0;
constexpr size_t WO_wt_out = WO_wt_in + al256((size_t)NL * NIN * DM * 2);
constexpr size_t WO_wt_up = WO_wt_out + al256((size_t)NL * DM * DM * 2);
constexpr size_t WO_wt_down = WO_wt_up + al256((size_t)NL * DFF * DM * 2);
constexpr size_t WO_wt_gate = WO_wt_down + al256((size_t)NL * DM * DFF * 2);
constexpr size_t WO_wt_proj = WO_wt_gate + al256((size_t)NL * DM * DM * 2);
constexpr size_t WO_hb = WO_wt_proj + al256((size_t)NL * DM * PLE * 2);
constexpr size_t WO_hb2 = WO_hb + al256((size_t)MTOK * DM * 2);
constexpr size_t WO_proj = WO_hb2 + al256((size_t)MTOK * DM * 2);
constexpr size_t WO_scr = WO_proj + al256((size_t)MTOK * NPJ * 2);
constexpr size_t WO_ogdn = WO_scr + al256((size_t)2048 * SCR_ITEM);
constexpr size_t WO_oswa = WO_ogdn + al256((size_t)MTOK * DM * 2);
constexpr size_t WO_mix = WO_oswa + al256((size_t)MTOK * DM * 2);
constexpr size_t WO_pb = WO_mix + al256((size_t)MTOK * DM * 2);
constexpr size_t WO_pp = WO_pb + al256((size_t)NL * MTOK * PLE * 2);
constexpr size_t WO_ssq0 = WO_pp + al256((size_t)NL * MTOK * DM * 2);
constexpr size_t WO_ssq1 = WO_ssq0 + al256((size_t)MTOK * 16 * 4);
constexpr size_t WO_ssq2 = WO_ssq1 + al256((size_t)MTOK * 16 * 4);
constexpr size_t WO_logits = WO_ssq2 + al256((size_t)MTOK * 16 * 4);
constexpr size_t WO_gsc = WO_logits + al256((size_t)MTOK * 16 * 4);
constexpr size_t WO_bar = WO_gsc + al256((size_t)2048 * 4);
constexpr size_t WS_TOTAL = WO_bar + al256((size_t)3456 * 4);
struct Params {
  const float *x_prompt, *x_sample, *cache_conv, *state_gdn, *cache_k, *cache_v, *p_prompt, *p_sample;
  const float *norm_mix, *w_in, *conv_w, *a_log, *dt_bias, *gdn_norm, *q_norm, *k_norm, *sinks, *w_out, *norm_ffn, *w_up, *w_down,
      *norm_ple, *w_gate, *w_proj;
  float* out;
  unsigned char* ws;
  DEVI bf16_t* wt_in() const { return (bf16_t*)(ws + WO_wt_in); }
  DEVI bf16_t* wt_out() const { return (bf16_t*)(ws + WO_wt_out); }
  DEVI bf16_t* wt_up() const { return (bf16_t*)(ws + WO_wt_up); }
  DEVI bf16_t* wt_down() const { return (bf16_t*)(ws + WO_wt_down); }
  DEVI bf16_t* wt_gate() const { return (bf16_t*)(ws + WO_wt_gate); }
  DEVI bf16_t* wt_proj() const { return (bf16_t*)(ws + WO_wt_proj); }
  DEVI bf16_t* hb() const { return (bf16_t*)(ws + WO_hb); }
  DEVI bf16_t* hb2() const { return (bf16_t*)(ws + WO_hb2); }
  DEVI bf16_t* proj() const { return (bf16_t*)(ws + WO_proj); }
  DEVI bf16_t* scr() const { return (bf16_t*)(ws + WO_scr); }
  DEVI bf16_t* ogdn() const { return (bf16_t*)(ws + WO_ogdn); }
  DEVI bf16_t* oswa() const { return (bf16_t*)(ws + WO_oswa); }
  DEVI bf16_t* mix() const { return (bf16_t*)(ws + WO_mix); }
  DEVI bf16_t* pb() const { return (bf16_t*)(ws + WO_pb); }
  DEVI bf16_t* pp() const { return (bf16_t*)(ws + WO_pp); }
  DEVI float* ssq0() const { return (float*)(ws + WO_ssq0); }
  DEVI float* ssq1() const { return (float*)(ws + WO_ssq1); }
  DEVI float* ssq2() const { return (float*)(ws + WO_ssq2); }
  DEVI float* logits() const { return (float*)(ws + WO_logits); }
  DEVI float* gsc() const { return (float*)(ws + WO_gsc); }
  DEVI unsigned* bar() const { return (unsigned*)(ws + WO_bar); }
};

DEVI float shx(float v, int m, int ln) { return __builtin_bit_cast(float, __builtin_amdgcn_ds_bpermute((ln ^ m) << 2, __builtin_bit_cast(int, v))); }
DEVI float shup(float v, int o, int ln) { return __builtin_bit_cast(float, __builtin_amdgcn_ds_bpermute((ln >= o ? ln - o : ln) << 2, __builtin_bit_cast(int, v))); }
DEVI float lo2f(unsigned u) { return __uint_as_float(u << 16); }
DEVI float hi2f(unsigned u) { return __uint_as_float(u & 0xffff0000u); }
DEVI float bf2f(bf16_t v) { return __uint_as_float(((unsigned)v) << 16); }
typedef __bf16 bf16x2_t __attribute__((ext_vector_type(2)));
DEVI unsigned pk2(float lo, float hi) { const f32x2 v = {lo, hi}; const bf16x2_t r = __builtin_convertvector(v, bf16x2_t); return __builtin_bit_cast(unsigned, r); }
DEVI bf16_t f2bf(float f) { return (bf16_t)(pk2(f, 0.f) & 0xffffu); }
DEVI float sigm(float x) { return __builtin_amdgcn_rcpf(1.f + __expf(-x)); }
DEVI float silu(float x) { return x * sigm(x); }
DEVI float softplus_f(float x) {
  const float e = __expf(x);
  return x > 20.f ? x : (e < 0.01f ? e * (1.f - 0.5f * e + 0.33333334f * e * e) : __logf(1.f + e));
}
DEVI f32x4 mfma16(bf16x8 a, bf16x8 b, f32x4 c) { return __builtin_amdgcn_mfma_f32_16x16x32_bf16(a, b, c, 0, 0, 0); }
DEVI bf16x8 as_bf(u32x4 v) { return __builtin_bit_cast(bf16x8, v); }
#define UNPACK8(v, f) do { f[0] = lo2f(v.x); f[1] = hi2f(v.x); f[2] = lo2f(v.y); f[3] = hi2f(v.y); f[4] = lo2f(v.z); f[5] = hi2f(v.z); f[6] = lo2f(v.w); f[7] = hi2f(v.w); } while (0)

DEVI int inmap(int n) { return n < 4096 ? n : (n < 7680 ? n + 16 : n - 7680 + 4096); }

struct WTile { const float* src; const float* scale; bf16_t* dst; int ldsrc, K, Nd, kt, nt, flags; };
DEVI WTile wtile_decode(const Params& p, int it) {
  constexpr int T_IN = 16 * 121, T_OUT = 256, T_UP = 1024, T_DOWN = 1024, T_GATE = 256, T_PROJ = 64;
  constexpr int T_L = T_IN + T_OUT + T_UP + T_DOWN + T_GATE + T_PROJ;
  const int l = it / T_L;
  int r = it % T_L;
  WTile t;
  t.scale = p.norm_mix;
  if (r < T_IN) { t.src = p.w_in + (size_t)l * DM * NIN; t.ldsrc = NIN; t.K = DM; t.Nd = NIN; t.dst = p.wt_in() + (size_t)l * NIN * DM; t.scale = p.norm_mix + l * DM; t.flags = 3; t.kt = r % 16; t.nt = r / 16; return t; }
  r -= T_IN;
  if (r < T_OUT) { t.src = p.w_out + (size_t)l * DM * DM; t.ldsrc = DM; t.K = DM; t.Nd = DM; t.dst = p.wt_out() + (size_t)l * DM * DM; t.flags = 0; t.kt = r % 16; t.nt = r / 16; return t; }
  r -= T_OUT;
  if (r < T_UP) { t.src = p.w_up + (size_t)l * DM * DFF; t.ldsrc = DFF; t.K = DM; t.Nd = DFF; t.dst = p.wt_up() + (size_t)l * DFF * DM; t.scale = p.norm_ffn + l * DM; t.flags = 2; t.kt = r % 16; t.nt = r / 16; return t; }
  r -= T_UP;
  if (r < T_DOWN) { t.src = p.w_down + (size_t)l * DFF * DM; t.ldsrc = DM; t.K = DFF; t.Nd = DM; t.dst = p.wt_down() + (size_t)l * DM * DFF; t.flags = 0; t.kt = r % 64; t.nt = r / 64; return t; }
  r -= T_DOWN;
  if (r < T_GATE) { t.src = p.w_gate + (size_t)l * DM * DM; t.ldsrc = DM; t.K = DM; t.Nd = DM; t.dst = p.wt_gate() + (size_t)l * DM * DM; t.scale = p.norm_ple + l * DM; t.flags = 2; t.kt = r % 16; t.nt = r / 16; return t; }
  r -= T_GATE;
  t.src = p.w_proj + (size_t)l * PLE * DM; t.ldsrc = DM; t.K = PLE; t.Nd = DM; t.dst = p.wt_proj() + (size_t)l * DM * PLE; t.flags = 0; t.kt = r % 4; t.nt = r / 4;
  return t;
}
DEVI void wtile_load(const WTile& t, float (&v)[16], float (&sv)[16], int tid) {
  const int nl = tid & 63, kq = tid >> 6;
  const int n = t.nt * 64 + nl, nc = n < t.Nd ? n : t.Nd - 1;
  const int sc = (t.flags & 1) ? inmap(nc) : nc;
  const int ksc = (t.flags & 2) ? 1 : 0;
#pragma unroll
  for (int r = 0; r < 16; ++r) {
    const int k = t.kt * 64 + r * 4 + kq;
    v[r] = t.src[(size_t)k * t.ldsrc + sc];
    sv[r] = t.scale[(k & 1023) * ksc];
  }
}
DEVI void wtile_store(const WTile& t, const float (&v)[16], const float (&sv)[16], float* sm, int tid) {
  const int nl = tid & 63, kq = tid >> 6;
  const bool ok = t.nt * 64 + nl < t.Nd;
  const bool has = (t.flags & 2) != 0;
#pragma unroll
  for (int r = 0; r < 16; ++r) sm[(r * 4 + kq) * 65 + nl] = ok ? v[r] * (has ? sv[r] : 1.f) : 0.f;
  __syncthreads();
  const int nr = tid >> 2, ks = (tid & 3) * 16;
  if (t.nt * 64 + nr < t.Nd) {
    unsigned w[8];
#pragma unroll
    for (int i = 0; i < 8; ++i) w[i] = pk2(sm[(ks + 2 * i) * 65 + nr], sm[(ks + 2 * i + 1) * 65 + nr]);
    u32x4* d = (u32x4*)(t.dst + (size_t)(t.nt * 64 + nr) * t.K + t.kt * 64 + ks);
    d[0] = (u32x4){w[0], w[1], w[2], w[3]};
    d[1] = (u32x4){w[4], w[5], w[6], w[7]};
  }
  __syncthreads();
}

__device__ void phase_p0(const Params& p, unsigned char* smem) {
  float* sm = (float*)smem;
  const int tid = (opq(threadIdx.x) & 255), lane = tid & 63, wid = tid >> 6;
  {
    constexpr int NT = NL * (16 * 121 + 256 + 1024 + 1024 + 256 + 64);
    const int vb = VB, vg = VG;
    const int nj = (NT - vb + vg - 1) / vg;
#define WT_IDX(j) (vb + ((j) < nj ? (j) : nj - 1) * vg)
    float va[16], sa[16], vb_[16], sb[16], vc[16], sc[16];
    WTile ta = wtile_decode(p, WT_IDX(0));
    wtile_load(ta, va, sa, tid);
    WTile tb = wtile_decode(p, WT_IDX(1));
    wtile_load(tb, vb_, sb, tid);
    for (int j = 0; j < nj; j += 3) {
      const WTile tc = wtile_decode(p, WT_IDX(j + 2));
      wtile_load(tc, vc, sc, tid);
      wtile_store(ta, va, sa, sm, tid);
      ta = wtile_decode(p, WT_IDX(j + 3));
      wtile_load(ta, va, sa, tid);
      if (j + 1 < nj) wtile_store(tb, vb_, sb, sm, tid);
      tb = wtile_decode(p, WT_IDX(j + 4));
      wtile_load(tb, vb_, sb, tid);
      if (j + 2 < nj) wtile_store(tc, vc, sc, sm, tid);
    }
#undef WT_IDX
  }
  for (int it = VB; it < MTOK / 4; it += VG) {
    const int row = it * 4 + wid;
    const float* src = row < MP ? p.x_prompt + (size_t)row * DM : p.x_sample + (size_t)(row - MP) * DM;
    bf16_t* hbd = p.hb() + (size_t)row * DM;
    float ss = 0.f;
#pragma unroll
    for (int i = 0; i < 4; ++i) {
      const int c = i * 256 + lane * 4;
      const f32x4 v = *(const f32x4*)(src + c);
      ss += v.x * v.x + v.y * v.y + v.z * v.z + v.w * v.w;
      *(u32x2*)(hbd + c) = (u32x2){pk2(v.x, v.y), pk2(v.z, v.w)};
    }
#pragma unroll
    for (int o = 1; o < 64; o <<= 1) ss += shx(ss, o, lane);
    if (lane < 16) p.ssq0()[(size_t)row * 16 + lane] = lane == 0 ? ss : 0.f;
  }
  const int G = NL * MTOK * 32;
  for (int g = VB * NTHR + tid; g < G; g += VG * NTHR) {
    const int l = g / (MTOK * 32), rem = g % (MTOK * 32), row = rem >> 5, c8 = rem & 31;
    const float* src = row < MP ? p.p_prompt + ((size_t)(l * MP + row) * PLE + c8 * 8) : p.p_sample + ((size_t)(l * MS + row - MP) * PLE + c8 * 8);
    const f32x4 a = *(const f32x4*)src, b = *(const f32x4*)(src + 4);
    *(u32x4*)(p.pb() + (size_t)g * 8) = (u32x4){pk2(a.x, a.y), pk2(a.z, a.w), pk2(b.x, b.y), pk2(b.z, b.w)};
  }
}

enum { EPI_PROJ = 0, EPI_LOGIT = 1, EPI_RESID = 2, EPI_UP = 3, EPI_PLE = 4, EPI_PP = 5 };
struct EpiArgs {
  const float* ssq_in; float* ssq_out; float* h; bf16_t* hb; bf16_t* obf; int ldo; float* of32; const bf16_t* pp; const bf16_t* hin;
};

template <int EPI>
DEVI float epi_rs(const EpiArgs& e, int row) {
  if (EPI == EPI_PROJ || EPI == EPI_LOGIT || EPI == EPI_UP || EPI == EPI_PLE) {
    const f32x4* sp = (const f32x4*)(e.ssq_in + (size_t)row * 16);
    const f32x4 a = sp[0], b = sp[1], c = sp[2], d = sp[3];
    const float s = ((a.x + a.y) + (a.z + a.w)) + ((b.x + b.y) + (b.z + b.w)) + ((c.x + c.y) + (c.z + c.w)) + ((d.x + d.y) + (d.z + d.w));
    return __builtin_amdgcn_rsqf(s * (1.f / 1024.f) + EPS);
  }
  return 1.f;
}
template <int EPI>
DEVI void epi_elem(const EpiArgs& e, int row, int col, f32x4 v, float rs, float& sq) {
  if (EPI == EPI_PROJ) {
    v *= rs;
    *(u32x2*)(e.obf + (size_t)row * e.ldo + col) = (u32x2){pk2(v.x, v.y), pk2(v.z, v.w)};
  } else if (EPI == EPI_LOGIT) {
    v *= rs;
    *(f32x4*)(e.of32 + (size_t)row * 16 + col) = v;
  } else if (EPI == EPI_PP) {
    *(u32x2*)(e.obf + (size_t)row * e.ldo + (col & 1023)) = (u32x2){pk2(v.x, v.y), pk2(v.z, v.w)};
  } else if (EPI == EPI_UP) {
    v *= rs;
    v.x = fmaxf(v.x, 0.f); v.y = fmaxf(v.y, 0.f); v.z = fmaxf(v.z, 0.f); v.w = fmaxf(v.w, 0.f);
    v = v * v;
    *(u32x2*)(e.obf + (size_t)row * e.ldo + col) = (u32x2){pk2(v.x, v.y), pk2(v.z, v.w)};
  } else {
    const u32x2 hraw = *(const u32x2*)(e.hin + (size_t)row * DM + col);
    f32x4 hv = (f32x4){lo2f(hraw.x), hi2f(hraw.x), lo2f(hraw.y), hi2f(hraw.y)};
    if (EPI == EPI_RESID) {
      hv += v;
    } else {
      const u32x2 pv = *(const u32x2*)(e.pp + (size_t)row * DM + col);
      hv.x += sigm(v.x * rs) * lo2f(pv.x); hv.y += sigm(v.y * rs) * hi2f(pv.x);
      hv.z += sigm(v.z * rs) * lo2f(pv.y); hv.w += sigm(v.w * rs) * hi2f(pv.y);
    }
    if (e.h) *(f32x4*)(e.h + (size_t)row * DM + col) = hv;
    *(u32x2*)(e.hb + (size_t)row * DM + col) = (u32x2){pk2(hv.x, hv.y), pk2(hv.z, hv.w)};
    sq += hv.x * hv.x + hv.y * hv.y + hv.z * hv.z + hv.w * hv.w;
  }
}

template <int EPI>
DEVI void epi_elem8(const EpiArgs& e, int row, int col, f32x4 v0, f32x4 v1, float rs, float& sq) {
  if (EPI == EPI_PROJ || EPI == EPI_UP || EPI == EPI_PP) {
    if (EPI != EPI_PP) { v0 *= rs; v1 *= rs; }
    if (EPI == EPI_UP) {
      v0.x = fmaxf(v0.x, 0.f); v0.y = fmaxf(v0.y, 0.f); v0.z = fmaxf(v0.z, 0.f); v0.w = fmaxf(v0.w, 0.f);
      v1.x = fmaxf(v1.x, 0.f); v1.y = fmaxf(v1.y, 0.f); v1.z = fmaxf(v1.z, 0.f); v1.w = fmaxf(v1.w, 0.f);
      v0 = v0 * v0; v1 = v1 * v1;
    }
    const int c = EPI == EPI_PP ? (col & 1023) : col;
    *(u32x4*)(e.obf + (size_t)row * e.ldo + c) = (u32x4){pk2(v0.x, v0.y), pk2(v0.z, v0.w), pk2(v1.x, v1.y), pk2(v1.z, v1.w)};
  } else {
    const u32x4 hraw = *(const u32x4*)(e.hin + (size_t)row * DM + col);
    f32x4 h0 = (f32x4){lo2f(hraw.x), hi2f(hraw.x), lo2f(hraw.y), hi2f(hraw.y)}, h1 = (f32x4){lo2f(hraw.z), hi2f(hraw.z), lo2f(hraw.w), hi2f(hraw.w)};
    if (EPI == EPI_RESID) {
      h0 += v0; h1 += v1;
    } else {
      const u32x4 pv = *(const u32x4*)(e.pp + (size_t)row * DM + col);
      h0.x += sigm(v0.x * rs) * lo2f(pv.x); h0.y += sigm(v0.y * rs) * hi2f(pv.x);
      h0.z += sigm(v0.z * rs) * lo2f(pv.y); h0.w += sigm(v0.w * rs) * hi2f(pv.y);
      h1.x += sigm(v1.x * rs) * lo2f(pv.z); h1.y += sigm(v1.y * rs) * hi2f(pv.z);
      h1.z += sigm(v1.z * rs) * lo2f(pv.w); h1.w += sigm(v1.w * rs) * hi2f(pv.w);
    }
    if (e.h) { float* hp = e.h + (size_t)row * DM + col; *(f32x4*)hp = h0; *(f32x4*)(hp + 4) = h1; }
    *(u32x4*)(e.hb + (size_t)row * DM + col) = (u32x4){pk2(h0.x, h0.y), pk2(h0.z, h0.w), pk2(h1.x, h1.y), pk2(h1.z, h1.w)};
    sq += (h0.x * h0.x + h0.y * h0.y + h0.z * h0.z + h0.w * h0.w) + (h1.x * h1.x + h1.y * h1.y + h1.z * h1.z + h1.w * h1.w);
  }
}

template <int WMT, int WNT, int WGM, int WGN, int EPI, int BK = 32, bool KSPLIT = false>
__device__ __forceinline__ void gemm_tile(const bf16_t* __restrict__ A, int lda, const bf16_t* __restrict__ Bt, int ldb, int K, int m0, int n0,
                                          bf16_t* lds, const EpiArgs& e) {
  constexpr int BM = WGM * WMT * 16, BN = WGN * WNT * 16, LDR = BK + 8;
  constexpr int STAGE = (BM + BN) * LDR;
  constexpr int PPR = BK / 8, RPI = NTHR / PPR;
  constexpr int NA = BM / RPI, NB = (BN + RPI - 1) / RPI;
  const int tid = (opq(threadIdx.x) & 255), lane = tid & 63, wid = tid >> 6;
  const int wm = wid / WGN, wn = wid % WGN;
  const int fr = lane & 15, fq = lane >> 4;
  f32x4 acc[WMT][WNT];
#pragma unroll
  for (int i = 0; i < WMT; ++i)
#pragma unroll
    for (int j = 0; j < WNT; ++j) acc[i][j] = (f32x4){0.f, 0.f, 0.f, 0.f};
  u32x4 ra0[NA], rb0[NB], ra1[NA], rb1[NB];
  const int khalf = KSPLIT ? VHALF : 0;
  const int nk = (KSPLIT ? K / 2 : K) / BK;
  const int prow = tid / PPR, ppc = tid % PPR;
  const unsigned ta = (unsigned)(prow * lda + ppc * 8) * 2u, tb = (unsigned)(prow * ldb + ppc * 8) * 2u;
  const char* Au = (const char*)(A + (size_t)m0 * lda + (size_t)khalf * (K / 2));
  const char* Bu = (const char*)(Bt + (size_t)n0 * ldb + (size_t)khalf * (K / 2));
#define BGUARD(i) (BN >= RPI * ((i) + 1) || prow + (i) * RPI < BN)
#define GLOAD(kt, RA, RB) do { \
    _Pragma("unroll") for (int i = 0; i < NA; ++i) RA[i] = *(const u32x4*)(Au + ((size_t)i * RPI * lda + (size_t)(kt) * BK) * 2 + ta); \
    _Pragma("unroll") for (int i = 0; i < NB; ++i) if (BGUARD(i)) RB[i] = *(const u32x4*)(Bu + ((size_t)i * RPI * ldb + (size_t)(kt) * BK) * 2 + tb); \
  } while (0)
#define LSTORE(st, RA, RB) do { bf16_t* sA_ = lds + (st) * STAGE; bf16_t* sB_ = sA_ + BM * LDR; \
    _Pragma("unroll") for (int i = 0; i < NA; ++i) *(u32x4*)(sA_ + (prow + i * RPI) * LDR + ppc * 8) = RA[i]; \
    _Pragma("unroll") for (int i = 0; i < NB; ++i) if (BGUARD(i)) *(u32x4*)(sB_ + (prow + i * RPI) * LDR + ppc * 8) = RB[i]; \
  } while (0)
#define COMPUTE(st) do { const bf16_t* sA = lds + (st) * STAGE; const bf16_t* sB = sA + BM * LDR; \
    _Pragma("unroll") for (int kk = 0; kk < BK / 32; ++kk) { \
      bf16x8 bfr[WNT]; \
      _Pragma("unroll") for (int nt = 0; nt < WNT; ++nt) bfr[nt] = *(const bf16x8*)(sB + (wn * WNT * 16 + nt * 16 + fr) * LDR + kk * 32 + fq * 8); \
      _Pragma("unroll") for (int mt = 0; mt < WMT; ++mt) { \
        const bf16x8 af = *(const bf16x8*)(sA + (wm * WMT * 16 + mt * 16 + fr) * LDR + kk * 32 + fq * 8); \
        _Pragma("unroll") for (int nt = 0; nt < WNT; ++nt) acc[mt][nt] = mfma16(bfr[nt], af, acc[mt][nt]); } } \
  } while (0)
  GLOAD(0, ra0, rb0);
  GLOAD(1, ra1, rb1);
  LSTORE(0, ra0, rb0);
  __syncthreads();
  for (int kt = 0; kt < nk; kt += 2) {
    const int k2 = kt + 2 < nk ? kt + 2 : nk - 2;
    GLOAD(k2, ra0, rb0);
    COMPUTE(0);
    LSTORE(1, ra1, rb1);
    __syncthreads();
    GLOAD(k2 + 1, ra1, rb1);
    COMPUTE(1);
    LSTORE(0, ra0, rb0);
    __syncthreads();
  }
#undef BGUARD
#undef COMPUTE
#undef GLOAD
#undef LSTORE
  if (KSPLIT) {
    f32x4* red = (f32x4*)((unsigned char*)lds + (khalf ? 0 : SMEM_BYTES));
    if (khalf == 1) {
#pragma unroll
      for (int i = 0; i < WMT; ++i)
#pragma unroll
        for (int j = 0; j < WNT; ++j) red[((wid * WMT + i) * WNT + j) * 64 + lane] = acc[i][j];
    }
    __syncthreads();
    if (khalf == 0) {
#pragma unroll
      for (int i = 0; i < WMT; ++i)
#pragma unroll
        for (int j = 0; j < WNT; ++j) acc[i][j] += red[((wid * WMT + i) * WNT + j) * 64 + lane];
    }
  }
  if (!KSPLIT || khalf == 0) {
#pragma unroll
  for (int mt = 0; mt < WMT; ++mt) {
    const int row = m0 + wm * WMT * 16 + mt * 16 + fr;
    const float rs = epi_rs<EPI>(e, row);
    float sq = 0.f;
#pragma unroll
    for (int nt = 0; nt < WNT; ++nt) epi_elem<EPI>(e, row, n0 + wn * WNT * 16 + nt * 16 + fq * 4, acc[mt][nt], rs, sq);
    if (EPI == EPI_RESID || EPI == EPI_PLE) {
      sq += shx(sq, 16, lane);
      sq += shx(sq, 32, lane);
      if (fq == 0) e.ssq_out[(size_t)row * 16 + (n0 / BN) * WGN + wn] = sq;
    }
  }
  }
  if (KSPLIT) __syncthreads();
}

namespace pg8 {
#define PG8_LAS __attribute__((address_space(3)))
typedef unsigned short bf16_t;
typedef short bf16x8 __attribute__((ext_vector_type(8)));
typedef float f32x4 __attribute__((ext_vector_type(4)));
typedef unsigned u32x4 __attribute__((ext_vector_type(4)));
constexpr int BM = 256, BK = 64, HALF = 128, HTB = HALF * BK * 2  , STAGE_BYTES = 8 * HTB, NXCD = 8, WGM = 8;

__host__ __device__ __forceinline__ int lds_byte(int r, int c) { const int st = (r >> 4) * 2 + (c >> 5), rr = r & 15, cc = c & 31, ob = rr * 64 + cc * 2; return st * 1024 + (ob ^ (((ob >> 9) & 1) << 5)); }
__host__ __device__ __forceinline__ void stage_rc(int b, int& R, int& C) { const int st = b / 1024, sb = b % 1024, swz = sb ^ (((sb >> 9) & 1) << 5); R = (st >> 1) * 16 + swz / 64; C = (st & 1) * 32 + (swz % 64) / 2; }
__host__ __device__ __forceinline__ int perm32(int rho) { const int n = rho >> 4, i = rho & 15; return 8 * (i >> 2) + 4 * n + (i & 3); }

struct Unit { int pm, pn; };
struct Gemm { const bf16_t* A; const bf16_t* Bt; int M, N, K; };

template <class Epi, class Sched, bool STAMP = false>
__device__ __forceinline__ void gemm_phase(PG8_LAS unsigned char* lds, const Gemm g, const Sched& S, const Epi& E, unsigned long long* stamps) {
    const int tid = opq((int)threadIdx.x), wid = __builtin_amdgcn_readfirstlane(tid >> 6), lane = tid & 63, wr = wid >> 2, wc = wid & 3, fr = lane & 15, fq = lane >> 4;
    const int K = g.K, nt = K / BK;
    int ts_lo = 0, ts_hi = 0, nts = 0; const unsigned long long rt_entry = STAMP ? (unsigned long long)wall_clock64() : 0ull;
#define PG8_STAMP() do { if (STAMP && wid == 0 && nts < 64) { const unsigned long long _c = (unsigned long long)clock64(); \
        ts_lo = (lane == nts) ? (int)(unsigned)_c : ts_lo; ts_hi = (lane == nts) ? (int)(unsigned)(_c >> 32) : ts_hi; ++nts; } } while (0)
    PG8_STAMP();
    unsigned voffA[2], voffB[2];
#pragma unroll
    for (int i = 0; i < 2; ++i) { int R, C; stage_rc(tid * 16 + i * 8192, R, C); const int Rb = Epi::PERM ? ((R & ~31) + perm32(R & 31)) : R;
        voffA[i] = (unsigned)(R * K + C) * 2u; voffB[i] = (unsigned)(Rb * K + C) * 2u; }
    const size_t kstep = (size_t)(BK * 2);
    const size_t hstep = (size_t)HALF * K * 2;
    const size_t tstep = 2 * hstep;
    const unsigned ldsw = (unsigned)wid * 1024u;
    const int aoff = lds_byte(wr * 64 + fr, fq * 8), boff = lds_byte(wc * 32 + fr, fq * 8);
#define PG8_SA(b, h) (((b) * 2 + (h)) * HTB)
#define PG8_SB(b, h) ((4 + (b) * 2 + (h)) * HTB)
#define PG8_STAGE(bufoff, gbase, voff) do { _Pragma("unroll") for (int _i = 0; _i < 2; ++_i) \
        __builtin_amdgcn_global_load_lds((const unsigned*)((const char*)(gbase) + (voff)[_i]), (PG8_LAS unsigned*)(lds + (bufoff) + ldsw + _i * 8192), 16, 0, 0); } while (0)
#define PG8_LDA(dst, b, h) do { _Pragma("unroll") for (int m = 0; m < 4; ++m) _Pragma("unroll") for (int k = 0; k < 2; ++k) dst[m][k] = *(const PG8_LAS bf16x8*)(lds + PG8_SA(b, h) + aoff + m * 2048 + k * 1024); } while (0)
#define PG8_LDB(dst, b, h) do { _Pragma("unroll") for (int n = 0; n < 2; ++n) _Pragma("unroll") for (int k = 0; k < 2; ++k) dst[n][k] = *(const PG8_LAS bf16x8*)(lds + PG8_SB(b, h) + boff + n * 2048 + k * 1024); } while (0)
#define PG8_MMA(ai, bj, At, Bt) do { __builtin_amdgcn_s_setprio(1); _Pragma("unroll") for (int m = 0; m < 4; ++m) _Pragma("unroll") for (int n = 0; n < 2; ++n) _Pragma("unroll") for (int k = 0; k < 2; ++k) \
        acc[ai][bj][m][n] = __builtin_amdgcn_mfma_f32_16x16x32_bf16(Bt[n][k], At[m][k], acc[ai][bj][m][n], 0, 0, 0); __builtin_amdgcn_s_setprio(0); } while (0)
#define PG8_WAIT_V(n) asm volatile("s_waitcnt vmcnt(" #n ")" ::: "memory")
#define PG8_WAIT_L(n) asm volatile("s_waitcnt lgkmcnt(" #n ")" ::: "memory")
#define PG8_BAR __builtin_amdgcn_s_barrier()
#define PG8_SCHED __builtin_amdgcn_sched_barrier(0)
    Unit cur, nxt; int ui = 0;
    if (!S.next(0, cur)) return;
    f32x4 acc[2][2][4][2];
#pragma unroll
    for (int a = 0; a < 2; ++a)
#pragma unroll
        for (int b = 0; b < 2; ++b)
#pragma unroll
            for (int m = 0; m < 4; ++m)
#pragma unroll
                for (int n = 0; n < 2; ++n) acc[a][b][m][n] = (f32x4){0.f, 0.f, 0.f, 0.f};
    bf16x8 At[4][2], B0[2][2], B1[2][2];
    const char* cA = (const char*)g.A + (size_t)cur.pm * tstep; const char* cB = (const char*)g.Bt + (size_t)cur.pn * tstep;
    S.a_ready(cur);
    PG8_STAGE(PG8_SB(0, 0), cB, voffB); PG8_STAGE(PG8_SA(0, 0), cA, voffA); PG8_STAGE(PG8_SB(0, 1), cB + hstep, voffB); PG8_STAGE(PG8_SA(0, 1), cA + hstep, voffA);
    if (wr == 1) PG8_BAR;
    PG8_WAIT_V(4); PG8_BAR;
    PG8_STAGE(PG8_SB(1, 0), cB + kstep, voffB); PG8_STAGE(PG8_SA(1, 0), cA + kstep, voffA); PG8_STAGE(PG8_SB(1, 1), cB + hstep + kstep, voffB);
    PG8_WAIT_V(6); PG8_BAR;
    PG8_STAMP();
    for (;;) {
        const bool has_next = S.next(ui + 1, nxt);
        const char* nA = has_next ? (const char*)g.A + (size_t)nxt.pm * tstep : cA; const char* nB = has_next ? (const char*)g.Bt + (size_t)nxt.pn * tstep : cB;
        for (int t = 0; t < nt; t += 2) {
            const bool last = (t == nt - 2);
            const char* a1 = cA + (size_t)(t + 1) * kstep;
            const char* a2 = last ? nA : cA + (size_t)(t + 2) * kstep; const char* b2 = last ? nB : cB + (size_t)(t + 2) * kstep;
            const char* a3 = a2 + kstep; const char* b3 = b2 + kstep;
            if (last && has_next) S.a_ready(nxt);
            PG8_LDB(B0, 0, 0); PG8_SCHED; PG8_LDA(At, 0, 0); PG8_STAGE(PG8_SA(1, 1), a1 + hstep, voffA);
            PG8_WAIT_L(8); PG8_BAR; PG8_WAIT_L(0); PG8_MMA(0, 0, At, B0); PG8_BAR; PG8_SCHED;
            PG8_LDB(B1, 0, 1); PG8_STAGE(PG8_SB(0, 0), b2, voffB);
            PG8_BAR; PG8_WAIT_L(0); PG8_MMA(0, 1, At, B1); PG8_BAR;
            PG8_LDA(At, 0, 1); PG8_STAGE(PG8_SA(0, 0), a2, voffA);
            PG8_BAR; PG8_WAIT_L(0); PG8_MMA(1, 0, At, B0); PG8_BAR; PG8_SCHED;
            PG8_STAGE(PG8_SB(0, 1), b2 + hstep, voffB);
            PG8_WAIT_V(6); PG8_BAR; PG8_MMA(1, 1, At, B1); PG8_BAR;
            PG8_LDB(B0, 1, 0); PG8_SCHED; PG8_LDA(At, 1, 0); PG8_STAGE(PG8_SA(0, 1), a2 + hstep, voffA);
            PG8_WAIT_L(8); PG8_BAR; PG8_WAIT_L(0); PG8_MMA(0, 0, At, B0); PG8_BAR; PG8_SCHED;
            PG8_LDB(B1, 1, 1); PG8_STAGE(PG8_SB(1, 0), b3, voffB);
            PG8_BAR; PG8_WAIT_L(0); PG8_MMA(0, 1, At, B1); PG8_BAR;
            PG8_LDA(At, 1, 1); PG8_STAGE(PG8_SA(1, 0), a3, voffA);
            PG8_BAR; PG8_WAIT_L(0); PG8_MMA(1, 0, At, B0); PG8_BAR; PG8_SCHED;
            PG8_STAGE(PG8_SB(1, 1), b3 + hstep, voffB);
            PG8_WAIT_V(6); PG8_BAR; PG8_MMA(1, 1, At, B1); PG8_BAR;
        }
        PG8_STAMP();
        if constexpr (!Epi::AFTER_DRAIN) { E(acc, cur, wr, wc, fr, fq); S.done(cur); }
        PG8_STAMP();
        if (!has_next) break;
#pragma unroll
        for (int a = 0; a < 2; ++a)
#pragma unroll
            for (int b = 0; b < 2; ++b)
#pragma unroll
                for (int m = 0; m < 4; ++m)
#pragma unroll
                    for (int n = 0; n < 2; ++n) acc[a][b][m][n] = (f32x4){0.f, 0.f, 0.f, 0.f};
        cur = nxt; cA = nA; cB = nB; ++ui;
    }
    PG8_WAIT_V(0);
    if (wr == 0) PG8_BAR;
    PG8_BAR;
    if constexpr (Epi::AFTER_DRAIN) { E.fused(acc, cur, wr, wc, fr, fq, lds, wid, lane); S.done(cur); }
    PG8_STAMP();
    if (STAMP && wid == 0) { stamps[lane] = lane < nts ? (((unsigned long long)(unsigned)ts_hi << 32) | (unsigned)ts_lo) : 0ull;
        if (lane == 62) stamps[62] = rt_entry; if (lane == 63) stamps[63] = (unsigned long long)wall_clock64(); }
#undef PG8_STAMP
#undef PG8_SA
#undef PG8_SB
#undef PG8_STAGE
#undef PG8_LDA
#undef PG8_LDB
#undef PG8_MMA
#undef PG8_WAIT_V
#undef PG8_WAIT_L
#undef PG8_BAR
#undef PG8_SCHED
}
}

DEVI void unit_map(int L, int nM, int nN, int& pm, int& pn) {
  const int nwg = nM * nN, q = nwg / 8, r = nwg % 8, xcd = L % 8, off = L / 8;
  const int wgid = (xcd < r ? xcd * (q + 1) : r * (q + 1) + (xcd - r) * q) + off;
  const int nig = 8 * nN, gid = wgid / nig, fm = gid * 8, gsz = (nM - fm) < 8 ? (nM - fm) : 8, w = wgid - gid * nig;
  pm = fm + (w % gsz); pn = w / gsz;
}
struct RowSched {
  int nM, nN, nLimit, G, c;
  __device__ __forceinline__ bool next(int i, pg8::Unit& u) const { const int L = i * G + c; if (L >= nLimit) return false; unit_map(L, nM, nN, u.pm, u.pn); return true; }
  __device__ __forceinline__ void a_ready(const pg8::Unit&) const {}
  __device__ __forceinline__ void done(const pg8::Unit&) const {}
};
struct DiagSched {
  int nLimit, G, c;
  __device__ __forceinline__ bool next(int i, pg8::Unit& u) const { const int L = i * G + c; if (L >= nLimit) return false; const int l = L / 272, r = L - l * 272; u.pm = l * 68 + (r >> 2); u.pn = l * 4 + (r & 3); return true; }
  __device__ __forceinline__ void a_ready(const pg8::Unit&) const {}
  __device__ __forceinline__ void done(const pg8::Unit&) const {}
};
template <int EPI> struct BigEpi {
  static constexpr bool PERM = true, AFTER_DRAIN = false;
  EpiArgs e;
  __device__ __forceinline__ void operator()(const f32x4 (&acc)[2][2][4][2], const pg8::Unit& u, int wr, int wc, int fr, int fq) const {
    const int lane = fq * 16 + fr;
#pragma unroll
    for (int ai = 0; ai < 2; ++ai)
#pragma unroll
      for (int m = 0; m < 4; ++m) {
        const int row = u.pm * 256 + ai * 128 + wr * 64 + m * 16 + fr;
        const float rs = epi_rs<EPI>(e, row);
        float sq = 0.f;
#pragma unroll
        for (int bj = 0; bj < 2; ++bj) epi_elem8<EPI>(e, row, u.pn * 256 + bj * 128 + wc * 32 + fq * 8, acc[ai][bj][m][0], acc[ai][bj][m][1], rs, sq);
        if (EPI == EPI_RESID || EPI == EPI_PLE) {
          sq += shx(sq, 16, lane);
          sq += shx(sq, 32, lane);
          if (fq == 0) e.ssq_out[(size_t)row * 16 + u.pn * 4 + wc] = sq;
        }
      }
  }
};

template <int EPI>
__device__ void gemm_big_phase(const bf16_t* A, const bf16_t* Bt, int K, int M, int N, unsigned char* lds_all, unsigned char* smem_half, const EpiArgs& e) {
  const int nM = M / 256, nN = N / 256, nU = nM * nN, G = gridDim.x;
  const int L = nU % G;
  const int nLimit = (L > 0 && L <= G / 4) ? nU - L : nU;
  RowSched S; S.nM = nM; S.nN = nN; S.nLimit = nLimit; S.G = G; S.c = blockIdx.x;
  pg8::Gemm g; g.A = A; g.Bt = Bt; g.M = M; g.N = N; g.K = K;
  BigEpi<EPI> E; E.e = e;
  pg8::gemm_phase<BigEpi<EPI>, RowSched>((PG8_LAS unsigned char*)lds_all, g, S, E, nullptr);
  __syncthreads();
  const int nSmall = (nU - nLimit) * 16;
  if (nSmall <= G && K >= 512) {
    for (int st = blockIdx.x; st < nSmall; st += G) {
      const int sub = st & 15; int pm, pn; unit_map(nLimit + (st >> 4), nM, nN, pm, pn);
      gemm_tile<1, 4, 4, 1, EPI, 128, true>(A, K, Bt, K, K, pm * 256 + (sub >> 2) * 64, pn * 256 + (sub & 3) * 64, (bf16_t*)smem_half, e);
    }
  } else {
    for (int st = VB; st < nSmall; st += VG) {
      const int sub = st & 15; int pm, pn; unit_map(nLimit + (st >> 4), nM, nN, pm, pn);
      gemm_tile<1, 4, 4, 1, EPI, 128>(A, K, Bt, K, K, pm * 256 + (sub >> 2) * 64, pn * 256 + (sub & 3) * 64, (bf16_t*)smem_half, e);
    }
  }
}


template <int I, int J4>
DEVI void solve_sub4(float& r, const float (&x)[64], const float* Am) {
  if constexpr (J4 * 4 < I) {
    const f32x4 a = *(const f32x4*)(Am + I * 64 + J4 * 4);
    if constexpr (J4 * 4 + 0 < I) r -= a.x * x[J4 * 4 + 0];
    if constexpr (J4 * 4 + 1 < I) r -= a.y * x[J4 * 4 + 1];
    if constexpr (J4 * 4 + 2 < I) r -= a.z * x[J4 * 4 + 2];
    if constexpr (J4 * 4 + 3 < I) r -= a.w * x[J4 * 4 + 3];
    solve_sub4<I, J4 + 1>(r, x, Am);
  }
}
template <int I>
DEVI void solve_rows(float (&x)[64], const float* Am, const bf16_t* src, const float* sc) {
  if constexpr (I < 64) {
    float r = bf2f(src[I * 136]) * sc[I];
    solve_sub4<I, 0>(r, x, Am);
    x[I] = r;
    asm volatile("" ::: "memory");
    solve_rows<I + 1>(x, Am, src, sc);
  }
}

__device__ void gdn_prep_item(const Params& p, int l, int item, unsigned char* smem) {
  const int tid = (opq(threadIdx.x) & 255), lane = tid & 63, wid = tid >> 6, fr = lane & 15, fq = lane >> 4;
  const int h = item & 7, n = (item >> 3) & 31, b = item >> 8;
  const int tok0 = b * 2048 + n * 64;
  bf16_t* qh = (bf16_t*)smem;
  bf16_t* kh = qh + 64 * 136;
  bf16_t* vh = kh + 64 * 136;
  float* Am = (float*)(vh + 64 * 136);
  float* sbeta = Am + 64 * 64;
  float* sgc = sbeta + 64;
  float* sbe = sgc + 64;
  float* seg = sbe + 64;
  float* sek = seg + 64;
  unsigned char* scr = (unsigned char*)p.scr() + (size_t)item * SCR_ITEM;
  bf16_t* g_uT = (bf16_t*)scr;
  bf16_t* g_w = (bf16_t*)(scr + 16384);
  bf16_t* g_qg = (bf16_t*)(scr + 32768);
  bf16_t* g_kgT = (bf16_t*)(scr + 49152);
  bf16_t* g_qk = (bf16_t*)(scr + 65536);

  if (wid == 0) {
    const float* lg = p.logits() + (size_t)(tok0 + lane) * 16;
    const float bl = lg[h], al = lg[8 + h];
    const float x = al + p.dt_bias[l * 8 + h];
    const float sp = softplus_f(x);
    float g = -__expf(p.a_log[l * 8 + h]) * sp;
#pragma unroll
    for (int o = 1; o < 64; o <<= 1) { const float t = shup(g, o, lane); if (lane >= o) g += t; }
    sbeta[lane] = sigm(bl);
    sgc[lane] = g;
    sbe[lane] = sigm(bl) * __expf(g);
    seg[lane] = __expf(g);
    const float glast = __builtin_bit_cast(float, __builtin_amdgcn_readlane(__builtin_bit_cast(int, g), 63));
    sek[lane] = __expf(glast - g);
  }
  u32x4 rwall[3][7];
#pragma unroll
  for (int sect = 0; sect < 3; ++sect)
#pragma unroll
    for (int r = 0; r < 7; ++r) {
      const int tl = n * 64 + wid * 16 + fq * 4 - 3 + r;
      rwall[sect][r] = (u32x4){0u, 0u, 0u, 0u};
      if (tl >= 0) rwall[sect][r] = *(const u32x4*)(p.proj() + (size_t)(b * 2048 + tl) * NPJ + sect * 1024 + h * 128 + fr * 8);
    }
#pragma unroll
  for (int sect = 0; sect < 3; ++sect) {
    const int ch0 = sect * 1024 + h * 128 + fr * 8;
    float cw[4][8];
#pragma unroll
    for (int j = 0; j < 4; ++j) {
      const f32x4 a = *(const f32x4*)(p.conv_w + (size_t)(l * 4 + j) * 3072 + ch0), c = *(const f32x4*)(p.conv_w + (size_t)(l * 4 + j) * 3072 + ch0 + 4);
      cw[j][0] = a.x; cw[j][1] = a.y; cw[j][2] = a.z; cw[j][3] = a.w; cw[j][4] = c.x; cw[j][5] = c.y; cw[j][6] = c.z; cw[j][7] = c.w;
    }
    const int ib = wid * 16 + fq * 4;
#pragma unroll
    for (int it = 0; it < 4; ++it) {
      float o[8];
#pragma unroll
      for (int c = 0; c < 8; ++c) o[c] = 0.f;
#pragma unroll
      for (int j = 0; j < 4; ++j) {
        float f[8];
        UNPACK8(rwall[sect][it + j], f);
#pragma unroll
        for (int c = 0; c < 8; ++c) o[c] += f[c] * cw[j][c];
      }
      float ss = 0.f;
#pragma unroll
      for (int c = 0; c < 8; ++c) { o[c] = silu(o[c]); ss += o[c] * o[c]; }
      if (sect < 2) {
        ss += shx(ss, 1, lane); ss += shx(ss, 2, lane); ss += shx(ss, 4, lane); ss += shx(ss, 8, lane);
        float rn = __builtin_amdgcn_rsqf(ss + EPS);
        if (sect == 0) rn *= 0.08838834764831845f;
#pragma unroll
        for (int c = 0; c < 8; ++c) o[c] *= rn;
      }
      const u32x4 pk = (u32x4){pk2(o[0], o[1]), pk2(o[2], o[3]), pk2(o[4], o[5]), pk2(o[6], o[7])};
      bf16_t* dst = sect == 0 ? qh + (ib + it) * 136 + fr * 8 : (sect == 1 ? kh + (ib + it) * 136 + fr * 8 : vh + (ib + it) * 136 + fr * 8);
      *(u32x4*)dst = pk;
    }
  }
  __syncthreads();
  {
    const int i = wid * 16 + fr;
    const float gi = sgc[i], bi = sbeta[i];
    bf16x8 kx[4], qx[4];
#pragma unroll
    for (int ks = 0; ks < 4; ++ks) {
      kx[ks] = *(const bf16x8*)(kh + i * 136 + ks * 32 + fq * 8);
      qx[ks] = *(const bf16x8*)(qh + i * 136 + ks * 32 + fq * 8);
    }
#pragma unroll
    for (int jt = 0; jt < 4; ++jt) {
      f32x4 akk = (f32x4){0.f, 0.f, 0.f, 0.f}, aqk = (f32x4){0.f, 0.f, 0.f, 0.f};
      if (jt <= wid) {
#pragma unroll
        for (int ks = 0; ks < 4; ++ks) {
          const bf16x8 kj = *(const bf16x8*)(kh + (jt * 16 + fr) * 136 + ks * 32 + fq * 8);
          akk = mfma16(kj, kx[ks], akk);
          aqk = mfma16(kj, qx[ks], aqk);
        }
      }
      const int j0 = jt * 16 + fq * 4;
      float av[4], qv[4];
#pragma unroll
      for (int jj = 0; jj < 4; ++jj) {
        const int j = j0 + jj;
        const float dec = j <= i ? __expf(gi - sgc[j]) : 0.f;
        av[jj] = j < i ? bi * akk[jj] * dec : 0.f;
        qv[jj] = aqk[jj] * dec;
      }
      *(f32x4*)(Am + i * 64 + j0) = (f32x4){av[0], av[1], av[2], av[3]};
      *(u32x2*)(g_qk + i * 64 + j0) = (u32x2){pk2(qv[0], qv[1]), pk2(qv[2], qv[3])};
    }
  }
  __syncthreads();
  {
    float x[64];
    const bool isu = tid < 128;
    const int cc = tid & 127;
    solve_rows<0>(x, Am, (isu ? vh : kh) + cc, isu ? sbeta : sbe);
    if (isu) {
      u32x4* d = (u32x4*)(g_uT + cc * 64);
#pragma unroll
      for (int q = 0; q < 8; ++q) d[q] = (u32x4){pk2(x[q * 8], x[q * 8 + 1]), pk2(x[q * 8 + 2], x[q * 8 + 3]), pk2(x[q * 8 + 4], x[q * 8 + 5]), pk2(x[q * 8 + 6], x[q * 8 + 7])};
    } else {
#pragma unroll
      for (int i = 0; i < 64; ++i) g_w[i * 128 + cc] = f2bf(x[i]);
    }
  }
  {
    const float gl = sgc[63];
#pragma unroll
    for (int q = 0; q < 4; ++q) {
      const int pc = tid + q * 256, i = pc >> 4, c8 = pc & 15;
      const u32x4 v = *(const u32x4*)(qh + i * 136 + c8 * 8);
      float f[8];
      UNPACK8(v, f);
      const float s = seg[i];
      *(u32x4*)(g_qg + i * 128 + c8 * 8) = (u32x4){pk2(f[0] * s, f[1] * s), pk2(f[2] * s, f[3] * s), pk2(f[4] * s, f[5] * s), pk2(f[6] * s, f[7] * s)};
    }
    if (tid >= 128) {
      const int dk = tid - 128;
      u32x4* d = (u32x4*)(g_kgT + dk * 64);
#pragma unroll
      for (int q = 0; q < 8; ++q) {
        float f[8];
#pragma unroll
        for (int c = 0; c < 8; ++c) { const int i = q * 8 + c; f[c] = bf2f(kh[i * 136 + dk]) * sek[i]; }
        d[q] = (u32x4){pk2(f[0], f[1]), pk2(f[2], f[3]), pk2(f[4], f[5]), pk2(f[6], f[7])};
      }
    }
    if (tid == 0) p.gsc()[item] = __expf(gl);
  }
  __syncthreads();
}

__device__ void gdn_scan_item(const Params& p, int l, int item, unsigned char* smem) {
  const int tid = (opq(threadIdx.x) & 255), lane = tid & 63, wid = tid >> 6, fr = lane & 15, fq = lane >> 4;
  const int dvs = item & 3, h = (item >> 2) & 7, b = item >> 5;
  bf16_t* ST = (bf16_t*)smem;
  bf16_t* VT = ST + 2 * 32 * 136;
  f32x4 S[2][2];
#pragma unroll
  for (int a = 0; a < 2; ++a)
#pragma unroll
    for (int c = 0; c < 2; ++c) S[a][c] = (f32x4){0.f, 0.f, 0.f, 0.f};
  __syncthreads();
  bf16x8 fw[4], fqg[4], fqk[2], fkg[2][2];
  u32x2 fu[2];
  float gs;
  bf16x8 nw[4], nqg[4], nqk[2], nkg[2][2];
  u32x2 nu[2];
  float ngs;
#define SCAN_LOAD(n_, W, QG, QK, KG, U, GS) do { \
    const int it_ = ((b * 32 + (n_)) << 3) + h; \
    const unsigned char* scr_ = (const unsigned char*)p.scr() + (size_t)it_ * SCR_ITEM; \
    const bf16_t* g_uT = (const bf16_t*)scr_; const bf16_t* g_w = (const bf16_t*)(scr_ + 16384); const bf16_t* g_qg = (const bf16_t*)(scr_ + 32768); \
    const bf16_t* g_kgT = (const bf16_t*)(scr_ + 49152); const bf16_t* g_qk = (const bf16_t*)(scr_ + 65536); \
    _Pragma("unroll") for (int ks = 0; ks < 4; ++ks) { \
      W[ks] = *(const bf16x8*)(g_w + (wid * 16 + fr) * 128 + ks * 32 + fq * 8); \
      QG[ks] = *(const bf16x8*)(g_qg + (wid * 16 + fr) * 128 + ks * 32 + fq * 8); } \
    _Pragma("unroll") for (int ks = 0; ks < 2; ++ks) { \
      QK[ks] = *(const bf16x8*)(g_qk + (wid * 16 + fr) * 64 + ks * 32 + fq * 8); \
      _Pragma("unroll") for (int mt = 0; mt < 2; ++mt) KG[mt][ks] = *(const bf16x8*)(g_kgT + ((2 * wid + mt) * 16 + fr) * 64 + ks * 32 + fq * 8); } \
    _Pragma("unroll") for (int nt = 0; nt < 2; ++nt) U[nt] = *(const u32x2*)(g_uT + (dvs * 32 + nt * 16 + fr) * 64 + wid * 16 + fq * 4); \
    GS = p.gsc()[it_]; } while (0)
  SCAN_LOAD(0, nw, nqg, nqk, nkg, nu, ngs);
  for (int n = 0; n < 32; ++n) {
#pragma unroll
    for (int ks = 0; ks < 4; ++ks) { fw[ks] = nw[ks]; fqg[ks] = nqg[ks]; }
#pragma unroll
    for (int ks = 0; ks < 2; ++ks) { fqk[ks] = nqk[ks]; fkg[0][ks] = nkg[0][ks]; fkg[1][ks] = nkg[1][ks]; }
    fu[0] = nu[0]; fu[1] = nu[1]; gs = ngs;
    { const int n1 = n + 1 < 32 ? n + 1 : 31; SCAN_LOAD(n1, nw, nqg, nqk, nkg, nu, ngs); }
    bf16_t* STc = ST + (n & 1) * 32 * 136;
#pragma unroll
    for (int mt = 0; mt < 2; ++mt)
#pragma unroll
      for (int nt = 0; nt < 2; ++nt)
        *(u32x2*)(STc + (nt * 16 + fr) * 136 + (2 * wid + mt) * 16 + fq * 4) = (u32x2){pk2(S[mt][nt].x, S[mt][nt].y), pk2(S[mt][nt].z, S[mt][nt].w)};
    __syncthreads();
#pragma unroll
    for (int nt = 0; nt < 2; ++nt) {
      f32x4 a = (f32x4){0.f, 0.f, 0.f, 0.f};
#pragma unroll
      for (int ks = 0; ks < 4; ++ks) {
        const bf16x8 sb = *(const bf16x8*)(STc + (nt * 16 + fr) * 136 + ks * 32 + fq * 8);
        a = mfma16(fw[ks], sb, a);
      }
      const float v0 = lo2f(fu[nt].x) - a.x, v1 = hi2f(fu[nt].x) - a.y, v2 = lo2f(fu[nt].y) - a.z, v3 = hi2f(fu[nt].y) - a.w;
      *(u32x2*)(VT + (nt * 16 + fr) * 72 + wid * 16 + fq * 4) = (u32x2){pk2(v0, v1), pk2(v2, v3)};
    }
    __syncthreads();
#pragma unroll
    for (int mt = 0; mt < 2; ++mt) {
      f32x4 a = (f32x4){0.f, 0.f, 0.f, 0.f};
#pragma unroll
      for (int ks = 0; ks < 4; ++ks) {
        const bf16x8 sa = *(const bf16x8*)(STc + (mt * 16 + fr) * 136 + ks * 32 + fq * 8);
        a = mfma16(sa, fqg[ks], a);
      }
#pragma unroll
      for (int ks = 0; ks < 2; ++ks) {
        const bf16x8 va = *(const bf16x8*)(VT + (mt * 16 + fr) * 72 + ks * 32 + fq * 8);
        a = mfma16(va, fqk[ks], a);
      }
      const size_t row = (size_t)b * 2048 + n * 64 + wid * 16 + fr;
      *(u32x2*)(p.ogdn() + row * DM + h * 128 + dvs * 32 + mt * 16 + fq * 4) = (u32x2){pk2(a.x, a.y), pk2(a.z, a.w)};
    }
#pragma unroll
    for (int mt = 0; mt < 2; ++mt)
#pragma unroll
      for (int nt = 0; nt < 2; ++nt) {
        f32x4 a = S[mt][nt] * gs;
#pragma unroll
        for (int ks = 0; ks < 2; ++ks) {
          const bf16x8 vb = *(const bf16x8*)(VT + (nt * 16 + fr) * 72 + ks * 32 + fq * 8);
          a = mfma16(fkg[mt][ks], vb, a);
        }
        S[mt][nt] = a;
      }
  }
  float* so = p.out + O_GDNP + ((size_t)(l * 8 + b) * 8 + h) * 16384;
#pragma unroll
  for (int mt = 0; mt < 2; ++mt)
#pragma unroll
    for (int nt = 0; nt < 2; ++nt)
#pragma unroll
      for (int jj = 0; jj < 4; ++jj) so[((2 * wid + mt) * 16 + fq * 4 + jj) * 128 + dvs * 32 + nt * 16 + fr] = S[mt][nt][jj];
  __syncthreads();
#undef SCAN_LOAD
}

__device__ void gdn_sample_item(const Params& p, int l, int item, unsigned char* smem) {
  const int tid = (opq(threadIdx.x) & 255), lane = tid & 63, wid = tid >> 6;
  const int h = item & 7, b = item >> 3;
  float* qs = (float*)smem;
  float* ks = qs + 1024;
  float* vs = ks + 1024;
  float* part = vs + 1024;
  float* sbeta = part + 256;
  float* sa = sbeta + 8;
  const int dv = tid & 127, half = tid >> 7;
  float S[64];
  const float* s0 = p.state_gdn + ((size_t)(l * 128 + b) * 8 + h) * 16384 + (half * 8192 + dv);
#pragma unroll
  for (int k = 0; k < 64; ++k) S[k] = s0[k * 128];
#pragma unroll
  for (int ps = 0; ps < 2; ++ps) {
    const int c = tid + ps * 256;
    if (c < 384) {
      const int sect = c >> 7, ci = c & 127;
      const int ch = sect * 1024 + h * 128 + ci;
      float xw[11], cwv[4];
#pragma unroll
      for (int j = 0; j < 4; ++j) cwv[j] = p.conv_w[(size_t)(l * 4 + j) * 3072 + ch];
#pragma unroll
      for (int j = 0; j < 3; ++j) xw[j] = p.cache_conv[((size_t)(l * 128 + b) * 3 + j) * 3072 + ch];
#pragma unroll
      for (int t = 0; t < 8; ++t) xw[3 + t] = bf2f(p.proj()[(size_t)(MP + b * 8 + t) * NPJ + ch]);
      float* dst = sect == 0 ? qs : (sect == 1 ? ks : vs);
#pragma unroll
      for (int t = 0; t < 8; ++t) dst[t * 128 + ci] = silu(xw[t] * cwv[0] + xw[t + 1] * cwv[1] + xw[t + 2] * cwv[2] + xw[t + 3] * cwv[3]);
    }
  }
  if (tid < 8) {
    const float* lg = p.logits() + (size_t)(MP + b * 8 + tid) * 16;
    const float x = lg[8 + h] + p.dt_bias[l * 8 + h];
    const float sp = softplus_f(x);
    sa[tid] = __expf(-__expf(p.a_log[l * 8 + h]) * sp);
    sbeta[tid] = sigm(lg[h]);
  }
  __syncthreads();
#pragma unroll
  for (int u = 0; u < 4; ++u) {
    const int t = wid * 2 + (u >> 1);
    float* arr = (u & 1) ? ks : qs;
    const float a0 = arr[t * 128 + lane], a1 = arr[t * 128 + 64 + lane];
    float ss = a0 * a0 + a1 * a1;
#pragma unroll
    for (int o = 1; o < 64; o <<= 1) ss += shx(ss, o, lane);
    float rn = __builtin_amdgcn_rsqf(ss + EPS);
    if (!(u & 1)) rn *= 0.08838834764831845f;
    arr[t * 128 + lane] = a0 * rn;
    arr[t * 128 + 64 + lane] = a1 * rn;
  }
  __syncthreads();
#pragma unroll 1
  for (int t = 0; t < 8; ++t) {
    const float a = sa[t], bt = sbeta[t];
    float kv = 0.f;
#pragma unroll
    for (int k4 = 0; k4 < 16; ++k4) {
      const f32x4 kk = *(const f32x4*)(ks + t * 128 + half * 64 + k4 * 4);
      S[k4 * 4 + 0] *= a; S[k4 * 4 + 1] *= a; S[k4 * 4 + 2] *= a; S[k4 * 4 + 3] *= a;
      kv += S[k4 * 4 + 0] * kk.x + S[k4 * 4 + 1] * kk.y + S[k4 * 4 + 2] * kk.z + S[k4 * 4 + 3] * kk.w;
      if ((k4 & 3) == 3) asm volatile("" ::: "memory");
    }
    part[half * 128 + dv] = kv;
    __syncthreads();
    const float delta = bt * (vs[t * 128 + dv] - (part[dv] + part[128 + dv]));
    __syncthreads();
    float o = 0.f;
#pragma unroll
    for (int k4 = 0; k4 < 16; ++k4) {
      const f32x4 kk = *(const f32x4*)(ks + t * 128 + half * 64 + k4 * 4);
      const f32x4 qq = *(const f32x4*)(qs + t * 128 + half * 64 + k4 * 4);
      S[k4 * 4 + 0] += kk.x * delta; S[k4 * 4 + 1] += kk.y * delta; S[k4 * 4 + 2] += kk.z * delta; S[k4 * 4 + 3] += kk.w * delta;
      o += S[k4 * 4 + 0] * qq.x + S[k4 * 4 + 1] * qq.y + S[k4 * 4 + 2] * qq.z + S[k4 * 4 + 3] * qq.w;
      if ((k4 & 3) == 3) asm volatile("" ::: "memory");
    }
    part[half * 128 + dv] = o;
    __syncthreads();
    if (half == 0) p.ogdn()[(size_t)(MP + b * 8 + t) * DM + h * 128 + dv] = f2bf(part[dv] + part[128 + dv]);
    __syncthreads();
  }
  float* so = p.out + O_GDNS + ((size_t)(l * 128 + b) * 8 + h) * 16384 + opq(half * 8192 + dv);
#pragma unroll
  for (int k = 0; k < 64; ++k) so[k * 128] = S[k];
  __syncthreads();
}

__device__ void gdn_sample_pair(const Params& p, int l, int pair, unsigned char* smem) {
  const int tid = (opq(threadIdx.x) & 255), lane = tid & 63, wid = tid >> 6;
  const int sub = tid >> 7, dv = tid & 127;
  const int item = pair * 2 + sub, h = item & 7, b = item >> 3;
  float* qs = (float*)smem + sub * 3104;
  float* ks = qs + 1024;
  float* vs = qs + 2048;
  float* sbeta = qs + 3072;
  float* sa = qs + 3080;
  f32x2 S2[64];
  const float* s0 = p.state_gdn + ((size_t)(l * 128 + b) * 8 + h) * 16384 + dv;
#pragma unroll
  for (int k = 0; k < 64; ++k) { S2[k].x = s0[(2 * k) * 128]; S2[k].y = s0[(2 * k + 1) * 128]; }
#pragma unroll
  for (int sect = 0; sect < 3; ++sect) {
    const int ch = sect * 1024 + h * 128 + dv;
    float xw[11], cwv[4];
#pragma unroll
    for (int j = 0; j < 4; ++j) cwv[j] = p.conv_w[(size_t)(l * 4 + j) * 3072 + ch];
#pragma unroll
    for (int j = 0; j < 3; ++j) xw[j] = p.cache_conv[((size_t)(l * 128 + b) * 3 + j) * 3072 + ch];
#pragma unroll
    for (int t = 0; t < 8; ++t) xw[3 + t] = bf2f(p.proj()[(size_t)(MP + b * 8 + t) * NPJ + ch]);
    float* dst = sect == 0 ? qs : (sect == 1 ? ks : vs);
#pragma unroll
    for (int t = 0; t < 8; ++t) dst[t * 128 + dv] = silu(xw[t] * cwv[0] + xw[t + 1] * cwv[1] + xw[t + 2] * cwv[2] + xw[t + 3] * cwv[3]);
  }
  if (dv < 8) {
    const float* lg = p.logits() + (size_t)(MP + b * 8 + dv) * 16;
    const float x = lg[8 + h] + p.dt_bias[l * 8 + h];
    sa[dv] = __expf(-__expf(p.a_log[l * 8 + h]) * softplus_f(x));
    sbeta[dv] = sigm(lg[h]);
  }
  __syncthreads();
#pragma unroll
  for (int u = 0; u < 8; ++u) {
    const int t = (wid & 1) * 4 + (u >> 1);
    float* arr = (u & 1) ? ks : qs;
    const float a0 = arr[t * 128 + lane], a1 = arr[t * 128 + 64 + lane];
    float ss = a0 * a0 + a1 * a1;
#pragma unroll
    for (int o = 1; o < 64; o <<= 1) ss += shx(ss, o, lane);
    float rn = __builtin_amdgcn_rsqf(ss + EPS);
    if (!(u & 1)) rn *= 0.08838834764831845f;
    arr[t * 128 + lane] = a0 * rn;
    arr[t * 128 + 64 + lane] = a1 * rn;
  }
  __syncthreads();
#pragma unroll 1
  for (int t = 0; t < 8; ++t) {
    const float a = sa[t], bt = sbeta[t];
    f32x2 kv2 = (f32x2){0.f, 0.f};
#pragma unroll
    for (int k4 = 0; k4 < 32; ++k4) {
      const f32x4 kk = *(const f32x4*)(ks + t * 128 + k4 * 4);
      kv2 += S2[2 * k4] * (f32x2){kk.x, kk.y};
      kv2 += S2[2 * k4 + 1] * (f32x2){kk.z, kk.w};
      if ((k4 & 3) == 3) asm volatile("" ::: "memory");
    }
    const float delta = bt * (vs[t * 128 + dv] - a * (kv2.x + kv2.y));
    const f32x2 a2 = (f32x2){a, a}, d2 = (f32x2){delta, delta};
    f32x2 o2 = (f32x2){0.f, 0.f};
#pragma unroll
    for (int k4 = 0; k4 < 32; ++k4) {
      const f32x4 kk = *(const f32x4*)(ks + t * 128 + k4 * 4);
      const f32x4 qq = *(const f32x4*)(qs + t * 128 + k4 * 4);
      S2[2 * k4] = S2[2 * k4] * a2 + (f32x2){kk.x, kk.y} * d2;
      S2[2 * k4 + 1] = S2[2 * k4 + 1] * a2 + (f32x2){kk.z, kk.w} * d2;
      o2 += S2[2 * k4] * (f32x2){qq.x, qq.y};
      o2 += S2[2 * k4 + 1] * (f32x2){qq.z, qq.w};
      if ((k4 & 3) == 3) asm volatile("" ::: "memory");
    }
    p.ogdn()[(size_t)(MP + b * 8 + t) * DM + h * 128 + dv] = f2bf(o2.x + o2.y);
  }
  float* so = p.out + O_GDNS + ((size_t)(l * 128 + b) * 8 + h) * 16384 + opq(dv);
#pragma unroll
  for (int k = 0; k < 64; ++k) { so[(2 * k) * 128] = S2[k].x; so[(2 * k + 1) * 128] = S2[k].y; }
  __syncthreads();
}

__device__ void swa_prompt_item(const Params& p, int l, int item, unsigned char* smem) {
  const int tid = (opq(threadIdx.x) & 255), lane = tid & 63, wid = tid >> 6, fr = lane & 15, fq = lane >> 4;
  const int kvh = item & 3, hb2 = (item >> 2) & 31, b = item >> 7;
  bf16_t* Ks = (bf16_t*)smem;
  bf16_t* VT = Ks + 208 * 72;
  bf16_t* Pw = VT + 64 * 216 + wid * 16 * 168;
  const int tk0 = hb2 * 64 - 128;
  u32x4 krw[7], vrw[7];
#pragma unroll
  for (int i = 0; i < 7; ++i) {
    const int pc = tid + i * NTHR, kj = pc >> 3, c8 = pc & 7, tk = tk0 + kj;
    krw[i] = (u32x4){0u, 0u, 0u, 0u}; vrw[i] = (u32x4){0u, 0u, 0u, 0u};
    if (pc < 208 * 8 && kj < 192 && tk >= 0) {
      const bf16_t* base = p.proj() + (size_t)(b * 2048 + tk) * NPJ + kvh * 64 + c8 * 8;
      krw[i] = *(const u32x4*)(base + C_SK); vrw[i] = *(const u32x4*)(base + C_SV);
    }
  }
#pragma unroll
  for (int i = 0; i < 7; ++i) {
    const int pc = tid + i * NTHR;
    if (pc >= 208 * 8) break;
    const int kj = pc >> 3, c8 = pc & 7, tk = tk0 + kj;
    const bool ok = kj < 192 && tk >= 0;
    float kf[8], vf[8];
    UNPACK8(krw[i], kf);
    UNPACK8(vrw[i], vf);
    float ss = 0.f;
#pragma unroll
    for (int c = 0; c < 8; ++c) ss += kf[c] * kf[c];
    ss += shx(ss, 1, lane); ss += shx(ss, 2, lane); ss += shx(ss, 4, lane);
    const float rn = __builtin_amdgcn_rsqf(ss * (1.f / 64.f) + EPS);
    const f32x4 w0 = *(const f32x4*)(p.k_norm + l * 64 + c8 * 8), w1 = *(const f32x4*)(p.k_norm + l * 64 + c8 * 8 + 4);
    kf[0] *= rn * w0.x; kf[1] *= rn * w0.y; kf[2] *= rn * w0.z; kf[3] *= rn * w0.w;
    kf[4] *= rn * w1.x; kf[5] *= rn * w1.y; kf[6] *= rn * w1.z; kf[7] *= rn * w1.w;
    *(u32x4*)(Ks + kj * 72 + c8 * 8) = (u32x4){pk2(kf[0], kf[1]), pk2(kf[2], kf[3]), pk2(kf[4], kf[5]), pk2(kf[6], kf[7])};
#pragma unroll
    for (int c = 0; c < 8; ++c) VT[(c8 * 8 + c) * 216 + kj] = f2bf(vf[c]);
    if (ok && tk >= 1920 && kj >= 128) {
      float* ko = p.out + O_KP + (((size_t)(l * 8 + b) * 128 + (tk - 1920)) * 4 + kvh) * 64 + c8 * 8;
      float* vo = p.out + O_VP + (((size_t)(l * 8 + b) * 128 + (tk - 1920)) * 4 + kvh) * 64 + c8 * 8;
      *(f32x4*)ko = (f32x4){kf[0], kf[1], kf[2], kf[3]};
      *(f32x4*)(ko + 4) = (f32x4){kf[4], kf[5], kf[6], kf[7]};
      *(f32x4*)vo = (f32x4){vf[0], vf[1], vf[2], vf[3]};
      *(f32x4*)(vo + 4) = (f32x4){vf[4], vf[5], vf[6], vf[7]};
    }
  }
  __syncthreads();
  const int kbase = wid * 16;
  const int ql = wid * 16 + fr;
  const size_t qrow = (size_t)b * 2048 + hb2 * 64 + ql;
  u32x4 qraw[4][2];
#pragma unroll
  for (int g = 0; g < 4; ++g) {
    const bf16_t* qp = p.proj() + qrow * NPJ + C_SQ + (kvh * 4 + g) * 64 + fq * 8;
    qraw[g][0] = *(const u32x4*)qp; qraw[g][1] = *(const u32x4*)(qp + 32);
  }
#pragma unroll
  for (int g = 0; g < 4; ++g) {
    const int head = kvh * 4 + g;
    const float slope = exp2f(-0.5f * (float)(head + 1));
    const float sink = p.sinks[l * 16 + head];
    bf16x8 qf[2];
    {
      const u32x4 r0 = qraw[g][0], r1 = qraw[g][1];
      float f0[8], f1[8];
      UNPACK8(r0, f0);
      UNPACK8(r1, f1);
      float ss = 0.f;
#pragma unroll
      for (int c = 0; c < 8; ++c) ss += f0[c] * f0[c] + f1[c] * f1[c];
      ss += shx(ss, 16, lane); ss += shx(ss, 32, lane);
      const float rn = __builtin_amdgcn_rsqf(ss * (1.f / 64.f) + EPS) * 0.125f;
      const float* qn = p.q_norm + l * 64 + fq * 8;
#pragma unroll
      for (int c = 0; c < 8; ++c) { f0[c] *= rn * qn[c]; f1[c] *= rn * qn[32 + c]; }
      qf[0] = as_bf((u32x4){pk2(f0[0], f0[1]), pk2(f0[2], f0[3]), pk2(f0[4], f0[5]), pk2(f0[6], f0[7])});
      qf[1] = as_bf((u32x4){pk2(f1[0], f1[1]), pk2(f1[2], f1[3]), pk2(f1[4], f1[5]), pk2(f1[6], f1[7])});
    }
    f32x4 sc[9];
    float mx = sink;
#pragma unroll
    for (int kt = 0; kt < 9; ++kt) {
      f32x4 a = (f32x4){0.f, 0.f, 0.f, 0.f};
#pragma unroll
      for (int ks = 0; ks < 2; ++ks) {
        const bf16x8 kf = *(const bf16x8*)(Ks + (kbase + kt * 16 + fr) * 72 + ks * 32 + fq * 8);
        a = mfma16(kf, qf[ks], a);
      }
#pragma unroll
      for (int jj = 0; jj < 4; ++jj) {
        const int kj = kbase + kt * 16 + fq * 4 + jj;
        const int dist = ql + 128 - kj;
        const bool ok = dist >= 0 && dist <= 128 && (tk0 + kj) >= 0;
        const float s = ok ? a[jj] - slope * (float)dist : -INFINITY;
        a[jj] = s;
        mx = fmaxf(mx, s);
      }
      sc[kt] = a;
    }
    mx = fmaxf(mx, shx(mx, 16, lane));
    mx = fmaxf(mx, shx(mx, 32, lane));
    float sum = 0.f;
#pragma unroll
    for (int kt = 0; kt < 9; ++kt) {
      f32x4 e;
#pragma unroll
      for (int jj = 0; jj < 4; ++jj) { e[jj] = __expf(sc[kt][jj] - mx); sum += e[jj]; }
      *(u32x2*)(Pw + fr * 168 + kt * 16 + fq * 4) = (u32x2){pk2(e.x, e.y), pk2(e.z, e.w)};
    }
    *(u32x2*)(Pw + fr * 168 + 144 + fq * 4) = (u32x2){0u, 0u};
    sum += shx(sum, 16, lane);
    sum += shx(sum, 32, lane);
    const float inv = __builtin_amdgcn_rcpf(sum + __expf(sink - mx));
    __builtin_amdgcn_wave_barrier();
#pragma unroll
    for (int dt = 0; dt < 4; ++dt) {
      f32x4 a = (f32x4){0.f, 0.f, 0.f, 0.f};
#pragma unroll
      for (int ks = 0; ks < 5; ++ks) {
        const bf16x8 vf = *(const bf16x8*)(VT + (dt * 16 + fr) * 216 + kbase + ks * 32 + fq * 8);
        const bf16x8 pf = *(const bf16x8*)(Pw + fr * 168 + ks * 32 + fq * 8);
        a = mfma16(vf, pf, a);
      }
      a *= inv;
      *(u32x2*)(p.oswa() + qrow * DM + head * 64 + dt * 16 + fq * 4) = (u32x2){pk2(a.x, a.y), pk2(a.z, a.w)};
    }
    __builtin_amdgcn_wave_barrier();
  }
  __syncthreads();
}

__device__ void swa_sample_item(const Params& p, int l, int item, unsigned char* smem) {
  const int tid = (opq(threadIdx.x) & 255), lane = tid & 63, wid = tid >> 6;
  const int kvh = item & 3, b = item >> 2;
  float* Ks = (float*)smem;
  float* Vs = Ks + 136 * 68;
  float* Qs = Vs + 136 * 64;
  float* Sc = Qs + 512;
  const size_t cbase = (size_t)(l * 128 + b) * 128;
  f32x4 kvr[8], vvr[8];
#pragma unroll
  for (int i = 0; i < 8; ++i) {
    const int idx = tid + i * NTHR, j = idx >> 4, c4 = idx & 15;
    kvr[i] = *(const f32x4*)(p.cache_k + ((cbase + j) * 4 + kvh) * 64 + c4 * 4);
    vvr[i] = *(const f32x4*)(p.cache_v + ((cbase + j) * 4 + kvh) * 64 + c4 * 4);
  }
  unsigned qrw[4];
#pragma unroll
  for (int g = 0; g < 4; ++g) qrw[g] = *(const unsigned*)(p.proj() + (size_t)(MP + b * 8 + (tid >> 5)) * NPJ + C_SQ + (kvh * 4 + g) * 64 + (tid & 31) * 2);
#pragma unroll
  for (int i = 0; i < 8; ++i) {
    const int idx = tid + i * NTHR, j = idx >> 4, c4 = idx & 15;
    const f32x4 kv = kvr[i], vv = vvr[i];
    *(f32x4*)(Ks + j * 68 + c4 * 4) = kv;
    *(f32x4*)(Vs + j * 64 + c4 * 4) = vv;
  }
  {
    const int t = tid >> 5, d = (tid & 31) * 2;
    const bf16_t* base = p.proj() + (size_t)(MP + b * 8 + t) * NPJ + kvh * 64 + d;
    const unsigned kr = *(const unsigned*)(base + C_SK), vr = *(const unsigned*)(base + C_SV);
    float k0 = lo2f(kr), k1 = hi2f(kr);
    float ss = k0 * k0 + k1 * k1;
#pragma unroll
    for (int o = 1; o < 32; o <<= 1) ss += shx(ss, o, lane);
    const float rn = __builtin_amdgcn_rsqf(ss * (1.f / 64.f) + EPS);
    Ks[(128 + t) * 68 + d] = k0 * rn * p.k_norm[l * 64 + d];
    Ks[(128 + t) * 68 + d + 1] = k1 * rn * p.k_norm[l * 64 + d + 1];
    Vs[(128 + t) * 64 + d] = lo2f(vr);
    Vs[(128 + t) * 64 + d + 1] = hi2f(vr);
  }
  __syncthreads();
  for (int idx = tid; idx < 128 * 64; idx += NTHR) {
    const int j = idx >> 6, d = idx & 63;
    p.out[O_KS + ((cbase + j) * 4 + kvh) * 64 + d] = Ks[(j + 8) * 68 + d];
    p.out[O_VS + ((cbase + j) * 4 + kvh) * 64 + d] = Vs[(j + 8) * 64 + d];
  }
#pragma unroll
  for (int g = 0; g < 4; ++g) {
    const int head = kvh * 4 + g;
    const float slope = exp2f(-0.5f * (float)(head + 1));
    const float sink = p.sinks[l * 16 + head];
    {
      const int t = tid >> 5, d = (tid & 31) * 2;
      const unsigned qr = qrw[g];
      const float q0 = lo2f(qr), q1 = hi2f(qr);
      float ss = q0 * q0 + q1 * q1;
#pragma unroll
      for (int o = 1; o < 32; o <<= 1) ss += shx(ss, o, lane);
      const float rn = __builtin_amdgcn_rsqf(ss * (1.f / 64.f) + EPS) * 0.125f;
      Qs[t * 64 + d] = q0 * rn * p.q_norm[l * 64 + d];
      Qs[t * 64 + d + 1] = q1 * rn * p.q_norm[l * 64 + d + 1];
    }
    __syncthreads();
    for (int idx = tid; idx < 8 * 136; idx += NTHR) {
      const int tq = idx / 136, j = idx % 136;
      float s = 0.f;
#pragma unroll
      for (int d4 = 0; d4 < 16; ++d4) {
        const f32x4 qv = *(const f32x4*)(Qs + tq * 64 + d4 * 4), kq = *(const f32x4*)(Ks + j * 68 + d4 * 4);
        s += (qv.x * kq.x + qv.y * kq.y) + (qv.z * kq.z + qv.w * kq.w);
      }
      const int dist = tq + 128 - j;
      Sc[tq * 136 + j] = (dist >= 0 && dist <= 128) ? s - slope * (float)dist : -INFINITY;
    }
    __syncthreads();
#pragma unroll
    for (int u = 0; u < 2; ++u) {
      const int tq = wid * 2 + u;
      const float s0 = Sc[tq * 136 + lane], s1 = Sc[tq * 136 + 64 + lane], s2 = lane < 8 ? Sc[tq * 136 + 128 + lane] : -INFINITY;
      float mx = fmaxf(fmaxf(s0, s1), fmaxf(s2, sink));
#pragma unroll
      for (int o = 1; o < 64; o <<= 1) mx = fmaxf(mx, shx(mx, o, lane));
      const float e0 = __expf(s0 - mx), e1 = __expf(s1 - mx), e2 = __expf(s2 - mx);
      float sum = e0 + e1 + e2;
#pragma unroll
      for (int o = 1; o < 64; o <<= 1) sum += shx(sum, o, lane);
      const float inv = __builtin_amdgcn_rcpf(sum + __expf(sink - mx));
      Sc[tq * 136 + lane] = e0 * inv;
      Sc[tq * 136 + 64 + lane] = e1 * inv;
      if (lane < 8) Sc[tq * 136 + 128 + lane] = e2 * inv;
    }
    __syncthreads();
    {
      const int tq = tid >> 5, d = (tid & 31) * 2;
      float o0 = 0.f, o1 = 0.f;
#pragma unroll 2
      for (int j4 = 0; j4 < 34; ++j4) {
        const f32x4 pj = *(const f32x4*)(Sc + tq * 136 + j4 * 4);
        const f32x2 va = *(const f32x2*)(Vs + (j4 * 4 + 0) * 64 + d), vb = *(const f32x2*)(Vs + (j4 * 4 + 1) * 64 + d);
        const f32x2 vc = *(const f32x2*)(Vs + (j4 * 4 + 2) * 64 + d), vd = *(const f32x2*)(Vs + (j4 * 4 + 3) * 64 + d);
        o0 += (pj.x * va.x + pj.y * vb.x) + (pj.z * vc.x + pj.w * vd.x);
        o1 += (pj.x * va.y + pj.y * vb.y) + (pj.z * vc.y + pj.w * vd.y);
      }
      *(unsigned*)(p.oswa() + (size_t)(MP + b * 8 + tq) * DM + head * 64 + d) = pk2(o0, o1);
    }
    __syncthreads();
  }
}

__device__ void phase_mix(const Params& p, int l) {
  const int tid = (opq(threadIdx.x) & 255), lane = tid & 63, wid = tid >> 6, fr = lane & 15, fq = lane >> 4;
  for (int it = VB; it < MTOK / 4; it += VG) {
    const size_t row = (size_t)it * 4 + wid;
#pragma unroll
    for (int ps = 0; ps < 2; ++ps) {
      const int ch = (ps * 4 + fq) * 128 + fr * 8;
      const u32x4 og = *(const u32x4*)(p.ogdn() + row * DM + ch);
      const u32x4 ob = *(const u32x4*)(p.oswa() + row * DM + ch);
      const u32x4 zz = *(const u32x4*)(p.proj() + row * NPJ + C_Z + ch);
      const u32x4 ga = *(const u32x4*)(p.proj() + row * NPJ + C_G + ch);
      const u32x4 gb = *(const u32x4*)(p.proj() + row * NPJ + C_G + 1024 + ch);
      float fo[8], fb[8], fz[8], fa[8], fg[8];
      UNPACK8(og, fo); UNPACK8(ob, fb); UNPACK8(zz, fz); UNPACK8(ga, fa); UNPACK8(gb, fg);
      float ss = 0.f;
#pragma unroll
      for (int c = 0; c < 8; ++c) ss += fo[c] * fo[c];
      ss += shx(ss, 1, lane); ss += shx(ss, 2, lane); ss += shx(ss, 4, lane); ss += shx(ss, 8, lane);
      const float rn = __builtin_amdgcn_rsqf(ss * (1.f / 128.f) + EPS);
      const f32x4 w0 = *(const f32x4*)(p.gdn_norm + l * 128 + fr * 8), w1 = *(const f32x4*)(p.gdn_norm + l * 128 + fr * 8 + 4);
      const float wn[8] = {w0.x, w0.y, w0.z, w0.w, w1.x, w1.y, w1.z, w1.w};
      float m[8];
#pragma unroll
      for (int c = 0; c < 8; ++c) m[c] = sigm(fa[c]) * (fo[c] * rn * wn[c] * silu(fz[c])) + sigm(fg[c]) * fb[c];
      *(u32x4*)(p.mix() + row * DM + ch) = (u32x4){pk2(m[0], m[1]), pk2(m[2], m[3]), pk2(m[4], m[5]), pk2(m[6], m[7])};
    }
  }
  const int NC = (8 + 128) * 3 * 3072;
  for (int i = VB * NTHR + tid; i < NC; i += VG * NTHR) {
    const int c = i % 3072, r = (i / 3072) % 3, bb = i / 9216;
    if (bb < 8) p.out[O_CONVP + ((size_t)(l * 8 + bb) * 3 + r) * 3072 + c] = bf2f(p.proj()[(size_t)(bb * 2048 + 2045 + r) * NPJ + c]);
    else p.out[O_CONVS + ((size_t)(l * 128 + bb - 8) * 3 + r) * 3072 + c] = bf2f(p.proj()[(size_t)(MP + (bb - 8) * 8 + 5 + r) * NPJ + c]);
  }
}

#define XB_TMO      128
#define XB_XCNT(j)  (256  + 64 * (j))
#define XB_XSUB(j)  (1280 + 64 * (j))
#define XB_XGEN(j)  (2304 + 64 * (j))
#define XB_TOP      3328
#define XB_TOPGEN   3392
#define XCD_BAR_WORDS 3456
#define XB_SPIN_CAP (1u << 18)
#define LAS __attribute__((address_space(3)))

__device__ __forceinline__ unsigned xb_ld(unsigned* p)              { return __hip_atomic_load(p, __ATOMIC_RELAXED, __HIP_MEMORY_SCOPE_AGENT); }
__device__ __forceinline__ unsigned xb_add(unsigned* p, unsigned v) { return __hip_atomic_fetch_add(p, v, __ATOMIC_RELAXED, __HIP_MEMORY_SCOPE_AGENT); }
__device__ __forceinline__ unsigned xb_xcc_id() { return (unsigned)__builtin_amdgcn_s_getreg((3 << 11) | 20) & 0xFu; }
#define XB_SPIN(cond, bar) do { unsigned _sp = 0; while (cond) { __builtin_amdgcn_s_sleep(1); \
    if ((++_sp & 255u) == 0u) { if (xb_ld(&(bar)[XB_TMO])) break; if (_sp > XB_SPIN_CAP) { atomicAdd(&(bar)[XB_TMO], 1u); break; } } } } while (0)

struct XcdBarrier {
    unsigned* bar; unsigned x;
    volatile LAS unsigned* st;
};

__device__ __forceinline__ XcdBarrier xcd_barrier_post(unsigned* bar, volatile LAS unsigned* st) {
    XcdBarrier b; b.bar = bar; b.x = xb_xcc_id(); b.st = st;
    if (threadIdx.x == 0) (void)xb_add(&bar[XB_XCNT(b.x)], 1u);
    return b;
}
__device__ __forceinline__ void xcd_barrier_complete(unsigned* bar, unsigned x, unsigned& nloc, unsigned& nx) {
    const unsigned G = gridDim.x * gridDim.y * gridDim.z;
    unsigned sum, cnt, mine, sp = 0u;
    for (;;) {
        sum = 0u; cnt = 0u; mine = 0u;
#pragma unroll
        for (unsigned j = 0; j < 16; ++j) { const unsigned c = xb_ld(&bar[XB_XCNT(j)]); sum += c; cnt += (c > 0u) ? 1u : 0u; mine = (j == x) ? c : mine; }
        if (sum == G) break;
        __builtin_amdgcn_s_sleep(1);
        if ((++sp & 255u) == 0u) { if (xb_ld(&bar[XB_TMO])) break; if (sp > XB_SPIN_CAP) { atomicAdd(&bar[XB_TMO], 1u); break; } }
    }
    nloc = mine > 0u ? mine : 1u; nx = cnt > 0u ? cnt : 1u;
}

__device__ __forceinline__ void xcd_barrier(const XcdBarrier& b) {
    asm volatile("s_waitcnt vmcnt(0)" ::: "memory");
    __syncthreads();
    if (threadIdx.x == 0) {
        unsigned* bar = b.bar;
        __builtin_amdgcn_s_waitcnt(0);
        unsigned nloc = b.st[0], nx = b.st[1];
        if (nloc == 0u) { xcd_barrier_complete(bar, b.x, nloc, nx); b.st[0] = nloc; b.st[1] = nx; }
        const unsigned old = xb_add(&bar[XB_XSUB(b.x)], 1u);
        const unsigned gen = old / nloc;
        if (old + 1u == (gen + 1u) * nloc) {
            __builtin_amdgcn_fence(__ATOMIC_RELEASE, "agent");
            asm volatile("s_waitcnt vmcnt(0)" ::: "memory");
            const unsigned og = xb_add(&bar[XB_TOP], 1u);
            const unsigned tg = og / nx;
            if (og + 1u == (tg + 1u) * nx) xb_add(&bar[XB_TOPGEN], 1u);
            else XB_SPIN(xb_ld(&bar[XB_TOPGEN]) == tg, bar);
            __builtin_amdgcn_fence(__ATOMIC_ACQUIRE, "agent");
            xb_add(&bar[XB_XGEN(b.x)], 1u);
            asm volatile("s_waitcnt vmcnt(0)" ::: "memory");
        } else {
            XB_SPIN(xb_ld(&bar[XB_XGEN(b.x)]) == gen, bar);
            __builtin_amdgcn_fence(__ATOMIC_ACQUIRE, "agent");
            asm volatile("s_waitcnt vmcnt(0)" ::: "memory");
        }
    }
    __syncthreads();
}


#define NPHASE_PRE 2
#define NPHASE_L 8
constexpr int LDS_TOTAL = 2 * SMEM_BYTES;
__global__ void __launch_bounds__(512, 2) mega(Params p, int ph_lo, int ph_hi) {
  extern __shared__ __attribute__((aligned(16))) unsigned char lds_all[];
  if (ph_hi < 0) cg::this_grid().sync();
  __shared__ uint4 xb_words;
  if (threadIdx.x == 0) xb_words = make_uint4(0u, 0u, 0u, 0u);
  __syncthreads();
  XcdBarrier xb = xcd_barrier_post(p.bar(), (volatile LAS unsigned*)&xb_words);
  unsigned char* smem = lds_all + VHALF * SMEM_BYTES;
  for (int ph = ph_lo; ph < ph_hi; ++ph) {
    if (ph > ph_lo) xcd_barrier(xb);
    if (ph == 0) { phase_p0(p, smem); continue; }
    if (ph == 1) {
      {
        EpiArgs e{};
        e.obf = p.pp(); e.ldo = DM;
        DiagSched S; S.nLimit = 1024; S.G = gridDim.x; S.c = blockIdx.x;
        pg8::Gemm g; g.A = p.pb(); g.Bt = p.wt_proj(); g.M = NL * MTOK; g.N = NL * DM; g.K = PLE;
        BigEpi<EPI_PP> E; E.e = e;
        pg8::gemm_phase<BigEpi<EPI_PP>, DiagSched>((PG8_LAS unsigned char*)lds_all, g, S, E, nullptr);
        __syncthreads();
      }
      for (int st = VB; st < 64 * 16; st += VG) {
        const int L = 1024 + (st >> 4), sub = st & 15, l = L / 272, r = L - l * 272, pm = r >> 2, pn = r & 3;
        EpiArgs e{};
        e.obf = p.pp() + (size_t)l * MTOK * DM; e.ldo = DM;
        gemm_tile<1, 4, 4, 1, EPI_PP, 128>(p.pb() + (size_t)l * MTOK * PLE, PLE, p.wt_proj() + (size_t)l * DM * PLE, PLE, PLE, pm * 256 + (sub >> 2) * 64, pn * 256 + (sub & 3) * 64, (bf16_t*)smem, e);
      }
      continue;
    }
    const int l = (ph - NPHASE_PRE) / NPHASE_L, s = (ph - NPHASE_PRE) % NPHASE_L;
#ifndef REPMASK
#define REPMASK 0
#endif
    for (int rep = 0; rep < (((REPMASK >> s) & 1) ? 2 : 1); ++rep) {
    if (rep) xcd_barrier(xb);
    switch (s) {
      case 0: {
        EpiArgs e{};
        e.ssq_in = p.ssq0(); e.obf = p.proj(); e.ldo = NPJ; e.of32 = p.logits();
        const bf16_t* Bt = p.wt_in() + (size_t)l * NIN * DM;
        gemm_big_phase<EPI_PROJ>(p.hb(), Bt, DM, MTOK, NPJ, lds_all, smem, e);
        for (int t = VB; t < 272; t += VG)
          gemm_tile<1, 1, 4, 1, EPI_LOGIT, 128>(p.hb(), DM, Bt + (size_t)NPJ * DM, DM, DM, t * 64, 0, (bf16_t*)smem, e);
      } break;
      case 1: {
        const int nB1 = VG == 512 ? 3072 : 3584;
        for (int t = VB; t < nB1; t += VG) {
          if (t < 2048) gdn_prep_item(p, l, t, smem);
          else if (t < 3072) swa_prompt_item(p, l, t - 2048, smem);
          else swa_sample_item(p, l, t - 3072, smem);
        }
      } break;
      case 2: {
        if (VG == 512) {
          if (VB < 256) gdn_scan_item(p, l, VB, smem);
          else {
            gdn_sample_pair(p, l, VB - 256, smem); gdn_sample_pair(p, l, VB, smem);
            swa_sample_item(p, l, (VB - 256) * 2, smem); swa_sample_item(p, l, (VB - 256) * 2 + 1, smem);
          }
        } else {
          for (int t = VB; t < 256 + 512; t += VG) {
            if (t < 256) gdn_scan_item(p, l, t, smem);
            else gdn_sample_pair(p, l, t - 256, smem);
          }
        }
      } break;
      case 3: phase_mix(p, l); break;
      case 4: {
        EpiArgs e{};
        e.hin = p.hb(); e.hb = p.hb2(); e.ssq_out = p.ssq1();
        gemm_big_phase<EPI_RESID>(p.mix(), p.wt_out() + (size_t)l * DM * DM, DM, MTOK, DM, lds_all, smem, e);
      } break;
      case 5: {
        EpiArgs e{};
        e.ssq_in = p.ssq1(); e.obf = p.proj(); e.ldo = DFF;
        gemm_big_phase<EPI_UP>(p.hb2(), p.wt_up() + (size_t)l * DFF * DM, DM, MTOK, DFF, lds_all, smem, e);
      } break;
      case 6: {
        EpiArgs e{};
        e.hin = p.hb2(); e.hb = p.hb2(); e.ssq_out = p.ssq2();
        gemm_big_phase<EPI_RESID>(p.proj(), p.wt_down() + (size_t)l * DM * DFF, DFF, MTOK, DM, lds_all, smem, e);
      } break;
      case 7: {
        EpiArgs e{};
        e.hin = p.hb2(); e.h = (l == NL - 1) ? p.out : nullptr; e.hb = p.hb(); e.ssq_in = p.ssq2(); e.ssq_out = p.ssq0(); e.pp = p.pp() + (size_t)l * MTOK * DM;
        gemm_big_phase<EPI_PLE>(p.hb2(), p.wt_gate() + (size_t)l * DM * DM, DM, MTOK, DM, lds_all, smem, e);
      } break;
    }
    }
  }
}

extern "C" void kernel_launch(void* const* d_in, const int* in_sizes, int n_in, void* d_out, int out_size, void* d_ws, size_t ws_size,
                              hipStream_t stream) {
  Params p{};
  const float* const* in = (const float* const*)d_in;
  p.x_prompt = in[0]; p.x_sample = in[1]; p.cache_conv = in[2]; p.state_gdn = in[3]; p.cache_k = in[4]; p.cache_v = in[5];
  p.p_prompt = in[6]; p.p_sample = in[7]; p.norm_mix = in[8]; p.w_in = in[9]; p.conv_w = in[10]; p.a_log = in[11]; p.dt_bias = in[12];
  p.gdn_norm = in[13]; p.q_norm = in[14]; p.k_norm = in[15]; p.sinks = in[16]; p.w_out = in[17]; p.norm_ffn = in[18]; p.w_up = in[19];
  p.w_down = in[20]; p.norm_ple = in[21]; p.w_gate = in[22]; p.w_proj = in[23];
  p.out = (float*)d_out;
  p.ws = (unsigned char*)d_ws;
  if (WS_TOTAL > ws_size) { fprintf(stderr, "workspace too small: need %zu have %zu\n", (size_t)WS_TOTAL, ws_size); return; }

  static int grid_blocks = 0;
  if (!grid_blocks) {
    int dev = 0, cus = 0, per_cu = 0;
    (void)hipGetDevice(&dev);
    (void)hipDeviceGetAttribute(&cus, hipDeviceAttributeMultiprocessorCount, dev);
    if (hipFuncSetAttribute((const void*)mega, hipFuncAttributeMaxDynamicSharedMemorySize, LDS_TOTAL) != hipSuccess) { fprintf(stderr, "hipFuncSetAttribute(dynamic LDS %d) failed\n", LDS_TOTAL); grid_blocks = -1; return; }
    (void)hipOccupancyMaxActiveBlocksPerMultiprocessor(&per_cu, (const void*)mega, 512, LDS_TOTAL);
    (void)hipGetLastError();
    grid_blocks = cus;
  }
  if (grid_blocks < 0) return;
  (void)hipMemsetAsync(p.ws + WO_bar, 0, (size_t)XCD_BAR_WORDS * 4, stream);
  int lo = 0, hi = NPHASE_PRE + NL * NPHASE_L;
  void* args[] = {&p, &lo, &hi};
  hipError_t e = hipLaunchCooperativeKernel((void*)mega, dim3(grid_blocks), dim3(512), args, LDS_TOTAL, stream);
  if (e != hipSuccess) fprintf(stderr, "cooperative launch failed: %s (grid %d)\n", hipGetErrorString(e), grid_blocks);
}
```

```cpp
#include <hip/hip_runtime.h>
#include <hip/hip_cooperative_groups.h>
#include <cstdio>
namespace cg = cooperative_groups;

typedef unsigned short bf16_t;
typedef short bf16x8 __attribute__((ext_vector_type(8)));
typedef float f32x4 __attribute__((ext_vector_type(4)));
typedef float f32x2 __attribute__((ext_vector_type(2)));
typedef unsigned u32x4 __attribute__((ext_vector_type(4)));
typedef unsigned u32x2 __attribute__((ext_vector_type(2)));

#define DEVI __device__ __forceinline__
DEVI int opq(int x) { asm volatile("" : "+v"(x)); return x; }

#define VHALF ((int)__builtin_amdgcn_readfirstlane((int)(threadIdx.x >> 8)))
#define VB ((int)blockIdx.x * 2 + VHALF)
#define VG ((int)gridDim.x * 2)
constexpr int NL = 4;
constexpr int MTOK = 17408, MP = 16384, MS = 1024;
constexpr int DM = 1024, NIN = 7696, NPJ = 7680, DFF = 4096, PLE = 256;
constexpr int C_Z = 3072, C_SQ = 4096, C_SK = 5120, C_SV = 5376, C_G = 5632;
constexpr float EPS = 1e-6f;
constexpr int NTHR = 256;
constexpr int SMEM_BYTES = 79872;
constexpr size_t SCR_ITEM = 73728;

constexpr size_t O_YP = 0, O_YS = 16777216, O_CONVP = 17825792, O_GDNP = 18120704, O_KP = 22315008, O_VP = 23363584,
                 O_CONVS = 24412160, O_GDNS = 29130752, O_KS = 96239616, O_VS = 113016832, O_END = 129794048;

constexpr size_t al256(size_t x) { return (x + 255) & ~(size_t)255; }
constexpr size_t WO_wt_in = 0;
constexpr size_t WO_wt_out = WO_wt_in + al256((size_t)NL * NIN * DM * 2);
constexpr size_t WO_wt_up = WO_wt_out + al256((size_t)NL * DM * DM * 2);
constexpr size_t WO_wt_down = WO_wt_up + al256((size_t)NL * DFF * DM * 2);
constexpr size_t WO_wt_gate = WO_wt_down + al256((size_t)NL * DM * DFF * 2);
constexpr size_t WO_wt_proj = WO_wt_gate + al256((size_t)NL * DM * DM * 2);
constexpr size_t WO_hb = WO_wt_proj + al256((size_t)NL * DM * PLE * 2);
constexpr size_t WO_hb2 = WO_hb + al256((size_t)MTOK * DM * 2);
constexpr size_t WO_proj = WO_hb2 + al256((size_t)MTOK * DM * 2);
constexpr size_t WO_scr = WO_proj + al256((size_t)MTOK * NPJ * 2);
constexpr size_t WO_ogdn = WO_scr + al256((size_t)2048 * SCR_ITEM);
constexpr size_t WO_oswa = WO_ogdn + al256((size_t)MTOK * DM * 2);
constexpr size_t WO_mix = WO_oswa + al256((size_t)MTOK * DM * 2);
constexpr size_t WO_pb = WO_mix + al256((size_t)MTOK * DM * 2);
constexpr size_t WO_pp = WO_pb + al256((size_t)NL * MTOK * PLE * 2);
constexpr size_t WO_ssq0 = WO_pp + al256((size_t)NL * MTOK * DM * 2);
constexpr size_t WO_ssq1 = WO_ssq0 + al256((size_t)MTOK * 16 * 4);
constexpr size_t WO_ssq2 = WO_ssq1 + al256((size_t)MTOK * 16 * 4);
constexpr size_t WO_logits = WO_ssq2 + al256((size_t)MTOK * 16 * 4);
constexpr size_t WO_gsc = WO_logits + al256((size_t)MTOK * 16 * 4);
constexpr size_t WO_bar = WO_gsc + al256((size_t)2048 * 4);
constexpr size_t WS_TOTAL = WO_bar + al256((size_t)3456 * 4);
struct Params {
  const float *x_prompt, *x_sample, *cache_conv, *state_gdn, *cache_k, *cache_v, *p_prompt, *p_sample;
  const float *norm_mix, *w_in, *conv_w, *a_log, *dt_bias, *gdn_norm, *q_norm, *k_norm, *sinks, *w_out, *norm_ffn, *w_up, *w_down,
      *norm_ple, *w_gate, *w_proj;
  float* out;
  unsigned char* ws;
  DEVI bf16_t* wt_in() const { return (bf16_t*)(ws + WO_wt_in); }
  DEVI bf16_t* wt_out() const { return (bf16_t*)(ws + WO_wt_out); }
  DEVI bf16_t* wt_up() const { return (bf16_t*)(ws + WO_wt_up); }
  DEVI bf16_t* wt_down() const { return (bf16_t*)(ws + WO_wt_down); }
  DEVI bf16_t* wt_gate() const { return (bf16_t*)(ws + WO_wt_gate); }
  DEVI bf16_t* wt_proj() const { return (bf16_t*)(ws + WO_wt_proj); }
  DEVI bf16_t* hb() const { return (bf16_t*)(ws + WO_hb); }
  DEVI bf16_t* hb2() const { return (bf16_t*)(ws + WO_hb2); }
  DEVI bf16_t* proj() const { return (bf16_t*)(ws + WO_proj); }
  DEVI bf16_t* scr() const { return (bf16_t*)(ws + WO_scr); }
  DEVI bf16_t* ogdn() const { return (bf16_t*)(ws + WO_ogdn); }
  DEVI bf16_t* oswa() const { return (bf16_t*)(ws + WO_oswa); }
  DEVI bf16_t* mix() const { return (bf16_t*)(ws + WO_mix); }
  DEVI bf16_t* pb() const { return (bf16_t*)(ws + WO_pb); }
  DEVI bf16_t* pp() const { return (bf16_t*)(ws + WO_pp); }
  DEVI float* ssq0() const { return (float*)(ws + WO_ssq0); }
  DEVI float* ssq1() const { return (float*)(ws + WO_ssq1); }
  DEVI float* ssq2() const { return (float*)(ws + WO_ssq2); }
  DEVI float* logits() const { return (float*)(ws + WO_logits); }
  DEVI float* gsc() const { return (float*)(ws + WO_gsc); }
  DEVI unsigned* bar() const { return (unsigned*)(ws + WO_bar); }
};

DEVI float shx(float v, int m, int ln) { return __builtin_bit_cast(float, __builtin_amdgcn_ds_bpermute((ln ^ m) << 2, __builtin_bit_cast(int, v))); }
DEVI float shup(float v, int o, int ln) { return __builtin_bit_cast(float, __builtin_amdgcn_ds_bpermute((ln >= o ? ln - o : ln) << 2, __builtin_bit_cast(int, v))); }
DEVI float lo2f(unsigned u) { return __uint_as_float(u << 16); }
DEVI float hi2f(unsigned u) { return __uint_as_float(u & 0xffff0000u); }
DEVI float bf2f(bf16_t v) { return __uint_as_float(((unsigned)v) << 16); }
typedef __bf16 bf16x2_t __attribute__((ext_vector_type(2)));
DEVI unsigned pk2(float lo, float hi) { const f32x2 v = {lo, hi}; const bf16x2_t r = __builtin_convertvector(v, bf16x2_t); return __builtin_bit_cast(unsigned, r); }
DEVI bf16_t f2bf(float f) { return (bf16_t)(pk2(f, 0.f) & 0xffffu); }
DEVI float sigm(float x) { return __builtin_amdgcn_rcpf(1.f + __expf(-x)); }
DEVI float silu(float x) { return x * sigm(x); }
DEVI float softplus_f(float x) {
  const float e = __expf(x);
  return x > 20.f ? x : (e < 0.01f ? e * (1.f - 0.5f * e + 0.33333334f * e * e) : __logf(1.f + e));
}
DEVI f32x4 mfma16(bf16x8 a, bf16x8 b, f32x4 c) { return __builtin_amdgcn_mfma_f32_16x16x32_bf16(a, b, c, 0, 0, 0); }
DEVI bf16x8 as_bf(u32x4 v) { return __builtin_bit_cast(bf16x8, v); }
#define UNPACK8(v, f) do { f[0] = lo2f(v.x); f[1] = hi2f(v.x); f[2] = lo2f(v.y); f[3] = hi2f(v.y); f[4] = lo2f(v.z); f[5] = hi2f(v.z); f[6] = lo2f(v.w); f[7] = hi2f(v.w); } while (0)

DEVI int inmap(int n) { return n < 4096 ? n : (n < 7680 ? n + 16 : n - 7680 + 4096); }

struct WTile { const float* src; const float* scale; bf16_t* dst; int ldsrc, K, Nd, kt, nt, flags; };
DEVI WTile wtile_decode(const Params& p, int it) {
  constexpr int T_IN = 16 * 121, T_OUT = 256, T_UP = 1024, T_DOWN = 1024, T_GATE = 256, T_PROJ = 64;
  constexpr int T_L = T_IN + T_OUT + T_UP + T_DOWN + T_GATE + T_PROJ;
  const int l = it / T_L;
  int r = it % T_L;
  WTile t;
  t.scale = p.norm_mix;
  if (r < T_IN) { t.src = p.w_in + (size_t)l * DM * NIN; t.ldsrc = NIN; t.K = DM; t.Nd = NIN; t.dst = p.wt_in() + (size_t)l * NIN * DM; t.scale = p.norm_mix + l * DM; t.flags = 3; t.kt = r % 16; t.nt = r / 16; return t; }
  r -= T_IN;
  if (r < T_OUT) { t.src = p.w_out + (size_t)l * DM * DM; t.ldsrc = DM; t.K = DM; t.Nd = DM; t.dst = p.wt_out() + (size_t)l * DM * DM; t.flags = 0; t.kt = r % 16; t.nt = r / 16; return t; }
  r -= T_OUT;
  if (r < T_UP) { t.src = p.w_up + (size_t)l * DM * DFF; t.ldsrc = DFF; t.K = DM; t.Nd = DFF; t.dst = p.wt_up() + (size_t)l * DFF * DM; t.scale = p.norm_ffn + l * DM; t.flags = 2; t.kt = r % 16; t.nt = r / 16; return t; }
  r -= T_UP;
  if (r < T_DOWN) { t.src = p.w_down + (size_t)l * DFF * DM; t.ldsrc = DM; t.K = DFF; t.Nd = DM; t.dst = p.wt_down() + (size_t)l * DM * DFF; t.flags = 0; t.kt = r % 64; t.nt = r / 64; return t; }
  r -= T_DOWN;
  if (r < T_GATE) { t.src = p.w_gate + (size_t)l * DM * DM; t.ldsrc = DM; t.K = DM; t.Nd = DM; t.dst = p.wt_gate() + (size_t)l * DM * DM; t.scale = p.norm_ple + l * DM; t.flags = 2; t.kt = r % 16; t.nt = r / 16; return t; }
  r -= T_GATE;
  t.src = p.w_proj + (size_t)l * PLE * DM; t.ldsrc = DM; t.K = PLE; t.Nd = DM; t.dst = p.wt_proj() + (size_t)l * DM * PLE; t.flags = 0; t.kt = r % 4; t.nt = r / 4;
  return t;
}
DEVI void wtile_load(const WTile& t, float (&v)[16], float (&sv)[16], int tid) {
  const int nl = tid & 63, kq = tid >> 6;
  const int n = t.nt * 64 + nl, nc = n < t.Nd ? n : t.Nd - 1;
  const int sc = (t.flags & 1) ? inmap(nc) : nc;
  const int ksc = (t.flags & 2) ? 1 : 0;
#pragma unroll
  for (int r = 0; r < 16; ++r) {
    const int k = t.kt * 64 + r * 4 + kq;
    v[r] = t.src[(size_t)k * t.ldsrc + sc];
    sv[r] = t.scale[(k & 1023) * ksc];
  }
}
DEVI void wtile_store(const WTile& t, const float (&v)[16], const float (&sv)[16], float* sm, int tid) {
  const int nl = tid & 63, kq = tid >> 6;
  const bool ok = t.nt * 64 + nl < t.Nd;
  const bool has = (t.flags & 2) != 0;
#pragma unroll
  for (int r = 0; r < 16; ++r) sm[(r * 4 + kq) * 65 + nl] = ok ? v[r] * (has ? sv[r] : 1.f) : 0.f;
  __syncthreads();
  const int nr = tid >> 2, ks = (tid & 3) * 16;
  if (t.nt * 64 + nr < t.Nd) {
    unsigned w[8];
#pragma unroll
    for (int i = 0; i < 8; ++i) w[i] = pk2(sm[(ks + 2 * i) * 65 + nr], sm[(ks + 2 * i + 1) * 65 + nr]);
    u32x4* d = (u32x4*)(t.dst + (size_t)(t.nt * 64 + nr) * t.K + t.kt * 64 + ks);
    d[0] = (u32x4){w[0], w[1], w[2], w[3]};
    d[1] = (u32x4){w[4], w[5], w[6], w[7]};
  }
  __syncthreads();
}

__device__ void phase_p0(const Params& p, unsigned char* smem) {
  float* sm = (float*)smem;
  const int tid = (opq(threadIdx.x) & 255), lane = tid & 63, wid = tid >> 6;
  {
    constexpr int NT = NL * (16 * 121 + 256 + 1024 + 1024 + 256 + 64);
    const int vb = VB, vg = VG;
    const int nj = (NT - vb + vg - 1) / vg;
#define WT_IDX(j) (vb + ((j) < nj ? (j) : nj - 1) * vg)
    float va[16], sa[16], vb_[16], sb[16], vc[16], sc[16];
    WTile ta = wtile_decode(p, WT_IDX(0));
    wtile_load(ta, va, sa, tid);
    WTile tb = wtile_decode(p, WT_IDX(1));
    wtile_load(tb, vb_, sb, tid);
    for (int j = 0; j < nj; j += 3) {
      const WTile tc = wtile_decode(p, WT_IDX(j + 2));
      wtile_load(tc, vc, sc, tid);
      wtile_store(ta, va, sa, sm, tid);
      ta = wtile_decode(p, WT_IDX(j + 3));
      wtile_load(ta, va, sa, tid);
      if (j + 1 < nj) wtile_store(tb, vb_, sb, sm, tid);
      tb = wtile_decode(p, WT_IDX(j + 4));
      wtile_load(tb, vb_, sb, tid);
      if (j + 2 < nj) wtile_store(tc, vc, sc, sm, tid);
    }
#undef WT_IDX
  }
  for (int it = VB; it < MTOK / 4; it += VG) {
    const int row = it * 4 + wid;
    const float* src = row < MP ? p.x_prompt + (size_t)row * DM : p.x_sample + (size_t)(row - MP) * DM;
    bf16_t* hbd = p.hb() + (size_t)row * DM;
    float ss = 0.f;
#pragma unroll
    for (int i = 0; i < 4; ++i) {
      const int c = i * 256 + lane * 4;
      const f32x4 v = *(const f32x4*)(src + c);
      ss += v.x * v.x + v.y * v.y + v.z * v.z + v.w * v.w;
      *(u32x2*)(hbd + c) = (u32x2){pk2(v.x, v.y), pk2(v.z, v.w)};
    }
#pragma unroll
    for (int o = 1; o < 64; o <<= 1) ss += shx(ss, o, lane);
    if (lane < 16) p.ssq0()[(size_t)row * 16 + lane] = lane == 0 ? ss : 0.f;
  }
  const int G = NL * MTOK * 32;
  for (int g = VB * NTHR + tid; g < G; g += VG * NTHR) {
    const int l = g / (MTOK * 32), rem = g % (MTOK * 32), row = rem >> 5, c8 = rem & 31;
    const float* src = row < MP ? p.p_prompt + ((size_t)(l * MP + row) * PLE + c8 * 8) : p.p_sample + ((size_t)(l * MS + row - MP) * PLE + c8 * 8);
    const f32x4 a = *(const f32x4*)src, b = *(const f32x4*)(src + 4);
    *(u32x4*)(p.pb() + (size_t)g * 8) = (u32x4){pk2(a.x, a.y), pk2(a.z, a.w), pk2(b.x, b.y), pk2(b.z, b.w)};
  }
}

enum { EPI_PROJ = 0, EPI_LOGIT = 1, EPI_RESID = 2, EPI_UP = 3, EPI_PLE = 4, EPI_PP = 5 };
struct EpiArgs {
  const float* ssq_in; float* ssq_out; float* h; bf16_t* hb; bf16_t* obf; int ldo; float* of32; const bf16_t* pp; const bf16_t* hin;
};

template <int EPI>
DEVI float epi_rs(const EpiArgs& e, int row) {
  if (EPI == EPI_PROJ || EPI == EPI_LOGIT || EPI == EPI_UP || EPI == EPI_PLE) {
    const f32x4* sp = (const f32x4*)(e.ssq_in + (size_t)row * 16);
    const f32x4 a = sp[0], b = sp[1], c = sp[2], d = sp[3];
    const float s = ((a.x + a.y) + (a.z + a.w)) + ((b.x + b.y) + (b.z + b.w)) + ((c.x + c.y) + (c.z + c.w)) + ((d.x + d.y) + (d.z + d.w));
    return __builtin_amdgcn_rsqf(s * (1.f / 1024.f) + EPS);
  }
  return 1.f;
}
template <int EPI>
DEVI void epi_elem(const EpiArgs& e, int row, int col, f32x4 v, float rs, float& sq) {
  if (EPI == EPI_PROJ) {
    v *= rs;
    *(u32x2*)(e.obf + (size_t)row * e.ldo + col) = (u32x2){pk2(v.x, v.y), pk2(v.z, v.w)};
  } else if (EPI == EPI_LOGIT) {
    v *= rs;
    *(f32x4*)(e.of32 + (size_t)row * 16 + col) = v;
  } else if (EPI == EPI_PP) {
    *(u32x2*)(e.obf + (size_t)row * e.ldo + (col & 1023)) = (u32x2){pk2(v.x, v.y), pk2(v.z, v.w)};
  } else if (EPI == EPI_UP) {
    v *= rs;
    v.x = fmaxf(v.x, 0.f); v.y = fmaxf(v.y, 0.f); v.z = fmaxf(v.z, 0.f); v.w = fmaxf(v.w, 0.f);
    v = v * v;
    *(u32x2*)(e.obf + (size_t)row * e.ldo + col) = (u32x2){pk2(v.x, v.y), pk2(v.z, v.w)};
  } else {
    const u32x2 hraw = *(const u32x2*)(e.hin + (size_t)row * DM + col);
    f32x4 hv = (f32x4){lo2f(hraw.x), hi2f(hraw.x), lo2f(hraw.y), hi2f(hraw.y)};
    if (EPI == EPI_RESID) {
      hv += v;
    } else {
      const u32x2 pv = *(const u32x2*)(e.pp + (size_t)row * DM + col);
      hv.x += sigm(v.x * rs) * lo2f(pv.x); hv.y += sigm(v.y * rs) * hi2f(pv.x);
      hv.z += sigm(v.z * rs) * lo2f(pv.y); hv.w += sigm(v.w * rs) * hi2f(pv.y);
    }
    if (e.h) *(f32x4*)(e.h + (size_t)row * DM + col) = hv;
    *(u32x2*)(e.hb + (size_t)row * DM + col) = (u32x2){pk2(hv.x, hv.y), pk2(hv.z, hv.w)};
    sq += hv.x * hv.x + hv.y * hv.y + hv.z * hv.z + hv.w * hv.w;
  }
}

template <int EPI>
DEVI void epi_elem8(const EpiArgs& e, int row, int col, f32x4 v0, f32x4 v1, float rs, float& sq) {
  if (EPI == EPI_PROJ || EPI == EPI_UP || EPI == EPI_PP) {
    if (EPI != EPI_PP) { v0 *= rs; v1 *= rs; }
    if (EPI == EPI_UP) {
      v0.x = fmaxf(v0.x, 0.f); v0.y = fmaxf(v0.y, 0.f); v0.z = fmaxf(v0.z, 0.f); v0.w = fmaxf(v0.w, 0.f);
      v1.x = fmaxf(v1.x, 0.f); v1.y = fmaxf(v1.y, 0.f); v1.z = fmaxf(v1.z, 0.f); v1.w = fmaxf(v1.w, 0.f);
      v0 = v0 * v0; v1 = v1 * v1;
    }
    const int c = EPI == EPI_PP ? (col & 1023) : col;
    *(u32x4*)(e.obf + (size_t)row * e.ldo + c) = (u32x4){pk2(v0.x, v0.y), pk2(v0.z, v0.w), pk2(v1.x, v1.y), pk2(v1.z, v1.w)};
  } else {
    const u32x4 hraw = *(const u32x4*)(e.hin + (size_t)row * DM + col);
    f32x4 h0 = (f32x4){lo2f(hraw.x), hi2f(hraw.x), lo2f(hraw.y), hi2f(hraw.y)}, h1 = (f32x4){lo2f(hraw.z), hi2f(hraw.z), lo2f(hraw.w), hi2f(hraw.w)};
    if (EPI == EPI_RESID) {
      h0 += v0; h1 += v1;
    } else {
      const u32x4 pv = *(const u32x4*)(e.pp + (size_t)row * DM + col);
      h0.x += sigm(v0.x * rs) * lo2f(pv.x); h0.y += sigm(v0.y * rs) * hi2f(pv.x);
      h0.z += sigm(v0.z * rs) * lo2f(pv.y); h0.w += sigm(v0.w * rs) * hi2f(pv.y);
      h1.x += sigm(v1.x * rs) * lo2f(pv.z); h1.y += sigm(v1.y * rs) * hi2f(pv.z);
      h1.z += sigm(v1.z * rs) * lo2f(pv.w); h1.w += sigm(v1.w * rs) * hi2f(pv.w);
    }
    if (e.h) { float* hp = e.h + (size_t)row * DM + col; *(f32x4*)hp = h0; *(f32x4*)(hp + 4) = h1; }
    *(u32x4*)(e.hb + (size_t)row * DM + col) = (u32x4){pk2(h0.x, h0.y), pk2(h0.z, h0.w), pk2(h1.x, h1.y), pk2(h1.z, h1.w)};
    sq += (h0.x * h0.x + h0.y * h0.y + h0.z * h0.z + h0.w * h0.w) + (h1.x * h1.x + h1.y * h1.y + h1.z * h1.z + h1.w * h1.w);
  }
}

template <int WMT, int WNT, int WGM, int WGN, int EPI, int BK = 32, bool KSPLIT = false>
__device__ __forceinline__ void gemm_tile(const bf16_t* __restrict__ A, int lda, const bf16_t* __restrict__ Bt, int ldb, int K, int m0, int n0,
                                          bf16_t* lds, const EpiArgs& e) {
  constexpr int BM = WGM * WMT * 16, BN = WGN * WNT * 16, LDR = BK + 8;
  constexpr int STAGE = (BM + BN) * LDR;
  constexpr int PPR = BK / 8, RPI = NTHR / PPR;
  constexpr int NA = BM / RPI, NB = (BN + RPI - 1) / RPI;
  const int tid = (opq(threadIdx.x) & 255), lane = tid & 63, wid = tid >> 6;
  const int wm = wid / WGN, wn = wid % WGN;
  const int fr = lane & 15, fq = lane >> 4;
  f32x4 acc[WMT][WNT];
#pragma unroll
  for (int i = 0; i < WMT; ++i)
#pragma unroll
    for (int j = 0; j < WNT; ++j) acc[i][j] = (f32x4){0.f, 0.f, 0.f, 0.f};
  u32x4 ra0[NA], rb0[NB], ra1[NA], rb1[NB];
  const int khalf = KSPLIT ? VHALF : 0;
  const int nk = (KSPLIT ? K / 2 : K) / BK;
  const int prow = tid / PPR, ppc = tid % PPR;
  const unsigned ta = (unsigned)(prow * lda + ppc * 8) * 2u, tb = (unsigned)(prow * ldb + ppc * 8) * 2u;
  const char* Au = (const char*)(A + (size_t)m0 * lda + (size_t)khalf * (K / 2));
  const char* Bu = (const char*)(Bt + (size_t)n0 * ldb + (size_t)khalf * (K / 2));
#define BGUARD(i) (BN >= RPI * ((i) + 1) || prow + (i) * RPI < BN)
#define GLOAD(kt, RA, RB) do { \
    _Pragma("unroll") for (int i = 0; i < NA; ++i) RA[i] = *(const u32x4*)(Au + ((size_t)i * RPI * lda + (size_t)(kt) * BK) * 2 + ta); \
    _Pragma("unroll") for (int i = 0; i < NB; ++i) if (BGUARD(i)) RB[i] = *(const u32x4*)(Bu + ((size_t)i * RPI * ldb + (size_t)(kt) * BK) * 2 + tb); \
  } while (0)
#define LSTORE(st, RA, RB) do { bf16_t* sA_ = lds + (st) * STAGE; bf16_t* sB_ = sA_ + BM * LDR; \
    _Pragma("unroll") for (int i = 0; i < NA; ++i) *(u32x4*)(sA_ + (prow + i * RPI) * LDR + ppc * 8) = RA[i]; \
    _Pragma("unroll") for (int i = 0; i < NB; ++i) if (BGUARD(i)) *(u32x4*)(sB_ + (prow + i * RPI) * LDR + ppc * 8) = RB[i]; \
  } while (0)
#define COMPUTE(st) do { const bf16_t* sA = lds + (st) * STAGE; const bf16_t* sB = sA + BM * LDR; \
    _Pragma("unroll") for (int kk = 0; kk < BK / 32; ++kk) { \
      bf16x8 bfr[WNT]; \
      _Pragma("unroll") for (int nt = 0; nt < WNT; ++nt) bfr[nt] = *(const bf16x8*)(sB + (wn * WNT * 16 + nt * 16 + fr) * LDR + kk * 32 + fq * 8); \
      _Pragma("unroll") for (int mt = 0; mt < WMT; ++mt) { \
        const bf16x8 af = *(const bf16x8*)(sA + (wm * WMT * 16 + mt * 16 + fr) * LDR + kk * 32 + fq * 8); \
        _Pragma("unroll") for (int nt = 0; nt < WNT; ++nt) acc[mt][nt] = mfma16(bfr[nt], af, acc[mt][nt]); } } \
  } while (0)
  GLOAD(0, ra0, rb0);
  GLOAD(1, ra1, rb1);
  LSTORE(0, ra0, rb0);
  __syncthreads();
  for (int kt = 0; kt < nk; kt += 2) {
    const int k2 = kt + 2 < nk ? kt + 2 : nk - 2;
    GLOAD(k2, ra0, rb0);
    COMPUTE(0);
    LSTORE(1, ra1, rb1);
    __syncthreads();
    GLOAD(k2 + 1, ra1, rb1);
    COMPUTE(1);
    LSTORE(0, ra0, rb0);
    __syncthreads();
  }
#undef BGUARD
#undef COMPUTE
#undef GLOAD
#undef LSTORE
  if (KSPLIT) {
    f32x4* red = (f32x4*)((unsigned char*)lds + (khalf ? 0 : SMEM_BYTES));
    if (khalf == 1) {
#pragma unroll
      for (int i = 0; i < WMT; ++i)
#pragma unroll
        for (int j = 0; j < WNT; ++j) red[((wid * WMT + i) * WNT + j) * 64 + lane] = acc[i][j];
    }
    __syncthreads();
    if (khalf == 0) {
#pragma unroll
      for (int i = 0; i < WMT; ++i)
#pragma unroll
        for (int j = 0; j < WNT; ++j) acc[i][j] += red[((wid * WMT + i) * WNT + j) * 64 + lane];
    }
  }
  if (!KSPLIT || khalf == 0) {
#pragma unroll
  for (int mt = 0; mt < WMT; ++mt) {
    const int row = m0 + wm * WMT * 16 + mt * 16 + fr;
    const float rs = epi_rs<EPI>(e, row);
    float sq = 0.f;
#pragma unroll
    for (int nt = 0; nt < WNT; ++nt) epi_elem<EPI>(e, row, n0 + wn * WNT * 16 + nt * 16 + fq * 4, acc[mt][nt], rs, sq);
    if (EPI == EPI_RESID || EPI == EPI_PLE) {
      sq += shx(sq, 16, lane);
      sq += shx(sq, 32, lane);
      if (fq == 0) e.ssq_out[(size_t)row * 16 + (n0 / BN) * WGN + wn] = sq;
    }
  }
  }
  if (KSPLIT) __syncthreads();
}

namespace pg8 {
#define PG8_LAS __attribute__((address_space(3)))
typedef unsigned short bf16_t;
typedef short bf16x8 __attribute__((ext_vector_type(8)));
typedef float f32x4 __attribute__((ext_vector_type(4)));
typedef unsigned u32x4 __attribute__((ext_vector_type(4)));
constexpr int BM = 256, BK = 64, HALF = 128, HTB = HALF * BK * 2  , STAGE_BYTES = 8 * HTB, NXCD = 8, WGM = 8;

__host__ __device__ __forceinline__ int lds_byte(int r, int c) { const int st = (r >> 4) * 2 + (c >> 5), rr = r & 15, cc = c & 31, ob = rr * 64 + cc * 2; return st * 1024 + (ob ^ (((ob >> 9) & 1) << 5)); }
__host__ __device__ __forceinline__ void stage_rc(int b, int& R, int& C) { const int st = b / 1024, sb = b % 1024, swz = sb ^ (((sb >> 9) & 1) << 5); R = (st >> 1) * 16 + swz / 64; C = (st & 1) * 32 + (swz % 64) / 2; }
__host__ __device__ __forceinline__ int perm32(int rho) { const int n = rho >> 4, i = rho & 15; return 8 * (i >> 2) + 4 * n + (i & 3); }

struct Unit { int pm, pn; };
struct Gemm { const bf16_t* A; const bf16_t* Bt; int M, N, K; };

template <class Epi, class Sched, bool STAMP = false>
__device__ __forceinline__ void gemm_phase(PG8_LAS unsigned char* lds, const Gemm g, const Sched& S, const Epi& E, unsigned long long* stamps) {
    const int tid = opq((int)threadIdx.x), wid = __builtin_amdgcn_readfirstlane(tid >> 6), lane = tid & 63, wr = wid >> 2, wc = wid & 3, fr = lane & 15, fq = lane >> 4;
    const int K = g.K, nt = K / BK;
    int ts_lo = 0, ts_hi = 0, nts = 0; const unsigned long long rt_entry = STAMP ? (unsigned long long)wall_clock64() : 0ull;
#define PG8_STAMP() do { if (STAMP && wid == 0 && nts < 64) { const unsigned long long _c = (unsigned long long)clock64(); \
        ts_lo = (lane == nts) ? (int)(unsigned)_c : ts_lo; ts_hi = (lane == nts) ? (int)(unsigned)(_c >> 32) : ts_hi; ++nts; } } while (0)
    PG8_STAMP();
    unsigned voffA[2], voffB[2];
#pragma unroll
    for (int i = 0; i < 2; ++i) { int R, C; stage_rc(tid * 16 + i * 8192, R, C); const int Rb = Epi::PERM ? ((R & ~31) + perm32(R & 31)) : R;
        voffA[i] = (unsigned)(R * K + C) * 2u; voffB[i] = (unsigned)(Rb * K + C) * 2u; }
    const size_t kstep = (size_t)(BK * 2);
    const size_t hstep = (size_t)HALF * K * 2;
    const size_t tstep = 2 * hstep;
    const unsigned ldsw = (unsigned)wid * 1024u;
    const int aoff = lds_byte(wr * 64 + fr, fq * 8), boff = lds_byte(wc * 32 + fr, fq * 8);
#define PG8_SA(b, h) (((b) * 2 + (h)) * HTB)
#define PG8_SB(b, h) ((4 + (b) * 2 + (h)) * HTB)
#define PG8_STAGE(bufoff, gbase, voff) do { _Pragma("unroll") for (int _i = 0; _i < 2; ++_i) \
        __builtin_amdgcn_global_load_lds((const unsigned*)((const char*)(gbase) + (voff)[_i]), (PG8_LAS unsigned*)(lds + (bufoff) + ldsw + _i * 8192), 16, 0, 0); } while (0)
#define PG8_LDA(dst, b, h) do { _Pragma("unroll") for (int m = 0; m < 4; ++m) _Pragma("unroll") for (int k = 0; k < 2; ++k) dst[m][k] = *(const PG8_LAS bf16x8*)(lds + PG8_SA(b, h) + aoff + m * 2048 + k * 1024); } while (0)
#define PG8_LDB(dst, b, h) do { _Pragma("unroll") for (int n = 0; n < 2; ++n) _Pragma("unroll") for (int k = 0; k < 2; ++k) dst[n][k] = *(const PG8_LAS bf16x8*)(lds + PG8_SB(b, h) + boff + n * 2048 + k * 1024); } while (0)
#define PG8_MMA(ai, bj, At, Bt) do { __builtin_amdgcn_s_setprio(1); _Pragma("unroll") for (int m = 0; m < 4; ++m) _Pragma("unroll") for (int n = 0; n < 2; ++n) _Pragma("unroll") for (int k = 0; k < 2; ++k) \
        acc[ai][bj][m][n] = __builtin_amdgcn_mfma_f32_16x16x32_bf16(Bt[n][k], At[m][k], acc[ai][bj][m][n], 0, 0, 0); __builtin_amdgcn_s_setprio(0); } while (0)
#define PG8_WAIT_V(n) asm volatile("s_waitcnt vmcnt(" #n ")" ::: "memory")
#define PG8_WAIT_L(n) asm volatile("s_waitcnt lgkmcnt(" #n ")" ::: "memory")
#define PG8_BAR __builtin_amdgcn_s_barrier()
#define PG8_SCHED __builtin_amdgcn_sched_barrier(0)
    Unit cur, nxt; int ui = 0;
    if (!S.next(0, cur)) return;
    f32x4 acc[2][2][4][2];
#pragma unroll
    for (int a = 0; a < 2; ++a)
#pragma unroll
        for (int b = 0; b < 2; ++b)
#pragma unroll
            for (int m = 0; m < 4; ++m)
#pragma unroll
                for (int n = 0; n < 2; ++n) acc[a][b][m][n] = (f32x4){0.f, 0.f, 0.f, 0.f};
    bf16x8 At[4][2], B0[2][2], B1[2][2];
    const char* cA = (const char*)g.A + (size_t)cur.pm * tstep; const char* cB = (const char*)g.Bt + (size_t)cur.pn * tstep;
    S.a_ready(cur);
    PG8_STAGE(PG8_SB(0, 0), cB, voffB); PG8_STAGE(PG8_SA(0, 0), cA, voffA); PG8_STAGE(PG8_SB(0, 1), cB + hstep, voffB); PG8_STAGE(PG8_SA(0, 1), cA + hstep, voffA);
    if (wr == 1) PG8_BAR;
    PG8_WAIT_V(4); PG8_BAR;
    PG8_STAGE(PG8_SB(1, 0), cB + kstep, voffB); PG8_STAGE(PG8_SA(1, 0), cA + kstep, voffA); PG8_STAGE(PG8_SB(1, 1), cB + hstep + kstep, voffB);
    PG8_WAIT_V(6); PG8_BAR;
    PG8_STAMP();
    for (;;) {
        const bool has_next = S.next(ui + 1, nxt);
        const char* nA = has_next ? (const char*)g.A + (size_t)nxt.pm * tstep : cA; const char* nB = has_next ? (const char*)g.Bt + (size_t)nxt.pn * tstep : cB;
        for (int t = 0; t < nt; t += 2) {
            const bool last = (t == nt - 2);
            const char* a1 = cA + (size_t)(t + 1) * kstep;
            const char* a2 = last ? nA : cA + (size_t)(t + 2) * kstep; const char* b2 = last ? nB : cB + (size_t)(t + 2) * kstep;
            const char* a3 = a2 + kstep; const char* b3 = b2 + kstep;
            if (last && has_next) S.a_ready(nxt);
            PG8_LDB(B0, 0, 0); PG8_SCHED; PG8_LDA(At, 0, 0); PG8_STAGE(PG8_SA(1, 1), a1 + hstep, voffA);
            PG8_WAIT_L(8); PG8_BAR; PG8_WAIT_L(0); PG8_MMA(0, 0, At, B0); PG8_BAR; PG8_SCHED;
            PG8_LDB(B1, 0, 1); PG8_STAGE(PG8_SB(0, 0), b2, voffB);
            PG8_BAR; PG8_WAIT_L(0); PG8_MMA(0, 1, At, B1); PG8_BAR;
            PG8_LDA(At, 0, 1); PG8_STAGE(PG8_SA(0, 0), a2, voffA);
            PG8_BAR; PG8_WAIT_L(0); PG8_MMA(1, 0, At, B0); PG8_BAR; PG8_SCHED;
            PG8_STAGE(PG8_SB(0, 1), b2 + hstep, voffB);
            PG8_WAIT_V(6); PG8_BAR; PG8_MMA(1, 1, At, B1); PG8_BAR;
            PG8_LDB(B0, 1, 0); PG8_SCHED; PG8_LDA(At, 1, 0); PG8_STAGE(PG8_SA(0, 1), a2 + hstep, voffA);
            PG8_WAIT_L(8); PG8_BAR; PG8_WAIT_L(0); PG8_MMA(0, 0, At, B0); PG8_BAR; PG8_SCHED;
            PG8_LDB(B1, 1, 1); PG8_STAGE(PG8_SB(1, 0), b3, voffB);
            PG8_BAR; PG8_WAIT_L(0); PG8_MMA(0, 1, At, B1); PG8_BAR;
            PG8_LDA(At, 1, 1); PG8_STAGE(PG8_SA(1, 0), a3, voffA);
            PG8_BAR; PG8_WAIT_L(0); PG8_MMA(1, 0, At, B0); PG8_BAR; PG8_SCHED;
            PG8_STAGE(PG8_SB(1, 1), b3 + hstep, voffB);
            PG8_WAIT_V(6); PG8_BAR; PG8_MMA(1, 1, At, B1); PG8_BAR;
        }
        PG8_STAMP();
        if constexpr (!Epi::AFTER_DRAIN) { E(acc, cur, wr, wc, fr, fq); S.done(cur); }
        PG8_STAMP();
        if (!has_next) break;
#pragma unroll
        for (int a = 0; a < 2; ++a)
#pragma unroll
            for (int b = 0; b < 2; ++b)
#pragma unroll
                for (int m = 0; m < 4; ++m)
#pragma unroll
                    for (int n = 0; n < 2; ++n) acc[a][b][m][n] = (f32x4){0.f, 0.f, 0.f, 0.f};
        cur = nxt; cA = nA; cB = nB; ++ui;
    }
    PG8_WAIT_V(0);
    if (wr == 0) PG8_BAR;
    PG8_BAR;
    if constexpr (Epi::AFTER_DRAIN) { E.fused(acc, cur, wr, wc, fr, fq, lds, wid, lane); S.done(cur); }
    PG8_STAMP();
    if (STAMP && wid == 0) { stamps[lane] = lane < nts ? (((unsigned long long)(unsigned)ts_hi << 32) | (unsigned)ts_lo) : 0ull;
        if (lane == 62) stamps[62] = rt_entry; if (lane == 63) stamps[63] = (unsigned long long)wall_clock64(); }
#undef PG8_STAMP
#undef PG8_SA
#undef PG8_SB
#undef PG8_STAGE
#undef PG8_LDA
#undef PG8_LDB
#undef PG8_MMA
#undef PG8_WAIT_V
#undef PG8_WAIT_L
#undef PG8_BAR
#undef PG8_SCHED
}
}

DEVI void unit_map(int L, int nM, int nN, int& pm, int& pn) {
  const int nwg = nM * nN, q = nwg / 8, r = nwg % 8, xcd = L % 8, off = L / 8;
  const int wgid = (xcd < r ? xcd * (q + 1) : r * (q + 1) + (xcd - r) * q) + off;
  const int nig = 8 * nN, gid = wgid / nig, fm = gid * 8, gsz = (nM - fm) < 8 ? (nM - fm) : 8, w = wgid - gid * nig;
  pm = fm + (w % gsz); pn = w / gsz;
}
struct RowSched {
  int nM, nN, nLimit, G, c;
  __device__ __forceinline__ bool next(int i, pg8::Unit& u) const { const int L = i * G + c; if (L >= nLimit) return false; unit_map(L, nM, nN, u.pm, u.pn); return true; }
  __device__ __forceinline__ void a_ready(const pg8::Unit&) const {}
  __device__ __forceinline__ void done(const pg8::Unit&) const {}
};
struct DiagSched {
  int nLimit, G, c;
  __device__ __forceinline__ bool next(int i, pg8::Unit& u) const { const int L = i * G + c; if (L >= nLimit) return false; const int l = L / 272, r = L - l * 272; u.pm = l * 68 + (r >> 2); u.pn = l * 4 + (r & 3); return true; }
  __device__ __forceinline__ void a_ready(const pg8::Unit&) const {}
  __device__ __forceinline__ void done(const pg8::Unit&) const {}
};
template <int EPI> struct BigEpi {
  static constexpr bool PERM = true, AFTER_DRAIN = false;
  EpiArgs e;
  __device__ __forceinline__ void operator()(const f32x4 (&acc)[2][2][4][2], const pg8::Unit& u, int wr, int wc, int fr, int fq) const {
    const int lane = fq * 16 + fr;
#pragma unroll
    for (int ai = 0; ai < 2; ++ai)
#pragma unroll
      for (int m = 0; m < 4; ++m) {
        const int row = u.pm * 256 + ai * 128 + wr * 64 + m * 16 + fr;
        const float rs = epi_rs<EPI>(e, row);
        float sq = 0.f;
#pragma unroll
        for (int bj = 0; bj < 2; ++bj) epi_elem8<EPI>(e, row, u.pn * 256 + bj * 128 + wc * 32 + fq * 8, acc[ai][bj][m][0], acc[ai][bj][m][1], rs, sq);
        if (EPI == EPI_RESID || EPI == EPI_PLE) {
          sq += shx(sq, 16, lane);
          sq += shx(sq, 32, lane);
          if (fq == 0) e.ssq_out[(size_t)row * 16 + u.pn * 4 + wc] = sq;
        }
      }
  }
};

template <int EPI>
__device__ void gemm_big_phase(const bf16_t* A, const bf16_t* Bt, int K, int M, int N, unsigned char* lds_all, unsigned char* smem_half, const EpiArgs& e) {
  const int nM = M / 256, nN = N / 256, nU = nM * nN, G = gridDim.x;
  const int L = nU % G;
  const int nLimit = (L > 0 && L <= G / 4) ? nU - L : nU;
  RowSched S; S.nM = nM; S.nN = nN; S.nLimit = nLimit; S.G = G; S.c = blockIdx.x;
  pg8::Gemm g; g.A = A; g.Bt = Bt; g.M = M; g.N = N; g.K = K;
  BigEpi<EPI> E; E.e = e;
  pg8::gemm_phase<BigEpi<EPI>, RowSched>((PG8_LAS unsigned char*)lds_all, g, S, E, nullptr);
  __syncthreads();
  const int nSmall = (nU - nLimit) * 16;
  if (nSmall <= G && K >= 512) {
    for (int st = blockIdx.x; st < nSmall; st += G) {
      const int sub = st & 15; int pm, pn; unit_map(nLimit + (st >> 4), nM, nN, pm, pn);
      gemm_tile<1, 4, 4, 1, EPI, 128, true>(A, K, Bt, K, K, pm * 256 + (sub >> 2) * 64, pn * 256 + (sub & 3) * 64, (bf16_t*)smem_half, e);
    }
  } else {
    for (int st = VB; st < nSmall; st += VG) {
      const int sub = st & 15; int pm, pn; unit_map(nLimit + (st >> 4), nM, nN, pm, pn);
      gemm_tile<1, 4, 4, 1, EPI, 128>(A, K, Bt, K, K, pm * 256 + (sub >> 2) * 64, pn * 256 + (sub & 3) * 64, (bf16_t*)smem_half, e);
    }
  }
}


template <int I, int J4>
DEVI void solve_sub4(float& r, const float (&x)[64], const float* Am) {
  if constexpr (J4 * 4 < I) {
    const f32x4 a = *(const f32x4*)(Am + I * 64 + J4 * 4);
    if constexpr (J4 * 4 + 0 < I) r -= a.x * x[J4 * 4 + 0];
    if constexpr (J4 * 4 + 1 < I) r -= a.y * x[J4 * 4 + 1];
    if constexpr (J4 * 4 + 2 < I) r -= a.z * x[J4 * 4 + 2];
    if constexpr (J4 * 4 + 3 < I) r -= a.w * x[J4 * 4 + 3];
    solve_sub4<I, J4 + 1>(r, x, Am);
  }
}
template <int I>
DEVI void solve_rows(float (&x)[64], const float* Am, const bf16_t* src, const float* sc) {
  if constexpr (I < 64) {
    float r = bf2f(src[I * 136]) * sc[I];
    solve_sub4<I, 0>(r, x, Am);
    x[I] = r;
    asm volatile("" ::: "memory");
    solve_rows<I + 1>(x, Am, src, sc);
  }
}

__device__ void gdn_prep_item(const Params& p, int l, int item, unsigned char* smem) {
  const int tid = (opq(threadIdx.x) & 255), lane = tid & 63, wid = tid >> 6, fr = lane & 15, fq = lane >> 4;
  const int h = item & 7, n = (item >> 3) & 31, b = item >> 8;
  const int tok0 = b * 2048 + n * 64;
  bf16_t* qh = (bf16_t*)smem;
  bf16_t* kh = qh + 64 * 136;
  bf16_t* vh = kh + 64 * 136;
  float* Am = (float*)(vh + 64 * 136);
  float* sbeta = Am + 64 * 64;
  float* sgc = sbeta + 64;
  float* sbe = sgc + 64;
  float* seg = sbe + 64;
  float* sek = seg + 64;
  unsigned char* scr = (unsigned char*)p.scr() + (size_t)item * SCR_ITEM;
  bf16_t* g_uT = (bf16_t*)scr;
  bf16_t* g_w = (bf16_t*)(scr + 16384);
  bf16_t* g_qg = (bf16_t*)(scr + 32768);
  bf16_t* g_kgT = (bf16_t*)(scr + 49152);
  bf16_t* g_qk = (bf16_t*)(scr + 65536);

  if (wid == 0) {
    const float* lg = p.logits() + (size_t)(tok0 + lane) * 16;
    const float bl = lg[h], al = lg[8 + h];
    const float x = al + p.dt_bias[l * 8 + h];
    const float sp = softplus_f(x);
    float g = -__expf(p.a_log[l * 8 + h]) * sp;
#pragma unroll
    for (int o = 1; o < 64; o <<= 1) { const float t = shup(g, o, lane); if (lane >= o) g += t; }
    sbeta[lane] = sigm(bl);
    sgc[lane] = g;
    sbe[lane] = sigm(bl) * __expf(g);
    seg[lane] = __expf(g);
    const float glast = __builtin_bit_cast(float, __builtin_amdgcn_readlane(__builtin_bit_cast(int, g), 63));
    sek[lane] = __expf(glast - g);
  }
  u32x4 rwall[3][7];
#pragma unroll
  for (int sect = 0; sect < 3; ++sect)
#pragma unroll
    for (int r = 0; r < 7; ++r) {
      const int tl = n * 64 + wid * 16 + fq * 4 - 3 + r;
      rwall[sect][r] = (u32x4){0u, 0u, 0u, 0u};
      if (tl >= 0) rwall[sect][r] = *(const u32x4*)(p.proj() + (size_t)(b * 2048 + tl) * NPJ + sect * 1024 + h * 128 + fr * 8);
    }
#pragma unroll
  for (int sect = 0; sect < 3; ++sect) {
    const int ch0 = sect * 1024 + h * 128 + fr * 8;
    float cw[4][8];
#pragma unroll
    for (int j = 0; j < 4; ++j) {
      const f32x4 a = *(const f32x4*)(p.conv_w + (size_t)(l * 4 + j) * 3072 + ch0), c = *(const f32x4*)(p.conv_w + (size_t)(l * 4 + j) * 3072 + ch0 + 4);
      cw[j][0] = a.x; cw[j][1] = a.y; cw[j][2] = a.z; cw[j][3] = a.w; cw[j][4] = c.x; cw[j][5] = c.y; cw[j][6] = c.z; cw[j][7] = c.w;
    }
    const int ib = wid * 16 + fq * 4;
#pragma unroll
    for (int it = 0; it < 4; ++it) {
      float o[8];
#pragma unroll
      for (int c = 0; c < 8; ++c) o[c] = 0.f;
#pragma unroll
      for (int j = 0; j < 4; ++j) {
        float f[8];
        UNPACK8(rwall[sect][it + j], f);
#pragma unroll
        for (int c = 0; c < 8; ++c) o[c] += f[c] * cw[j][c];
      }
      float ss = 0.f;
#pragma unroll
      for (int c = 0; c < 8; ++c) { o[c] = silu(o[c]); ss += o[c] * o[c]; }
      if (sect < 2) {
        ss += shx(ss, 1, lane); ss += shx(ss, 2, lane); ss += shx(ss, 4, lane); ss += shx(ss, 8, lane);
        float rn = __builtin_amdgcn_rsqf(ss + EPS);
        if (sect == 0) rn *= 0.08838834764831845f;
#pragma unroll
        for (int c = 0; c < 8; ++c) o[c] *= rn;
      }
      const u32x4 pk = (u32x4){pk2(o[0], o[1]), pk2(o[2], o[3]), pk2(o[4], o[5]), pk2(o[6], o[7])};
      bf16_t* dst = sect == 0 ? qh + (ib + it) * 136 + fr * 8 : (sect == 1 ? kh + (ib + it) * 136 + fr * 8 : vh + (ib + it) * 136 + fr * 8);
      *(u32x4*)dst = pk;
    }
  }
  __syncthreads();
  {
    const int i = wid * 16 + fr;
    const float gi = sgc[i], bi = sbeta[i];
    bf16x8 kx[4], qx[4];
#pragma unroll
    for (int ks = 0; ks < 4; ++ks) {
      kx[ks] = *(const bf16x8*)(kh + i * 136 + ks * 32 + fq * 8);
      qx[ks] = *(const bf16x8*)(qh + i * 136 + ks * 32 + fq * 8);
    }
#pragma unroll
    for (int jt = 0; jt < 4; ++jt) {
      f32x4 akk = (f32x4){0.f, 0.f, 0.f, 0.f}, aqk = (f32x4){0.f, 0.f, 0.f, 0.f};
      if (jt <= wid) {
#pragma unroll
        for (int ks = 0; ks < 4; ++ks) {
          const bf16x8 kj = *(const bf16x8*)(kh + (jt * 16 + fr) * 136 + ks * 32 + fq * 8);
          akk = mfma16(kj, kx[ks], akk);
          aqk = mfma16(kj, qx[ks], aqk);
        }
      }
      const int j0 = jt * 16 + fq * 4;
      float av[4], qv[4];
#pragma unroll
      for (int jj = 0; jj < 4; ++jj) {
        const int j = j0 + jj;
        const float dec = j <= i ? __expf(gi - sgc[j]) : 0.f;
        av[jj] = j < i ? bi * akk[jj] * dec : 0.f;
        qv[jj] = aqk[jj] * dec;
      }
      *(f32x4*)(Am + i * 64 + j0) = (f32x4){av[0], av[1], av[2], av[3]};
      *(u32x2*)(g_qk + i * 64 + j0) = (u32x2){pk2(qv[0], qv[1]), pk2(qv[2], qv[3])};
    }
  }
  __syncthreads();
  {
    float x[64];
    const bool isu = tid < 128;
    const int cc = tid & 127;
    solve_rows<0>(x, Am, (isu ? vh : kh) + cc, isu ? sbeta : sbe);
    if (isu) {
      u32x4* d = (u32x4*)(g_uT + cc * 64);
#pragma unroll
      for (int q = 0; q < 8; ++q) d[q] = (u32x4){pk2(x[q * 8], x[q * 8 + 1]), pk2(x[q * 8 + 2], x[q * 8 + 3]), pk2(x[q * 8 + 4], x[q * 8 + 5]), pk2(x[q * 8 + 6], x[q * 8 + 7])};
    } else {
#pragma unroll
      for (int i = 0; i < 64; ++i) g_w[i * 128 + cc] = f2bf(x[i]);
    }
  }
  {
    const float gl = sgc[63];
#pragma unroll
    for (int q = 0; q < 4; ++q) {
      const int pc = tid + q * 256, i = pc >> 4, c8 = pc & 15;
      const u32x4 v = *(const u32x4*)(qh + i * 136 + c8 * 8);
      float f[8];
      UNPACK8(v, f);
      const float s = seg[i];
      *(u32x4*)(g_qg + i * 128 + c8 * 8) = (u32x4){pk2(f[0] * s, f[1] * s), pk2(f[2] * s, f[3] * s), pk2(f[4] * s, f[5] * s), pk2(f[6] * s, f[7] * s)};
    }
    if (tid >= 128) {
      const int dk = tid - 128;
      u32x4* d = (u32x4*)(g_kgT + dk * 64);
#pragma unroll
      for (int q = 0; q < 8; ++q) {
        float f[8];
#pragma unroll
        for (int c = 0; c < 8; ++c) { const int i = q * 8 + c; f[c] = bf2f(kh[i * 136 + dk]) * sek[i]; }
        d[q] = (u32x4){pk2(f[0], f[1]), pk2(f[2], f[3]), pk2(f[4], f[5]), pk2(f[6], f[7])};
      }
    }
    if (tid == 0) p.gsc()[item] = __expf(gl);
  }
  __syncthreads();
}

__device__ void gdn_scan_item(const Params& p, int l, int item, unsigned char* smem) {
  const int tid = (opq(threadIdx.x) & 255), lane = tid & 63, wid = tid >> 6, fr = lane & 15, fq = lane >> 4;
  const int dvs = item & 3, h = (item >> 2) & 7, b = item >> 5;
  bf16_t* ST = (bf16_t*)smem;
  bf16_t* VT = ST + 2 * 32 * 136;
  f32x4 S[2][2];
#pragma unroll
  for (int a = 0; a < 2; ++a)
#pragma unroll
    for (int c = 0; c < 2; ++c) S[a][c] = (f32x4){0.f, 0.f, 0.f, 0.f};
  __syncthreads();
  bf16x8 fw[4], fqg[4], fqk[2], fkg[2][2];
  u32x2 fu[2];
  float gs;
  bf16x8 nw[4], nqg[4], nqk[2], nkg[2][2];
  u32x2 nu[2];
  float ngs;
#define SCAN_LOAD(n_, W, QG, QK, KG, U, GS) do { \
    const int it_ = ((b * 32 + (n_)) << 3) + h; \
    const unsigned char* scr_ = (const unsigned char*)p.scr() + (size_t)it_ * SCR_ITEM; \
    const bf16_t* g_uT = (const bf16_t*)scr_; const bf16_t* g_w = (const bf16_t*)(scr_ + 16384); const bf16_t* g_qg = (const bf16_t*)(scr_ + 32768); \
    const bf16_t* g_kgT = (const bf16_t*)(scr_ + 49152); const bf16_t* g_qk = (const bf16_t*)(scr_ + 65536); \
    _Pragma("unroll") for (int ks = 0; ks < 4; ++ks) { \
      W[ks] = *(const bf16x8*)(g_w + (wid * 16 + fr) * 128 + ks * 32 + fq * 8); \
      QG[ks] = *(const bf16x8*)(g_qg + (wid * 16 + fr) * 128 + ks * 32 + fq * 8); } \
    _Pragma("unroll") for (int ks = 0; ks < 2; ++ks) { \
      QK[ks] = *(const bf16x8*)(g_qk + (wid * 16 + fr) * 64 + ks * 32 + fq * 8); \
      _Pragma("unroll") for (int mt = 0; mt < 2; ++mt) KG[mt][ks] = *(const bf16x8*)(g_kgT + ((2 * wid + mt) * 16 + fr) * 64 + ks * 32 + fq * 8); } \
    _Pragma("unroll") for (int nt = 0; nt < 2; ++nt) U[nt] = *(const u32x2*)(g_uT + (dvs * 32 + nt * 16 + fr) * 64 + wid * 16 + fq * 4); \
    GS = p.gsc()[it_]; } while (0)
  SCAN_LOAD(0, nw, nqg, nqk, nkg, nu, ngs);
  for (int n = 0; n < 32; ++n) {
#pragma unroll
    for (int ks = 0; ks < 4; ++ks) { fw[ks] = nw[ks]; fqg[ks] = nqg[ks]; }
#pragma unroll
    for (int ks = 0; ks < 2; ++ks) { fqk[ks] = nqk[ks]; fkg[0][ks] = nkg[0][ks]; fkg[1][ks] = nkg[1][ks]; }
    fu[0] = nu[0]; fu[1] = nu[1]; gs = ngs;
    { const int n1 = n + 1 < 32 ? n + 1 : 31; SCAN_LOAD(n1, nw, nqg, nqk, nkg, nu, ngs); }
    bf16_t* STc = ST + (n & 1) * 32 * 136;
#pragma unroll
    for (int mt = 0; mt < 2; ++mt)
#pragma unroll
      for (int nt = 0; nt < 2; ++nt)
        *(u32x2*)(STc + (nt * 16 + fr) * 136 + (2 * wid + mt) * 16 + fq * 4) = (u32x2){pk2(S[mt][nt].x, S[mt][nt].y), pk2(S[mt][nt].z, S[mt][nt].w)};
    __syncthreads();
#pragma unroll
    for (int nt = 0; nt < 2; ++nt) {
      f32x4 a = (f32x4){0.f, 0.f, 0.f, 0.f};
#pragma unroll
      for (int ks = 0; ks < 4; ++ks) {
        const bf16x8 sb = *(const bf16x8*)(STc + (nt * 16 + fr) * 136 + ks * 32 + fq * 8);
        a = mfma16(fw[ks], sb, a);
      }
      const float v0 = lo2f(fu[nt].x) - a.x, v1 = hi2f(fu[nt].x) - a.y, v2 = lo2f(fu[nt].y) - a.z, v3 = hi2f(fu[nt].y) - a.w;
      *(u32x2*)(VT + (nt * 16 + fr) * 72 + wid * 16 + fq * 4) = (u32x2){pk2(v0, v1), pk2(v2, v3)};
    }
    __syncthreads();
#pragma unroll
    for (int mt = 0; mt < 2; ++mt) {
      f32x4 a = (f32x4){0.f, 0.f, 0.f, 0.f};
#pragma unroll
      for (int ks = 0; ks < 4; ++ks) {
        const bf16x8 sa = *(const bf16x8*)(STc + (mt * 16 + fr) * 136 + ks * 32 + fq * 8);
        a = mfma16(sa, fqg[ks], a);
      }
#pragma unroll
      for (int ks = 0; ks < 2; ++ks) {
        const bf16x8 va = *(const bf16x8*)(VT + (mt * 16 + fr) * 72 + ks * 32 + fq * 8);
        a = mfma16(va, fqk[ks], a);
      }
      const size_t row = (size_t)b * 2048 + n * 64 + wid * 16 + fr;
      *(u32x2*)(p.ogdn() + row * DM + h * 128 + dvs * 32 + mt * 16 + fq * 4) = (u32x2){pk2(a.x, a.y), pk2(a.z, a.w)};
    }
#pragma unroll
    for (int mt = 0; mt < 2; ++mt)
#pragma unroll
      for (int nt = 0; nt < 2; ++nt) {
        f32x4 a = S[mt][nt] * gs;
#pragma unroll
        for (int ks = 0; ks < 2; ++ks) {
          const bf16x8 vb = *(const bf16x8*)(VT + (nt * 16 + fr) * 72 + ks * 32 + fq * 8);
          a = mfma16(fkg[mt][ks], vb, a);
        }
        S[mt][nt] = a;
      }
  }
  float* so = p.out + O_GDNP + ((size_t)(l * 8 + b) * 8 + h) * 16384;
#pragma unroll
  for (int mt = 0; mt < 2; ++mt)
#pragma unroll
    for (int nt = 0; nt < 2; ++nt)
#pragma unroll
      for (int jj = 0; jj < 4; ++jj) so[((2 * wid + mt) * 16 + fq * 4 + jj) * 128 + dvs * 32 + nt * 16 + fr] = S[mt][nt][jj];
  __syncthreads();
#undef SCAN_LOAD
}

__device__ void gdn_sample_item(const Params& p, int l, int item, unsigned char* smem) {
  const int tid = (opq(threadIdx.x) & 255), lane = tid & 63, wid = tid >> 6;
  const int h = item & 7, b = item >> 3;
  float* qs = (float*)smem;
  float* ks = qs + 1024;
  float* vs = ks + 1024;
  float* part = vs + 1024;
  float* sbeta = part + 256;
  float* sa = sbeta + 8;
  const int dv = tid & 127, half = tid >> 7;
  float S[64];
  const float* s0 = p.state_gdn + ((size_t)(l * 128 + b) * 8 + h) * 16384 + (half * 8192 + dv);
#pragma unroll
  for (int k = 0; k < 64; ++k) S[k] = s0[k * 128];
#pragma unroll
  for (int ps = 0; ps < 2; ++ps) {
    const int c = tid + ps * 256;
    if (c < 384) {
      const int sect = c >> 7, ci = c & 127;
      const int ch = sect * 1024 + h * 128 + ci;
      float xw[11], cwv[4];
#pragma unroll
      for (int j = 0; j < 4; ++j) cwv[j] = p.conv_w[(size_t)(l * 4 + j) * 3072 + ch];
#pragma unroll
      for (int j = 0; j < 3; ++j) xw[j] = p.cache_conv[((size_t)(l * 128 + b) * 3 + j) * 3072 + ch];
#pragma unroll
      for (int t = 0; t < 8; ++t) xw[3 + t] = bf2f(p.proj()[(size_t)(MP + b * 8 + t) * NPJ + ch]);
      float* dst = sect == 0 ? qs : (sect == 1 ? ks : vs);
#pragma unroll
      for (int t = 0; t < 8; ++t) dst[t * 128 + ci] = silu(xw[t] * cwv[0] + xw[t + 1] * cwv[1] + xw[t + 2] * cwv[2] + xw[t + 3] * cwv[3]);
    }
  }
  if (tid < 8) {
    const float* lg = p.logits() + (size_t)(MP + b * 8 + tid) * 16;
    const float x = lg[8 + h] + p.dt_bias[l * 8 + h];
    const float sp = softplus_f(x);
    sa[tid] = __expf(-__expf(p.a_log[l * 8 + h]) * sp);
    sbeta[tid] = sigm(lg[h]);
  }
  __syncthreads();
#pragma unroll
  for (int u = 0; u < 4; ++u) {
    const int t = wid * 2 + (u >> 1);
    float* arr = (u & 1) ? ks : qs;
    const float a0 = arr[t * 128 + lane], a1 = arr[t * 128 + 64 + lane];
    float ss = a0 * a0 + a1 * a1;
#pragma unroll
    for (int o = 1; o < 64; o <<= 1) ss += shx(ss, o, lane);
    float rn = __builtin_amdgcn_rsqf(ss + EPS);
    if (!(u & 1)) rn *= 0.08838834764831845f;
    arr[t * 128 + lane] = a0 * rn;
    arr[t * 128 + 64 + lane] = a1 * rn;
  }
  __syncthreads();
#pragma unroll 1
  for (int t = 0; t < 8; ++t) {
    const float a = sa[t], bt = sbeta[t];
    float kv = 0.f;
#pragma unroll
    for (int k4 = 0; k4 < 16; ++k4) {
      const f32x4 kk = *(const f32x4*)(ks + t * 128 + half * 64 + k4 * 4);
      S[k4 * 4 + 0] *= a; S[k4 * 4 + 1] *= a; S[k4 * 4 + 2] *= a; S[k4 * 4 + 3] *= a;
      kv += S[k4 * 4 + 0] * kk.x + S[k4 * 4 + 1] * kk.y + S[k4 * 4 + 2] * kk.z + S[k4 * 4 + 3] * kk.w;
      if ((k4 & 3) == 3) asm volatile("" ::: "memory");
    }
    part[half * 128 + dv] = kv;
    __syncthreads();
    const float delta = bt * (vs[t * 128 + dv] - (part[dv] + part[128 + dv]));
    __syncthreads();
    float o = 0.f;
#pragma unroll
    for (int k4 = 0; k4 < 16; ++k4) {
      const f32x4 kk = *(const f32x4*)(ks + t * 128 + half * 64 + k4 * 4);
      const f32x4 qq = *(const f32x4*)(qs + t * 128 + half * 64 + k4 * 4);
      S[k4 * 4 + 0] += kk.x * delta; S[k4 * 4 + 1] += kk.y * delta; S[k4 * 4 + 2] += kk.z * delta; S[k4 * 4 + 3] += kk.w * delta;
      o += S[k4 * 4 + 0] * qq.x + S[k4 * 4 + 1] * qq.y + S[k4 * 4 + 2] * qq.z + S[k4 * 4 + 3] * qq.w;
      if ((k4 & 3) == 3) asm volatile("" ::: "memory");
    }
    part[half * 128 + dv] = o;
    __syncthreads();
    if (half == 0) p.ogdn()[(size_t)(MP + b * 8 + t) * DM + h * 128 + dv] = f2bf(part[dv] + part[128 + dv]);
    __syncthreads();
  }
  float* so = p.out + O_GDNS + ((size_t)(l * 128 + b) * 8 + h) * 16384 + opq(half * 8192 + dv);
#pragma unroll
  for (int k = 0; k < 64; ++k) so[k * 128] = S[k];
  __syncthreads();
}

__device__ void gdn_sample_pair(const Params& p, int l, int pair, unsigned char* smem) {
  const int tid = (opq(threadIdx.x) & 255), lane = tid & 63, wid = tid >> 6;
  const int sub = tid >> 7, dv = tid & 127;
  const int item = pair * 2 + sub, h = item & 7, b = item >> 3;
  float* qs = (float*)smem + sub * 3104;
  float* ks = qs + 1024;
  float* vs = qs + 2048;
  float* sbeta = qs + 3072;
  float* sa = qs + 3080;
  f32x2 S2[64];
  const float* s0 = p.state_gdn + ((size_t)(l * 128 + b) * 8 + h) * 16384 + dv;
#pragma unroll
  for (int k = 0; k < 64; ++k) { S2[k].x = s0[(2 * k) * 128]; S2[k].y = s0[(2 * k + 1) * 128]; }
#pragma unroll
  for (int sect = 0; sect < 3; ++sect) {
    const int ch = sect * 1024 + h * 128 + dv;
    float xw[11], cwv[4];
#pragma unroll
    for (int j = 0; j < 4; ++j) cwv[j] = p.conv_w[(size_t)(l * 4 + j) * 3072 + ch];
#pragma unroll
    for (int j = 0; j < 3; ++j) xw[j] = p.cache_conv[((size_t)(l * 128 + b) * 3 + j) * 3072 + ch];
#pragma unroll
    for (int t = 0; t < 8; ++t) xw[3 + t] = bf2f(p.proj()[(size_t)(MP + b * 8 + t) * NPJ + ch]);
    float* dst = sect == 0 ? qs : (sect == 1 ? ks : vs);
#pragma unroll
    for (int t = 0; t < 8; ++t) dst[t * 128 + dv] = silu(xw[t] * cwv[0] + xw[t + 1] * cwv[1] + xw[t + 2] * cwv[2] + xw[t + 3] * cwv[3]);
  }
  if (dv < 8) {
    const float* lg = p.logits() + (size_t)(MP + b * 8 + dv) * 16;
    const float x = lg[8 + h] + p.dt_bias[l * 8 + h];
    sa[dv] = __expf(-__expf(p.a_log[l * 8 + h]) * softplus_f(x));
    sbeta[dv] = sigm(lg[h]);
  }
  __syncthreads();
#pragma unroll
  for (int u = 0; u < 8; ++u) {
    const int t = (wid & 1) * 4 + (u >> 1);
    float* arr = (u & 1) ? ks : qs;
    const float a0 = arr[t * 128 + lane], a1 = arr[t * 128 + 64 + lane];
    float ss = a0 * a0 + a1 * a1;
#pragma unroll
    for (int o = 1; o < 64; o <<= 1) ss += shx(ss, o, lane);
    float rn = __builtin_amdgcn_rsqf(ss + EPS);
    if (!(u & 1)) rn *= 0.08838834764831845f;
    arr[t * 128 + lane] = a0 * rn;
    arr[t * 128 + 64 + lane] = a1 * rn;
  }
  __syncthreads();
#pragma unroll 1
  for (int t = 0; t < 8; ++t) {
    const float a = sa[t], bt = sbeta[t];
    f32x2 kv2 = (f32x2){0.f, 0.f};
#pragma unroll
    for (int k4 = 0; k4 < 32; ++k4) {
      const f32x4 kk = *(const f32x4*)(ks + t * 128 + k4 * 4);
      kv2 += S2[2 * k4] * (f32x2){kk.x, kk.y};
      kv2 += S2[2 * k4 + 1] * (f32x2){kk.z, kk.w};
      if ((k4 & 3) == 3) asm volatile("" ::: "memory");
    }
    const float delta = bt * (vs[t * 128 + dv] - a * (kv2.x + kv2.y));
    const f32x2 a2 = (f32x2){a, a}, d2 = (f32x2){delta, delta};
    f32x2 o2 = (f32x2){0.f, 0.f};
#pragma unroll
    for (int k4 = 0; k4 < 32; ++k4) {
      const f32x4 kk = *(const f32x4*)(ks + t * 128 + k4 * 4);
      const f32x4 qq = *(const f32x4*)(qs + t * 128 + k4 * 4);
      S2[2 * k4] = S2[2 * k4] * a2 + (f32x2){kk.x, kk.y} * d2;
      S2[2 * k4 + 1] = S2[2 * k4 + 1] * a2 + (f32x2){kk.z, kk.w} * d2;
      o2 += S2[2 * k4] * (f32x2){qq.x, qq.y};
      o2 += S2[2 * k4 + 1] * (f32x2){qq.z, qq.w};
      if ((k4 & 3) == 3) asm volatile("" ::: "memory");
    }
    p.ogdn()[(size_t)(MP + b * 8 + t) * DM + h * 128 + dv] = f2bf(o2.x + o2.y);
  }
  float* so = p.out + O_GDNS + ((size_t)(l * 128 + b) * 8 + h) * 16384 + opq(dv);
#pragma unroll
  for (int k = 0; k < 64; ++k) { so[(2 * k) * 128] = S2[k].x; so[(2 * k + 1) * 128] = S2[k].y; }
  __syncthreads();
}

__device__ void swa_prompt_item(const Params& p, int l, int item, unsigned char* smem) {
  const int tid = (opq(threadIdx.x) & 255), lane = tid & 63, wid = tid >> 6, fr = lane & 15, fq = lane >> 4;
  const int kvh = item & 3, hb2 = (item >> 2) & 31, b = item >> 7;
  bf16_t* Ks = (bf16_t*)smem;
  bf16_t* VT = Ks + 208 * 72;
  bf16_t* Pw = VT + 64 * 216 + wid * 16 * 168;
  const int tk0 = hb2 * 64 - 128;
  u32x4 krw[7], vrw[7];
#pragma unroll
  for (int i = 0; i < 7; ++i) {
    const int pc = tid + i * NTHR, kj = pc >> 3, c8 = pc & 7, tk = tk0 + kj;
    krw[i] = (u32x4){0u, 0u, 0u, 0u}; vrw[i] = (u32x4){0u, 0u, 0u, 0u};
    if (pc < 208 * 8 && kj < 192 && tk >= 0) {
      const bf16_t* base = p.proj() + (size_t)(b * 2048 + tk) * NPJ + kvh * 64 + c8 * 8;
      krw[i] = *(const u32x4*)(base + C_SK); vrw[i] = *(const u32x4*)(base + C_SV);
    }
  }
#pragma unroll
  for (int i = 0; i < 7; ++i) {
    const int pc = tid + i * NTHR;
    if (pc >= 208 * 8) break;
    const int kj = pc >> 3, c8 = pc & 7, tk = tk0 + kj;
    const bool ok = kj < 192 && tk >= 0;
    float kf[8], vf[8];
    UNPACK8(krw[i], kf);
    UNPACK8(vrw[i], vf);
    float ss = 0.f;
#pragma unroll
    for (int c = 0; c < 8; ++c) ss += kf[c] * kf[c];
    ss += shx(ss, 1, lane); ss += shx(ss, 2, lane); ss += shx(ss, 4, lane);
    const float rn = __builtin_amdgcn_rsqf(ss * (1.f / 64.f) + EPS);
    const f32x4 w0 = *(const f32x4*)(p.k_norm + l * 64 + c8 * 8), w1 = *(const f32x4*)(p.k_norm + l * 64 + c8 * 8 + 4);
    kf[0] *= rn * w0.x; kf[1] *= rn * w0.y; kf[2] *= rn * w0.z; kf[3] *= rn * w0.w;
    kf[4] *= rn * w1.x; kf[5] *= rn * w1.y; kf[6] *= rn * w1.z; kf[7] *= rn * w1.w;
    *(u32x4*)(Ks + kj * 72 + c8 * 8) = (u32x4){pk2(kf[0], kf[1]), pk2(kf[2], kf[3]), pk2(kf[4], kf[5]), pk2(kf[6], kf[7])};
#pragma unroll
    for (int c = 0; c < 8; ++c) VT[(c8 * 8 + c) * 216 + kj] = f2bf(vf[c]);
    if (ok && tk >= 1920 && kj >= 128) {
      float* ko = p.out + O_KP + (((size_t)(l * 8 + b) * 128 + (tk - 1920)) * 4 + kvh) * 64 + c8 * 8;
      float* vo = p.out + O_VP + (((size_t)(l * 8 + b) * 128 + (tk - 1920)) * 4 + kvh) * 64 + c8 * 8;
      *(f32x4*)ko = (f32x4){kf[0], kf[1], kf[2], kf[3]};
      *(f32x4*)(ko + 4) = (f32x4){kf[4], kf[5], kf[6], kf[7]};
      *(f32x4*)vo = (f32x4){vf[0], vf[1], vf[2], vf[3]};
      *(f32x4*)(vo + 4) = (f32x4){vf[4], vf[5], vf[6], vf[7]};
    }
  }
  __syncthreads();
  const int kbase = wid * 16;
  const int ql = wid * 16 + fr;
  const size_t qrow = (size_t)b * 2048 + hb2 * 64 + ql;
  u32x4 qraw[4][2];
#pragma unroll
  for (int g = 0; g < 4; ++g) {
    const bf16_t* qp = p.proj() + qrow * NPJ + C_SQ + (kvh * 4 + g) * 64 + fq * 8;
    qraw[g][0] = *(const u32x4*)qp; qraw[g][1] = *(const u32x4*)(qp + 32);
  }
#pragma unroll
  for (int g = 0; g < 4; ++g) {
    const int head = kvh * 4 + g;
    const float slope = exp2f(-0.5f * (float)(head + 1));
    const float sink = p.sinks[l * 16 + head];
    bf16x8 qf[2];
    {
      const u32x4 r0 = qraw[g][0], r1 = qraw[g][1];
      float f0[8], f1[8];
      UNPACK8(r0, f0);
      UNPACK8(r1, f1);
      float ss = 0.f;
#pragma unroll
      for (int c = 0; c < 8; ++c) ss += f0[c] * f0[c] + f1[c] * f1[c];
      ss += shx(ss, 16, lane); ss += shx(ss, 32, lane);
      const float rn = __builtin_amdgcn_rsqf(ss * (1.f / 64.f) + EPS) * 0.125f;
      const float* qn = p.q_norm + l * 64 + fq * 8;
#pragma unroll
      for (int c = 0; c < 8; ++c) { f0[c] *= rn * qn[c]; f1[c] *= rn * qn[32 + c]; }
      qf[0] = as_bf((u32x4){pk2(f0[0], f0[1]), pk2(f0[2], f0[3]), pk2(f0[4], f0[5]), pk2(f0[6], f0[7])});
      qf[1] = as_bf((u32x4){pk2(f1[0], f1[1]), pk2(f1[2], f1[3]), pk2(f1[4], f1[5]), pk2(f1[6], f1[7])});
    }
    f32x4 sc[9];
    float mx = sink;
#pragma unroll
    for (int kt = 0; kt < 9; ++kt) {
      f32x4 a = (f32x4){0.f, 0.f, 0.f, 0.f};
#pragma unroll
      for (int ks = 0; ks < 2; ++ks) {
        const bf16x8 kf = *(const bf16x8*)(Ks + (kbase + kt * 16 + fr) * 72 + ks * 32 + fq * 8);
        a = mfma16(kf, qf[ks], a);
      }
#pragma unroll
      for (int jj = 0; jj < 4; ++jj) {
        const int kj = kbase + kt * 16 + fq * 4 + jj;
        const int dist = ql + 128 - kj;
        const bool ok = dist >= 0 && dist <= 128 && (tk0 + kj) >= 0;
        const float s = ok ? a[jj] - slope * (float)dist : -INFINITY;
        a[jj] = s;
        mx = fmaxf(mx, s);
      }
      sc[kt] = a;
    }
    mx = fmaxf(mx, shx(mx, 16, lane));
    mx = fmaxf(mx, shx(mx, 32, lane));
    float sum = 0.f;
#pragma unroll
    for (int kt = 0; kt < 9; ++kt) {
      f32x4 e;
#pragma unroll
      for (int jj = 0; jj < 4; ++jj) { e[jj] = __expf(sc[kt][jj] - mx); sum += e[jj]; }
      *(u32x2*)(Pw + fr * 168 + kt * 16 + fq * 4) = (u32x2){pk2(e.x, e.y), pk2(e.z, e.w)};
    }
    *(u32x2*)(Pw + fr * 168 + 144 + fq * 4) = (u32x2){0u, 0u};
    sum += shx(sum, 16, lane);
    sum += shx(sum, 32, lane);
    const float inv = __builtin_amdgcn_rcpf(sum + __expf(sink - mx));
    __builtin_amdgcn_wave_barrier();
#pragma unroll
    for (int dt = 0; dt < 4; ++dt) {
      f32x4 a = (f32x4){0.f, 0.f, 0.f, 0.f};
#pragma unroll
      for (int ks = 0; ks < 5; ++ks) {
        const bf16x8 vf = *(const bf16x8*)(VT + (dt * 16 + fr) * 216 + kbase + ks * 32 + fq * 8);
        const bf16x8 pf = *(const bf16x8*)(Pw + fr * 168 + ks * 32 + fq * 8);
        a = mfma16(vf, pf, a);
      }
      a *= inv;
      *(u32x2*)(p.oswa() + qrow * DM + head * 64 + dt * 16 + fq * 4) = (u32x2){pk2(a.x, a.y), pk2(a.z, a.w)};
    }
    __builtin_amdgcn_wave_barrier();
  }
  __syncthreads();
}

__device__ void swa_sample_item(const Params& p, int l, int item, unsigned char* smem) {
  const int tid = (opq(threadIdx.x) & 255), lane = tid & 63, wid = tid >> 6;
  const int kvh = item & 3, b = item >> 2;
  float* Ks = (float*)smem;
  float* Vs = Ks + 136 * 68;
  float* Qs = Vs + 136 * 64;
  float* Sc = Qs + 512;
  const size_t cbase = (size_t)(l * 128 + b) * 128;
  f32x4 kvr[8], vvr[8];
#pragma unroll
  for (int i = 0; i < 8; ++i) {
    const int idx = tid + i * NTHR, j = idx >> 4, c4 = idx & 15;
    kvr[i] = *(const f32x4*)(p.cache_k + ((cbase + j) * 4 + kvh) * 64 + c4 * 4);
    vvr[i] = *(const f32x4*)(p.cache_v + ((cbase + j) * 4 + kvh) * 64 + c4 * 4);
  }
  unsigned qrw[4];
#pragma unroll
  for (int g = 0; g < 4; ++g) qrw[g] = *(const unsigned*)(p.proj() + (size_t)(MP + b * 8 + (tid >> 5)) * NPJ + C_SQ + (kvh * 4 + g) * 64 + (tid & 31) * 2);
#pragma unroll
  for (int i = 0; i < 8; ++i) {
    const int idx = tid + i * NTHR, j = idx >> 4, c4 = idx & 15;
    const f32x4 kv = kvr[i], vv = vvr[i];
    *(f32x4*)(Ks + j * 68 + c4 * 4) = kv;
    *(f32x4*)(Vs + j * 64 + c4 * 4) = vv;
  }
  {
    const int t = tid >> 5, d = (tid & 31) * 2;
    const bf16_t* base = p.proj() + (size_t)(MP + b * 8 + t) * NPJ + kvh * 64 + d;
    const unsigned kr = *(const unsigned*)(base + C_SK), vr = *(const unsigned*)(base + C_SV);
    float k0 = lo2f(kr), k1 = hi2f(kr);
    float ss = k0 * k0 + k1 * k1;
#pragma unroll
    for (int o = 1; o < 32; o <<= 1) ss += shx(ss, o, lane);
    const float rn = __builtin_amdgcn_rsqf(ss * (1.f / 64.f) + EPS);
    Ks[(128 + t) * 68 + d] = k0 * rn * p.k_norm[l * 64 + d];
    Ks[(128 + t) * 68 + d + 1] = k1 * rn * p.k_norm[l * 64 + d + 1];
    Vs[(128 + t) * 64 + d] = lo2f(vr);
    Vs[(128 + t) * 64 + d + 1] = hi2f(vr);
  }
  __syncthreads();
  for (int idx = tid; idx < 128 * 64; idx += NTHR) {
    const int j = idx >> 6, d = idx & 63;
    p.out[O_KS + ((cbase + j) * 4 + kvh) * 64 + d] = Ks[(j + 8) * 68 + d];
    p.out[O_VS + ((cbase + j) * 4 + kvh) * 64 + d] = Vs[(j + 8) * 64 + d];
  }
#pragma unroll
  for (int g = 0; g < 4; ++g) {
    const int head = kvh * 4 + g;
    const float slope = exp2f(-0.5f * (float)(head + 1));
    const float sink = p.sinks[l * 16 + head];
    {
      const int t = tid >> 5, d = (tid & 31) * 2;
      const unsigned qr = qrw[g];
      const float q0 = lo2f(qr), q1 = hi2f(qr);
      float ss = q0 * q0 + q1 * q1;
#pragma unroll
      for (int o = 1; o < 32; o <<= 1) ss += shx(ss, o, lane);
      const float rn = __builtin_amdgcn_rsqf(ss * (1.f / 64.f) + EPS) * 0.125f;
      Qs[t * 64 + d] = q0 * rn * p.q_norm[l * 64 + d];
      Qs[t * 64 + d + 1] = q1 * rn * p.q_norm[l * 64 + d + 1];
    }
    __syncthreads();
    for (int idx = tid; idx < 8 * 136; idx += NTHR) {
      const int tq = idx / 136, j = idx % 136;
      float s = 0.f;
#pragma unroll
      for (int d4 = 0; d4 < 16; ++d4) {
        const f32x4 qv = *(const f32x4*)(Qs + tq * 64 + d4 * 4), kq = *(const f32x4*)(Ks + j * 68 + d4 * 4);
        s += (qv.x * kq.x + qv.y * kq.y) + (qv.z * kq.z + qv.w * kq.w);
      }
      const int dist = tq + 128 - j;
      Sc[tq * 136 + j] = (dist >= 0 && dist <= 128) ? s - slope * (float)dist : -INFINITY;
    }
    __syncthreads();
#pragma unroll
    for (int u = 0; u < 2; ++u) {
      const int tq = wid * 2 + u;
      const float s0 = Sc[tq * 136 + lane], s1 = Sc[tq * 136 + 64 + lane], s2 = lane < 8 ? Sc[tq * 136 + 128 + lane] : -INFINITY;
      float mx = fmaxf(fmaxf(s0, s1), fmaxf(s2, sink));
#pragma unroll
      for (int o = 1; o < 64; o <<= 1) mx = fmaxf(mx, shx(mx, o, lane));
      const float e0 = __expf(s0 - mx), e1 = __expf(s1 - mx), e2 = __expf(s2 - mx);
      float sum = e0 + e1 + e2;
#pragma unroll
      for (int o = 1; o < 64; o <<= 1) sum += shx(sum, o, lane);
      const float inv = __builtin_amdgcn_rcpf(sum + __expf(sink - mx));
      Sc[tq * 136 + lane] = e0 * inv;
      Sc[tq * 136 + 64 + lane] = e1 * inv;
      if (lane < 8) Sc[tq * 136 + 128 + lane] = e2 * inv;
    }
    __syncthreads();
    {
      const int tq = tid >> 5, d = (tid & 31) * 2;
      float o0 = 0.f, o1 = 0.f;
#pragma unroll 2
      for (int j4 = 0; j4 < 34; ++j4) {
        const f32x4 pj = *(const f32x4*)(Sc + tq * 136 + j4 * 4);
        const f32x2 va = *(const f32x2*)(Vs + (j4 * 4 + 0) * 64 + d), vb = *(const f32x2*)(Vs + (j4 * 4 + 1) * 64 + d);
        const f32x2 vc = *(const f32x2*)(Vs + (j4 * 4 + 2) * 64 + d), vd = *(const f32x2*)(Vs + (j4 * 4 + 3) * 64 + d);
        o0 += (pj.x * va.x + pj.y * vb.x) + (pj.z * vc.x + pj.w * vd.x);
        o1 += (pj.x * va.y + pj.y * vb.y) + (pj.z * vc.y + pj.w * vd.y);
      }
      *(unsigned*)(p.oswa() + (size_t)(MP + b * 8 + tq) * DM + head * 64 + d) = pk2(o0, o1);
    }
    __syncthreads();
  }
}

__device__ void phase_mix(const Params& p, int l) {
  const int tid = (opq(threadIdx.x) & 255), lane = tid & 63, wid = tid >> 6, fr = lane & 15, fq = lane >> 4;
  for (int it = VB; it < MTOK / 4; it += VG) {
    const size_t row = (size_t)it * 4 + wid;
#pragma unroll
    for (int ps = 0; ps < 2; ++ps) {
      const int ch = (ps * 4 + fq) * 128 + fr * 8;
      const u32x4 og = *(const u32x4*)(p.ogdn() + row * DM + ch);
      const u32x4 ob = *(const u32x4*)(p.oswa() + row * DM + ch);
      const u32x4 zz = *(const u32x4*)(p.proj() + row * NPJ + C_Z + ch);
      const u32x4 ga = *(const u32x4*)(p.proj() + row * NPJ + C_G + ch);
      const u32x4 gb = *(const u32x4*)(p.proj() + row * NPJ + C_G + 1024 + ch);
      float fo[8], fb[8], fz[8], fa[8], fg[8];
      UNPACK8(og, fo); UNPACK8(ob, fb); UNPACK8(zz, fz); UNPACK8(ga, fa); UNPACK8(gb, fg);
      float ss = 0.f;
#pragma unroll
      for (int c = 0; c < 8; ++c) ss += fo[c] * fo[c];
      ss += shx(ss, 1, lane); ss += shx(ss, 2, lane); ss += shx(ss, 4, lane); ss += shx(ss, 8, lane);
      const float rn = __builtin_amdgcn_rsqf(ss * (1.f / 128.f) + EPS);
      const f32x4 w0 = *(const f32x4*)(p.gdn_norm + l * 128 + fr * 8), w1 = *(const f32x4*)(p.gdn_norm + l * 128 + fr * 8 + 4);
      const float wn[8] = {w0.x, w0.y, w0.z, w0.w, w1.x, w1.y, w1.z, w1.w};
      float m[8];
#pragma unroll
      for (int c = 0; c < 8; ++c) m[c] = sigm(fa[c]) * (fo[c] * rn * wn[c] * silu(fz[c])) + sigm(fg[c]) * fb[c];
      *(u32x4*)(p.mix() + row * DM + ch) = (u32x4){pk2(m[0], m[1]), pk2(m[2], m[3]), pk2(m[4], m[5]), pk2(m[6], m[7])};
    }
  }
  const int NC = (8 + 128) * 3 * 3072;
  for (int i = VB * NTHR + tid; i < NC; i += VG * NTHR) {
    const int c = i % 3072, r = (i / 3072) % 3, bb = i / 9216;
    if (bb < 8) p.out[O_CONVP + ((size_t)(l * 8 + bb) * 3 + r) * 3072 + c] = bf2f(p.proj()[(size_t)(bb * 2048 + 2045 + r) * NPJ + c]);
    else p.out[O_CONVS + ((size_t)(l * 128 + bb - 8) * 3 + r) * 3072 + c] = bf2f(p.proj()[(size_t)(MP + (bb - 8) * 8 + 5 + r) * NPJ + c]);
  }
}

#define XB_TMO      128
#define XB_XCNT(j)  (256  + 64 * (j))
#define XB_XSUB(j)  (1280 + 64 * (j))
#define XB_XGEN(j)  (2304 + 64 * (j))
#define XB_TOP      3328
#define XB_TOPGEN   3392
#define XCD_BAR_WORDS 3456
#define XB_SPIN_CAP (1u << 18)
#define LAS __attribute__((address_space(3)))

__device__ __forceinline__ unsigned xb_ld(unsigned* p)              { return __hip_atomic_load(p, __ATOMIC_RELAXED, __HIP_MEMORY_SCOPE_AGENT); }
__device__ __forceinline__ unsigned xb_add(unsigned* p, unsigned v) { return __hip_atomic_fetch_add(p, v, __ATOMIC_RELAXED, __HIP_MEMORY_SCOPE_AGENT); }
__device__ __forceinline__ unsigned xb_xcc_id() { return (unsigned)__builtin_amdgcn_s_getreg((3 << 11) | 20) & 0xFu; }
#define XB_SPIN(cond, bar) do { unsigned _sp = 0; while (cond) { __builtin_amdgcn_s_sleep(1); \
    if ((++_sp & 255u) == 0u) { if (xb_ld(&(bar)[XB_TMO])) break; if (_sp > XB_SPIN_CAP) { atomicAdd(&(bar)[XB_TMO], 1u); break; } } } } while (0)

struct XcdBarrier {
    unsigned* bar; unsigned x;
    volatile LAS unsigned* st;
};

__device__ __forceinline__ XcdBarrier xcd_barrier_post(unsigned* bar, volatile LAS unsigned* st) {
    XcdBarrier b; b.bar = bar; b.x = xb_xcc_id(); b.st = st;
    if (threadIdx.x == 0) (void)xb_add(&bar[XB_XCNT(b.x)], 1u);
    return b;
}
__device__ __forceinline__ void xcd_barrier_complete(unsigned* bar, unsigned x, unsigned& nloc, unsigned& nx) {
    const unsigned G = gridDim.x * gridDim.y * gridDim.z;
    unsigned sum, cnt, mine, sp = 0u;
    for (;;) {
        sum = 0u; cnt = 0u; mine = 0u;
#pragma unroll
        for (unsigned j = 0; j < 16; ++j) { const unsigned c = xb_ld(&bar[XB_XCNT(j)]); sum += c; cnt += (c > 0u) ? 1u : 0u; mine = (j == x) ? c : mine; }
        if (sum == G) break;
        __builtin_amdgcn_s_sleep(1);
        if ((++sp & 255u) == 0u) { if (xb_ld(&bar[XB_TMO])) break; if (sp > XB_SPIN_CAP) { atomicAdd(&bar[XB_TMO], 1u); break; } }
    }
    nloc = mine > 0u ? mine : 1u; nx = cnt > 0u ? cnt : 1u;
}

__device__ __forceinline__ void xcd_barrier(const XcdBarrier& b) {
    asm volatile("s_waitcnt vmcnt(0)" ::: "memory");
    __syncthreads();
    if (threadIdx.x == 0) {
        unsigned* bar = b.bar;
        __builtin_amdgcn_s_waitcnt(0);
        unsigned nloc = b.st[0], nx = b.st[1];
        if (nloc == 0u) { xcd_barrier_complete(bar, b.x, nloc, nx); b.st[0] = nloc; b.st[1] = nx; }
        const unsigned old = xb_add(&bar[XB_XSUB(b.x)], 1u);
        const unsigned gen = old / nloc;
        if (old + 1u == (gen + 1u) * nloc) {
            __builtin_amdgcn_fence(__ATOMIC_RELEASE, "agent");
            asm volatile("s_waitcnt vmcnt(0)" ::: "memory");
            const unsigned og = xb_add(&bar[XB_TOP], 1u);
            const unsigned tg = og / nx;
            if (og + 1u == (tg + 1u) * nx) xb_add(&bar[XB_TOPGEN], 1u);
            else XB_SPIN(xb_ld(&bar[XB_TOPGEN]) == tg, bar);
            __builtin_amdgcn_fence(__ATOMIC_ACQUIRE, "agent");
            xb_add(&bar[XB_XGEN(b.x)], 1u);
            asm volatile("s_waitcnt vmcnt(0)" ::: "memory");
        } else {
            XB_SPIN(xb_ld(&bar[XB_XGEN(b.x)]) == gen, bar);
            __builtin_amdgcn_fence(__ATOMIC_ACQUIRE, "agent");
            asm volatile("s_waitcnt vmcnt(0)" ::: "memory");
        }
    }
    __syncthreads();
}


#define NPHASE_PRE 2
#define NPHASE_L 8
constexpr int LDS_TOTAL = 2 * SMEM_BYTES;
__global__ void __launch_bounds__(512, 2) mega(Params p, int ph_lo, int ph_hi) {
  extern __shared__ __attribute__((aligned(16))) unsigned char lds_all[];
  if (ph_hi < 0) cg::this_grid().sync();
  __shared__ uint4 xb_words;
  if (threadIdx.x == 0) xb_words = make_uint4(0u, 0u, 0u, 0u);
  __syncthreads();
  XcdBarrier xb = xcd_barrier_post(p.bar(), (volatile LAS unsigned*)&xb_words);
  unsigned char* smem = lds_all + VHALF * SMEM_BYTES;
  for (int ph = ph_lo; ph < ph_hi; ++ph) {
    if (ph > ph_lo) xcd_barrier(xb);
    if (ph == 0) { phase_p0(p, smem); continue; }
    if (ph == 1) {
      {
        EpiArgs e{};
        e.obf = p.pp(); e.ldo = DM;
        DiagSched S; S.nLimit = 1024; S.G = gridDim.x; S.c = blockIdx.x;
        pg8::Gemm g; g.A = p.pb(); g.Bt = p.wt_proj(); g.M = NL * MTOK; g.N = NL * DM; g.K = PLE;
        BigEpi<EPI_PP> E; E.e = e;
        pg8::gemm_phase<BigEpi<EPI_PP>, DiagSched>((PG8_LAS unsigned char*)lds_all, g, S, E, nullptr);
        __syncthreads();
      }
      for (int st = VB; st < 64 * 16; st += VG) {
        const int L = 1024 + (st >> 4), sub = st & 15, l = L / 272, r = L - l * 272, pm = r >> 2, pn = r & 3;
        EpiArgs e{};
        e.obf = p.pp() + (size_t)l * MTOK * DM; e.ldo = DM;
        gemm_tile<1, 4, 4, 1, EPI_PP, 128>(p.pb() + (size_t)l * MTOK * PLE, PLE, p.wt_proj() + (size_t)l * DM * PLE, PLE, PLE, pm * 256 + (sub >> 2) * 64, pn * 256 + (sub & 3) * 64, (bf16_t*)smem, e);
      }
      continue;
    }
    const int l = (ph - NPHASE_PRE) / NPHASE_L, s = (ph - NPHASE_PRE) % NPHASE_L;
#ifndef REPMASK
#define REPMASK 0
#endif
    for (int rep = 0; rep < (((REPMASK >> s) & 1) ? 2 : 1); ++rep) {
    if (rep) xcd_barrier(xb);
    switch (s) {
      case 0: {
        EpiArgs e{};
        e.ssq_in = p.ssq0(); e.obf = p.proj(); e.ldo = NPJ; e.of32 = p.logits();
        const bf16_t* Bt = p.wt_in() + (size_t)l * NIN * DM;
        gemm_big_phase<EPI_PROJ>(p.hb(), Bt, DM, MTOK, NPJ, lds_all, smem, e);
        for (int t = VB; t < 272; t += VG)
          gemm_tile<1, 1, 4, 1, EPI_LOGIT, 128>(p.hb(), DM, Bt + (size_t)NPJ * DM, DM, DM, t * 64, 0, (bf16_t*)smem, e);
      } break;
      case 1: {
        const int nB1 = VG == 512 ? 3072 : 3584;
        for (int t = VB; t < nB1; t += VG) {
          if (t < 2048) gdn_prep_item(p, l, t, smem);
          else if (t < 3072) swa_prompt_item(p, l, t - 2048, smem);
          else swa_sample_item(p, l, t - 3072, smem);
        }
      } break;
      case 2: {
        if (VG == 512) {
          if (VB < 256) {
            const int w = blockIdx.x, q = (w >> 4) * 8 + (w & 7), m = (w >> 3) & 1;
            gdn_scan_item(p, l, q * 4 + m * 2 + VHALF, smem);
          } else {
            gdn_sample_pair(p, l, VB - 256, smem); gdn_sample_pair(p, l, VB, smem);
            swa_sample_item(p, l, (VB - 256) * 2, smem); swa_sample_item(p, l, (VB - 256) * 2 + 1, smem);
          }
        } else {
          for (int t = VB; t < 256 + 512; t += VG) {
            if (t < 256) gdn_scan_item(p, l, t, smem);
            else gdn_sample_pair(p, l, t - 256, smem);
          }
        }
      } break;
      case 3: phase_mix(p, l); break;
      case 4: {
        EpiArgs e{};
        e.hin = p.hb(); e.hb = p.hb2(); e.ssq_out = p.ssq1();
        gemm_big_phase<EPI_RESID>(p.mix(), p.wt_out() + (size_t)l * DM * DM, DM, MTOK, DM, lds_all, smem, e);
      } break;
      case 5: {
        EpiArgs e{};
        e.ssq_in = p.ssq1(); e.obf = p.proj(); e.ldo = DFF;
        gemm_big_phase<EPI_UP>(p.hb2(), p.wt_up() + (size_t)l * DFF * DM, DM, MTOK, DFF, lds_all, smem, e);
      } break;
      case 6: {
        EpiArgs e{};
        e.hin = p.hb2(); e.hb = p.hb2(); e.ssq_out = p.ssq2();
        gemm_big_phase<EPI_RESID>(p.proj(), p.wt_down() + (size_t)l * DM * DFF, DFF, MTOK, DM, lds_all, smem, e);
      } break;
      case 7: {
        EpiArgs e{};
        e.hin = p.hb2(); e.h = (l == NL - 1) ? p.out : nullptr; e.hb = p.hb(); e.ssq_in = p.ssq2(); e.ssq_out = p.ssq0(); e.pp = p.pp() + (size_t)l * MTOK * DM;
        gemm_big_phase<EPI_PLE>(p.hb2(), p.wt_gate() + (size_t)l * DM * DM, DM, MTOK, DM, lds_all, smem, e);
      } break;
    }
    }
  }
}

extern "C" void kernel_launch(void* const* d_in, const int* in_sizes, int n_in, void* d_out, int out_size, void* d_ws, size_t ws_size,
                              hipStream_t stream) {
  Params p{};
  const float* const* in = (const float* const*)d_in;
  p.x_prompt = in[0]; p.x_sample = in[1]; p.cache_conv = in[2]; p.state_gdn = in[3]; p.cache_k = in[4]; p.cache_v = in[5];
  p.p_prompt = in[6]; p.p_sample = in[7]; p.norm_mix = in[8]; p.w_in = in[9]; p.conv_w = in[10]; p.a_log = in[11]; p.dt_bias = in[12];
  p.gdn_norm = in[13]; p.q_norm = in[14]; p.k_norm = in[15]; p.sinks = in[16]; p.w_out = in[17]; p.norm_ffn = in[18]; p.w_up = in[19];
  p.w_down = in[20]; p.norm_ple = in[21]; p.w_gate = in[22]; p.w_proj = in[23];
  p.out = (float*)d_out;
  p.ws = (unsigned char*)d_ws;
  if (WS_TOTAL > ws_size) { fprintf(stderr, "workspace too small: need %zu have %zu\n", (size_t)WS_TOTAL, ws_size); return; }

  static int grid_blocks = 0;
  if (!grid_blocks) {
    int dev = 0, cus = 0, per_cu = 0;
    (void)hipGetDevice(&dev);
    (void)hipDeviceGetAttribute(&cus, hipDeviceAttributeMultiprocessorCount, dev);
    if (hipFuncSetAttribute((const void*)mega, hipFuncAttributeMaxDynamicSharedMemorySize, LDS_TOTAL) != hipSuccess) { fprintf(stderr, "hipFuncSetAttribute(dynamic LDS %d) failed\n", LDS_TOTAL); grid_blocks = -1; return; }
    (void)hipOccupancyMaxActiveBlocksPerMultiprocessor(&per_cu, (const void*)mega, 512, LDS_TOTAL);
    (void)hipGetLastError();
    grid_blocks = cus;
  }
  if (grid_blocks < 0) return;
  (void)hipMemsetAsync(p.ws + WO_bar, 0, (size_t)XCD_BAR_WORDS * 4, stream);
  int lo = 0, hi = NPHASE_PRE + NL * NPHASE_L;
  void* args[] = {&p, &lo, &hi};
  hipError_t e = hipLaunchCooperativeKernel((void*)mega, dim3(grid_blocks), dim3(512), args, LDS_TOTAL, stream);
  if (e != hipSuccess) fprintf(stderr, "cooperative launch failed: %s (grid %d)\n", hipGetErrorString(e), grid_blocks);
}
```
